# Optimizing an MI355X kernel written in HIP

```python
import math
import jax
import jax.numpy as jnp
from jax import lax
import numpy as np


D_MODEL = 1024
BATCH = 16
SEQ = 4096
DEPTH = 2

CTX_LEN = 256
GRID_W = 64
F32 = jnp.float32
BRANCH_WIDTH = 512
N_BRANCH = 3
M_HEADS = 4
M_HEAD_DIM = BRANCH_WIDTH // M_HEADS
M_WIDTH = M_HEADS * M_HEAD_DIM
M_GATES = 4 * M_HEADS
M_CHUNK = 64
M_CONV = 3
W_HEADS = 8
W_KV_HEADS = 2
W_HEAD_DIM = BRANCH_WIDTH // W_HEADS
W_WIDTH = W_HEADS * W_HEAD_DIM
W_KV_WIDTH = W_KV_HEADS * W_HEAD_DIM
WINDOW = 128
W_BLOCK = 128
DF_HEADS = 4
DF_V_DIM = BRANCH_WIDTH // DF_HEADS
DF_QK_DIM = DF_V_DIM // 2
DF_WIDTH = DF_HEADS * DF_V_DIM
DF_QK_WIDTH = DF_HEADS * 2 * DF_QK_DIM
DF_BLOCK = 128
ROPE_DIM = 64
ROPE_BASE = 10000.0
FFN_HIDDEN = -(-8 * D_MODEL // (3 * 256)) * 256
EPS = 1e-6
IN_SIZES = (M_WIDTH, M_WIDTH, M_WIDTH, M_WIDTH, M_GATES,
            W_WIDTH, W_KV_WIDTH, W_KV_WIDTH,
            DF_QK_WIDTH, DF_QK_WIDTH, DF_WIDTH,
            N_BRANCH * D_MODEL)
IN_WIDTH = sum(IN_SIZES)
IN_OFFSETS = tuple(int(o) for o in np.cumsum(IN_SIZES)[:-1])

kernel_name = 'hybrid_mlstm_swa_diffattn_prefix_block'


def rms_norm(x, g):
    xf = x.astype(F32)
    y = xf * lax.rsqrt(jnp.mean(xf * xf, axis=-1, keepdims=True) + EPS)
    return (y * g.astype(F32)).astype(x.dtype)


def head_rms_norm(y, g):
    H, dh = y.shape[-2:]
    return rms_norm(y, g.reshape(H, dh)).reshape(y.shape[:-2] + (H * dh,))


def modulate(x, g, shift, scale):
    return rms_norm(x, g) * (1 + scale) + shift


def adaln(cond, w_mod, b_mod):
    return jnp.split(jax.nn.silu(cond) @ w_mod + b_mod, 6, axis=-1)


def split_heads(a, h):
    return a.reshape(a.shape[:-1] + (h, a.shape[-1] // h))


def axial_rope_tables(n_tokens):
    rows = n_tokens // GRID_W
    r, col = jnp.meshgrid(jnp.arange(rows), jnp.arange(GRID_W), indexing='ij')
    half = ROPE_DIM // 2
    inv = ROPE_BASE ** (-jnp.arange(0, half, 2, dtype=F32) / half)
    ang_r = r.reshape(-1, 1).astype(F32) * inv
    ang_c = col.reshape(-1, 1).astype(F32) * inv
    ang = jnp.concatenate([ang_r, ang_r, ang_c, ang_c], axis=-1)
    return jnp.cos(ang), jnp.sin(ang)


def apply_rope(x, cos, sin):
    xf = x.astype(F32)
    a = xf.reshape(xf.shape[:-1] + (2, 2, ROPE_DIM // 4))
    rot = jnp.concatenate([-a[..., 1:, :], a[..., :1, :]], axis=-2).reshape(xf.shape)
    return (xf * cos[:, None, :] + rot * sin[:, None, :]).astype(x.dtype)


def short_conv(u, w):
    K = w.shape[0]
    p = K // 2
    T = u.shape[1]
    up = jnp.pad(u, ((0, 0), (p, p), (0, 0)))
    return sum(up[:, j:j + T] * w[j] for j in range(K))


def mlstm_inputs(mq, mk, mv, mg, b_gate, conv_w):
    B, T, _ = mq.shape
    qk = jax.nn.silu(short_conv(jnp.concatenate([mq, mk], axis=-1), conv_w))
    heads = lambda a: jnp.transpose(a.astype(F32).reshape(B, T, M_HEADS, M_HEAD_DIM), (0, 2, 1, 3))
    q = heads(qk[..., :M_WIDTH])
    k = heads(qk[..., M_WIDTH:]) * M_HEAD_DIM ** -0.5
    v = heads(mv)
    g = jnp.transpose((mg + b_gate).astype(F32).reshape(B, T, 4, M_HEADS), (2, 0, 3, 1))
    return q, k, v, g


def mlstm_zero_state(b):
    return (jnp.zeros((b, M_HEADS, M_HEAD_DIM, M_HEAD_DIM), F32),
            jnp.zeros((b, M_HEADS, M_HEAD_DIM), F32),
            jnp.zeros((b, M_HEADS), F32))


def mlstm_scan(q, k, v, i_pre, log_f, state, return_h):
    B, H, T, d = q.shape
    nc = T // M_CHUNK
    chunks = lambda a: jnp.moveaxis(a.reshape((B, H, nc, M_CHUNK) + a.shape[3:]), 2, 0)
    causal = jnp.tril(jnp.ones((M_CHUNK, M_CHUNK), dtype=bool))

    def step(carry, inp):
        C, n, m = carry
        qc, kc, vc, ic, fc = inp
        b = jnp.cumsum(fc, axis=-1)
        b_end = b[..., -1]
        log_end = b_end[..., None] - b + ic
        m_new = jnp.maximum(b_end + m, log_end.max(-1))
        w_end = jnp.exp(log_end - m_new[..., None])
        decay = jnp.exp(b_end + m - m_new)
        C_new = decay[..., None, None] * C + jnp.einsum('bhs,bhsv,bhsk->bhvk', w_end, vc, kc)
        n_new = decay[..., None] * n + jnp.einsum('bhs,bhsk->bhk', w_end, kc)
        if not return_h:
            return (C_new, n_new, m_new), None
        log_w = jnp.where(causal, b[..., :, None] - b[..., None, :] + ic[..., None, :], -jnp.inf)
        log_inter = b + m[..., None]
        m_row = jnp.maximum(log_inter, log_w.max(-1))
        w_intra = jnp.exp(log_w - m_row[..., None])
        w_inter = jnp.exp(log_inter - m_row)
        s = jnp.einsum('bhtk,bhsk->bhts', qc, kc) * w_intra
        num = jnp.einsum('bhts,bhsv->bhtv', s, vc) + w_inter[..., None] * jnp.einsum('bhvk,bhtk->bhtv', C, qc)
        den = s.sum(-1) + w_inter * jnp.einsum('bhk,bhtk->bht', n, qc)
        h = num / jnp.maximum(jnp.abs(den), jnp.exp(-m_row))[..., None]
        return (C_new, n_new, m_new), h

    carry, hs = lax.scan(step, state, tuple(chunks(a) for a in (q, k, v, i_pre, log_f)))
    h = jnp.moveaxis(hs, 0, 2).reshape(B, H, T, d) if return_h else None
    return h, carry


def mlstm_bidir(q, k, v, g, st_fwd, st_bwd, return_h):
    i_f, f_f, i_b, f_b = g
    h_f, st_f = mlstm_scan(q, k, v, i_f, jax.nn.log_sigmoid(f_f), st_fwd, return_h)
    rev = lambda a: jnp.flip(a, axis=2)
    h_b, st_b = mlstm_scan(rev(q), rev(k), rev(v), rev(i_b), rev(jax.nn.log_sigmoid(f_b)), st_bwd, return_h)
    h = h_f + rev(h_b) if return_h else None
    return h, st_f, st_b


def mlstm_out(h, o_pre, norm_w):
    B, H, T, d = h.shape
    y = jnp.transpose(h, (0, 2, 1, 3)) * jax.nn.sigmoid(o_pre.astype(F32)).reshape(B, T, H, d)
    return head_rms_norm(y, norm_w).astype(o_pre.dtype)


def _sink_attend(qn, key_sets, sink_l):
    logits = []
    for k, _, valid in key_sets:
        s = jnp.einsum('bqgrd,bkgd->bgrqk', qn, k)
        logits.append(s if valid is None else jnp.where(valid, s, -jnp.inf))
    m = sink_l
    for s in logits:
        m = jnp.maximum(m, s.max(-1))
    e = [jnp.exp(s - m[..., None]) for s in logits]
    den = jnp.exp(sink_l - m) + sum(ei.sum(-1) for ei in e)
    num = sum(jnp.einsum('bgrqk,bkgd->bgrqd', ei, ks[1]) for ei, ks in zip(e, key_sets))
    return jnp.transpose(num / den[..., None], (0, 3, 1, 2, 4))


def window_attention_latent(q, k, v, kc, vc, sink):
    B, T, H, d = q.shape
    G = k.shape[2]
    R = H // G
    nb = T // W_BLOCK
    qb = jnp.moveaxis(q.astype(F32).reshape(B, nb, W_BLOCK, G, R, d), 1, 0) * d ** -0.5
    pad = ((0, 0), (W_BLOCK, W_BLOCK), (0, 0), (0, 0))
    kp = jnp.pad(k.astype(F32), pad)
    vp = jnp.pad(v.astype(F32), pad)
    ctx_set = (kc.astype(F32), vc.astype(F32), None)
    sink_l = sink.astype(F32).reshape(G, R, 1)
    q_off = jnp.arange(W_BLOCK)
    k_off = jnp.arange(3 * W_BLOCK) - W_BLOCK

    def one_block(args):
        n, qn = args
        start = n * W_BLOCK
        kn = lax.dynamic_slice_in_dim(kp, start, 3 * W_BLOCK, axis=1)
        vn = lax.dynamic_slice_in_dim(vp, start, 3 * W_BLOCK, axis=1)
        s_pos = start + k_off
        valid = (jnp.abs(q_off[:, None] - k_off[None, :]) <= WINDOW) & ((s_pos >= 0) & (s_pos < T))[None, :]
        return _sink_attend(qn, ((kn, vn, valid), ctx_set), sink_l)

    out = lax.map(one_block, (jnp.arange(nb), qb))
    return jnp.moveaxis(out, 0, 1).reshape(B, T, H * d)


def window_attention_ctx(q, k, v, sink):
    B, Tc, H, d = q.shape
    G = k.shape[2]
    qn = q.astype(F32).reshape(B, Tc, G, H // G, d) * d ** -0.5
    o = _sink_attend(qn, ((k.astype(F32), v.astype(F32), None),), sink.astype(F32).reshape(G, H // G, 1))
    return o.reshape(B, Tc, H * d)


def _diff_attend(qn, k, v, lam):
    s = jnp.einsum('bqhcd,bkhcd->bchqk', qn, k)
    p = jax.nn.softmax(s, axis=-1)
    return jnp.einsum('bhqk,bkhv->bqhv', p[:, 0] - lam * p[:, 1], v)


def diff_attention_latent(q, k, v, kc, vc, lam):
    B, T, H, _, d = q.shape
    nb = T // DF_BLOCK
    k_all = jnp.concatenate([kc, k], axis=1).astype(F32)
    v_all = jnp.concatenate([vc, v], axis=1).astype(F32)
    qb = jnp.moveaxis(q.astype(F32).reshape(B, nb, DF_BLOCK, H, 2, d), 1, 0) * d ** -0.5
    out = lax.map(lambda qn: _diff_attend(qn, k_all, v_all, lam), qb)
    return jnp.moveaxis(out, 0, 1).reshape(B, T, H, -1)


def diff_out(y, d_norm, lam_init, dt):
    return (head_rms_norm(y, d_norm) * (1 - lam_init)).astype(dt)


def merge_branches(ys, gate_pre, w_branch, w_out):
    B, T, _ = gate_pre.shape
    gates = jax.nn.sigmoid(gate_pre).reshape(B, T, N_BRANCH, D_MODEL)
    merged = sum(gates[..., i, :] * (ys[i] @ w_branch[i]) for i in range(N_BRANCH))
    return merged @ w_out


def swiglu(h, w_in, w_out):
    gate, up = jnp.split(h @ w_in, 2, axis=-1)
    return (jax.nn.silu(gate) * up) @ w_out


def mixer_sublayer(h, hc, w_in, b_gate, conv_w, m_norm, sink, lam, lam_init, d_norm,
                   w_branch, w_out, cos, sin, need_ctx):
    dt = h.dtype
    B, T, _ = h.shape
    Tc = hc.shape[1]
    p = jnp.split(h @ w_in, IN_OFFSETS, axis=-1)
    pc = jnp.split(hc @ w_in, IN_OFFSETS, axis=-1)
    q, k, v, g = mlstm_inputs(p[0], p[1], p[2], p[4], b_gate, conv_w)
    qc, kc, vc, gc = mlstm_inputs(pc[0], pc[1], pc[2], pc[4], b_gate, conv_w)
    zero = mlstm_zero_state(hc.shape[0])
    hm_c, st_f, st_b = mlstm_bidir(qc, kc, vc, gc, zero, zero, need_ctx)
    hm, _, _ = mlstm_bidir(q, k, v, g, st_f, st_b, True)
    ya = mlstm_out(hm, p[3], m_norm)
    wq = apply_rope(split_heads(p[5], W_HEADS), cos, sin)
    wk = apply_rope(split_heads(p[6], W_KV_HEADS), cos, sin)
    wv = split_heads(p[7], W_KV_HEADS)
    wkc = split_heads(pc[6], W_KV_HEADS)
    wvc = split_heads(pc[7], W_KV_HEADS)
    yb = window_attention_latent(wq, wk, wv, wkc, wvc, sink).astype(dt)
    dq = apply_rope(p[8].reshape(B, T, DF_HEADS * 2, DF_QK_DIM), cos, sin).reshape(B, T, DF_HEADS, 2, DF_QK_DIM)
    dk = apply_rope(p[9].reshape(B, T, DF_HEADS * 2, DF_QK_DIM), cos, sin).reshape(B, T, DF_HEADS, 2, DF_QK_DIM)
    dv = split_heads(p[10], DF_HEADS)
    dkc = pc[9].reshape(B, Tc, DF_HEADS, 2, DF_QK_DIM)
    dvc = split_heads(pc[10], DF_HEADS)
    yc = diff_out(diff_attention_latent(dq, dk, dv, dkc, dvc, lam), d_norm, lam_init, dt)
    out = merge_branches((ya, yb, yc), p[11], w_branch, w_out)
    if not need_ctx:
        return out, None
    ya_c = mlstm_out(hm_c, pc[3], m_norm)
    yb_c = window_attention_ctx(split_heads(pc[5], W_HEADS), wkc, wvc, sink).astype(dt)
    dqc = pc[8].reshape(B, Tc, DF_HEADS, 2, DF_QK_DIM).astype(F32) * DF_QK_DIM ** -0.5
    yc_c = diff_out(_diff_attend(dqc, dkc.astype(F32), dvc.astype(F32), lam), d_norm, lam_init, dt)
    out_c = merge_branches((ya_c, yb_c, yc_c), pc[11], w_branch, w_out)
    return out, out_c


def setup_inputs(seed: int = 0) -> dict:
    key = jax.random.key(seed)
    ks = jax.random.split(key, 24)
    nrm = lambda k, shape, s: jax.random.normal(k, shape, F32) * s
    L = DEPTH
    D = D_MODEL
    fb = jnp.linspace(3.0, 6.0, M_HEADS)
    zb = jnp.zeros((M_HEADS,), F32)
    gate_base = jnp.concatenate([zb, fb, zb, fb])
    return {
        'x': nrm(ks[0], (BATCH, SEQ, D), 1.0),
        'c': nrm(ks[1], (BATCH, D), 1.0),
        'ctx': nrm(ks[2], (BATCH, CTX_LEN, D), 1.0),
        'c_ctx': nrm(ks[3], (D,), 1.0),
        'w_mod': nrm(ks[4], (L, D, 6 * D), 0.5 * D ** -0.5),
        'b_mod': nrm(ks[5], (L, 6 * D), 0.02),
        'g_mix': 1.0 + nrm(ks[6], (L, D), 0.02),
        'g_ffn': 1.0 + nrm(ks[7], (L, D), 0.02),
        'w_in': nrm(ks[8], (L, D, IN_WIDTH), D ** -0.5),
        'b_gate': gate_base + nrm(ks[9], (L, M_GATES), 0.1),
        'conv_w': nrm(ks[10], (L, M_CONV, 2 * M_WIDTH), M_CONV ** -0.5),
        'm_norm': 1.0 + nrm(ks[11], (L, M_WIDTH), 0.02),
        'sink': nrm(ks[12], (L, W_HEADS), 0.5),
        'lam_q1': nrm(ks[13], (L, DF_QK_DIM), 0.1),
        'lam_k1': nrm(ks[14], (L, DF_QK_DIM), 0.1),
        'lam_q2': nrm(ks[15], (L, DF_QK_DIM), 0.1),
        'lam_k2': nrm(ks[16], (L, DF_QK_DIM), 0.1),
        'd_norm': 1.0 + nrm(ks[17], (L, DF_WIDTH), 0.02),
        'w_branch': nrm(ks[18], (L, N_BRANCH, BRANCH_WIDTH, D), BRANCH_WIDTH ** -0.5),
        'w_out': nrm(ks[19], (L, D, D), D ** -0.5),
        'w_ffn_in': nrm(ks[20], (L, D, 2 * FFN_HIDDEN), D ** -0.5),
        'w_ffn_out': nrm(ks[21], (L, FFN_HIDDEN, D), FFN_HIDDEN ** -0.5),
        'g_final': 1.0 + nrm(ks[22], (D,), 0.02),
    }


def reference(x, c, ctx, c_ctx, w_mod, b_mod, g_mix, g_ffn, w_in, b_gate, conv_w, m_norm, sink,
              lam_q1, lam_k1, lam_q2, lam_k2, d_norm, w_branch, w_out, w_ffn_in, w_ffn_out, g_final):
    T = x.shape[1]
    cos, sin = axial_rope_tables(T)
    xc = ctx
    for l in range(DEPTH):
        need_ctx = l < DEPTH - 1
        sh1, sc1, gt1, sh2, sc2, gt2 = adaln(c[:, None, :], w_mod[l], b_mod[l])
        sh1c, sc1c, gt1c, sh2c, sc2c, gt2c = adaln(c_ctx, w_mod[l], b_mod[l])
        lam_init = 0.8 - 0.6 * math.exp(-0.3 * l)
        lam = (jnp.exp(jnp.sum(lam_q1[l].astype(F32) * lam_k1[l].astype(F32)))
               - jnp.exp(jnp.sum(lam_q2[l].astype(F32) * lam_k2[l].astype(F32))) + lam_init)
        out, out_c = mixer_sublayer(modulate(x, g_mix[l], sh1, sc1), modulate(xc, g_mix[l], sh1c, sc1c),
                                    w_in[l], b_gate[l], conv_w[l], m_norm[l], sink[l], lam, lam_init,
                                    d_norm[l], w_branch[l], w_out[l], cos, sin, need_ctx)
        x = x + gt1 * out
        x = x + gt2 * swiglu(modulate(x, g_ffn[l], sh2, sc2), w_ffn_in[l], w_ffn_out[l])
        if need_ctx:
            xc = xc + gt1c * out_c
            xc = xc + gt2c * swiglu(modulate(xc, g_ffn[l], sh2c, sc2c), w_ffn_in[l], w_ffn_out[l])
    return rms_norm(x, g_final)
```

```cpp
#include <hip/hip_runtime.h>
#include <hip/hip_cooperative_groups.h>
#include <cstdio>
#include <cstdint>
namespace cg = cooperative_groups;

typedef unsigned short u16;
using bf16x8 = __attribute__((ext_vector_type(8))) short;
using f32x4 = __attribute__((ext_vector_type(4))) float;
using f32x16 = __attribute__((ext_vector_type(16))) float;

#define DEV __device__ __forceinline__

constexpr int D = 1024, NB = 16, T = 4096, TC = 256;
constexpr int NLAT = NB * T;
constexpr int NCTXR = NB * TC;
constexpr int MTOT = NLAT + NCTXR;
constexpr int KEYS = T + TC;
constexpr int INW = 7440;
constexpr int PW = 3712;
constexpr int C_MQ = 0, C_MK = 512, C_MV = 1024, C_MO = 1536, C_WQ = 2048, C_WK = 2560, C_DQ = 2688, C_DK = 3200;
constexpr int NIN = 4608;
constexpr int FH = 2816;
constexpr float EPS = 1e-6f;
constexpr float L2E = 1.4426950408889634f;
constexpr int NTHREADS = 512;
constexpr int LDS_BYTES = 147456;

constexpr size_t W_IN = 0;
constexpr size_t W_G = W_IN + (size_t)NIN * 1024;
constexpr size_t W_B = W_G + (size_t)3072 * 1024;
constexpr size_t W_O = W_B + (size_t)3 * 1024 * 512;
constexpr size_t W_FI = W_O + (size_t)1024 * 1024;
constexpr size_t W_FO = W_FI + (size_t)5632 * 1024;
constexpr size_t W_LAYER = W_FO + (size_t)1024 * FH;

struct Params {
  const float *x, *c, *ctx, *c_ctx, *w_mod, *b_mod, *g_mix, *g_ffn, *w_in, *b_gate, *conv_w, *m_norm, *sink;
  const float *lam_q1, *lam_k1, *lam_q2, *lam_k2, *d_norm, *w_branch, *w_out, *w_ffn_in, *w_ffn_out, *g_final;
  float* out;
  char* ws;
};


constexpr size_t al256(size_t x) { return (x + 255) & ~(size_t)255; }
constexpr size_t O_W = 0;
constexpr size_t O_MOD = O_W + al256(2 * W_LAYER * 2);
constexpr size_t O_ROPE = O_MOD + al256((size_t)2 * 17 * 6144 * 4);
constexpr size_t O_LAM = O_ROPE + al256((size_t)T * 32 * 2 * 4);
constexpr size_t O_CTR = O_LAM + 256;
constexpr size_t O_GATES = O_CTR + 256;
constexpr size_t O_H = O_GATES + al256((size_t)MTOT * 16 * 4);
constexpr size_t O_P = O_H + al256((size_t)MTOT * 1024 * 2);
constexpr size_t O_VTW = O_P + al256((size_t)MTOT * PW * 2);
constexpr size_t O_VTD = O_VTW + al256((size_t)NB * 2 * 64 * KEYS * 2);
constexpr size_t O_HFB = O_VTD + al256((size_t)NB * 4 * 128 * KEYS * 2);
constexpr size_t O_XC = O_HFB + al256((size_t)2 * MTOT * 512 * 2);
constexpr size_t WS_TOTAL = O_XC + al256((size_t)NCTXR * 1024 * 4) + 65536;
#define WS_W(P) reinterpret_cast<u16*>((P).ws + O_W)
#define WS_MOD(P) reinterpret_cast<float*>((P).ws + O_MOD)
#define WS_ROPE(P) reinterpret_cast<float*>((P).ws + O_ROPE)
#define WS_LAM(P) reinterpret_cast<float*>((P).ws + O_LAM)
#define WS_CTR(P) reinterpret_cast<unsigned*>((P).ws + O_CTR)
#define WS_GATES(P) reinterpret_cast<float*>((P).ws + O_GATES)
#define WS_H(P) reinterpret_cast<u16*>((P).ws + O_H)
#define WS_P(P) reinterpret_cast<u16*>((P).ws + O_P)
#define WS_VTW(P) reinterpret_cast<u16*>((P).ws + O_VTW)
#define WS_VTD(P) reinterpret_cast<u16*>((P).ws + O_VTD)
#define WS_HFB(P) reinterpret_cast<u16*>((P).ws + O_HFB)
#define WS_XC(P) reinterpret_cast<float*>((P).ws + O_XC)

DEV int my_tid() {
  int t = threadIdx.x;
  asm volatile("" : "+v"(t));
  return t;
}
DEV u16 f2bf(float f) {
  uint32_t u = __float_as_uint(f);
  u += 0x7fffu + ((u >> 16) & 1u);
  return (u16)(u >> 16);
}
DEV float bf2f(u16 h) { return __uint_as_float(((uint32_t)h) << 16); }
DEV uint32_t pack2(float a, float b) { return (uint32_t)f2bf(a) | ((uint32_t)f2bf(b) << 16); }
DEV float bflo(uint32_t v) { return __uint_as_float(v << 16); }
DEV float bfhi(uint32_t v) { return __uint_as_float(v & 0xffff0000u); }
DEV float fexp2(float x) { return __builtin_amdgcn_exp2f(x); }
DEV float sigmoidf_(float x) { return 1.f / (1.f + __expf(-x)); }
DEV float siluf_(float x) { return x / (1.f + __expf(-x)); }
DEV float wave_sum(float v) {
#pragma unroll
  for (int o = 32; o > 0; o >>= 1) v += __shfl_xor(v, o);
  return v;
}
DEV bf16x8 ld16(const void* p) { return *reinterpret_cast<const bf16x8*>(p); }
DEV bf16x8 mk8(uint32_t a, uint32_t b, uint32_t c, uint32_t d) {
  uint4 u = make_uint4(a, b, c, d);
  return *reinterpret_cast<bf16x8*>(&u);
}
DEV f32x16 mfma32(bf16x8 a, bf16x8 b, f32x16 c) { return __builtin_amdgcn_mfma_f32_32x32x16_bf16(a, b, c, 0, 0, 0); }
DEV f32x4 mfma16(bf16x8 a, bf16x8 b, f32x4 c) { return __builtin_amdgcn_mfma_f32_16x16x32_bf16(a, b, c, 0, 0, 0); }
DEV int pi32(int r) { return (r & ~12) | ((r & 4) << 1) | ((r & 8) >> 1); }


DEV void grid_barrier(unsigned* bar, unsigned& epoch) {
  __threadfence();
  __syncthreads();
  epoch += gridDim.x;
  if (my_tid() == 0) {
    __hip_atomic_fetch_add(bar, 1u, __ATOMIC_RELEASE, __HIP_MEMORY_SCOPE_AGENT);
    while (__hip_atomic_load(bar, __ATOMIC_ACQUIRE, __HIP_MEMORY_SCOPE_AGENT) < epoch) __builtin_amdgcn_s_sleep(2);
  }
  __syncthreads();
  __threadfence();
}
#define GSYNC() grid_barrier(bar, epoch)
#define GSYNC_ONLY()

template <int MI, int NI>
DEV void gemm_mainloop(const u16* __restrict__ A, int lda, const u16* __restrict__ Bt, int ldb, int K,
                       f32x4 (&acc)[MI][NI], char* smem) {
  constexpr int BM = 32 * MI;
  constexpr int NA = BM * 8 / NTHREADS;
  constexpr int NBL = NI;
  constexpr int ABYTES = BM * 128, BBYTES = 64 * NI * 128;
  char* As = smem;
  char* Bs = smem + 2 * ABYTES;
  const int tid = my_tid(), lane = tid & 63, wid = tid >> 6, wr = wid >> 2, wc = wid & 3, fr = lane & 15, fq = lane >> 4;
  const int nk = K / 64;
  auto stage = [&](int kt, int buf) {
#pragma unroll
    for (int i = 0; i < NA; ++i) {
      int id = tid + i * NTHREADS, r = id >> 3, c = (id & 7) ^ ((r >> 1) & 7);
      __builtin_amdgcn_global_load_lds((const unsigned*)(A + (size_t)r * lda + kt * 64 + c * 8),
                                       (unsigned*)(As + buf * ABYTES + id * 16), 16, 0, 0);
    }
#pragma unroll
    for (int i = 0; i < NBL; ++i) {
      int id = tid + i * NTHREADS, r = id >> 3, c = (id & 7) ^ ((r >> 1) & 7);
      __builtin_amdgcn_global_load_lds((const unsigned*)(Bt + (size_t)r * ldb + kt * 64 + c * 8),
                                       (unsigned*)(Bs + buf * BBYTES + id * 16), 16, 0, 0);
    }
  };
  __syncthreads();
  stage(0, 0);
  asm volatile("s_waitcnt vmcnt(0)" ::: "memory");
  __syncthreads();
  for (int kt = 0; kt < nk; ++kt) {
    const int buf = kt & 1;
    if (kt + 1 < nk) stage(kt + 1, buf ^ 1);
#pragma unroll
    for (int ks = 0; ks < 2; ++ks) {
      bf16x8 bfr[NI];
#pragma unroll
      for (int ni = 0; ni < NI; ++ni) {
        int r = wc * (NI * 16) + ni * 16 + fr;
        bfr[ni] = ld16(Bs + buf * BBYTES + r * 128 + (((ks * 4 + fq) ^ ((r >> 1) & 7)) << 4));
      }
#pragma unroll
      for (int mh = 0; mh < MI; mh += 4) {
        bf16x8 af[4];
#pragma unroll
        for (int mi = 0; mi < 4; ++mi) {
          int r = wr * (MI * 16) + (mh + mi) * 16 + fr;
          af[mi] = ld16(As + buf * ABYTES + r * 128 + (((ks * 4 + fq) ^ ((r >> 1) & 7)) << 4));
        }
#pragma unroll
        for (int mi = 0; mi < 4; ++mi)
#pragma unroll
          for (int ni = 0; ni < NI; ++ni) acc[mh + mi][ni] = mfma16(af[mi], bfr[ni], acc[mh + mi][ni]);
      }
      __builtin_amdgcn_sched_barrier(0);
    }
    asm volatile("s_waitcnt vmcnt(0)" ::: "memory");
    __syncthreads();
  }
}

template <int MI, int NI>
DEV void zero_acc(f32x4 (&acc)[MI][NI]) {
#pragma unroll
  for (int mi = 0; mi < MI; ++mi)
#pragma unroll
    for (int ni = 0; ni < NI; ++ni) acc[mi][ni] = f32x4{0.f, 0.f, 0.f, 0.f};
}

template <int MI, class Epi>
DEV void gemm_phase(const u16* A, int lda, const u16* Bt, int ldb, int M, int N, int K, Epi epi, char* smem) {
  constexpr int BM = 32 * MI;
  const int nM = M / BM, nN = N / 256;
  const int wid = my_tid() >> 6, wr = wid >> 2, wc = wid & 3;
  for (int tile = blockIdx.x; tile < nM * nN; tile += gridDim.x) {
    int tm = tile / nN, tn = tile % nN;
    f32x4 acc[MI][4];
    zero_acc<MI, 4>(acc);
    gemm_mainloop<MI, 4>(A + (size_t)tm * BM * lda, lda, Bt + (size_t)tn * 256 * ldb, ldb, K, acc, smem);
    epi(acc, tm * BM + wr * (MI * 16), tn * 256 + wc * 64);
  }
}

DEV int map_col(int type, int n) {
  if (type == 0) {
    if (n < 2048) return n;
    if (n < 2688) return n + 16;
    if (n < 3712) return n + 144;
    if (n < 3840) return n - 1008;
    if (n < 4352) return n + 16;
    if (n < 4368) return n - 2304;
    return -1;
  }
  if (type == 1) return n + 4368;
  if (type == 2) return n;
  int q = n >> 5, r = n & 31;
  return r < 16 ? (q * 16 + r) : (FH + q * 16 + r - 16);
}

DEV void tr_tile(const float* __restrict__ src, int ldsrc, u16* __restrict__ dst, int K, int n0, int k0, int type, char* smem) {
  float* tile = reinterpret_cast<float*>(smem);
  const int tid = my_tid();
  {
    int n = tid & 63, sc = map_col(type, n0 + n);
#pragma unroll
    for (int i = 0; i < 8; ++i) {
      int k = (tid >> 6) + 8 * i;
      tile[k * 65 + n] = sc >= 0 ? src[(size_t)(k0 + k) * ldsrc + sc] : 0.f;
    }
  }
  __syncthreads();
  {
    int n = tid >> 3, kc = tid & 7;
    uint32_t w[4];
#pragma unroll
    for (int j = 0; j < 4; ++j) w[j] = pack2(tile[(kc * 8 + 2 * j) * 65 + n], tile[(kc * 8 + 2 * j + 1) * 65 + n]);
    *reinterpret_cast<uint4*>(dst + (size_t)(n0 + n) * K + k0 + kc * 8) = make_uint4(w[0], w[1], w[2], w[3]);
  }
  __syncthreads();
}

DEV void phase_prologue(const Params& P, char* smem) {
  const int tid = my_tid();
  constexpr int TPL = 4672;
  for (int it = blockIdx.x; it < 2 * TPL; it += gridDim.x) {
    int l = it / TPL, t = it % TPL;
    u16* Wl = WS_W(P) + (size_t)l * W_LAYER;
    if (t < 1152) {
      tr_tile(P.w_in + (size_t)l * 1024 * INW, INW, Wl + W_IN, 1024, (t / 16) * 64, (t % 16) * 64, 0, smem);
    } else if (t < 1920) {
      t -= 1152;
      tr_tile(P.w_in + (size_t)l * 1024 * INW, INW, Wl + W_G, 1024, (t / 16) * 64, (t % 16) * 64, 1, smem);
    } else if (t < 2304) {
      t -= 1920;
      int i = t / 128;
      t %= 128;
      tr_tile(P.w_branch + ((size_t)l * 3 + i) * 512 * 1024, 1024, Wl + W_B + (size_t)i * 1024 * 512, 512, (t / 8) * 64, (t % 8) * 64, 2, smem);
    } else if (t < 2560) {
      t -= 2304;
      tr_tile(P.w_out + (size_t)l * 1024 * 1024, 1024, Wl + W_O, 1024, (t / 16) * 64, (t % 16) * 64, 2, smem);
    } else if (t < 3968) {
      t -= 2560;
      tr_tile(P.w_ffn_in + (size_t)l * 1024 * 5632, 5632, Wl + W_FI, 1024, (t / 16) * 64, (t % 16) * 64, 3, smem);
    } else {
      t -= 3968;
      tr_tile(P.w_ffn_out + (size_t)l * FH * 1024, 1024, Wl + W_FO, FH, (t / 44) * 64, (t % 44) * 64, 2, smem);
    }
  }
  for (int it = blockIdx.x; it < 384; it += gridDim.x) {
    int l = it / 192, n0 = (it % 192) * 32;
    float* sc = reinterpret_cast<float*>(smem);
    float* red = sc + 17 * 1024;
    __syncthreads();
    for (int idx = tid; idx < 17 * 1024; idx += NTHREADS) {
      int cond = idx >> 10, k = idx & 1023;
      float cv = cond < 16 ? P.c[cond * 1024 + k] : P.c_ctx[k];
      sc[idx] = siluf_(cv);
    }
    __syncthreads();
    int col = tid & 31, ks = tid >> 5;
    float acc[17];
#pragma unroll
    for (int j = 0; j < 17; ++j) acc[j] = 0.f;
    const float* wm = P.w_mod + (size_t)l * 1024 * 6144 + n0 + col;
    for (int k = ks * 64; k < ks * 64 + 64; ++k) {
      float w = wm[(size_t)k * 6144];
#pragma unroll
      for (int j = 0; j < 17; ++j) acc[j] += sc[j * 1024 + k] * w;
    }
#pragma unroll
    for (int j = 0; j < 17; ++j) red[(ks * 17 + j) * 32 + col] = acc[j];
    __syncthreads();
    for (int o = tid; o < 17 * 32; o += NTHREADS) {
      int j = o >> 5, cc = o & 31;
      float s = 0.f;
      for (int q = 0; q < 16; ++q) s += red[(q * 17 + j) * 32 + cc];
      WS_MOD(P)[((size_t)l * 17 + j) * 6144 + n0 + cc] = s + P.b_mod[l * 6144 + n0 + cc];
    }
  }
  for (int idx = blockIdx.x * NTHREADS + tid; idx < T * 32; idx += gridDim.x * NTHREADS) {
    int t = idx >> 5, j = idx & 31;
    int pos = j < 16 ? (t >> 6) : (t & 63);
    float inv = powf(10000.f, -(float)(j & 15) / 16.f);
    float ang = (float)pos * inv;
    WS_ROPE(P)[idx * 2] = cosf(ang);
    WS_ROPE(P)[idx * 2 + 1] = sinf(ang);
  }
  for (int idx = blockIdx.x * NTHREADS + tid; idx < NCTXR * 1024 / 4; idx += gridDim.x * NTHREADS)
    reinterpret_cast<float4*>(WS_XC(P))[idx] = reinterpret_cast<const float4*>(P.ctx)[idx];
  if (blockIdx.x == 0 && tid < 64) {
    for (int l = 0; l < 2; ++l) {
      float a = wave_sum(P.lam_q1[l * 64 + tid] * P.lam_k1[l * 64 + tid]);
      float b = wave_sum(P.lam_q2[l * 64 + tid] * P.lam_k2[l * 64 + tid]);
      float lam_init = 0.8f - 0.6f * expf(-0.3f * (float)l);
      if (tid == 0) WS_LAM(P)[l] = expf(a) - expf(b) + lam_init;
    }
    if (tid < 8) WS_CTR(P)[tid] = 0u;
  }
}

DEV void phase_norm_mod(const Params& P, const float* xlat, const float* xctx, int nrows, const float* g,
                        const float* modl, int sh_off, int sc_off) {
  const int lane = my_tid() & 63, wid = my_tid() >> 6;
  for (int row = blockIdx.x * 8 + wid; row < nrows; row += gridDim.x * 8) {
    const float* src = row < NLAT ? xlat + (size_t)row * 1024 : xctx + (size_t)(row - NLAT) * 1024;
    int cond = row < NLAT ? row >> 12 : 16;
    const float* md = modl + (size_t)cond * 6144;
    float4 v[4];
    float ss = 0.f;
#pragma unroll
    for (int i = 0; i < 4; ++i) {
      v[i] = *reinterpret_cast<const float4*>(src + i * 256 + lane * 4);
      ss += v[i].x * v[i].x + v[i].y * v[i].y + v[i].z * v[i].z + v[i].w * v[i].w;
    }
    ss = wave_sum(ss);
    float rstd = rsqrtf(ss * (1.f / 1024.f) + EPS);
#pragma unroll
    for (int i = 0; i < 4; ++i) {
      int cb = i * 256 + lane * 4;
      float4 gg = *reinterpret_cast<const float4*>(g + cb);
      float4 sh = *reinterpret_cast<const float4*>(md + sh_off + cb);
      float4 sc = *reinterpret_cast<const float4*>(md + sc_off + cb);
      float y0 = v[i].x * rstd * gg.x * (1.f + sc.x) + sh.x;
      float y1 = v[i].y * rstd * gg.y * (1.f + sc.y) + sh.y;
      float y2 = v[i].z * rstd * gg.z * (1.f + sc.z) + sh.z;
      float y3 = v[i].w * rstd * gg.w * (1.f + sc.w) + sh.w;
      *reinterpret_cast<uint2*>(WS_H(P) + (size_t)row * 1024 + cb) = make_uint2(pack2(y0, y1), pack2(y2, y3));
    }
  }
}

DEV void phase_final_norm(const Params& P) {
  const int lane = my_tid() & 63, wid = my_tid() >> 6;
  for (int row = blockIdx.x * 8 + wid; row < NLAT; row += gridDim.x * 8) {
    float* src = P.out + (size_t)row * 1024;
    float4 v[4];
    float ss = 0.f;
#pragma unroll
    for (int i = 0; i < 4; ++i) {
      v[i] = *reinterpret_cast<const float4*>(src + i * 256 + lane * 4);
      ss += v[i].x * v[i].x + v[i].y * v[i].y + v[i].z * v[i].z + v[i].w * v[i].w;
    }
    ss = wave_sum(ss);
    float rstd = rsqrtf(ss * (1.f / 1024.f) + EPS);
#pragma unroll
    for (int i = 0; i < 4; ++i) {
      int cb = i * 256 + lane * 4;
      float4 gg = *reinterpret_cast<const float4*>(P.g_final + cb);
      float4 o = make_float4(v[i].x * rstd * gg.x, v[i].y * rstd * gg.y, v[i].z * rstd * gg.z, v[i].w * rstd * gg.w);
      *reinterpret_cast<float4*>(src + cb) = o;
    }
  }
}

struct EpiInProj {
  const Params& P;
  int l;
  DEV void operator()(f32x4 (&acc)[8][4], int row0, int col0) const {
    const int lane = my_tid() & 63, fr = lane & 15, fq = lane >> 4;
    if (col0 >= 4416) return;
    if (col0 < C_WQ) {
#pragma unroll
      for (int mi = 0; mi < 8; ++mi)
#pragma unroll
        for (int ni = 0; ni < 4; ++ni)
#pragma unroll
          for (int j = 0; j < 4; ++j)
            WS_P(P)[(size_t)(row0 + mi * 16 + fq * 4 + j) * PW + col0 + ni * 16 + fr] = f2bf(acc[mi][ni][j]);
    } else if (col0 < 3712) {
      const bool isq = (col0 < C_WK) || (col0 >= C_DQ && col0 < C_DK);
      const float qs = isq ? 0.125f : 1.f;
#pragma unroll
      for (int mi = 0; mi < 8; ++mi)
#pragma unroll
        for (int j = 0; j < 4; ++j) {
          int row = row0 + mi * 16 + fq * 4 + j;
          u16* dst = WS_P(P) + (size_t)row * PW + col0 + fr;
          if (row < NLAT) {
            int t = row & (T - 1);
            const float2* rt = reinterpret_cast<const float2*>(WS_ROPE(P)) + t * 32;
#pragma unroll
            for (int hf = 0; hf < 2; ++hf) {
              float2 cs = rt[hf * 16 + fr];
              float x1 = acc[mi][hf * 2][j], x2 = acc[mi][hf * 2 + 1][j];
              dst[hf * 32] = f2bf((x1 * cs.x - x2 * cs.y) * qs);
              dst[hf * 32 + 16] = f2bf((x2 * cs.x + x1 * cs.y) * qs);
            }
          } else {
#pragma unroll
            for (int ni = 0; ni < 4; ++ni) dst[ni * 16] = f2bf(acc[mi][ni][j] * qs);
          }
        }
    } else if (col0 < 4352) {
      u16* base;
      int vrow0;
      const int hdW = (col0 - 3712) >> 6;
      const int hdD = (col0 - 3840) >> 7;
      const bool isw = col0 < 3840;
#pragma unroll
      for (int mi = 0; mi < 8; ++mi) {
        int row = row0 + mi * 16 + fq * 4;
        int b, key;
        if (row < NLAT) { b = row >> 12; key = 256 + (row & (T - 1)); }
        else { b = (row - NLAT) >> 8; key = (row - NLAT) & 255; }
        if (isw) { base = WS_VTW(P) + ((size_t)(b * 2 + hdW) * 64) * KEYS; vrow0 = 0; }
        else { base = WS_VTD(P) + ((size_t)(b * 4 + hdD) * 128) * KEYS; vrow0 = (col0 - 3840) & 127; }
#pragma unroll
        for (int ni = 0; ni < 4; ++ni) {
          int v = vrow0 + ni * 16 + fr;
          *reinterpret_cast<uint2*>(base + (size_t)v * KEYS + key) =
              make_uint2(pack2(acc[mi][ni][0], acc[mi][ni][1]), pack2(acc[mi][ni][2], acc[mi][ni][3]));
        }
      }
    } else {
      float bg = P.b_gate[l * 16 + fr];
#pragma unroll
      for (int mi = 0; mi < 8; ++mi)
#pragma unroll
        for (int j = 0; j < 4; ++j) WS_GATES(P)[(size_t)(row0 + mi * 16 + fq * 4 + j) * 16 + fr] = acc[mi][0][j] + bg;
    }
  }
};

template <int QB, int VB, int KW>
struct AttnCore {
  static constexpr int DV = 32 * VB;
  static constexpr int KST = KW * 2 + 16;
  static constexpr int VST = 128 + 16;
  static constexpr int KBYTES = 64 * KST, VBYTES = DV * VST;
  static constexpr int NKL = 64 * (KW / 8) / NTHREADS, NVL = DV * 8 / NTHREADS;
  static constexpr int TOTAL = 2 * (KBYTES + VBYTES);

  static DEV void run(const u16* qptr, int ldq, const u16* kctx, const u16* klat, int ldk, int kcol, const u16* vt,
                      int nctx, int nlat, int lat_t0, bool window, int qtok0, float m_init, float l_init,
                      f32x16 (&O)[QB][VB], char* smem) {
    const int tid = my_tid(), lane = tid & 63, r = lane & 31, hh = lane >> 5;
    char* Ks = smem;
    char* Vs = smem + 2 * KBYTES;
    bf16x8 qf[QB][4];
#pragma unroll
    for (int qb = 0; qb < QB; ++qb)
#pragma unroll
      for (int ks = 0; ks < 4; ++ks) qf[qb][ks] = ld16(qptr + (size_t)(qb * 32 + r) * ldq + ks * 16 + hh * 8);
    float m[QB], lsum[QB];
#pragma unroll
    for (int qb = 0; qb < QB; ++qb) {
      m[qb] = m_init;
      lsum[qb] = hh == 0 ? l_init : 0.f;
#pragma unroll
      for (int vb = 0; vb < VB; ++vb)
#pragma unroll
        for (int i = 0; i < 16; ++i) O[qb][vb][i] = 0.f;
    }
    bf16x8 rk[NKL], rv[NVL];
    const int ntiles = nctx + nlat;
    auto gload = [&](int j) {
      int kidx = j < nctx ? j * 64 : 256 + lat_t0 + (j - nctx) * 64;
      const u16* krow = j < nctx ? kctx + (size_t)(j * 64) * ldk : klat + (size_t)(lat_t0 + (j - nctx) * 64) * ldk;
#pragma unroll
      for (int i = 0; i < NKL; ++i) {
        int id = tid + i * NTHREADS, row = id / (KW / 8), c = id % (KW / 8);
        rk[i] = ld16(krow + (size_t)row * ldk + c * 8);
      }
#pragma unroll
      for (int i = 0; i < NVL; ++i) {
        int id = tid + i * NTHREADS, row = id >> 3, c = id & 7;
        rv[i] = ld16(vt + (size_t)row * KEYS + kidx + c * 8);
      }
    };
    auto lstore = [&](int buf) {
#pragma unroll
      for (int i = 0; i < NKL; ++i) {
        int id = tid + i * NTHREADS, row = id / (KW / 8), c = id % (KW / 8);
        *reinterpret_cast<bf16x8*>(Ks + buf * KBYTES + row * KST + c * 16) = rk[i];
      }
#pragma unroll
      for (int i = 0; i < NVL; ++i) {
        int id = tid + i * NTHREADS, row = id >> 3, c = id & 7;
        *reinterpret_cast<bf16x8*>(Vs + buf * VBYTES + row * VST + c * 16) = rv[i];
      }
    };
    __syncthreads();
    gload(0);
    lstore(0);
    __syncthreads();
    for (int j = 0; j < ntiles; ++j) {
      const int buf = j & 1;
      if (j + 1 < ntiles) gload(j + 1);
      bf16x8 pf[QB][2][2];
#pragma unroll
      for (int qb = 0; qb < QB; ++qb) {
        f32x16 S[2];
#pragma unroll
        for (int kb = 0; kb < 2; ++kb) {
#pragma unroll
          for (int i = 0; i < 16; ++i) S[kb][i] = 0.f;
#pragma unroll
          for (int ks = 0; ks < 4; ++ks) {
            bf16x8 kf = ld16(Ks + buf * KBYTES + (kb * 32 + pi32(r)) * KST + (kcol + ks * 16 + hh * 8) * 2);
            S[kb] = mfma32(kf, qf[qb][ks], S[kb]);
          }
        }
        __builtin_amdgcn_sched_barrier(0);
        if (window && j >= nctx) {
          int kt0 = lat_t0 + (j - nctx) * 64;
          int qt = qtok0 + qb * 32 + r;
#pragma unroll
          for (int kb = 0; kb < 2; ++kb)
#pragma unroll
            for (int i = 0; i < 16; ++i) {
              int kt = kt0 + kb * 32 + 16 * (i >> 3) + 8 * hh + (i & 7);
              int dlt = qt - kt;
              if (dlt > 128 || dlt < -128) S[kb][i] = -1e30f;
            }
        }
        float mloc = -1e30f;
#pragma unroll
        for (int kb = 0; kb < 2; ++kb)
#pragma unroll
          for (int i = 0; i < 16; ++i) mloc = fmaxf(mloc, S[kb][i]);
        mloc = fmaxf(mloc, __shfl_xor(mloc, 32));
        float mnew = fmaxf(m[qb], mloc);
        float alpha = fexp2((m[qb] - mnew) * L2E);
        m[qb] = mnew;
        float mb = mnew * L2E, ps = 0.f;
#pragma unroll
        for (int kb = 0; kb < 2; ++kb) {
          float pv[16];
#pragma unroll
          for (int i = 0; i < 16; ++i) {
            pv[i] = fexp2(S[kb][i] * L2E - mb);
            ps += pv[i];
          }
#pragma unroll
          for (int s = 0; s < 2; ++s)
            pf[qb][kb][s] = mk8(pack2(pv[8 * s], pv[8 * s + 1]), pack2(pv[8 * s + 2], pv[8 * s + 3]),
                                pack2(pv[8 * s + 4], pv[8 * s + 5]), pack2(pv[8 * s + 6], pv[8 * s + 7]));
        }
        lsum[qb] = lsum[qb] * alpha + ps;
        __builtin_amdgcn_sched_barrier(0);
#pragma unroll
        for (int vb = 0; vb < VB; ++vb)
#pragma unroll
          for (int i = 0; i < 16; ++i) O[qb][vb][i] *= alpha;
      }
      __builtin_amdgcn_sched_barrier(0);
#pragma unroll
      for (int vb = 0; vb < VB; ++vb) {
#pragma unroll
        for (int kb = 0; kb < 2; ++kb)
#pragma unroll
          for (int s = 0; s < 2; ++s) {
            bf16x8 vf = ld16(Vs + buf * VBYTES + (vb * 32 + r) * VST + (kb * 32 + s * 16 + hh * 8) * 2);
#pragma unroll
            for (int qb = 0; qb < QB; ++qb) O[qb][vb] = mfma32(vf, pf[qb][kb][s], O[qb][vb]);
          }
        __builtin_amdgcn_sched_barrier(0);
      }
      if (j + 1 < ntiles) lstore(buf ^ 1);
      __syncthreads();
    }
#pragma unroll
    for (int qb = 0; qb < QB; ++qb) {
      float lt = lsum[qb] + __shfl_xor(lsum[qb], 32);
      float inv = 1.f / lt;
#pragma unroll
      for (int vb = 0; vb < VB; ++vb)
#pragma unroll
        for (int i = 0; i < 16; ++i) O[qb][vb][i] *= inv;
    }
  }
};

DEV void diff_item(const Params& P, int l, int b, int h, int qt, bool ctxq, char* smem) {
  const int tid = my_tid(), lane = tid & 63, wid = tid >> 6, r = lane & 31, hh = lane >> 5;
  const int comp = wid >> 2, wq = wid & 3;
  const int rowbase = ctxq ? NLAT + b * 256 + qt * 128 : b * T + qt * 128;
  const u16* qptr = WS_P(P) + (size_t)(rowbase + wq * 32) * PW + C_DQ + h * 128 + comp * 64;
  const u16* kctx = WS_P(P) + (size_t)(NLAT + b * 256) * PW + C_DK + h * 128;
  const u16* klat = WS_P(P) + (size_t)(b * T) * PW + C_DK + h * 128;
  const u16* vt = WS_VTD(P) + ((size_t)(b * 4 + h) * 128) * KEYS;
  f32x16 O[1][4];
  AttnCore<1, 4, 128>::run(qptr, PW, kctx, klat, PW, comp * 64, vt, 4, ctxq ? 0 : 64, 0, false, 0, -1e30f, 0.f, O, smem);
  float* ex = reinterpret_cast<float*>(smem);
  __syncthreads();
  if (comp == 1) {
#pragma unroll
    for (int vb = 0; vb < 4; ++vb)
#pragma unroll
      for (int i = 0; i < 16; ++i) ex[(wq * 64 + vb * 16 + i) * 64 + lane] = O[0][vb][i];
  }
  __syncthreads();
  if (comp == 0) {
    const float lam = WS_LAM(P)[l];
    const float lam_init = 0.8f - 0.6f * expf(-0.3f * (float)l);
    float ss = 0.f;
#pragma unroll
    for (int vb = 0; vb < 4; ++vb)
#pragma unroll
      for (int i = 0; i < 16; ++i) {
        float y = O[0][vb][i] - lam * ex[(wq * 64 + vb * 16 + i) * 64 + lane];
        O[0][vb][i] = y;
        ss += y * y;
      }
    ss += __shfl_xor(ss, 32);
    float sc = rsqrtf(ss * (1.f / 128.f) + EPS) * (1.f - lam_init);
    const float* dn = P.d_norm + l * 512 + h * 128;
    u16* dst = WS_P(P) + (size_t)(rowbase + wq * 32 + r) * PW + C_DQ + h * 128;
#pragma unroll
    for (int vb = 0; vb < 4; ++vb)
#pragma unroll
      for (int g4 = 0; g4 < 4; ++g4) {
        int v = vb * 32 + g4 * 8 + hh * 4;
        float4 w = *reinterpret_cast<const float4*>(dn + v);
        *reinterpret_cast<uint2*>(dst + v) =
            make_uint2(pack2(O[0][vb][g4 * 4] * sc * w.x, O[0][vb][g4 * 4 + 1] * sc * w.y),
                       pack2(O[0][vb][g4 * 4 + 2] * sc * w.z, O[0][vb][g4 * 4 + 3] * sc * w.w));
      }
  }
  __syncthreads();
}

DEV void win_item(const Params& P, int l, int b, int g, int qb, bool ctxq, char* smem) {
  const int tid = my_tid(), lane = tid & 63, wid = tid >> 6, r = lane & 31, hh = lane >> 5;
  const int hr = wid >> 1, qh = wid & 1;
  const int head = g * 4 + hr;
  const int rowbase = (ctxq ? NLAT + b * 256 + qb * 64 : b * T + qb * 64) + qh * 32;
  const u16* qptr = WS_P(P) + (size_t)rowbase * PW + C_WQ + head * 64;
  const u16* kctx = WS_P(P) + (size_t)(NLAT + b * 256) * PW + C_WK + g * 64;
  const u16* klat = WS_P(P) + (size_t)(b * T) * PW + C_WK + g * 64;
  const u16* vt = WS_VTW(P) + ((size_t)(b * 2 + g) * 64) * KEYS;
  int t0 = 0, nlat = 0;
  if (!ctxq) {
    t0 = qb * 64 - 128;
    if (t0 < 0) t0 = 0;
    int t1 = qb * 64 + 192;
    if (t1 > T) t1 = T;
    nlat = (t1 - t0) >> 6;
  }
  f32x16 O[1][2];
  AttnCore<1, 2, 64>::run(qptr, PW, kctx, klat, PW, 0, vt, 4, nlat, t0, !ctxq, qb * 64 + qh * 32, P.sink[l * 8 + head], 1.f, O, smem);
  u16* dst = WS_P(P) + (size_t)(rowbase + r) * PW + C_WQ + head * 64;
#pragma unroll
  for (int vb = 0; vb < 2; ++vb)
#pragma unroll
    for (int g4 = 0; g4 < 4; ++g4) {
      int v = vb * 32 + g4 * 8 + hh * 4;
      *reinterpret_cast<uint2*>(dst + v) = make_uint2(pack2(O[0][vb][g4 * 4], O[0][vb][g4 * 4 + 1]),
                                                        pack2(O[0][vb][g4 * 4 + 2], O[0][vb][g4 * 4 + 3]));
    }
}

DEV void mlstm_item(const Params& P, int l, int b, int hd, int dir, bool need_ctx, char* smem) {
  const int tid = my_tid(), lane = tid & 63, wid = tid >> 6, r = lane & 31, hh = lane >> 5;
  constexpr int QST = 272, TST = 144;
  char* Qs = smem;
  char* Ks = Qs + 64 * QST;
  char* KwT = Ks + 64 * QST;
  char* VT = KwT + 128 * TST;
  char* Sp = VT + 128 * TST;
  char* Rq = Sp + 64 * TST;
  char* Rk = Rq + 66 * QST;
  float* fb = reinterpret_cast<float*>(Rk + 66 * QST);
  float* sb = fb;
  float* sa = fb + 64;
  float* sM = fb + 128;
  float* denp = fb + 192;
  float* qn = fb + 320;
  float* nb = fb + 384;
  float* cw = fb + 640;
  __syncthreads();
  if (tid < 256) nb[tid] = 0.f;
  for (int i = tid; i < 768; i += NTHREADS) {
    int qk = i / 384, tap = (i % 384) / 128, d = i & 127;
    cw[i] = P.conv_w[(size_t)l * 3 * 1024 + tap * 1024 + qk * 512 + hd * 128 + d];
  }
  f32x16 CT[4];
#pragma unroll
  for (int kb = 0; kb < 4; ++kb)
#pragma unroll
    for (int i = 0; i < 16; ++i) CT[kb][i] = 0.f;
  float mstate = 0.f;
  u16* hout = WS_HFB(P) + (size_t)dir * MTOT * 512;
  const float kscale = 0.08838834764831845f;

  for (int step = 0; step < 68; ++step) {
    int seg0, seglen, c;
    if (step < 4) { seg0 = NLAT + b * 256; seglen = 256; c = dir ? 3 - step : step; }
    else { seg0 = b * T; seglen = T; c = dir ? 67 - step : step - 4; }
    const int u0 = c * 64;
    const int rowbase = seg0 + u0;
    const int cur = step & 1;
    __syncthreads();
    bf16x8 rvv[2];
#pragma unroll
    for (int i = 0; i < 3; ++i) {
      int id = tid + i * NTHREADS;
      if (id < 66 * 16) {
        int row = id >> 4, cc = id & 15;
        int uu = u0 + row - 1;
        bool ok = uu >= 0 && uu < seglen;
        const u16* src = WS_P(P) + (size_t)(seg0 + (ok ? uu : 0)) * PW + hd * 128 + cc * 8;
        bf16x8 z = {0, 0, 0, 0, 0, 0, 0, 0};
        bf16x8 a = ok ? ld16(src + C_MQ) : z;
        bf16x8 bq = ok ? ld16(src + C_MK) : z;
        *reinterpret_cast<bf16x8*>(Rq + row * QST + cc * 16) = a;
        *reinterpret_cast<bf16x8*>(Rk + row * QST + cc * 16) = bq;
      }
    }
#pragma unroll
    for (int i = 0; i < 2; ++i) {
      int id = tid + i * NTHREADS, u = id >> 4, cc = id & 15;
      rvv[i] = ld16(WS_P(P) + (size_t)(rowbase + u) * PW + C_MV + hd * 128 + cc * 8);
    }
    if (wid == 0) {
      const int pos = dir ? 63 - lane : lane;
      const float* gp = WS_GATES(P) + (size_t)(rowbase + pos) * 16;
      float ig = gp[(dir * 2) * 4 + hd], fg = gp[(dir * 2 + 1) * 4 + hd];
      float lf = fminf(fg, 0.f) - log1pf(__expf(-fabsf(fg)));
      float bsum = lf;
#pragma unroll
      for (int o = 1; o < 64; o <<= 1) { float t2 = __shfl_up(bsum, o); if (lane >= o) bsum += t2; }
      float a = ig - bsum, am = a;
#pragma unroll
      for (int o = 1; o < 64; o <<= 1) { float t2 = __shfl_up(am, o); if (lane >= o) am = fmaxf(am, t2); }
      sb[pos] = bsum;
      sa[pos] = a;
      sM[pos] = fmaxf(mstate, am);
    }
    __syncthreads();
    const int eidx = dir ? 0 : 63;
    const float Mend = sM[eidx], bend = sb[eidx];
    const float decay = __expf(mstate - Mend);
#pragma unroll 1
    for (int i = 0; i < 2; ++i) {
      int id = tid + i * NTHREADS, u = id >> 4, cc = id & 15;
      float wend = __expf(sa[u] - Mend);
      uint32_t qo[4], ko[4];
      float kv[8];
      bf16x8 q0 = ld16(Rq + (u)*QST + cc * 16), q1 = ld16(Rq + (u + 1) * QST + cc * 16), q2 = ld16(Rq + (u + 2) * QST + cc * 16);
      bf16x8 k0 = ld16(Rk + (u)*QST + cc * 16), k1 = ld16(Rk + (u + 1) * QST + cc * 16), k2 = ld16(Rk + (u + 2) * QST + cc * 16);
#pragma unroll
      for (int e = 0; e < 8; ++e) {
        int d = cc * 8 + e;
        float xq = cw[0 * 128 + d] * bf2f((u16)q0[e]) + cw[1 * 128 + d] * bf2f((u16)q1[e]) + cw[2 * 128 + d] * bf2f((u16)q2[e]);
        float xk = cw[384 + 0 * 128 + d] * bf2f((u16)k0[e]) + cw[384 + 1 * 128 + d] * bf2f((u16)k1[e]) + cw[384 + 2 * 128 + d] * bf2f((u16)k2[e]);
        float qv = siluf_(xq);
        kv[e] = siluf_(xk) * kscale;
        if (e & 1) { qo[e >> 1] |= ((uint32_t)f2bf(qv)) << 16; ko[e >> 1] |= ((uint32_t)f2bf(kv[e])) << 16; }
        else { qo[e >> 1] = f2bf(qv); ko[e >> 1] = f2bf(kv[e]); }
        *reinterpret_cast<u16*>(KwT + (d)*TST + u * 2) = f2bf(kv[e] * wend);
        *reinterpret_cast<u16*>(VT + (d)*TST + u * 2) = (u16)rvv[i][e];
      }
      *reinterpret_cast<uint4*>(Qs + u * QST + cc * 16) = make_uint4(qo[0], qo[1], qo[2], qo[3]);
      *reinterpret_cast<uint4*>(Ks + u * QST + cc * 16) = make_uint4(ko[0], ko[1], ko[2], ko[3]);
    }
    __syncthreads();
    if (wid < 4) {
      const int sblk = wid & 1, tblk = wid >> 1;
      f32x16 S;
#pragma unroll
      for (int i = 0; i < 16; ++i) S[i] = 0.f;
#pragma unroll
      for (int ks = 0; ks < 8; ++ks) {
        bf16x8 kf = ld16(Ks + (sblk * 32 + pi32(r)) * QST + (ks * 16 + hh * 8) * 2);
        bf16x8 qf = ld16(Qs + (tblk * 32 + r) * QST + (ks * 16 + hh * 8) * 2);
        S = mfma32(kf, qf, S);
      }
      const int t = tblk * 32 + r;
      const float Mt = sM[t];
      float ds = 0.f, val[16];
#pragma unroll
      for (int i = 0; i < 16; ++i) {
        int s = sblk * 32 + 16 * (i >> 3) + 8 * hh + (i & 7);
        bool ok = dir ? (s >= t) : (s <= t);
        val[i] = ok ? S[i] * __expf(sa[s] - Mt) : 0.f;
        ds += val[i];
      }
      ds += __shfl_xor(ds, 32);
      if (hh == 0) denp[sblk * 64 + t] = ds;
#pragma unroll
      for (int s2 = 0; s2 < 2; ++s2)
        *reinterpret_cast<uint4*>(Sp + t * TST + (sblk * 32 + s2 * 16 + hh * 8) * 2) =
            make_uint4(pack2(val[8 * s2], val[8 * s2 + 1]), pack2(val[8 * s2 + 2], val[8 * s2 + 3]),
                       pack2(val[8 * s2 + 4], val[8 * s2 + 5]), pack2(val[8 * s2 + 6], val[8 * s2 + 7]));
    } else if (wid == 4) {
      float s = 0.f;
      const float* nc = nb + cur * 128;
      for (int k8 = 0; k8 < 16; ++k8) {
        bf16x8 qv = ld16(Qs + lane * QST + k8 * 16);
#pragma unroll
        for (int e = 0; e < 8; ++e) s += nc[k8 * 8 + e] * bf2f((u16)qv[e]);
      }
      qn[lane] = s;
    } else if (wid == 5) {
      const float* nc = nb + cur * 128;
      float* nn = nb + (cur ^ 1) * 128;
#pragma unroll
      for (int q2 = 0; q2 < 2; ++q2) {
        int k = lane + q2 * 64;
        float s = 0.f;
        for (int s8 = 0; s8 < 8; ++s8) {
          bf16x8 kv = ld16(KwT + k * TST + s8 * 16);
#pragma unroll
          for (int e = 0; e < 8; ++e) s += bf2f((u16)kv[e]);
        }
        nn[k] = decay * nc[k] + s;
      }
    }
    __syncthreads();
    {
      bf16x8 vf[4];
      const int vb = wid & 3, tb = wid >> 2;
#pragma unroll
      for (int ks = 0; ks < 4; ++ks) vf[ks] = ld16(VT + (vb * 32 + r) * TST + (ks * 16 + hh * 8) * 2);
      const bool wr_h = (step >= 4) || need_ctx;
      {
        const int t = tb * 32 + r;
        f32x16 acc;
#pragma unroll
        for (int i = 0; i < 16; ++i) acc[i] = 0.f;
#pragma unroll
        for (int kb = 0; kb < 4; ++kb)
#pragma unroll
          for (int s2 = 0; s2 < 2; ++s2) {
            bf16x8 af = mk8(pack2(CT[kb][8 * s2], CT[kb][8 * s2 + 1]), pack2(CT[kb][8 * s2 + 2], CT[kb][8 * s2 + 3]),
                            pack2(CT[kb][8 * s2 + 4], CT[kb][8 * s2 + 5]), pack2(CT[kb][8 * s2 + 6], CT[kb][8 * s2 + 7]));
            uint2 lo = *reinterpret_cast<const uint2*>(Qs + t * QST + (kb * 32 + s2 * 16 + hh * 4) * 2);
            uint2 hi = *reinterpret_cast<const uint2*>(Qs + t * QST + (kb * 32 + s2 * 16 + 8 + hh * 4) * 2);
            acc = mfma32(af, mk8(lo.x, lo.y, hi.x, hi.y), acc);
          }
        const float Mt = sM[t];
        const float winter = __expf(mstate - Mt);
#pragma unroll
        for (int i = 0; i < 16; ++i) acc[i] *= winter;
#pragma unroll
        for (int ks = 0; ks < 4; ++ks) {
          bf16x8 sf = ld16(Sp + t * TST + (ks * 16 + hh * 8) * 2);
          acc = mfma32(vf[ks], sf, acc);
        }
        float den = denp[t] + denp[64 + t] + winter * qn[t];
        float sc = 1.f / fmaxf(fabsf(den), __expf(-(sb[t] + Mt)));
        if (wr_h) {
          u16* dst = hout + (size_t)(rowbase + t) * 512 + hd * 128 + vb * 32;
#pragma unroll
          for (int g4 = 0; g4 < 4; ++g4)
            *reinterpret_cast<uint2*>(dst + g4 * 8 + hh * 4) =
                make_uint2(pack2(acc[g4 * 4] * sc, acc[g4 * 4 + 1] * sc), pack2(acc[g4 * 4 + 2] * sc, acc[g4 * 4 + 3] * sc));
        }
      }
#pragma unroll
      for (int kb = 0; kb < 4; ++kb) {
#pragma unroll
        for (int i = 0; i < 16; ++i) CT[kb][i] *= decay;
#pragma unroll
        for (int ks = 0; ks < 4; ++ks) {
          bf16x8 kf = ld16(KwT + (kb * 32 + r) * TST + (ks * 16 + hh * 8) * 2);
          CT[kb] = mfma32(kf, vf[ks], CT[kb]);
        }
      }
    }
    mstate = bend + Mend;
  }
  __syncthreads();
}

DEV int next_item(unsigned* ctr, int* s_item) {
  __syncthreads();
  if (my_tid() == 0) *s_item = (int)atomicAdd(ctr, 1u);
  __syncthreads();
  return *s_item;
}
DEV void phase_mixers(const Params& P, int l, char* smem) {
  const bool need_ctx = (l == 0);
  __shared__ int s_item;
  const int n_ml = 128, n_diff = 2048, n_win = 2048, n_dc = need_ctx ? 128 : 0, n_wc = need_ctx ? 128 : 0;
  for (;;) {
    int it = next_item(&WS_CTR(P)[l * 4 + 0], &s_item);
    if (it >= n_ml) break;
    mlstm_item(P, l, it >> 3, (it >> 1) & 3, it & 1, need_ctx, smem);
  }
  for (;;) {
    int it = next_item(&WS_CTR(P)[l * 4 + 1], &s_item);
    if (it >= n_diff + n_dc) break;
    bool cq = it >= n_diff;
    int i2 = it - n_diff;
    int b = cq ? i2 >> 3 : it >> 7, hd = cq ? (i2 >> 1) & 3 : (it >> 5) & 3, qt = cq ? i2 & 1 : it & 31;
    diff_item(P, l, b, hd, qt, cq, smem);
  }
  for (;;) {
    int it = next_item(&WS_CTR(P)[l * 4 + 2], &s_item);
    if (it >= n_win + n_wc) break;
    bool cq = it >= n_win;
    int i2 = it - n_win;
    int b = cq ? i2 >> 3 : it >> 7, g = cq ? (i2 >> 2) & 1 : (it >> 6) & 1, qb = cq ? i2 & 3 : it & 63;
    win_item(P, l, b, g, qb, cq, smem);
  }
}

DEV void phase_ya(const Params& P, int l, int nrows) {
  const int lane = my_tid() & 63, wid = my_tid() >> 6;
  const u16* hf = WS_HFB(P);
  const u16* hb = WS_HFB(P) + (size_t)MTOT * 512;
  for (int row = blockIdx.x * 8 + wid; row < nrows; row += gridDim.x * 8) {
    uint4 a = *reinterpret_cast<const uint4*>(hf + (size_t)row * 512 + lane * 8);
    uint4 bq = *reinterpret_cast<const uint4*>(hb + (size_t)row * 512 + lane * 8);
    uint4 o = *reinterpret_cast<const uint4*>(WS_P(P) + (size_t)row * PW + C_MO + lane * 8);
    uint32_t aa[4] = {a.x, a.y, a.z, a.w}, bb[4] = {bq.x, bq.y, bq.z, bq.w}, oo[4] = {o.x, o.y, o.z, o.w};
    float y[8], ss = 0.f;
#pragma unroll
    for (int j = 0; j < 4; ++j) {
      y[2 * j] = (bflo(aa[j]) + bflo(bb[j])) * sigmoidf_(bflo(oo[j]));
      y[2 * j + 1] = (bfhi(aa[j]) + bfhi(bb[j])) * sigmoidf_(bfhi(oo[j]));
      ss += y[2 * j] * y[2 * j] + y[2 * j + 1] * y[2 * j + 1];
    }
#pragma unroll
    for (int of = 1; of < 16; of <<= 1) ss += __shfl_xor(ss, of);
    float rstd = rsqrtf(ss * (1.f / 128.f) + EPS);
    const float* mn = P.m_norm + l * 512 + lane * 8;
    uint32_t w[4];
#pragma unroll
    for (int j = 0; j < 4; ++j) w[j] = pack2(y[2 * j] * rstd * mn[2 * j], y[2 * j + 1] * rstd * mn[2 * j + 1]);
    *reinterpret_cast<uint4*>(WS_P(P) + (size_t)row * PW + C_MO + lane * 8) = make_uint4(w[0], w[1], w[2], w[3]);
  }
}

DEV void phase_merge(const Params& P, int l, int M, char* smem) {
  const u16* Wl = WS_W(P) + (size_t)l * W_LAYER;
  u16* merged = WS_HFB(P);
  const int nM = M / 128, nN = 8;
  const int lane = my_tid() & 63, wid = my_tid() >> 6, wr = wid >> 2, wc = wid & 3, fr = lane & 15, fq = lane >> 4;
  for (int tile = blockIdx.x; tile < nM * nN; tile += gridDim.x) {
    int tm = tile / nN, tn = tile % nN;
    f32x4 mg[4][2];
    zero_acc<4, 2>(mg);
#pragma unroll 1
    for (int i = 0; i < 3; ++i) {
      f32x4 acc[4][2];
      zero_acc<4, 2>(acc);
      gemm_mainloop<4, 2>(WS_H(P) + (size_t)tm * 128 * 1024, 1024, Wl + W_G + (size_t)(i * 1024 + tn * 128) * 1024, 1024, 1024, acc, smem);
      uint32_t gp[4][2][2];
#pragma unroll
      for (int mi = 0; mi < 4; ++mi)
#pragma unroll
        for (int ni = 0; ni < 2; ++ni) {
          gp[mi][ni][0] = pack2(sigmoidf_(acc[mi][ni][0]), sigmoidf_(acc[mi][ni][1]));
          gp[mi][ni][1] = pack2(sigmoidf_(acc[mi][ni][2]), sigmoidf_(acc[mi][ni][3]));
        }
      zero_acc<4, 2>(acc);
      int yc = i == 0 ? C_MO : (i == 1 ? C_WQ : C_DQ);
      gemm_mainloop<4, 2>(WS_P(P) + (size_t)tm * 128 * PW + yc, PW, Wl + W_B + (size_t)i * 1024 * 512 + (size_t)(tn * 128) * 512, 512, 512, acc, smem);
#pragma unroll
      for (int mi = 0; mi < 4; ++mi)
#pragma unroll
        for (int ni = 0; ni < 2; ++ni) {
          mg[mi][ni][0] += bflo(gp[mi][ni][0]) * acc[mi][ni][0];
          mg[mi][ni][1] += bfhi(gp[mi][ni][0]) * acc[mi][ni][1];
          mg[mi][ni][2] += bflo(gp[mi][ni][1]) * acc[mi][ni][2];
          mg[mi][ni][3] += bfhi(gp[mi][ni][1]) * acc[mi][ni][3];
        }
    }
    const int row0 = tm * 128 + wr * 64, col0 = tn * 128 + wc * 32;
#pragma unroll
    for (int mi = 0; mi < 4; ++mi)
#pragma unroll
      for (int ni = 0; ni < 2; ++ni)
#pragma unroll
        for (int j = 0; j < 4; ++j)
          merged[(size_t)(row0 + mi * 16 + fq * 4 + j) * 1024 + col0 + ni * 16 + fr] = f2bf(mg[mi][ni][j]);
  }
}

struct EpiResid {
  const Params& P;
  const float* src_lat;
  const float* modl;
  int gt_off;
  DEV void operator()(f32x4 (&acc)[8][4], int row0, int col0) const {
    const int lane = my_tid() & 63, fr = lane & 15, fq = lane >> 4;
#pragma unroll
    for (int mi = 0; mi < 8; ++mi)
#pragma unroll
      for (int j = 0; j < 4; ++j) {
        int row = row0 + mi * 16 + fq * 4 + j;
        const float* src;
        float* dst;
        int cond;
        if (row < NLAT) { src = src_lat + (size_t)row * 1024; dst = P.out + (size_t)row * 1024; cond = row >> 12; }
        else { src = WS_XC(P) + (size_t)(row - NLAT) * 1024; dst = WS_XC(P) + (size_t)(row - NLAT) * 1024; cond = 16; }
        const float* gt = modl + (size_t)cond * 6144 + gt_off;
#pragma unroll
        for (int ni = 0; ni < 4; ++ni) {
          int col = col0 + ni * 16 + fr;
          dst[col] = src[col] + gt[col] * acc[mi][ni][j];
        }
      }
  }
};

struct EpiSwiglu {
  u16* act;
  DEV void operator()(f32x4 (&acc)[8][4], int row0, int col0) const {
    const int lane = my_tid() & 63, fr = lane & 15, fq = lane >> 4;
#pragma unroll
    for (int mi = 0; mi < 8; ++mi)
#pragma unroll
      for (int j = 0; j < 4; ++j) {
        int row = row0 + mi * 16 + fq * 4 + j;
#pragma unroll
        for (int pr = 0; pr < 2; ++pr) {
          float gte = acc[mi][pr * 2][j], up = acc[mi][pr * 2 + 1][j];
          act[(size_t)row * FH + ((col0 + pr * 32) >> 1) + fr] = f2bf(siluf_(gte) * up);
        }
      }
  }
};


#ifdef SELFCHECK
#define DBGF(P) reinterpret_cast<float*>((P).ws + O_XC + (size_t)NCTXR * 1024 * 4)
DEV float blk_reduce(float v, bool ismax, float* red) {
  const int tid = my_tid(), lane = tid & 63, wid = tid >> 6;
#pragma unroll
  for (int o = 32; o > 0; o >>= 1) { float t = __shfl_xor(v, o); v = ismax ? fmaxf(v, t) : v + t; }
  __syncthreads();
  if (lane == 0) red[wid] = v;
  __syncthreads();
  float r = red[0];
  for (int i = 1; i < 8; ++i) r = ismax ? fmaxf(r, red[i]) : r + red[i];
  __syncthreads();
  return r;
}
DEV void chk_sample(int s, int& b, int& hd, int& t) {
  const int ti = s & 7;
  b = (s * 5 + 3) & 15; hd = s & 7;
  t = ti == 0 ? 0 : ti == 1 ? 63 : ti == 2 ? 64 : ti == 3 ? 127 : ti == 4 ? 2048 + 65 : ti == 5 ? 3000 : ti == 6 ? 4032 : 4095;
}
DEV void check_pre(const Params& P, int l, char* smem) {
  const int tid = my_tid();
  float* sc = reinterpret_cast<float*>(smem);
  float* red = sc + 2 * 4352;
  float* ov = red + 16;
  float* dbg = DBGF(P);
  const u16* p = WS_P(P);
  for (int it = blockIdx.x; it < 24; it += gridDim.x) {
    const bool isdiff = it >= 12;
    const int s = isdiff ? it - 12 : it;
    int b, hd, t;
    chk_sample(s, b, hd, t);
    const bool ctxq = s >= 8;
    if (ctxq) t &= 255;
    const size_t row = ctxq ? (size_t)NLAT + b * 256 + t : (size_t)b * T + t;
    __syncthreads();
    if (!isdiff) {
      const int head = hd, g = head >> 2;
      const int lo = ctxq ? 0 : max(0, t - 128), hi = ctxq ? -1 : min(T - 1, t + 128);
      const int nk = 256 + (hi - lo + 1);
      float mx = -1e30f;
      for (int k = tid; k < nk; k += NTHREADS) {
        size_t krow = k < 256 ? (size_t)NLAT + b * 256 + k : (size_t)b * T + lo + (k - 256);
        float a = 0.f;
        for (int d = 0; d < 64; ++d) a += bf2f(p[row * PW + C_WQ + head * 64 + d]) * bf2f(p[krow * PW + C_WK + g * 64 + d]);
        sc[k] = a;
        mx = fmaxf(mx, a);
      }
      mx = blk_reduce(mx, true, red);
      const float sk = P.sink[l * 8 + head];
      mx = fmaxf(mx, sk);
      float sm = 0.f;
      for (int k = tid; k < nk; k += NTHREADS) { float e = expf(sc[k] - mx); sc[k] = e; sm += e; }
      sm = blk_reduce(sm, false, red) + expf(sk - mx);
      if (tid < 64) {
        float o = 0.f;
        for (int k = 0; k < nk; ++k) {
          int kidx = k < 256 ? k : 256 + lo + (k - 256);
          o += sc[k] * bf2f(WS_VTW(P)[((size_t)(b * 2 + g) * 64 + tid) * KEYS + kidx]);
        }
        dbg[it * 128 + tid] = o / sm;
      }
    } else {
      const int h = hd & 3;
      const int nk = ctxq ? 256 : KEYS;
      float mx0 = -1e30f, mx1 = -1e30f;
      for (int k = tid; k < nk; k += NTHREADS) {
        size_t krow = k < 256 ? (size_t)NLAT + b * 256 + k : (size_t)b * T + (k - 256);
        float a0 = 0.f, a1 = 0.f;
        for (int d = 0; d < 64; ++d) {
          a0 += bf2f(p[row * PW + C_DQ + h * 128 + d]) * bf2f(p[krow * PW + C_DK + h * 128 + d]);
          a1 += bf2f(p[row * PW + C_DQ + h * 128 + 64 + d]) * bf2f(p[krow * PW + C_DK + h * 128 + 64 + d]);
        }
        sc[k] = a0; sc[4352 + k] = a1;
        mx0 = fmaxf(mx0, a0); mx1 = fmaxf(mx1, a1);
      }
      mx0 = blk_reduce(mx0, true, red);
      mx1 = blk_reduce(mx1, true, red);
      float s0 = 0.f, s1 = 0.f;
      for (int k = tid; k < nk; k += NTHREADS) {
        float e0 = expf(sc[k] - mx0), e1 = expf(sc[4352 + k] - mx1);
        sc[k] = e0; sc[4352 + k] = e1; s0 += e0; s1 += e1;
      }
      s0 = blk_reduce(s0, false, red);
      s1 = blk_reduce(s1, false, red);
      const float lam = WS_LAM(P)[l], lam_init = 0.8f - 0.6f * expf(-0.3f * (float)l);
      float y = 0.f;
      if (tid < 128) {
        for (int k = 0; k < nk; ++k)
          y += (sc[k] / s0 - lam * sc[4352 + k] / s1) * bf2f(WS_VTD(P)[((size_t)(b * 4 + h) * 128 + tid) * KEYS + k]);
        ov[tid] = y;
      }
      __syncthreads();
      if (tid < 128) {
        float ss = 0.f;
        for (int v = 0; v < 128; ++v) ss += ov[v] * ov[v];
        dbg[it * 128 + tid] = y * rsqrtf(ss / 128.f + EPS) * P.d_norm[l * 512 + h * 128 + tid] * (1.f - lam_init);
      }
    }
  }
}
DEV void check_post(const Params& P, int l, unsigned* flags) {
  const int tid = my_tid();
  const float* dbg = DBGF(P);
  const u16* p = WS_P(P);
  for (int it = blockIdx.x; it < 24; it += gridDim.x) {
    const bool isdiff = it >= 12;
    const int s = isdiff ? it - 12 : it;
    int b, hd, t;
    chk_sample(s, b, hd, t);
    const bool ctxq = s >= 8;
    if (ctxq) t &= 255;
    const size_t row = ctxq ? (size_t)NLAT + b * 256 + t : (size_t)b * T + t;
    if (ctxq && l != 0) continue;
    const int n = isdiff ? 128 : 64;
    if (tid < n) {
      float got = isdiff ? bf2f(p[row * PW + C_DQ + (hd & 3) * 128 + tid]) : bf2f(p[row * PW + C_WQ + hd * 64 + tid]);
      float ex = dbg[it * 128 + tid];
      if (!(fabsf(got - ex) <= 0.03f + 0.03f * fabsf(ex))) atomicOr(flags, isdiff ? (ctxq ? 32u : 2u) : (ctxq ? 16u : 1u));
    }
  }
}
DEV void check_mlstm(const Params& P, int l, char* smem, unsigned* flags) {
  const int tid = my_tid(), lane = tid & 63;
  float* qs = reinterpret_cast<float*>(smem);
  float* ks = qs + 128;
  float* vs = ks + 128;
  float* nn = vs + 128;
  float* sc = nn + 128;
  float* red = sc + 8;
  const u16* p = WS_P(P);
  for (int it = blockIdx.x; it < 4; it += gridDim.x) {
    const int b = (it * 7 + 2) & 15, hd = (it + 1) & 3, dir = it & 1;
    const int v = tid >> 2, kq = tid & 3;
    float C[32];
#pragma unroll
    for (int j = 0; j < 32; ++j) C[j] = 0.f;
    __syncthreads();
    if (tid < 128) nn[tid] = 0.f;
    if (tid == 0) sc[0] = 0.f;
    __syncthreads();
    const int nsteps = (l == 0) ? 256 + T : 256 + T;
    for (int st = 0; st < nsteps; ++st) {
      int seg0, seglen, u;
      if (st < 256) { seg0 = NLAT + b * 256; seglen = 256; u = dir ? 255 - st : st; }
      else { seg0 = b * T; seglen = T; u = dir ? T - 1 - (st - 256) : st - 256; }
      const size_t row = (size_t)seg0 + u;
      if (tid < 128) {
        float xq = 0.f, xk = 0.f;
        for (int tp = 0; tp < 3; ++tp) {
          int uu = u + tp - 1;
          if (uu >= 0 && uu < seglen) {
            xq += P.conv_w[(size_t)l * 3072 + tp * 1024 + hd * 128 + tid] * bf2f(p[((size_t)seg0 + uu) * PW + C_MQ + hd * 128 + tid]);
            xk += P.conv_w[(size_t)l * 3072 + tp * 1024 + 512 + hd * 128 + tid] * bf2f(p[((size_t)seg0 + uu) * PW + C_MK + hd * 128 + tid]);
          }
        }
        qs[tid] = xq / (1.f + expf(-xq));
        ks[tid] = xk / (1.f + expf(-xk)) * 0.08838834764831845f;
        vs[tid] = bf2f(p[row * PW + C_MV + hd * 128 + tid]);
      }
      if (tid == 0) {
        float ig = WS_GATES(P)[row * 16 + dir * 8 + hd], fg = WS_GATES(P)[row * 16 + dir * 8 + 4 + hd];
        float lf = fminf(fg, 0.f) - log1pf(expf(-fabsf(fg)));
        float m = sc[0], mn = fmaxf(lf + m, ig);
        sc[1] = expf(lf + m - mn);
        sc[2] = expf(ig - mn);
        sc[3] = mn;
      }
      __syncthreads();
      const float fd = sc[1], iw = sc[2], mn = sc[3];
      float pd = 0.f;
#pragma unroll
      for (int j = 0; j < 32; ++j) {
        C[j] = fd * C[j] + iw * vs[v] * ks[kq * 32 + j];
        pd += C[j] * qs[kq * 32 + j];
      }
      pd += __shfl_xor(pd, 1);
      pd += __shfl_xor(pd, 2);
      float dn = 0.f;
      if (tid < 128) { float nv = fd * nn[tid] + iw * ks[tid]; nn[tid] = nv; dn = nv * qs[tid]; }
      dn = blk_reduce(dn, false, red);
      if (tid == 0) sc[0] = mn;
      const float hval = pd / fmaxf(fabsf(dn), expf(-mn));
      float sq = (kq == 0) ? hval * hval : 0.f;
      sq = blk_reduce(sq, false, red);
      const float rms = sqrtf(sq / 128.f);
      const bool cmp = (st < 256) ? (l == 0) : true;
      if (cmp && kq == 0 && ((u & 63) == 0 || (u & 63) == 63 || (u % 97) == 0)) {
        float got = bf2f(WS_HFB(P)[(size_t)dir * MTOT * 512 + row * 512 + hd * 128 + v]);
        if (!(fabsf(got - hval) <= 0.05f * rms + 0.05f * fabsf(hval) + 1e-3f)) atomicOr(flags, dir ? 8u : 4u);
      }
    }
  }
}
#endif


#ifdef SELFCHECK
DEV void flag_if(bool bad, unsigned* flags, unsigned bit) { if (bad) atomicOr(flags, bit); }
DEV bool close_(float got, float ex, float tol) { return fabsf(got - ex) <= tol + tol * fabsf(ex); }
DEV void check_inproj(const Params& P, int l, char* smem, unsigned* flags) {
  const int tid = my_tid();
  float* red = reinterpret_cast<float*>(smem);
  float* hrow = red + 16;
  const float* modl = WS_MOD(P) + (size_t)l * 17 * 6144;
  for (int it = blockIdx.x; it < 64; it += gridDim.x) {
    const int ri = it & 7;
    const int row = ri == 0 ? 0 : ri == 1 ? 4095 : ri == 2 ? 4096 + 77 : ri == 3 ? 30000 : ri == 4 ? 65535 : ri == 5 ? NLAT : ri == 6 ? NLAT + 300 : MTOT - 1;
    const int cond = row < NLAT ? row >> 12 : 16;
    {
      int col = (it * 769 + 5) % 6144;
      float a = 0.f;
      for (int k = tid; k < 1024; k += NTHREADS) {
        float cv = cond < 16 ? P.c[cond * 1024 + k] : P.c_ctx[k];
        a += cv / (1.f + expf(-cv)) * P.w_mod[(size_t)l * 1024 * 6144 + (size_t)k * 6144 + col];
      }
      a = blk_reduce(a, false, red) + P.b_mod[l * 6144 + col];
      if (tid == 0) flag_if(!close_(modl[(size_t)cond * 6144 + col], a, 2e-3f), flags, 1u);
    }
    const float* xs = row < NLAT ? ((l == 0 ? P.x : P.out) + (size_t)row * 1024) : (WS_XC(P) + (size_t)(row - NLAT) * 1024);
    float ss = 0.f;
    for (int k = tid; k < 1024; k += NTHREADS) ss += xs[k] * xs[k];
    ss = blk_reduce(ss, false, red);
    const float rstd = rsqrtf(ss / 1024.f + EPS);
    for (int k = tid; k < 1024; k += NTHREADS) {
      float y = xs[k] * rstd * P.g_mix[l * 1024 + k] * (1.f + modl[(size_t)cond * 6144 + 1024 + k]) + modl[(size_t)cond * 6144 + k];
      hrow[k] = y;
      flag_if(!close_(bf2f(WS_H(P)[(size_t)row * 1024 + k]), y, 1e-2f), flags, 2u);
    }
    __syncthreads();
    const int oi = it >> 3;
    const int oj = (oi * 2 + (it & 1)) & 15;
    const int oc = oj == 0 ? 3 : oj == 1 ? 600 : oj == 2 ? 1100 : oj == 3 ? 1999 : oj == 4 ? 2050 : oj == 5 ? 2064 + 70 : oj == 6 ? 2576 + 100 :
                   oj == 7 ? 2704 + 5 : oj == 8 ? 2832 + 200 : oj == 9 ? 2832 + 37 : oj == 10 ? 3344 + 90 : oj == 11 ? 3344 + 300 :
                   oj == 12 ? 3856 + 10 : oj == 13 ? 3856 + 500 : oj == 14 ? 2048 + 15 : 2064 + 500;
    auto dotcol = [&](int c) {
      float a = 0.f;
      for (int k = tid; k < 1024; k += NTHREADS) a += hrow[k] * P.w_in[(size_t)l * 1024 * INW + (size_t)k * INW + c];
      return blk_reduce(a, false, red);
    };
    float val = dotcol(oc);
    const u16* p = WS_P(P);
    const bool lat = row < NLAT;
    const int t = row & (T - 1);
    float got = 0.f, ex = val;
    unsigned bit = 4u;
    if (oc < 2048) { got = bf2f(p[(size_t)row * PW + oc]); }
    else if (oc < 2064) { got = WS_GATES(P)[(size_t)row * 16 + oc - 2048]; ex = val + P.b_gate[l * 16 + oc - 2048]; }
    else if (oc >= 2704 && oc < 2832) {
      int cgi = oc - 2704, g = cgi >> 6, vd = cgi & 63;
      int b = lat ? row >> 12 : (row - NLAT) >> 8, key = lat ? 256 + t : (row - NLAT) & 255;
      got = bf2f(WS_VTW(P)[((size_t)(b * 2 + g) * 64 + vd) * KEYS + key]);
      bit = 8u;
    } else if (oc >= 3856) {
      int cgi = oc - 3856, h = cgi >> 7, vd = cgi & 127;
      int b = lat ? row >> 12 : (row - NLAT) >> 8, key = lat ? 256 + t : (row - NLAT) & 255;
      got = bf2f(WS_VTD(P)[((size_t)(b * 4 + h) * 128 + vd) * KEYS + key]);
      bit = 8u;
    } else {
      int base, nb0;
      bool isq;
      if (oc < 2576) { base = 2064; nb0 = C_WQ; isq = true; }
      else if (oc < 2704) { base = 2576; nb0 = C_WK; isq = false; }
      else if (oc < 3344) { base = 2832; nb0 = C_DQ; isq = true; }
      else { base = 3344; nb0 = C_DK; isq = false; }
      int rel = oc - base, dd = rel & 63, j = dd & 15, second = (dd >> 4) & 1, axis = dd >> 5;
      float other = dotcol(second ? oc - 16 : oc + 16);
      if (lat) {
        int pos = axis ? (t & 63) : (t >> 6);
        float ang = (float)pos * powf(10000.f, -(float)j / 16.f);
        float cs = cosf(ang), sn = sinf(ang);
        ex = second ? (val * cs + other * sn) : (val * cs - other * sn);
      }
      if (isq) ex *= 0.125f;
      got = bf2f(p[(size_t)row * PW + nb0 + rel]);
      bit = 16u;
    }
    if (tid == 0) flag_if(!close_(got, ex, 3e-2f), flags, bit);
    __syncthreads();
  }
}
DEV void check_post6(const Params& P, int l, char* smem, unsigned* flags, const float* xprev) {
  const int tid = my_tid();
  float* red = reinterpret_cast<float*>(smem);
  const u16* Yp = WS_P(P);
  const float* modl = WS_MOD(P) + (size_t)l * 17 * 6144;
  for (int it = blockIdx.x; it < 16; it += gridDim.x) {
    const int ri = it & 7;
    const int row = ri == 0 ? 1 : ri == 1 ? 4097 : ri == 2 ? 12345 : ri == 3 ? 40000 : ri == 4 ? 65534 : ri == 5 ? NLAT + 1 : ri == 6 ? NLAT + 2000 : MTOT - 2;
    if (row >= NLAT && l != 0) continue;
    const int col = (it * 331 + 17) & 1023;
    const int cond = row < NLAT ? row >> 12 : 16;
    float mg = 0.f;
    for (int i = 0; i < 3; ++i) {
      float a = 0.f, z = 0.f;
      for (int k = tid; k < 1024; k += NTHREADS) a += bf2f(WS_H(P)[(size_t)row * 1024 + k]) * P.w_in[(size_t)l * 1024 * INW + (size_t)k * INW + 4368 + i * 1024 + col];
      a = blk_reduce(a, false, red);
      const int yc = i == 0 ? C_MO : (i == 1 ? C_WQ : C_DQ);
      for (int k = tid; k < 512; k += NTHREADS) z += bf2f(Yp[(size_t)row * PW + yc + k]) * P.w_branch[((size_t)l * 3 + i) * 512 * 1024 + (size_t)k * 1024 + col];
      z = blk_reduce(z, false, red);
      mg += z / (1.f + expf(-a));
    }
    if (tid == 0) flag_if(!close_(bf2f(WS_HFB(P)[(size_t)row * 1024 + col]), mg, 3e-2f), flags, 1u);
    float o = 0.f;
    for (int k = tid; k < 1024; k += NTHREADS) o += bf2f(WS_HFB(P)[(size_t)row * 1024 + k]) * P.w_out[(size_t)l * 1024 * 1024 + (size_t)k * 1024 + col];
    o = blk_reduce(o, false, red);
    const float xo = row < NLAT ? xprev[(size_t)row * 1024 + col] : -1e9f;
    const float xn = row < NLAT ? P.out[(size_t)row * 1024 + col] : WS_XC(P)[(size_t)(row - NLAT) * 1024 + col];
    if (tid == 0 && row < NLAT && (l == 0)) flag_if(!close_(xn, xo + modl[(size_t)cond * 6144 + 2048 + col] * o, 2e-2f), flags, 2u);
    if (tid == 0) DBGF(P)[4096 + it] = xn;
  }
}
DEV void check_post9(const Params& P, int l, char* smem, unsigned* flags) {
  const int tid = my_tid();
  float* red = reinterpret_cast<float*>(smem);
  const float* modl = WS_MOD(P) + (size_t)l * 17 * 6144;
  for (int it = blockIdx.x; it < 16; it += gridDim.x) {
    const int ri = it & 7;
    const int row = ri == 0 ? 1 : ri == 1 ? 4097 : ri == 2 ? 12345 : ri == 3 ? 40000 : ri == 4 ? 65534 : ri == 5 ? NLAT + 1 : ri == 6 ? NLAT + 2000 : MTOT - 2;
    if (row >= NLAT && l != 0) continue;
    const int col = (it * 331 + 17) & 1023;
    const int cond = row < NLAT ? row >> 12 : 16;
    const int j = (it * 97 + 13) % FH;
    float g = 0.f, u = 0.f;
    for (int k = tid; k < 1024; k += NTHREADS) {
      float hv = bf2f(WS_H(P)[(size_t)row * 1024 + k]);
      g += hv * P.w_ffn_in[(size_t)l * 1024 * 5632 + (size_t)k * 5632 + j];
      u += hv * P.w_ffn_in[(size_t)l * 1024 * 5632 + (size_t)k * 5632 + FH + j];
    }
    g = blk_reduce(g, false, red);
    u = blk_reduce(u, false, red);
    if (tid == 0) flag_if(!close_(bf2f(WS_P(P)[(size_t)row * FH + j]), g / (1.f + expf(-g)) * u, 3e-2f), flags, 4u);
    float o = 0.f;
    for (int k = tid; k < FH; k += NTHREADS) o += bf2f(WS_P(P)[(size_t)row * FH + k]) * P.w_ffn_out[(size_t)l * FH * 1024 + (size_t)k * 1024 + col];
    o = blk_reduce(o, false, red);
    const float xn = row < NLAT ? P.out[(size_t)row * 1024 + col] : WS_XC(P)[(size_t)(row - NLAT) * 1024 + col];
    if (tid == 0) flag_if(!close_(xn, DBGF(P)[4096 + it] + modl[(size_t)cond * 6144 + 5120 + col] * o, 2e-2f), flags, 8u);
  }
}
#endif

#ifdef DEBUG_STAGE
DEV void debug_dump(const Params& P, int stage) {
  const int tid = my_tid();
  for (size_t idx = (size_t)blockIdx.x * NTHREADS + tid; idx < (size_t)NLAT * 1024; idx += (size_t)gridDim.x * NTHREADS) {
    size_t row = idx >> 10;
    int c = (int)(idx & 1023);
    size_t r2 = row + (row < 4096 ? NLAT : 0);
    float v = 0.f;
    const u16* p = WS_P(P);
    if (stage == 1) {
      v = bf2f(p[row * PW + c]) + bf2f(p[row * PW + 1024 + c]) + bf2f(p[row * PW + 2048 + c]) + (c < 640 ? bf2f(p[row * PW + 3072 + c]) : 0.f);
      v += bf2f(p[r2 * PW + c]) + bf2f(p[r2 * PW + 1024 + c]) + bf2f(p[r2 * PW + 2048 + c]);
      v += bf2f(WS_VTD(P)[r2 * 512 + (c & 511)]) + bf2f(WS_VTW(P)[r2 * 128 + (c & 127)]) + WS_GATES(P)[r2 * 16 + (c & 15)];
      v += bf2f(WS_VTD(P)[row * 512 + (c & 511)]) + bf2f(WS_VTW(P)[row * 128 + (c & 127)]) + WS_GATES(P)[row * 16 + (c & 15)];
    } else if (stage == 21) {
      v = bf2f(WS_HFB(P)[row * 512 + (c & 511)]) + 2.f * bf2f(WS_HFB(P)[(size_t)MTOT * 512 + row * 512 + (c & 511)]);
      v += bf2f(WS_HFB(P)[r2 * 512 + (c & 511)]) + 2.f * bf2f(WS_HFB(P)[(size_t)MTOT * 512 + r2 * 512 + (c & 511)]);
    } else if (stage == 22) {
      v = bf2f(p[row * PW + C_WQ + (c & 511)]) + bf2f(p[r2 * PW + C_WQ + (c & 511)]);
    } else if (stage == 23) {
      v = bf2f(p[row * PW + C_DQ + (c & 511)]) + bf2f(p[r2 * PW + C_DQ + (c & 511)]);
    } else if (stage == 3) {
      v = bf2f(WS_HFB(P)[row * 1024 + c]) + bf2f(WS_HFB(P)[r2 * 1024 + c]);
    } else if (stage == 4) {
      v = P.out[idx] + WS_XC(P)[(row & 4095) * 1024 + c];
    } else if (stage == 5) {
      v = bf2f(WS_H(P)[row * 1024 + c]) + bf2f(WS_H(P)[r2 * 1024 + c]);
    } else if (stage == 6) {
      v = bf2f(p[row * FH + c]) + bf2f(p[row * FH + 1024 + c]) + bf2f(p[r2 * FH + 1792 + c]);
    }
    if (stage != 4) P.out[idx] = v; else P.out[idx] = v;
  }
}
#define DBG(st) if (l == 0 && DEBUG_STAGE == st) { GSYNC_ONLY(); debug_dump(P, st); return true; }
#else
#define DBG(st)
#endif
template <int l>
DEV bool layer_body(const Params& P, unsigned* bar, unsigned& epoch, char* smem) {
  constexpr bool need_ctx = (l == 0);
  const float* modl = WS_MOD(P) + (size_t)l * 17 * 6144;
  const u16* Wl = WS_W(P) + (size_t)l * W_LAYER;
  const float* xlat = l == 0 ? P.x : P.out;
  constexpr int Mtok = need_ctx ? MTOT : NLAT;
  phase_norm_mod(P, xlat, WS_XC(P), MTOT, P.g_mix + l * 1024, modl, 0, 1024);
  GSYNC();
  gemm_phase<8>(WS_H(P), 1024, Wl + W_IN, 1024, MTOT, NIN, 1024, EpiInProj{P, l}, smem);
  GSYNC();
  DBG(1)
#ifdef SELFCHECK
#if SELFCHECK == 2
  check_inproj(P, l, smem, WS_CTR(P) + 16 + l * 3);
#else
  check_pre(P, l, smem);
#endif
  GSYNC();
#endif
  phase_mixers(P, l, smem);
  GSYNC();
#if defined(SELFCHECK) && SELFCHECK == 1
  check_post(P, l, WS_CTR(P) + 17 + l * 3);
  check_mlstm(P, l, smem, WS_CTR(P) + 17 + l * 3);
  GSYNC();
#endif
  DBG(21)
  DBG(22)
  DBG(23)
  phase_ya(P, l, Mtok);
  GSYNC();
  phase_merge(P, l, Mtok, smem);
  GSYNC();
  DBG(3)
  gemm_phase<8>(WS_HFB(P), 1024, Wl + W_O, 1024, Mtok, 1024, 1024, EpiResid{P, xlat, modl, 2048}, smem);
  GSYNC();
#if defined(SELFCHECK) && SELFCHECK == 2
  check_post6(P, l, smem, WS_CTR(P) + 18 + l * 3, xlat);
  GSYNC();
#endif
  DBG(4)
  phase_norm_mod(P, P.out, WS_XC(P), Mtok, P.g_ffn + l * 1024, modl, 3072, 4096);
  GSYNC();
  DBG(5)
  gemm_phase<8>(WS_H(P), 1024, Wl + W_FI, 1024, Mtok, 5632, 1024, EpiSwiglu{WS_P(P)}, smem);
  GSYNC();
  DBG(6)
  gemm_phase<8>(WS_P(P), FH, Wl + W_FO, FH, Mtok, 1024, FH, EpiResid{P, P.out, modl, 5120}, smem);
  GSYNC();
#if defined(SELFCHECK) && SELFCHECK == 2
  check_post9(P, l, smem, WS_CTR(P) + 18 + l * 3);
  GSYNC();
#endif
  return false;
}

__global__ void __launch_bounds__(NTHREADS) fwd_megakernel(Params P) {
  extern __shared__ __attribute__((aligned(16))) char smem[];
  cg::grid_group grid = cg::this_grid();
  unsigned* bar = WS_CTR(P) + 32;
  unsigned epoch = 0;
  grid.sync();
  phase_prologue(P, smem);
  GSYNC();
  if (layer_body<0>(P, bar, epoch, smem)) return;
  if (layer_body<1>(P, bar, epoch, smem)) return;
  phase_final_norm(P);
#ifdef SELFCHECK
  GSYNC();
  if (blockIdx.x == 0 && my_tid() == 0) {
    float scale = 1000.f;
    for (int w = 0; w < 6; ++w) {
      unsigned f = WS_CTR(P)[16 + w];
      if (f) { P.out[0] = (10.f + (float)f) * scale; break; }
      scale *= 10.f;
    }
  }
#endif
}

extern "C" void kernel_launch(void* const* d_in, const int* in_sizes, int n_in, void* d_out, int out_size, void* d_ws,
                              size_t ws_size, hipStream_t stream) {
  static int grid_blocks = 0;
  if (!grid_blocks) {
    int dev = 0, cus = 0, per_cu = 0;
    hipGetDevice(&dev);
    hipDeviceGetAttribute(&cus, hipDeviceAttributeMultiprocessorCount, dev);
    hipFuncSetAttribute((const void*)fwd_megakernel, hipFuncAttributeMaxDynamicSharedMemorySize, LDS_BYTES);
    hipOccupancyMaxActiveBlocksPerMultiprocessor(&per_cu, fwd_megakernel, NTHREADS, LDS_BYTES);
    if (per_cu < 1) per_cu = 1;
    if (per_cu > 1) per_cu = 1;
    grid_blocks = cus * per_cu;
  }
  Params P{};
  const float* const* in = reinterpret_cast<const float* const*>(d_in);
  P.x = in[0]; P.c = in[1]; P.ctx = in[2]; P.c_ctx = in[3]; P.w_mod = in[4]; P.b_mod = in[5]; P.g_mix = in[6];
  P.g_ffn = in[7]; P.w_in = in[8]; P.b_gate = in[9]; P.conv_w = in[10]; P.m_norm = in[11]; P.sink = in[12];
  P.lam_q1 = in[13]; P.lam_k1 = in[14]; P.lam_q2 = in[15]; P.lam_k2 = in[16]; P.d_norm = in[17]; P.w_branch = in[18];
  P.w_out = in[19]; P.w_ffn_in = in[20]; P.w_ffn_out = in[21]; P.g_final = in[22];
  P.out = reinterpret_cast<float*>(d_out);
  P.ws = reinterpret_cast<char*>(d_ws);
  if (WS_TOTAL > ws_size) fprintf(stderr, "workspace too small: need %zu have %zu\n", (size_t)WS_TOTAL, ws_size);
  hipMemsetAsync(P.ws + O_CTR, 0, 256, stream);
  void* args[] = {&P};
  hipError_t e = hipLaunchCooperativeKernel((const void*)fwd_megakernel, dim3(grid_blocks), dim3(NTHREADS), args, LDS_BYTES, stream);
  if (e != hipSuccess) fprintf(stderr, "cooperative launch failed: %s (grid %d)\n", hipGetErrorString(e), grid_blocks);
}
```

```cpp
#include <hip/hip_runtime.h>
#include <hip/hip_cooperative_groups.h>
#include <cstdio>
#include <cstdint>
namespace cg = cooperative_groups;

typedef unsigned short u16;
using bf16x8 = __attribute__((ext_vector_type(8))) short;
using f32x4 = __attribute__((ext_vector_type(4))) float;
using f32x16 = __attribute__((ext_vector_type(16))) float;

#define DEV __device__ __forceinline__

constexpr int D = 1024, NB = 16, T = 4096, TC = 256;
constexpr int NLAT = NB * T;
constexpr int NCTXR = NB * TC;
constexpr int MTOT = NLAT + NCTXR;
constexpr int KEYS = T + TC;
constexpr int INW = 7440;
constexpr int PW = 3712;
constexpr int C_MQ = 0, C_MK = 512, C_MV = 1024, C_MO = 1536, C_WQ = 2048, C_WK = 2560, C_DQ = 2688, C_DK = 3200;
constexpr int NIN = 4608;
constexpr int FH = 2816;
constexpr float EPS = 1e-6f;
constexpr float L2E = 1.4426950408889634f;
constexpr int NTHREADS = 512;
constexpr int LDS_BYTES = 147456;

constexpr size_t W_IN = 0;
constexpr size_t W_G = W_IN + (size_t)NIN * 1024;
constexpr size_t W_B = W_G + (size_t)3072 * 1024;
constexpr size_t W_O = W_B + (size_t)3 * 1024 * 512;
constexpr size_t W_FI = W_O + (size_t)1024 * 1024;
constexpr size_t W_FO = W_FI + (size_t)5632 * 1024;
constexpr size_t W_LAYER = W_FO + (size_t)1024 * FH;

struct Params {
  const float *x, *c, *ctx, *c_ctx, *w_mod, *b_mod, *g_mix, *g_ffn, *w_in, *b_gate, *conv_w, *m_norm, *sink;
  const float *lam_q1, *lam_k1, *lam_q2, *lam_k2, *d_norm, *w_branch, *w_out, *w_ffn_in, *w_ffn_out, *g_final;
  float* out;
  char* ws;
};


constexpr size_t al256(size_t x) { return (x + 255) & ~(size_t)255; }
constexpr size_t O_W = 0;
constexpr size_t O_MOD = O_W + al256(2 * W_LAYER * 2);
constexpr size_t O_ROPE = O_MOD + al256((size_t)2 * 17 * 6144 * 4);
constexpr size_t O_LAM = O_ROPE + al256((size_t)T * 32 * 2 * 4);
constexpr size_t O_CTR = O_LAM + 256;
constexpr size_t O_GATES = O_CTR + 256;
constexpr size_t O_H = O_GATES + al256((size_t)MTOT * 16 * 4);
constexpr size_t O_P = O_H + al256((size_t)MTOT * 1024 * 2);
constexpr size_t O_VTW = O_P + al256((size_t)MTOT * PW * 2);
constexpr size_t O_VTD = O_VTW + al256((size_t)NB * 2 * 64 * KEYS * 2);
constexpr size_t O_HFB = O_VTD + al256((size_t)NB * 4 * 128 * KEYS * 2);
constexpr size_t O_XC = O_HFB + al256((size_t)2 * MTOT * 512 * 2);
constexpr size_t WS_TOTAL = O_XC + al256((size_t)NCTXR * 1024 * 4) + 65536;
#define WS_W(P) reinterpret_cast<u16*>((P).ws + O_W)
#define WS_MOD(P) reinterpret_cast<float*>((P).ws + O_MOD)
#define WS_ROPE(P) reinterpret_cast<float*>((P).ws + O_ROPE)
#define WS_LAM(P) reinterpret_cast<float*>((P).ws + O_LAM)
#define WS_CTR(P) reinterpret_cast<unsigned*>((P).ws + O_CTR)
#define WS_GATES(P) reinterpret_cast<float*>((P).ws + O_GATES)
#define WS_H(P) reinterpret_cast<u16*>((P).ws + O_H)
#define WS_P(P) reinterpret_cast<u16*>((P).ws + O_P)
#define WS_VTW(P) reinterpret_cast<u16*>((P).ws + O_VTW)
#define WS_VTD(P) reinterpret_cast<u16*>((P).ws + O_VTD)
#define WS_HFB(P) reinterpret_cast<u16*>((P).ws + O_HFB)
#define WS_XC(P) reinterpret_cast<float*>((P).ws + O_XC)

DEV int my_tid() {
  int t = threadIdx.x;
  asm volatile("" : "+v"(t));
  return t;
}
typedef __bf16 bf2_t __attribute__((ext_vector_type(2)));
typedef float f2_t __attribute__((ext_vector_type(2)));
DEV uint32_t pack2(float a, float b) {
  f2_t v = {a, b};
  bf2_t r = __builtin_convertvector(v, bf2_t);
  return *reinterpret_cast<uint32_t*>(&r);
}
DEV u16 f2bf(float f) { return (u16)(pack2(f, 0.f) & 0xffffu); }
DEV float bf2f(u16 h) { return __uint_as_float(((uint32_t)h) << 16); }
DEV float bflo(uint32_t v) { return __uint_as_float(v << 16); }
DEV float bfhi(uint32_t v) { return __uint_as_float(v & 0xffff0000u); }
DEV float fexp2(float x) { return __builtin_amdgcn_exp2f(x); }
DEV float sigmoidf_(float x) { return 1.f / (1.f + __expf(-x)); }
DEV float siluf_(float x) { return x / (1.f + __expf(-x)); }
DEV float wave_sum(float v) {
#pragma unroll
  for (int o = 32; o > 0; o >>= 1) v += __shfl_xor(v, o);
  return v;
}
DEV bf16x8 ld16(const void* p) { return *reinterpret_cast<const bf16x8*>(p); }
DEV bf16x8 mk8(uint32_t a, uint32_t b, uint32_t c, uint32_t d) {
  uint4 u = make_uint4(a, b, c, d);
  return *reinterpret_cast<bf16x8*>(&u);
}
DEV f32x16 mfma32(bf16x8 a, bf16x8 b, f32x16 c) { return __builtin_amdgcn_mfma_f32_32x32x16_bf16(a, b, c, 0, 0, 0); }
DEV f32x4 mfma16(bf16x8 a, bf16x8 b, f32x4 c) { return __builtin_amdgcn_mfma_f32_16x16x32_bf16(a, b, c, 0, 0, 0); }
DEV int pi32(int r) { return (r & ~12) | ((r & 4) << 1) | ((r & 8) >> 1); }


DEV void grid_barrier(unsigned* bar, unsigned& epoch) {
  asm volatile("s_waitcnt vmcnt(0)" ::: "memory");
  __syncthreads();
  epoch += gridDim.x;
  if (my_tid() == 0) {
    __builtin_amdgcn_fence(__ATOMIC_RELEASE, "agent");
    __hip_atomic_fetch_add(bar, 1u, __ATOMIC_RELAXED, __HIP_MEMORY_SCOPE_AGENT);
    while (__hip_atomic_load(bar, __ATOMIC_RELAXED, __HIP_MEMORY_SCOPE_AGENT) < epoch) __builtin_amdgcn_s_sleep(2);
    __builtin_amdgcn_fence(__ATOMIC_ACQUIRE, "agent");
  }
  __syncthreads();
}
#define GSYNC() grid_barrier(bar, epoch)
#define GSYNC_ONLY()

template <int N>
DEV void wait_vm() { asm volatile("s_waitcnt vmcnt(%0)" ::"n"(N) : "memory"); }

template <int MI, int NI>
DEV void gemm_mainloop(const u16* __restrict__ A, int lda, const u16* __restrict__ Bt, int ldb, int K,
                       f32x4 (&acc)[MI][NI], char* smem) {
  constexpr int BM = 32 * MI, BN = 64 * NI;
  constexpr int NA = BM * 4 / NTHREADS, NBL = BN * 4 / NTHREADS;
  constexpr int ABYTES = BM * 64, BBYTES = BN * 64, SBYTES = ABYTES + BBYTES;
  constexpr int NL = NA + NBL;
  const int tid = my_tid(), lane = tid & 63, wid = tid >> 6, wr = wid >> 2, wc = wid & 3, fr = lane & 15, fq = lane >> 4;
  const int nk = K / 32;
  auto stage = [&](int kt) {
    char* base = smem + (kt & 3) * SBYTES;
#pragma unroll
    for (int i = 0; i < NA; ++i) {
      int id = tid + i * NTHREADS, r = id >> 2, c = (id & 3) ^ ((r >> 2) & 3);
      __builtin_amdgcn_global_load_lds((const unsigned*)(A + (size_t)r * lda + kt * 32 + c * 8), (unsigned*)(base + id * 16), 16, 0, 0);
    }
#pragma unroll
    for (int i = 0; i < NBL; ++i) {
      int id = tid + i * NTHREADS, r = id >> 2, c = (id & 3) ^ ((r >> 2) & 3);
      __builtin_amdgcn_global_load_lds((const unsigned*)(Bt + (size_t)r * ldb + kt * 32 + c * 8), (unsigned*)(base + ABYTES + id * 16), 16, 0, 0);
    }
  };
  wait_vm<0>();
  __syncthreads();
  stage(0);
  if (nk > 1) stage(1);
  if (nk > 2) stage(2);
  for (int kt = 0; kt < nk; ++kt) {
    if (kt + 2 < nk) wait_vm<2 * NL>();
    else if (kt + 1 < nk) wait_vm<NL>();
    else wait_vm<0>();
    asm volatile("" ::: "memory");
    __builtin_amdgcn_s_barrier();
    asm volatile("" ::: "memory");
    if (kt + 3 < nk) stage(kt + 3);
    const char* As = smem + (kt & 3) * SBYTES;
    const char* Bs = As + ABYTES;
    bf16x8 bfr[NI];
#pragma unroll
    for (int ni = 0; ni < NI; ++ni) {
      int r = wc * (NI * 16) + ni * 16 + fr;
      bfr[ni] = ld16(Bs + r * 64 + ((fq ^ ((r >> 2) & 3)) << 4));
    }
#pragma unroll
    for (int mh = 0; mh < MI; mh += 4) {
      bf16x8 af[4];
#pragma unroll
      for (int mi = 0; mi < 4; ++mi) {
        int r = wr * (MI * 16) + (mh + mi) * 16 + fr;
        af[mi] = ld16(As + r * 64 + ((fq ^ ((r >> 2) & 3)) << 4));
      }
#pragma unroll
      for (int mi = 0; mi < 4; ++mi)
#pragma unroll
        for (int ni = 0; ni < NI; ++ni) acc[mh + mi][ni] = mfma16(af[mi], bfr[ni], acc[mh + mi][ni]);
    }
  }
}

template <int MI, int NI>
DEV void zero_acc(f32x4 (&acc)[MI][NI]) {
#pragma unroll
  for (int mi = 0; mi < MI; ++mi)
#pragma unroll
    for (int ni = 0; ni < NI; ++ni) acc[mi][ni] = f32x4{0.f, 0.f, 0.f, 0.f};
}

template <int MI, class Epi>
DEV void gemm_phase(const u16* A, int lda, const u16* Bt, int ldb, int M, int N, int K, Epi epi, char* smem) {
  constexpr int BM = 32 * MI;
  const int nM = M / BM, nN = N / 256;
  const int wid = my_tid() >> 6, wr = wid >> 2, wc = wid & 3;
  for (int tile = blockIdx.x; tile < nM * nN; tile += gridDim.x) {
    int tm = tile / nN, tn = tile % nN;
    f32x4 acc[MI][4];
    zero_acc<MI, 4>(acc);
    gemm_mainloop<MI, 4>(A + (size_t)tm * BM * lda, lda, Bt + (size_t)tn * 256 * ldb, ldb, K, acc, smem);
    epi(acc, tm * BM + wr * (MI * 16), tn * 256 + wc * 64);
  }
}

DEV int map_col(int type, int n) {
  if (type == 0) {
    if (n < 2048) return n;
    if (n < 2688) return n + 16;
    if (n < 3712) return n + 144;
    if (n < 3840) return n - 1008;
    if (n < 4352) return n + 16;
    if (n < 4368) return n - 2304;
    return -1;
  }
  if (type == 1) return n + 4368;
  if (type == 2) return n;
  int q = n >> 5, r = n & 31;
  return r < 16 ? (q * 16 + r) : (FH + q * 16 + r - 16);
}

DEV void tr_tile(const float* __restrict__ src, int ldsrc, u16* __restrict__ dst, int K, int n0, int k0, int type, char* smem) {
  float* tile = reinterpret_cast<float*>(smem);
  const int tid = my_tid();
  {
    int n = tid & 63, sc = map_col(type, n0 + n);
#pragma unroll
    for (int i = 0; i < 8; ++i) {
      int k = (tid >> 6) + 8 * i;
      tile[k * 65 + n] = sc >= 0 ? src[(size_t)(k0 + k) * ldsrc + sc] : 0.f;
    }
  }
  __syncthreads();
  {
    int n = tid >> 3, kc = tid & 7;
    uint32_t w[4];
#pragma unroll
    for (int j = 0; j < 4; ++j) w[j] = pack2(tile[(kc * 8 + 2 * j) * 65 + n], tile[(kc * 8 + 2 * j + 1) * 65 + n]);
    *reinterpret_cast<uint4*>(dst + (size_t)(n0 + n) * K + k0 + kc * 8) = make_uint4(w[0], w[1], w[2], w[3]);
  }
  __syncthreads();
}

DEV void phase_prologue(const Params& P, char* smem) {
  const int tid = my_tid();
  constexpr int TPL = 4672;
  for (int it = blockIdx.x; it < 2 * TPL; it += gridDim.x) {
    int l = it / TPL, t = it % TPL;
    u16* Wl = WS_W(P) + (size_t)l * W_LAYER;
    if (t < 1152) {
      tr_tile(P.w_in + (size_t)l * 1024 * INW, INW, Wl + W_IN, 1024, (t / 16) * 64, (t % 16) * 64, 0, smem);
    } else if (t < 1920) {
      t -= 1152;
      tr_tile(P.w_in + (size_t)l * 1024 * INW, INW, Wl + W_G, 1024, (t / 16) * 64, (t % 16) * 64, 1, smem);
    } else if (t < 2304) {
      t -= 1920;
      int i = t / 128;
      t %= 128;
      tr_tile(P.w_branch + ((size_t)l * 3 + i) * 512 * 1024, 1024, Wl + W_B + (size_t)i * 1024 * 512, 512, (t / 8) * 64, (t % 8) * 64, 2, smem);
    } else if (t < 2560) {
      t -= 2304;
      tr_tile(P.w_out + (size_t)l * 1024 * 1024, 1024, Wl + W_O, 1024, (t / 16) * 64, (t % 16) * 64, 2, smem);
    } else if (t < 3968) {
      t -= 2560;
      tr_tile(P.w_ffn_in + (size_t)l * 1024 * 5632, 5632, Wl + W_FI, 1024, (t / 16) * 64, (t % 16) * 64, 3, smem);
    } else {
      t -= 3968;
      tr_tile(P.w_ffn_out + (size_t)l * FH * 1024, 1024, Wl + W_FO, FH, (t / 44) * 64, (t % 44) * 64, 2, smem);
    }
  }
  for (int it = blockIdx.x; it < 384; it += gridDim.x) {
    int l = it / 192, n0 = (it % 192) * 32;
    float* sc = reinterpret_cast<float*>(smem);
    float* red = sc + 17 * 1024;
    __syncthreads();
    for (int idx = tid; idx < 17 * 1024; idx += NTHREADS) {
      int cond = idx >> 10, k = idx & 1023;
      float cv = cond < 16 ? P.c[cond * 1024 + k] : P.c_ctx[k];
      sc[idx] = siluf_(cv);
    }
    __syncthreads();
    int col = tid & 31, ks = tid >> 5;
    float acc[17];
#pragma unroll
    for (int j = 0; j < 17; ++j) acc[j] = 0.f;
    const float* wm = P.w_mod + (size_t)l * 1024 * 6144 + n0 + col;
    for (int k = ks * 64; k < ks * 64 + 64; ++k) {
      float w = wm[(size_t)k * 6144];
#pragma unroll
      for (int j = 0; j < 17; ++j) acc[j] += sc[j * 1024 + k] * w;
    }
#pragma unroll
    for (int j = 0; j < 17; ++j) red[(ks * 17 + j) * 32 + col] = acc[j];
    __syncthreads();
    for (int o = tid; o < 17 * 32; o += NTHREADS) {
      int j = o >> 5, cc = o & 31;
      float s = 0.f;
      for (int q = 0; q < 16; ++q) s += red[(q * 17 + j) * 32 + cc];
      WS_MOD(P)[((size_t)l * 17 + j) * 6144 + n0 + cc] = s + P.b_mod[l * 6144 + n0 + cc];
    }
  }
  for (int idx = blockIdx.x * NTHREADS + tid; idx < T * 32; idx += gridDim.x * NTHREADS) {
    int t = idx >> 5, j = idx & 31;
    int pos = j < 16 ? (t >> 6) : (t & 63);
    float inv = powf(10000.f, -(float)(j & 15) / 16.f);
    float ang = (float)pos * inv;
    WS_ROPE(P)[idx * 2] = cosf(ang);
    WS_ROPE(P)[idx * 2 + 1] = sinf(ang);
  }
  for (int idx = blockIdx.x * NTHREADS + tid; idx < NCTXR * 1024 / 4; idx += gridDim.x * NTHREADS)
    reinterpret_cast<float4*>(WS_XC(P))[idx] = reinterpret_cast<const float4*>(P.ctx)[idx];
  if (blockIdx.x == 0 && tid < 64) {
    for (int l = 0; l < 2; ++l) {
      float a = wave_sum(P.lam_q1[l * 64 + tid] * P.lam_k1[l * 64 + tid]);
      float b = wave_sum(P.lam_q2[l * 64 + tid] * P.lam_k2[l * 64 + tid]);
      float lam_init = 0.8f - 0.6f * expf(-0.3f * (float)l);
      if (tid == 0) WS_LAM(P)[l] = expf(a) - expf(b) + lam_init;
    }
    if (tid < 8) WS_CTR(P)[tid] = 0u;
  }
}

DEV void phase_norm_mod(const Params& P, const float* xlat, const float* xctx, int nrows, const float* g,
                        const float* modl, int sh_off, int sc_off) {
  const int lane = my_tid() & 63, wid = my_tid() >> 6;
  for (int row = blockIdx.x * 8 + wid; row < nrows; row += gridDim.x * 8) {
    const float* src = row < NLAT ? xlat + (size_t)row * 1024 : xctx + (size_t)(row - NLAT) * 1024;
    int cond = row < NLAT ? row >> 12 : 16;
    const float* md = modl + (size_t)cond * 6144;
    float4 v[4];
    float ss = 0.f;
#pragma unroll
    for (int i = 0; i < 4; ++i) {
      v[i] = *reinterpret_cast<const float4*>(src + i * 256 + lane * 4);
      ss += v[i].x * v[i].x + v[i].y * v[i].y + v[i].z * v[i].z + v[i].w * v[i].w;
    }
    ss = wave_sum(ss);
    float rstd = rsqrtf(ss * (1.f / 1024.f) + EPS);
#pragma unroll
    for (int i = 0; i < 4; ++i) {
      int cb = i * 256 + lane * 4;
      float4 gg = *reinterpret_cast<const float4*>(g + cb);
      float4 sh = *reinterpret_cast<const float4*>(md + sh_off + cb);
      float4 sc = *reinterpret_cast<const float4*>(md + sc_off + cb);
      float y0 = v[i].x * rstd * gg.x * (1.f + sc.x) + sh.x;
      float y1 = v[i].y * rstd * gg.y * (1.f + sc.y) + sh.y;
      float y2 = v[i].z * rstd * gg.z * (1.f + sc.z) + sh.z;
      float y3 = v[i].w * rstd * gg.w * (1.f + sc.w) + sh.w;
      *reinterpret_cast<uint2*>(WS_H(P) + (size_t)row * 1024 + cb) = make_uint2(pack2(y0, y1), pack2(y2, y3));
    }
  }
}

DEV void phase_final_norm(const Params& P) {
  const int lane = my_tid() & 63, wid = my_tid() >> 6;
  for (int row = blockIdx.x * 8 + wid; row < NLAT; row += gridDim.x * 8) {
    float* src = P.out + (size_t)row * 1024;
    float4 v[4];
    float ss = 0.f;
#pragma unroll
    for (int i = 0; i < 4; ++i) {
      v[i] = *reinterpret_cast<const float4*>(src + i * 256 + lane * 4);
      ss += v[i].x * v[i].x + v[i].y * v[i].y + v[i].z * v[i].z + v[i].w * v[i].w;
    }
    ss = wave_sum(ss);
    float rstd = rsqrtf(ss * (1.f / 1024.f) + EPS);
#pragma unroll
    for (int i = 0; i < 4; ++i) {
      int cb = i * 256 + lane * 4;
      float4 gg = *reinterpret_cast<const float4*>(P.g_final + cb);
      float4 o = make_float4(v[i].x * rstd * gg.x, v[i].y * rstd * gg.y, v[i].z * rstd * gg.z, v[i].w * rstd * gg.w);
      *reinterpret_cast<float4*>(src + cb) = o;
    }
  }
}

struct EpiInProj {
  const Params& P;
  int l;
  DEV void operator()(f32x4 (&acc)[8][4], int row0, int col0) const {
    const int lane = my_tid() & 63, fr = lane & 15, fq = lane >> 4;
    if (col0 >= 4416) return;
    if (col0 < C_WQ) {
#pragma unroll
      for (int mi = 0; mi < 8; ++mi)
#pragma unroll
        for (int ni = 0; ni < 4; ++ni)
#pragma unroll
          for (int j = 0; j < 4; ++j)
            WS_P(P)[(size_t)(row0 + mi * 16 + fq * 4 + j) * PW + col0 + ni * 16 + fr] = f2bf(acc[mi][ni][j]);
    } else if (col0 < 3712) {
      const bool isq = (col0 < C_WK) || (col0 >= C_DQ && col0 < C_DK);
      const float qs = isq ? 0.125f : 1.f;
#pragma unroll
      for (int mi = 0; mi < 8; ++mi)
#pragma unroll
        for (int j = 0; j < 4; ++j) {
          int row = row0 + mi * 16 + fq * 4 + j;
          u16* dst = WS_P(P) + (size_t)row * PW + col0 + fr;
          if (row < NLAT) {
            int t = row & (T - 1);
            const float2* rt = reinterpret_cast<const float2*>(WS_ROPE(P)) + t * 32;
#pragma unroll
            for (int hf = 0; hf < 2; ++hf) {
              float2 cs = rt[hf * 16 + fr];
              float x1 = acc[mi][hf * 2][j], x2 = acc[mi][hf * 2 + 1][j];
              dst[hf * 32] = f2bf((x1 * cs.x - x2 * cs.y) * qs);
              dst[hf * 32 + 16] = f2bf((x2 * cs.x + x1 * cs.y) * qs);
            }
          } else {
#pragma unroll
            for (int ni = 0; ni < 4; ++ni) dst[ni * 16] = f2bf(acc[mi][ni][j] * qs);
          }
        }
    } else if (col0 < 4352) {
      u16* base;
      int vrow0;
      const int hdW = (col0 - 3712) >> 6;
      const int hdD = (col0 - 3840) >> 7;
      const bool isw = col0 < 3840;
#pragma unroll
      for (int mi = 0; mi < 8; ++mi) {
        int row = row0 + mi * 16 + fq * 4;
        int b, key;
        if (row < NLAT) { b = row >> 12; key = 256 + (row & (T - 1)); }
        else { b = (row - NLAT) >> 8; key = (row - NLAT) & 255; }
        if (isw) { base = WS_VTW(P) + ((size_t)(b * 2 + hdW) * 64) * KEYS; vrow0 = 0; }
        else { base = WS_VTD(P) + ((size_t)(b * 4 + hdD) * 128) * KEYS; vrow0 = (col0 - 3840) & 127; }
#pragma unroll
        for (int ni = 0; ni < 4; ++ni) {
          int v = vrow0 + ni * 16 + fr;
          *reinterpret_cast<uint2*>(base + (size_t)v * KEYS + key) =
              make_uint2(pack2(acc[mi][ni][0], acc[mi][ni][1]), pack2(acc[mi][ni][2], acc[mi][ni][3]));
        }
      }
    } else {
      float bg = P.b_gate[l * 16 + fr];
#pragma unroll
      for (int mi = 0; mi < 8; ++mi)
#pragma unroll
        for (int j = 0; j < 4; ++j) WS_GATES(P)[(size_t)(row0 + mi * 16 + fq * 4 + j) * 16 + fr] = acc[mi][0][j] + bg;
    }
  }
};

template <int QB, int VB, int KW>
struct AttnCore {
  static constexpr int DV = 32 * VB;
  static constexpr int KST = KW * 2 + 16;
  static constexpr int VST = 128 + 16;
  static constexpr int KBYTES = 64 * KST, VBYTES = DV * VST;
  static constexpr int NKL = 64 * (KW / 8) / NTHREADS, NVL = DV * 8 / NTHREADS;
  static constexpr int TOTAL = 2 * (KBYTES + VBYTES);

  static DEV void run(const u16* qptr, int ldq, const u16* kctx, const u16* klat, int ldk, int kcol, const u16* vt,
                      int nctx, int nlat, int lat_t0, bool window, int qtok0, float m_init, float l_init,
                      f32x16 (&O)[QB][VB], char* smem) {
    const int tid = my_tid(), lane = tid & 63, r = lane & 31, hh = lane >> 5;
    char* Ks = smem;
    char* Vs = smem + 2 * KBYTES;
    bf16x8 qf[QB][4];
#pragma unroll
    for (int qb = 0; qb < QB; ++qb)
#pragma unroll
      for (int ks = 0; ks < 4; ++ks) qf[qb][ks] = ld16(qptr + (size_t)(qb * 32 + r) * ldq + ks * 16 + hh * 8);
    float m[QB], lsum[QB];
#pragma unroll
    for (int qb = 0; qb < QB; ++qb) {
      m[qb] = m_init;
      lsum[qb] = hh == 0 ? l_init : 0.f;
#pragma unroll
      for (int vb = 0; vb < VB; ++vb)
#pragma unroll
        for (int i = 0; i < 16; ++i) O[qb][vb][i] = 0.f;
    }
    bf16x8 rk[NKL], rv[NVL];
    const int ntiles = nctx + nlat;
    auto gload = [&](int j) {
      int kidx = j < nctx ? j * 64 : 256 + lat_t0 + (j - nctx) * 64;
      const u16* krow = j < nctx ? kctx + (size_t)(j * 64) * ldk : klat + (size_t)(lat_t0 + (j - nctx) * 64) * ldk;
#pragma unroll
      for (int i = 0; i < NKL; ++i) {
        int id = tid + i * NTHREADS, row = id / (KW / 8), c = id % (KW / 8);
        rk[i] = ld16(krow + (size_t)row * ldk + c * 8);
      }
#pragma unroll
      for (int i = 0; i < NVL; ++i) {
        int id = tid + i * NTHREADS, row = id >> 3, c = id & 7;
        rv[i] = ld16(vt + (size_t)row * KEYS + kidx + c * 8);
      }
    };
    auto lstore = [&](int buf) {
#pragma unroll
      for (int i = 0; i < NKL; ++i) {
        int id = tid + i * NTHREADS, row = id / (KW / 8), c = id % (KW / 8);
        *reinterpret_cast<bf16x8*>(Ks + buf * KBYTES + row * KST + c * 16) = rk[i];
      }
#pragma unroll
      for (int i = 0; i < NVL; ++i) {
        int id = tid + i * NTHREADS, row = id >> 3, c = id & 7;
        *reinterpret_cast<bf16x8*>(Vs + buf * VBYTES + row * VST + c * 16) = rv[i];
      }
    };
    __syncthreads();
    gload(0);
    lstore(0);
    __syncthreads();
    for (int j = 0; j < ntiles; ++j) {
      const int buf = j & 1;
      if (j + 1 < ntiles) gload(j + 1);
      bf16x8 pf[QB][2][2];
#pragma unroll
      for (int qb = 0; qb < QB; ++qb) {
        f32x16 S[2];
#pragma unroll
        for (int kb = 0; kb < 2; ++kb) {
#pragma unroll
          for (int i = 0; i < 16; ++i) S[kb][i] = 0.f;
#pragma unroll
          for (int ks = 0; ks < 4; ++ks) {
            bf16x8 kf = ld16(Ks + buf * KBYTES + (kb * 32 + pi32(r)) * KST + (kcol + ks * 16 + hh * 8) * 2);
            S[kb] = mfma32(kf, qf[qb][ks], S[kb]);
          }
        }
        __builtin_amdgcn_sched_barrier(0);
        if (window && j >= nctx) {
          int kt0 = lat_t0 + (j - nctx) * 64;
          int qt = qtok0 + qb * 32 + r;
#pragma unroll
          for (int kb = 0; kb < 2; ++kb)
#pragma unroll
            for (int i = 0; i < 16; ++i) {
              int kt = kt0 + kb * 32 + 16 * (i >> 3) + 8 * hh + (i & 7);
              int dlt = qt - kt;
              if (dlt > 128 || dlt < -128) S[kb][i] = -1e30f;
            }
        }
        float mloc = -1e30f;
#pragma unroll
        for (int kb = 0; kb < 2; ++kb)
#pragma unroll
          for (int i = 0; i < 16; ++i) mloc = fmaxf(mloc, S[kb][i]);
        mloc = fmaxf(mloc, __shfl_xor(mloc, 32));
        if (__any(mloc > m[qb] + 5.5f)) {
          float mnew = fmaxf(m[qb], mloc);
          float alpha = fexp2((m[qb] - mnew) * L2E);
          m[qb] = mnew;
          lsum[qb] *= alpha;
#pragma unroll
          for (int vb = 0; vb < VB; ++vb)
#pragma unroll
            for (int i = 0; i < 16; ++i) O[qb][vb][i] *= alpha;
        }
        float mb = m[qb] * L2E, ps = 0.f;
#pragma unroll
        for (int kb = 0; kb < 2; ++kb) {
          float pv[16];
#pragma unroll
          for (int i = 0; i < 16; ++i) {
            pv[i] = fexp2(S[kb][i] * L2E - mb);
            ps += pv[i];
          }
#pragma unroll
          for (int s = 0; s < 2; ++s)
            pf[qb][kb][s] = mk8(pack2(pv[8 * s], pv[8 * s + 1]), pack2(pv[8 * s + 2], pv[8 * s + 3]),
                                pack2(pv[8 * s + 4], pv[8 * s + 5]), pack2(pv[8 * s + 6], pv[8 * s + 7]));
        }
        lsum[qb] += ps;
        __builtin_amdgcn_sched_barrier(0);
      }
      __builtin_amdgcn_sched_barrier(0);
#pragma unroll
      for (int vb = 0; vb < VB; ++vb) {
#pragma unroll
        for (int kb = 0; kb < 2; ++kb)
#pragma unroll
          for (int s = 0; s < 2; ++s) {
            bf16x8 vf = ld16(Vs + buf * VBYTES + (vb * 32 + r) * VST + (kb * 32 + s * 16 + hh * 8) * 2);
#pragma unroll
            for (int qb = 0; qb < QB; ++qb) O[qb][vb] = mfma32(vf, pf[qb][kb][s], O[qb][vb]);
          }
        __builtin_amdgcn_sched_barrier(0);
      }
      if (j + 1 < ntiles) lstore(buf ^ 1);
      __syncthreads();
    }
#pragma unroll
    for (int qb = 0; qb < QB; ++qb) {
      float lt = lsum[qb] + __shfl_xor(lsum[qb], 32);
      float inv = 1.f / lt;
#pragma unroll
      for (int vb = 0; vb < VB; ++vb)
#pragma unroll
        for (int i = 0; i < 16; ++i) O[qb][vb][i] *= inv;
    }
  }
};

DEV void diff_item(const Params& P, int l, int b, int h, int qt, bool ctxq, char* smem) {
  const int tid = my_tid(), lane = tid & 63, wid = tid >> 6, r = lane & 31, hh = lane >> 5;
  const int comp = wid >> 2, wq = wid & 3;
  const int rowbase = ctxq ? NLAT + b * 256 + qt * 128 : b * T + qt * 128;
  const u16* qptr = WS_P(P) + (size_t)(rowbase + wq * 32) * PW + C_DQ + h * 128 + comp * 64;
  const u16* kctx = WS_P(P) + (size_t)(NLAT + b * 256) * PW + C_DK + h * 128;
  const u16* klat = WS_P(P) + (size_t)(b * T) * PW + C_DK + h * 128;
  const u16* vt = WS_VTD(P) + ((size_t)(b * 4 + h) * 128) * KEYS;
  f32x16 O[1][4];
  AttnCore<1, 4, 128>::run(qptr, PW, kctx, klat, PW, comp * 64, vt, 4, ctxq ? 0 : 64, 0, false, 0, -1e30f, 0.f, O, smem);
  float* ex = reinterpret_cast<float*>(smem);
  __syncthreads();
  if (comp == 1) {
#pragma unroll
    for (int vb = 0; vb < 4; ++vb)
#pragma unroll
      for (int i = 0; i < 16; ++i) ex[(wq * 64 + vb * 16 + i) * 64 + lane] = O[0][vb][i];
  }
  __syncthreads();
  if (comp == 0) {
    const float lam = WS_LAM(P)[l];
    const float lam_init = 0.8f - 0.6f * expf(-0.3f * (float)l);
    float ss = 0.f;
#pragma unroll
    for (int vb = 0; vb < 4; ++vb)
#pragma unroll
      for (int i = 0; i < 16; ++i) {
        float y = O[0][vb][i] - lam * ex[(wq * 64 + vb * 16 + i) * 64 + lane];
        O[0][vb][i] = y;
        ss += y * y;
      }
    ss += __shfl_xor(ss, 32);
    float sc = rsqrtf(ss * (1.f / 128.f) + EPS) * (1.f - lam_init);
    const float* dn = P.d_norm + l * 512 + h * 128;
    u16* dst = WS_P(P) + (size_t)(rowbase + wq * 32 + r) * PW + C_DQ + h * 128;
#pragma unroll
    for (int vb = 0; vb < 4; ++vb)
#pragma unroll
      for (int g4 = 0; g4 < 4; ++g4) {
        int v = vb * 32 + g4 * 8 + hh * 4;
        float4 w = *reinterpret_cast<const float4*>(dn + v);
        *reinterpret_cast<uint2*>(dst + v) =
            make_uint2(pack2(O[0][vb][g4 * 4] * sc * w.x, O[0][vb][g4 * 4 + 1] * sc * w.y),
                       pack2(O[0][vb][g4 * 4 + 2] * sc * w.z, O[0][vb][g4 * 4 + 3] * sc * w.w));
      }
  }
  __syncthreads();
}

DEV void win_item(const Params& P, int l, int b, int g, int qb, bool ctxq, char* smem) {
  const int tid = my_tid(), lane = tid & 63, wid = tid >> 6, r = lane & 31, hh = lane >> 5;
  const int hr = wid >> 1, qh = wid & 1;
  const int head = g * 4 + hr;
  const int rowbase = (ctxq ? NLAT + b * 256 + qb * 64 : b * T + qb * 64) + qh * 32;
  const u16* qptr = WS_P(P) + (size_t)rowbase * PW + C_WQ + head * 64;
  const u16* kctx = WS_P(P) + (size_t)(NLAT + b * 256) * PW + C_WK + g * 64;
  const u16* klat = WS_P(P) + (size_t)(b * T) * PW + C_WK + g * 64;
  const u16* vt = WS_VTW(P) + ((size_t)(b * 2 + g) * 64) * KEYS;
  int t0 = 0, nlat = 0;
  if (!ctxq) {
    t0 = qb * 64 - 128;
    if (t0 < 0) t0 = 0;
    int t1 = qb * 64 + 192;
    if (t1 > T) t1 = T;
    nlat = (t1 - t0) >> 6;
  }
  f32x16 O[1][2];
  AttnCore<1, 2, 64>::run(qptr, PW, kctx, klat, PW, 0, vt, 4, nlat, t0, !ctxq, qb * 64 + qh * 32, P.sink[l * 8 + head], 1.f, O, smem);
  u16* dst = WS_P(P) + (size_t)(rowbase + r) * PW + C_WQ + head * 64;
#pragma unroll
  for (int vb = 0; vb < 2; ++vb)
#pragma unroll
    for (int g4 = 0; g4 < 4; ++g4) {
      int v = vb * 32 + g4 * 8 + hh * 4;
      *reinterpret_cast<uint2*>(dst + v) = make_uint2(pack2(O[0][vb][g4 * 4], O[0][vb][g4 * 4 + 1]),
                                                        pack2(O[0][vb][g4 * 4 + 2], O[0][vb][g4 * 4 + 3]));
    }
}

DEV void mlstm_item(const Params& P, int l, int b, int hd, int dir, bool need_ctx, char* smem) {
  const int tid = my_tid(), lane = tid & 63, wid = tid >> 6, r = lane & 31, hh = lane >> 5;
  constexpr int QST = 272, TST = 144;
  char* Qs = smem;
  char* Ks = Qs + 64 * QST;
  char* KwT = Ks + 64 * QST;
  char* VT = KwT + 128 * TST;
  char* Sp = VT + 128 * TST;
  char* Rq = Sp + 64 * TST;
  char* Rk = Rq + 66 * QST;
  float* fb = reinterpret_cast<float*>(Rk + 66 * QST);
  float* sb = fb;
  float* sa = fb + 64;
  float* sM = fb + 128;
  float* denp = fb + 192;
  float* qn = fb + 320;
  float* nb = fb + 384;
  float* cw = fb + 640;
  __syncthreads();
  if (tid < 256) nb[tid] = 0.f;
  for (int i = tid; i < 768; i += NTHREADS) {
    int qk = i / 384, tap = (i % 384) / 128, d = i & 127;
    cw[i] = P.conv_w[(size_t)l * 3 * 1024 + tap * 1024 + qk * 512 + hd * 128 + d];
  }
  f32x16 CT[4];
#pragma unroll
  for (int kb = 0; kb < 4; ++kb)
#pragma unroll
    for (int i = 0; i < 16; ++i) CT[kb][i] = 0.f;
  float mstate = 0.f;
  u16* hout = WS_HFB(P) + (size_t)dir * MTOT * 512;
  const float kscale = 0.08838834764831845f;

  for (int step = 0; step < 68; ++step) {
    int seg0, seglen, c;
    if (step < 4) { seg0 = NLAT + b * 256; seglen = 256; c = dir ? 3 - step : step; }
    else { seg0 = b * T; seglen = T; c = dir ? 67 - step : step - 4; }
    const int u0 = c * 64;
    const int rowbase = seg0 + u0;
    const int cur = step & 1;
    __syncthreads();
    bf16x8 rvv[2];
#pragma unroll
    for (int i = 0; i < 3; ++i) {
      int id = tid + i * NTHREADS;
      if (id < 66 * 16) {
        int row = id >> 4, cc = id & 15;
        int uu = u0 + row - 1;
        bool ok = uu >= 0 && uu < seglen;
        const u16* src = WS_P(P) + (size_t)(seg0 + (ok ? uu : 0)) * PW + hd * 128 + cc * 8;
        bf16x8 z = {0, 0, 0, 0, 0, 0, 0, 0};
        bf16x8 a = ok ? ld16(src + C_MQ) : z;
        bf16x8 bq = ok ? ld16(src + C_MK) : z;
        *reinterpret_cast<bf16x8*>(Rq + row * QST + cc * 16) = a;
        *reinterpret_cast<bf16x8*>(Rk + row * QST + cc * 16) = bq;
      }
    }
#pragma unroll
    for (int i = 0; i < 2; ++i) {
      int id = tid + i * NTHREADS, u = id >> 4, cc = id & 15;
      rvv[i] = ld16(WS_P(P) + (size_t)(rowbase + u) * PW + C_MV + hd * 128 + cc * 8);
    }
    if (wid == 0) {
      const int pos = dir ? 63 - lane : lane;
      const float* gp = WS_GATES(P) + (size_t)(rowbase + pos) * 16;
      float ig = gp[(dir * 2) * 4 + hd], fg = gp[(dir * 2 + 1) * 4 + hd];
      float lf = fminf(fg, 0.f) - log1pf(__expf(-fabsf(fg)));
      float bsum = lf;
#pragma unroll
      for (int o = 1; o < 64; o <<= 1) { float t2 = __shfl_up(bsum, o); if (lane >= o) bsum += t2; }
      float a = ig - bsum, am = a;
#pragma unroll
      for (int o = 1; o < 64; o <<= 1) { float t2 = __shfl_up(am, o); if (lane >= o) am = fmaxf(am, t2); }
      sb[pos] = bsum;
      sa[pos] = a;
      sM[pos] = fmaxf(mstate, am);
    }
    __syncthreads();
    const int eidx = dir ? 0 : 63;
    const float Mend = sM[eidx], bend = sb[eidx];
    const float decay = __expf(mstate - Mend);
#pragma unroll 1
    for (int i = 0; i < 2; ++i) {
      int id = tid + i * NTHREADS, u = id >> 4, cc = id & 15;
      float wend = __expf(sa[u] - Mend);
      uint32_t qo[4], ko[4];
      float kv[8];
      bf16x8 q0 = ld16(Rq + (u)*QST + cc * 16), q1 = ld16(Rq + (u + 1) * QST + cc * 16), q2 = ld16(Rq + (u + 2) * QST + cc * 16);
      bf16x8 k0 = ld16(Rk + (u)*QST + cc * 16), k1 = ld16(Rk + (u + 1) * QST + cc * 16), k2 = ld16(Rk + (u + 2) * QST + cc * 16);
#pragma unroll
      for (int e = 0; e < 8; ++e) {
        int d = cc * 8 + e;
        float xq = cw[0 * 128 + d] * bf2f((u16)q0[e]) + cw[1 * 128 + d] * bf2f((u16)q1[e]) + cw[2 * 128 + d] * bf2f((u16)q2[e]);
        float xk = cw[384 + 0 * 128 + d] * bf2f((u16)k0[e]) + cw[384 + 1 * 128 + d] * bf2f((u16)k1[e]) + cw[384 + 2 * 128 + d] * bf2f((u16)k2[e]);
        float qv = siluf_(xq);
        kv[e] = siluf_(xk) * kscale;
        if (e & 1) { qo[e >> 1] |= ((uint32_t)f2bf(qv)) << 16; ko[e >> 1] |= ((uint32_t)f2bf(kv[e])) << 16; }
        else { qo[e >> 1] = f2bf(qv); ko[e >> 1] = f2bf(kv[e]); }
        *reinterpret_cast<u16*>(KwT + (d)*TST + u * 2) = f2bf(kv[e] * wend);
        *reinterpret_cast<u16*>(VT + (d)*TST + u * 2) = (u16)rvv[i][e];
      }
      *reinterpret_cast<uint4*>(Qs + u * QST + cc * 16) = make_uint4(qo[0], qo[1], qo[2], qo[3]);
      *reinterpret_cast<uint4*>(Ks + u * QST + cc * 16) = make_uint4(ko[0], ko[1], ko[2], ko[3]);
    }
    __syncthreads();
    if (wid < 4) {
      const int sblk = wid & 1, tblk = wid >> 1;
      f32x16 S;
#pragma unroll
      for (int i = 0; i < 16; ++i) S[i] = 0.f;
#pragma unroll
      for (int ks = 0; ks < 8; ++ks) {
        bf16x8 kf = ld16(Ks + (sblk * 32 + pi32(r)) * QST + (ks * 16 + hh * 8) * 2);
        bf16x8 qf = ld16(Qs + (tblk * 32 + r) * QST + (ks * 16 + hh * 8) * 2);
        S = mfma32(kf, qf, S);
      }
      const int t = tblk * 32 + r;
      const float Mt = sM[t];
      float ds = 0.f, val[16];
#pragma unroll
      for (int i = 0; i < 16; ++i) {
        int s = sblk * 32 + 16 * (i >> 3) + 8 * hh + (i & 7);
        bool ok = dir ? (s >= t) : (s <= t);
        val[i] = ok ? S[i] * __expf(sa[s] - Mt) : 0.f;
        ds += val[i];
      }
      ds += __shfl_xor(ds, 32);
      if (hh == 0) denp[sblk * 64 + t] = ds;
#pragma unroll
      for (int s2 = 0; s2 < 2; ++s2)
        *reinterpret_cast<uint4*>(Sp + t * TST + (sblk * 32 + s2 * 16 + hh * 8) * 2) =
            make_uint4(pack2(val[8 * s2], val[8 * s2 + 1]), pack2(val[8 * s2 + 2], val[8 * s2 + 3]),
                       pack2(val[8 * s2 + 4], val[8 * s2 + 5]), pack2(val[8 * s2 + 6], val[8 * s2 + 7]));
    } else if (wid == 4) {
      float s = 0.f;
      const float* nc = nb + cur * 128;
      for (int k8 = 0; k8 < 16; ++k8) {
        bf16x8 qv = ld16(Qs + lane * QST + k8 * 16);
#pragma unroll
        for (int e = 0; e < 8; ++e) s += nc[k8 * 8 + e] * bf2f((u16)qv[e]);
      }
      qn[lane] = s;
    } else if (wid == 5) {
      const float* nc = nb + cur * 128;
      float* nn = nb + (cur ^ 1) * 128;
#pragma unroll
      for (int q2 = 0; q2 < 2; ++q2) {
        int k = lane + q2 * 64;
        float s = 0.f;
        for (int s8 = 0; s8 < 8; ++s8) {
          bf16x8 kv = ld16(KwT + k * TST + s8 * 16);
#pragma unroll
          for (int e = 0; e < 8; ++e) s += bf2f((u16)kv[e]);
        }
        nn[k] = decay * nc[k] + s;
      }
    }
    __syncthreads();
    {
      bf16x8 vf[4];
      const int vb = wid & 3, tb = wid >> 2;
#pragma unroll
      for (int ks = 0; ks < 4; ++ks) vf[ks] = ld16(VT + (vb * 32 + r) * TST + (ks * 16 + hh * 8) * 2);
      const bool wr_h = (step >= 4) || need_ctx;
      {
        const int t = tb * 32 + r;
        f32x16 acc;
#pragma unroll
        for (int i = 0; i < 16; ++i) acc[i] = 0.f;
#pragma unroll
        for (int kb = 0; kb < 4; ++kb)
#pragma unroll
          for (int s2 = 0; s2 < 2; ++s2) {
            bf16x8 af = mk8(pack2(CT[kb][8 * s2], CT[kb][8 * s2 + 1]), pack2(CT[kb][8 * s2 + 2], CT[kb][8 * s2 + 3]),
                            pack2(CT[kb][8 * s2 + 4], CT[kb][8 * s2 + 5]), pack2(CT[kb][8 * s2 + 6], CT[kb][8 * s2 + 7]));
            uint2 lo = *reinterpret_cast<const uint2*>(Qs + t * QST + (kb * 32 + s2 * 16 + hh * 4) * 2);
            uint2 hi = *reinterpret_cast<const uint2*>(Qs + t * QST + (kb * 32 + s2 * 16 + 8 + hh * 4) * 2);
            acc = mfma32(af, mk8(lo.x, lo.y, hi.x, hi.y), acc);
          }
        const float Mt = sM[t];
        const float winter = __expf(mstate - Mt);
#pragma unroll
        for (int i = 0; i < 16; ++i) acc[i] *= winter;
#pragma unroll
        for (int ks = 0; ks < 4; ++ks) {
          bf16x8 sf = ld16(Sp + t * TST + (ks * 16 + hh * 8) * 2);
          acc = mfma32(vf[ks], sf, acc);
        }
        float den = denp[t] + denp[64 + t] + winter * qn[t];
        float sc = 1.f / fmaxf(fabsf(den), __expf(-(sb[t] + Mt)));
        if (wr_h) {
          u16* dst = hout + (size_t)(rowbase + t) * 512 + hd * 128 + vb * 32;
#pragma unroll
          for (int g4 = 0; g4 < 4; ++g4)
            *reinterpret_cast<uint2*>(dst + g4 * 8 + hh * 4) =
                make_uint2(pack2(acc[g4 * 4] * sc, acc[g4 * 4 + 1] * sc), pack2(acc[g4 * 4 + 2] * sc, acc[g4 * 4 + 3] * sc));
        }
      }
#pragma unroll
      for (int kb = 0; kb < 4; ++kb) {
#pragma unroll
        for (int i = 0; i < 16; ++i) CT[kb][i] *= decay;
#pragma unroll
        for (int ks = 0; ks < 4; ++ks) {
          bf16x8 kf = ld16(KwT + (kb * 32 + r) * TST + (ks * 16 + hh * 8) * 2);
          CT[kb] = mfma32(kf, vf[ks], CT[kb]);
        }
      }
    }
    mstate = bend + Mend;
  }
  __syncthreads();
}

DEV int next_item(unsigned* ctr, int* s_item) {
  __syncthreads();
  if (my_tid() == 0) *s_item = (int)atomicAdd(ctr, 1u);
  __syncthreads();
  return *s_item;
}
DEV void phase_mixers(const Params& P, int l, char* smem) {
  const bool need_ctx = (l == 0);
  __shared__ int s_item;
  const int n_ml = 128, n_diff = 2048, n_win = 2048, n_dc = need_ctx ? 128 : 0, n_wc = need_ctx ? 128 : 0;
  for (;;) {
    int it = next_item(&WS_CTR(P)[l * 4 + 0], &s_item);
    if (it >= n_ml) break;
    mlstm_item(P, l, it >> 3, (it >> 1) & 3, it & 1, need_ctx, smem);
  }
  for (;;) {
    int it = next_item(&WS_CTR(P)[l * 4 + 1], &s_item);
    if (it >= n_diff + n_dc) break;
    bool cq = it >= n_diff;
    int i2 = it - n_diff;
    int b = cq ? i2 >> 3 : it >> 7, hd = cq ? (i2 >> 1) & 3 : (it >> 5) & 3, qt = cq ? i2 & 1 : it & 31;
    diff_item(P, l, b, hd, qt, cq, smem);
  }
  for (;;) {
    int it = next_item(&WS_CTR(P)[l * 4 + 2], &s_item);
    if (it >= n_win + n_wc) break;
    bool cq = it >= n_win;
    int i2 = it - n_win;
    int b = cq ? i2 >> 3 : it >> 7, g = cq ? (i2 >> 2) & 1 : (it >> 6) & 1, qb = cq ? i2 & 3 : it & 63;
    win_item(P, l, b, g, qb, cq, smem);
  }
}

DEV void phase_ya(const Params& P, int l, int nrows) {
  const int lane = my_tid() & 63, wid = my_tid() >> 6;
  const u16* hf = WS_HFB(P);
  const u16* hb = WS_HFB(P) + (size_t)MTOT * 512;
  for (int row = blockIdx.x * 8 + wid; row < nrows; row += gridDim.x * 8) {
    uint4 a = *reinterpret_cast<const uint4*>(hf + (size_t)row * 512 + lane * 8);
    uint4 bq = *reinterpret_cast<const uint4*>(hb + (size_t)row * 512 + lane * 8);
    uint4 o = *reinterpret_cast<const uint4*>(WS_P(P) + (size_t)row * PW + C_MO + lane * 8);
    uint32_t aa[4] = {a.x, a.y, a.z, a.w}, bb[4] = {bq.x, bq.y, bq.z, bq.w}, oo[4] = {o.x, o.y, o.z, o.w};
    float y[8], ss = 0.f;
#pragma unroll
    for (int j = 0; j < 4; ++j) {
      y[2 * j] = (bflo(aa[j]) + bflo(bb[j])) * sigmoidf_(bflo(oo[j]));
      y[2 * j + 1] = (bfhi(aa[j]) + bfhi(bb[j])) * sigmoidf_(bfhi(oo[j]));
      ss += y[2 * j] * y[2 * j] + y[2 * j + 1] * y[2 * j + 1];
    }
#pragma unroll
    for (int of = 1; of < 16; of <<= 1) ss += __shfl_xor(ss, of);
    float rstd = rsqrtf(ss * (1.f / 128.f) + EPS);
    const float* mn = P.m_norm + l * 512 + lane * 8;
    uint32_t w[4];
#pragma unroll
    for (int j = 0; j < 4; ++j) w[j] = pack2(y[2 * j] * rstd * mn[2 * j], y[2 * j + 1] * rstd * mn[2 * j + 1]);
    *reinterpret_cast<uint4*>(WS_P(P) + (size_t)row * PW + C_MO + lane * 8) = make_uint4(w[0], w[1], w[2], w[3]);
  }
}

DEV void phase_merge(const Params& P, int l, int M, char* smem) {
  const u16* Wl = WS_W(P) + (size_t)l * W_LAYER;
  u16* merged = WS_HFB(P);
  const int nM = M / 128, nN = 8;
  const int lane = my_tid() & 63, wid = my_tid() >> 6, wr = wid >> 2, wc = wid & 3, fr = lane & 15, fq = lane >> 4;
  for (int tile = blockIdx.x; tile < nM * nN; tile += gridDim.x) {
    int tm = tile / nN, tn = tile % nN;
    f32x4 mg[4][2];
    zero_acc<4, 2>(mg);
#pragma unroll 1
    for (int i = 0; i < 3; ++i) {
      f32x4 acc[4][2];
      zero_acc<4, 2>(acc);
      gemm_mainloop<4, 2>(WS_H(P) + (size_t)tm * 128 * 1024, 1024, Wl + W_G + (size_t)(i * 1024 + tn * 128) * 1024, 1024, 1024, acc, smem);
      uint32_t gp[4][2][2];
#pragma unroll
      for (int mi = 0; mi < 4; ++mi)
#pragma unroll
        for (int ni = 0; ni < 2; ++ni) {
          gp[mi][ni][0] = pack2(sigmoidf_(acc[mi][ni][0]), sigmoidf_(acc[mi][ni][1]));
          gp[mi][ni][1] = pack2(sigmoidf_(acc[mi][ni][2]), sigmoidf_(acc[mi][ni][3]));
        }
      zero_acc<4, 2>(acc);
      int yc = i == 0 ? C_MO : (i == 1 ? C_WQ : C_DQ);
      gemm_mainloop<4, 2>(WS_P(P) + (size_t)tm * 128 * PW + yc, PW, Wl + W_B + (size_t)i * 1024 * 512 + (size_t)(tn * 128) * 512, 512, 512, acc, smem);
#pragma unroll
      for (int mi = 0; mi < 4; ++mi)
#pragma unroll
        for (int ni = 0; ni < 2; ++ni) {
          mg[mi][ni][0] += bflo(gp[mi][ni][0]) * acc[mi][ni][0];
          mg[mi][ni][1] += bfhi(gp[mi][ni][0]) * acc[mi][ni][1];
          mg[mi][ni][2] += bflo(gp[mi][ni][1]) * acc[mi][ni][2];
          mg[mi][ni][3] += bfhi(gp[mi][ni][1]) * acc[mi][ni][3];
        }
    }
    const int row0 = tm * 128 + wr * 64, col0 = tn * 128 + wc * 32;
#pragma unroll
    for (int mi = 0; mi < 4; ++mi)
#pragma unroll
      for (int ni = 0; ni < 2; ++ni)
#pragma unroll
        for (int j = 0; j < 4; ++j)
          merged[(size_t)(row0 + mi * 16 + fq * 4 + j) * 1024 + col0 + ni * 16 + fr] = f2bf(mg[mi][ni][j]);
  }
}

struct EpiResid {
  const Params& P;
  const float* src_lat;
  const float* modl;
  int gt_off;
  DEV void operator()(f32x4 (&acc)[8][4], int row0, int col0) const {
    const int lane = my_tid() & 63, fr = lane & 15, fq = lane >> 4;
#pragma unroll
    for (int mi = 0; mi < 8; ++mi)
#pragma unroll
      for (int j = 0; j < 4; ++j) {
        int row = row0 + mi * 16 + fq * 4 + j;
        const float* src;
        float* dst;
        int cond;
        if (row < NLAT) { src = src_lat + (size_t)row * 1024; dst = P.out + (size_t)row * 1024; cond = row >> 12; }
        else { src = WS_XC(P) + (size_t)(row - NLAT) * 1024; dst = WS_XC(P) + (size_t)(row - NLAT) * 1024; cond = 16; }
        const float* gt = modl + (size_t)cond * 6144 + gt_off;
#pragma unroll
        for (int ni = 0; ni < 4; ++ni) {
          int col = col0 + ni * 16 + fr;
          dst[col] = src[col] + gt[col] * acc[mi][ni][j];
        }
      }
  }
};

struct EpiSwiglu {
  u16* act;
  DEV void operator()(f32x4 (&acc)[8][4], int row0, int col0) const {
    const int lane = my_tid() & 63, fr = lane & 15, fq = lane >> 4;
#pragma unroll
    for (int mi = 0; mi < 8; ++mi)
#pragma unroll
      for (int j = 0; j < 4; ++j) {
        int row = row0 + mi * 16 + fq * 4 + j;
#pragma unroll
        for (int pr = 0; pr < 2; ++pr) {
          float gte = acc[mi][pr * 2][j], up = acc[mi][pr * 2 + 1][j];
          act[(size_t)row * FH + ((col0 + pr * 32) >> 1) + fr] = f2bf(siluf_(gte) * up);
        }
      }
  }
};


#ifdef SELFCHECK
#define DBGF(P) reinterpret_cast<float*>((P).ws + O_XC + (size_t)NCTXR * 1024 * 4)
DEV float blk_reduce(float v, bool ismax, float* red) {
  const int tid = my_tid(), lane = tid & 63, wid = tid >> 6;
#pragma unroll
  for (int o = 32; o > 0; o >>= 1) { float t = __shfl_xor(v, o); v = ismax ? fmaxf(v, t) : v + t; }
  __syncthreads();
  if (lane == 0) red[wid] = v;
  __syncthreads();
  float r = red[0];
  for (int i = 1; i < 8; ++i) r = ismax ? fmaxf(r, red[i]) : r + red[i];
  __syncthreads();
  return r;
}
DEV void chk_sample(int s, int& b, int& hd, int& t) {
  const int ti = s & 7;
  b = (s * 5 + 3) & 15; hd = s & 7;
  t = ti == 0 ? 0 : ti == 1 ? 63 : ti == 2 ? 64 : ti == 3 ? 127 : ti == 4 ? 2048 + 65 : ti == 5 ? 3000 : ti == 6 ? 4032 : 4095;
}
DEV void check_pre(const Params& P, int l, char* smem) {
  const int tid = my_tid();
  float* sc = reinterpret_cast<float*>(smem);
  float* red = sc + 2 * 4352;
  float* ov = red + 16;
  float* dbg = DBGF(P);
  const u16* p = WS_P(P);
  for (int it = blockIdx.x; it < 24; it += gridDim.x) {
    const bool isdiff = it >= 12;
    const int s = isdiff ? it - 12 : it;
    int b, hd, t;
    chk_sample(s, b, hd, t);
    const bool ctxq = s >= 8;
    if (ctxq) t &= 255;
    const size_t row = ctxq ? (size_t)NLAT + b * 256 + t : (size_t)b * T + t;
    __syncthreads();
    if (!isdiff) {
      const int head = hd, g = head >> 2;
      const int lo = ctxq ? 0 : max(0, t - 128), hi = ctxq ? -1 : min(T - 1, t + 128);
      const int nk = 256 + (hi - lo + 1);
      float mx = -1e30f;
      for (int k = tid; k < nk; k += NTHREADS) {
        size_t krow = k < 256 ? (size_t)NLAT + b * 256 + k : (size_t)b * T + lo + (k - 256);
        float a = 0.f;
        for (int d = 0; d < 64; ++d) a += bf2f(p[row * PW + C_WQ + head * 64 + d]) * bf2f(p[krow * PW + C_WK + g * 64 + d]);
        sc[k] = a;
        mx = fmaxf(mx, a);
      }
      mx = blk_reduce(mx, true, red);
      const float sk = P.sink[l * 8 + head];
      mx = fmaxf(mx, sk);
      float sm = 0.f;
      for (int k = tid; k < nk; k += NTHREADS) { float e = expf(sc[k] - mx); sc[k] = e; sm += e; }
      sm = blk_reduce(sm, false, red) + expf(sk - mx);
      if (tid < 64) {
        float o = 0.f;
        for (int k = 0; k < nk; ++k) {
          int kidx = k < 256 ? k : 256 + lo + (k - 256);
          o += sc[k] * bf2f(WS_VTW(P)[((size_t)(b * 2 + g) * 64 + tid) * KEYS + kidx]);
        }
        dbg[it * 128 + tid] = o / sm;
      }
    } else {
      const int h = hd & 3;
      const int nk = ctxq ? 256 : KEYS;
      float mx0 = -1e30f, mx1 = -1e30f;
      for (int k = tid; k < nk; k += NTHREADS) {
        size_t krow = k < 256 ? (size_t)NLAT + b * 256 + k : (size_t)b * T + (k - 256);
        float a0 = 0.f, a1 = 0.f;
        for (int d = 0; d < 64; ++d) {
          a0 += bf2f(p[row * PW + C_DQ + h * 128 + d]) * bf2f(p[krow * PW + C_DK + h * 128 + d]);
          a1 += bf2f(p[row * PW + C_DQ + h * 128 + 64 + d]) * bf2f(p[krow * PW + C_DK + h * 128 + 64 + d]);
        }
        sc[k] = a0; sc[4352 + k] = a1;
        mx0 = fmaxf(mx0, a0); mx1 = fmaxf(mx1, a1);
      }
      mx0 = blk_reduce(mx0, true, red);
      mx1 = blk_reduce(mx1, true, red);
      float s0 = 0.f, s1 = 0.f;
      for (int k = tid; k < nk; k += NTHREADS) {
        float e0 = expf(sc[k] - mx0), e1 = expf(sc[4352 + k] - mx1);
        sc[k] = e0; sc[4352 + k] = e1; s0 += e0; s1 += e1;
      }
      s0 = blk_reduce(s0, false, red);
      s1 = blk_reduce(s1, false, red);
      const float lam = WS_LAM(P)[l], lam_init = 0.8f - 0.6f * expf(-0.3f * (float)l);
      float y = 0.f;
      if (tid < 128) {
        for (int k = 0; k < nk; ++k)
          y += (sc[k] / s0 - lam * sc[4352 + k] / s1) * bf2f(WS_VTD(P)[((size_t)(b * 4 + h) * 128 + tid) * KEYS + k]);
        ov[tid] = y;
      }
      __syncthreads();
      if (tid < 128) {
        float ss = 0.f;
        for (int v = 0; v < 128; ++v) ss += ov[v] * ov[v];
        dbg[it * 128 + tid] = y * rsqrtf(ss / 128.f + EPS) * P.d_norm[l * 512 + h * 128 + tid] * (1.f - lam_init);
      }
    }
  }
}
DEV void check_post(const Params& P, int l, unsigned* flags) {
  const int tid = my_tid();
  const float* dbg = DBGF(P);
  const u16* p = WS_P(P);
  for (int it = blockIdx.x; it < 24; it += gridDim.x) {
    const bool isdiff = it >= 12;
    const int s = isdiff ? it - 12 : it;
    int b, hd, t;
    chk_sample(s, b, hd, t);
    const bool ctxq = s >= 8;
    if (ctxq) t &= 255;
    const size_t row = ctxq ? (size_t)NLAT + b * 256 + t : (size_t)b * T + t;
    if (ctxq && l != 0) continue;
    const int n = isdiff ? 128 : 64;
    if (tid < n) {
      float got = isdiff ? bf2f(p[row * PW + C_DQ + (hd & 3) * 128 + tid]) : bf2f(p[row * PW + C_WQ + hd * 64 + tid]);
      float ex = dbg[it * 128 + tid];
      if (!(fabsf(got - ex) <= 0.03f + 0.03f * fabsf(ex))) atomicOr(flags, isdiff ? (ctxq ? 32u : 2u) : (ctxq ? 16u : 1u));
    }
  }
}
DEV void check_mlstm(const Params& P, int l, char* smem, unsigned* flags) {
  const int tid = my_tid(), lane = tid & 63;
  float* qs = reinterpret_cast<float*>(smem);
  float* ks = qs + 128;
  float* vs = ks + 128;
  float* nn = vs + 128;
  float* sc = nn + 128;
  float* red = sc + 8;
  const u16* p = WS_P(P);
  for (int it = blockIdx.x; it < 4; it += gridDim.x) {
    const int b = (it * 7 + 2) & 15, hd = (it + 1) & 3, dir = it & 1;
    const int v = tid >> 2, kq = tid & 3;
    float C[32];
#pragma unroll
    for (int j = 0; j < 32; ++j) C[j] = 0.f;
    __syncthreads();
    if (tid < 128) nn[tid] = 0.f;
    if (tid == 0) sc[0] = 0.f;
    __syncthreads();
    const int nsteps = (l == 0) ? 256 + T : 256 + T;
    for (int st = 0; st < nsteps; ++st) {
      int seg0, seglen, u;
      if (st < 256) { seg0 = NLAT + b * 256; seglen = 256; u = dir ? 255 - st : st; }
      else { seg0 = b * T; seglen = T; u = dir ? T - 1 - (st - 256) : st - 256; }
      const size_t row = (size_t)seg0 + u;
      if (tid < 128) {
        float xq = 0.f, xk = 0.f;
        for (int tp = 0; tp < 3; ++tp) {
          int uu = u + tp - 1;
          if (uu >= 0 && uu < seglen) {
            xq += P.conv_w[(size_t)l * 3072 + tp * 1024 + hd * 128 + tid] * bf2f(p[((size_t)seg0 + uu) * PW + C_MQ + hd * 128 + tid]);
            xk += P.conv_w[(size_t)l * 3072 + tp * 1024 + 512 + hd * 128 + tid] * bf2f(p[((size_t)seg0 + uu) * PW + C_MK + hd * 128 + tid]);
          }
        }
        qs[tid] = xq / (1.f + expf(-xq));
        ks[tid] = xk / (1.f + expf(-xk)) * 0.08838834764831845f;
        vs[tid] = bf2f(p[row * PW + C_MV + hd * 128 + tid]);
      }
      if (tid == 0) {
        float ig = WS_GATES(P)[row * 16 + dir * 8 + hd], fg = WS_GATES(P)[row * 16 + dir * 8 + 4 + hd];
        float lf = fminf(fg, 0.f) - log1pf(expf(-fabsf(fg)));
        float m = sc[0], mn = fmaxf(lf + m, ig);
        sc[1] = expf(lf + m - mn);
        sc[2] = expf(ig - mn);
        sc[3] = mn;
      }
      __syncthreads();
      const float fd = sc[1], iw = sc[2], mn = sc[3];
      float pd = 0.f;
#pragma unroll
      for (int j = 0; j < 32; ++j) {
        C[j] = fd * C[j] + iw * vs[v] * ks[kq * 32 + j];
        pd += C[j] * qs[kq * 32 + j];
      }
      pd += __shfl_xor(pd, 1);
      pd += __shfl_xor(pd, 2);
      float dn = 0.f;
      if (tid < 128) { float nv = fd * nn[tid] + iw * ks[tid]; nn[tid] = nv; dn = nv * qs[tid]; }
      dn = blk_reduce(dn, false, red);
      if (tid == 0) sc[0] = mn;
      const float hval = pd / fmaxf(fabsf(dn), expf(-mn));
      float sq = (kq == 0) ? hval * hval : 0.f;
      sq = blk_reduce(sq, false, red);
      const float rms = sqrtf(sq / 128.f);
      const bool cmp = (st < 256) ? (l == 0) : true;
      if (cmp && kq == 0 && ((u & 63) == 0 || (u & 63) == 63 || (u % 97) == 0)) {
        float got = bf2f(WS_HFB(P)[(size_t)dir * MTOT * 512 + row * 512 + hd * 128 + v]);
        if (!(fabsf(got - hval) <= 0.05f * rms + 0.05f * fabsf(hval) + 1e-3f)) atomicOr(flags, dir ? 8u : 4u);
      }
    }
  }
}
#endif


#ifdef SELFCHECK
DEV void flag_if(bool bad, unsigned* flags, unsigned bit) { if (bad) atomicOr(flags, bit); }
DEV bool close_(float got, float ex, float tol) { return fabsf(got - ex) <= tol + tol * fabsf(ex); }
DEV void check_inproj(const Params& P, int l, char* smem, unsigned* flags) {
  const int tid = my_tid();
  float* red = reinterpret_cast<float*>(smem);
  float* hrow = red + 16;
  const float* modl = WS_MOD(P) + (size_t)l * 17 * 6144;
  for (int it = blockIdx.x; it < 64; it += gridDim.x) {
    const int ri = it & 7;
    const int row = ri == 0 ? 0 : ri == 1 ? 4095 : ri == 2 ? 4096 + 77 : ri == 3 ? 30000 : ri == 4 ? 65535 : ri == 5 ? NLAT : ri == 6 ? NLAT + 300 : MTOT - 1;
    const int cond = row < NLAT ? row >> 12 : 16;
    {
      int col = (it * 769 + 5) % 6144;
      float a = 0.f;
      for (int k = tid; k < 1024; k += NTHREADS) {
        float cv = cond < 16 ? P.c[cond * 1024 + k] : P.c_ctx[k];
        a += cv / (1.f + expf(-cv)) * P.w_mod[(size_t)l * 1024 * 6144 + (size_t)k * 6144 + col];
      }
      a = blk_reduce(a, false, red) + P.b_mod[l * 6144 + col];
      if (tid == 0) flag_if(!close_(modl[(size_t)cond * 6144 + col], a, 2e-3f), flags, 1u);
    }
    const float* xs = row < NLAT ? ((l == 0 ? P.x : P.out) + (size_t)row * 1024) : (WS_XC(P) + (size_t)(row - NLAT) * 1024);
    float ss = 0.f;
    for (int k = tid; k < 1024; k += NTHREADS) ss += xs[k] * xs[k];
    ss = blk_reduce(ss, false, red);
    const float rstd = rsqrtf(ss / 1024.f + EPS);
    for (int k = tid; k < 1024; k += NTHREADS) {
      float y = xs[k] * rstd * P.g_mix[l * 1024 + k] * (1.f + modl[(size_t)cond * 6144 + 1024 + k]) + modl[(size_t)cond * 6144 + k];
      hrow[k] = y;
      flag_if(!close_(bf2f(WS_H(P)[(size_t)row * 1024 + k]), y, 1e-2f), flags, 2u);
    }
    __syncthreads();
    const int oi = it >> 3;
    const int oj = (oi * 2 + (it & 1)) & 15;
    const int oc = oj == 0 ? 3 : oj == 1 ? 600 : oj == 2 ? 1100 : oj == 3 ? 1999 : oj == 4 ? 2050 : oj == 5 ? 2064 + 70 : oj == 6 ? 2576 + 100 :
                   oj == 7 ? 2704 + 5 : oj == 8 ? 2832 + 200 : oj == 9 ? 2832 + 37 : oj == 10 ? 3344 + 90 : oj == 11 ? 3344 + 300 :
                   oj == 12 ? 3856 + 10 : oj == 13 ? 3856 + 500 : oj == 14 ? 2048 + 15 : 2064 + 500;
    auto dotcol = [&](int c) {
      float a = 0.f;
      for (int k = tid; k < 1024; k += NTHREADS) a += hrow[k] * P.w_in[(size_t)l * 1024 * INW + (size_t)k * INW + c];
      return blk_reduce(a, false, red);
    };
    float val = dotcol(oc);
    const u16* p = WS_P(P);
    const bool lat = row < NLAT;
    const int t = row & (T - 1);
    float got = 0.f, ex = val;
    unsigned bit = 4u;
    if (oc < 2048) { got = bf2f(p[(size_t)row * PW + oc]); }
    else if (oc < 2064) { got = WS_GATES(P)[(size_t)row * 16 + oc - 2048]; ex = val + P.b_gate[l * 16 + oc - 2048]; }
    else if (oc >= 2704 && oc < 2832) {
      int cgi = oc - 2704, g = cgi >> 6, vd = cgi & 63;
      int b = lat ? row >> 12 : (row - NLAT) >> 8, key = lat ? 256 + t : (row - NLAT) & 255;
      got = bf2f(WS_VTW(P)[((size_t)(b * 2 + g) * 64 + vd) * KEYS + key]);
      bit = 8u;
    } else if (oc >= 3856) {
      int cgi = oc - 3856, h = cgi >> 7, vd = cgi & 127;
      int b = lat ? row >> 12 : (row - NLAT) >> 8, key = lat ? 256 + t : (row - NLAT) & 255;
      got = bf2f(WS_VTD(P)[((size_t)(b * 4 + h) * 128 + vd) * KEYS + key]);
      bit = 8u;
    } else {
      int base, nb0;
      bool isq;
      if (oc < 2576) { base = 2064; nb0 = C_WQ; isq = true; }
      else if (oc < 2704) { base = 2576; nb0 = C_WK; isq = false; }
      else if (oc < 3344) { base = 2832; nb0 = C_DQ; isq = true; }
      else { base = 3344; nb0 = C_DK; isq = false; }
      int rel = oc - base, dd = rel & 63, j = dd & 15, second = (dd >> 4) & 1, axis = dd >> 5;
      float other = dotcol(second ? oc - 16 : oc + 16);
      if (lat) {
        int pos = axis ? (t & 63) : (t >> 6);
        float ang = (float)pos * powf(10000.f, -(float)j / 16.f);
        float cs = cosf(ang), sn = sinf(ang);
        ex = second ? (val * cs + other * sn) : (val * cs - other * sn);
      }
      if (isq) ex *= 0.125f;
      got = bf2f(p[(size_t)row * PW + nb0 + rel]);
      bit = 16u;
    }
    if (tid == 0) flag_if(!close_(got, ex, 3e-2f), flags, bit);
    __syncthreads();
  }
}
DEV void check_post6(const Params& P, int l, char* smem, unsigned* flags, const float* xprev) {
  const int tid = my_tid();
  float* red = reinterpret_cast<float*>(smem);
  const u16* Yp = WS_P(P);
  const float* modl = WS_MOD(P) + (size_t)l * 17 * 6144;
  for (int it = blockIdx.x; it < 16; it += gridDim.x) {
    const int ri = it & 7;
    const int row = ri == 0 ? 1 : ri == 1 ? 4097 : ri == 2 ? 12345 : ri == 3 ? 40000 : ri == 4 ? 65534 : ri == 5 ? NLAT + 1 : ri == 6 ? NLAT + 2000 : MTOT - 2;
    if (row >= NLAT && l != 0) continue;
    const int col = (it * 331 + 17) & 1023;
    const int cond = row < NLAT ? row >> 12 : 16;
    float mg = 0.f;
    for (int i = 0; i < 3; ++i) {
      float a = 0.f, z = 0.f;
      for (int k = tid; k < 1024; k += NTHREADS) a += bf2f(WS_H(P)[(size_t)row * 1024 + k]) * P.w_in[(size_t)l * 1024 * INW + (size_t)k * INW + 4368 + i * 1024 + col];
      a = blk_reduce(a, false, red);
      const int yc = i == 0 ? C_MO : (i == 1 ? C_WQ : C_DQ);
      for (int k = tid; k < 512; k += NTHREADS) z += bf2f(Yp[(size_t)row * PW + yc + k]) * P.w_branch[((size_t)l * 3 + i) * 512 * 1024 + (size_t)k * 1024 + col];
      z = blk_reduce(z, false, red);
      mg += z / (1.f + expf(-a));
    }
    if (tid == 0) flag_if(!close_(bf2f(WS_HFB(P)[(size_t)row * 1024 + col]), mg, 3e-2f), flags, 1u);
    float o = 0.f;
    for (int k = tid; k < 1024; k += NTHREADS) o += bf2f(WS_HFB(P)[(size_t)row * 1024 + k]) * P.w_out[(size_t)l * 1024 * 1024 + (size_t)k * 1024 + col];
    o = blk_reduce(o, false, red);
    const float xo = row < NLAT ? xprev[(size_t)row * 1024 + col] : -1e9f;
    const float xn = row < NLAT ? P.out[(size_t)row * 1024 + col] : WS_XC(P)[(size_t)(row - NLAT) * 1024 + col];
    if (tid == 0 && row < NLAT && (l == 0)) flag_if(!close_(xn, xo + modl[(size_t)cond * 6144 + 2048 + col] * o, 2e-2f), flags, 2u);
    if (tid == 0) DBGF(P)[4096 + it] = xn;
  }
}
DEV void check_post9(const Params& P, int l, char* smem, unsigned* flags) {
  const int tid = my_tid();
  float* red = reinterpret_cast<float*>(smem);
  const float* modl = WS_MOD(P) + (size_t)l * 17 * 6144;
  for (int it = blockIdx.x; it < 16; it += gridDim.x) {
    const int ri = it & 7;
    const int row = ri == 0 ? 1 : ri == 1 ? 4097 : ri == 2 ? 12345 : ri == 3 ? 40000 : ri == 4 ? 65534 : ri == 5 ? NLAT + 1 : ri == 6 ? NLAT + 2000 : MTOT - 2;
    if (row >= NLAT && l != 0) continue;
    const int col = (it * 331 + 17) & 1023;
    const int cond = row < NLAT ? row >> 12 : 16;
    const int j = (it * 97 + 13) % FH;
    float g = 0.f, u = 0.f;
    for (int k = tid; k < 1024; k += NTHREADS) {
      float hv = bf2f(WS_H(P)[(size_t)row * 1024 + k]);
      g += hv * P.w_ffn_in[(size_t)l * 1024 * 5632 + (size_t)k * 5632 + j];
      u += hv * P.w_ffn_in[(size_t)l * 1024 * 5632 + (size_t)k * 5632 + FH + j];
    }
    g = blk_reduce(g, false, red);
    u = blk_reduce(u, false, red);
    if (tid == 0) flag_if(!close_(bf2f(WS_P(P)[(size_t)row * FH + j]), g / (1.f + expf(-g)) * u, 3e-2f), flags, 4u);
    float o = 0.f;
    for (int k = tid; k < FH; k += NTHREADS) o += bf2f(WS_P(P)[(size_t)row * FH + k]) * P.w_ffn_out[(size_t)l * FH * 1024 + (size_t)k * 1024 + col];
    o = blk_reduce(o, false, red);
    const float xn = row < NLAT ? P.out[(size_t)row * 1024 + col] : WS_XC(P)[(size_t)(row - NLAT) * 1024 + col];
    if (tid == 0) flag_if(!close_(xn, DBGF(P)[4096 + it] + modl[(size_t)cond * 6144 + 5120 + col] * o, 2e-2f), flags, 8u);
  }
}
#endif

#ifdef DEBUG_STAGE
DEV void debug_dump(const Params& P, int stage) {
  const int tid = my_tid();
  for (size_t idx = (size_t)blockIdx.x * NTHREADS + tid; idx < (size_t)NLAT * 1024; idx += (size_t)gridDim.x * NTHREADS) {
    size_t row = idx >> 10;
    int c = (int)(idx & 1023);
    size_t r2 = row + (row < 4096 ? NLAT : 0);
    float v = 0.f;
    const u16* p = WS_P(P);
    if (stage == 1) {
      v = bf2f(p[row * PW + c]) + bf2f(p[row * PW + 1024 + c]) + bf2f(p[row * PW + 2048 + c]) + (c < 640 ? bf2f(p[row * PW + 3072 + c]) : 0.f);
      v += bf2f(p[r2 * PW + c]) + bf2f(p[r2 * PW + 1024 + c]) + bf2f(p[r2 * PW + 2048 + c]);
      v += bf2f(WS_VTD(P)[r2 * 512 + (c & 511)]) + bf2f(WS_VTW(P)[r2 * 128 + (c & 127)]) + WS_GATES(P)[r2 * 16 + (c & 15)];
      v += bf2f(WS_VTD(P)[row * 512 + (c & 511)]) + bf2f(WS_VTW(P)[row * 128 + (c & 127)]) + WS_GATES(P)[row * 16 + (c & 15)];
    } else if (stage == 21) {
      v = bf2f(WS_HFB(P)[row * 512 + (c & 511)]) + 2.f * bf2f(WS_HFB(P)[(size_t)MTOT * 512 + row * 512 + (c & 511)]);
      v += bf2f(WS_HFB(P)[r2 * 512 + (c & 511)]) + 2.f * bf2f(WS_HFB(P)[(size_t)MTOT * 512 + r2 * 512 + (c & 511)]);
    } else if (stage == 22) {
      v = bf2f(p[row * PW + C_WQ + (c & 511)]) + bf2f(p[r2 * PW + C_WQ + (c & 511)]);
    } else if (stage == 23) {
      v = bf2f(p[row * PW + C_DQ + (c & 511)]) + bf2f(p[r2 * PW + C_DQ + (c & 511)]);
    } else if (stage == 3) {
      v = bf2f(WS_HFB(P)[row * 1024 + c]) + bf2f(WS_HFB(P)[r2 * 1024 + c]);
    } else if (stage == 4) {
      v = P.out[idx] + WS_XC(P)[(row & 4095) * 1024 + c];
    } else if (stage == 5) {
      v = bf2f(WS_H(P)[row * 1024 + c]) + bf2f(WS_H(P)[r2 * 1024 + c]);
    } else if (stage == 6) {
      v = bf2f(p[row * FH + c]) + bf2f(p[row * FH + 1024 + c]) + bf2f(p[r2 * FH + 1792 + c]);
    }
    if (stage != 4) P.out[idx] = v; else P.out[idx] = v;
  }
}
#define DBG(st) if (l == 0 && DEBUG_STAGE == st) { GSYNC_ONLY(); debug_dump(P, st); return true; }
#else
#define DBG(st)
#endif
template <int l>
DEV bool layer_body(const Params& P, unsigned* bar, unsigned& epoch, char* smem) {
  constexpr bool need_ctx = (l == 0);
  const float* modl = WS_MOD(P) + (size_t)l * 17 * 6144;
  const u16* Wl = WS_W(P) + (size_t)l * W_LAYER;
  const float* xlat = l == 0 ? P.x : P.out;
  constexpr int Mtok = need_ctx ? MTOT : NLAT;
  phase_norm_mod(P, xlat, WS_XC(P), MTOT, P.g_mix + l * 1024, modl, 0, 1024);
  GSYNC();
  gemm_phase<8>(WS_H(P), 1024, Wl + W_IN, 1024, MTOT, NIN, 1024, EpiInProj{P, l}, smem);
#ifdef REPEAT_GEMMS
  if (l == 1) gemm_phase<8>(WS_H(P), 1024, Wl + W_IN, 1024, MTOT, NIN, 1024, EpiInProj{P, l}, smem);
#endif
  GSYNC();
  DBG(1)
#ifdef SELFCHECK
#if SELFCHECK == 2
  check_inproj(P, l, smem, WS_CTR(P) + 16 + l * 3);
#else
  check_pre(P, l, smem);
#endif
  GSYNC();
#endif
  phase_mixers(P, l, smem);
  GSYNC();
#if defined(SELFCHECK) && SELFCHECK == 1
  check_post(P, l, WS_CTR(P) + 17 + l * 3);
  check_mlstm(P, l, smem, WS_CTR(P) + 17 + l * 3);
  GSYNC();
#endif
  DBG(21)
  DBG(22)
  DBG(23)
  phase_ya(P, l, Mtok);
  GSYNC();
  phase_merge(P, l, Mtok, smem);
#ifdef REPEAT_GEMMS
  if (l == 1) phase_merge(P, l, Mtok, smem);
#endif
  GSYNC();
  DBG(3)
  gemm_phase<8>(WS_HFB(P), 1024, Wl + W_O, 1024, Mtok, 1024, 1024, EpiResid{P, xlat, modl, 2048}, smem);
  GSYNC();
#if defined(SELFCHECK) && SELFCHECK == 2
  check_post6(P, l, smem, WS_CTR(P) + 18 + l * 3, xlat);
  GSYNC();
#endif
  DBG(4)
  phase_norm_mod(P, P.out, WS_XC(P), Mtok, P.g_ffn + l * 1024, modl, 3072, 4096);
  GSYNC();
  DBG(5)
  gemm_phase<8>(WS_H(P), 1024, Wl + W_FI, 1024, Mtok, 5632, 1024, EpiSwiglu{WS_P(P)}, smem);
#ifdef REPEAT_GEMMS
  if (l == 1) gemm_phase<8>(WS_H(P), 1024, Wl + W_FI, 1024, Mtok, 5632, 1024, EpiSwiglu{WS_P(P)}, smem);
#endif
  GSYNC();
  DBG(6)
  gemm_phase<8>(WS_P(P), FH, Wl + W_FO, FH, Mtok, 1024, FH, EpiResid{P, P.out, modl, 5120}, smem);
  GSYNC();
#if defined(SELFCHECK) && SELFCHECK == 2
  check_post9(P, l, smem, WS_CTR(P) + 18 + l * 3);
  GSYNC();
#endif
  return false;
}

__global__ void __launch_bounds__(NTHREADS) fwd_megakernel(Params P) {
  extern __shared__ __attribute__((aligned(16))) char smem[];
  cg::grid_group grid = cg::this_grid();
  unsigned* bar = WS_CTR(P) + 32;
  unsigned epoch = 0;
  grid.sync();
  phase_prologue(P, smem);
  GSYNC();
  if (layer_body<0>(P, bar, epoch, smem)) return;
  if (layer_body<1>(P, bar, epoch, smem)) return;
  phase_final_norm(P);
#ifdef SELFCHECK
  GSYNC();
  if (blockIdx.x == 0 && my_tid() == 0) {
    float scale = 1000.f;
    for (int w = 0; w < 6; ++w) {
      unsigned f = WS_CTR(P)[16 + w];
      if (f) { P.out[0] = (10.f + (float)f) * scale; break; }
      scale *= 10.f;
    }
  }
#endif
}

extern "C" void kernel_launch(void* const* d_in, const int* in_sizes, int n_in, void* d_out, int out_size, void* d_ws,
                              size_t ws_size, hipStream_t stream) {
  static int grid_blocks = 0;
  if (!grid_blocks) {
    int dev = 0, cus = 0, per_cu = 0;
    hipGetDevice(&dev);
    hipDeviceGetAttribute(&cus, hipDeviceAttributeMultiprocessorCount, dev);
    hipFuncSetAttribute((const void*)fwd_megakernel, hipFuncAttributeMaxDynamicSharedMemorySize, LDS_BYTES);
    hipOccupancyMaxActiveBlocksPerMultiprocessor(&per_cu, fwd_megakernel, NTHREADS, LDS_BYTES);
    if (per_cu < 1) per_cu = 1;
    if (per_cu > 1) per_cu = 1;
    grid_blocks = cus * per_cu;
  }
  Params P{};
  const float* const* in = reinterpret_cast<const float* const*>(d_in);
  P.x = in[0]; P.c = in[1]; P.ctx = in[2]; P.c_ctx = in[3]; P.w_mod = in[4]; P.b_mod = in[5]; P.g_mix = in[6];
  P.g_ffn = in[7]; P.w_in = in[8]; P.b_gate = in[9]; P.conv_w = in[10]; P.m_norm = in[11]; P.sink = in[12];
  P.lam_q1 = in[13]; P.lam_k1 = in[14]; P.lam_q2 = in[15]; P.lam_k2 = in[16]; P.d_norm = in[17]; P.w_branch = in[18];
  P.w_out = in[19]; P.w_ffn_in = in[20]; P.w_ffn_out = in[21]; P.g_final = in[22];
  P.out = reinterpret_cast<float*>(d_out);
  P.ws = reinterpret_cast<char*>(d_ws);
  if (WS_TOTAL > ws_size) fprintf(stderr, "workspace too small: need %zu have %zu\n", (size_t)WS_TOTAL, ws_size);
  hipMemsetAsync(P.ws + O_CTR, 0, 256, stream);
  void* args[] = {&P};
  hipError_t e = hipLaunchCooperativeKernel((const void*)fwd_megakernel, dim3(grid_blocks), dim3(NTHREADS), args, LDS_BYTES, stream);
  if (e != hipSuccess) fprintf(stderr, "cooperative launch failed: %s (grid %d)\n", hipGetErrorString(e), grid_blocks);
}
```

```cpp
#include <hip/hip_runtime.h>
#include <hip/hip_cooperative_groups.h>
#include <cstdio>
#include <cstdint>
namespace cg = cooperative_groups;

typedef unsigned short u16;
using bf16x8 = __attribute__((ext_vector_type(8))) short;
using f32x4 = __attribute__((ext_vector_type(4))) float;
using f32x16 = __attribute__((ext_vector_type(16))) float;

#define DEV __device__ __forceinline__

constexpr int D = 1024, NB = 16, T = 4096, TC = 256;
constexpr int NLAT = NB * T;
constexpr int NCTXR = NB * TC;
constexpr int MTOT = NLAT + NCTXR;
constexpr int KEYS = T + TC;
constexpr int INW = 7440;
constexpr int PW = 3712;
constexpr int C_MQ = 0, C_MK = 512, C_MV = 1024, C_MO = 1536, C_WQ = 2048, C_WK = 2560, C_DQ = 2688, C_DK = 3200;
constexpr int NIN = 4608;
constexpr int FH = 2816;
constexpr float EPS = 1e-6f;
constexpr float L2E = 1.4426950408889634f;
constexpr int NTHREADS = 512;
constexpr int LDS_BYTES = 147456;

constexpr size_t W_IN = 0;
constexpr size_t W_G = W_IN + (size_t)NIN * 1024;
constexpr size_t W_B = W_G + (size_t)3072 * 1024;
constexpr size_t W_O = W_B + (size_t)3 * 1024 * 512;
constexpr size_t W_FI = W_O + (size_t)1024 * 1024;
constexpr size_t W_FO = W_FI + (size_t)5632 * 1024;
constexpr size_t W_LAYER = W_FO + (size_t)1024 * FH;

struct Params {
  const float *x, *c, *ctx, *c_ctx, *w_mod, *b_mod, *g_mix, *g_ffn, *w_in, *b_gate, *conv_w, *m_norm, *sink;
  const float *lam_q1, *lam_k1, *lam_q2, *lam_k2, *d_norm, *w_branch, *w_out, *w_ffn_in, *w_ffn_out, *g_final;
  float* out;
  char* ws;
};


constexpr size_t al256(size_t x) { return (x + 255) & ~(size_t)255; }
constexpr size_t O_W = 0;
constexpr size_t O_MOD = O_W + al256(2 * W_LAYER * 2);
constexpr size_t O_ROPE = O_MOD + al256((size_t)2 * 17 * 6144 * 4);
constexpr size_t O_LAM = O_ROPE + al256((size_t)T * 32 * 2 * 4);
constexpr size_t O_CTR = O_LAM + 256;
constexpr size_t O_GATES = O_CTR + 2048;
constexpr size_t O_H = O_GATES + al256((size_t)MTOT * 16 * 4);
constexpr size_t O_P = O_H + al256((size_t)MTOT * 1024 * 2);
constexpr size_t O_VTW = O_P + al256((size_t)MTOT * PW * 2);
constexpr size_t O_VTD = O_VTW + al256((size_t)NB * 2 * 64 * KEYS * 2);
constexpr size_t O_HFB = O_VTD + al256((size_t)NB * 4 * 128 * KEYS * 2);
constexpr size_t O_XC = O_HFB + al256((size_t)2 * MTOT * 512 * 2);
constexpr size_t WS_TOTAL = O_XC + al256((size_t)NCTXR * 1024 * 4) + 65536;
#define WS_W(P) reinterpret_cast<u16*>((P).ws + O_W)
#define WS_MOD(P) reinterpret_cast<float*>((P).ws + O_MOD)
#define WS_ROPE(P) reinterpret_cast<float*>((P).ws + O_ROPE)
#define WS_LAM(P) reinterpret_cast<float*>((P).ws + O_LAM)
#define WS_CTR(P) reinterpret_cast<unsigned*>((P).ws + O_CTR)
#define WS_GATES(P) reinterpret_cast<float*>((P).ws + O_GATES)
#define WS_H(P) reinterpret_cast<u16*>((P).ws + O_H)
#define WS_P(P) reinterpret_cast<u16*>((P).ws + O_P)
#define WS_VTW(P) reinterpret_cast<u16*>((P).ws + O_VTW)
#define WS_VTD(P) reinterpret_cast<u16*>((P).ws + O_VTD)
#define WS_HFB(P) reinterpret_cast<u16*>((P).ws + O_HFB)
#define WS_XC(P) reinterpret_cast<float*>((P).ws + O_XC)

DEV int my_tid() {
  int t = threadIdx.x;
  asm volatile("" : "+v"(t));
  return t;
}
typedef __bf16 bf2_t __attribute__((ext_vector_type(2)));
typedef float f2_t __attribute__((ext_vector_type(2)));
DEV uint32_t pack2(float a, float b) {
  f2_t v = {a, b};
  bf2_t r = __builtin_convertvector(v, bf2_t);
  return *reinterpret_cast<uint32_t*>(&r);
}
DEV u16 f2bf(float f) { return (u16)(pack2(f, 0.f) & 0xffffu); }
DEV float bf2f(u16 h) { return __uint_as_float(((uint32_t)h) << 16); }
DEV float bflo(uint32_t v) { return __uint_as_float(v << 16); }
DEV float bfhi(uint32_t v) { return __uint_as_float(v & 0xffff0000u); }
DEV float fexp2(float x) { return __builtin_amdgcn_exp2f(x); }
DEV float sigmoidf_(float x) { return 1.f / (1.f + __expf(-x)); }
DEV float siluf_(float x) { return x / (1.f + __expf(-x)); }
DEV float wave_sum(float v) {
#pragma unroll
  for (int o = 32; o > 0; o >>= 1) v += __shfl_xor(v, o);
  return v;
}
DEV bf16x8 ld16(const void* p) { return *reinterpret_cast<const bf16x8*>(p); }
DEV bf16x8 mk8(uint32_t a, uint32_t b, uint32_t c, uint32_t d) {
  uint4 u = make_uint4(a, b, c, d);
  return *reinterpret_cast<bf16x8*>(&u);
}
DEV f32x16 mfma32(bf16x8 a, bf16x8 b, f32x16 c) { return __builtin_amdgcn_mfma_f32_32x32x16_bf16(a, b, c, 0, 0, 0); }
DEV f32x4 mfma16(bf16x8 a, bf16x8 b, f32x4 c) { return __builtin_amdgcn_mfma_f32_16x16x32_bf16(a, b, c, 0, 0, 0); }
DEV int pi32(int r) { return (r & ~12) | ((r & 4) << 1) | ((r & 8) >> 1); }


DEV void grid_barrier(unsigned* bar, unsigned& epoch) {
  asm volatile("s_waitcnt vmcnt(0)" ::: "memory");
  __syncthreads();
  epoch += 1;
  if (my_tid() == 0) {
    __builtin_amdgcn_fence(__ATOMIC_RELEASE, "agent");
    unsigned* loc = bar + 32 + (blockIdx.x & 7) * 32;
    const unsigned per = gridDim.x >> 3;
    unsigned old = __hip_atomic_fetch_add(loc, 1u, __ATOMIC_RELAXED, __HIP_MEMORY_SCOPE_AGENT);
    if (old + 1 == per * epoch) __hip_atomic_fetch_add(bar, 1u, __ATOMIC_RELAXED, __HIP_MEMORY_SCOPE_AGENT);
    while (__hip_atomic_load(bar, __ATOMIC_RELAXED, __HIP_MEMORY_SCOPE_AGENT) < 8u * epoch) __builtin_amdgcn_s_sleep(1);
    __builtin_amdgcn_fence(__ATOMIC_ACQUIRE, "agent");
  }
  __syncthreads();
}
#define GSYNC() grid_barrier(bar, epoch)
#define GSYNC_ONLY()

template <int N>
DEV void wait_vm() { asm volatile("s_waitcnt vmcnt(%0)" ::"n"(N) : "memory"); }

template <int MI, int NI>
DEV void gemm_mainloop(const u16* __restrict__ A, int lda, const u16* __restrict__ Bt, int ldb, int K,
                       f32x4 (&acc)[MI][NI], char* smem) {
  constexpr int BM = 32 * MI, BN = 64 * NI;
  constexpr int NA = BM * 4 / NTHREADS, NBL = BN * 4 / NTHREADS;
  constexpr int ABYTES = BM * 64, BBYTES = BN * 64, SBYTES = ABYTES + BBYTES;
  constexpr int NL = NA + NBL;
  const int tid = my_tid(), lane = tid & 63, wid = tid >> 6, wr = wid >> 2, wc = wid & 3, fr = lane & 15, fq = lane >> 4;
  const int nk = K / 32;
  auto stage = [&](int kt) {
    char* base = smem + (kt & 3) * SBYTES;
#pragma unroll
    for (int i = 0; i < NA; ++i) {
      int id = tid + i * NTHREADS, r = id >> 2, c = (id & 3) ^ (((r >> 3) & 1) * 3);
      __builtin_amdgcn_global_load_lds((const unsigned*)(A + (size_t)r * lda + kt * 32 + c * 8), (unsigned*)(base + id * 16), 16, 0, 0);
    }
#pragma unroll
    for (int i = 0; i < NBL; ++i) {
      int id = tid + i * NTHREADS, r = id >> 2, c = (id & 3) ^ (((r >> 3) & 1) * 3);
      __builtin_amdgcn_global_load_lds((const unsigned*)(Bt + (size_t)r * ldb + kt * 32 + c * 8), (unsigned*)(base + ABYTES + id * 16), 16, 0, 0);
    }
  };
  wait_vm<0>();
  __syncthreads();
  stage(0);
  if (nk > 1) stage(1);
  if (nk > 2) stage(2);
  for (int kt = 0; kt < nk; ++kt) {
    if (kt + 2 < nk) wait_vm<2 * NL>();
    else if (kt + 1 < nk) wait_vm<NL>();
    else wait_vm<0>();
    asm volatile("" ::: "memory");
    __builtin_amdgcn_s_barrier();
    asm volatile("" ::: "memory");
    const char* As = smem + (kt & 3) * SBYTES;
    const char* Bs = As + ABYTES;
    bf16x8 bfr[NI], af[MI];
#pragma unroll
    for (int ni = 0; ni < NI; ++ni) {
      int r = wc * (NI * 16) + ni * 16 + fr;
      bfr[ni] = ld16(Bs + r * 64 + ((fq ^ (((r >> 3) & 1) * 3)) << 4));
    }
#pragma unroll
    for (int mi = 0; mi < MI; ++mi) {
      int r = wr * (MI * 16) + mi * 16 + fr;
      af[mi] = ld16(As + r * 64 + ((fq ^ (((r >> 3) & 1) * 3)) << 4));
    }
    if (kt + 3 < nk) stage(kt + 3);
    __builtin_amdgcn_sched_barrier(0);
    __builtin_amdgcn_s_setprio(1);
#pragma unroll
    for (int mi = 0; mi < MI; ++mi)
#pragma unroll
      for (int ni = 0; ni < NI; ++ni) acc[mi][ni] = mfma16(af[mi], bfr[ni], acc[mi][ni]);
    __builtin_amdgcn_s_setprio(0);
    __builtin_amdgcn_sched_barrier(0);
  }
}

template <int MI, int NI>
DEV void zero_acc(f32x4 (&acc)[MI][NI]) {
#pragma unroll
  for (int mi = 0; mi < MI; ++mi)
#pragma unroll
    for (int ni = 0; ni < NI; ++ni) acc[mi][ni] = f32x4{0.f, 0.f, 0.f, 0.f};
}


DEV void tile_coords(int tile, int total, int nN, int& tm, int& tn) {
  int t = tile;
  if (gridDim.x == 256 && tile < (total & ~255)) {
    int j = tile & 255;
    t = (tile & ~255) + (j & 7) * 32 + (j >> 3);
  }
  int p = t / (4 * nN), q = t - p * (4 * nN);
  tn = q >> 2;
  tm = p * 4 + (q & 3);
}

template <int MI, class Epi>
DEV void gemm_phase(const u16* A, int lda, const u16* Bt, int ldb, int M, int N, int K, Epi epi, char* smem) {
  constexpr int BM = 32 * MI;
  const int nM = M / BM, nN = N / 256;
  const int wid = my_tid() >> 6, wr = wid >> 2, wc = wid & 3;
  for (int tile = blockIdx.x; tile < nM * nN; tile += gridDim.x) {
    int tm, tn;
    tile_coords(tile, nM * nN, nN, tm, tn);
    f32x4 acc[MI][4];
    zero_acc<MI, 4>(acc);
    gemm_mainloop<MI, 4>(A + (size_t)tm * BM * lda, lda, Bt + (size_t)tn * 256 * ldb, ldb, K, acc, smem);
    epi(acc, tm * BM + wr * (MI * 16), tn * 256 + wc * 64);
  }
}

DEV int map_col(int type, int n) {
  if (type == 0) {
    if (n < 2048) return n;
    if (n < 2688) return n + 16;
    if (n < 3712) return n + 144;
    if (n < 3840) return n - 1008;
    if (n < 4352) return n + 16;
    if (n < 4368) return n - 2304;
    return -1;
  }
  if (type == 1) return n + 4368;
  if (type == 2) return n;
  int q = n >> 5, r = n & 31;
  return r < 16 ? (q * 16 + r) : (FH + q * 16 + r - 16);
}

DEV void tr_tile(const float* __restrict__ src, int ldsrc, u16* __restrict__ dst, int K, int n0, int k0, int type, char* smem) {
  float* tile = reinterpret_cast<float*>(smem);
  const int tid = my_tid();
  {
    int n = tid & 63, sc = map_col(type, n0 + n);
#pragma unroll
    for (int i = 0; i < 8; ++i) {
      int k = (tid >> 6) + 8 * i;
      tile[k * 65 + n] = sc >= 0 ? src[(size_t)(k0 + k) * ldsrc + sc] : 0.f;
    }
  }
  __syncthreads();
  {
    int n = tid >> 3, kc = tid & 7;
    uint32_t w[4];
#pragma unroll
    for (int j = 0; j < 4; ++j) w[j] = pack2(tile[(kc * 8 + 2 * j) * 65 + n], tile[(kc * 8 + 2 * j + 1) * 65 + n]);
    *reinterpret_cast<uint4*>(dst + (size_t)(n0 + n) * K + k0 + kc * 8) = make_uint4(w[0], w[1], w[2], w[3]);
  }
  __syncthreads();
}

DEV void phase_prologue(const Params& P, char* smem) {
  const int tid = my_tid();
  constexpr int TPL = 4672;
  for (int it = blockIdx.x; it < 2 * TPL; it += gridDim.x) {
    int l = it / TPL, t = it % TPL;
    u16* Wl = WS_W(P) + (size_t)l * W_LAYER;
    if (t < 1152) {
      tr_tile(P.w_in + (size_t)l * 1024 * INW, INW, Wl + W_IN, 1024, (t / 16) * 64, (t % 16) * 64, 0, smem);
    } else if (t < 1920) {
      t -= 1152;
      tr_tile(P.w_in + (size_t)l * 1024 * INW, INW, Wl + W_G, 1024, (t / 16) * 64, (t % 16) * 64, 1, smem);
    } else if (t < 2304) {
      t -= 1920;
      int i = t / 128;
      t %= 128;
      tr_tile(P.w_branch + ((size_t)l * 3 + i) * 512 * 1024, 1024, Wl + W_B + (size_t)i * 1024 * 512, 512, (t / 8) * 64, (t % 8) * 64, 2, smem);
    } else if (t < 2560) {
      t -= 2304;
      tr_tile(P.w_out + (size_t)l * 1024 * 1024, 1024, Wl + W_O, 1024, (t / 16) * 64, (t % 16) * 64, 2, smem);
    } else if (t < 3968) {
      t -= 2560;
      tr_tile(P.w_ffn_in + (size_t)l * 1024 * 5632, 5632, Wl + W_FI, 1024, (t / 16) * 64, (t % 16) * 64, 3, smem);
    } else {
      t -= 3968;
      tr_tile(P.w_ffn_out + (size_t)l * FH * 1024, 1024, Wl + W_FO, FH, (t / 44) * 64, (t % 44) * 64, 2, smem);
    }
  }
  for (int it = blockIdx.x; it < 384; it += gridDim.x) {
    int l = it / 192, n0 = (it % 192) * 32;
    float* sc = reinterpret_cast<float*>(smem);
    float* red = sc + 17 * 1024;
    __syncthreads();
    for (int idx = tid; idx < 17 * 1024; idx += NTHREADS) {
      int cond = idx >> 10, k = idx & 1023;
      float cv = cond < 16 ? P.c[cond * 1024 + k] : P.c_ctx[k];
      sc[idx] = siluf_(cv);
    }
    __syncthreads();
    int col = tid & 31, ks = tid >> 5;
    float acc[17];
#pragma unroll
    for (int j = 0; j < 17; ++j) acc[j] = 0.f;
    const float* wm = P.w_mod + (size_t)l * 1024 * 6144 + n0 + col;
    for (int k = ks * 64; k < ks * 64 + 64; ++k) {
      float w = wm[(size_t)k * 6144];
#pragma unroll
      for (int j = 0; j < 17; ++j) acc[j] += sc[j * 1024 + k] * w;
    }
#pragma unroll
    for (int j = 0; j < 17; ++j) red[(ks * 17 + j) * 32 + col] = acc[j];
    __syncthreads();
    for (int o = tid; o < 17 * 32; o += NTHREADS) {
      int j = o >> 5, cc = o & 31;
      float s = 0.f;
      for (int q = 0; q < 16; ++q) s += red[(q * 17 + j) * 32 + cc];
      WS_MOD(P)[((size_t)l * 17 + j) * 6144 + n0 + cc] = s + P.b_mod[l * 6144 + n0 + cc];
    }
  }
  for (int idx = blockIdx.x * NTHREADS + tid; idx < T * 32; idx += gridDim.x * NTHREADS) {
    int t = idx >> 5, j = idx & 31;
    int pos = j < 16 ? (t >> 6) : (t & 63);
    float inv = powf(10000.f, -(float)(j & 15) / 16.f);
    float ang = (float)pos * inv;
    WS_ROPE(P)[idx * 2] = cosf(ang);
    WS_ROPE(P)[idx * 2 + 1] = sinf(ang);
  }
  for (int idx = blockIdx.x * NTHREADS + tid; idx < NCTXR * 1024 / 4; idx += gridDim.x * NTHREADS)
    reinterpret_cast<float4*>(WS_XC(P))[idx] = reinterpret_cast<const float4*>(P.ctx)[idx];
  if (blockIdx.x == 0 && tid < 64) {
    for (int l = 0; l < 2; ++l) {
      float a = wave_sum(P.lam_q1[l * 64 + tid] * P.lam_k1[l * 64 + tid]);
      float b = wave_sum(P.lam_q2[l * 64 + tid] * P.lam_k2[l * 64 + tid]);
      float lam_init = 0.8f - 0.6f * expf(-0.3f * (float)l);
      if (tid == 0) WS_LAM(P)[l] = expf(a) - expf(b) + lam_init;
    }
    if (tid < 8) WS_CTR(P)[tid] = 0u;
  }
}

DEV void phase_norm_mod(const Params& P, const float* xlat, const float* xctx, int nrows, const float* g,
                        const float* modl, int sh_off, int sc_off) {
  const int lane = my_tid() & 63, wid = my_tid() >> 6;
  for (int row = blockIdx.x * 8 + wid; row < nrows; row += gridDim.x * 8) {
    const float* src = row < NLAT ? xlat + (size_t)row * 1024 : xctx + (size_t)(row - NLAT) * 1024;
    int cond = row < NLAT ? row >> 12 : 16;
    const float* md = modl + (size_t)cond * 6144;
    float4 v[4];
    float ss = 0.f;
#pragma unroll
    for (int i = 0; i < 4; ++i) {
      v[i] = *reinterpret_cast<const float4*>(src + i * 256 + lane * 4);
      ss += v[i].x * v[i].x + v[i].y * v[i].y + v[i].z * v[i].z + v[i].w * v[i].w;
    }
    ss = wave_sum(ss);
    float rstd = rsqrtf(ss * (1.f / 1024.f) + EPS);
#pragma unroll
    for (int i = 0; i < 4; ++i) {
      int cb = i * 256 + lane * 4;
      float4 gg = *reinterpret_cast<const float4*>(g + cb);
      float4 sh = *reinterpret_cast<const float4*>(md + sh_off + cb);
      float4 sc = *reinterpret_cast<const float4*>(md + sc_off + cb);
      float y0 = v[i].x * rstd * gg.x * (1.f + sc.x) + sh.x;
      float y1 = v[i].y * rstd * gg.y * (1.f + sc.y) + sh.y;
      float y2 = v[i].z * rstd * gg.z * (1.f + sc.z) + sh.z;
      float y3 = v[i].w * rstd * gg.w * (1.f + sc.w) + sh.w;
      *reinterpret_cast<uint2*>(WS_H(P) + (size_t)row * 1024 + cb) = make_uint2(pack2(y0, y1), pack2(y2, y3));
    }
  }
}

DEV void phase_final_norm(const Params& P) {
  const int lane = my_tid() & 63, wid = my_tid() >> 6;
  for (int row = blockIdx.x * 8 + wid; row < NLAT; row += gridDim.x * 8) {
    float* src = P.out + (size_t)row * 1024;
    float4 v[4];
    float ss = 0.f;
#pragma unroll
    for (int i = 0; i < 4; ++i) {
      v[i] = *reinterpret_cast<const float4*>(src + i * 256 + lane * 4);
      ss += v[i].x * v[i].x + v[i].y * v[i].y + v[i].z * v[i].z + v[i].w * v[i].w;
    }
    ss = wave_sum(ss);
    float rstd = rsqrtf(ss * (1.f / 1024.f) + EPS);
#pragma unroll
    for (int i = 0; i < 4; ++i) {
      int cb = i * 256 + lane * 4;
      float4 gg = *reinterpret_cast<const float4*>(P.g_final + cb);
      float4 o = make_float4(v[i].x * rstd * gg.x, v[i].y * rstd * gg.y, v[i].z * rstd * gg.z, v[i].w * rstd * gg.w);
      *reinterpret_cast<float4*>(src + cb) = o;
    }
  }
}

struct EpiInProj {
  const Params& P;
  int l;
  DEV void operator()(f32x4 (&acc)[8][4], int row0, int col0) const {
    const int lane = my_tid() & 63, fr = lane & 15, fq = lane >> 4;
    if (col0 >= 4416) return;
    if (col0 < C_WQ) {
#pragma unroll
      for (int mi = 0; mi < 8; ++mi)
#pragma unroll
        for (int ni = 0; ni < 4; ++ni)
#pragma unroll
          for (int j = 0; j < 4; ++j)
            WS_P(P)[(size_t)(row0 + mi * 16 + fq * 4 + j) * PW + col0 + ni * 16 + fr] = f2bf(acc[mi][ni][j]);
    } else if (col0 < 3712) {
      const bool isq = (col0 < C_WK) || (col0 >= C_DQ && col0 < C_DK);
      const float qs = isq ? 0.125f : 1.f;
#pragma unroll
      for (int mi = 0; mi < 8; ++mi)
#pragma unroll
        for (int j = 0; j < 4; ++j) {
          int row = row0 + mi * 16 + fq * 4 + j;
          u16* dst = WS_P(P) + (size_t)row * PW + col0 + fr;
          if (row < NLAT) {
            int t = row & (T - 1);
            const float2* rt = reinterpret_cast<const float2*>(WS_ROPE(P)) + t * 32;
#pragma unroll
            for (int hf = 0; hf < 2; ++hf) {
              float2 cs = rt[hf * 16 + fr];
              float x1 = acc[mi][hf * 2][j], x2 = acc[mi][hf * 2 + 1][j];
              dst[hf * 32] = f2bf((x1 * cs.x - x2 * cs.y) * qs);
              dst[hf * 32 + 16] = f2bf((x2 * cs.x + x1 * cs.y) * qs);
            }
          } else {
#pragma unroll
            for (int ni = 0; ni < 4; ++ni) dst[ni * 16] = f2bf(acc[mi][ni][j] * qs);
          }
        }
    } else if (col0 < 4352) {
      u16* base;
      int vrow0;
      const int hdW = (col0 - 3712) >> 6;
      const int hdD = (col0 - 3840) >> 7;
      const bool isw = col0 < 3840;
#pragma unroll
      for (int mi = 0; mi < 8; ++mi) {
        int row = row0 + mi * 16 + fq * 4;
        int b, key;
        if (row < NLAT) { b = row >> 12; key = 256 + (row & (T - 1)); }
        else { b = (row - NLAT) >> 8; key = (row - NLAT) & 255; }
        if (isw) { base = WS_VTW(P) + ((size_t)(b * 2 + hdW) * 64) * KEYS; vrow0 = 0; }
        else { base = WS_VTD(P) + ((size_t)(b * 4 + hdD) * 128) * KEYS; vrow0 = (col0 - 3840) & 127; }
#pragma unroll
        for (int ni = 0; ni < 4; ++ni) {
          int v = vrow0 + ni * 16 + fr;
          *reinterpret_cast<uint2*>(base + (size_t)v * KEYS + key) =
              make_uint2(pack2(acc[mi][ni][0], acc[mi][ni][1]), pack2(acc[mi][ni][2], acc[mi][ni][3]));
        }
      }
    } else {
      float bg = P.b_gate[l * 16 + fr];
#pragma unroll
      for (int mi = 0; mi < 8; ++mi)
#pragma unroll
        for (int j = 0; j < 4; ++j) WS_GATES(P)[(size_t)(row0 + mi * 16 + fq * 4 + j) * 16 + fr] = acc[mi][0][j] + bg;
    }
  }
};

template <int QB, int VB, int KW>
struct AttnCore {
  static constexpr int DV = 32 * VB;
  static constexpr int KST = KW * 2 + 16;
  static constexpr int VST = 128 + 16;
  static constexpr int KBYTES = 64 * KST, VBYTES = DV * VST;
  static constexpr int NKL = 64 * (KW / 8) / NTHREADS, NVL = DV * 8 / NTHREADS;
  static constexpr int TOTAL = 2 * (KBYTES + VBYTES);

  static DEV void run(const u16* qptr, int ldq, const u16* kctx, const u16* klat, int ldk, int kcol, const u16* vt,
                      int nctx, int nlat, int lat_t0, bool window, int qtok0, float m_init, float l_init,
                      f32x16 (&O)[QB][VB], char* smem) {
    const int tid = my_tid(), lane = tid & 63, r = lane & 31, hh = lane >> 5;
    char* Ks = smem;
    char* Vs = smem + 2 * KBYTES;
    bf16x8 qf[QB][4];
#pragma unroll
    for (int qb = 0; qb < QB; ++qb)
#pragma unroll
      for (int ks = 0; ks < 4; ++ks) qf[qb][ks] = ld16(qptr + (size_t)(qb * 32 + r) * ldq + ks * 16 + hh * 8);
    float m[QB], lsum[QB];
#pragma unroll
    for (int qb = 0; qb < QB; ++qb) {
      m[qb] = m_init;
      lsum[qb] = hh == 0 ? l_init : 0.f;
#pragma unroll
      for (int vb = 0; vb < VB; ++vb)
#pragma unroll
        for (int i = 0; i < 16; ++i) O[qb][vb][i] = 0.f;
    }
    bf16x8 rk[NKL], rv[NVL];
    const int ntiles = nctx + nlat;
    auto gload = [&](int j) {
      int kidx = j < nctx ? j * 64 : 256 + lat_t0 + (j - nctx) * 64;
      const u16* krow = j < nctx ? kctx + (size_t)(j * 64) * ldk : klat + (size_t)(lat_t0 + (j - nctx) * 64) * ldk;
#pragma unroll
      for (int i = 0; i < NKL; ++i) {
        int id = tid + i * NTHREADS, row = id / (KW / 8), c = id % (KW / 8);
        rk[i] = ld16(krow + (size_t)row * ldk + c * 8);
      }
#pragma unroll
      for (int i = 0; i < NVL; ++i) {
        int id = tid + i * NTHREADS, row = id >> 3, c = id & 7;
        rv[i] = ld16(vt + (size_t)row * KEYS + kidx + c * 8);
      }
    };
    auto lstore = [&](int buf) {
#pragma unroll
      for (int i = 0; i < NKL; ++i) {
        int id = tid + i * NTHREADS, row = id / (KW / 8), c = id % (KW / 8);
        *reinterpret_cast<bf16x8*>(Ks + buf * KBYTES + row * KST + c * 16) = rk[i];
      }
#pragma unroll
      for (int i = 0; i < NVL; ++i) {
        int id = tid + i * NTHREADS, row = id >> 3, c = id & 7;
        *reinterpret_cast<bf16x8*>(Vs + buf * VBYTES + row * VST + c * 16) = rv[i];
      }
    };
    __syncthreads();
    gload(0);
    lstore(0);
    __syncthreads();
    for (int j = 0; j < ntiles; ++j) {
      const int buf = j & 1;
      if (j + 1 < ntiles) gload(j + 1);
      bf16x8 pf[QB][2][2];
#pragma unroll
      for (int qb = 0; qb < QB; ++qb) {
        f32x16 S[2];
#pragma unroll
        for (int kb = 0; kb < 2; ++kb) {
#pragma unroll
          for (int i = 0; i < 16; ++i) S[kb][i] = 0.f;
#pragma unroll
          for (int ks = 0; ks < 4; ++ks) {
            bf16x8 kf = ld16(Ks + buf * KBYTES + (kb * 32 + pi32(r)) * KST + (kcol + ks * 16 + hh * 8) * 2);
            S[kb] = mfma32(kf, qf[qb][ks], S[kb]);
          }
        }
        __builtin_amdgcn_sched_barrier(0);
        if (window && j >= nctx) {
          int kt0 = lat_t0 + (j - nctx) * 64;
          int qt = qtok0 + qb * 32 + r;
#pragma unroll
          for (int kb = 0; kb < 2; ++kb)
#pragma unroll
            for (int i = 0; i < 16; ++i) {
              int kt = kt0 + kb * 32 + 16 * (i >> 3) + 8 * hh + (i & 7);
              int dlt = qt - kt;
              if (dlt > 128 || dlt < -128) S[kb][i] = -1e30f;
            }
        }
        float mloc = -1e30f;
#pragma unroll
        for (int kb = 0; kb < 2; ++kb)
#pragma unroll
          for (int i = 0; i < 16; ++i) mloc = fmaxf(mloc, S[kb][i]);
        mloc = fmaxf(mloc, __shfl_xor(mloc, 32));
        if (__any(mloc > m[qb] + 5.5f)) {
          float mnew = fmaxf(m[qb], mloc);
          float alpha = fexp2((m[qb] - mnew) * L2E);
          m[qb] = mnew;
          lsum[qb] *= alpha;
#pragma unroll
          for (int vb = 0; vb < VB; ++vb)
#pragma unroll
            for (int i = 0; i < 16; ++i) O[qb][vb][i] *= alpha;
        }
        float mb = m[qb] * L2E, ps = 0.f;
#pragma unroll
        for (int kb = 0; kb < 2; ++kb) {
          float pv[16];
#pragma unroll
          for (int i = 0; i < 16; ++i) {
            pv[i] = fexp2(S[kb][i] * L2E - mb);
            ps += pv[i];
          }
#pragma unroll
          for (int s = 0; s < 2; ++s)
            pf[qb][kb][s] = mk8(pack2(pv[8 * s], pv[8 * s + 1]), pack2(pv[8 * s + 2], pv[8 * s + 3]),
                                pack2(pv[8 * s + 4], pv[8 * s + 5]), pack2(pv[8 * s + 6], pv[8 * s + 7]));
        }
        lsum[qb] += ps;
        __builtin_amdgcn_sched_barrier(0);
      }
      __builtin_amdgcn_sched_barrier(0);
#pragma unroll
      for (int vb = 0; vb < VB; ++vb) {
#pragma unroll
        for (int kb = 0; kb < 2; ++kb)
#pragma unroll
          for (int s = 0; s < 2; ++s) {
            bf16x8 vf = ld16(Vs + buf * VBYTES + (vb * 32 + r) * VST + (kb * 32 + s * 16 + hh * 8) * 2);
#pragma unroll
            for (int qb = 0; qb < QB; ++qb) O[qb][vb] = mfma32(vf, pf[qb][kb][s], O[qb][vb]);
          }
        __builtin_amdgcn_sched_barrier(0);
      }
      if (j + 1 < ntiles) lstore(buf ^ 1);
      __syncthreads();
    }
#pragma unroll
    for (int qb = 0; qb < QB; ++qb) {
      float lt = lsum[qb] + __shfl_xor(lsum[qb], 32);
      float inv = 1.f / lt;
#pragma unroll
      for (int vb = 0; vb < VB; ++vb)
#pragma unroll
        for (int i = 0; i < 16; ++i) O[qb][vb][i] *= inv;
    }
  }
};

DEV void diff_item(const Params& P, int l, int b, int h, int qt, bool ctxq, char* smem) {
  const int tid = my_tid(), lane = tid & 63, wid = tid >> 6, r = lane & 31, hh = lane >> 5;
  const int comp = wid >> 2, wq = wid & 3;
  const int rowbase = ctxq ? NLAT + b * 256 + qt * 128 : b * T + qt * 128;
  const u16* qptr = WS_P(P) + (size_t)(rowbase + wq * 32) * PW + C_DQ + h * 128 + comp * 64;
  const u16* kctx = WS_P(P) + (size_t)(NLAT + b * 256) * PW + C_DK + h * 128;
  const u16* klat = WS_P(P) + (size_t)(b * T) * PW + C_DK + h * 128;
  const u16* vt = WS_VTD(P) + ((size_t)(b * 4 + h) * 128) * KEYS;
  f32x16 O[1][4];
  AttnCore<1, 4, 128>::run(qptr, PW, kctx, klat, PW, comp * 64, vt, 4, ctxq ? 0 : 64, 0, false, 0, -1e30f, 0.f, O, smem);
  float* ex = reinterpret_cast<float*>(smem);
  __syncthreads();
  if (comp == 1) {
#pragma unroll
    for (int vb = 0; vb < 4; ++vb)
#pragma unroll
      for (int i = 0; i < 16; ++i) ex[(wq * 64 + vb * 16 + i) * 64 + lane] = O[0][vb][i];
  }
  __syncthreads();
  if (comp == 0) {
    const float lam = WS_LAM(P)[l];
    const float lam_init = 0.8f - 0.6f * expf(-0.3f * (float)l);
    float ss = 0.f;
#pragma unroll
    for (int vb = 0; vb < 4; ++vb)
#pragma unroll
      for (int i = 0; i < 16; ++i) {
        float y = O[0][vb][i] - lam * ex[(wq * 64 + vb * 16 + i) * 64 + lane];
        O[0][vb][i] = y;
        ss += y * y;
      }
    ss += __shfl_xor(ss, 32);
    float sc = rsqrtf(ss * (1.f / 128.f) + EPS) * (1.f - lam_init);
    const float* dn = P.d_norm + l * 512 + h * 128;
    u16* dst = WS_P(P) + (size_t)(rowbase + wq * 32 + r) * PW + C_DQ + h * 128;
#pragma unroll
    for (int vb = 0; vb < 4; ++vb)
#pragma unroll
      for (int g4 = 0; g4 < 4; ++g4) {
        int v = vb * 32 + g4 * 8 + hh * 4;
        float4 w = *reinterpret_cast<const float4*>(dn + v);
        *reinterpret_cast<uint2*>(dst + v) =
            make_uint2(pack2(O[0][vb][g4 * 4] * sc * w.x, O[0][vb][g4 * 4 + 1] * sc * w.y),
                       pack2(O[0][vb][g4 * 4 + 2] * sc * w.z, O[0][vb][g4 * 4 + 3] * sc * w.w));
      }
  }
  __syncthreads();
}

DEV void win_item(const Params& P, int l, int b, int g, int qb, bool ctxq, char* smem) {
  const int tid = my_tid(), lane = tid & 63, wid = tid >> 6, r = lane & 31, hh = lane >> 5;
  const int hr = wid >> 1, qh = wid & 1;
  const int head = g * 4 + hr;
  const int rowbase = (ctxq ? NLAT + b * 256 + qb * 64 : b * T + qb * 64) + qh * 32;
  const u16* qptr = WS_P(P) + (size_t)rowbase * PW + C_WQ + head * 64;
  const u16* kctx = WS_P(P) + (size_t)(NLAT + b * 256) * PW + C_WK + g * 64;
  const u16* klat = WS_P(P) + (size_t)(b * T) * PW + C_WK + g * 64;
  const u16* vt = WS_VTW(P) + ((size_t)(b * 2 + g) * 64) * KEYS;
  int t0 = 0, nlat = 0;
  if (!ctxq) {
    t0 = qb * 64 - 128;
    if (t0 < 0) t0 = 0;
    int t1 = qb * 64 + 192;
    if (t1 > T) t1 = T;
    nlat = (t1 - t0) >> 6;
  }
  f32x16 O[1][2];
  AttnCore<1, 2, 64>::run(qptr, PW, kctx, klat, PW, 0, vt, 4, nlat, t0, !ctxq, qb * 64 + qh * 32, P.sink[l * 8 + head], 1.f, O, smem);
  u16* dst = WS_P(P) + (size_t)(rowbase + r) * PW + C_WQ + head * 64;
#pragma unroll
  for (int vb = 0; vb < 2; ++vb)
#pragma unroll
    for (int g4 = 0; g4 < 4; ++g4) {
      int v = vb * 32 + g4 * 8 + hh * 4;
      *reinterpret_cast<uint2*>(dst + v) = make_uint2(pack2(O[0][vb][g4 * 4], O[0][vb][g4 * 4 + 1]),
                                                        pack2(O[0][vb][g4 * 4 + 2], O[0][vb][g4 * 4 + 3]));
    }
}

DEV void mlstm_item(const Params& P, int l, int b, int hd, int dir, bool need_ctx, char* smem) {
  const int tid = my_tid(), lane = tid & 63, wid = tid >> 6, r = lane & 31, hh = lane >> 5;
  constexpr int QST = 272, TST = 144;
  char* Qs = smem;
  char* Ks = Qs + 64 * QST;
  char* KwT = Ks + 64 * QST;
  char* VT = KwT + 128 * TST;
  char* Sp = VT + 128 * TST;
  char* Rq = Sp + 64 * TST;
  char* Rk = Rq + 66 * QST;
  float* fb = reinterpret_cast<float*>(Rk + 66 * QST);
  float* sb = fb;
  float* sa = fb + 64;
  float* sM = fb + 128;
  float* denp = fb + 192;
  float* qn = fb + 320;
  float* nb = fb + 384;
  float* cw = fb + 640;
  __syncthreads();
  if (tid < 256) nb[tid] = 0.f;
  for (int i = tid; i < 768; i += NTHREADS) {
    int qk = i / 384, tap = (i % 384) / 128, d = i & 127;
    cw[i] = P.conv_w[(size_t)l * 3 * 1024 + tap * 1024 + qk * 512 + hd * 128 + d];
  }
  f32x16 CT[4];
#pragma unroll
  for (int kb = 0; kb < 4; ++kb)
#pragma unroll
    for (int i = 0; i < 16; ++i) CT[kb][i] = 0.f;
  float mstate = 0.f;
  u16* hout = WS_HFB(P) + (size_t)dir * MTOT * 512;
  const float kscale = 0.08838834764831845f;

  for (int step = 0; step < 68; ++step) {
    int seg0, seglen, c;
    if (step < 4) { seg0 = NLAT + b * 256; seglen = 256; c = dir ? 3 - step : step; }
    else { seg0 = b * T; seglen = T; c = dir ? 67 - step : step - 4; }
    const int u0 = c * 64;
    const int rowbase = seg0 + u0;
    const int cur = step & 1;
    __syncthreads();
    bf16x8 rvv[2];
#pragma unroll
    for (int i = 0; i < 3; ++i) {
      int id = tid + i * NTHREADS;
      if (id < 66 * 16) {
        int row = id >> 4, cc = id & 15;
        int uu = u0 + row - 1;
        bool ok = uu >= 0 && uu < seglen;
        const u16* src = WS_P(P) + (size_t)(seg0 + (ok ? uu : 0)) * PW + hd * 128 + cc * 8;
        bf16x8 z = {0, 0, 0, 0, 0, 0, 0, 0};
        bf16x8 a = ok ? ld16(src + C_MQ) : z;
        bf16x8 bq = ok ? ld16(src + C_MK) : z;
        *reinterpret_cast<bf16x8*>(Rq + row * QST + cc * 16) = a;
        *reinterpret_cast<bf16x8*>(Rk + row * QST + cc * 16) = bq;
      }
    }
#pragma unroll
    for (int i = 0; i < 2; ++i) {
      int id = tid + i * NTHREADS, u = id >> 4, cc = id & 15;
      rvv[i] = ld16(WS_P(P) + (size_t)(rowbase + u) * PW + C_MV + hd * 128 + cc * 8);
    }
    if (wid == 0) {
      const int pos = dir ? 63 - lane : lane;
      const float* gp = WS_GATES(P) + (size_t)(rowbase + pos) * 16;
      float ig = gp[(dir * 2) * 4 + hd], fg = gp[(dir * 2 + 1) * 4 + hd];
      float lf = fminf(fg, 0.f) - log1pf(__expf(-fabsf(fg)));
      float bsum = lf;
#pragma unroll
      for (int o = 1; o < 64; o <<= 1) { float t2 = __shfl_up(bsum, o); if (lane >= o) bsum += t2; }
      float a = ig - bsum, am = a;
#pragma unroll
      for (int o = 1; o < 64; o <<= 1) { float t2 = __shfl_up(am, o); if (lane >= o) am = fmaxf(am, t2); }
      sb[pos] = bsum;
      sa[pos] = a;
      sM[pos] = fmaxf(mstate, am);
    }
    __syncthreads();
    const int eidx = dir ? 0 : 63;
    const float Mend = sM[eidx], bend = sb[eidx];
    const float decay = __expf(mstate - Mend);
#pragma unroll 1
    for (int i = 0; i < 2; ++i) {
      int id = tid + i * NTHREADS, u = id >> 4, cc = id & 15;
      float wend = __expf(sa[u] - Mend);
      uint32_t qo[4], ko[4];
      float kv[8];
      bf16x8 q0 = ld16(Rq + (u)*QST + cc * 16), q1 = ld16(Rq + (u + 1) * QST + cc * 16), q2 = ld16(Rq + (u + 2) * QST + cc * 16);
      bf16x8 k0 = ld16(Rk + (u)*QST + cc * 16), k1 = ld16(Rk + (u + 1) * QST + cc * 16), k2 = ld16(Rk + (u + 2) * QST + cc * 16);
#pragma unroll
      for (int e = 0; e < 8; ++e) {
        int d = cc * 8 + e;
        float xq = cw[0 * 128 + d] * bf2f((u16)q0[e]) + cw[1 * 128 + d] * bf2f((u16)q1[e]) + cw[2 * 128 + d] * bf2f((u16)q2[e]);
        float xk = cw[384 + 0 * 128 + d] * bf2f((u16)k0[e]) + cw[384 + 1 * 128 + d] * bf2f((u16)k1[e]) + cw[384 + 2 * 128 + d] * bf2f((u16)k2[e]);
        float qv = siluf_(xq);
        kv[e] = siluf_(xk) * kscale;
        if (e & 1) { qo[e >> 1] |= ((uint32_t)f2bf(qv)) << 16; ko[e >> 1] |= ((uint32_t)f2bf(kv[e])) << 16; }
        else { qo[e >> 1] = f2bf(qv); ko[e >> 1] = f2bf(kv[e]); }
        *reinterpret_cast<u16*>(KwT + (d)*TST + u * 2) = f2bf(kv[e] * wend);
        *reinterpret_cast<u16*>(VT + (d)*TST + u * 2) = (u16)rvv[i][e];
      }
      *reinterpret_cast<uint4*>(Qs + u * QST + cc * 16) = make_uint4(qo[0], qo[1], qo[2], qo[3]);
      *reinterpret_cast<uint4*>(Ks + u * QST + cc * 16) = make_uint4(ko[0], ko[1], ko[2], ko[3]);
    }
    __syncthreads();
    if (wid < 4) {
      const int sblk = wid & 1, tblk = wid >> 1;
      f32x16 S;
#pragma unroll
      for (int i = 0; i < 16; ++i) S[i] = 0.f;
#pragma unroll
      for (int ks = 0; ks < 8; ++ks) {
        bf16x8 kf = ld16(Ks + (sblk * 32 + pi32(r)) * QST + (ks * 16 + hh * 8) * 2);
        bf16x8 qf = ld16(Qs + (tblk * 32 + r) * QST + (ks * 16 + hh * 8) * 2);
        S = mfma32(kf, qf, S);
      }
      const int t = tblk * 32 + r;
      const float Mt = sM[t];
      float ds = 0.f, val[16];
#pragma unroll
      for (int i = 0; i < 16; ++i) {
        int s = sblk * 32 + 16 * (i >> 3) + 8 * hh + (i & 7);
        bool ok = dir ? (s >= t) : (s <= t);
        val[i] = ok ? S[i] * __expf(sa[s] - Mt) : 0.f;
        ds += val[i];
      }
      ds += __shfl_xor(ds, 32);
      if (hh == 0) denp[sblk * 64 + t] = ds;
#pragma unroll
      for (int s2 = 0; s2 < 2; ++s2)
        *reinterpret_cast<uint4*>(Sp + t * TST + (sblk * 32 + s2 * 16 + hh * 8) * 2) =
            make_uint4(pack2(val[8 * s2], val[8 * s2 + 1]), pack2(val[8 * s2 + 2], val[8 * s2 + 3]),
                       pack2(val[8 * s2 + 4], val[8 * s2 + 5]), pack2(val[8 * s2 + 6], val[8 * s2 + 7]));
    } else if (wid == 4) {
      float s = 0.f;
      const float* nc = nb + cur * 128;
      for (int k8 = 0; k8 < 16; ++k8) {
        bf16x8 qv = ld16(Qs + lane * QST + k8 * 16);
#pragma unroll
        for (int e = 0; e < 8; ++e) s += nc[k8 * 8 + e] * bf2f((u16)qv[e]);
      }
      qn[lane] = s;
    } else if (wid == 5) {
      const float* nc = nb + cur * 128;
      float* nn = nb + (cur ^ 1) * 128;
#pragma unroll
      for (int q2 = 0; q2 < 2; ++q2) {
        int k = lane + q2 * 64;
        float s = 0.f;
        for (int s8 = 0; s8 < 8; ++s8) {
          bf16x8 kv = ld16(KwT + k * TST + s8 * 16);
#pragma unroll
          for (int e = 0; e < 8; ++e) s += bf2f((u16)kv[e]);
        }
        nn[k] = decay * nc[k] + s;
      }
    }
    __syncthreads();
    {
      bf16x8 vf[4];
      const int vb = wid & 3, tb = wid >> 2;
#pragma unroll
      for (int ks = 0; ks < 4; ++ks) vf[ks] = ld16(VT + (vb * 32 + r) * TST + (ks * 16 + hh * 8) * 2);
      const bool wr_h = (step >= 4) || need_ctx;
      {
        const int t = tb * 32 + r;
        f32x16 acc;
#pragma unroll
        for (int i = 0; i < 16; ++i) acc[i] = 0.f;
#pragma unroll
        for (int kb = 0; kb < 4; ++kb)
#pragma unroll
          for (int s2 = 0; s2 < 2; ++s2) {
            bf16x8 af = mk8(pack2(CT[kb][8 * s2], CT[kb][8 * s2 + 1]), pack2(CT[kb][8 * s2 + 2], CT[kb][8 * s2 + 3]),
                            pack2(CT[kb][8 * s2 + 4], CT[kb][8 * s2 + 5]), pack2(CT[kb][8 * s2 + 6], CT[kb][8 * s2 + 7]));
            uint2 lo = *reinterpret_cast<const uint2*>(Qs + t * QST + (kb * 32 + s2 * 16 + hh * 4) * 2);
            uint2 hi = *reinterpret_cast<const uint2*>(Qs + t * QST + (kb * 32 + s2 * 16 + 8 + hh * 4) * 2);
            acc = mfma32(af, mk8(lo.x, lo.y, hi.x, hi.y), acc);
          }
        const float Mt = sM[t];
        const float winter = __expf(mstate - Mt);
#pragma unroll
        for (int i = 0; i < 16; ++i) acc[i] *= winter;
#pragma unroll
        for (int ks = 0; ks < 4; ++ks) {
          bf16x8 sf = ld16(Sp + t * TST + (ks * 16 + hh * 8) * 2);
          acc = mfma32(vf[ks], sf, acc);
        }
        float den = denp[t] + denp[64 + t] + winter * qn[t];
        float sc = 1.f / fmaxf(fabsf(den), __expf(-(sb[t] + Mt)));
        if (wr_h) {
          u16* dst = hout + (size_t)(rowbase + t) * 512 + hd * 128 + vb * 32;
#pragma unroll
          for (int g4 = 0; g4 < 4; ++g4)
            *reinterpret_cast<uint2*>(dst + g4 * 8 + hh * 4) =
                make_uint2(pack2(acc[g4 * 4] * sc, acc[g4 * 4 + 1] * sc), pack2(acc[g4 * 4 + 2] * sc, acc[g4 * 4 + 3] * sc));
        }
      }
#pragma unroll
      for (int kb = 0; kb < 4; ++kb) {
#pragma unroll
        for (int i = 0; i < 16; ++i) CT[kb][i] *= decay;
#pragma unroll
        for (int ks = 0; ks < 4; ++ks) {
          bf16x8 kf = ld16(KwT + (kb * 32 + r) * TST + (ks * 16 + hh * 8) * 2);
          CT[kb] = mfma32(kf, vf[ks], CT[kb]);
        }
      }
    }
    mstate = bend + Mend;
  }
  __syncthreads();
}

DEV int next_item(unsigned* ctr, int* s_item) {
  __syncthreads();
  if (my_tid() == 0) *s_item = (int)atomicAdd(ctr, 1u);
  __syncthreads();
  return *s_item;
}
DEV void phase_mixers(const Params& P, int l, char* smem) {
  const bool need_ctx = (l == 0);
  __shared__ int s_item;
  const int n_ml = 128, n_diff = 2048, n_win = 2048, n_dc = need_ctx ? 128 : 0, n_wc = need_ctx ? 128 : 0;
  for (;;) {
    int it = next_item(&WS_CTR(P)[l * 4 + 0], &s_item);
    if (it >= n_ml) break;
    mlstm_item(P, l, it >> 3, (it >> 1) & 3, it & 1, need_ctx, smem);
  }
  for (;;) {
    int it = next_item(&WS_CTR(P)[l * 4 + 1], &s_item);
    if (it >= n_diff + n_dc) break;
    bool cq = it >= n_diff;
    int i2 = it - n_diff;
    int b = cq ? i2 >> 3 : it >> 7, hd = cq ? (i2 >> 1) & 3 : (it >> 5) & 3, qt = cq ? i2 & 1 : it & 31;
    diff_item(P, l, b, hd, qt, cq, smem);
  }
  for (;;) {
    int it = next_item(&WS_CTR(P)[l * 4 + 2], &s_item);
    if (it >= n_win + n_wc) break;
    bool cq = it >= n_win;
    int i2 = it - n_win;
    int b = cq ? i2 >> 3 : it >> 7, g = cq ? (i2 >> 2) & 1 : (it >> 6) & 1, qb = cq ? i2 & 3 : it & 63;
    win_item(P, l, b, g, qb, cq, smem);
  }
}

DEV void phase_ya(const Params& P, int l, int nrows) {
  const int lane = my_tid() & 63, wid = my_tid() >> 6;
  const u16* hf = WS_HFB(P);
  const u16* hb = WS_HFB(P) + (size_t)MTOT * 512;
  for (int row = blockIdx.x * 8 + wid; row < nrows; row += gridDim.x * 8) {
    uint4 a = *reinterpret_cast<const uint4*>(hf + (size_t)row * 512 + lane * 8);
    uint4 bq = *reinterpret_cast<const uint4*>(hb + (size_t)row * 512 + lane * 8);
    uint4 o = *reinterpret_cast<const uint4*>(WS_P(P) + (size_t)row * PW + C_MO + lane * 8);
    uint32_t aa[4] = {a.x, a.y, a.z, a.w}, bb[4] = {bq.x, bq.y, bq.z, bq.w}, oo[4] = {o.x, o.y, o.z, o.w};
    float y[8], ss = 0.f;
#pragma unroll
    for (int j = 0; j < 4; ++j) {
      y[2 * j] = (bflo(aa[j]) + bflo(bb[j])) * sigmoidf_(bflo(oo[j]));
      y[2 * j + 1] = (bfhi(aa[j]) + bfhi(bb[j])) * sigmoidf_(bfhi(oo[j]));
      ss += y[2 * j] * y[2 * j] + y[2 * j + 1] * y[2 * j + 1];
    }
#pragma unroll
    for (int of = 1; of < 16; of <<= 1) ss += __shfl_xor(ss, of);
    float rstd = rsqrtf(ss * (1.f / 128.f) + EPS);
    const float* mn = P.m_norm + l * 512 + lane * 8;
    uint32_t w[4];
#pragma unroll
    for (int j = 0; j < 4; ++j) w[j] = pack2(y[2 * j] * rstd * mn[2 * j], y[2 * j + 1] * rstd * mn[2 * j + 1]);
    *reinterpret_cast<uint4*>(WS_P(P) + (size_t)row * PW + C_MO + lane * 8) = make_uint4(w[0], w[1], w[2], w[3]);
  }
}

DEV void phase_merge(const Params& P, int l, int M, char* smem) {
  const u16* Wl = WS_W(P) + (size_t)l * W_LAYER;
  u16* merged = WS_HFB(P);
  const int nM = M / 128, nN = 8;
  const int lane = my_tid() & 63, wid = my_tid() >> 6, wr = wid >> 2, wc = wid & 3, fr = lane & 15, fq = lane >> 4;
  for (int tile = blockIdx.x; tile < nM * nN; tile += gridDim.x) {
    int tm, tn;
    tile_coords(tile, nM * nN, nN, tm, tn);
    f32x4 mg[4][2];
    zero_acc<4, 2>(mg);
#pragma unroll 1
    for (int i = 0; i < 3; ++i) {
      f32x4 acc[4][2];
      zero_acc<4, 2>(acc);
      gemm_mainloop<4, 2>(WS_H(P) + (size_t)tm * 128 * 1024, 1024, Wl + W_G + (size_t)(i * 1024 + tn * 128) * 1024, 1024, 1024, acc, smem);
      uint32_t gp[4][2][2];
#pragma unroll
      for (int mi = 0; mi < 4; ++mi)
#pragma unroll
        for (int ni = 0; ni < 2; ++ni) {
          gp[mi][ni][0] = pack2(sigmoidf_(acc[mi][ni][0]), sigmoidf_(acc[mi][ni][1]));
          gp[mi][ni][1] = pack2(sigmoidf_(acc[mi][ni][2]), sigmoidf_(acc[mi][ni][3]));
        }
      zero_acc<4, 2>(acc);
      int yc = i == 0 ? C_MO : (i == 1 ? C_WQ : C_DQ);
      gemm_mainloop<4, 2>(WS_P(P) + (size_t)tm * 128 * PW + yc, PW, Wl + W_B + (size_t)i * 1024 * 512 + (size_t)(tn * 128) * 512, 512, 512, acc, smem);
#pragma unroll
      for (int mi = 0; mi < 4; ++mi)
#pragma unroll
        for (int ni = 0; ni < 2; ++ni) {
          mg[mi][ni][0] += bflo(gp[mi][ni][0]) * acc[mi][ni][0];
          mg[mi][ni][1] += bfhi(gp[mi][ni][0]) * acc[mi][ni][1];
          mg[mi][ni][2] += bflo(gp[mi][ni][1]) * acc[mi][ni][2];
          mg[mi][ni][3] += bfhi(gp[mi][ni][1]) * acc[mi][ni][3];
        }
    }
    const int row0 = tm * 128 + wr * 64, col0 = tn * 128 + wc * 32;
#pragma unroll
    for (int mi = 0; mi < 4; ++mi)
#pragma unroll
      for (int ni = 0; ni < 2; ++ni)
#pragma unroll
        for (int j = 0; j < 4; ++j)
          merged[(size_t)(row0 + mi * 16 + fq * 4 + j) * 1024 + col0 + ni * 16 + fr] = f2bf(mg[mi][ni][j]);
  }
}

struct EpiResid {
  const Params& P;
  const float* src_lat;
  const float* modl;
  int gt_off;
  DEV void operator()(f32x4 (&acc)[8][4], int row0, int col0) const {
    const int lane = my_tid() & 63, fr = lane & 15, fq = lane >> 4;
#pragma unroll
    for (int mi = 0; mi < 8; ++mi)
#pragma unroll
      for (int j = 0; j < 4; ++j) {
        int row = row0 + mi * 16 + fq * 4 + j;
        const float* src;
        float* dst;
        int cond;
        if (row < NLAT) { src = src_lat + (size_t)row * 1024; dst = P.out + (size_t)row * 1024; cond = row >> 12; }
        else { src = WS_XC(P) + (size_t)(row - NLAT) * 1024; dst = WS_XC(P) + (size_t)(row - NLAT) * 1024; cond = 16; }
        const float* gt = modl + (size_t)cond * 6144 + gt_off;
#pragma unroll
        for (int ni = 0; ni < 4; ++ni) {
          int col = col0 + ni * 16 + fr;
          dst[col] = src[col] + gt[col] * acc[mi][ni][j];
        }
      }
  }
};

struct EpiSwiglu {
  u16* act;
  DEV void operator()(f32x4 (&acc)[8][4], int row0, int col0) const {
    const int lane = my_tid() & 63, fr = lane & 15, fq = lane >> 4;
#pragma unroll
    for (int mi = 0; mi < 8; ++mi)
#pragma unroll
      for (int j = 0; j < 4; ++j) {
        int row = row0 + mi * 16 + fq * 4 + j;
#pragma unroll
        for (int pr = 0; pr < 2; ++pr) {
          float gte = acc[mi][pr * 2][j], up = acc[mi][pr * 2 + 1][j];
          act[(size_t)row * FH + ((col0 + pr * 32) >> 1) + fr] = f2bf(siluf_(gte) * up);
        }
      }
  }
};


#ifdef SELFCHECK
#define DBGF(P) reinterpret_cast<float*>((P).ws + O_XC + (size_t)NCTXR * 1024 * 4)
DEV float blk_reduce(float v, bool ismax, float* red) {
  const int tid = my_tid(), lane = tid & 63, wid = tid >> 6;
#pragma unroll
  for (int o = 32; o > 0; o >>= 1) { float t = __shfl_xor(v, o); v = ismax ? fmaxf(v, t) : v + t; }
  __syncthreads();
  if (lane == 0) red[wid] = v;
  __syncthreads();
  float r = red[0];
  for (int i = 1; i < 8; ++i) r = ismax ? fmaxf(r, red[i]) : r + red[i];
  __syncthreads();
  return r;
}
DEV void chk_sample(int s, int& b, int& hd, int& t) {
  const int ti = s & 7;
  b = (s * 5 + 3) & 15; hd = s & 7;
  t = ti == 0 ? 0 : ti == 1 ? 63 : ti == 2 ? 64 : ti == 3 ? 127 : ti == 4 ? 2048 + 65 : ti == 5 ? 3000 : ti == 6 ? 4032 : 4095;
}
DEV void check_pre(const Params& P, int l, char* smem) {
  const int tid = my_tid();
  float* sc = reinterpret_cast<float*>(smem);
  float* red = sc + 2 * 4352;
  float* ov = red + 16;
  float* dbg = DBGF(P);
  const u16* p = WS_P(P);
  for (int it = blockIdx.x; it < 24; it += gridDim.x) {
    const bool isdiff = it >= 12;
    const int s = isdiff ? it - 12 : it;
    int b, hd, t;
    chk_sample(s, b, hd, t);
    const bool ctxq = s >= 8;
    if (ctxq) t &= 255;
    const size_t row = ctxq ? (size_t)NLAT + b * 256 + t : (size_t)b * T + t;
    __syncthreads();
    if (!isdiff) {
      const int head = hd, g = head >> 2;
      const int lo = ctxq ? 0 : max(0, t - 128), hi = ctxq ? -1 : min(T - 1, t + 128);
      const int nk = 256 + (hi - lo + 1);
      float mx = -1e30f;
      for (int k = tid; k < nk; k += NTHREADS) {
        size_t krow = k < 256 ? (size_t)NLAT + b * 256 + k : (size_t)b * T + lo + (k - 256);
        float a = 0.f;
        for (int d = 0; d < 64; ++d) a += bf2f(p[row * PW + C_WQ + head * 64 + d]) * bf2f(p[krow * PW + C_WK + g * 64 + d]);
        sc[k] = a;
        mx = fmaxf(mx, a);
      }
      mx = blk_reduce(mx, true, red);
      const float sk = P.sink[l * 8 + head];
      mx = fmaxf(mx, sk);
      float sm = 0.f;
      for (int k = tid; k < nk; k += NTHREADS) { float e = expf(sc[k] - mx); sc[k] = e; sm += e; }
      sm = blk_reduce(sm, false, red) + expf(sk - mx);
      if (tid < 64) {
        float o = 0.f;
        for (int k = 0; k < nk; ++k) {
          int kidx = k < 256 ? k : 256 + lo + (k - 256);
          o += sc[k] * bf2f(WS_VTW(P)[((size_t)(b * 2 + g) * 64 + tid) * KEYS + kidx]);
        }
        dbg[it * 128 + tid] = o / sm;
      }
    } else {
      const int h = hd & 3;
      const int nk = ctxq ? 256 : KEYS;
      float mx0 = -1e30f, mx1 = -1e30f;
      for (int k = tid; k < nk; k += NTHREADS) {
        size_t krow = k < 256 ? (size_t)NLAT + b * 256 + k : (size_t)b * T + (k - 256);
        float a0 = 0.f, a1 = 0.f;
        for (int d = 0; d < 64; ++d) {
          a0 += bf2f(p[row * PW + C_DQ + h * 128 + d]) * bf2f(p[krow * PW + C_DK + h * 128 + d]);
          a1 += bf2f(p[row * PW + C_DQ + h * 128 + 64 + d]) * bf2f(p[krow * PW + C_DK + h * 128 + 64 + d]);
        }
        sc[k] = a0; sc[4352 + k] = a1;
        mx0 = fmaxf(mx0, a0); mx1 = fmaxf(mx1, a1);
      }
      mx0 = blk_reduce(mx0, true, red);
      mx1 = blk_reduce(mx1, true, red);
      float s0 = 0.f, s1 = 0.f;
      for (int k = tid; k < nk; k += NTHREADS) {
        float e0 = expf(sc[k] - mx0), e1 = expf(sc[4352 + k] - mx1);
        sc[k] = e0; sc[4352 + k] = e1; s0 += e0; s1 += e1;
      }
      s0 = blk_reduce(s0, false, red);
      s1 = blk_reduce(s1, false, red);
      const float lam = WS_LAM(P)[l], lam_init = 0.8f - 0.6f * expf(-0.3f * (float)l);
      float y = 0.f;
      if (tid < 128) {
        for (int k = 0; k < nk; ++k)
          y += (sc[k] / s0 - lam * sc[4352 + k] / s1) * bf2f(WS_VTD(P)[((size_t)(b * 4 + h) * 128 + tid) * KEYS + k]);
        ov[tid] = y;
      }
      __syncthreads();
      if (tid < 128) {
        float ss = 0.f;
        for (int v = 0; v < 128; ++v) ss += ov[v] * ov[v];
        dbg[it * 128 + tid] = y * rsqrtf(ss / 128.f + EPS) * P.d_norm[l * 512 + h * 128 + tid] * (1.f - lam_init);
      }
    }
  }
}
DEV void check_post(const Params& P, int l, unsigned* flags) {
  const int tid = my_tid();
  const float* dbg = DBGF(P);
  const u16* p = WS_P(P);
  for (int it = blockIdx.x; it < 24; it += gridDim.x) {
    const bool isdiff = it >= 12;
    const int s = isdiff ? it - 12 : it;
    int b, hd, t;
    chk_sample(s, b, hd, t);
    const bool ctxq = s >= 8;
    if (ctxq) t &= 255;
    const size_t row = ctxq ? (size_t)NLAT + b * 256 + t : (size_t)b * T + t;
    if (ctxq && l != 0) continue;
    const int n = isdiff ? 128 : 64;
    if (tid < n) {
      float got = isdiff ? bf2f(p[row * PW + C_DQ + (hd & 3) * 128 + tid]) : bf2f(p[row * PW + C_WQ + hd * 64 + tid]);
      float ex = dbg[it * 128 + tid];
      if (!(fabsf(got - ex) <= 0.03f + 0.03f * fabsf(ex))) atomicOr(flags, isdiff ? (ctxq ? 32u : 2u) : (ctxq ? 16u : 1u));
    }
  }
}
DEV void check_mlstm(const Params& P, int l, char* smem, unsigned* flags) {
  const int tid = my_tid(), lane = tid & 63;
  float* qs = reinterpret_cast<float*>(smem);
  float* ks = qs + 128;
  float* vs = ks + 128;
  float* nn = vs + 128;
  float* sc = nn + 128;
  float* red = sc + 8;
  const u16* p = WS_P(P);
  for (int it = blockIdx.x; it < 4; it += gridDim.x) {
    const int b = (it * 7 + 2) & 15, hd = (it + 1) & 3, dir = it & 1;
    const int v = tid >> 2, kq = tid & 3;
    float C[32];
#pragma unroll
    for (int j = 0; j < 32; ++j) C[j] = 0.f;
    __syncthreads();
    if (tid < 128) nn[tid] = 0.f;
    if (tid == 0) sc[0] = 0.f;
    __syncthreads();
    const int nsteps = (l == 0) ? 256 + T : 256 + T;
    for (int st = 0; st < nsteps; ++st) {
      int seg0, seglen, u;
      if (st < 256) { seg0 = NLAT + b * 256; seglen = 256; u = dir ? 255 - st : st; }
      else { seg0 = b * T; seglen = T; u = dir ? T - 1 - (st - 256) : st - 256; }
      const size_t row = (size_t)seg0 + u;
      if (tid < 128) {
        float xq = 0.f, xk = 0.f;
        for (int tp = 0; tp < 3; ++tp) {
          int uu = u + tp - 1;
          if (uu >= 0 && uu < seglen) {
            xq += P.conv_w[(size_t)l * 3072 + tp * 1024 + hd * 128 + tid] * bf2f(p[((size_t)seg0 + uu) * PW + C_MQ + hd * 128 + tid]);
            xk += P.conv_w[(size_t)l * 3072 + tp * 1024 + 512 + hd * 128 + tid] * bf2f(p[((size_t)seg0 + uu) * PW + C_MK + hd * 128 + tid]);
          }
        }
        qs[tid] = xq / (1.f + expf(-xq));
        ks[tid] = xk / (1.f + expf(-xk)) * 0.08838834764831845f;
        vs[tid] = bf2f(p[row * PW + C_MV + hd * 128 + tid]);
      }
      if (tid == 0) {
        float ig = WS_GATES(P)[row * 16 + dir * 8 + hd], fg = WS_GATES(P)[row * 16 + dir * 8 + 4 + hd];
        float lf = fminf(fg, 0.f) - log1pf(expf(-fabsf(fg)));
        float m = sc[0], mn = fmaxf(lf + m, ig);
        sc[1] = expf(lf + m - mn);
        sc[2] = expf(ig - mn);
        sc[3] = mn;
      }
      __syncthreads();
      const float fd = sc[1], iw = sc[2], mn = sc[3];
      float pd = 0.f;
#pragma unroll
      for (int j = 0; j < 32; ++j) {
        C[j] = fd * C[j] + iw * vs[v] * ks[kq * 32 + j];
        pd += C[j] * qs[kq * 32 + j];
      }
      pd += __shfl_xor(pd, 1);
      pd += __shfl_xor(pd, 2);
      float dn = 0.f;
      if (tid < 128) { float nv = fd * nn[tid] + iw * ks[tid]; nn[tid] = nv; dn = nv * qs[tid]; }
      dn = blk_reduce(dn, false, red);
      if (tid == 0) sc[0] = mn;
      const float hval = pd / fmaxf(fabsf(dn), expf(-mn));
      float sq = (kq == 0) ? hval * hval : 0.f;
      sq = blk_reduce(sq, false, red);
      const float rms = sqrtf(sq / 128.f);
      const bool cmp = (st < 256) ? (l == 0) : true;
      if (cmp && kq == 0 && ((u & 63) == 0 || (u & 63) == 63 || (u % 97) == 0)) {
        float got = bf2f(WS_HFB(P)[(size_t)dir * MTOT * 512 + row * 512 + hd * 128 + v]);
        if (!(fabsf(got - hval) <= 0.05f * rms + 0.05f * fabsf(hval) + 1e-3f)) atomicOr(flags, dir ? 8u : 4u);
      }
    }
  }
}
#endif


#ifdef SELFCHECK
DEV void flag_if(bool bad, unsigned* flags, unsigned bit) { if (bad) atomicOr(flags, bit); }
DEV bool close_(float got, float ex, float tol) { return fabsf(got - ex) <= tol + tol * fabsf(ex); }
DEV void check_inproj(const Params& P, int l, char* smem, unsigned* flags) {
  const int tid = my_tid();
  float* red = reinterpret_cast<float*>(smem);
  float* hrow = red + 16;
  const float* modl = WS_MOD(P) + (size_t)l * 17 * 6144;
  for (int it = blockIdx.x; it < 64; it += gridDim.x) {
    const int ri = it & 7;
    const int row = ri == 0 ? 0 : ri == 1 ? 4095 : ri == 2 ? 4096 + 77 : ri == 3 ? 30000 : ri == 4 ? 65535 : ri == 5 ? NLAT : ri == 6 ? NLAT + 300 : MTOT - 1;
    const int cond = row < NLAT ? row >> 12 : 16;
    {
      int col = (it * 769 + 5) % 6144;
      float a = 0.f;
      for (int k = tid; k < 1024; k += NTHREADS) {
        float cv = cond < 16 ? P.c[cond * 1024 + k] : P.c_ctx[k];
        a += cv / (1.f + expf(-cv)) * P.w_mod[(size_t)l * 1024 * 6144 + (size_t)k * 6144 + col];
      }
      a = blk_reduce(a, false, red) + P.b_mod[l * 6144 + col];
      if (tid == 0) flag_if(!close_(modl[(size_t)cond * 6144 + col], a, 2e-3f), flags, 1u);
    }
    const float* xs = row < NLAT ? ((l == 0 ? P.x : P.out) + (size_t)row * 1024) : (WS_XC(P) + (size_t)(row - NLAT) * 1024);
    float ss = 0.f;
    for (int k = tid; k < 1024; k += NTHREADS) ss += xs[k] * xs[k];
    ss = blk_reduce(ss, false, red);
    const float rstd = rsqrtf(ss / 1024.f + EPS);
    for (int k = tid; k < 1024; k += NTHREADS) {
      float y = xs[k] * rstd * P.g_mix[l * 1024 + k] * (1.f + modl[(size_t)cond * 6144 + 1024 + k]) + modl[(size_t)cond * 6144 + k];
      hrow[k] = y;
      flag_if(!close_(bf2f(WS_H(P)[(size_t)row * 1024 + k]), y, 1e-2f), flags, 2u);
    }
    __syncthreads();
    const int oi = it >> 3;
    const int oj = (oi * 2 + (it & 1)) & 15;
    const int oc = oj == 0 ? 3 : oj == 1 ? 600 : oj == 2 ? 1100 : oj == 3 ? 1999 : oj == 4 ? 2050 : oj == 5 ? 2064 + 70 : oj == 6 ? 2576 + 100 :
                   oj == 7 ? 2704 + 5 : oj == 8 ? 2832 + 200 : oj == 9 ? 2832 + 37 : oj == 10 ? 3344 + 90 : oj == 11 ? 3344 + 300 :
                   oj == 12 ? 3856 + 10 : oj == 13 ? 3856 + 500 : oj == 14 ? 2048 + 15 : 2064 + 500;
    auto dotcol = [&](int c) {
      float a = 0.f;
      for (int k = tid; k < 1024; k += NTHREADS) a += hrow[k] * P.w_in[(size_t)l * 1024 * INW + (size_t)k * INW + c];
      return blk_reduce(a, false, red);
    };
    float val = dotcol(oc);
    const u16* p = WS_P(P);
    const bool lat = row < NLAT;
    const int t = row & (T - 1);
    float got = 0.f, ex = val;
    unsigned bit = 4u;
    if (oc < 2048) { got = bf2f(p[(size_t)row * PW + oc]); }
    else if (oc < 2064) { got = WS_GATES(P)[(size_t)row * 16 + oc - 2048]; ex = val + P.b_gate[l * 16 + oc - 2048]; }
    else if (oc >= 2704 && oc < 2832) {
      int cgi = oc - 2704, g = cgi >> 6, vd = cgi & 63;
      int b = lat ? row >> 12 : (row - NLAT) >> 8, key = lat ? 256 + t : (row - NLAT) & 255;
      got = bf2f(WS_VTW(P)[((size_t)(b * 2 + g) * 64 + vd) * KEYS + key]);
      bit = 8u;
    } else if (oc >= 3856) {
      int cgi = oc - 3856, h = cgi >> 7, vd = cgi & 127;
      int b = lat ? row >> 12 : (row - NLAT) >> 8, key = lat ? 256 + t : (row - NLAT) & 255;
      got = bf2f(WS_VTD(P)[((size_t)(b * 4 + h) * 128 + vd) * KEYS + key]);
      bit = 8u;
    } else {
      int base, nb0;
      bool isq;
      if (oc < 2576) { base = 2064; nb0 = C_WQ; isq = true; }
      else if (oc < 2704) { base = 2576; nb0 = C_WK; isq = false; }
      else if (oc < 3344) { base = 2832; nb0 = C_DQ; isq = true; }
      else { base = 3344; nb0 = C_DK; isq = false; }
      int rel = oc - base, dd = rel & 63, j = dd & 15, second = (dd >> 4) & 1, axis = dd >> 5;
      float other = dotcol(second ? oc - 16 : oc + 16);
      if (lat) {
        int pos = axis ? (t & 63) : (t >> 6);
        float ang = (float)pos * powf(10000.f, -(float)j / 16.f);
        float cs = cosf(ang), sn = sinf(ang);
        ex = second ? (val * cs + other * sn) : (val * cs - other * sn);
      }
      if (isq) ex *= 0.125f;
      got = bf2f(p[(size_t)row * PW + nb0 + rel]);
      bit = 16u;
    }
    if (tid == 0) flag_if(!close_(got, ex, 3e-2f), flags, bit);
    __syncthreads();
  }
}
DEV void check_post6(const Params& P, int l, char* smem, unsigned* flags, const float* xprev) {
  const int tid = my_tid();
  float* red = reinterpret_cast<float*>(smem);
  const u16* Yp = WS_P(P);
  const float* modl = WS_MOD(P) + (size_t)l * 17 * 6144;
  for (int it = blockIdx.x; it < 16; it += gridDim.x) {
    const int ri = it & 7;
    const int row = ri == 0 ? 1 : ri == 1 ? 4097 : ri == 2 ? 12345 : ri == 3 ? 40000 : ri == 4 ? 65534 : ri == 5 ? NLAT + 1 : ri == 6 ? NLAT + 2000 : MTOT - 2;
    if (row >= NLAT && l != 0) continue;
    const int col = (it * 331 + 17) & 1023;
    const int cond = row < NLAT ? row >> 12 : 16;
    float mg = 0.f;
    for (int i = 0; i < 3; ++i) {
      float a = 0.f, z = 0.f;
      for (int k = tid; k < 1024; k += NTHREADS) a += bf2f(WS_H(P)[(size_t)row * 1024 + k]) * P.w_in[(size_t)l * 1024 * INW + (size_t)k * INW + 4368 + i * 1024 + col];
      a = blk_reduce(a, false, red);
      const int yc = i == 0 ? C_MO : (i == 1 ? C_WQ : C_DQ);
      for (int k = tid; k < 512; k += NTHREADS) z += bf2f(Yp[(size_t)row * PW + yc + k]) * P.w_branch[((size_t)l * 3 + i) * 512 * 1024 + (size_t)k * 1024 + col];
      z = blk_reduce(z, false, red);
      mg += z / (1.f + expf(-a));
    }
    if (tid == 0) flag_if(!close_(bf2f(WS_HFB(P)[(size_t)row * 1024 + col]), mg, 3e-2f), flags, 1u);
    float o = 0.f;
    for (int k = tid; k < 1024; k += NTHREADS) o += bf2f(WS_HFB(P)[(size_t)row * 1024 + k]) * P.w_out[(size_t)l * 1024 * 1024 + (size_t)k * 1024 + col];
    o = blk_reduce(o, false, red);
    const float xo = row < NLAT ? xprev[(size_t)row * 1024 + col] : -1e9f;
    const float xn = row < NLAT ? P.out[(size_t)row * 1024 + col] : WS_XC(P)[(size_t)(row - NLAT) * 1024 + col];
    if (tid == 0 && row < NLAT && (l == 0)) flag_if(!close_(xn, xo + modl[(size_t)cond * 6144 + 2048 + col] * o, 2e-2f), flags, 2u);
    if (tid == 0) DBGF(P)[4096 + it] = xn;
  }
}
DEV void check_post9(const Params& P, int l, char* smem, unsigned* flags) {
  const int tid = my_tid();
  float* red = reinterpret_cast<float*>(smem);
  const float* modl = WS_MOD(P) + (size_t)l * 17 * 6144;
  for (int it = blockIdx.x; it < 16; it += gridDim.x) {
    const int ri = it & 7;
    const int row = ri == 0 ? 1 : ri == 1 ? 4097 : ri == 2 ? 12345 : ri == 3 ? 40000 : ri == 4 ? 65534 : ri == 5 ? NLAT + 1 : ri == 6 ? NLAT + 2000 : MTOT - 2;
    if (row >= NLAT && l != 0) continue;
    const int col = (it * 331 + 17) & 1023;
    const int cond = row < NLAT ? row >> 12 : 16;
    const int j = (it * 97 + 13) % FH;
    float g = 0.f, u = 0.f;
    for (int k = tid; k < 1024; k += NTHREADS) {
      float hv = bf2f(WS_H(P)[(size_t)row * 1024 + k]);
      g += hv * P.w_ffn_in[(size_t)l * 1024 * 5632 + (size_t)k * 5632 + j];
      u += hv * P.w_ffn_in[(size_t)l * 1024 * 5632 + (size_t)k * 5632 + FH + j];
    }
    g = blk_reduce(g, false, red);
    u = blk_reduce(u, false, red);
    if (tid == 0) flag_if(!close_(bf2f(WS_P(P)[(size_t)row * FH + j]), g / (1.f + expf(-g)) * u, 3e-2f), flags, 4u);
    float o = 0.f;
    for (int k = tid; k < FH; k += NTHREADS) o += bf2f(WS_P(P)[(size_t)row * FH + k]) * P.w_ffn_out[(size_t)l * FH * 1024 + (size_t)k * 1024 + col];
    o = blk_reduce(o, false, red);
    const float xn = row < NLAT ? P.out[(size_t)row * 1024 + col] : WS_XC(P)[(size_t)(row - NLAT) * 1024 + col];
    if (tid == 0) flag_if(!close_(xn, DBGF(P)[4096 + it] + modl[(size_t)cond * 6144 + 5120 + col] * o, 2e-2f), flags, 8u);
  }
}
#endif

#ifdef DEBUG_STAGE
DEV void debug_dump(const Params& P, int stage) {
  const int tid = my_tid();
  for (size_t idx = (size_t)blockIdx.x * NTHREADS + tid; idx < (size_t)NLAT * 1024; idx += (size_t)gridDim.x * NTHREADS) {
    size_t row = idx >> 10;
    int c = (int)(idx & 1023);
    size_t r2 = row + (row < 4096 ? NLAT : 0);
    float v = 0.f;
    const u16* p = WS_P(P);
    if (stage == 1) {
      v = bf2f(p[row * PW + c]) + bf2f(p[row * PW + 1024 + c]) + bf2f(p[row * PW + 2048 + c]) + (c < 640 ? bf2f(p[row * PW + 3072 + c]) : 0.f);
      v += bf2f(p[r2 * PW + c]) + bf2f(p[r2 * PW + 1024 + c]) + bf2f(p[r2 * PW + 2048 + c]);
      v += bf2f(WS_VTD(P)[r2 * 512 + (c & 511)]) + bf2f(WS_VTW(P)[r2 * 128 + (c & 127)]) + WS_GATES(P)[r2 * 16 + (c & 15)];
      v += bf2f(WS_VTD(P)[row * 512 + (c & 511)]) + bf2f(WS_VTW(P)[row * 128 + (c & 127)]) + WS_GATES(P)[row * 16 + (c & 15)];
    } else if (stage == 21) {
      v = bf2f(WS_HFB(P)[row * 512 + (c & 511)]) + 2.f * bf2f(WS_HFB(P)[(size_t)MTOT * 512 + row * 512 + (c & 511)]);
      v += bf2f(WS_HFB(P)[r2 * 512 + (c & 511)]) + 2.f * bf2f(WS_HFB(P)[(size_t)MTOT * 512 + r2 * 512 + (c & 511)]);
    } else if (stage == 22) {
      v = bf2f(p[row * PW + C_WQ + (c & 511)]) + bf2f(p[r2 * PW + C_WQ + (c & 511)]);
    } else if (stage == 23) {
      v = bf2f(p[row * PW + C_DQ + (c & 511)]) + bf2f(p[r2 * PW + C_DQ + (c & 511)]);
    } else if (stage == 3) {
      v = bf2f(WS_HFB(P)[row * 1024 + c]) + bf2f(WS_HFB(P)[r2 * 1024 + c]);
    } else if (stage == 4) {
      v = P.out[idx] + WS_XC(P)[(row & 4095) * 1024 + c];
    } else if (stage == 5) {
      v = bf2f(WS_H(P)[row * 1024 + c]) + bf2f(WS_H(P)[r2 * 1024 + c]);
    } else if (stage == 6) {
      v = bf2f(p[row * FH + c]) + bf2f(p[row * FH + 1024 + c]) + bf2f(p[r2 * FH + 1792 + c]);
    }
    if (stage != 4) P.out[idx] = v; else P.out[idx] = v;
  }
}
#define DBG(st) if (l == 0 && DEBUG_STAGE == st) { GSYNC_ONLY(); debug_dump(P, st); return true; }
#else
#define DBG(st)
#endif
template <int l>
DEV bool layer_body(const Params& P, unsigned* bar, unsigned& epoch, char* smem) {
  constexpr bool need_ctx = (l == 0);
  const float* modl = WS_MOD(P) + (size_t)l * 17 * 6144;
  const u16* Wl = WS_W(P) + (size_t)l * W_LAYER;
  const float* xlat = l == 0 ? P.x : P.out;
  constexpr int Mtok = need_ctx ? MTOT : NLAT;
  phase_norm_mod(P, xlat, WS_XC(P), MTOT, P.g_mix + l * 1024, modl, 0, 1024);
  GSYNC();
  gemm_phase<8>(WS_H(P), 1024, Wl + W_IN, 1024, MTOT, NIN, 1024, EpiInProj{P, l}, smem);
#ifdef REPEAT_GEMMS
  if (l == 1) gemm_phase<8>(WS_H(P), 1024, Wl + W_IN, 1024, MTOT, NIN, 1024, EpiInProj{P, l}, smem);
#endif
  GSYNC();
  DBG(1)
#ifdef SELFCHECK
#if SELFCHECK == 2
  check_inproj(P, l, smem, WS_CTR(P) + 16 + l * 3);
#else
  check_pre(P, l, smem);
#endif
  GSYNC();
#endif
  phase_mixers(P, l, smem);
  GSYNC();
#if defined(SELFCHECK) && SELFCHECK == 1
  check_post(P, l, WS_CTR(P) + 17 + l * 3);
  check_mlstm(P, l, smem, WS_CTR(P) + 17 + l * 3);
  GSYNC();
#endif
  DBG(21)
  DBG(22)
  DBG(23)
  phase_ya(P, l, Mtok);
  GSYNC();
  phase_merge(P, l, Mtok, smem);
#ifdef REPEAT_GEMMS
  if (l == 1) phase_merge(P, l, Mtok, smem);
#endif
  GSYNC();
  DBG(3)
  gemm_phase<8>(WS_HFB(P), 1024, Wl + W_O, 1024, Mtok, 1024, 1024, EpiResid{P, xlat, modl, 2048}, smem);
  GSYNC();
#if defined(SELFCHECK) && SELFCHECK == 2
  check_post6(P, l, smem, WS_CTR(P) + 18 + l * 3, xlat);
  GSYNC();
#endif
  DBG(4)
  phase_norm_mod(P, P.out, WS_XC(P), Mtok, P.g_ffn + l * 1024, modl, 3072, 4096);
  GSYNC();
  DBG(5)
  gemm_phase<8>(WS_H(P), 1024, Wl + W_FI, 1024, Mtok, 5632, 1024, EpiSwiglu{WS_P(P)}, smem);
#ifdef REPEAT_GEMMS
  if (l == 1) gemm_phase<8>(WS_H(P), 1024, Wl + W_FI, 1024, Mtok, 5632, 1024, EpiSwiglu{WS_P(P)}, smem);
#endif
  GSYNC();
  DBG(6)
  gemm_phase<8>(WS_P(P), FH, Wl + W_FO, FH, Mtok, 1024, FH, EpiResid{P, P.out, modl, 5120}, smem);
  GSYNC();
#if defined(SELFCHECK) && SELFCHECK == 2
  check_post9(P, l, smem, WS_CTR(P) + 18 + l * 3);
  GSYNC();
#endif
  return false;
}

__global__ void __launch_bounds__(NTHREADS) fwd_megakernel(Params P) {
  extern __shared__ __attribute__((aligned(16))) char smem[];
  cg::grid_group grid = cg::this_grid();
  unsigned* bar = WS_CTR(P) + 64;
  unsigned epoch = 0;
  grid.sync();
  phase_prologue(P, smem);
  GSYNC();
  if (layer_body<0>(P, bar, epoch, smem)) return;
  if (layer_body<1>(P, bar, epoch, smem)) return;
  phase_final_norm(P);
#ifdef SELFCHECK
  GSYNC();
  if (blockIdx.x == 0 && my_tid() == 0) {
    float scale = 1000.f;
    for (int w = 0; w < 6; ++w) {
      unsigned f = WS_CTR(P)[16 + w];
      if (f) { P.out[0] = (10.f + (float)f) * scale; break; }
      scale *= 10.f;
    }
  }
#endif
}

extern "C" void kernel_launch(void* const* d_in, const int* in_sizes, int n_in, void* d_out, int out_size, void* d_ws,
                              size_t ws_size, hipStream_t stream) {
  static int grid_blocks = 0;
  if (!grid_blocks) {
    int dev = 0, cus = 0, per_cu = 0;
    hipGetDevice(&dev);
    hipDeviceGetAttribute(&cus, hipDeviceAttributeMultiprocessorCount, dev);
    hipFuncSetAttribute((const void*)fwd_megakernel, hipFuncAttributeMaxDynamicSharedMemorySize, LDS_BYTES);
    hipOccupancyMaxActiveBlocksPerMultiprocessor(&per_cu, fwd_megakernel, NTHREADS, LDS_BYTES);
    if (per_cu < 1) per_cu = 1;
    if (per_cu > 1) per_cu = 1;
    grid_blocks = cus * per_cu;
  }
  Params P{};
  const float* const* in = reinterpret_cast<const float* const*>(d_in);
  P.x = in[0]; P.c = in[1]; P.ctx = in[2]; P.c_ctx = in[3]; P.w_mod = in[4]; P.b_mod = in[5]; P.g_mix = in[6];
  P.g_ffn = in[7]; P.w_in = in[8]; P.b_gate = in[9]; P.conv_w = in[10]; P.m_norm = in[11]; P.sink = in[12];
  P.lam_q1 = in[13]; P.lam_k1 = in[14]; P.lam_q2 = in[15]; P.lam_k2 = in[16]; P.d_norm = in[17]; P.w_branch = in[18];
  P.w_out = in[19]; P.w_ffn_in = in[20]; P.w_ffn_out = in[21]; P.g_final = in[22];
  P.out = reinterpret_cast<float*>(d_out);
  P.ws = reinterpret_cast<char*>(d_ws);
  if (WS_TOTAL > ws_size) fprintf(stderr, "workspace too small: need %zu have %zu\n", (size_t)WS_TOTAL, ws_size);
  hipMemsetAsync(P.ws + O_CTR, 0, 2048, stream);
  void* args[] = {&P};
  hipError_t e = hipLaunchCooperativeKernel((const void*)fwd_megakernel, dim3(grid_blocks), dim3(NTHREADS), args, LDS_BYTES, stream);
  if (e != hipSuccess) fprintf(stderr, "cooperative launch failed: %s (grid %d)\n", hipGetErrorString(e), grid_blocks);
}
```

```cpp
#include <hip/hip_runtime.h>
#include <hip/hip_cooperative_groups.h>
#include <cstdio>
#include <cstdint>
namespace cg = cooperative_groups;

typedef unsigned short u16;
using bf16x8 = __attribute__((ext_vector_type(8))) short;
using f32x4 = __attribute__((ext_vector_type(4))) float;
using f32x16 = __attribute__((ext_vector_type(16))) float;

#define DEV __device__ __forceinline__

constexpr int D = 1024, NB = 16, T = 4096, TC = 256;
constexpr int NLAT = NB * T;
constexpr int NCTXR = NB * TC;
constexpr int MTOT = NLAT + NCTXR;
constexpr int KEYS = T + TC;
constexpr int INW = 7440;
constexpr int PW = 3712;
constexpr int C_MQ = 0, C_MK = 512, C_MV = 1024, C_MO = 1536, C_WQ = 2048, C_WK = 2560, C_DQ = 2688, C_DK = 3200;
constexpr int NIN = 4608;
constexpr int FH = 2816;
constexpr float EPS = 1e-6f;
constexpr float L2E = 1.4426950408889634f;
constexpr int NTHREADS = 512;
constexpr int LDS_BYTES = 147456;

constexpr size_t W_IN = 0;
constexpr size_t W_G = W_IN + (size_t)NIN * 1024;
constexpr size_t W_B = W_G + (size_t)3072 * 1024;
constexpr size_t W_O = W_B + (size_t)3 * 1024 * 512;
constexpr size_t W_FI = W_O + (size_t)1024 * 1024;
constexpr size_t W_FO = W_FI + (size_t)5632 * 1024;
constexpr size_t W_LAYER = W_FO + (size_t)1024 * FH;

struct Params {
  const float *x, *c, *ctx, *c_ctx, *w_mod, *b_mod, *g_mix, *g_ffn, *w_in, *b_gate, *conv_w, *m_norm, *sink;
  const float *lam_q1, *lam_k1, *lam_q2, *lam_k2, *d_norm, *w_branch, *w_out, *w_ffn_in, *w_ffn_out, *g_final;
  float* out;
  char* ws;
};


constexpr size_t al256(size_t x) { return (x + 255) & ~(size_t)255; }
constexpr size_t O_W = 0;
constexpr size_t O_MOD = O_W + al256(2 * W_LAYER * 2);
constexpr size_t O_ROPE = O_MOD + al256((size_t)2 * 17 * 6144 * 4);
constexpr size_t O_LAM = O_ROPE + al256((size_t)T * 32 * 2 * 4);
constexpr size_t O_CTR = O_LAM + 256;
constexpr size_t O_GATES = O_CTR + 2048;
constexpr size_t O_H = O_GATES + al256((size_t)MTOT * 16 * 4);
constexpr size_t O_P = O_H + al256((size_t)MTOT * 1024 * 2);
constexpr size_t O_VTW = O_P + al256((size_t)MTOT * PW * 2);
constexpr size_t O_VTD = O_VTW + al256((size_t)NB * 2 * 64 * KEYS * 2);
constexpr size_t O_HFB = O_VTD + al256((size_t)NB * 4 * 128 * KEYS * 2);
constexpr size_t O_XC = O_HFB + al256((size_t)2 * MTOT * 512 * 2);
constexpr size_t WS_TOTAL = O_XC + al256((size_t)NCTXR * 1024 * 4) + 65536;
#define WS_W(P) reinterpret_cast<u16*>((P).ws + O_W)
#define WS_MOD(P) reinterpret_cast<float*>((P).ws + O_MOD)
#define WS_ROPE(P) reinterpret_cast<float*>((P).ws + O_ROPE)
#define WS_LAM(P) reinterpret_cast<float*>((P).ws + O_LAM)
#define WS_CTR(P) reinterpret_cast<unsigned*>((P).ws + O_CTR)
#define WS_GATES(P) reinterpret_cast<float*>((P).ws + O_GATES)
#define WS_H(P) reinterpret_cast<u16*>((P).ws + O_H)
#define WS_P(P) reinterpret_cast<u16*>((P).ws + O_P)
#define WS_VTW(P) reinterpret_cast<u16*>((P).ws + O_VTW)
#define WS_VTD(P) reinterpret_cast<u16*>((P).ws + O_VTD)
#define WS_HFB(P) reinterpret_cast<u16*>((P).ws + O_HFB)
#define WS_XC(P) reinterpret_cast<float*>((P).ws + O_XC)

DEV int my_tid() {
  int t = threadIdx.x;
  asm volatile("" : "+v"(t));
  return t;
}
typedef __bf16 bf2_t __attribute__((ext_vector_type(2)));
typedef float f2_t __attribute__((ext_vector_type(2)));
DEV uint32_t pack2(float a, float b) {
  f2_t v = {a, b};
  bf2_t r = __builtin_convertvector(v, bf2_t);
  return *reinterpret_cast<uint32_t*>(&r);
}
DEV u16 f2bf(float f) { return (u16)(pack2(f, 0.f) & 0xffffu); }
DEV float bf2f(u16 h) { return __uint_as_float(((uint32_t)h) << 16); }
DEV float bflo(uint32_t v) { return __uint_as_float(v << 16); }
DEV float bfhi(uint32_t v) { return __uint_as_float(v & 0xffff0000u); }
DEV float fexp2(float x) { return __builtin_amdgcn_exp2f(x); }
DEV float sigmoidf_(float x) { return 1.f / (1.f + __expf(-x)); }
DEV float siluf_(float x) { return x / (1.f + __expf(-x)); }
DEV float wave_sum(float v) {
#pragma unroll
  for (int o = 32; o > 0; o >>= 1) v += __shfl_xor(v, o);
  return v;
}
DEV bf16x8 ld16(const void* p) { return *reinterpret_cast<const bf16x8*>(p); }
DEV bf16x8 mk8(uint32_t a, uint32_t b, uint32_t c, uint32_t d) {
  uint4 u = make_uint4(a, b, c, d);
  return *reinterpret_cast<bf16x8*>(&u);
}
DEV f32x16 mfma32(bf16x8 a, bf16x8 b, f32x16 c) { return __builtin_amdgcn_mfma_f32_32x32x16_bf16(a, b, c, 0, 0, 0); }
DEV f32x4 mfma16(bf16x8 a, bf16x8 b, f32x4 c) { return __builtin_amdgcn_mfma_f32_16x16x32_bf16(a, b, c, 0, 0, 0); }
DEV int pi32(int r) { return (r & ~12) | ((r & 4) << 1) | ((r & 8) >> 1); }


DEV void grid_barrier(unsigned* bar, unsigned& epoch) {
  asm volatile("s_waitcnt vmcnt(0)" ::: "memory");
  __syncthreads();
  epoch += 1;
  if (my_tid() == 0) {
    __builtin_amdgcn_fence(__ATOMIC_RELEASE, "agent");
    unsigned* loc = bar + 32 + (blockIdx.x & 7) * 32;
    const unsigned per = gridDim.x >> 3;
    unsigned old = __hip_atomic_fetch_add(loc, 1u, __ATOMIC_RELAXED, __HIP_MEMORY_SCOPE_AGENT);
    if (old + 1 == per * epoch) __hip_atomic_fetch_add(bar, 1u, __ATOMIC_RELAXED, __HIP_MEMORY_SCOPE_AGENT);
    while (__hip_atomic_load(bar, __ATOMIC_RELAXED, __HIP_MEMORY_SCOPE_AGENT) < 8u * epoch) __builtin_amdgcn_s_sleep(1);
    __builtin_amdgcn_fence(__ATOMIC_ACQUIRE, "agent");
  }
  __syncthreads();
}
#define GSYNC() grid_barrier(bar, epoch)
#define GSYNC_ONLY()

template <int N>
DEV void wait_vm() { asm volatile("s_waitcnt vmcnt(%0)" ::"n"(N) : "memory"); }

template <int MI, int NI>
DEV void gemm_mainloop(const u16* __restrict__ A, int lda, const u16* __restrict__ Bt, int ldb, int K,
                       f32x4 (&acc)[MI][NI], char* smem) {
  constexpr int BM = 32 * MI, BN = 64 * NI;
  constexpr int NA = BM * 4 / NTHREADS, NBL = BN * 4 / NTHREADS;
  constexpr int ABYTES = BM * 64, BBYTES = BN * 64, SBYTES = ABYTES + BBYTES;
  constexpr int NL = NA + NBL;
  const int tid = my_tid(), lane = tid & 63, wid = tid >> 6, wr = wid >> 2, wc = wid & 3, fr = lane & 15, fq = lane >> 4;
  const int nk = K / 32;
  auto stage = [&](int kt) {
    char* base = smem + (kt & 3) * SBYTES;
#pragma unroll
    for (int i = 0; i < NA; ++i) {
      int id = tid + i * NTHREADS, r = id >> 2, c = (id & 3) ^ (((r >> 3) & 1) * 3);
      __builtin_amdgcn_global_load_lds((const unsigned*)(A + (size_t)r * lda + kt * 32 + c * 8), (unsigned*)(base + id * 16), 16, 0, 0);
    }
#pragma unroll
    for (int i = 0; i < NBL; ++i) {
      int id = tid + i * NTHREADS, r = id >> 2, c = (id & 3) ^ (((r >> 3) & 1) * 3);
      __builtin_amdgcn_global_load_lds((const unsigned*)(Bt + (size_t)r * ldb + kt * 32 + c * 8), (unsigned*)(base + ABYTES + id * 16), 16, 0, 0);
    }
  };
  wait_vm<0>();
  __syncthreads();
  stage(0);
  if (nk > 1) stage(1);
  if (nk > 2) stage(2);
  for (int kt = 0; kt < nk; ++kt) {
    if (kt + 2 < nk) wait_vm<2 * NL>();
    else if (kt + 1 < nk) wait_vm<NL>();
    else wait_vm<0>();
    asm volatile("" ::: "memory");
    __builtin_amdgcn_s_barrier();
    asm volatile("" ::: "memory");
    const char* As = smem + (kt & 3) * SBYTES;
    const char* Bs = As + ABYTES;
    bf16x8 bfr[NI], af[MI];
#pragma unroll
    for (int ni = 0; ni < NI; ++ni) {
      int r = wc * (NI * 16) + ni * 16 + fr;
      bfr[ni] = ld16(Bs + r * 64 + ((fq ^ (((r >> 3) & 1) * 3)) << 4));
    }
#pragma unroll
    for (int mi = 0; mi < MI; ++mi) {
      int r = wr * (MI * 16) + mi * 16 + fr;
      af[mi] = ld16(As + r * 64 + ((fq ^ (((r >> 3) & 1) * 3)) << 4));
    }
    if (kt + 3 < nk) stage(kt + 3);
    __builtin_amdgcn_sched_barrier(0);
    __builtin_amdgcn_s_setprio(1);
#pragma unroll
    for (int mi = 0; mi < MI; ++mi)
#pragma unroll
      for (int ni = 0; ni < NI; ++ni) acc[mi][ni] = mfma16(af[mi], bfr[ni], acc[mi][ni]);
    __builtin_amdgcn_s_setprio(0);
    __builtin_amdgcn_sched_barrier(0);
  }
}

template <int MI, int NI>
DEV void zero_acc(f32x4 (&acc)[MI][NI]) {
#pragma unroll
  for (int mi = 0; mi < MI; ++mi)
#pragma unroll
    for (int ni = 0; ni < NI; ++ni) acc[mi][ni] = f32x4{0.f, 0.f, 0.f, 0.f};
}


DEV void tile_coords(int tile, int total, int nN, int& tm, int& tn) {
  int t = tile;
  if (gridDim.x == 256 && tile < (total & ~255)) {
    int j = tile & 255;
    t = (tile & ~255) + (j & 7) * 32 + (j >> 3);
  }
  int p = t / (4 * nN), q = t - p * (4 * nN);
  tn = q >> 2;
  tm = p * 4 + (q & 3);
}

template <int MI, class Epi>
DEV void gemm_phase(const u16* A, int lda, const u16* Bt, int ldb, int M, int N, int K, Epi epi, char* smem) {
  constexpr int BM = 32 * MI;
  const int nM = M / BM, nN = N / 256;
  const int wid = my_tid() >> 6, wr = wid >> 2, wc = wid & 3;
  for (int tile = blockIdx.x; tile < nM * nN; tile += gridDim.x) {
    int tm, tn;
    tile_coords(tile, nM * nN, nN, tm, tn);
    f32x4 acc[MI][4];
    zero_acc<MI, 4>(acc);
    gemm_mainloop<MI, 4>(A + (size_t)tm * BM * lda, lda, Bt + (size_t)tn * 256 * ldb, ldb, K, acc, smem);
    epi(acc, tm * BM + wr * (MI * 16), tn * 256 + wc * 64);
  }
}

DEV int map_col(int type, int n) {
  if (type == 0) {
    if (n < 2048) return n;
    if (n < 2688) return n + 16;
    if (n < 3712) return n + 144;
    if (n < 3840) return n - 1008;
    if (n < 4352) return n + 16;
    if (n < 4368) return n - 2304;
    return -1;
  }
  if (type == 1) return n + 4368;
  if (type == 2) return n;
  int q = n >> 5, r = n & 31;
  return r < 16 ? (q * 16 + r) : (FH + q * 16 + r - 16);
}

DEV void tr_tile(const float* __restrict__ src, int ldsrc, u16* __restrict__ dst, int K, int n0, int k0, int type, char* smem) {
  float* tile = reinterpret_cast<float*>(smem);
  const int tid = my_tid();
  {
    int n = tid & 63, sc = map_col(type, n0 + n);
#pragma unroll
    for (int i = 0; i < 8; ++i) {
      int k = (tid >> 6) + 8 * i;
      tile[k * 65 + n] = sc >= 0 ? src[(size_t)(k0 + k) * ldsrc + sc] : 0.f;
    }
  }
  __syncthreads();
  {
    int n = tid >> 3, kc = tid & 7;
    uint32_t w[4];
#pragma unroll
    for (int j = 0; j < 4; ++j) w[j] = pack2(tile[(kc * 8 + 2 * j) * 65 + n], tile[(kc * 8 + 2 * j + 1) * 65 + n]);
    *reinterpret_cast<uint4*>(dst + (size_t)(n0 + n) * K + k0 + kc * 8) = make_uint4(w[0], w[1], w[2], w[3]);
  }
  __syncthreads();
}

DEV void phase_prologue(const Params& P, char* smem) {
  const int tid = my_tid();
  constexpr int TPL = 4672;
  for (int it = blockIdx.x; it < 2 * TPL; it += gridDim.x) {
    int l = it / TPL, t = it % TPL;
    u16* Wl = WS_W(P) + (size_t)l * W_LAYER;
    if (t < 1152) {
      tr_tile(P.w_in + (size_t)l * 1024 * INW, INW, Wl + W_IN, 1024, (t / 16) * 64, (t % 16) * 64, 0, smem);
    } else if (t < 1920) {
      t -= 1152;
      tr_tile(P.w_in + (size_t)l * 1024 * INW, INW, Wl + W_G, 1024, (t / 16) * 64, (t % 16) * 64, 1, smem);
    } else if (t < 2304) {
      t -= 1920;
      int i = t / 128;
      t %= 128;
      tr_tile(P.w_branch + ((size_t)l * 3 + i) * 512 * 1024, 1024, Wl + W_B + (size_t)i * 1024 * 512, 512, (t / 8) * 64, (t % 8) * 64, 2, smem);
    } else if (t < 2560) {
      t -= 2304;
      tr_tile(P.w_out + (size_t)l * 1024 * 1024, 1024, Wl + W_O, 1024, (t / 16) * 64, (t % 16) * 64, 2, smem);
    } else if (t < 3968) {
      t -= 2560;
      tr_tile(P.w_ffn_in + (size_t)l * 1024 * 5632, 5632, Wl + W_FI, 1024, (t / 16) * 64, (t % 16) * 64, 3, smem);
    } else {
      t -= 3968;
      tr_tile(P.w_ffn_out + (size_t)l * FH * 1024, 1024, Wl + W_FO, FH, (t / 44) * 64, (t % 44) * 64, 2, smem);
    }
  }
  for (int it = blockIdx.x; it < 384; it += gridDim.x) {
    int l = it / 192, n0 = (it % 192) * 32;
    float* sc = reinterpret_cast<float*>(smem);
    float* red = sc + 17 * 1024;
    __syncthreads();
    for (int idx = tid; idx < 17 * 1024; idx += NTHREADS) {
      int cond = idx >> 10, k = idx & 1023;
      float cv = cond < 16 ? P.c[cond * 1024 + k] : P.c_ctx[k];
      sc[idx] = siluf_(cv);
    }
    __syncthreads();
    int col = tid & 31, ks = tid >> 5;
    float acc[17];
#pragma unroll
    for (int j = 0; j < 17; ++j) acc[j] = 0.f;
    const float* wm = P.w_mod + (size_t)l * 1024 * 6144 + n0 + col;
    for (int k = ks * 64; k < ks * 64 + 64; ++k) {
      float w = wm[(size_t)k * 6144];
#pragma unroll
      for (int j = 0; j < 17; ++j) acc[j] += sc[j * 1024 + k] * w;
    }
#pragma unroll
    for (int j = 0; j < 17; ++j) red[(ks * 17 + j) * 32 + col] = acc[j];
    __syncthreads();
    for (int o = tid; o < 17 * 32; o += NTHREADS) {
      int j = o >> 5, cc = o & 31;
      float s = 0.f;
      for (int q = 0; q < 16; ++q) s += red[(q * 17 + j) * 32 + cc];
      WS_MOD(P)[((size_t)l * 17 + j) * 6144 + n0 + cc] = s + P.b_mod[l * 6144 + n0 + cc];
    }
  }
  for (int idx = blockIdx.x * NTHREADS + tid; idx < T * 32; idx += gridDim.x * NTHREADS) {
    int t = idx >> 5, j = idx & 31;
    int pos = j < 16 ? (t >> 6) : (t & 63);
    float inv = powf(10000.f, -(float)(j & 15) / 16.f);
    float ang = (float)pos * inv;
    WS_ROPE(P)[idx * 2] = cosf(ang);
    WS_ROPE(P)[idx * 2 + 1] = sinf(ang);
  }
  for (int idx = blockIdx.x * NTHREADS + tid; idx < NCTXR * 1024 / 4; idx += gridDim.x * NTHREADS)
    reinterpret_cast<float4*>(WS_XC(P))[idx] = reinterpret_cast<const float4*>(P.ctx)[idx];
  if (blockIdx.x == 0 && tid < 64) {
    for (int l = 0; l < 2; ++l) {
      float a = wave_sum(P.lam_q1[l * 64 + tid] * P.lam_k1[l * 64 + tid]);
      float b = wave_sum(P.lam_q2[l * 64 + tid] * P.lam_k2[l * 64 + tid]);
      float lam_init = 0.8f - 0.6f * expf(-0.3f * (float)l);
      if (tid == 0) WS_LAM(P)[l] = expf(a) - expf(b) + lam_init;
    }
    if (tid < 8) WS_CTR(P)[tid] = 0u;
  }
}

DEV void phase_norm_mod(const Params& P, const float* xlat, const float* xctx, int nrows, const float* g,
                        const float* modl, int sh_off, int sc_off) {
  const int lane = my_tid() & 63, wid = my_tid() >> 6;
  for (int row = blockIdx.x * 8 + wid; row < nrows; row += gridDim.x * 8) {
    const float* src = row < NLAT ? xlat + (size_t)row * 1024 : xctx + (size_t)(row - NLAT) * 1024;
    int cond = row < NLAT ? row >> 12 : 16;
    const float* md = modl + (size_t)cond * 6144;
    float4 v[4];
    float ss = 0.f;
#pragma unroll
    for (int i = 0; i < 4; ++i) {
      v[i] = *reinterpret_cast<const float4*>(src + i * 256 + lane * 4);
      ss += v[i].x * v[i].x + v[i].y * v[i].y + v[i].z * v[i].z + v[i].w * v[i].w;
    }
    ss = wave_sum(ss);
    float rstd = rsqrtf(ss * (1.f / 1024.f) + EPS);
#pragma unroll
    for (int i = 0; i < 4; ++i) {
      int cb = i * 256 + lane * 4;
      float4 gg = *reinterpret_cast<const float4*>(g + cb);
      float4 sh = *reinterpret_cast<const float4*>(md + sh_off + cb);
      float4 sc = *reinterpret_cast<const float4*>(md + sc_off + cb);
      float y0 = v[i].x * rstd * gg.x * (1.f + sc.x) + sh.x;
      float y1 = v[i].y * rstd * gg.y * (1.f + sc.y) + sh.y;
      float y2 = v[i].z * rstd * gg.z * (1.f + sc.z) + sh.z;
      float y3 = v[i].w * rstd * gg.w * (1.f + sc.w) + sh.w;
      *reinterpret_cast<uint2*>(WS_H(P) + (size_t)row * 1024 + cb) = make_uint2(pack2(y0, y1), pack2(y2, y3));
    }
  }
}

DEV void phase_final_norm(const Params& P) {
  const int lane = my_tid() & 63, wid = my_tid() >> 6;
  for (int row = blockIdx.x * 8 + wid; row < NLAT; row += gridDim.x * 8) {
    float* src = P.out + (size_t)row * 1024;
    float4 v[4];
    float ss = 0.f;
#pragma unroll
    for (int i = 0; i < 4; ++i) {
      v[i] = *reinterpret_cast<const float4*>(src + i * 256 + lane * 4);
      ss += v[i].x * v[i].x + v[i].y * v[i].y + v[i].z * v[i].z + v[i].w * v[i].w;
    }
    ss = wave_sum(ss);
    float rstd = rsqrtf(ss * (1.f / 1024.f) + EPS);
#pragma unroll
    for (int i = 0; i < 4; ++i) {
      int cb = i * 256 + lane * 4;
      float4 gg = *reinterpret_cast<const float4*>(P.g_final + cb);
      float4 o = make_float4(v[i].x * rstd * gg.x, v[i].y * rstd * gg.y, v[i].z * rstd * gg.z, v[i].w * rstd * gg.w);
      *reinterpret_cast<float4*>(src + cb) = o;
    }
  }
}

struct EpiInProj {
  const Params& P;
  int l;
  DEV void operator()(f32x4 (&acc)[8][4], int row0, int col0) const {
    const int lane = my_tid() & 63, fr = lane & 15, fq = lane >> 4;
    if (col0 >= 4416) return;
    if (col0 < C_WQ) {
#pragma unroll
      for (int mi = 0; mi < 8; ++mi)
#pragma unroll
        for (int ni = 0; ni < 4; ++ni)
#pragma unroll
          for (int j = 0; j < 4; ++j)
            WS_P(P)[(size_t)(row0 + mi * 16 + fq * 4 + j) * PW + col0 + ni * 16 + fr] = f2bf(acc[mi][ni][j]);
    } else if (col0 < 3712) {
      const bool isq = (col0 < C_WK) || (col0 >= C_DQ && col0 < C_DK);
      const float qs = isq ? 0.125f : 1.f;
#pragma unroll
      for (int mi = 0; mi < 8; ++mi)
#pragma unroll
        for (int j = 0; j < 4; ++j) {
          int row = row0 + mi * 16 + fq * 4 + j;
          u16* dst = WS_P(P) + (size_t)row * PW + col0 + fr;
          if (row < NLAT) {
            int t = row & (T - 1);
            const float2* rt = reinterpret_cast<const float2*>(WS_ROPE(P)) + t * 32;
#pragma unroll
            for (int hf = 0; hf < 2; ++hf) {
              float2 cs = rt[hf * 16 + fr];
              float x1 = acc[mi][hf * 2][j], x2 = acc[mi][hf * 2 + 1][j];
              dst[hf * 32] = f2bf((x1 * cs.x - x2 * cs.y) * qs);
              dst[hf * 32 + 16] = f2bf((x2 * cs.x + x1 * cs.y) * qs);
            }
          } else {
#pragma unroll
            for (int ni = 0; ni < 4; ++ni) dst[ni * 16] = f2bf(acc[mi][ni][j] * qs);
          }
        }
    } else if (col0 < 4352) {
      u16* base;
      int vrow0;
      const int hdW = (col0 - 3712) >> 6;
      const int hdD = (col0 - 3840) >> 7;
      const bool isw = col0 < 3840;
#pragma unroll
      for (int mi = 0; mi < 8; ++mi) {
        int row = row0 + mi * 16 + fq * 4;
        int b, key;
        if (row < NLAT) { b = row >> 12; key = 256 + (row & (T - 1)); }
        else { b = (row - NLAT) >> 8; key = (row - NLAT) & 255; }
        if (isw) { base = WS_VTW(P) + ((size_t)(b * 2 + hdW) * 64) * KEYS; vrow0 = 0; }
        else { base = WS_VTD(P) + ((size_t)(b * 4 + hdD) * 128) * KEYS; vrow0 = (col0 - 3840) & 127; }
#pragma unroll
        for (int ni = 0; ni < 4; ++ni) {
          int v = vrow0 + ni * 16 + fr;
          *reinterpret_cast<uint2*>(base + (size_t)v * KEYS + key) =
              make_uint2(pack2(acc[mi][ni][0], acc[mi][ni][1]), pack2(acc[mi][ni][2], acc[mi][ni][3]));
        }
      }
    } else {
      float bg = P.b_gate[l * 16 + fr];
#pragma unroll
      for (int mi = 0; mi < 8; ++mi)
#pragma unroll
        for (int j = 0; j < 4; ++j) WS_GATES(P)[(size_t)(row0 + mi * 16 + fq * 4 + j) * 16 + fr] = acc[mi][0][j] + bg;
    }
  }
};

template <int QB, int VB, int KW>
struct AttnCore {
  static constexpr int DV = 32 * VB;
  static constexpr int KST = KW * 2 + 16;
  static constexpr int VST = 128 + 16;
  static constexpr int KBYTES = 64 * KST, VBYTES = DV * VST;
  static constexpr int NKL = 64 * (KW / 8) / NTHREADS, NVL = DV * 8 / NTHREADS;
  static constexpr int TOTAL = 2 * (KBYTES + VBYTES);

  static DEV void run(const u16* qptr, int ldq, const u16* kctx, const u16* klat, int ldk, int kcol, const u16* vt,
                      int nctx, int nlat, int lat_t0, bool window, int qtok0, float m_init, float l_init,
                      f32x16 (&O)[QB][VB], char* smem) {
    const int tid = my_tid(), lane = tid & 63, r = lane & 31, hh = lane >> 5;
    char* Ks = smem;
    char* Vs = smem + 2 * KBYTES;
    bf16x8 qf[QB][4];
#pragma unroll
    for (int qb = 0; qb < QB; ++qb)
#pragma unroll
      for (int ks = 0; ks < 4; ++ks) qf[qb][ks] = ld16(qptr + (size_t)(qb * 32 + r) * ldq + ks * 16 + hh * 8);
    float m[QB], lsum[QB];
#pragma unroll
    for (int qb = 0; qb < QB; ++qb) {
      m[qb] = m_init;
      lsum[qb] = hh == 0 ? l_init : 0.f;
#pragma unroll
      for (int vb = 0; vb < VB; ++vb)
#pragma unroll
        for (int i = 0; i < 16; ++i) O[qb][vb][i] = 0.f;
    }
    bf16x8 rk[NKL], rv[NVL];
    const int ntiles = nctx + nlat;
    auto gload = [&](int j) {
      int kidx = j < nctx ? j * 64 : 256 + lat_t0 + (j - nctx) * 64;
      const u16* krow = j < nctx ? kctx + (size_t)(j * 64) * ldk : klat + (size_t)(lat_t0 + (j - nctx) * 64) * ldk;
#pragma unroll
      for (int i = 0; i < NKL; ++i) {
        int id = tid + i * NTHREADS, row = id / (KW / 8), c = id % (KW / 8);
        rk[i] = ld16(krow + (size_t)row * ldk + c * 8);
      }
#pragma unroll
      for (int i = 0; i < NVL; ++i) {
        int id = tid + i * NTHREADS, row = id >> 3, c = id & 7;
        rv[i] = ld16(vt + (size_t)row * KEYS + kidx + c * 8);
      }
    };
    auto lstore = [&](int buf) {
#pragma unroll
      for (int i = 0; i < NKL; ++i) {
        int id = tid + i * NTHREADS, row = id / (KW / 8), c = id % (KW / 8);
        *reinterpret_cast<bf16x8*>(Ks + buf * KBYTES + row * KST + c * 16) = rk[i];
      }
#pragma unroll
      for (int i = 0; i < NVL; ++i) {
        int id = tid + i * NTHREADS, row = id >> 3, c = id & 7;
        *reinterpret_cast<bf16x8*>(Vs + buf * VBYTES + row * VST + c * 16) = rv[i];
      }
    };
    __syncthreads();
    gload(0);
    lstore(0);
    __syncthreads();
    for (int j = 0; j < ntiles; ++j) {
      const int buf = j & 1;
      if (j + 1 < ntiles) gload(j + 1);
      bf16x8 pf[QB][2][2];
#pragma unroll
      for (int qb = 0; qb < QB; ++qb) {
        f32x16 S[2];
#pragma unroll
        for (int kb = 0; kb < 2; ++kb) {
#pragma unroll
          for (int i = 0; i < 16; ++i) S[kb][i] = 0.f;
#pragma unroll
          for (int ks = 0; ks < 4; ++ks) {
            bf16x8 kf = ld16(Ks + buf * KBYTES + (kb * 32 + pi32(r)) * KST + (kcol + ks * 16 + hh * 8) * 2);
            S[kb] = mfma32(kf, qf[qb][ks], S[kb]);
          }
        }
        __builtin_amdgcn_sched_barrier(0);
        if (window && j >= nctx) {
          int kt0 = lat_t0 + (j - nctx) * 64;
          int qt = qtok0 + qb * 32 + r;
#pragma unroll
          for (int kb = 0; kb < 2; ++kb)
#pragma unroll
            for (int i = 0; i < 16; ++i) {
              int kt = kt0 + kb * 32 + 16 * (i >> 3) + 8 * hh + (i & 7);
              int dlt = qt - kt;
              if (dlt > 128 || dlt < -128) S[kb][i] = -1e30f;
            }
        }
        float mloc = -1e30f;
#pragma unroll
        for (int kb = 0; kb < 2; ++kb)
#pragma unroll
          for (int i = 0; i < 16; ++i) mloc = fmaxf(mloc, S[kb][i]);
        mloc = fmaxf(mloc, __shfl_xor(mloc, 32));
        if (__any(mloc > m[qb] + 5.5f)) {
          float mnew = fmaxf(m[qb], mloc);
          float alpha = fexp2((m[qb] - mnew) * L2E);
          m[qb] = mnew;
          lsum[qb] *= alpha;
#pragma unroll
          for (int vb = 0; vb < VB; ++vb)
#pragma unroll
            for (int i = 0; i < 16; ++i) O[qb][vb][i] *= alpha;
        }
        float mb = m[qb] * L2E, ps = 0.f;
#pragma unroll
        for (int kb = 0; kb < 2; ++kb) {
          float pv[16];
#pragma unroll
          for (int i = 0; i < 16; ++i) {
            pv[i] = fexp2(S[kb][i] * L2E - mb);
            ps += pv[i];
          }
#pragma unroll
          for (int s = 0; s < 2; ++s)
            pf[qb][kb][s] = mk8(pack2(pv[8 * s], pv[8 * s + 1]), pack2(pv[8 * s + 2], pv[8 * s + 3]),
                                pack2(pv[8 * s + 4], pv[8 * s + 5]), pack2(pv[8 * s + 6], pv[8 * s + 7]));
        }
        lsum[qb] += ps;
        __builtin_amdgcn_sched_barrier(0);
      }
      __builtin_amdgcn_sched_barrier(0);
#pragma unroll
      for (int vb = 0; vb < VB; ++vb) {
#pragma unroll
        for (int kb = 0; kb < 2; ++kb)
#pragma unroll
          for (int s = 0; s < 2; ++s) {
            bf16x8 vf = ld16(Vs + buf * VBYTES + (vb * 32 + r) * VST + (kb * 32 + s * 16 + hh * 8) * 2);
#pragma unroll
            for (int qb = 0; qb < QB; ++qb) O[qb][vb] = mfma32(vf, pf[qb][kb][s], O[qb][vb]);
          }
        __builtin_amdgcn_sched_barrier(0);
      }
      if (j + 1 < ntiles) lstore(buf ^ 1);
      __syncthreads();
    }
#pragma unroll
    for (int qb = 0; qb < QB; ++qb) {
      float lt = lsum[qb] + __shfl_xor(lsum[qb], 32);
      float inv = 1.f / lt;
#pragma unroll
      for (int vb = 0; vb < VB; ++vb)
#pragma unroll
        for (int i = 0; i < 16; ++i) O[qb][vb][i] *= inv;
    }
  }
};

DEV void diff_item(const Params& P, int l, int b, int h, int qt, bool ctxq, char* smem) {
  const int tid = my_tid(), lane = tid & 63, wid = tid >> 6, r = lane & 31, hh = lane >> 5;
  const int comp = wid >> 2, wq = wid & 3;
  const int rowbase = ctxq ? NLAT + b * 256 + qt * 128 : b * T + qt * 128;
  const u16* qptr = WS_P(P) + (size_t)(rowbase + wq * 32) * PW + C_DQ + h * 128 + comp * 64;
  const u16* kctx = WS_P(P) + (size_t)(NLAT + b * 256) * PW + C_DK + h * 128;
  const u16* klat = WS_P(P) + (size_t)(b * T) * PW + C_DK + h * 128;
  const u16* vt = WS_VTD(P) + ((size_t)(b * 4 + h) * 128) * KEYS;
  f32x16 O[1][4];
  AttnCore<1, 4, 128>::run(qptr, PW, kctx, klat, PW, comp * 64, vt, 4, ctxq ? 0 : 64, 0, false, 0, -1e30f, 0.f, O, smem);
  float* ex = reinterpret_cast<float*>(smem);
  __syncthreads();
  if (comp == 1) {
#pragma unroll
    for (int vb = 0; vb < 4; ++vb)
#pragma unroll
      for (int i = 0; i < 16; ++i) ex[(wq * 64 + vb * 16 + i) * 64 + lane] = O[0][vb][i];
  }
  __syncthreads();
  if (comp == 0) {
    const float lam = WS_LAM(P)[l];
    const float lam_init = 0.8f - 0.6f * expf(-0.3f * (float)l);
    float ss = 0.f;
#pragma unroll
    for (int vb = 0; vb < 4; ++vb)
#pragma unroll
      for (int i = 0; i < 16; ++i) {
        float y = O[0][vb][i] - lam * ex[(wq * 64 + vb * 16 + i) * 64 + lane];
        O[0][vb][i] = y;
        ss += y * y;
      }
    ss += __shfl_xor(ss, 32);
    float sc = rsqrtf(ss * (1.f / 128.f) + EPS) * (1.f - lam_init);
    const float* dn = P.d_norm + l * 512 + h * 128;
    u16* dst = WS_P(P) + (size_t)(rowbase + wq * 32 + r) * PW + C_DQ + h * 128;
#pragma unroll
    for (int vb = 0; vb < 4; ++vb)
#pragma unroll
      for (int g4 = 0; g4 < 4; ++g4) {
        int v = vb * 32 + g4 * 8 + hh * 4;
        float4 w = *reinterpret_cast<const float4*>(dn + v);
        *reinterpret_cast<uint2*>(dst + v) =
            make_uint2(pack2(O[0][vb][g4 * 4] * sc * w.x, O[0][vb][g4 * 4 + 1] * sc * w.y),
                       pack2(O[0][vb][g4 * 4 + 2] * sc * w.z, O[0][vb][g4 * 4 + 3] * sc * w.w));
      }
  }
  __syncthreads();
}

DEV void win_item(const Params& P, int l, int b, int g, int qb, bool ctxq, char* smem) {
  const int tid = my_tid(), lane = tid & 63, wid = tid >> 6, r = lane & 31, hh = lane >> 5;
  const int hr = wid >> 1, qh = wid & 1;
  const int head = g * 4 + hr;
  const int rowbase = (ctxq ? NLAT + b * 256 + qb * 64 : b * T + qb * 64) + qh * 32;
  const u16* qptr = WS_P(P) + (size_t)rowbase * PW + C_WQ + head * 64;
  const u16* kctx = WS_P(P) + (size_t)(NLAT + b * 256) * PW + C_WK + g * 64;
  const u16* klat = WS_P(P) + (size_t)(b * T) * PW + C_WK + g * 64;
  const u16* vt = WS_VTW(P) + ((size_t)(b * 2 + g) * 64) * KEYS;
  int t0 = 0, nlat = 0;
  if (!ctxq) {
    t0 = qb * 64 - 128;
    if (t0 < 0) t0 = 0;
    int t1 = qb * 64 + 192;
    if (t1 > T) t1 = T;
    nlat = (t1 - t0) >> 6;
  }
  f32x16 O[1][2];
  AttnCore<1, 2, 64>::run(qptr, PW, kctx, klat, PW, 0, vt, 4, nlat, t0, !ctxq, qb * 64 + qh * 32, P.sink[l * 8 + head], 1.f, O, smem);
  u16* dst = WS_P(P) + (size_t)(rowbase + r) * PW + C_WQ + head * 64;
#pragma unroll
  for (int vb = 0; vb < 2; ++vb)
#pragma unroll
    for (int g4 = 0; g4 < 4; ++g4) {
      int v = vb * 32 + g4 * 8 + hh * 4;
      *reinterpret_cast<uint2*>(dst + v) = make_uint2(pack2(O[0][vb][g4 * 4], O[0][vb][g4 * 4 + 1]),
                                                        pack2(O[0][vb][g4 * 4 + 2], O[0][vb][g4 * 4 + 3]));
    }
}

DEV void mlstm_item(const Params& P, int l, int b, int hd, int dir, bool need_ctx, char* smem) {
  const int tid = my_tid(), lane = tid & 63, wid = tid >> 6, r = lane & 31, hh = lane >> 5;
  constexpr int QST = 272, TST = 144;
  char* Qs = smem;
  char* Ks = Qs + 64 * QST;
  char* KwT = Ks + 64 * QST;
  char* VT = KwT + 128 * TST;
  char* Sp = VT + 128 * TST;
  char* Rq = Sp + 64 * TST;
  char* Rk = Rq + 66 * QST;
  float* fb = reinterpret_cast<float*>(Rk + 66 * QST);
  float* sb = fb;
  float* sa = fb + 64;
  float* sM = fb + 128;
  float* denp = fb + 192;
  float* qn = fb + 320;
  float* nb = fb + 384;
  float* cw = fb + 640;
  __syncthreads();
  if (tid < 256) nb[tid] = 0.f;
  for (int i = tid; i < 768; i += NTHREADS) {
    int qk = i / 384, tap = (i % 384) / 128, d = i & 127;
    cw[i] = P.conv_w[(size_t)l * 3 * 1024 + tap * 1024 + qk * 512 + hd * 128 + d];
  }
  f32x16 CT[4];
#pragma unroll
  for (int kb = 0; kb < 4; ++kb)
#pragma unroll
    for (int i = 0; i < 16; ++i) CT[kb][i] = 0.f;
  float mstate = 0.f;
  u16* hout = WS_HFB(P) + (size_t)dir * MTOT * 512;
  const float kscale = 0.08838834764831845f;

  for (int step = 0; step < 68; ++step) {
    int seg0, seglen, c;
    if (step < 4) { seg0 = NLAT + b * 256; seglen = 256; c = dir ? 3 - step : step; }
    else { seg0 = b * T; seglen = T; c = dir ? 67 - step : step - 4; }
    const int u0 = c * 64;
    const int rowbase = seg0 + u0;
    const int cur = step & 1;
    __syncthreads();
    bf16x8 rvv[2];
#pragma unroll
    for (int i = 0; i < 3; ++i) {
      int id = tid + i * NTHREADS;
      if (id < 66 * 16) {
        int row = id >> 4, cc = id & 15;
        int uu = u0 + row - 1;
        bool ok = uu >= 0 && uu < seglen;
        const u16* src = WS_P(P) + (size_t)(seg0 + (ok ? uu : 0)) * PW + hd * 128 + cc * 8;
        bf16x8 z = {0, 0, 0, 0, 0, 0, 0, 0};
        bf16x8 a = ok ? ld16(src + C_MQ) : z;
        bf16x8 bq = ok ? ld16(src + C_MK) : z;
        *reinterpret_cast<bf16x8*>(Rq + row * QST + cc * 16) = a;
        *reinterpret_cast<bf16x8*>(Rk + row * QST + cc * 16) = bq;
      }
    }
#pragma unroll
    for (int i = 0; i < 2; ++i) {
      int id = tid + i * NTHREADS, u = id >> 4, cc = id & 15;
      rvv[i] = ld16(WS_P(P) + (size_t)(rowbase + u) * PW + C_MV + hd * 128 + cc * 8);
    }
    if (wid == 0) {
      const int pos = dir ? 63 - lane : lane;
      const float* gp = WS_GATES(P) + (size_t)(rowbase + pos) * 16;
      float ig = gp[(dir * 2) * 4 + hd], fg = gp[(dir * 2 + 1) * 4 + hd];
      float lf = fminf(fg, 0.f) - log1pf(__expf(-fabsf(fg)));
      float bsum = lf;
#pragma unroll
      for (int o = 1; o < 64; o <<= 1) { float t2 = __shfl_up(bsum, o); if (lane >= o) bsum += t2; }
      float a = ig - bsum, am = a;
#pragma unroll
      for (int o = 1; o < 64; o <<= 1) { float t2 = __shfl_up(am, o); if (lane >= o) am = fmaxf(am, t2); }
      sb[pos] = bsum;
      sa[pos] = a;
      sM[pos] = fmaxf(mstate, am);
    }
    __syncthreads();
    const int eidx = dir ? 0 : 63;
    const float Mend = sM[eidx], bend = sb[eidx];
    const float decay = __expf(mstate - Mend);
#pragma unroll 1
    for (int i = 0; i < 2; ++i) {
      int id = tid + i * NTHREADS, u = id >> 4, cc = id & 15;
      float wend = __expf(sa[u] - Mend);
      uint32_t qo[4], ko[4];
      float kv[8];
      bf16x8 q0 = ld16(Rq + (u)*QST + cc * 16), q1 = ld16(Rq + (u + 1) * QST + cc * 16), q2 = ld16(Rq + (u + 2) * QST + cc * 16);
      bf16x8 k0 = ld16(Rk + (u)*QST + cc * 16), k1 = ld16(Rk + (u + 1) * QST + cc * 16), k2 = ld16(Rk + (u + 2) * QST + cc * 16);
#pragma unroll
      for (int e = 0; e < 8; ++e) {
        int d = cc * 8 + e;
        float xq = cw[0 * 128 + d] * bf2f((u16)q0[e]) + cw[1 * 128 + d] * bf2f((u16)q1[e]) + cw[2 * 128 + d] * bf2f((u16)q2[e]);
        float xk = cw[384 + 0 * 128 + d] * bf2f((u16)k0[e]) + cw[384 + 1 * 128 + d] * bf2f((u16)k1[e]) + cw[384 + 2 * 128 + d] * bf2f((u16)k2[e]);
        float qv = siluf_(xq);
        kv[e] = siluf_(xk) * kscale;
        if (e & 1) { qo[e >> 1] |= ((uint32_t)f2bf(qv)) << 16; ko[e >> 1] |= ((uint32_t)f2bf(kv[e])) << 16; }
        else { qo[e >> 1] = f2bf(qv); ko[e >> 1] = f2bf(kv[e]); }
        *reinterpret_cast<u16*>(KwT + (d)*TST + u * 2) = f2bf(kv[e] * wend);
        *reinterpret_cast<u16*>(VT + (d)*TST + u * 2) = (u16)rvv[i][e];
      }
      *reinterpret_cast<uint4*>(Qs + u * QST + cc * 16) = make_uint4(qo[0], qo[1], qo[2], qo[3]);
      *reinterpret_cast<uint4*>(Ks + u * QST + cc * 16) = make_uint4(ko[0], ko[1], ko[2], ko[3]);
    }
    __syncthreads();
    if (wid < 4) {
      const int sblk = wid & 1, tblk = wid >> 1;
      f32x16 S;
#pragma unroll
      for (int i = 0; i < 16; ++i) S[i] = 0.f;
#pragma unroll
      for (int ks = 0; ks < 8; ++ks) {
        bf16x8 kf = ld16(Ks + (sblk * 32 + pi32(r)) * QST + (ks * 16 + hh * 8) * 2);
        bf16x8 qf = ld16(Qs + (tblk * 32 + r) * QST + (ks * 16 + hh * 8) * 2);
        S = mfma32(kf, qf, S);
      }
      const int t = tblk * 32 + r;
      const float Mt = sM[t];
      float ds = 0.f, val[16];
#pragma unroll
      for (int i = 0; i < 16; ++i) {
        int s = sblk * 32 + 16 * (i >> 3) + 8 * hh + (i & 7);
        bool ok = dir ? (s >= t) : (s <= t);
        val[i] = ok ? S[i] * __expf(sa[s] - Mt) : 0.f;
        ds += val[i];
      }
      ds += __shfl_xor(ds, 32);
      if (hh == 0) denp[sblk * 64 + t] = ds;
#pragma unroll
      for (int s2 = 0; s2 < 2; ++s2)
        *reinterpret_cast<uint4*>(Sp + t * TST + (sblk * 32 + s2 * 16 + hh * 8) * 2) =
            make_uint4(pack2(val[8 * s2], val[8 * s2 + 1]), pack2(val[8 * s2 + 2], val[8 * s2 + 3]),
                       pack2(val[8 * s2 + 4], val[8 * s2 + 5]), pack2(val[8 * s2 + 6], val[8 * s2 + 7]));
    } else if (wid == 4) {
      float s = 0.f;
      const float* nc = nb + cur * 128;
      for (int k8 = 0; k8 < 16; ++k8) {
        bf16x8 qv = ld16(Qs + lane * QST + k8 * 16);
#pragma unroll
        for (int e = 0; e < 8; ++e) s += nc[k8 * 8 + e] * bf2f((u16)qv[e]);
      }
      qn[lane] = s;
    } else if (wid == 5) {
      const float* nc = nb + cur * 128;
      float* nn = nb + (cur ^ 1) * 128;
#pragma unroll
      for (int q2 = 0; q2 < 2; ++q2) {
        int k = lane + q2 * 64;
        float s = 0.f;
        for (int s8 = 0; s8 < 8; ++s8) {
          bf16x8 kv = ld16(KwT + k * TST + s8 * 16);
#pragma unroll
          for (int e = 0; e < 8; ++e) s += bf2f((u16)kv[e]);
        }
        nn[k] = decay * nc[k] + s;
      }
    }
    __syncthreads();
    {
      bf16x8 vf[4];
      const int vb = wid & 3, tb = wid >> 2;
#pragma unroll
      for (int ks = 0; ks < 4; ++ks) vf[ks] = ld16(VT + (vb * 32 + r) * TST + (ks * 16 + hh * 8) * 2);
      const bool wr_h = (step >= 4) || need_ctx;
      {
        const int t = tb * 32 + r;
        f32x16 acc;
#pragma unroll
        for (int i = 0; i < 16; ++i) acc[i] = 0.f;
#pragma unroll
        for (int kb = 0; kb < 4; ++kb)
#pragma unroll
          for (int s2 = 0; s2 < 2; ++s2) {
            bf16x8 af = mk8(pack2(CT[kb][8 * s2], CT[kb][8 * s2 + 1]), pack2(CT[kb][8 * s2 + 2], CT[kb][8 * s2 + 3]),
                            pack2(CT[kb][8 * s2 + 4], CT[kb][8 * s2 + 5]), pack2(CT[kb][8 * s2 + 6], CT[kb][8 * s2 + 7]));
            uint2 lo = *reinterpret_cast<const uint2*>(Qs + t * QST + (kb * 32 + s2 * 16 + hh * 4) * 2);
            uint2 hi = *reinterpret_cast<const uint2*>(Qs + t * QST + (kb * 32 + s2 * 16 + 8 + hh * 4) * 2);
            acc = mfma32(af, mk8(lo.x, lo.y, hi.x, hi.y), acc);
          }
        const float Mt = sM[t];
        const float winter = __expf(mstate - Mt);
#pragma unroll
        for (int i = 0; i < 16; ++i) acc[i] *= winter;
#pragma unroll
        for (int ks = 0; ks < 4; ++ks) {
          bf16x8 sf = ld16(Sp + t * TST + (ks * 16 + hh * 8) * 2);
          acc = mfma32(vf[ks], sf, acc);
        }
        float den = denp[t] + denp[64 + t] + winter * qn[t];
        float sc = 1.f / fmaxf(fabsf(den), __expf(-(sb[t] + Mt)));
        if (wr_h) {
          u16* dst = hout + (size_t)(rowbase + t) * 512 + hd * 128 + vb * 32;
#pragma unroll
          for (int g4 = 0; g4 < 4; ++g4)
            *reinterpret_cast<uint2*>(dst + g4 * 8 + hh * 4) =
                make_uint2(pack2(acc[g4 * 4] * sc, acc[g4 * 4 + 1] * sc), pack2(acc[g4 * 4 + 2] * sc, acc[g4 * 4 + 3] * sc));
        }
      }
#pragma unroll
      for (int kb = 0; kb < 4; ++kb) {
#pragma unroll
        for (int i = 0; i < 16; ++i) CT[kb][i] *= decay;
#pragma unroll
        for (int ks = 0; ks < 4; ++ks) {
          bf16x8 kf = ld16(KwT + (kb * 32 + r) * TST + (ks * 16 + hh * 8) * 2);
          CT[kb] = mfma32(kf, vf[ks], CT[kb]);
        }
      }
    }
    mstate = bend + Mend;
  }
  __syncthreads();
}

DEV int next_item(unsigned* ctr, int* s_item) {
  __syncthreads();
  if (my_tid() == 0) *s_item = (int)atomicAdd(ctr, 1u);
  __syncthreads();
  return *s_item;
}
DEV void phase_mixers(const Params& P, int l, char* smem) {
  const bool need_ctx = (l == 0);
  __shared__ int s_item;
  const int n_ml = 128, n_diff = 2048, n_win = 2048, n_dc = need_ctx ? 128 : 0, n_wc = need_ctx ? 128 : 0;
  for (;;) {
    int it = next_item(&WS_CTR(P)[l * 4 + 0], &s_item);
    if (it >= n_ml) break;
    mlstm_item(P, l, it >> 3, (it >> 1) & 3, it & 1, need_ctx, smem);
  }
  for (;;) {
    int it = next_item(&WS_CTR(P)[l * 4 + 1], &s_item);
    if (it >= n_diff + n_dc) break;
    bool cq = it >= n_diff;
    int i2 = it - n_diff;
    int b = cq ? i2 >> 3 : it >> 7, hd = cq ? (i2 >> 1) & 3 : (it >> 5) & 3, qt = cq ? i2 & 1 : it & 31;
    diff_item(P, l, b, hd, qt, cq, smem);
  }
  for (;;) {
    int it = next_item(&WS_CTR(P)[l * 4 + 2], &s_item);
    if (it >= n_win + n_wc) break;
    bool cq = it >= n_win;
    int i2 = it - n_win;
    int b = cq ? i2 >> 3 : it >> 7, g = cq ? (i2 >> 2) & 1 : (it >> 6) & 1, qb = cq ? i2 & 3 : it & 63;
    win_item(P, l, b, g, qb, cq, smem);
  }
}

DEV void phase_ya(const Params& P, int l, int nrows) {
  const int lane = my_tid() & 63, wid = my_tid() >> 6;
  const u16* hf = WS_HFB(P);
  const u16* hb = WS_HFB(P) + (size_t)MTOT * 512;
  for (int row = blockIdx.x * 8 + wid; row < nrows; row += gridDim.x * 8) {
    uint4 a = *reinterpret_cast<const uint4*>(hf + (size_t)row * 512 + lane * 8);
    uint4 bq = *reinterpret_cast<const uint4*>(hb + (size_t)row * 512 + lane * 8);
    uint4 o = *reinterpret_cast<const uint4*>(WS_P(P) + (size_t)row * PW + C_MO + lane * 8);
    uint32_t aa[4] = {a.x, a.y, a.z, a.w}, bb[4] = {bq.x, bq.y, bq.z, bq.w}, oo[4] = {o.x, o.y, o.z, o.w};
    float y[8], ss = 0.f;
#pragma unroll
    for (int j = 0; j < 4; ++j) {
      y[2 * j] = (bflo(aa[j]) + bflo(bb[j])) * sigmoidf_(bflo(oo[j]));
      y[2 * j + 1] = (bfhi(aa[j]) + bfhi(bb[j])) * sigmoidf_(bfhi(oo[j]));
      ss += y[2 * j] * y[2 * j] + y[2 * j + 1] * y[2 * j + 1];
    }
#pragma unroll
    for (int of = 1; of < 16; of <<= 1) ss += __shfl_xor(ss, of);
    float rstd = rsqrtf(ss * (1.f / 128.f) + EPS);
    const float* mn = P.m_norm + l * 512 + lane * 8;
    uint32_t w[4];
#pragma unroll
    for (int j = 0; j < 4; ++j) w[j] = pack2(y[2 * j] * rstd * mn[2 * j], y[2 * j + 1] * rstd * mn[2 * j + 1]);
    *reinterpret_cast<uint4*>(WS_P(P) + (size_t)row * PW + C_MO + lane * 8) = make_uint4(w[0], w[1], w[2], w[3]);
  }
}

DEV void phase_merge(const Params& P, int l, int M, char* smem) {
  const u16* Wl = WS_W(P) + (size_t)l * W_LAYER;
  u16* merged = WS_HFB(P);
  const int nM = M / 128, nN = 4;
  const int lane = my_tid() & 63, wid = my_tid() >> 6, wr = wid >> 2, wc = wid & 3, fr = lane & 15, fq = lane >> 4;
  for (int tile = blockIdx.x; tile < nM * nN; tile += gridDim.x) {
    int tm, tn;
    tile_coords(tile, nM * nN, nN, tm, tn);
    f32x4 mg[4][4];
    zero_acc<4, 4>(mg);
#pragma unroll 1
    for (int i = 0; i < 3; ++i) {
      f32x4 acc[4][4];
      zero_acc<4, 4>(acc);
      gemm_mainloop<4, 4>(WS_H(P) + (size_t)tm * 128 * 1024, 1024, Wl + W_G + (size_t)(i * 1024 + tn * 256) * 1024, 1024, 1024, acc, smem);
      uint32_t gp[4][4][2];
#pragma unroll
      for (int mi = 0; mi < 4; ++mi)
#pragma unroll
        for (int ni = 0; ni < 4; ++ni) {
          gp[mi][ni][0] = pack2(sigmoidf_(acc[mi][ni][0]), sigmoidf_(acc[mi][ni][1]));
          gp[mi][ni][1] = pack2(sigmoidf_(acc[mi][ni][2]), sigmoidf_(acc[mi][ni][3]));
        }
      zero_acc<4, 4>(acc);
      int yc = i == 0 ? C_MO : (i == 1 ? C_WQ : C_DQ);
      gemm_mainloop<4, 4>(WS_P(P) + (size_t)tm * 128 * PW + yc, PW, Wl + W_B + (size_t)i * 1024 * 512 + (size_t)(tn * 256) * 512, 512, 512, acc, smem);
#pragma unroll
      for (int mi = 0; mi < 4; ++mi)
#pragma unroll
        for (int ni = 0; ni < 4; ++ni) {
          mg[mi][ni][0] += bflo(gp[mi][ni][0]) * acc[mi][ni][0];
          mg[mi][ni][1] += bfhi(gp[mi][ni][0]) * acc[mi][ni][1];
          mg[mi][ni][2] += bflo(gp[mi][ni][1]) * acc[mi][ni][2];
          mg[mi][ni][3] += bfhi(gp[mi][ni][1]) * acc[mi][ni][3];
        }
    }
    const int row0 = tm * 128 + wr * 64, col0 = tn * 256 + wc * 64;
#pragma unroll
    for (int mi = 0; mi < 4; ++mi)
#pragma unroll
      for (int ni = 0; ni < 4; ++ni)
#pragma unroll
        for (int j = 0; j < 4; ++j)
          merged[(size_t)(row0 + mi * 16 + fq * 4 + j) * 1024 + col0 + ni * 16 + fr] = f2bf(mg[mi][ni][j]);
  }
}

struct EpiResid {
  const Params& P;
  const float* src_lat;
  const float* modl;
  int gt_off;
  DEV void operator()(f32x4 (&acc)[8][4], int row0, int col0) const {
    const int lane = my_tid() & 63, fr = lane & 15, fq = lane >> 4;
#pragma unroll
    for (int mi = 0; mi < 8; ++mi)
#pragma unroll
      for (int j = 0; j < 4; ++j) {
        int row = row0 + mi * 16 + fq * 4 + j;
        const float* src;
        float* dst;
        int cond;
        if (row < NLAT) { src = src_lat + (size_t)row * 1024; dst = P.out + (size_t)row * 1024; cond = row >> 12; }
        else { src = WS_XC(P) + (size_t)(row - NLAT) * 1024; dst = WS_XC(P) + (size_t)(row - NLAT) * 1024; cond = 16; }
        const float* gt = modl + (size_t)cond * 6144 + gt_off;
#pragma unroll
        for (int ni = 0; ni < 4; ++ni) {
          int col = col0 + ni * 16 + fr;
          dst[col] = src[col] + gt[col] * acc[mi][ni][j];
        }
      }
  }
};

struct EpiSwiglu {
  u16* act;
  DEV void operator()(f32x4 (&acc)[8][4], int row0, int col0) const {
    const int lane = my_tid() & 63, fr = lane & 15, fq = lane >> 4;
#pragma unroll
    for (int mi = 0; mi < 8; ++mi)
#pragma unroll
      for (int j = 0; j < 4; ++j) {
        int row = row0 + mi * 16 + fq * 4 + j;
#pragma unroll
        for (int pr = 0; pr < 2; ++pr) {
          float gte = acc[mi][pr * 2][j], up = acc[mi][pr * 2 + 1][j];
          act[(size_t)row * FH + ((col0 + pr * 32) >> 1) + fr] = f2bf(siluf_(gte) * up);
        }
      }
  }
};


#ifdef SELFCHECK
#define DBGF(P) reinterpret_cast<float*>((P).ws + O_XC + (size_t)NCTXR * 1024 * 4)
DEV float blk_reduce(float v, bool ismax, float* red) {
  const int tid = my_tid(), lane = tid & 63, wid = tid >> 6;
#pragma unroll
  for (int o = 32; o > 0; o >>= 1) { float t = __shfl_xor(v, o); v = ismax ? fmaxf(v, t) : v + t; }
  __syncthreads();
  if (lane == 0) red[wid] = v;
  __syncthreads();
  float r = red[0];
  for (int i = 1; i < 8; ++i) r = ismax ? fmaxf(r, red[i]) : r + red[i];
  __syncthreads();
  return r;
}
DEV void chk_sample(int s, int& b, int& hd, int& t) {
  const int ti = s & 7;
  b = (s * 5 + 3) & 15; hd = s & 7;
  t = ti == 0 ? 0 : ti == 1 ? 63 : ti == 2 ? 64 : ti == 3 ? 127 : ti == 4 ? 2048 + 65 : ti == 5 ? 3000 : ti == 6 ? 4032 : 4095;
}
DEV void check_pre(const Params& P, int l, char* smem) {
  const int tid = my_tid();
  float* sc = reinterpret_cast<float*>(smem);
  float* red = sc + 2 * 4352;
  float* ov = red + 16;
  float* dbg = DBGF(P);
  const u16* p = WS_P(P);
  for (int it = blockIdx.x; it < 24; it += gridDim.x) {
    const bool isdiff = it >= 12;
    const int s = isdiff ? it - 12 : it;
    int b, hd, t;
    chk_sample(s, b, hd, t);
    const bool ctxq = s >= 8;
    if (ctxq) t &= 255;
    const size_t row = ctxq ? (size_t)NLAT + b * 256 + t : (size_t)b * T + t;
    __syncthreads();
    if (!isdiff) {
      const int head = hd, g = head >> 2;
      const int lo = ctxq ? 0 : max(0, t - 128), hi = ctxq ? -1 : min(T - 1, t + 128);
      const int nk = 256 + (hi - lo + 1);
      float mx = -1e30f;
      for (int k = tid; k < nk; k += NTHREADS) {
        size_t krow = k < 256 ? (size_t)NLAT + b * 256 + k : (size_t)b * T + lo + (k - 256);
        float a = 0.f;
        for (int d = 0; d < 64; ++d) a += bf2f(p[row * PW + C_WQ + head * 64 + d]) * bf2f(p[krow * PW + C_WK + g * 64 + d]);
        sc[k] = a;
        mx = fmaxf(mx, a);
      }
      mx = blk_reduce(mx, true, red);
      const float sk = P.sink[l * 8 + head];
      mx = fmaxf(mx, sk);
      float sm = 0.f;
      for (int k = tid; k < nk; k += NTHREADS) { float e = expf(sc[k] - mx); sc[k] = e; sm += e; }
      sm = blk_reduce(sm, false, red) + expf(sk - mx);
      if (tid < 64) {
        float o = 0.f;
        for (int k = 0; k < nk; ++k) {
          int kidx = k < 256 ? k : 256 + lo + (k - 256);
          o += sc[k] * bf2f(WS_VTW(P)[((size_t)(b * 2 + g) * 64 + tid) * KEYS + kidx]);
        }
        dbg[it * 128 + tid] = o / sm;
      }
    } else {
      const int h = hd & 3;
      const int nk = ctxq ? 256 : KEYS;
      float mx0 = -1e30f, mx1 = -1e30f;
      for (int k = tid; k < nk; k += NTHREADS) {
        size_t krow = k < 256 ? (size_t)NLAT + b * 256 + k : (size_t)b * T + (k - 256);
        float a0 = 0.f, a1 = 0.f;
        for (int d = 0; d < 64; ++d) {
          a0 += bf2f(p[row * PW + C_DQ + h * 128 + d]) * bf2f(p[krow * PW + C_DK + h * 128 + d]);
          a1 += bf2f(p[row * PW + C_DQ + h * 128 + 64 + d]) * bf2f(p[krow * PW + C_DK + h * 128 + 64 + d]);
        }
        sc[k] = a0; sc[4352 + k] = a1;
        mx0 = fmaxf(mx0, a0); mx1 = fmaxf(mx1, a1);
      }
      mx0 = blk_reduce(mx0, true, red);
      mx1 = blk_reduce(mx1, true, red);
      float s0 = 0.f, s1 = 0.f;
      for (int k = tid; k < nk; k += NTHREADS) {
        float e0 = expf(sc[k] - mx0), e1 = expf(sc[4352 + k] - mx1);
        sc[k] = e0; sc[4352 + k] = e1; s0 += e0; s1 += e1;
      }
      s0 = blk_reduce(s0, false, red);
      s1 = blk_reduce(s1, false, red);
      const float lam = WS_LAM(P)[l], lam_init = 0.8f - 0.6f * expf(-0.3f * (float)l);
      float y = 0.f;
      if (tid < 128) {
        for (int k = 0; k < nk; ++k)
          y += (sc[k] / s0 - lam * sc[4352 + k] / s1) * bf2f(WS_VTD(P)[((size_t)(b * 4 + h) * 128 + tid) * KEYS + k]);
        ov[tid] = y;
      }
      __syncthreads();
      if (tid < 128) {
        float ss = 0.f;
        for (int v = 0; v < 128; ++v) ss += ov[v] * ov[v];
        dbg[it * 128 + tid] = y * rsqrtf(ss / 128.f + EPS) * P.d_norm[l * 512 + h * 128 + tid] * (1.f - lam_init);
      }
    }
  }
}
DEV void check_post(const Params& P, int l, unsigned* flags) {
  const int tid = my_tid();
  const float* dbg = DBGF(P);
  const u16* p = WS_P(P);
  for (int it = blockIdx.x; it < 24; it += gridDim.x) {
    const bool isdiff = it >= 12;
    const int s = isdiff ? it - 12 : it;
    int b, hd, t;
    chk_sample(s, b, hd, t);
    const bool ctxq = s >= 8;
    if (ctxq) t &= 255;
    const size_t row = ctxq ? (size_t)NLAT + b * 256 + t : (size_t)b * T + t;
    if (ctxq && l != 0) continue;
    const int n = isdiff ? 128 : 64;
    if (tid < n) {
      float got = isdiff ? bf2f(p[row * PW + C_DQ + (hd & 3) * 128 + tid]) : bf2f(p[row * PW + C_WQ + hd * 64 + tid]);
      float ex = dbg[it * 128 + tid];
      if (!(fabsf(got - ex) <= 0.03f + 0.03f * fabsf(ex))) atomicOr(flags, isdiff ? (ctxq ? 32u : 2u) : (ctxq ? 16u : 1u));
    }
  }
}
DEV void check_mlstm(const Params& P, int l, char* smem, unsigned* flags) {
  const int tid = my_tid(), lane = tid & 63;
  float* qs = reinterpret_cast<float*>(smem);
  float* ks = qs + 128;
  float* vs = ks + 128;
  float* nn = vs + 128;
  float* sc = nn + 128;
  float* red = sc + 8;
  const u16* p = WS_P(P);
  for (int it = blockIdx.x; it < 4; it += gridDim.x) {
    const int b = (it * 7 + 2) & 15, hd = (it + 1) & 3, dir = it & 1;
    const int v = tid >> 2, kq = tid & 3;
    float C[32];
#pragma unroll
    for (int j = 0; j < 32; ++j) C[j] = 0.f;
    __syncthreads();
    if (tid < 128) nn[tid] = 0.f;
    if (tid == 0) sc[0] = 0.f;
    __syncthreads();
    const int nsteps = (l == 0) ? 256 + T : 256 + T;
    for (int st = 0; st < nsteps; ++st) {
      int seg0, seglen, u;
      if (st < 256) { seg0 = NLAT + b * 256; seglen = 256; u = dir ? 255 - st : st; }
      else { seg0 = b * T; seglen = T; u = dir ? T - 1 - (st - 256) : st - 256; }
      const size_t row = (size_t)seg0 + u;
      if (tid < 128) {
        float xq = 0.f, xk = 0.f;
        for (int tp = 0; tp < 3; ++tp) {
          int uu = u + tp - 1;
          if (uu >= 0 && uu < seglen) {
            xq += P.conv_w[(size_t)l * 3072 + tp * 1024 + hd * 128 + tid] * bf2f(p[((size_t)seg0 + uu) * PW + C_MQ + hd * 128 + tid]);
            xk += P.conv_w[(size_t)l * 3072 + tp * 1024 + 512 + hd * 128 + tid] * bf2f(p[((size_t)seg0 + uu) * PW + C_MK + hd * 128 + tid]);
          }
        }
        qs[tid] = xq / (1.f + expf(-xq));
        ks[tid] = xk / (1.f + expf(-xk)) * 0.08838834764831845f;
        vs[tid] = bf2f(p[row * PW + C_MV + hd * 128 + tid]);
      }
      if (tid == 0) {
        float ig = WS_GATES(P)[row * 16 + dir * 8 + hd], fg = WS_GATES(P)[row * 16 + dir * 8 + 4 + hd];
        float lf = fminf(fg, 0.f) - log1pf(expf(-fabsf(fg)));
        float m = sc[0], mn = fmaxf(lf + m, ig);
        sc[1] = expf(lf + m - mn);
        sc[2] = expf(ig - mn);
        sc[3] = mn;
      }
      __syncthreads();
      const float fd = sc[1], iw = sc[2], mn = sc[3];
      float pd = 0.f;
#pragma unroll
      for (int j = 0; j < 32; ++j) {
        C[j] = fd * C[j] + iw * vs[v] * ks[kq * 32 + j];
        pd += C[j] * qs[kq * 32 + j];
      }
      pd += __shfl_xor(pd, 1);
      pd += __shfl_xor(pd, 2);
      float dn = 0.f;
      if (tid < 128) { float nv = fd * nn[tid] + iw * ks[tid]; nn[tid] = nv; dn = nv * qs[tid]; }
      dn = blk_reduce(dn, false, red);
      if (tid == 0) sc[0] = mn;
      const float hval = pd / fmaxf(fabsf(dn), expf(-mn));
      float sq = (kq == 0) ? hval * hval : 0.f;
      sq = blk_reduce(sq, false, red);
      const float rms = sqrtf(sq / 128.f);
      const bool cmp = (st < 256) ? (l == 0) : true;
      if (cmp && kq == 0 && ((u & 63) == 0 || (u & 63) == 63 || (u % 97) == 0)) {
        float got = bf2f(WS_HFB(P)[(size_t)dir * MTOT * 512 + row * 512 + hd * 128 + v]);
        if (!(fabsf(got - hval) <= 0.05f * rms + 0.05f * fabsf(hval) + 1e-3f)) atomicOr(flags, dir ? 8u : 4u);
      }
    }
  }
}
#endif


#ifdef SELFCHECK
DEV void flag_if(bool bad, unsigned* flags, unsigned bit) { if (bad) atomicOr(flags, bit); }
DEV bool close_(float got, float ex, float tol) { return fabsf(got - ex) <= tol + tol * fabsf(ex); }
DEV void check_inproj(const Params& P, int l, char* smem, unsigned* flags) {
  const int tid = my_tid();
  float* red = reinterpret_cast<float*>(smem);
  float* hrow = red + 16;
  const float* modl = WS_MOD(P) + (size_t)l * 17 * 6144;
  for (int it = blockIdx.x; it < 64; it += gridDim.x) {
    const int ri = it & 7;
    const int row = ri == 0 ? 0 : ri == 1 ? 4095 : ri == 2 ? 4096 + 77 : ri == 3 ? 30000 : ri == 4 ? 65535 : ri == 5 ? NLAT : ri == 6 ? NLAT + 300 : MTOT - 1;
    const int cond = row < NLAT ? row >> 12 : 16;
    {
      int col = (it * 769 + 5) % 6144;
      float a = 0.f;
      for (int k = tid; k < 1024; k += NTHREADS) {
        float cv = cond < 16 ? P.c[cond * 1024 + k] : P.c_ctx[k];
        a += cv / (1.f + expf(-cv)) * P.w_mod[(size_t)l * 1024 * 6144 + (size_t)k * 6144 + col];
      }
      a = blk_reduce(a, false, red) + P.b_mod[l * 6144 + col];
      if (tid == 0) flag_if(!close_(modl[(size_t)cond * 6144 + col], a, 2e-3f), flags, 1u);
    }
    const float* xs = row < NLAT ? ((l == 0 ? P.x : P.out) + (size_t)row * 1024) : (WS_XC(P) + (size_t)(row - NLAT) * 1024);
    float ss = 0.f;
    for (int k = tid; k < 1024; k += NTHREADS) ss += xs[k] * xs[k];
    ss = blk_reduce(ss, false, red);
    const float rstd = rsqrtf(ss / 1024.f + EPS);
    for (int k = tid; k < 1024; k += NTHREADS) {
      float y = xs[k] * rstd * P.g_mix[l * 1024 + k] * (1.f + modl[(size_t)cond * 6144 + 1024 + k]) + modl[(size_t)cond * 6144 + k];
      hrow[k] = y;
      flag_if(!close_(bf2f(WS_H(P)[(size_t)row * 1024 + k]), y, 1e-2f), flags, 2u);
    }
    __syncthreads();
    const int oi = it >> 3;
    const int oj = (oi * 2 + (it & 1)) & 15;
    const int oc = oj == 0 ? 3 : oj == 1 ? 600 : oj == 2 ? 1100 : oj == 3 ? 1999 : oj == 4 ? 2050 : oj == 5 ? 2064 + 70 : oj == 6 ? 2576 + 100 :
                   oj == 7 ? 2704 + 5 : oj == 8 ? 2832 + 200 : oj == 9 ? 2832 + 37 : oj == 10 ? 3344 + 90 : oj == 11 ? 3344 + 300 :
                   oj == 12 ? 3856 + 10 : oj == 13 ? 3856 + 500 : oj == 14 ? 2048 + 15 : 2064 + 500;
    auto dotcol = [&](int c) {
      float a = 0.f;
      for (int k = tid; k < 1024; k += NTHREADS) a += hrow[k] * P.w_in[(size_t)l * 1024 * INW + (size_t)k * INW + c];
      return blk_reduce(a, false, red);
    };
    float val = dotcol(oc);
    const u16* p = WS_P(P);
    const bool lat = row < NLAT;
    const int t = row & (T - 1);
    float got = 0.f, ex = val;
    unsigned bit = 4u;
    if (oc < 2048) { got = bf2f(p[(size_t)row * PW + oc]); }
    else if (oc < 2064) { got = WS_GATES(P)[(size_t)row * 16 + oc - 2048]; ex = val + P.b_gate[l * 16 + oc - 2048]; }
    else if (oc >= 2704 && oc < 2832) {
      int cgi = oc - 2704, g = cgi >> 6, vd = cgi & 63;
      int b = lat ? row >> 12 : (row - NLAT) >> 8, key = lat ? 256 + t : (row - NLAT) & 255;
      got = bf2f(WS_VTW(P)[((size_t)(b * 2 + g) * 64 + vd) * KEYS + key]);
      bit = 8u;
    } else if (oc >= 3856) {
      int cgi = oc - 3856, h = cgi >> 7, vd = cgi & 127;
      int b = lat ? row >> 12 : (row - NLAT) >> 8, key = lat ? 256 + t : (row - NLAT) & 255;
      got = bf2f(WS_VTD(P)[((size_t)(b * 4 + h) * 128 + vd) * KEYS + key]);
      bit = 8u;
    } else {
      int base, nb0;
      bool isq;
      if (oc < 2576) { base = 2064; nb0 = C_WQ; isq = true; }
      else if (oc < 2704) { base = 2576; nb0 = C_WK; isq = false; }
      else if (oc < 3344) { base = 2832; nb0 = C_DQ; isq = true; }
      else { base = 3344; nb0 = C_DK; isq = false; }
      int rel = oc - base, dd = rel & 63, j = dd & 15, second = (dd >> 4) & 1, axis = dd >> 5;
      float other = dotcol(second ? oc - 16 : oc + 16);
      if (lat) {
        int pos = axis ? (t & 63) : (t >> 6);
        float ang = (float)pos * powf(10000.f, -(float)j / 16.f);
        float cs = cosf(ang), sn = sinf(ang);
        ex = second ? (val * cs + other * sn) : (val * cs - other * sn);
      }
      if (isq) ex *= 0.125f;
      got = bf2f(p[(size_t)row * PW + nb0 + rel]);
      bit = 16u;
    }
    if (tid == 0) flag_if(!close_(got, ex, 3e-2f), flags, bit);
    __syncthreads();
  }
}
DEV void check_post6(const Params& P, int l, char* smem, unsigned* flags, const float* xprev) {
  const int tid = my_tid();
  float* red = reinterpret_cast<float*>(smem);
  const u16* Yp = WS_P(P);
  const float* modl = WS_MOD(P) + (size_t)l * 17 * 6144;
  for (int it = blockIdx.x; it < 16; it += gridDim.x) {
    const int ri = it & 7;
    const int row = ri == 0 ? 1 : ri == 1 ? 4097 : ri == 2 ? 12345 : ri == 3 ? 40000 : ri == 4 ? 65534 : ri == 5 ? NLAT + 1 : ri == 6 ? NLAT + 2000 : MTOT - 2;
    if (row >= NLAT && l != 0) continue;
    const int col = (it * 331 + 17) & 1023;
    const int cond = row < NLAT ? row >> 12 : 16;
    float mg = 0.f;
    for (int i = 0; i < 3; ++i) {
      float a = 0.f, z = 0.f;
      for (int k = tid; k < 1024; k += NTHREADS) a += bf2f(WS_H(P)[(size_t)row * 1024 + k]) * P.w_in[(size_t)l * 1024 * INW + (size_t)k * INW + 4368 + i * 1024 + col];
      a = blk_reduce(a, false, red);
      const int yc = i == 0 ? C_MO : (i == 1 ? C_WQ : C_DQ);
      for (int k = tid; k < 512; k += NTHREADS) z += bf2f(Yp[(size_t)row * PW + yc + k]) * P.w_branch[((size_t)l * 3 + i) * 512 * 1024 + (size_t)k * 1024 + col];
      z = blk_reduce(z, false, red);
      mg += z / (1.f + expf(-a));
    }
    if (tid == 0) flag_if(!close_(bf2f(WS_HFB(P)[(size_t)row * 1024 + col]), mg, 3e-2f), flags, 1u);
    float o = 0.f;
    for (int k = tid; k < 1024; k += NTHREADS) o += bf2f(WS_HFB(P)[(size_t)row * 1024 + k]) * P.w_out[(size_t)l * 1024 * 1024 + (size_t)k * 1024 + col];
    o = blk_reduce(o, false, red);
    const float xo = row < NLAT ? xprev[(size_t)row * 1024 + col] : -1e9f;
    const float xn = row < NLAT ? P.out[(size_t)row * 1024 + col] : WS_XC(P)[(size_t)(row - NLAT) * 1024 + col];
    if (tid == 0 && row < NLAT && (l == 0)) flag_if(!close_(xn, xo + modl[(size_t)cond * 6144 + 2048 + col] * o, 2e-2f), flags, 2u);
    if (tid == 0) DBGF(P)[4096 + it] = xn;
  }
}
DEV void check_post9(const Params& P, int l, char* smem, unsigned* flags) {
  const int tid = my_tid();
  float* red = reinterpret_cast<float*>(smem);
  const float* modl = WS_MOD(P) + (size_t)l * 17 * 6144;
  for (int it = blockIdx.x; it < 16; it += gridDim.x) {
    const int ri = it & 7;
    const int row = ri == 0 ? 1 : ri == 1 ? 4097 : ri == 2 ? 12345 : ri == 3 ? 40000 : ri == 4 ? 65534 : ri == 5 ? NLAT + 1 : ri == 6 ? NLAT + 2000 : MTOT - 2;
    if (row >= NLAT && l != 0) continue;
    const int col = (it * 331 + 17) & 1023;
    const int cond = row < NLAT ? row >> 12 : 16;
    const int j = (it * 97 + 13) % FH;
    float g = 0.f, u = 0.f;
    for (int k = tid; k < 1024; k += NTHREADS) {
      float hv = bf2f(WS_H(P)[(size_t)row * 1024 + k]);
      g += hv * P.w_ffn_in[(size_t)l * 1024 * 5632 + (size_t)k * 5632 + j];
      u += hv * P.w_ffn_in[(size_t)l * 1024 * 5632 + (size_t)k * 5632 + FH + j];
    }
    g = blk_reduce(g, false, red);
    u = blk_reduce(u, false, red);
    if (tid == 0) flag_if(!close_(bf2f(WS_P(P)[(size_t)row * FH + j]), g / (1.f + expf(-g)) * u, 3e-2f), flags, 4u);
    float o = 0.f;
    for (int k = tid; k < FH; k += NTHREADS) o += bf2f(WS_P(P)[(size_t)row * FH + k]) * P.w_ffn_out[(size_t)l * FH * 1024 + (size_t)k * 1024 + col];
    o = blk_reduce(o, false, red);
    const float xn = row < NLAT ? P.out[(size_t)row * 1024 + col] : WS_XC(P)[(size_t)(row - NLAT) * 1024 + col];
    if (tid == 0) flag_if(!close_(xn, DBGF(P)[4096 + it] + modl[(size_t)cond * 6144 + 5120 + col] * o, 2e-2f), flags, 8u);
  }
}
#endif

#ifdef DEBUG_STAGE
DEV void debug_dump(const Params& P, int stage) {
  const int tid = my_tid();
  for (size_t idx = (size_t)blockIdx.x * NTHREADS + tid; idx < (size_t)NLAT * 1024; idx += (size_t)gridDim.x * NTHREADS) {
    size_t row = idx >> 10;
    int c = (int)(idx & 1023);
    size_t r2 = row + (row < 4096 ? NLAT : 0);
    float v = 0.f;
    const u16* p = WS_P(P);
    if (stage == 1) {
      v = bf2f(p[row * PW + c]) + bf2f(p[row * PW + 1024 + c]) + bf2f(p[row * PW + 2048 + c]) + (c < 640 ? bf2f(p[row * PW + 3072 + c]) : 0.f);
      v += bf2f(p[r2 * PW + c]) + bf2f(p[r2 * PW + 1024 + c]) + bf2f(p[r2 * PW + 2048 + c]);
      v += bf2f(WS_VTD(P)[r2 * 512 + (c & 511)]) + bf2f(WS_VTW(P)[r2 * 128 + (c & 127)]) + WS_GATES(P)[r2 * 16 + (c & 15)];
      v += bf2f(WS_VTD(P)[row * 512 + (c & 511)]) + bf2f(WS_VTW(P)[row * 128 + (c & 127)]) + WS_GATES(P)[row * 16 + (c & 15)];
    } else if (stage == 21) {
      v = bf2f(WS_HFB(P)[row * 512 + (c & 511)]) + 2.f * bf2f(WS_HFB(P)[(size_t)MTOT * 512 + row * 512 + (c & 511)]);
      v += bf2f(WS_HFB(P)[r2 * 512 + (c & 511)]) + 2.f * bf2f(WS_HFB(P)[(size_t)MTOT * 512 + r2 * 512 + (c & 511)]);
    } else if (stage == 22) {
      v = bf2f(p[row * PW + C_WQ + (c & 511)]) + bf2f(p[r2 * PW + C_WQ + (c & 511)]);
    } else if (stage == 23) {
      v = bf2f(p[row * PW + C_DQ + (c & 511)]) + bf2f(p[r2 * PW + C_DQ + (c & 511)]);
    } else if (stage == 3) {
      v = bf2f(WS_HFB(P)[row * 1024 + c]) + bf2f(WS_HFB(P)[r2 * 1024 + c]);
    } else if (stage == 4) {
      v = P.out[idx] + WS_XC(P)[(row & 4095) * 1024 + c];
    } else if (stage == 5) {
      v = bf2f(WS_H(P)[row * 1024 + c]) + bf2f(WS_H(P)[r2 * 1024 + c]);
    } else if (stage == 6) {
      v = bf2f(p[row * FH + c]) + bf2f(p[row * FH + 1024 + c]) + bf2f(p[r2 * FH + 1792 + c]);
    }
    if (stage != 4) P.out[idx] = v; else P.out[idx] = v;
  }
}
#define DBG(st) if (l == 0 && DEBUG_STAGE == st) { GSYNC_ONLY(); debug_dump(P, st); return true; }
#else
#define DBG(st)
#endif
template <int l>
DEV bool layer_body(const Params& P, unsigned* bar, unsigned& epoch, char* smem) {
  constexpr bool need_ctx = (l == 0);
  const float* modl = WS_MOD(P) + (size_t)l * 17 * 6144;
  const u16* Wl = WS_W(P) + (size_t)l * W_LAYER;
  const float* xlat = l == 0 ? P.x : P.out;
  constexpr int Mtok = need_ctx ? MTOT : NLAT;
  phase_norm_mod(P, xlat, WS_XC(P), MTOT, P.g_mix + l * 1024, modl, 0, 1024);
  GSYNC();
  gemm_phase<8>(WS_H(P), 1024, Wl + W_IN, 1024, MTOT, NIN, 1024, EpiInProj{P, l}, smem);
#ifdef REPEAT_GEMMS
  if (l == 1) gemm_phase<8>(WS_H(P), 1024, Wl + W_IN, 1024, MTOT, NIN, 1024, EpiInProj{P, l}, smem);
#endif
  GSYNC();
  DBG(1)
#ifdef SELFCHECK
#if SELFCHECK == 2
  check_inproj(P, l, smem, WS_CTR(P) + 16 + l * 3);
#else
  check_pre(P, l, smem);
#endif
  GSYNC();
#endif
  phase_mixers(P, l, smem);
  GSYNC();
#if defined(SELFCHECK) && SELFCHECK == 1
  check_post(P, l, WS_CTR(P) + 17 + l * 3);
  check_mlstm(P, l, smem, WS_CTR(P) + 17 + l * 3);
  GSYNC();
#endif
  DBG(21)
  DBG(22)
  DBG(23)
  phase_ya(P, l, Mtok);
  GSYNC();
  phase_merge(P, l, Mtok, smem);
#ifdef REPEAT_GEMMS
  if (l == 1) phase_merge(P, l, Mtok, smem);
#endif
  GSYNC();
  DBG(3)
  gemm_phase<8>(WS_HFB(P), 1024, Wl + W_O, 1024, Mtok, 1024, 1024, EpiResid{P, xlat, modl, 2048}, smem);
  GSYNC();
#if defined(SELFCHECK) && SELFCHECK == 2
  check_post6(P, l, smem, WS_CTR(P) + 18 + l * 3, xlat);
  GSYNC();
#endif
  DBG(4)
  phase_norm_mod(P, P.out, WS_XC(P), Mtok, P.g_ffn + l * 1024, modl, 3072, 4096);
  GSYNC();
  DBG(5)
  gemm_phase<8>(WS_H(P), 1024, Wl + W_FI, 1024, Mtok, 5632, 1024, EpiSwiglu{WS_P(P)}, smem);
#ifdef REPEAT_GEMMS
  if (l == 1) gemm_phase<8>(WS_H(P), 1024, Wl + W_FI, 1024, Mtok, 5632, 1024, EpiSwiglu{WS_P(P)}, smem);
#endif
  GSYNC();
  DBG(6)
  gemm_phase<8>(WS_P(P), FH, Wl + W_FO, FH, Mtok, 1024, FH, EpiResid{P, P.out, modl, 5120}, smem);
  GSYNC();
#if defined(SELFCHECK) && SELFCHECK == 2
  check_post9(P, l, smem, WS_CTR(P) + 18 + l * 3);
  GSYNC();
#endif
  return false;
}

__global__ void __launch_bounds__(NTHREADS) fwd_megakernel(Params P) {
  extern __shared__ __attribute__((aligned(16))) char smem[];
  cg::grid_group grid = cg::this_grid();
  unsigned* bar = WS_CTR(P) + 64;
  unsigned epoch = 0;
  grid.sync();
  phase_prologue(P, smem);
  GSYNC();
  if (layer_body<0>(P, bar, epoch, smem)) return;
  if (layer_body<1>(P, bar, epoch, smem)) return;
  phase_final_norm(P);
#ifdef SELFCHECK
  GSYNC();
  if (blockIdx.x == 0 && my_tid() == 0) {
    float scale = 1000.f;
    for (int w = 0; w < 6; ++w) {
      unsigned f = WS_CTR(P)[16 + w];
      if (f) { P.out[0] = (10.f + (float)f) * scale; break; }
      scale *= 10.f;
    }
  }
#endif
}

extern "C" void kernel_launch(void* const* d_in, const int* in_sizes, int n_in, void* d_out, int out_size, void* d_ws,
                              size_t ws_size, hipStream_t stream) {
  static int grid_blocks = 0;
  if (!grid_blocks) {
    int dev = 0, cus = 0, per_cu = 0;
    hipGetDevice(&dev);
    hipDeviceGetAttribute(&cus, hipDeviceAttributeMultiprocessorCount, dev);
    hipFuncSetAttribute((const void*)fwd_megakernel, hipFuncAttributeMaxDynamicSharedMemorySize, LDS_BYTES);
    hipOccupancyMaxActiveBlocksPerMultiprocessor(&per_cu, fwd_megakernel, NTHREADS, LDS_BYTES);
    if (per_cu < 1) per_cu = 1;
    if (per_cu > 1) per_cu = 1;
    grid_blocks = cus * per_cu;
  }
  Params P{};
  const float* const* in = reinterpret_cast<const float* const*>(d_in);
  P.x = in[0]; P.c = in[1]; P.ctx = in[2]; P.c_ctx = in[3]; P.w_mod = in[4]; P.b_mod = in[5]; P.g_mix = in[6];
  P.g_ffn = in[7]; P.w_in = in[8]; P.b_gate = in[9]; P.conv_w = in[10]; P.m_norm = in[11]; P.sink = in[12];
  P.lam_q1 = in[13]; P.lam_k1 = in[14]; P.lam_q2 = in[15]; P.lam_k2 = in[16]; P.d_norm = in[17]; P.w_branch = in[18];
  P.w_out = in[19]; P.w_ffn_in = in[20]; P.w_ffn_out = in[21]; P.g_final = in[22];
  P.out = reinterpret_cast<float*>(d_out);
  P.ws = reinterpret_cast<char*>(d_ws);
  if (WS_TOTAL > ws_size) fprintf(stderr, "workspace too small: need %zu have %zu\n", (size_t)WS_TOTAL, ws_size);
  hipMemsetAsync(P.ws + O_CTR, 0, 2048, stream);
  void* args[] = {&P};
  hipError_t e = hipLaunchCooperativeKernel((const void*)fwd_megakernel, dim3(grid_blocks), dim3(NTHREADS), args, LDS_BYTES, stream);
  if (e != hipSuccess) fprintf(stderr, "cooperative launch failed: %s (grid %d)\n", hipGetErrorString(e), grid_blocks);
}
```

```cpp
#include <hip/hip_runtime.h>
#include <hip/hip_cooperative_groups.h>
#include <cstdio>
#include <cstdint>
namespace cg = cooperative_groups;

typedef unsigned short u16;
using bf16x8 = __attribute__((ext_vector_type(8))) short;
using f32x4 = __attribute__((ext_vector_type(4))) float;
using f32x16 = __attribute__((ext_vector_type(16))) float;

#define DEV __device__ __forceinline__

constexpr int D = 1024, NB = 16, T = 4096, TC = 256;
constexpr int NLAT = NB * T;
constexpr int NCTXR = NB * TC;
constexpr int MTOT = NLAT + NCTXR;
constexpr int KEYS = T + TC;
constexpr int INW = 7440;
constexpr int PW = 3712;
constexpr int C_MQ = 0, C_MK = 512, C_MV = 1024, C_MO = 1536, C_WQ = 2048, C_WK = 2560, C_DQ = 2688, C_DK = 3200;
constexpr int NIN = 4608;
constexpr int FH = 2816;
constexpr float EPS = 1e-6f;
constexpr float L2E = 1.4426950408889634f;
constexpr int NTHREADS = 512;
constexpr int LDS_BYTES = 147456;

constexpr size_t W_IN = 0;
constexpr size_t W_G = W_IN + (size_t)NIN * 1024;
constexpr size_t W_B = W_G + (size_t)3072 * 1024;
constexpr size_t W_O = W_B + (size_t)3 * 1024 * 512;
constexpr size_t W_FI = W_O + (size_t)1024 * 1024;
constexpr size_t W_FO = W_FI + (size_t)5632 * 1024;
constexpr size_t W_LAYER = W_FO + (size_t)1024 * FH;

struct Params {
  const float *x, *c, *ctx, *c_ctx, *w_mod, *b_mod, *g_mix, *g_ffn, *w_in, *b_gate, *conv_w, *m_norm, *sink;
  const float *lam_q1, *lam_k1, *lam_q2, *lam_k2, *d_norm, *w_branch, *w_out, *w_ffn_in, *w_ffn_out, *g_final;
  float* out;
  char* ws;
};


constexpr size_t al256(size_t x) { return (x + 255) & ~(size_t)255; }
constexpr size_t O_W = 0;
constexpr size_t O_MOD = O_W + al256(2 * W_LAYER * 2);
constexpr size_t O_ROPE = O_MOD + al256((size_t)2 * 17 * 6144 * 4);
constexpr size_t O_LAM = O_ROPE + al256((size_t)T * 32 * 2 * 4);
constexpr size_t O_CTR = O_LAM + 256;
constexpr size_t O_GATES = O_CTR + 2048;
constexpr size_t O_H = O_GATES + al256((size_t)MTOT * 16 * 4);
constexpr size_t O_P = O_H + al256((size_t)MTOT * 1024 * 2);
constexpr size_t O_VTW = O_P + al256((size_t)MTOT * PW * 2);
constexpr size_t O_VTD = O_VTW + al256((size_t)NB * 2 * 64 * KEYS * 2);
constexpr size_t O_HFB = O_VTD + al256((size_t)NB * 4 * 128 * KEYS * 2);
constexpr size_t O_XC = O_HFB + al256((size_t)2 * MTOT * 512 * 2);
constexpr size_t WS_TOTAL = O_XC + al256((size_t)NCTXR * 1024 * 4) + 65536;
#define WS_W(P) reinterpret_cast<u16*>((P).ws + O_W)
#define WS_MOD(P) reinterpret_cast<float*>((P).ws + O_MOD)
#define WS_ROPE(P) reinterpret_cast<float*>((P).ws + O_ROPE)
#define WS_LAM(P) reinterpret_cast<float*>((P).ws + O_LAM)
#define WS_CTR(P) reinterpret_cast<unsigned*>((P).ws + O_CTR)
#define WS_GATES(P) reinterpret_cast<float*>((P).ws + O_GATES)
#define WS_H(P) reinterpret_cast<u16*>((P).ws + O_H)
#define WS_P(P) reinterpret_cast<u16*>((P).ws + O_P)
#define WS_VTW(P) reinterpret_cast<u16*>((P).ws + O_VTW)
#define WS_VTD(P) reinterpret_cast<u16*>((P).ws + O_VTD)
#define WS_HFB(P) reinterpret_cast<u16*>((P).ws + O_HFB)
#define WS_XC(P) reinterpret_cast<float*>((P).ws + O_XC)

DEV int my_tid() {
  int t = threadIdx.x;
  asm volatile("" : "+v"(t));
  return t;
}
typedef __bf16 bf2_t __attribute__((ext_vector_type(2)));
typedef float f2_t __attribute__((ext_vector_type(2)));
DEV uint32_t pack2(float a, float b) {
  f2_t v = {a, b};
  bf2_t r = __builtin_convertvector(v, bf2_t);
  return *reinterpret_cast<uint32_t*>(&r);
}
DEV u16 f2bf(float f) { return (u16)(pack2(f, 0.f) & 0xffffu); }
DEV float bf2f(u16 h) { return __uint_as_float(((uint32_t)h) << 16); }
DEV float bflo(uint32_t v) { return __uint_as_float(v << 16); }
DEV float bfhi(uint32_t v) { return __uint_as_float(v & 0xffff0000u); }
DEV float fexp2(float x) { return __builtin_amdgcn_exp2f(x); }
DEV float sigmoidf_(float x) { return 1.f / (1.f + __expf(-x)); }
DEV float siluf_(float x) { return x / (1.f + __expf(-x)); }
DEV float wave_sum(float v) {
#pragma unroll
  for (int o = 32; o > 0; o >>= 1) v += __shfl_xor(v, o);
  return v;
}
DEV bf16x8 ld16(const void* p) { return *reinterpret_cast<const bf16x8*>(p); }
DEV bf16x8 mk8(uint32_t a, uint32_t b, uint32_t c, uint32_t d) {
  uint4 u = make_uint4(a, b, c, d);
  return *reinterpret_cast<bf16x8*>(&u);
}
DEV f32x16 mfma32(bf16x8 a, bf16x8 b, f32x16 c) { return __builtin_amdgcn_mfma_f32_32x32x16_bf16(a, b, c, 0, 0, 0); }
DEV f32x4 mfma16(bf16x8 a, bf16x8 b, f32x4 c) { return __builtin_amdgcn_mfma_f32_16x16x32_bf16(a, b, c, 0, 0, 0); }
DEV int pi32(int r) { return (r & ~12) | ((r & 4) << 1) | ((r & 8) >> 1); }


DEV void grid_barrier(unsigned* bar, unsigned& epoch) {
  asm volatile("s_waitcnt vmcnt(0)" ::: "memory");
  __syncthreads();
  epoch += 1;
  if (my_tid() == 0) {
    __builtin_amdgcn_fence(__ATOMIC_RELEASE, "agent");
    unsigned* loc = bar + 32 + (blockIdx.x & 7) * 32;
    const unsigned per = gridDim.x >> 3;
    unsigned old = __hip_atomic_fetch_add(loc, 1u, __ATOMIC_RELAXED, __HIP_MEMORY_SCOPE_AGENT);
    if (old + 1 == per * epoch) __hip_atomic_fetch_add(bar, 1u, __ATOMIC_RELAXED, __HIP_MEMORY_SCOPE_AGENT);
    while (__hip_atomic_load(bar, __ATOMIC_RELAXED, __HIP_MEMORY_SCOPE_AGENT) < 8u * epoch) __builtin_amdgcn_s_sleep(1);
    __builtin_amdgcn_fence(__ATOMIC_ACQUIRE, "agent");
  }
  __syncthreads();
}
#define GSYNC() grid_barrier(bar, epoch)
#define GSYNC_ONLY()

template <int N>
DEV void wait_vm() { asm volatile("s_waitcnt vmcnt(%0)" ::"n"(N) : "memory"); }

template <int MI, int NI>
DEV void gemm_mainloop(const u16* __restrict__ A, int lda, const u16* __restrict__ Bt, int ldb, int K,
                       f32x4 (&acc)[MI][NI], char* smem) {
  constexpr int BM = 32 * MI, BN = 64 * NI;
  constexpr int NA = BM * 4 / NTHREADS, NBL = BN * 4 / NTHREADS;
  constexpr int ABYTES = BM * 64, BBYTES = BN * 64, SBYTES = ABYTES + BBYTES;
  constexpr int NL = NA + NBL;
  const int tid = my_tid(), lane = tid & 63, wid = tid >> 6, wr = wid >> 2, wc = wid & 3, fr = lane & 15, fq = lane >> 4;
  const int nk = K / 32;
  auto stage = [&](int kt) {
    char* base = smem + (kt & 3) * SBYTES;
#pragma unroll
    for (int i = 0; i < NA; ++i) {
      int id = tid + i * NTHREADS, r = id >> 2, c = (id & 3) ^ (((r >> 3) & 1) * 3);
      __builtin_amdgcn_global_load_lds((const unsigned*)(A + (size_t)r * lda + kt * 32 + c * 8), (unsigned*)(base + id * 16), 16, 0, 0);
    }
#pragma unroll
    for (int i = 0; i < NBL; ++i) {
      int id = tid + i * NTHREADS, r = id >> 2, c = (id & 3) ^ (((r >> 3) & 1) * 3);
      __builtin_amdgcn_global_load_lds((const unsigned*)(Bt + (size_t)r * ldb + kt * 32 + c * 8), (unsigned*)(base + ABYTES + id * 16), 16, 0, 0);
    }
  };
  wait_vm<0>();
  __syncthreads();
  stage(0);
  if (nk > 1) stage(1);
  if (nk > 2) stage(2);
  for (int kt = 0; kt < nk; ++kt) {
    if (kt + 2 < nk) wait_vm<2 * NL>();
    else if (kt + 1 < nk) wait_vm<NL>();
    else wait_vm<0>();
    asm volatile("" ::: "memory");
    __builtin_amdgcn_s_barrier();
    asm volatile("" ::: "memory");
    const char* As = smem + (kt & 3) * SBYTES;
    const char* Bs = As + ABYTES;
    bf16x8 bfr[NI], af[MI];
#pragma unroll
    for (int ni = 0; ni < NI; ++ni) {
      int r = wc * (NI * 16) + ni * 16 + fr;
      bfr[ni] = ld16(Bs + r * 64 + ((fq ^ (((r >> 3) & 1) * 3)) << 4));
    }
#pragma unroll
    for (int mi = 0; mi < MI; ++mi) {
      int r = wr * (MI * 16) + mi * 16 + fr;
      af[mi] = ld16(As + r * 64 + ((fq ^ (((r >> 3) & 1) * 3)) << 4));
    }
    if (kt + 3 < nk) stage(kt + 3);
    __builtin_amdgcn_sched_barrier(0);
    __builtin_amdgcn_s_setprio(1);
#pragma unroll
    for (int mi = 0; mi < MI; ++mi)
#pragma unroll
      for (int ni = 0; ni < NI; ++ni) acc[mi][ni] = mfma16(af[mi], bfr[ni], acc[mi][ni]);
    __builtin_amdgcn_s_setprio(0);
    __builtin_amdgcn_sched_barrier(0);
  }
}

template <int MI, int NI>
DEV void zero_acc(f32x4 (&acc)[MI][NI]) {
#pragma unroll
  for (int mi = 0; mi < MI; ++mi)
#pragma unroll
    for (int ni = 0; ni < NI; ++ni) acc[mi][ni] = f32x4{0.f, 0.f, 0.f, 0.f};
}


DEV void tile_coords(int tile, int total, int nN, int& tm, int& tn) {
  int t = tile;
  if (gridDim.x == 256 && tile < (total & ~255)) {
    int j = tile & 255;
    t = (tile & ~255) + (j & 7) * 32 + (j >> 3);
  }
  int p = t / (4 * nN), q = t - p * (4 * nN);
  tn = q >> 2;
  tm = p * 4 + (q & 3);
}

template <int MI, class Epi>
DEV void gemm_phase(const u16* A, int lda, const u16* Bt, int ldb, int M, int N, int K, Epi epi, char* smem) {
  constexpr int BM = 32 * MI;
  const int nM = M / BM, nN = N / 256;
  const int wid = my_tid() >> 6, wr = wid >> 2, wc = wid & 3;
  for (int tile = blockIdx.x; tile < nM * nN; tile += gridDim.x) {
    int tm, tn;
    tile_coords(tile, nM * nN, nN, tm, tn);
    f32x4 acc[MI][4];
    zero_acc<MI, 4>(acc);
    gemm_mainloop<MI, 4>(A + (size_t)tm * BM * lda, lda, Bt + (size_t)tn * 256 * ldb, ldb, K, acc, smem);
    epi(acc, tm * BM + wr * (MI * 16), tn * 256 + wc * 64);
  }
}

DEV int map_col(int type, int n) {
  if (type == 0) {
    if (n < 2048) return n;
    if (n < 2688) return n + 16;
    if (n < 3712) return n + 144;
    if (n < 3840) return n - 1008;
    if (n < 4352) return n + 16;
    if (n < 4368) return n - 2304;
    return -1;
  }
  if (type == 1) return n + 4368;
  if (type == 2) return n;
  int q = n >> 5, r = n & 31;
  return r < 16 ? (q * 16 + r) : (FH + q * 16 + r - 16);
}

DEV void tr_tile(const float* __restrict__ src, int ldsrc, u16* __restrict__ dst, int K, int n0, int k0, int type, char* smem) {
  float* tile = reinterpret_cast<float*>(smem);
  const int tid = my_tid();
  {
    int n = tid & 63, sc = map_col(type, n0 + n);
#pragma unroll
    for (int i = 0; i < 8; ++i) {
      int k = (tid >> 6) + 8 * i;
      tile[k * 65 + n] = sc >= 0 ? src[(size_t)(k0 + k) * ldsrc + sc] : 0.f;
    }
  }
  __syncthreads();
  {
    int n = tid >> 3, kc = tid & 7;
    uint32_t w[4];
#pragma unroll
    for (int j = 0; j < 4; ++j) w[j] = pack2(tile[(kc * 8 + 2 * j) * 65 + n], tile[(kc * 8 + 2 * j + 1) * 65 + n]);
    *reinterpret_cast<uint4*>(dst + (size_t)(n0 + n) * K + k0 + kc * 8) = make_uint4(w[0], w[1], w[2], w[3]);
  }
  __syncthreads();
}

DEV void phase_prologue(const Params& P, char* smem) {
  const int tid = my_tid();
  constexpr int TPL = 4672;
  for (int it = blockIdx.x; it < 2 * TPL; it += gridDim.x) {
    int l = it / TPL, t = it % TPL;
    u16* Wl = WS_W(P) + (size_t)l * W_LAYER;
    if (t < 1152) {
      tr_tile(P.w_in + (size_t)l * 1024 * INW, INW, Wl + W_IN, 1024, (t / 16) * 64, (t % 16) * 64, 0, smem);
    } else if (t < 1920) {
      t -= 1152;
      tr_tile(P.w_in + (size_t)l * 1024 * INW, INW, Wl + W_G, 1024, (t / 16) * 64, (t % 16) * 64, 1, smem);
    } else if (t < 2304) {
      t -= 1920;
      int i = t / 128;
      t %= 128;
      tr_tile(P.w_branch + ((size_t)l * 3 + i) * 512 * 1024, 1024, Wl + W_B + (size_t)i * 1024 * 512, 512, (t / 8) * 64, (t % 8) * 64, 2, smem);
    } else if (t < 2560) {
      t -= 2304;
      tr_tile(P.w_out + (size_t)l * 1024 * 1024, 1024, Wl + W_O, 1024, (t / 16) * 64, (t % 16) * 64, 2, smem);
    } else if (t < 3968) {
      t -= 2560;
      tr_tile(P.w_ffn_in + (size_t)l * 1024 * 5632, 5632, Wl + W_FI, 1024, (t / 16) * 64, (t % 16) * 64, 3, smem);
    } else {
      t -= 3968;
      tr_tile(P.w_ffn_out + (size_t)l * FH * 1024, 1024, Wl + W_FO, FH, (t / 44) * 64, (t % 44) * 64, 2, smem);
    }
  }
  for (int it = blockIdx.x; it < 384; it += gridDim.x) {
    int l = it / 192, n0 = (it % 192) * 32;
    float* sc = reinterpret_cast<float*>(smem);
    float* red = sc + 17 * 1024;
    __syncthreads();
    for (int idx = tid; idx < 17 * 1024; idx += NTHREADS) {
      int cond = idx >> 10, k = idx & 1023;
      float cv = cond < 16 ? P.c[cond * 1024 + k] : P.c_ctx[k];
      sc[idx] = siluf_(cv);
    }
    __syncthreads();
    int col = tid & 31, ks = tid >> 5;
    float acc[17];
#pragma unroll
    for (int j = 0; j < 17; ++j) acc[j] = 0.f;
    const float* wm = P.w_mod + (size_t)l * 1024 * 6144 + n0 + col;
    for (int k = ks * 64; k < ks * 64 + 64; ++k) {
      float w = wm[(size_t)k * 6144];
#pragma unroll
      for (int j = 0; j < 17; ++j) acc[j] += sc[j * 1024 + k] * w;
    }
#pragma unroll
    for (int j = 0; j < 17; ++j) red[(ks * 17 + j) * 32 + col] = acc[j];
    __syncthreads();
    for (int o = tid; o < 17 * 32; o += NTHREADS) {
      int j = o >> 5, cc = o & 31;
      float s = 0.f;
      for (int q = 0; q < 16; ++q) s += red[(q * 17 + j) * 32 + cc];
      WS_MOD(P)[((size_t)l * 17 + j) * 6144 + n0 + cc] = s + P.b_mod[l * 6144 + n0 + cc];
    }
  }
  for (int idx = blockIdx.x * NTHREADS + tid; idx < T * 32; idx += gridDim.x * NTHREADS) {
    int t = idx >> 5, j = idx & 31;
    int pos = j < 16 ? (t >> 6) : (t & 63);
    float inv = powf(10000.f, -(float)(j & 15) / 16.f);
    float ang = (float)pos * inv;
    WS_ROPE(P)[idx * 2] = cosf(ang);
    WS_ROPE(P)[idx * 2 + 1] = sinf(ang);
  }
  for (int idx = blockIdx.x * NTHREADS + tid; idx < NCTXR * 1024 / 4; idx += gridDim.x * NTHREADS)
    reinterpret_cast<float4*>(WS_XC(P))[idx] = reinterpret_cast<const float4*>(P.ctx)[idx];
  if (blockIdx.x == 0 && tid < 64) {
    for (int l = 0; l < 2; ++l) {
      float a = wave_sum(P.lam_q1[l * 64 + tid] * P.lam_k1[l * 64 + tid]);
      float b = wave_sum(P.lam_q2[l * 64 + tid] * P.lam_k2[l * 64 + tid]);
      float lam_init = 0.8f - 0.6f * expf(-0.3f * (float)l);
      if (tid == 0) WS_LAM(P)[l] = expf(a) - expf(b) + lam_init;
    }
    if (tid < 8) WS_CTR(P)[tid] = 0u;
  }
}

DEV void phase_norm_mod(const Params& P, const float* xlat, const float* xctx, int nrows, const float* g,
                        const float* modl, int sh_off, int sc_off) {
  const int lane = my_tid() & 63, wid = my_tid() >> 6;
  for (int row = blockIdx.x * 8 + wid; row < nrows; row += gridDim.x * 8) {
    const float* src = row < NLAT ? xlat + (size_t)row * 1024 : xctx + (size_t)(row - NLAT) * 1024;
    int cond = row < NLAT ? row >> 12 : 16;
    const float* md = modl + (size_t)cond * 6144;
    float4 v[4];
    float ss = 0.f;
#pragma unroll
    for (int i = 0; i < 4; ++i) {
      v[i] = *reinterpret_cast<const float4*>(src + i * 256 + lane * 4);
      ss += v[i].x * v[i].x + v[i].y * v[i].y + v[i].z * v[i].z + v[i].w * v[i].w;
    }
    ss = wave_sum(ss);
    float rstd = rsqrtf(ss * (1.f / 1024.f) + EPS);
#pragma unroll
    for (int i = 0; i < 4; ++i) {
      int cb = i * 256 + lane * 4;
      float4 gg = *reinterpret_cast<const float4*>(g + cb);
      float4 sh = *reinterpret_cast<const float4*>(md + sh_off + cb);
      float4 sc = *reinterpret_cast<const float4*>(md + sc_off + cb);
      float y0 = v[i].x * rstd * gg.x * (1.f + sc.x) + sh.x;
      float y1 = v[i].y * rstd * gg.y * (1.f + sc.y) + sh.y;
      float y2 = v[i].z * rstd * gg.z * (1.f + sc.z) + sh.z;
      float y3 = v[i].w * rstd * gg.w * (1.f + sc.w) + sh.w;
      *reinterpret_cast<uint2*>(WS_H(P) + (size_t)row * 1024 + cb) = make_uint2(pack2(y0, y1), pack2(y2, y3));
    }
  }
}

DEV void phase_final_norm(const Params& P) {
  const int lane = my_tid() & 63, wid = my_tid() >> 6;
  for (int row = blockIdx.x * 8 + wid; row < NLAT; row += gridDim.x * 8) {
    float* src = P.out + (size_t)row * 1024;
    float4 v[4];
    float ss = 0.f;
#pragma unroll
    for (int i = 0; i < 4; ++i) {
      v[i] = *reinterpret_cast<const float4*>(src + i * 256 + lane * 4);
      ss += v[i].x * v[i].x + v[i].y * v[i].y + v[i].z * v[i].z + v[i].w * v[i].w;
    }
    ss = wave_sum(ss);
    float rstd = rsqrtf(ss * (1.f / 1024.f) + EPS);
#pragma unroll
    for (int i = 0; i < 4; ++i) {
      int cb = i * 256 + lane * 4;
      float4 gg = *reinterpret_cast<const float4*>(P.g_final + cb);
      float4 o = make_float4(v[i].x * rstd * gg.x, v[i].y * rstd * gg.y, v[i].z * rstd * gg.z, v[i].w * rstd * gg.w);
      *reinterpret_cast<float4*>(src + cb) = o;
    }
  }
}

struct EpiInProj {
  const Params& P;
  int l;
  DEV void operator()(f32x4 (&acc)[8][4], int row0, int col0) const {
    const int lane = my_tid() & 63, fr = lane & 15, fq = lane >> 4;
    if (col0 >= 4416) return;
    if (col0 < C_WQ) {
#pragma unroll
      for (int mi = 0; mi < 8; ++mi)
#pragma unroll
        for (int ni = 0; ni < 4; ++ni)
#pragma unroll
          for (int j = 0; j < 4; ++j)
            WS_P(P)[(size_t)(row0 + mi * 16 + fq * 4 + j) * PW + col0 + ni * 16 + fr] = f2bf(acc[mi][ni][j]);
    } else if (col0 < 3712) {
      const bool isq = (col0 < C_WK) || (col0 >= C_DQ && col0 < C_DK);
      const float qs = isq ? 0.125f : 1.f;
#pragma unroll
      for (int mi = 0; mi < 8; ++mi)
#pragma unroll
        for (int j = 0; j < 4; ++j) {
          int row = row0 + mi * 16 + fq * 4 + j;
          u16* dst = WS_P(P) + (size_t)row * PW + col0 + fr;
          if (row < NLAT) {
            int t = row & (T - 1);
            const float2* rt = reinterpret_cast<const float2*>(WS_ROPE(P)) + t * 32;
#pragma unroll
            for (int hf = 0; hf < 2; ++hf) {
              float2 cs = rt[hf * 16 + fr];
              float x1 = acc[mi][hf * 2][j], x2 = acc[mi][hf * 2 + 1][j];
              dst[hf * 32] = f2bf((x1 * cs.x - x2 * cs.y) * qs);
              dst[hf * 32 + 16] = f2bf((x2 * cs.x + x1 * cs.y) * qs);
            }
          } else {
#pragma unroll
            for (int ni = 0; ni < 4; ++ni) dst[ni * 16] = f2bf(acc[mi][ni][j] * qs);
          }
        }
    } else if (col0 < 4352) {
      u16* base;
      int vrow0;
      const int hdW = (col0 - 3712) >> 6;
      const int hdD = (col0 - 3840) >> 7;
      const bool isw = col0 < 3840;
#pragma unroll
      for (int mi = 0; mi < 8; ++mi) {
        int row = row0 + mi * 16 + fq * 4;
        int b, key;
        if (row < NLAT) { b = row >> 12; key = 256 + (row & (T - 1)); }
        else { b = (row - NLAT) >> 8; key = (row - NLAT) & 255; }
        if (isw) { base = WS_VTW(P) + ((size_t)(b * 2 + hdW) * 64) * KEYS; vrow0 = 0; }
        else { base = WS_VTD(P) + ((size_t)(b * 4 + hdD) * 128) * KEYS; vrow0 = (col0 - 3840) & 127; }
#pragma unroll
        for (int ni = 0; ni < 4; ++ni) {
          int v = vrow0 + ni * 16 + fr;
          *reinterpret_cast<uint2*>(base + (size_t)v * KEYS + key) =
              make_uint2(pack2(acc[mi][ni][0], acc[mi][ni][1]), pack2(acc[mi][ni][2], acc[mi][ni][3]));
        }
      }
    } else {
      float bg = P.b_gate[l * 16 + fr];
#pragma unroll
      for (int mi = 0; mi < 8; ++mi)
#pragma unroll
        for (int j = 0; j < 4; ++j) WS_GATES(P)[(size_t)(row0 + mi * 16 + fq * 4 + j) * 16 + fr] = acc[mi][0][j] + bg;
    }
  }
};

template <int QB, int VB, int KW>
struct AttnCore {
  static constexpr int DV = 32 * VB;
  static constexpr int KST = KW * 2 + 16;
  static constexpr int VST = 128 + 16;
  static constexpr int KBYTES = 64 * KST, VBYTES = DV * VST;
  static constexpr int NKL = 64 * (KW / 8) / NTHREADS, NVL = DV * 8 / NTHREADS;
  static constexpr int TOTAL = 2 * (KBYTES + VBYTES);

  static DEV void run(const u16* qptr, int ldq, const u16* kctx, const u16* klat, int ldk, int kcol, const u16* vt,
                      int nctx, int nlat, int lat_t0, bool window, int qtok0, float m_init, float l_init,
                      f32x16 (&O)[QB][VB], char* smem) {
    const int tid = my_tid(), lane = tid & 63, r = lane & 31, hh = lane >> 5;
    char* Ks = smem;
    char* Vs = smem + 2 * KBYTES;
    bf16x8 qf[QB][4];
#pragma unroll
    for (int qb = 0; qb < QB; ++qb)
#pragma unroll
      for (int ks = 0; ks < 4; ++ks) qf[qb][ks] = ld16(qptr + (size_t)(qb * 32 + r) * ldq + ks * 16 + hh * 8);
    float m[QB], lsum[QB];
#pragma unroll
    for (int qb = 0; qb < QB; ++qb) {
      m[qb] = m_init;
      lsum[qb] = hh == 0 ? l_init : 0.f;
#pragma unroll
      for (int vb = 0; vb < VB; ++vb)
#pragma unroll
        for (int i = 0; i < 16; ++i) O[qb][vb][i] = 0.f;
    }
    bf16x8 rk[NKL], rv[NVL];
    const int ntiles = nctx + nlat;
    auto gload = [&](int j) {
      int kidx = j < nctx ? j * 64 : 256 + lat_t0 + (j - nctx) * 64;
      const u16* krow = j < nctx ? kctx + (size_t)(j * 64) * ldk : klat + (size_t)(lat_t0 + (j - nctx) * 64) * ldk;
#pragma unroll
      for (int i = 0; i < NKL; ++i) {
        int id = tid + i * NTHREADS, row = id / (KW / 8), c = id % (KW / 8);
        rk[i] = ld16(krow + (size_t)row * ldk + c * 8);
      }
#pragma unroll
      for (int i = 0; i < NVL; ++i) {
        int id = tid + i * NTHREADS, row = id >> 3, c = id & 7;
        rv[i] = ld16(vt + (size_t)row * KEYS + kidx + c * 8);
      }
    };
    auto lstore = [&](int buf) {
#pragma unroll
      for (int i = 0; i < NKL; ++i) {
        int id = tid + i * NTHREADS, row = id / (KW / 8), c = id % (KW / 8);
        *reinterpret_cast<bf16x8*>(Ks + buf * KBYTES + row * KST + c * 16) = rk[i];
      }
#pragma unroll
      for (int i = 0; i < NVL; ++i) {
        int id = tid + i * NTHREADS, row = id >> 3, c = id & 7;
        *reinterpret_cast<bf16x8*>(Vs + buf * VBYTES + row * VST + c * 16) = rv[i];
      }
    };
    __syncthreads();
    gload(0);
    lstore(0);
    __syncthreads();
    for (int j = 0; j < ntiles; ++j) {
      const int buf = j & 1;
      if (j + 1 < ntiles) gload(j + 1);
      bf16x8 pf[QB][2][2];
#pragma unroll
      for (int qb = 0; qb < QB; ++qb) {
        f32x16 S[2];
#pragma unroll
        for (int kb = 0; kb < 2; ++kb) {
#pragma unroll
          for (int i = 0; i < 16; ++i) S[kb][i] = 0.f;
#pragma unroll
          for (int ks = 0; ks < 4; ++ks) {
            bf16x8 kf = ld16(Ks + buf * KBYTES + (kb * 32 + pi32(r)) * KST + (kcol + ks * 16 + hh * 8) * 2);
            S[kb] = mfma32(kf, qf[qb][ks], S[kb]);
          }
        }
        __builtin_amdgcn_sched_barrier(0);
        if (window && j >= nctx) {
          int kt0 = lat_t0 + (j - nctx) * 64;
          int qt = qtok0 + qb * 32 + r;
#pragma unroll
          for (int kb = 0; kb < 2; ++kb)
#pragma unroll
            for (int i = 0; i < 16; ++i) {
              int kt = kt0 + kb * 32 + 16 * (i >> 3) + 8 * hh + (i & 7);
              int dlt = qt - kt;
              if (dlt > 128 || dlt < -128) S[kb][i] = -1e30f;
            }
        }
        float mloc = -1e30f;
#pragma unroll
        for (int kb = 0; kb < 2; ++kb)
#pragma unroll
          for (int i = 0; i < 16; ++i) mloc = fmaxf(mloc, S[kb][i]);
        mloc = fmaxf(mloc, __shfl_xor(mloc, 32));
        if (__any(mloc > m[qb] + 5.5f)) {
          float mnew = fmaxf(m[qb], mloc);
          float alpha = fexp2((m[qb] - mnew) * L2E);
          m[qb] = mnew;
          lsum[qb] *= alpha;
#pragma unroll
          for (int vb = 0; vb < VB; ++vb)
#pragma unroll
            for (int i = 0; i < 16; ++i) O[qb][vb][i] *= alpha;
        }
        float mb = m[qb] * L2E, ps = 0.f;
#pragma unroll
        for (int kb = 0; kb < 2; ++kb) {
          float pv[16];
#pragma unroll
          for (int i = 0; i < 16; ++i) {
            pv[i] = fexp2(S[kb][i] * L2E - mb);
            ps += pv[i];
          }
#pragma unroll
          for (int s = 0; s < 2; ++s)
            pf[qb][kb][s] = mk8(pack2(pv[8 * s], pv[8 * s + 1]), pack2(pv[8 * s + 2], pv[8 * s + 3]),
                                pack2(pv[8 * s + 4], pv[8 * s + 5]), pack2(pv[8 * s + 6], pv[8 * s + 7]));
        }
        lsum[qb] += ps;
        __builtin_amdgcn_sched_barrier(0);
      }
      __builtin_amdgcn_sched_barrier(0);
#pragma unroll
      for (int vb = 0; vb < VB; ++vb) {
#pragma unroll
        for (int kb = 0; kb < 2; ++kb)
#pragma unroll
          for (int s = 0; s < 2; ++s) {
            bf16x8 vf = ld16(Vs + buf * VBYTES + (vb * 32 + r) * VST + (kb * 32 + s * 16 + hh * 8) * 2);
#pragma unroll
            for (int qb = 0; qb < QB; ++qb) O[qb][vb] = mfma32(vf, pf[qb][kb][s], O[qb][vb]);
          }
        __builtin_amdgcn_sched_barrier(0);
      }
      if (j + 1 < ntiles) lstore(buf ^ 1);
      __syncthreads();
    }
#pragma unroll
    for (int qb = 0; qb < QB; ++qb) {
      float lt = lsum[qb] + __shfl_xor(lsum[qb], 32);
      float inv = 1.f / lt;
#pragma unroll
      for (int vb = 0; vb < VB; ++vb)
#pragma unroll
        for (int i = 0; i < 16; ++i) O[qb][vb][i] *= inv;
    }
  }
};

DEV void diff_item(const Params& P, int l, int b, int h, int qt, bool ctxq, char* smem) {
  const int tid = my_tid(), lane = tid & 63, wid = tid >> 6, r = lane & 31, hh = lane >> 5;
  const int comp = wid >> 2, wq = wid & 3;
  const int rowbase = ctxq ? NLAT + b * 256 + qt * 128 : b * T + qt * 128;
  const u16* qptr = WS_P(P) + (size_t)(rowbase + wq * 32) * PW + C_DQ + h * 128 + comp * 64;
  const u16* kctx = WS_P(P) + (size_t)(NLAT + b * 256) * PW + C_DK + h * 128;
  const u16* klat = WS_P(P) + (size_t)(b * T) * PW + C_DK + h * 128;
  const u16* vt = WS_VTD(P) + ((size_t)(b * 4 + h) * 128) * KEYS;
  f32x16 O[1][4];
  AttnCore<1, 4, 128>::run(qptr, PW, kctx, klat, PW, comp * 64, vt, 4, ctxq ? 0 : 64, 0, false, 0, -1e30f, 0.f, O, smem);
  float* ex = reinterpret_cast<float*>(smem);
  __syncthreads();
  if (comp == 1) {
#pragma unroll
    for (int vb = 0; vb < 4; ++vb)
#pragma unroll
      for (int i = 0; i < 16; ++i) ex[(wq * 64 + vb * 16 + i) * 64 + lane] = O[0][vb][i];
  }
  __syncthreads();
  if (comp == 0) {
    const float lam = WS_LAM(P)[l];
    const float lam_init = 0.8f - 0.6f * expf(-0.3f * (float)l);
    float ss = 0.f;
#pragma unroll
    for (int vb = 0; vb < 4; ++vb)
#pragma unroll
      for (int i = 0; i < 16; ++i) {
        float y = O[0][vb][i] - lam * ex[(wq * 64 + vb * 16 + i) * 64 + lane];
        O[0][vb][i] = y;
        ss += y * y;
      }
    ss += __shfl_xor(ss, 32);
    float sc = rsqrtf(ss * (1.f / 128.f) + EPS) * (1.f - lam_init);
    const float* dn = P.d_norm + l * 512 + h * 128;
    u16* dst = WS_P(P) + (size_t)(rowbase + wq * 32 + r) * PW + C_DQ + h * 128;
#pragma unroll
    for (int vb = 0; vb < 4; ++vb)
#pragma unroll
      for (int g4 = 0; g4 < 4; ++g4) {
        int v = vb * 32 + g4 * 8 + hh * 4;
        float4 w = *reinterpret_cast<const float4*>(dn + v);
        *reinterpret_cast<uint2*>(dst + v) =
            make_uint2(pack2(O[0][vb][g4 * 4] * sc * w.x, O[0][vb][g4 * 4 + 1] * sc * w.y),
                       pack2(O[0][vb][g4 * 4 + 2] * sc * w.z, O[0][vb][g4 * 4 + 3] * sc * w.w));
      }
  }
  __syncthreads();
}

DEV void win_item(const Params& P, int l, int b, int g, int qb, bool ctxq, char* smem) {
  const int tid = my_tid(), lane = tid & 63, wid = tid >> 6, r = lane & 31, hh = lane >> 5;
  const int hr = wid >> 1, qh = wid & 1;
  const int head = g * 4 + hr;
  const int rowbase = (ctxq ? NLAT + b * 256 + qb * 64 : b * T + qb * 64) + qh * 32;
  const u16* qptr = WS_P(P) + (size_t)rowbase * PW + C_WQ + head * 64;
  const u16* kctx = WS_P(P) + (size_t)(NLAT + b * 256) * PW + C_WK + g * 64;
  const u16* klat = WS_P(P) + (size_t)(b * T) * PW + C_WK + g * 64;
  const u16* vt = WS_VTW(P) + ((size_t)(b * 2 + g) * 64) * KEYS;
  int t0 = 0, nlat = 0;
  if (!ctxq) {
    t0 = qb * 64 - 128;
    if (t0 < 0) t0 = 0;
    int t1 = qb * 64 + 192;
    if (t1 > T) t1 = T;
    nlat = (t1 - t0) >> 6;
  }
  f32x16 O[1][2];
  AttnCore<1, 2, 64>::run(qptr, PW, kctx, klat, PW, 0, vt, 4, nlat, t0, !ctxq, qb * 64 + qh * 32, P.sink[l * 8 + head], 1.f, O, smem);
  u16* dst = WS_P(P) + (size_t)(rowbase + r) * PW + C_WQ + head * 64;
#pragma unroll
  for (int vb = 0; vb < 2; ++vb)
#pragma unroll
    for (int g4 = 0; g4 < 4; ++g4) {
      int v = vb * 32 + g4 * 8 + hh * 4;
      *reinterpret_cast<uint2*>(dst + v) = make_uint2(pack2(O[0][vb][g4 * 4], O[0][vb][g4 * 4 + 1]),
                                                        pack2(O[0][vb][g4 * 4 + 2], O[0][vb][g4 * 4 + 3]));
    }
}

DEV void mlstm_item(const Params& P, int l, int b, int hd, int dir, bool need_ctx, char* smem) {
  const int tid = my_tid(), lane = tid & 63, wid = tid >> 6, r = lane & 31, hh = lane >> 5;
  constexpr int QST = 272, TST = 144;
  char* Qs = smem;
  char* Ks = Qs + 64 * QST;
  char* KwT = Ks + 64 * QST;
  char* VT = KwT + 128 * TST;
  char* Sp = VT + 128 * TST;
  char* Rq = Sp + 64 * TST;
  char* Rk = Rq + 66 * QST;
  float* fb = reinterpret_cast<float*>(Rk + 66 * QST);
  float* sb = fb;
  float* sa = fb + 64;
  float* sM = fb + 128;
  float* denp = fb + 192;
  float* qn = fb + 320;
  float* nb = fb + 384;
  float* cw = fb + 640;
  __syncthreads();
  if (tid < 256) nb[tid] = 0.f;
  for (int i = tid; i < 768; i += NTHREADS) {
    int qk = i / 384, tap = (i % 384) / 128, d = i & 127;
    cw[i] = P.conv_w[(size_t)l * 3 * 1024 + tap * 1024 + qk * 512 + hd * 128 + d];
  }
  f32x16 CT[4];
#pragma unroll
  for (int kb = 0; kb < 4; ++kb)
#pragma unroll
    for (int i = 0; i < 16; ++i) CT[kb][i] = 0.f;
  float mstate = 0.f;
  u16* hout = WS_HFB(P) + (size_t)dir * MTOT * 512;
  const float kscale = 0.08838834764831845f;

  auto geom = [&](int step, int& seg0, int& seglen, int& u0) {
    int c;
    if (step < 4) { seg0 = NLAT + b * 256; seglen = 256; c = dir ? 3 - step : step; }
    else { seg0 = b * T; seglen = T; c = dir ? 67 - step : step - 4; }
    u0 = c * 64;
  };
  bf16x8 pq[3], pk[3], pvv[2];
  float pig = 0.f, pfg = 0.f;
  auto issue_loads = [&](int step) {
    int seg0, seglen, u0;
    geom(step, seg0, seglen, u0);
#pragma unroll
    for (int i = 0; i < 3; ++i) {
      int id = tid + i * NTHREADS;
      bf16x8 z = {0, 0, 0, 0, 0, 0, 0, 0};
      pq[i] = z;
      pk[i] = z;
      if (id < 66 * 16) {
        int row = id >> 4, cc = id & 15;
        int uu = u0 + row - 1;
        bool ok = uu >= 0 && uu < seglen;
        const u16* src = WS_P(P) + (size_t)(seg0 + (ok ? uu : 0)) * PW + hd * 128 + cc * 8;
        if (ok) { pq[i] = ld16(src + C_MQ); pk[i] = ld16(src + C_MK); }
      }
    }
#pragma unroll
    for (int i = 0; i < 2; ++i) {
      int id = tid + i * NTHREADS, u = id >> 4, cc = id & 15;
      pvv[i] = ld16(WS_P(P) + (size_t)(seg0 + u0 + u) * PW + C_MV + hd * 128 + cc * 8);
    }
    if (wid == 0) {
      const int pos = dir ? 63 - lane : lane;
      const float* gp = WS_GATES(P) + (size_t)(seg0 + u0 + pos) * 16;
      pig = gp[(dir * 2) * 4 + hd];
      pfg = gp[(dir * 2 + 1) * 4 + hd];
    }
  };
  issue_loads(0);

  for (int step = 0; step < 68; ++step) {
    int seg0, seglen, u0;
    geom(step, seg0, seglen, u0);
    const int rowbase = seg0 + u0;
    const int cur = step & 1;
    __syncthreads();
    bf16x8 rvv[2];
#pragma unroll
    for (int i = 0; i < 3; ++i) {
      int id = tid + i * NTHREADS;
      if (id < 66 * 16) {
        int row = id >> 4, cc = id & 15;
        *reinterpret_cast<bf16x8*>(Rq + row * QST + cc * 16) = pq[i];
        *reinterpret_cast<bf16x8*>(Rk + row * QST + cc * 16) = pk[i];
      }
    }
    rvv[0] = pvv[0];
    rvv[1] = pvv[1];
    const float ig = pig, fg = pfg;
    if (step + 1 < 68) issue_loads(step + 1);
    if (wid == 0) {
      const int pos = dir ? 63 - lane : lane;
      float lf = fminf(fg, 0.f) - log1pf(__expf(-fabsf(fg)));
      float bsum = lf;
#pragma unroll
      for (int o = 1; o < 64; o <<= 1) { float t2 = __shfl_up(bsum, o); if (lane >= o) bsum += t2; }
      float a = ig - bsum, am = a;
#pragma unroll
      for (int o = 1; o < 64; o <<= 1) { float t2 = __shfl_up(am, o); if (lane >= o) am = fmaxf(am, t2); }
      sb[pos] = bsum;
      sa[pos] = a;
      sM[pos] = fmaxf(mstate, am);
    }
    __syncthreads();
    const int eidx = dir ? 0 : 63;
    const float Mend = sM[eidx], bend = sb[eidx];
    const float decay = __expf(mstate - Mend);
#pragma unroll 1
    for (int i = 0; i < 2; ++i) {
      int id = tid + i * NTHREADS, u = id >> 4, cc = id & 15;
      float wend = __expf(sa[u] - Mend);
      uint32_t qo[4], ko[4];
      float kv[8];
      bf16x8 q0 = ld16(Rq + (u)*QST + cc * 16), q1 = ld16(Rq + (u + 1) * QST + cc * 16), q2 = ld16(Rq + (u + 2) * QST + cc * 16);
      bf16x8 k0 = ld16(Rk + (u)*QST + cc * 16), k1 = ld16(Rk + (u + 1) * QST + cc * 16), k2 = ld16(Rk + (u + 2) * QST + cc * 16);
#pragma unroll
      for (int e = 0; e < 8; ++e) {
        int d = cc * 8 + e;
        float xq = cw[0 * 128 + d] * bf2f((u16)q0[e]) + cw[1 * 128 + d] * bf2f((u16)q1[e]) + cw[2 * 128 + d] * bf2f((u16)q2[e]);
        float xk = cw[384 + 0 * 128 + d] * bf2f((u16)k0[e]) + cw[384 + 1 * 128 + d] * bf2f((u16)k1[e]) + cw[384 + 2 * 128 + d] * bf2f((u16)k2[e]);
        float qv = siluf_(xq);
        kv[e] = siluf_(xk) * kscale;
        if (e & 1) { qo[e >> 1] |= ((uint32_t)f2bf(qv)) << 16; ko[e >> 1] |= ((uint32_t)f2bf(kv[e])) << 16; }
        else { qo[e >> 1] = f2bf(qv); ko[e >> 1] = f2bf(kv[e]); }
        *reinterpret_cast<u16*>(KwT + (d)*TST + u * 2) = f2bf(kv[e] * wend);
        *reinterpret_cast<u16*>(VT + (d)*TST + u * 2) = (u16)rvv[i][e];
      }
      *reinterpret_cast<uint4*>(Qs + u * QST + cc * 16) = make_uint4(qo[0], qo[1], qo[2], qo[3]);
      *reinterpret_cast<uint4*>(Ks + u * QST + cc * 16) = make_uint4(ko[0], ko[1], ko[2], ko[3]);
    }
    __syncthreads();
    if (wid < 4) {
      const int sblk = wid & 1, tblk = wid >> 1;
      f32x16 S;
#pragma unroll
      for (int i = 0; i < 16; ++i) S[i] = 0.f;
#pragma unroll
      for (int ks = 0; ks < 8; ++ks) {
        bf16x8 kf = ld16(Ks + (sblk * 32 + pi32(r)) * QST + (ks * 16 + hh * 8) * 2);
        bf16x8 qf = ld16(Qs + (tblk * 32 + r) * QST + (ks * 16 + hh * 8) * 2);
        S = mfma32(kf, qf, S);
      }
      const int t = tblk * 32 + r;
      const float Mt = sM[t];
      float ds = 0.f, val[16];
#pragma unroll
      for (int i = 0; i < 16; ++i) {
        int s = sblk * 32 + 16 * (i >> 3) + 8 * hh + (i & 7);
        bool ok = dir ? (s >= t) : (s <= t);
        val[i] = ok ? S[i] * __expf(sa[s] - Mt) : 0.f;
        ds += val[i];
      }
      ds += __shfl_xor(ds, 32);
      if (hh == 0) denp[sblk * 64 + t] = ds;
#pragma unroll
      for (int s2 = 0; s2 < 2; ++s2)
        *reinterpret_cast<uint4*>(Sp + t * TST + (sblk * 32 + s2 * 16 + hh * 8) * 2) =
            make_uint4(pack2(val[8 * s2], val[8 * s2 + 1]), pack2(val[8 * s2 + 2], val[8 * s2 + 3]),
                       pack2(val[8 * s2 + 4], val[8 * s2 + 5]), pack2(val[8 * s2 + 6], val[8 * s2 + 7]));
    } else if (wid == 4) {
      float s = 0.f;
      const float* nc = nb + cur * 128;
      for (int k8 = 0; k8 < 16; ++k8) {
        bf16x8 qv = ld16(Qs + lane * QST + k8 * 16);
#pragma unroll
        for (int e = 0; e < 8; ++e) s += nc[k8 * 8 + e] * bf2f((u16)qv[e]);
      }
      qn[lane] = s;
    } else if (wid == 5) {
      const float* nc = nb + cur * 128;
      float* nn = nb + (cur ^ 1) * 128;
#pragma unroll
      for (int q2 = 0; q2 < 2; ++q2) {
        int k = lane + q2 * 64;
        float s = 0.f;
        for (int s8 = 0; s8 < 8; ++s8) {
          bf16x8 kv = ld16(KwT + k * TST + s8 * 16);
#pragma unroll
          for (int e = 0; e < 8; ++e) s += bf2f((u16)kv[e]);
        }
        nn[k] = decay * nc[k] + s;
      }
    }
    __syncthreads();
    {
      bf16x8 vf[4];
      const int vb = wid & 3, tb = wid >> 2;
#pragma unroll
      for (int ks = 0; ks < 4; ++ks) vf[ks] = ld16(VT + (vb * 32 + r) * TST + (ks * 16 + hh * 8) * 2);
      const bool wr_h = (step >= 4) || need_ctx;
      {
        const int t = tb * 32 + r;
        f32x16 acc;
#pragma unroll
        for (int i = 0; i < 16; ++i) acc[i] = 0.f;
#pragma unroll
        for (int kb = 0; kb < 4; ++kb)
#pragma unroll
          for (int s2 = 0; s2 < 2; ++s2) {
            bf16x8 af = mk8(pack2(CT[kb][8 * s2], CT[kb][8 * s2 + 1]), pack2(CT[kb][8 * s2 + 2], CT[kb][8 * s2 + 3]),
                            pack2(CT[kb][8 * s2 + 4], CT[kb][8 * s2 + 5]), pack2(CT[kb][8 * s2 + 6], CT[kb][8 * s2 + 7]));
            uint2 lo = *reinterpret_cast<const uint2*>(Qs + t * QST + (kb * 32 + s2 * 16 + hh * 4) * 2);
            uint2 hi = *reinterpret_cast<const uint2*>(Qs + t * QST + (kb * 32 + s2 * 16 + 8 + hh * 4) * 2);
            acc = mfma32(af, mk8(lo.x, lo.y, hi.x, hi.y), acc);
          }
        const float Mt = sM[t];
        const float winter = __expf(mstate - Mt);
#pragma unroll
        for (int i = 0; i < 16; ++i) acc[i] *= winter;
#pragma unroll
        for (int ks = 0; ks < 4; ++ks) {
          bf16x8 sf = ld16(Sp + t * TST + (ks * 16 + hh * 8) * 2);
          acc = mfma32(vf[ks], sf, acc);
        }
        float den = denp[t] + denp[64 + t] + winter * qn[t];
        float sc = 1.f / fmaxf(fabsf(den), __expf(-(sb[t] + Mt)));
        if (wr_h) {
          u16* dst = hout + (size_t)(rowbase + t) * 512 + hd * 128 + vb * 32;
#pragma unroll
          for (int g4 = 0; g4 < 4; ++g4)
            *reinterpret_cast<uint2*>(dst + g4 * 8 + hh * 4) =
                make_uint2(pack2(acc[g4 * 4] * sc, acc[g4 * 4 + 1] * sc), pack2(acc[g4 * 4 + 2] * sc, acc[g4 * 4 + 3] * sc));
        }
      }
#pragma unroll
      for (int kb = 0; kb < 4; ++kb) {
#pragma unroll
        for (int i = 0; i < 16; ++i) CT[kb][i] *= decay;
#pragma unroll
        for (int ks = 0; ks < 4; ++ks) {
          bf16x8 kf = ld16(KwT + (kb * 32 + r) * TST + (ks * 16 + hh * 8) * 2);
          CT[kb] = mfma32(kf, vf[ks], CT[kb]);
        }
      }
    }
    mstate = bend + Mend;
  }
  __syncthreads();
}

DEV int next_item(unsigned* ctr, int* s_item) {
  __syncthreads();
  if (my_tid() == 0) *s_item = (int)atomicAdd(ctr, 1u);
  __syncthreads();
  return *s_item;
}
DEV void phase_mixers(const Params& P, int l, char* smem) {
  const bool need_ctx = (l == 0);
  __shared__ int s_item;
  const int n_ml = 128, n_diff = 2048, n_win = 2048, n_dc = need_ctx ? 128 : 0, n_wc = need_ctx ? 128 : 0;
  for (;;) {
    int it = next_item(&WS_CTR(P)[l * 4 + 0], &s_item);
    if (it >= n_ml) break;
    mlstm_item(P, l, it >> 3, (it >> 1) & 3, it & 1, need_ctx, smem);
  }
  for (;;) {
    int it = next_item(&WS_CTR(P)[l * 4 + 1], &s_item);
    if (it >= n_diff + n_dc) break;
    bool cq = it >= n_diff;
    int i2 = it - n_diff;
    int b = cq ? i2 >> 3 : it >> 7, hd = cq ? (i2 >> 1) & 3 : (it >> 5) & 3, qt = cq ? i2 & 1 : it & 31;
    diff_item(P, l, b, hd, qt, cq, smem);
  }
  for (;;) {
    int it = next_item(&WS_CTR(P)[l * 4 + 2], &s_item);
    if (it >= n_win + n_wc) break;
    bool cq = it >= n_win;
    int i2 = it - n_win;
    int b = cq ? i2 >> 3 : it >> 7, g = cq ? (i2 >> 2) & 1 : (it >> 6) & 1, qb = cq ? i2 & 3 : it & 63;
    win_item(P, l, b, g, qb, cq, smem);
  }
}

DEV void phase_ya(const Params& P, int l, int nrows) {
  const int lane = my_tid() & 63, wid = my_tid() >> 6;
  const u16* hf = WS_HFB(P);
  const u16* hb = WS_HFB(P) + (size_t)MTOT * 512;
  for (int row = blockIdx.x * 8 + wid; row < nrows; row += gridDim.x * 8) {
    uint4 a = *reinterpret_cast<const uint4*>(hf + (size_t)row * 512 + lane * 8);
    uint4 bq = *reinterpret_cast<const uint4*>(hb + (size_t)row * 512 + lane * 8);
    uint4 o = *reinterpret_cast<const uint4*>(WS_P(P) + (size_t)row * PW + C_MO + lane * 8);
    uint32_t aa[4] = {a.x, a.y, a.z, a.w}, bb[4] = {bq.x, bq.y, bq.z, bq.w}, oo[4] = {o.x, o.y, o.z, o.w};
    float y[8], ss = 0.f;
#pragma unroll
    for (int j = 0; j < 4; ++j) {
      y[2 * j] = (bflo(aa[j]) + bflo(bb[j])) * sigmoidf_(bflo(oo[j]));
      y[2 * j + 1] = (bfhi(aa[j]) + bfhi(bb[j])) * sigmoidf_(bfhi(oo[j]));
      ss += y[2 * j] * y[2 * j] + y[2 * j + 1] * y[2 * j + 1];
    }
#pragma unroll
    for (int of = 1; of < 16; of <<= 1) ss += __shfl_xor(ss, of);
    float rstd = rsqrtf(ss * (1.f / 128.f) + EPS);
    const float* mn = P.m_norm + l * 512 + lane * 8;
    uint32_t w[4];
#pragma unroll
    for (int j = 0; j < 4; ++j) w[j] = pack2(y[2 * j] * rstd * mn[2 * j], y[2 * j + 1] * rstd * mn[2 * j + 1]);
    *reinterpret_cast<uint4*>(WS_P(P) + (size_t)row * PW + C_MO + lane * 8) = make_uint4(w[0], w[1], w[2], w[3]);
  }
}

DEV void phase_merge(const Params& P, int l, int M, char* smem) {
  const u16* Wl = WS_W(P) + (size_t)l * W_LAYER;
  u16* merged = WS_HFB(P);
  const int nM = M / 128, nN = 4;
  const int lane = my_tid() & 63, wid = my_tid() >> 6, wr = wid >> 2, wc = wid & 3, fr = lane & 15, fq = lane >> 4;
  for (int tile = blockIdx.x; tile < nM * nN; tile += gridDim.x) {
    int tm, tn;
    tile_coords(tile, nM * nN, nN, tm, tn);
    f32x4 mg[4][4];
    zero_acc<4, 4>(mg);
#pragma unroll 1
    for (int i = 0; i < 3; ++i) {
      f32x4 acc[4][4];
      zero_acc<4, 4>(acc);
      gemm_mainloop<4, 4>(WS_H(P) + (size_t)tm * 128 * 1024, 1024, Wl + W_G + (size_t)(i * 1024 + tn * 256) * 1024, 1024, 1024, acc, smem);
      uint32_t gp[4][4][2];
#pragma unroll
      for (int mi = 0; mi < 4; ++mi)
#pragma unroll
        for (int ni = 0; ni < 4; ++ni) {
          gp[mi][ni][0] = pack2(sigmoidf_(acc[mi][ni][0]), sigmoidf_(acc[mi][ni][1]));
          gp[mi][ni][1] = pack2(sigmoidf_(acc[mi][ni][2]), sigmoidf_(acc[mi][ni][3]));
        }
      zero_acc<4, 4>(acc);
      int yc = i == 0 ? C_MO : (i == 1 ? C_WQ : C_DQ);
      gemm_mainloop<4, 4>(WS_P(P) + (size_t)tm * 128 * PW + yc, PW, Wl + W_B + (size_t)i * 1024 * 512 + (size_t)(tn * 256) * 512, 512, 512, acc, smem);
#pragma unroll
      for (int mi = 0; mi < 4; ++mi)
#pragma unroll
        for (int ni = 0; ni < 4; ++ni) {
          mg[mi][ni][0] += bflo(gp[mi][ni][0]) * acc[mi][ni][0];
          mg[mi][ni][1] += bfhi(gp[mi][ni][0]) * acc[mi][ni][1];
          mg[mi][ni][2] += bflo(gp[mi][ni][1]) * acc[mi][ni][2];
          mg[mi][ni][3] += bfhi(gp[mi][ni][1]) * acc[mi][ni][3];
        }
    }
    const int row0 = tm * 128 + wr * 64, col0 = tn * 256 + wc * 64;
#pragma unroll
    for (int mi = 0; mi < 4; ++mi)
#pragma unroll
      for (int ni = 0; ni < 4; ++ni)
#pragma unroll
        for (int j = 0; j < 4; ++j)
          merged[(size_t)(row0 + mi * 16 + fq * 4 + j) * 1024 + col0 + ni * 16 + fr] = f2bf(mg[mi][ni][j]);
  }
}

struct EpiResid {
  const Params& P;
  const float* src_lat;
  const float* modl;
  int gt_off;
  DEV void operator()(f32x4 (&acc)[8][4], int row0, int col0) const {
    const int lane = my_tid() & 63, fr = lane & 15, fq = lane >> 4;
#pragma unroll
    for (int mi = 0; mi < 8; ++mi)
#pragma unroll
      for (int j = 0; j < 4; ++j) {
        int row = row0 + mi * 16 + fq * 4 + j;
        const float* src;
        float* dst;
        int cond;
        if (row < NLAT) { src = src_lat + (size_t)row * 1024; dst = P.out + (size_t)row * 1024; cond = row >> 12; }
        else { src = WS_XC(P) + (size_t)(row - NLAT) * 1024; dst = WS_XC(P) + (size_t)(row - NLAT) * 1024; cond = 16; }
        const float* gt = modl + (size_t)cond * 6144 + gt_off;
#pragma unroll
        for (int ni = 0; ni < 4; ++ni) {
          int col = col0 + ni * 16 + fr;
          dst[col] = src[col] + gt[col] * acc[mi][ni][j];
        }
      }
  }
};

struct EpiSwiglu {
  u16* act;
  DEV void operator()(f32x4 (&acc)[8][4], int row0, int col0) const {
    const int lane = my_tid() & 63, fr = lane & 15, fq = lane >> 4;
#pragma unroll
    for (int mi = 0; mi < 8; ++mi)
#pragma unroll
      for (int j = 0; j < 4; ++j) {
        int row = row0 + mi * 16 + fq * 4 + j;
#pragma unroll
        for (int pr = 0; pr < 2; ++pr) {
          float gte = acc[mi][pr * 2][j], up = acc[mi][pr * 2 + 1][j];
          act[(size_t)row * FH + ((col0 + pr * 32) >> 1) + fr] = f2bf(siluf_(gte) * up);
        }
      }
  }
};


#ifdef SELFCHECK
#define DBGF(P) reinterpret_cast<float*>((P).ws + O_XC + (size_t)NCTXR * 1024 * 4)
DEV float blk_reduce(float v, bool ismax, float* red) {
  const int tid = my_tid(), lane = tid & 63, wid = tid >> 6;
#pragma unroll
  for (int o = 32; o > 0; o >>= 1) { float t = __shfl_xor(v, o); v = ismax ? fmaxf(v, t) : v + t; }
  __syncthreads();
  if (lane == 0) red[wid] = v;
  __syncthreads();
  float r = red[0];
  for (int i = 1; i < 8; ++i) r = ismax ? fmaxf(r, red[i]) : r + red[i];
  __syncthreads();
  return r;
}
DEV void chk_sample(int s, int& b, int& hd, int& t) {
  const int ti = s & 7;
  b = (s * 5 + 3) & 15; hd = s & 7;
  t = ti == 0 ? 0 : ti == 1 ? 63 : ti == 2 ? 64 : ti == 3 ? 127 : ti == 4 ? 2048 + 65 : ti == 5 ? 3000 : ti == 6 ? 4032 : 4095;
}
DEV void check_pre(const Params& P, int l, char* smem) {
  const int tid = my_tid();
  float* sc = reinterpret_cast<float*>(smem);
  float* red = sc + 2 * 4352;
  float* ov = red + 16;
  float* dbg = DBGF(P);
  const u16* p = WS_P(P);
  for (int it = blockIdx.x; it < 24; it += gridDim.x) {
    const bool isdiff = it >= 12;
    const int s = isdiff ? it - 12 : it;
    int b, hd, t;
    chk_sample(s, b, hd, t);
    const bool ctxq = s >= 8;
    if (ctxq) t &= 255;
    const size_t row = ctxq ? (size_t)NLAT + b * 256 + t : (size_t)b * T + t;
    __syncthreads();
    if (!isdiff) {
      const int head = hd, g = head >> 2;
      const int lo = ctxq ? 0 : max(0, t - 128), hi = ctxq ? -1 : min(T - 1, t + 128);
      const int nk = 256 + (hi - lo + 1);
      float mx = -1e30f;
      for (int k = tid; k < nk; k += NTHREADS) {
        size_t krow = k < 256 ? (size_t)NLAT + b * 256 + k : (size_t)b * T + lo + (k - 256);
        float a = 0.f;
        for (int d = 0; d < 64; ++d) a += bf2f(p[row * PW + C_WQ + head * 64 + d]) * bf2f(p[krow * PW + C_WK + g * 64 + d]);
        sc[k] = a;
        mx = fmaxf(mx, a);
      }
      mx = blk_reduce(mx, true, red);
      const float sk = P.sink[l * 8 + head];
      mx = fmaxf(mx, sk);
      float sm = 0.f;
      for (int k = tid; k < nk; k += NTHREADS) { float e = expf(sc[k] - mx); sc[k] = e; sm += e; }
      sm = blk_reduce(sm, false, red) + expf(sk - mx);
      if (tid < 64) {
        float o = 0.f;
        for (int k = 0; k < nk; ++k) {
          int kidx = k < 256 ? k : 256 + lo + (k - 256);
          o += sc[k] * bf2f(WS_VTW(P)[((size_t)(b * 2 + g) * 64 + tid) * KEYS + kidx]);
        }
        dbg[it * 128 + tid] = o / sm;
      }
    } else {
      const int h = hd & 3;
      const int nk = ctxq ? 256 : KEYS;
      float mx0 = -1e30f, mx1 = -1e30f;
      for (int k = tid; k < nk; k += NTHREADS) {
        size_t krow = k < 256 ? (size_t)NLAT + b * 256 + k : (size_t)b * T + (k - 256);
        float a0 = 0.f, a1 = 0.f;
        for (int d = 0; d < 64; ++d) {
          a0 += bf2f(p[row * PW + C_DQ + h * 128 + d]) * bf2f(p[krow * PW + C_DK + h * 128 + d]);
          a1 += bf2f(p[row * PW + C_DQ + h * 128 + 64 + d]) * bf2f(p[krow * PW + C_DK + h * 128 + 64 + d]);
        }
        sc[k] = a0; sc[4352 + k] = a1;
        mx0 = fmaxf(mx0, a0); mx1 = fmaxf(mx1, a1);
      }
      mx0 = blk_reduce(mx0, true, red);
      mx1 = blk_reduce(mx1, true, red);
      float s0 = 0.f, s1 = 0.f;
      for (int k = tid; k < nk; k += NTHREADS) {
        float e0 = expf(sc[k] - mx0), e1 = expf(sc[4352 + k] - mx1);
        sc[k] = e0; sc[4352 + k] = e1; s0 += e0; s1 += e1;
      }
      s0 = blk_reduce(s0, false, red);
      s1 = blk_reduce(s1, false, red);
      const float lam = WS_LAM(P)[l], lam_init = 0.8f - 0.6f * expf(-0.3f * (float)l);
      float y = 0.f;
      if (tid < 128) {
        for (int k = 0; k < nk; ++k)
          y += (sc[k] / s0 - lam * sc[4352 + k] / s1) * bf2f(WS_VTD(P)[((size_t)(b * 4 + h) * 128 + tid) * KEYS + k]);
        ov[tid] = y;
      }
      __syncthreads();
      if (tid < 128) {
        float ss = 0.f;
        for (int v = 0; v < 128; ++v) ss += ov[v] * ov[v];
        dbg[it * 128 + tid] = y * rsqrtf(ss / 128.f + EPS) * P.d_norm[l * 512 + h * 128 + tid] * (1.f - lam_init);
      }
    }
  }
}
DEV void check_post(const Params& P, int l, unsigned* flags) {
  const int tid = my_tid();
  const float* dbg = DBGF(P);
  const u16* p = WS_P(P);
  for (int it = blockIdx.x; it < 24; it += gridDim.x) {
    const bool isdiff = it >= 12;
    const int s = isdiff ? it - 12 : it;
    int b, hd, t;
    chk_sample(s, b, hd, t);
    const bool ctxq = s >= 8;
    if (ctxq) t &= 255;
    const size_t row = ctxq ? (size_t)NLAT + b * 256 + t : (size_t)b * T + t;
    if (ctxq && l != 0) continue;
    const int n = isdiff ? 128 : 64;
    if (tid < n) {
      float got = isdiff ? bf2f(p[row * PW + C_DQ + (hd & 3) * 128 + tid]) : bf2f(p[row * PW + C_WQ + hd * 64 + tid]);
      float ex = dbg[it * 128 + tid];
      if (!(fabsf(got - ex) <= 0.03f + 0.03f * fabsf(ex))) atomicOr(flags, isdiff ? (ctxq ? 32u : 2u) : (ctxq ? 16u : 1u));
    }
  }
}
DEV void check_mlstm(const Params& P, int l, char* smem, unsigned* flags) {
  const int tid = my_tid(), lane = tid & 63;
  float* qs = reinterpret_cast<float*>(smem);
  float* ks = qs + 128;
  float* vs = ks + 128;
  float* nn = vs + 128;
  float* sc = nn + 128;
  float* red = sc + 8;
  const u16* p = WS_P(P);
  for (int it = blockIdx.x; it < 4; it += gridDim.x) {
    const int b = (it * 7 + 2) & 15, hd = (it + 1) & 3, dir = it & 1;
    const int v = tid >> 2, kq = tid & 3;
    float C[32];
#pragma unroll
    for (int j = 0; j < 32; ++j) C[j] = 0.f;
    __syncthreads();
    if (tid < 128) nn[tid] = 0.f;
    if (tid == 0) sc[0] = 0.f;
    __syncthreads();
    const int nsteps = (l == 0) ? 256 + T : 256 + T;
    for (int st = 0; st < nsteps; ++st) {
      int seg0, seglen, u;
      if (st < 256) { seg0 = NLAT + b * 256; seglen = 256; u = dir ? 255 - st : st; }
      else { seg0 = b * T; seglen = T; u = dir ? T - 1 - (st - 256) : st - 256; }
      const size_t row = (size_t)seg0 + u;
      if (tid < 128) {
        float xq = 0.f, xk = 0.f;
        for (int tp = 0; tp < 3; ++tp) {
          int uu = u + tp - 1;
          if (uu >= 0 && uu < seglen) {
            xq += P.conv_w[(size_t)l * 3072 + tp * 1024 + hd * 128 + tid] * bf2f(p[((size_t)seg0 + uu) * PW + C_MQ + hd * 128 + tid]);
            xk += P.conv_w[(size_t)l * 3072 + tp * 1024 + 512 + hd * 128 + tid] * bf2f(p[((size_t)seg0 + uu) * PW + C_MK + hd * 128 + tid]);
          }
        }
        qs[tid] = xq / (1.f + expf(-xq));
        ks[tid] = xk / (1.f + expf(-xk)) * 0.08838834764831845f;
        vs[tid] = bf2f(p[row * PW + C_MV + hd * 128 + tid]);
      }
      if (tid == 0) {
        float ig = WS_GATES(P)[row * 16 + dir * 8 + hd], fg = WS_GATES(P)[row * 16 + dir * 8 + 4 + hd];
        float lf = fminf(fg, 0.f) - log1pf(expf(-fabsf(fg)));
        float m = sc[0], mn = fmaxf(lf + m, ig);
        sc[1] = expf(lf + m - mn);
        sc[2] = expf(ig - mn);
        sc[3] = mn;
      }
      __syncthreads();
      const float fd = sc[1], iw = sc[2], mn = sc[3];
      float pd = 0.f;
#pragma unroll
      for (int j = 0; j < 32; ++j) {
        C[j] = fd * C[j] + iw * vs[v] * ks[kq * 32 + j];
        pd += C[j] * qs[kq * 32 + j];
      }
      pd += __shfl_xor(pd, 1);
      pd += __shfl_xor(pd, 2);
      float dn = 0.f;
      if (tid < 128) { float nv = fd * nn[tid] + iw * ks[tid]; nn[tid] = nv; dn = nv * qs[tid]; }
      dn = blk_reduce(dn, false, red);
      if (tid == 0) sc[0] = mn;
      const float hval = pd / fmaxf(fabsf(dn), expf(-mn));
      float sq = (kq == 0) ? hval * hval : 0.f;
      sq = blk_reduce(sq, false, red);
      const float rms = sqrtf(sq / 128.f);
      const bool cmp = (st < 256) ? (l == 0) : true;
      if (cmp && kq == 0 && ((u & 63) == 0 || (u & 63) == 63 || (u % 97) == 0)) {
        float got = bf2f(WS_HFB(P)[(size_t)dir * MTOT * 512 + row * 512 + hd * 128 + v]);
        if (!(fabsf(got - hval) <= 0.05f * rms + 0.05f * fabsf(hval) + 1e-3f)) atomicOr(flags, dir ? 8u : 4u);
      }
    }
  }
}
#endif


#ifdef SELFCHECK
DEV void flag_if(bool bad, unsigned* flags, unsigned bit) { if (bad) atomicOr(flags, bit); }
DEV bool close_(float got, float ex, float tol) { return fabsf(got - ex) <= tol + tol * fabsf(ex); }
DEV void check_inproj(const Params& P, int l, char* smem, unsigned* flags) {
  const int tid = my_tid();
  float* red = reinterpret_cast<float*>(smem);
  float* hrow = red + 16;
  const float* modl = WS_MOD(P) + (size_t)l * 17 * 6144;
  for (int it = blockIdx.x; it < 64; it += gridDim.x) {
    const int ri = it & 7;
    const int row = ri == 0 ? 0 : ri == 1 ? 4095 : ri == 2 ? 4096 + 77 : ri == 3 ? 30000 : ri == 4 ? 65535 : ri == 5 ? NLAT : ri == 6 ? NLAT + 300 : MTOT - 1;
    const int cond = row < NLAT ? row >> 12 : 16;
    {
      int col = (it * 769 + 5) % 6144;
      float a = 0.f;
      for (int k = tid; k < 1024; k += NTHREADS) {
        float cv = cond < 16 ? P.c[cond * 1024 + k] : P.c_ctx[k];
        a += cv / (1.f + expf(-cv)) * P.w_mod[(size_t)l * 1024 * 6144 + (size_t)k * 6144 + col];
      }
      a = blk_reduce(a, false, red) + P.b_mod[l * 6144 + col];
      if (tid == 0) flag_if(!close_(modl[(size_t)cond * 6144 + col], a, 2e-3f), flags, 1u);
    }
    const float* xs = row < NLAT ? ((l == 0 ? P.x : P.out) + (size_t)row * 1024) : (WS_XC(P) + (size_t)(row - NLAT) * 1024);
    float ss = 0.f;
    for (int k = tid; k < 1024; k += NTHREADS) ss += xs[k] * xs[k];
    ss = blk_reduce(ss, false, red);
    const float rstd = rsqrtf(ss / 1024.f + EPS);
    for (int k = tid; k < 1024; k += NTHREADS) {
      float y = xs[k] * rstd * P.g_mix[l * 1024 + k] * (1.f + modl[(size_t)cond * 6144 + 1024 + k]) + modl[(size_t)cond * 6144 + k];
      hrow[k] = y;
      flag_if(!close_(bf2f(WS_H(P)[(size_t)row * 1024 + k]), y, 1e-2f), flags, 2u);
    }
    __syncthreads();
    const int oi = it >> 3;
    const int oj = (oi * 2 + (it & 1)) & 15;
    const int oc = oj == 0 ? 3 : oj == 1 ? 600 : oj == 2 ? 1100 : oj == 3 ? 1999 : oj == 4 ? 2050 : oj == 5 ? 2064 + 70 : oj == 6 ? 2576 + 100 :
                   oj == 7 ? 2704 + 5 : oj == 8 ? 2832 + 200 : oj == 9 ? 2832 + 37 : oj == 10 ? 3344 + 90 : oj == 11 ? 3344 + 300 :
                   oj == 12 ? 3856 + 10 : oj == 13 ? 3856 + 500 : oj == 14 ? 2048 + 15 : 2064 + 500;
    auto dotcol = [&](int c) {
      float a = 0.f;
      for (int k = tid; k < 1024; k += NTHREADS) a += hrow[k] * P.w_in[(size_t)l * 1024 * INW + (size_t)k * INW + c];
      return blk_reduce(a, false, red);
    };
    float val = dotcol(oc);
    const u16* p = WS_P(P);
    const bool lat = row < NLAT;
    const int t = row & (T - 1);
    float got = 0.f, ex = val;
    unsigned bit = 4u;
    if (oc < 2048) { got = bf2f(p[(size_t)row * PW + oc]); }
    else if (oc < 2064) { got = WS_GATES(P)[(size_t)row * 16 + oc - 2048]; ex = val + P.b_gate[l * 16 + oc - 2048]; }
    else if (oc >= 2704 && oc < 2832) {
      int cgi = oc - 2704, g = cgi >> 6, vd = cgi & 63;
      int b = lat ? row >> 12 : (row - NLAT) >> 8, key = lat ? 256 + t : (row - NLAT) & 255;
      got = bf2f(WS_VTW(P)[((size_t)(b * 2 + g) * 64 + vd) * KEYS + key]);
      bit = 8u;
    } else if (oc >= 3856) {
      int cgi = oc - 3856, h = cgi >> 7, vd = cgi & 127;
      int b = lat ? row >> 12 : (row - NLAT) >> 8, key = lat ? 256 + t : (row - NLAT) & 255;
      got = bf2f(WS_VTD(P)[((size_t)(b * 4 + h) * 128 + vd) * KEYS + key]);
      bit = 8u;
    } else {
      int base, nb0;
      bool isq;
      if (oc < 2576) { base = 2064; nb0 = C_WQ; isq = true; }
      else if (oc < 2704) { base = 2576; nb0 = C_WK; isq = false; }
      else if (oc < 3344) { base = 2832; nb0 = C_DQ; isq = true; }
      else { base = 3344; nb0 = C_DK; isq = false; }
      int rel = oc - base, dd = rel & 63, j = dd & 15, second = (dd >> 4) & 1, axis = dd >> 5;
      float other = dotcol(second ? oc - 16 : oc + 16);
      if (lat) {
        int pos = axis ? (t & 63) : (t >> 6);
        float ang = (float)pos * powf(10000.f, -(float)j / 16.f);
        float cs = cosf(ang), sn = sinf(ang);
        ex = second ? (val * cs + other * sn) : (val * cs - other * sn);
      }
      if (isq) ex *= 0.125f;
      got = bf2f(p[(size_t)row * PW + nb0 + rel]);
      bit = 16u;
    }
    if (tid == 0) flag_if(!close_(got, ex, 3e-2f), flags, bit);
    __syncthreads();
  }
}
DEV void check_post6(const Params& P, int l, char* smem, unsigned* flags, const float* xprev) {
  const int tid = my_tid();
  float* red = reinterpret_cast<float*>(smem);
  const u16* Yp = WS_P(P);
  const float* modl = WS_MOD(P) + (size_t)l * 17 * 6144;
  for (int it = blockIdx.x; it < 16; it += gridDim.x) {
    const int ri = it & 7;
    const int row = ri == 0 ? 1 : ri == 1 ? 4097 : ri == 2 ? 12345 : ri == 3 ? 40000 : ri == 4 ? 65534 : ri == 5 ? NLAT + 1 : ri == 6 ? NLAT + 2000 : MTOT - 2;
    if (row >= NLAT && l != 0) continue;
    const int col = (it * 331 + 17) & 1023;
    const int cond = row < NLAT ? row >> 12 : 16;
    float mg = 0.f;
    for (int i = 0; i < 3; ++i) {
      float a = 0.f, z = 0.f;
      for (int k = tid; k < 1024; k += NTHREADS) a += bf2f(WS_H(P)[(size_t)row * 1024 + k]) * P.w_in[(size_t)l * 1024 * INW + (size_t)k * INW + 4368 + i * 1024 + col];
      a = blk_reduce(a, false, red);
      const int yc = i == 0 ? C_MO : (i == 1 ? C_WQ : C_DQ);
      for (int k = tid; k < 512; k += NTHREADS) z += bf2f(Yp[(size_t)row * PW + yc + k]) * P.w_branch[((size_t)l * 3 + i) * 512 * 1024 + (size_t)k * 1024 + col];
      z = blk_reduce(z, false, red);
      mg += z / (1.f + expf(-a));
    }
    if (tid == 0) flag_if(!close_(bf2f(WS_HFB(P)[(size_t)row * 1024 + col]), mg, 3e-2f), flags, 1u);
    float o = 0.f;
    for (int k = tid; k < 1024; k += NTHREADS) o += bf2f(WS_HFB(P)[(size_t)row * 1024 + k]) * P.w_out[(size_t)l * 1024 * 1024 + (size_t)k * 1024 + col];
    o = blk_reduce(o, false, red);
    const float xo = row < NLAT ? xprev[(size_t)row * 1024 + col] : -1e9f;
    const float xn = row < NLAT ? P.out[(size_t)row * 1024 + col] : WS_XC(P)[(size_t)(row - NLAT) * 1024 + col];
    if (tid == 0 && row < NLAT && (l == 0)) flag_if(!close_(xn, xo + modl[(size_t)cond * 6144 + 2048 + col] * o, 2e-2f), flags, 2u);
    if (tid == 0) DBGF(P)[4096 + it] = xn;
  }
}
DEV void check_post9(const Params& P, int l, char* smem, unsigned* flags) {
  const int tid = my_tid();
  float* red = reinterpret_cast<float*>(smem);
  const float* modl = WS_MOD(P) + (size_t)l * 17 * 6144;
  for (int it = blockIdx.x; it < 16; it += gridDim.x) {
    const int ri = it & 7;
    const int row = ri == 0 ? 1 : ri == 1 ? 4097 : ri == 2 ? 12345 : ri == 3 ? 40000 : ri == 4 ? 65534 : ri == 5 ? NLAT + 1 : ri == 6 ? NLAT + 2000 : MTOT - 2;
    if (row >= NLAT && l != 0) continue;
    const int col = (it * 331 + 17) & 1023;
    const int cond = row < NLAT ? row >> 12 : 16;
    const int j = (it * 97 + 13) % FH;
    float g = 0.f, u = 0.f;
    for (int k = tid; k < 1024; k += NTHREADS) {
      float hv = bf2f(WS_H(P)[(size_t)row * 1024 + k]);
      g += hv * P.w_ffn_in[(size_t)l * 1024 * 5632 + (size_t)k * 5632 + j];
      u += hv * P.w_ffn_in[(size_t)l * 1024 * 5632 + (size_t)k * 5632 + FH + j];
    }
    g = blk_reduce(g, false, red);
    u = blk_reduce(u, false, red);
    if (tid == 0) flag_if(!close_(bf2f(WS_P(P)[(size_t)row * FH + j]), g / (1.f + expf(-g)) * u, 3e-2f), flags, 4u);
    float o = 0.f;
    for (int k = tid; k < FH; k += NTHREADS) o += bf2f(WS_P(P)[(size_t)row * FH + k]) * P.w_ffn_out[(size_t)l * FH * 1024 + (size_t)k * 1024 + col];
    o = blk_reduce(o, false, red);
    const float xn = row < NLAT ? P.out[(size_t)row * 1024 + col] : WS_XC(P)[(size_t)(row - NLAT) * 1024 + col];
    if (tid == 0) flag_if(!close_(xn, DBGF(P)[4096 + it] + modl[(size_t)cond * 6144 + 5120 + col] * o, 2e-2f), flags, 8u);
  }
}
#endif

#ifdef DEBUG_STAGE
DEV void debug_dump(const Params& P, int stage) {
  const int tid = my_tid();
  for (size_t idx = (size_t)blockIdx.x * NTHREADS + tid; idx < (size_t)NLAT * 1024; idx += (size_t)gridDim.x * NTHREADS) {
    size_t row = idx >> 10;
    int c = (int)(idx & 1023);
    size_t r2 = row + (row < 4096 ? NLAT : 0);
    float v = 0.f;
    const u16* p = WS_P(P);
    if (stage == 1) {
      v = bf2f(p[row * PW + c]) + bf2f(p[row * PW + 1024 + c]) + bf2f(p[row * PW + 2048 + c]) + (c < 640 ? bf2f(p[row * PW + 3072 + c]) : 0.f);
      v += bf2f(p[r2 * PW + c]) + bf2f(p[r2 * PW + 1024 + c]) + bf2f(p[r2 * PW + 2048 + c]);
      v += bf2f(WS_VTD(P)[r2 * 512 + (c & 511)]) + bf2f(WS_VTW(P)[r2 * 128 + (c & 127)]) + WS_GATES(P)[r2 * 16 + (c & 15)];
      v += bf2f(WS_VTD(P)[row * 512 + (c & 511)]) + bf2f(WS_VTW(P)[row * 128 + (c & 127)]) + WS_GATES(P)[row * 16 + (c & 15)];
    } else if (stage == 21) {
      v = bf2f(WS_HFB(P)[row * 512 + (c & 511)]) + 2.f * bf2f(WS_HFB(P)[(size_t)MTOT * 512 + row * 512 + (c & 511)]);
      v += bf2f(WS_HFB(P)[r2 * 512 + (c & 511)]) + 2.f * bf2f(WS_HFB(P)[(size_t)MTOT * 512 + r2 * 512 + (c & 511)]);
    } else if (stage == 22) {
      v = bf2f(p[row * PW + C_WQ + (c & 511)]) + bf2f(p[r2 * PW + C_WQ + (c & 511)]);
    } else if (stage == 23) {
      v = bf2f(p[row * PW + C_DQ + (c & 511)]) + bf2f(p[r2 * PW + C_DQ + (c & 511)]);
    } else if (stage == 3) {
      v = bf2f(WS_HFB(P)[row * 1024 + c]) + bf2f(WS_HFB(P)[r2 * 1024 + c]);
    } else if (stage == 4) {
      v = P.out[idx] + WS_XC(P)[(row & 4095) * 1024 + c];
    } else if (stage == 5) {
      v = bf2f(WS_H(P)[row * 1024 + c]) + bf2f(WS_H(P)[r2 * 1024 + c]);
    } else if (stage == 6) {
      v = bf2f(p[row * FH + c]) + bf2f(p[row * FH + 1024 + c]) + bf2f(p[r2 * FH + 1792 + c]);
    }
    if (stage != 4) P.out[idx] = v; else P.out[idx] = v;
  }
}
#define DBG(st) if (l == 0 && DEBUG_STAGE == st) { GSYNC_ONLY(); debug_dump(P, st); return true; }
#else
#define DBG(st)
#endif
template <int l>
DEV bool layer_body(const Params& P, unsigned* bar, unsigned& epoch, char* smem) {
  constexpr bool need_ctx = (l == 0);
  const float* modl = WS_MOD(P) + (size_t)l * 17 * 6144;
  const u16* Wl = WS_W(P) + (size_t)l * W_LAYER;
  const float* xlat = l == 0 ? P.x : P.out;
  constexpr int Mtok = need_ctx ? MTOT : NLAT;
  phase_norm_mod(P, xlat, WS_XC(P), MTOT, P.g_mix + l * 1024, modl, 0, 1024);
  GSYNC();
  gemm_phase<8>(WS_H(P), 1024, Wl + W_IN, 1024, MTOT, NIN, 1024, EpiInProj{P, l}, smem);
#ifdef REPEAT_GEMMS
  if (l == 1) gemm_phase<8>(WS_H(P), 1024, Wl + W_IN, 1024, MTOT, NIN, 1024, EpiInProj{P, l}, smem);
#endif
  GSYNC();
  DBG(1)
#ifdef SELFCHECK
#if SELFCHECK == 2
  check_inproj(P, l, smem, WS_CTR(P) + 16 + l * 3);
#else
  check_pre(P, l, smem);
#endif
  GSYNC();
#endif
  phase_mixers(P, l, smem);
  GSYNC();
#if defined(SELFCHECK) && SELFCHECK == 1
  check_post(P, l, WS_CTR(P) + 17 + l * 3);
  check_mlstm(P, l, smem, WS_CTR(P) + 17 + l * 3);
  GSYNC();
#endif
  DBG(21)
  DBG(22)
  DBG(23)
  phase_ya(P, l, Mtok);
  GSYNC();
  phase_merge(P, l, Mtok, smem);
#ifdef REPEAT_GEMMS
  if (l == 1) phase_merge(P, l, Mtok, smem);
#endif
  GSYNC();
  DBG(3)
  gemm_phase<8>(WS_HFB(P), 1024, Wl + W_O, 1024, Mtok, 1024, 1024, EpiResid{P, xlat, modl, 2048}, smem);
  GSYNC();
#if defined(SELFCHECK) && SELFCHECK == 2
  check_post6(P, l, smem, WS_CTR(P) + 18 + l * 3, xlat);
  GSYNC();
#endif
  DBG(4)
  phase_norm_mod(P, P.out, WS_XC(P), Mtok, P.g_ffn + l * 1024, modl, 3072, 4096);
  GSYNC();
  DBG(5)
  gemm_phase<8>(WS_H(P), 1024, Wl + W_FI, 1024, Mtok, 5632, 1024, EpiSwiglu{WS_P(P)}, smem);
#ifdef REPEAT_GEMMS
  if (l == 1) gemm_phase<8>(WS_H(P), 1024, Wl + W_FI, 1024, Mtok, 5632, 1024, EpiSwiglu{WS_P(P)}, smem);
#endif
  GSYNC();
  DBG(6)
  gemm_phase<8>(WS_P(P), FH, Wl + W_FO, FH, Mtok, 1024, FH, EpiResid{P, P.out, modl, 5120}, smem);
  GSYNC();
#if defined(SELFCHECK) && SELFCHECK == 2
  check_post9(P, l, smem, WS_CTR(P) + 18 + l * 3);
  GSYNC();
#endif
  return false;
}

__global__ void __launch_bounds__(NTHREADS) fwd_megakernel(Params P) {
  extern __shared__ __attribute__((aligned(16))) char smem[];
  cg::grid_group grid = cg::this_grid();
  unsigned* bar = WS_CTR(P) + 64;
  unsigned epoch = 0;
  grid.sync();
  phase_prologue(P, smem);
  GSYNC();
  if (layer_body<0>(P, bar, epoch, smem)) return;
  if (layer_body<1>(P, bar, epoch, smem)) return;
  phase_final_norm(P);
#ifdef SELFCHECK
  GSYNC();
  if (blockIdx.x == 0 && my_tid() == 0) {
    float scale = 1000.f;
    for (int w = 0; w < 6; ++w) {
      unsigned f = WS_CTR(P)[16 + w];
      if (f) { P.out[0] = (10.f + (float)f) * scale; break; }
      scale *= 10.f;
    }
  }
#endif
}

extern "C" void kernel_launch(void* const* d_in, const int* in_sizes, int n_in, void* d_out, int out_size, void* d_ws,
                              size_t ws_size, hipStream_t stream) {
  static int grid_blocks = 0;
  if (!grid_blocks) {
    int dev = 0, cus = 0, per_cu = 0;
    hipGetDevice(&dev);
    hipDeviceGetAttribute(&cus, hipDeviceAttributeMultiprocessorCount, dev);
    hipFuncSetAttribute((const void*)fwd_megakernel, hipFuncAttributeMaxDynamicSharedMemorySize, LDS_BYTES);
    hipOccupancyMaxActiveBlocksPerMultiprocessor(&per_cu, fwd_megakernel, NTHREADS, LDS_BYTES);
    if (per_cu < 1) per_cu = 1;
    if (per_cu > 1) per_cu = 1;
    grid_blocks = cus * per_cu;
  }
  Params P{};
  const float* const* in = reinterpret_cast<const float* const*>(d_in);
  P.x = in[0]; P.c = in[1]; P.ctx = in[2]; P.c_ctx = in[3]; P.w_mod = in[4]; P.b_mod = in[5]; P.g_mix = in[6];
  P.g_ffn = in[7]; P.w_in = in[8]; P.b_gate = in[9]; P.conv_w = in[10]; P.m_norm = in[11]; P.sink = in[12];
  P.lam_q1 = in[13]; P.lam_k1 = in[14]; P.lam_q2 = in[15]; P.lam_k2 = in[16]; P.d_norm = in[17]; P.w_branch = in[18];
  P.w_out = in[19]; P.w_ffn_in = in[20]; P.w_ffn_out = in[21]; P.g_final = in[22];
  P.out = reinterpret_cast<float*>(d_out);
  P.ws = reinterpret_cast<char*>(d_ws);
  if (WS_TOTAL > ws_size) fprintf(stderr, "workspace too small: need %zu have %zu\n", (size_t)WS_TOTAL, ws_size);
  hipMemsetAsync(P.ws + O_CTR, 0, 2048, stream);
  void* args[] = {&P};
  hipError_t e = hipLaunchCooperativeKernel((const void*)fwd_megakernel, dim3(grid_blocks), dim3(NTHREADS), args, LDS_BYTES, stream);
  if (e != hipSuccess) fprintf(stderr, "cooperative launch failed: %s (grid %d)\n", hipGetErrorString(e), grid_blocks);
}
```

```cpp
#include <hip/hip_runtime.h>
#include <hip/hip_cooperative_groups.h>
#include <cstdio>
#include <cstdint>
namespace cg = cooperative_groups;

typedef unsigned short u16;
using bf16x8 = __attribute__((ext_vector_type(8))) short;
using f32x4 = __attribute__((ext_vector_type(4))) float;
using f32x16 = __attribute__((ext_vector_type(16))) float;

#define DEV __device__ __forceinline__

constexpr int D = 1024, NB = 16, T = 4096, TC = 256;
constexpr int NLAT = NB * T;
constexpr int NCTXR = NB * TC;
constexpr int MTOT = NLAT + NCTXR;
constexpr int KEYS = T + TC;
constexpr int INW = 7440;
constexpr int PW = 3712;
constexpr int C_MQ = 0, C_MK = 512, C_MV = 1024, C_MO = 1536, C_WQ = 2048, C_WK = 2560, C_DQ = 2688, C_DK = 3200;
constexpr int NIN = 4608;
constexpr int FH = 2816;
constexpr float EPS = 1e-6f;
constexpr float L2E = 1.4426950408889634f;
constexpr int NTHREADS = 512;
constexpr int LDS_BYTES = 147456;

constexpr size_t W_IN = 0;
constexpr size_t W_G = W_IN + (size_t)NIN * 1024;
constexpr size_t W_B = W_G + (size_t)3072 * 1024;
constexpr size_t W_O = W_B + (size_t)3 * 1024 * 512;
constexpr size_t W_FI = W_O + (size_t)1024 * 1024;
constexpr size_t W_FO = W_FI + (size_t)5632 * 1024;
constexpr size_t W_LAYER = W_FO + (size_t)1024 * FH;

struct Params {
  const float *x, *c, *ctx, *c_ctx, *w_mod, *b_mod, *g_mix, *g_ffn, *w_in, *b_gate, *conv_w, *m_norm, *sink;
  const float *lam_q1, *lam_k1, *lam_q2, *lam_k2, *d_norm, *w_branch, *w_out, *w_ffn_in, *w_ffn_out, *g_final;
  float* out;
  char* ws;
};


constexpr size_t al256(size_t x) { return (x + 255) & ~(size_t)255; }
constexpr size_t O_W = 0;
constexpr size_t O_MOD = O_W + al256(2 * W_LAYER * 2);
constexpr size_t O_ROPE = O_MOD + al256((size_t)2 * 17 * 6144 * 4);
constexpr size_t O_LAM = O_ROPE + al256((size_t)T * 32 * 2 * 4);
constexpr size_t O_CTR = O_LAM + 256;
constexpr size_t O_GATES = O_CTR + 2048;
constexpr size_t O_H = O_GATES + al256((size_t)MTOT * 16 * 4);
constexpr size_t O_P = O_H + al256((size_t)MTOT * 1024 * 2);
constexpr size_t O_VTW = O_P + al256((size_t)MTOT * PW * 2);
constexpr size_t O_VTD = O_VTW + al256((size_t)NB * 2 * 64 * KEYS * 2);
constexpr size_t O_HFB = O_VTD + al256((size_t)NB * 4 * 128 * KEYS * 2);
constexpr size_t O_XC = O_HFB + al256((size_t)2 * MTOT * 512 * 2);
constexpr size_t WS_TOTAL = O_XC + al256((size_t)NCTXR * 1024 * 4) + 65536;
#define WS_W(P) reinterpret_cast<u16*>((P).ws + O_W)
#define WS_MOD(P) reinterpret_cast<float*>((P).ws + O_MOD)
#define WS_ROPE(P) reinterpret_cast<float*>((P).ws + O_ROPE)
#define WS_LAM(P) reinterpret_cast<float*>((P).ws + O_LAM)
#define WS_CTR(P) reinterpret_cast<unsigned*>((P).ws + O_CTR)
#define WS_GATES(P) reinterpret_cast<float*>((P).ws + O_GATES)
#define WS_H(P) reinterpret_cast<u16*>((P).ws + O_H)
#define WS_P(P) reinterpret_cast<u16*>((P).ws + O_P)
#define WS_VTW(P) reinterpret_cast<u16*>((P).ws + O_VTW)
#define WS_VTD(P) reinterpret_cast<u16*>((P).ws + O_VTD)
#define WS_HFB(P) reinterpret_cast<u16*>((P).ws + O_HFB)
#define WS_XC(P) reinterpret_cast<float*>((P).ws + O_XC)

DEV int my_tid() {
  int t = threadIdx.x;
  asm volatile("" : "+v"(t));
  return t;
}
typedef __bf16 bf2_t __attribute__((ext_vector_type(2)));
typedef float f2_t __attribute__((ext_vector_type(2)));
DEV uint32_t pack2(float a, float b) {
  f2_t v = {a, b};
  bf2_t r = __builtin_convertvector(v, bf2_t);
  return *reinterpret_cast<uint32_t*>(&r);
}
DEV u16 f2bf(float f) { return (u16)(pack2(f, 0.f) & 0xffffu); }
DEV float bf2f(u16 h) { return __uint_as_float(((uint32_t)h) << 16); }
DEV float bflo(uint32_t v) { return __uint_as_float(v << 16); }
DEV float bfhi(uint32_t v) { return __uint_as_float(v & 0xffff0000u); }
DEV float fexp2(float x) { return __builtin_amdgcn_exp2f(x); }
DEV float sigmoidf_(float x) { return 1.f / (1.f + __expf(-x)); }
DEV float siluf_(float x) { return x / (1.f + __expf(-x)); }
DEV float wave_sum(float v) {
#pragma unroll
  for (int o = 32; o > 0; o >>= 1) v += __shfl_xor(v, o);
  return v;
}
DEV bf16x8 ld16(const void* p) { return *reinterpret_cast<const bf16x8*>(p); }
DEV bf16x8 mk8(uint32_t a, uint32_t b, uint32_t c, uint32_t d) {
  uint4 u = make_uint4(a, b, c, d);
  return *reinterpret_cast<bf16x8*>(&u);
}
DEV f32x16 mfma32(bf16x8 a, bf16x8 b, f32x16 c) { return __builtin_amdgcn_mfma_f32_32x32x16_bf16(a, b, c, 0, 0, 0); }
DEV f32x4 mfma16(bf16x8 a, bf16x8 b, f32x4 c) { return __builtin_amdgcn_mfma_f32_16x16x32_bf16(a, b, c, 0, 0, 0); }
DEV int pi32(int r) { return (r & ~12) | ((r & 4) << 1) | ((r & 8) >> 1); }


DEV void grid_barrier(unsigned* bar, unsigned& epoch) {
  asm volatile("s_waitcnt vmcnt(0)" ::: "memory");
  __syncthreads();
  epoch += 1;
  if (my_tid() == 0) {
    __builtin_amdgcn_fence(__ATOMIC_RELEASE, "agent");
    unsigned* loc = bar + 32 + (blockIdx.x & 7) * 32;
    const unsigned per = gridDim.x >> 3;
    unsigned old = __hip_atomic_fetch_add(loc, 1u, __ATOMIC_RELAXED, __HIP_MEMORY_SCOPE_AGENT);
    if (old + 1 == per * epoch) __hip_atomic_fetch_add(bar, 1u, __ATOMIC_RELAXED, __HIP_MEMORY_SCOPE_AGENT);
    while (__hip_atomic_load(bar, __ATOMIC_RELAXED, __HIP_MEMORY_SCOPE_AGENT) < 8u * epoch) __builtin_amdgcn_s_sleep(1);
    __builtin_amdgcn_fence(__ATOMIC_ACQUIRE, "agent");
  }
  __syncthreads();
}
#define GSYNC() grid_barrier(bar, epoch)
#define GSYNC_ONLY()

template <int N>
DEV void wait_vm() { asm volatile("s_waitcnt vmcnt(%0)" ::"n"(N) : "memory"); }

template <int MI, int NI>
DEV void gemm_mainloop(const u16* __restrict__ A, int lda, const u16* __restrict__ Bt, int ldb, int K,
                       f32x4 (&acc)[MI][NI], char* smem) {
  constexpr int BM = 32 * MI, BN = 64 * NI;
  constexpr int NA = BM * 4 / NTHREADS, NBL = BN * 4 / NTHREADS;
  constexpr int ABYTES = BM * 64, BBYTES = BN * 64, SBYTES = ABYTES + BBYTES;
  constexpr int NL = NA + NBL;
  const int tid = my_tid(), lane = tid & 63, wid = tid >> 6, wr = wid >> 2, wc = wid & 3, fr = lane & 15, fq = lane >> 4;
  const int nk = K / 32;
  auto stage = [&](int kt) {
    char* base = smem + (kt & 3) * SBYTES;
#pragma unroll
    for (int i = 0; i < NA; ++i) {
      int id = tid + i * NTHREADS, r = id >> 2, c = (id & 3) ^ (((r >> 3) & 1) * 3);
      __builtin_amdgcn_global_load_lds((const unsigned*)(A + (size_t)r * lda + kt * 32 + c * 8), (unsigned*)(base + id * 16), 16, 0, 0);
    }
#pragma unroll
    for (int i = 0; i < NBL; ++i) {
      int id = tid + i * NTHREADS, r = id >> 2, c = (id & 3) ^ (((r >> 3) & 1) * 3);
      __builtin_amdgcn_global_load_lds((const unsigned*)(Bt + (size_t)r * ldb + kt * 32 + c * 8), (unsigned*)(base + ABYTES + id * 16), 16, 0, 0);
    }
  };
  wait_vm<0>();
  __syncthreads();
  stage(0);
  if (nk > 1) stage(1);
  if (nk > 2) stage(2);
  for (int kt = 0; kt < nk; ++kt) {
    if (kt + 2 < nk) wait_vm<2 * NL>();
    else if (kt + 1 < nk) wait_vm<NL>();
    else wait_vm<0>();
    asm volatile("" ::: "memory");
    __builtin_amdgcn_s_barrier();
    asm volatile("" ::: "memory");
    const char* As = smem + (kt & 3) * SBYTES;
    const char* Bs = As + ABYTES;
    bf16x8 bfr[NI], af[MI];
#pragma unroll
    for (int ni = 0; ni < NI; ++ni) {
      int r = wc * (NI * 16) + ni * 16 + fr;
      bfr[ni] = ld16(Bs + r * 64 + ((fq ^ (((r >> 3) & 1) * 3)) << 4));
    }
#pragma unroll
    for (int mi = 0; mi < MI; ++mi) {
      int r = wr * (MI * 16) + mi * 16 + fr;
      af[mi] = ld16(As + r * 64 + ((fq ^ (((r >> 3) & 1) * 3)) << 4));
    }
    if (kt + 3 < nk) stage(kt + 3);
    __builtin_amdgcn_sched_barrier(0);
    __builtin_amdgcn_s_setprio(1);
#pragma unroll
    for (int mi = 0; mi < MI; ++mi)
#pragma unroll
      for (int ni = 0; ni < NI; ++ni) acc[mi][ni] = mfma16(af[mi], bfr[ni], acc[mi][ni]);
    __builtin_amdgcn_s_setprio(0);
    __builtin_amdgcn_sched_barrier(0);
  }
}

template <int MI, int NI>
DEV void zero_acc(f32x4 (&acc)[MI][NI]) {
#pragma unroll
  for (int mi = 0; mi < MI; ++mi)
#pragma unroll
    for (int ni = 0; ni < NI; ++ni) acc[mi][ni] = f32x4{0.f, 0.f, 0.f, 0.f};
}


DEV void tile_coords(int tile, int total, int nN, int& tm, int& tn) {
  int t = tile;
  if (gridDim.x == 256 && tile < (total & ~255)) {
    int j = tile & 255;
    t = (tile & ~255) + (j & 7) * 32 + (j >> 3);
  }
  int p = t / (4 * nN), q = t - p * (4 * nN);
  tn = q >> 2;
  tm = p * 4 + (q & 3);
}

template <int MI, class Epi>
DEV void gemm_phase(const u16* A, int lda, const u16* Bt, int ldb, int M, int N, int K, Epi epi, char* smem) {
  constexpr int BM = 32 * MI;
  const int nM = M / BM, nN = N / 256;
  const int wid = my_tid() >> 6, wr = wid >> 2, wc = wid & 3;
  for (int tile = blockIdx.x; tile < nM * nN; tile += gridDim.x) {
    int tm, tn;
    tile_coords(tile, nM * nN, nN, tm, tn);
    f32x4 acc[MI][4];
    zero_acc<MI, 4>(acc);
    gemm_mainloop<MI, 4>(A + (size_t)tm * BM * lda, lda, Bt + (size_t)tn * 256 * ldb, ldb, K, acc, smem);
    epi(acc, tm * BM + wr * (MI * 16), tn * 256 + wc * 64);
  }
}

DEV int map_col(int type, int n) {
  if (type == 0) {
    if (n < 2048) return n;
    if (n < 2688) return n + 16;
    if (n < 3712) return n + 144;
    if (n < 3840) return n - 1008;
    if (n < 4352) return n + 16;
    if (n < 4368) return n - 2304;
    return -1;
  }
  if (type == 1) return n + 4368;
  if (type == 2) return n;
  int q = n >> 5, r = n & 31;
  return r < 16 ? (q * 16 + r) : (FH + q * 16 + r - 16);
}

DEV void tr_tile(const float* __restrict__ src, int ldsrc, u16* __restrict__ dst, int K, int n0, int k0, int type, char* smem) {
  float* tile = reinterpret_cast<float*>(smem);
  const int tid = my_tid();
  {
    int n = tid & 63, sc = map_col(type, n0 + n);
#pragma unroll
    for (int i = 0; i < 8; ++i) {
      int k = (tid >> 6) + 8 * i;
      tile[k * 65 + n] = sc >= 0 ? src[(size_t)(k0 + k) * ldsrc + sc] : 0.f;
    }
  }
  __syncthreads();
  {
    int n = tid >> 3, kc = tid & 7;
    uint32_t w[4];
#pragma unroll
    for (int j = 0; j < 4; ++j) w[j] = pack2(tile[(kc * 8 + 2 * j) * 65 + n], tile[(kc * 8 + 2 * j + 1) * 65 + n]);
    *reinterpret_cast<uint4*>(dst + (size_t)(n0 + n) * K + k0 + kc * 8) = make_uint4(w[0], w[1], w[2], w[3]);
  }
  __syncthreads();
}

DEV void phase_prologue(const Params& P, char* smem) {
  const int tid = my_tid();
  constexpr int TPL = 4672;
  for (int it = blockIdx.x; it < 2 * TPL; it += gridDim.x) {
    int l = it / TPL, t = it % TPL;
    u16* Wl = WS_W(P) + (size_t)l * W_LAYER;
    if (t < 1152) {
      tr_tile(P.w_in + (size_t)l * 1024 * INW, INW, Wl + W_IN, 1024, (t / 16) * 64, (t % 16) * 64, 0, smem);
    } else if (t < 1920) {
      t -= 1152;
      tr_tile(P.w_in + (size_t)l * 1024 * INW, INW, Wl + W_G, 1024, (t / 16) * 64, (t % 16) * 64, 1, smem);
    } else if (t < 2304) {
      t -= 1920;
      int i = t / 128;
      t %= 128;
      tr_tile(P.w_branch + ((size_t)l * 3 + i) * 512 * 1024, 1024, Wl + W_B + (size_t)i * 1024 * 512, 512, (t / 8) * 64, (t % 8) * 64, 2, smem);
    } else if (t < 2560) {
      t -= 2304;
      tr_tile(P.w_out + (size_t)l * 1024 * 1024, 1024, Wl + W_O, 1024, (t / 16) * 64, (t % 16) * 64, 2, smem);
    } else if (t < 3968) {
      t -= 2560;
      tr_tile(P.w_ffn_in + (size_t)l * 1024 * 5632, 5632, Wl + W_FI, 1024, (t / 16) * 64, (t % 16) * 64, 3, smem);
    } else {
      t -= 3968;
      tr_tile(P.w_ffn_out + (size_t)l * FH * 1024, 1024, Wl + W_FO, FH, (t / 44) * 64, (t % 44) * 64, 2, smem);
    }
  }
  for (int it = blockIdx.x; it < 384; it += gridDim.x) {
    int l = it / 192, n0 = (it % 192) * 32;
    float* sc = reinterpret_cast<float*>(smem);
    float* red = sc + 17 * 1024;
    __syncthreads();
    for (int idx = tid; idx < 17 * 1024; idx += NTHREADS) {
      int cond = idx >> 10, k = idx & 1023;
      float cv = cond < 16 ? P.c[cond * 1024 + k] : P.c_ctx[k];
      sc[idx] = siluf_(cv);
    }
    __syncthreads();
    int col = tid & 31, ks = tid >> 5;
    float acc[17];
#pragma unroll
    for (int j = 0; j < 17; ++j) acc[j] = 0.f;
    const float* wm = P.w_mod + (size_t)l * 1024 * 6144 + n0 + col;
    for (int k = ks * 64; k < ks * 64 + 64; ++k) {
      float w = wm[(size_t)k * 6144];
#pragma unroll
      for (int j = 0; j < 17; ++j) acc[j] += sc[j * 1024 + k] * w;
    }
#pragma unroll
    for (int j = 0; j < 17; ++j) red[(ks * 17 + j) * 32 + col] = acc[j];
    __syncthreads();
    for (int o = tid; o < 17 * 32; o += NTHREADS) {
      int j = o >> 5, cc = o & 31;
      float s = 0.f;
      for (int q = 0; q < 16; ++q) s += red[(q * 17 + j) * 32 + cc];
      WS_MOD(P)[((size_t)l * 17 + j) * 6144 + n0 + cc] = s + P.b_mod[l * 6144 + n0 + cc];
    }
  }
  for (int idx = blockIdx.x * NTHREADS + tid; idx < T * 32; idx += gridDim.x * NTHREADS) {
    int t = idx >> 5, j = idx & 31;
    int pos = j < 16 ? (t >> 6) : (t & 63);
    float inv = powf(10000.f, -(float)(j & 15) / 16.f);
    float ang = (float)pos * inv;
    WS_ROPE(P)[idx * 2] = cosf(ang);
    WS_ROPE(P)[idx * 2 + 1] = sinf(ang);
  }
  for (int idx = blockIdx.x * NTHREADS + tid; idx < NCTXR * 1024 / 4; idx += gridDim.x * NTHREADS)
    reinterpret_cast<float4*>(WS_XC(P))[idx] = reinterpret_cast<const float4*>(P.ctx)[idx];
  if (blockIdx.x == 0 && tid < 64) {
    for (int l = 0; l < 2; ++l) {
      float a = wave_sum(P.lam_q1[l * 64 + tid] * P.lam_k1[l * 64 + tid]);
      float b = wave_sum(P.lam_q2[l * 64 + tid] * P.lam_k2[l * 64 + tid]);
      float lam_init = 0.8f - 0.6f * expf(-0.3f * (float)l);
      if (tid == 0) WS_LAM(P)[l] = expf(a) - expf(b) + lam_init;
    }
    if (tid < 8) WS_CTR(P)[tid] = 0u;
  }
}

DEV void phase_norm_mod(const Params& P, const float* xlat, const float* xctx, int nrows, const float* g,
                        const float* modl, int sh_off, int sc_off) {
  const int lane = my_tid() & 63, wid = my_tid() >> 6;
  for (int row = blockIdx.x * 8 + wid; row < nrows; row += gridDim.x * 8) {
    const float* src = row < NLAT ? xlat + (size_t)row * 1024 : xctx + (size_t)(row - NLAT) * 1024;
    int cond = row < NLAT ? row >> 12 : 16;
    const float* md = modl + (size_t)cond * 6144;
    float4 v[4];
    float ss = 0.f;
#pragma unroll
    for (int i = 0; i < 4; ++i) {
      v[i] = *reinterpret_cast<const float4*>(src + i * 256 + lane * 4);
      ss += v[i].x * v[i].x + v[i].y * v[i].y + v[i].z * v[i].z + v[i].w * v[i].w;
    }
    ss = wave_sum(ss);
    float rstd = rsqrtf(ss * (1.f / 1024.f) + EPS);
#pragma unroll
    for (int i = 0; i < 4; ++i) {
      int cb = i * 256 + lane * 4;
      float4 gg = *reinterpret_cast<const float4*>(g + cb);
      float4 sh = *reinterpret_cast<const float4*>(md + sh_off + cb);
      float4 sc = *reinterpret_cast<const float4*>(md + sc_off + cb);
      float y0 = v[i].x * rstd * gg.x * (1.f + sc.x) + sh.x;
      float y1 = v[i].y * rstd * gg.y * (1.f + sc.y) + sh.y;
      float y2 = v[i].z * rstd * gg.z * (1.f + sc.z) + sh.z;
      float y3 = v[i].w * rstd * gg.w * (1.f + sc.w) + sh.w;
      *reinterpret_cast<uint2*>(WS_H(P) + (size_t)row * 1024 + cb) = make_uint2(pack2(y0, y1), pack2(y2, y3));
    }
  }
}

DEV void phase_final_norm(const Params& P) {
  const int lane = my_tid() & 63, wid = my_tid() >> 6;
  for (int row = blockIdx.x * 8 + wid; row < NLAT; row += gridDim.x * 8) {
    float* src = P.out + (size_t)row * 1024;
    float4 v[4];
    float ss = 0.f;
#pragma unroll
    for (int i = 0; i < 4; ++i) {
      v[i] = *reinterpret_cast<const float4*>(src + i * 256 + lane * 4);
      ss += v[i].x * v[i].x + v[i].y * v[i].y + v[i].z * v[i].z + v[i].w * v[i].w;
    }
    ss = wave_sum(ss);
    float rstd = rsqrtf(ss * (1.f / 1024.f) + EPS);
#pragma unroll
    for (int i = 0; i < 4; ++i) {
      int cb = i * 256 + lane * 4;
      float4 gg = *reinterpret_cast<const float4*>(P.g_final + cb);
      float4 o = make_float4(v[i].x * rstd * gg.x, v[i].y * rstd * gg.y, v[i].z * rstd * gg.z, v[i].w * rstd * gg.w);
      *reinterpret_cast<float4*>(src + cb) = o;
    }
  }
}

struct EpiInProj {
  const Params& P;
  int l;
  DEV void operator()(f32x4 (&acc)[8][4], int row0, int col0) const {
    const int lane = my_tid() & 63, fr = lane & 15, fq = lane >> 4;
    if (col0 >= 4416) return;
    if (col0 < C_WQ) {
#pragma unroll
      for (int mi = 0; mi < 8; ++mi)
#pragma unroll
        for (int ni = 0; ni < 4; ++ni)
#pragma unroll
          for (int j = 0; j < 4; ++j)
            WS_P(P)[(size_t)(row0 + mi * 16 + fq * 4 + j) * PW + col0 + ni * 16 + fr] = f2bf(acc[mi][ni][j]);
    } else if (col0 < 3712) {
      const bool isq = (col0 < C_WK) || (col0 >= C_DQ && col0 < C_DK);
      const float qs = isq ? 0.125f : 1.f;
#pragma unroll
      for (int mi = 0; mi < 8; ++mi)
#pragma unroll
        for (int j = 0; j < 4; ++j) {
          int row = row0 + mi * 16 + fq * 4 + j;
          u16* dst = WS_P(P) + (size_t)row * PW + col0 + fr;
          if (row < NLAT) {
            int t = row & (T - 1);
            const float2* rt = reinterpret_cast<const float2*>(WS_ROPE(P)) + t * 32;
#pragma unroll
            for (int hf = 0; hf < 2; ++hf) {
              float2 cs = rt[hf * 16 + fr];
              float x1 = acc[mi][hf * 2][j], x2 = acc[mi][hf * 2 + 1][j];
              dst[hf * 32] = f2bf((x1 * cs.x - x2 * cs.y) * qs);
              dst[hf * 32 + 16] = f2bf((x2 * cs.x + x1 * cs.y) * qs);
            }
          } else {
#pragma unroll
            for (int ni = 0; ni < 4; ++ni) dst[ni * 16] = f2bf(acc[mi][ni][j] * qs);
          }
        }
    } else if (col0 < 4352) {
      u16* base;
      int vrow0;
      const int hdW = (col0 - 3712) >> 6;
      const int hdD = (col0 - 3840) >> 7;
      const bool isw = col0 < 3840;
#pragma unroll
      for (int mi = 0; mi < 8; ++mi) {
        int row = row0 + mi * 16 + fq * 4;
        int b, key;
        if (row < NLAT) { b = row >> 12; key = 256 + (row & (T - 1)); }
        else { b = (row - NLAT) >> 8; key = (row - NLAT) & 255; }
        if (isw) { base = WS_VTW(P) + ((size_t)(b * 2 + hdW) * 64) * KEYS; vrow0 = 0; }
        else { base = WS_VTD(P) + ((size_t)(b * 4 + hdD) * 128) * KEYS; vrow0 = (col0 - 3840) & 127; }
#pragma unroll
        for (int ni = 0; ni < 4; ++ni) {
          int v = vrow0 + ni * 16 + fr;
          *reinterpret_cast<uint2*>(base + (size_t)v * KEYS + key) =
              make_uint2(pack2(acc[mi][ni][0], acc[mi][ni][1]), pack2(acc[mi][ni][2], acc[mi][ni][3]));
        }
      }
    } else {
      float bg = P.b_gate[l * 16 + fr];
#pragma unroll
      for (int mi = 0; mi < 8; ++mi)
#pragma unroll
        for (int j = 0; j < 4; ++j) WS_GATES(P)[(size_t)(row0 + mi * 16 + fq * 4 + j) * 16 + fr] = acc[mi][0][j] + bg;
    }
  }
};

template <int QB, int VB, int KW>
struct AttnCore {
  static constexpr int DV = 32 * VB;
  static constexpr int KST = KW * 2 + 16;
  static constexpr int VST = 128 + 16;
  static constexpr int KBYTES = 64 * KST, VBYTES = DV * VST;
  static constexpr int NKL = 64 * (KW / 8) / NTHREADS, NVL = DV * 8 / NTHREADS;
  static constexpr int TOTAL = 2 * (KBYTES + VBYTES);

  static DEV void run(const u16* qptr, int ldq, const u16* kctx, const u16* klat, int ldk, int kcol, const u16* vt,
                      int nctx, int nlat, int lat_t0, bool window, int qtok0, float m_init, float l_init,
                      f32x16 (&O)[QB][VB], char* smem) {
    const int tid = my_tid(), lane = tid & 63, r = lane & 31, hh = lane >> 5;
    char* Ks = smem;
    char* Vs = smem + 2 * KBYTES;
    bf16x8 qf[QB][4];
#pragma unroll
    for (int qb = 0; qb < QB; ++qb)
#pragma unroll
      for (int ks = 0; ks < 4; ++ks) qf[qb][ks] = ld16(qptr + (size_t)(qb * 32 + r) * ldq + ks * 16 + hh * 8);
    float m[QB], lsum[QB];
#pragma unroll
    for (int qb = 0; qb < QB; ++qb) {
      m[qb] = m_init;
      lsum[qb] = hh == 0 ? l_init : 0.f;
#pragma unroll
      for (int vb = 0; vb < VB; ++vb)
#pragma unroll
        for (int i = 0; i < 16; ++i) O[qb][vb][i] = 0.f;
    }
    bf16x8 rk[NKL], rv[NVL];
    const int ntiles = nctx + nlat;
    auto gload = [&](int j) {
      int kidx = j < nctx ? j * 64 : 256 + lat_t0 + (j - nctx) * 64;
      const u16* krow = j < nctx ? kctx + (size_t)(j * 64) * ldk : klat + (size_t)(lat_t0 + (j - nctx) * 64) * ldk;
#pragma unroll
      for (int i = 0; i < NKL; ++i) {
        int id = tid + i * NTHREADS, row = id / (KW / 8), c = id % (KW / 8);
        rk[i] = ld16(krow + (size_t)row * ldk + c * 8);
      }
#pragma unroll
      for (int i = 0; i < NVL; ++i) {
        int id = tid + i * NTHREADS, row = id >> 3, c = id & 7;
        rv[i] = ld16(vt + (size_t)row * KEYS + kidx + c * 8);
      }
    };
    auto lstore = [&](int buf) {
#pragma unroll
      for (int i = 0; i < NKL; ++i) {
        int id = tid + i * NTHREADS, row = id / (KW / 8), c = id % (KW / 8);
        *reinterpret_cast<bf16x8*>(Ks + buf * KBYTES + row * KST + c * 16) = rk[i];
      }
#pragma unroll
      for (int i = 0; i < NVL; ++i) {
        int id = tid + i * NTHREADS, row = id >> 3, c = id & 7;
        *reinterpret_cast<bf16x8*>(Vs + buf * VBYTES + row * VST + c * 16) = rv[i];
      }
    };
    __syncthreads();
    gload(0);
    lstore(0);
    __syncthreads();
    for (int j = 0; j < ntiles; ++j) {
      const int buf = j & 1;
      if (j + 1 < ntiles) gload(j + 1);
      bf16x8 pf[QB][2][2];
#pragma unroll
      for (int qb = 0; qb < QB; ++qb) {
        f32x16 S[2];
#pragma unroll
        for (int kb = 0; kb < 2; ++kb) {
#pragma unroll
          for (int i = 0; i < 16; ++i) S[kb][i] = 0.f;
#pragma unroll
          for (int ks = 0; ks < 4; ++ks) {
            bf16x8 kf = ld16(Ks + buf * KBYTES + (kb * 32 + pi32(r)) * KST + (kcol + ks * 16 + hh * 8) * 2);
            S[kb] = mfma32(kf, qf[qb][ks], S[kb]);
          }
        }
        __builtin_amdgcn_sched_barrier(0);
        if (window && j >= nctx) {
          int kt0 = lat_t0 + (j - nctx) * 64;
          int qt = qtok0 + qb * 32 + r;
#pragma unroll
          for (int kb = 0; kb < 2; ++kb)
#pragma unroll
            for (int i = 0; i < 16; ++i) {
              int kt = kt0 + kb * 32 + 16 * (i >> 3) + 8 * hh + (i & 7);
              int dlt = qt - kt;
              if (dlt > 128 || dlt < -128) S[kb][i] = -1e30f;
            }
        }
        float mloc = -1e30f;
#pragma unroll
        for (int kb = 0; kb < 2; ++kb)
#pragma unroll
          for (int i = 0; i < 16; ++i) mloc = fmaxf(mloc, S[kb][i]);
        mloc = fmaxf(mloc, __shfl_xor(mloc, 32));
        if (__any(mloc > m[qb] + 5.5f)) {
          float mnew = fmaxf(m[qb], mloc);
          float alpha = fexp2((m[qb] - mnew) * L2E);
          m[qb] = mnew;
          lsum[qb] *= alpha;
#pragma unroll
          for (int vb = 0; vb < VB; ++vb)
#pragma unroll
            for (int i = 0; i < 16; ++i) O[qb][vb][i] *= alpha;
        }
        float mb = m[qb] * L2E, ps = 0.f;
#pragma unroll
        for (int kb = 0; kb < 2; ++kb) {
          float pv[16];
#pragma unroll
          for (int i = 0; i < 16; ++i) {
            pv[i] = fexp2(S[kb][i] * L2E - mb);
            ps += pv[i];
          }
#pragma unroll
          for (int s = 0; s < 2; ++s)
            pf[qb][kb][s] = mk8(pack2(pv[8 * s], pv[8 * s + 1]), pack2(pv[8 * s + 2], pv[8 * s + 3]),
                                pack2(pv[8 * s + 4], pv[8 * s + 5]), pack2(pv[8 * s + 6], pv[8 * s + 7]));
        }
        lsum[qb] += ps;
        __builtin_amdgcn_sched_barrier(0);
      }
      __builtin_amdgcn_sched_barrier(0);
#pragma unroll
      for (int vb = 0; vb < VB; ++vb) {
#pragma unroll
        for (int kb = 0; kb < 2; ++kb)
#pragma unroll
          for (int s = 0; s < 2; ++s) {
            bf16x8 vf = ld16(Vs + buf * VBYTES + (vb * 32 + r) * VST + (kb * 32 + s * 16 + hh * 8) * 2);
#pragma unroll
            for (int qb = 0; qb < QB; ++qb) O[qb][vb] = mfma32(vf, pf[qb][kb][s], O[qb][vb]);
          }
        __builtin_amdgcn_sched_barrier(0);
      }
      if (j + 1 < ntiles) lstore(buf ^ 1);
      __syncthreads();
    }
#pragma unroll
    for (int qb = 0; qb < QB; ++qb) {
      float lt = lsum[qb] + __shfl_xor(lsum[qb], 32);
      float inv = 1.f / lt;
#pragma unroll
      for (int vb = 0; vb < VB; ++vb)
#pragma unroll
        for (int i = 0; i < 16; ++i) O[qb][vb][i] *= inv;
    }
  }
};

DEV void diff_item(const Params& P, int l, int b, int h, int qt, bool ctxq, char* smem) {
  const int tid = my_tid(), lane = tid & 63, wid = tid >> 6, r = lane & 31, hh = lane >> 5;
  const int comp = wid >> 2, wq = wid & 3;
  const int rowbase = ctxq ? NLAT + b * 256 + qt * 128 : b * T + qt * 128;
  const u16* qptr = WS_P(P) + (size_t)(rowbase + wq * 32) * PW + C_DQ + h * 128 + comp * 64;
  const u16* kctx = WS_P(P) + (size_t)(NLAT + b * 256) * PW + C_DK + h * 128;
  const u16* klat = WS_P(P) + (size_t)(b * T) * PW + C_DK + h * 128;
  const u16* vt = WS_VTD(P) + ((size_t)(b * 4 + h) * 128) * KEYS;
  f32x16 O[1][4];
  AttnCore<1, 4, 128>::run(qptr, PW, kctx, klat, PW, comp * 64, vt, 4, ctxq ? 0 : 64, 0, false, 0, -1e30f, 0.f, O, smem);
  float* ex = reinterpret_cast<float*>(smem);
  __syncthreads();
  if (comp == 1) {
#pragma unroll
    for (int vb = 0; vb < 4; ++vb)
#pragma unroll
      for (int i = 0; i < 16; ++i) ex[(wq * 64 + vb * 16 + i) * 64 + lane] = O[0][vb][i];
  }
  __syncthreads();
  if (comp == 0) {
    const float lam = WS_LAM(P)[l];
    const float lam_init = 0.8f - 0.6f * expf(-0.3f * (float)l);
    float ss = 0.f;
#pragma unroll
    for (int vb = 0; vb < 4; ++vb)
#pragma unroll
      for (int i = 0; i < 16; ++i) {
        float y = O[0][vb][i] - lam * ex[(wq * 64 + vb * 16 + i) * 64 + lane];
        O[0][vb][i] = y;
        ss += y * y;
      }
    ss += __shfl_xor(ss, 32);
    float sc = rsqrtf(ss * (1.f / 128.f) + EPS) * (1.f - lam_init);
    const float* dn = P.d_norm + l * 512 + h * 128;
    u16* dst = WS_P(P) + (size_t)(rowbase + wq * 32 + r) * PW + C_DQ + h * 128;
#pragma unroll
    for (int vb = 0; vb < 4; ++vb)
#pragma unroll
      for (int g4 = 0; g4 < 4; ++g4) {
        int v = vb * 32 + g4 * 8 + hh * 4;
        float4 w = *reinterpret_cast<const float4*>(dn + v);
        *reinterpret_cast<uint2*>(dst + v) =
            make_uint2(pack2(O[0][vb][g4 * 4] * sc * w.x, O[0][vb][g4 * 4 + 1] * sc * w.y),
                       pack2(O[0][vb][g4 * 4 + 2] * sc * w.z, O[0][vb][g4 * 4 + 3] * sc * w.w));
      }
  }
  __syncthreads();
}

DEV void win_item(const Params& P, int l, int b, int g, int qb, bool ctxq, char* smem) {
  const int tid = my_tid(), lane = tid & 63, wid = tid >> 6, r = lane & 31, hh = lane >> 5;
  const int hr = wid >> 1, qh = wid & 1;
  const int head = g * 4 + hr;
  const int rowbase = (ctxq ? NLAT + b * 256 + qb * 64 : b * T + qb * 64) + qh * 32;
  const u16* qptr = WS_P(P) + (size_t)rowbase * PW + C_WQ + head * 64;
  const u16* kctx = WS_P(P) + (size_t)(NLAT + b * 256) * PW + C_WK + g * 64;
  const u16* klat = WS_P(P) + (size_t)(b * T) * PW + C_WK + g * 64;
  const u16* vt = WS_VTW(P) + ((size_t)(b * 2 + g) * 64) * KEYS;
  int t0 = 0, nlat = 0;
  if (!ctxq) {
    t0 = qb * 64 - 128;
    if (t0 < 0) t0 = 0;
    int t1 = qb * 64 + 192;
    if (t1 > T) t1 = T;
    nlat = (t1 - t0) >> 6;
  }
  f32x16 O[1][2];
  AttnCore<1, 2, 64>::run(qptr, PW, kctx, klat, PW, 0, vt, 4, nlat, t0, !ctxq, qb * 64 + qh * 32, P.sink[l * 8 + head], 1.f, O, smem);
  u16* dst = WS_P(P) + (size_t)(rowbase + r) * PW + C_WQ + head * 64;
#pragma unroll
  for (int vb = 0; vb < 2; ++vb)
#pragma unroll
    for (int g4 = 0; g4 < 4; ++g4) {
      int v = vb * 32 + g4 * 8 + hh * 4;
      *reinterpret_cast<uint2*>(dst + v) = make_uint2(pack2(O[0][vb][g4 * 4], O[0][vb][g4 * 4 + 1]),
                                                        pack2(O[0][vb][g4 * 4 + 2], O[0][vb][g4 * 4 + 3]));
    }
}

DEV void mlstm_item(const Params& P, int l, int b, int hd, int dir, bool need_ctx, char* smem) {
  const int tid = my_tid(), lane = tid & 63, wid = tid >> 6, r = lane & 31, hh = lane >> 5;
  constexpr int QST = 272, TST = 144;
  char* Qs = smem;
  char* Ks = Qs + 64 * QST;
  char* KwT = Ks + 64 * QST;
  char* VT = KwT + 128 * TST;
  char* Sp = VT + 128 * TST;
  char* Rq = Sp + 64 * TST;
  char* Rk = Rq + 66 * QST;
  float* fb = reinterpret_cast<float*>(Rk + 66 * QST);
  float* sb = fb;
  float* sa = fb + 64;
  float* sM = fb + 128;
  float* denp = fb + 192;
  float* qn = fb + 320;
  float* nb = fb + 384;
  float* cw = fb + 640;
  __syncthreads();
  if (tid < 256) nb[tid] = 0.f;
  for (int i = tid; i < 768; i += NTHREADS) {
    int qk = i / 384, tap = (i % 384) / 128, d = i & 127;
    cw[i] = P.conv_w[(size_t)l * 3 * 1024 + tap * 1024 + qk * 512 + hd * 128 + d];
  }
  f32x16 CT[4];
#pragma unroll
  for (int kb = 0; kb < 4; ++kb)
#pragma unroll
    for (int i = 0; i < 16; ++i) CT[kb][i] = 0.f;
  float mstate = 0.f;
  u16* hout = WS_HFB(P) + (size_t)dir * MTOT * 512;
  const float kscale = 0.08838834764831845f;

  auto geom = [&](int step, int& seg0, int& seglen, int& u0) {
    int c;
    if (step < 4) { seg0 = NLAT + b * 256; seglen = 256; c = dir ? 3 - step : step; }
    else { seg0 = b * T; seglen = T; c = dir ? 67 - step : step - 4; }
    u0 = c * 64;
  };
  bf16x8 pq[3], pk[3], pvv[2];
  float pig = 0.f, pfg = 0.f;
  auto issue_loads = [&](int step) {
    int seg0, seglen, u0;
    geom(step, seg0, seglen, u0);
#pragma unroll
    for (int i = 0; i < 3; ++i) {
      int id = tid + i * NTHREADS;
      bf16x8 z = {0, 0, 0, 0, 0, 0, 0, 0};
      pq[i] = z;
      pk[i] = z;
      if (id < 66 * 16) {
        int row = id >> 4, cc = id & 15;
        int uu = u0 + row - 1;
        bool ok = uu >= 0 && uu < seglen;
        const u16* src = WS_P(P) + (size_t)(seg0 + (ok ? uu : 0)) * PW + hd * 128 + cc * 8;
        if (ok) { pq[i] = ld16(src + C_MQ); pk[i] = ld16(src + C_MK); }
      }
    }
#pragma unroll
    for (int i = 0; i < 2; ++i) {
      int id = tid + i * NTHREADS, u = id >> 4, cc = id & 15;
      pvv[i] = ld16(WS_P(P) + (size_t)(seg0 + u0 + u) * PW + C_MV + hd * 128 + cc * 8);
    }
    if (wid == 0) {
      const int pos = dir ? 63 - lane : lane;
      const float* gp = WS_GATES(P) + (size_t)(seg0 + u0 + pos) * 16;
      pig = gp[(dir * 2) * 4 + hd];
      pfg = gp[(dir * 2 + 1) * 4 + hd];
    }
  };
  issue_loads(0);

  for (int step = 0; step < 68; ++step) {
    int seg0, seglen, u0;
    geom(step, seg0, seglen, u0);
    const int rowbase = seg0 + u0;
    const int cur = step & 1;
    __syncthreads();
    bf16x8 rvv[2];
#pragma unroll
    for (int i = 0; i < 3; ++i) {
      int id = tid + i * NTHREADS;
      if (id < 66 * 16) {
        int row = id >> 4, cc = id & 15;
        *reinterpret_cast<bf16x8*>(Rq + row * QST + cc * 16) = pq[i];
        *reinterpret_cast<bf16x8*>(Rk + row * QST + cc * 16) = pk[i];
      }
    }
    rvv[0] = pvv[0];
    rvv[1] = pvv[1];
    const float ig = pig, fg = pfg;
    if (step + 1 < 68) issue_loads(step + 1);
    if (wid == 0) {
      const int pos = dir ? 63 - lane : lane;
      float lf = fminf(fg, 0.f) - log1pf(__expf(-fabsf(fg)));
      float bsum = lf;
#pragma unroll
      for (int o = 1; o < 64; o <<= 1) { float t2 = __shfl_up(bsum, o); if (lane >= o) bsum += t2; }
      float a = ig - bsum, am = a;
#pragma unroll
      for (int o = 1; o < 64; o <<= 1) { float t2 = __shfl_up(am, o); if (lane >= o) am = fmaxf(am, t2); }
      sb[pos] = bsum;
      sa[pos] = a;
      sM[pos] = fmaxf(mstate, am);
    }
    __syncthreads();
    const int eidx = dir ? 0 : 63;
    const float Mend = sM[eidx], bend = sb[eidx];
    const float decay = __expf(mstate - Mend);
#pragma unroll 1
    for (int i = 0; i < 2; ++i) {
      int id = tid + i * NTHREADS, u = id >> 4, cc = id & 15;
      float wend = __expf(sa[u] - Mend);
      uint32_t qo[4], ko[4];
      float kv[8];
      bf16x8 q0 = ld16(Rq + (u)*QST + cc * 16), q1 = ld16(Rq + (u + 1) * QST + cc * 16), q2 = ld16(Rq + (u + 2) * QST + cc * 16);
      bf16x8 k0 = ld16(Rk + (u)*QST + cc * 16), k1 = ld16(Rk + (u + 1) * QST + cc * 16), k2 = ld16(Rk + (u + 2) * QST + cc * 16);
#pragma unroll
      for (int e = 0; e < 8; ++e) {
        int d = cc * 8 + e;
        float xq = cw[0 * 128 + d] * bf2f((u16)q0[e]) + cw[1 * 128 + d] * bf2f((u16)q1[e]) + cw[2 * 128 + d] * bf2f((u16)q2[e]);
        float xk = cw[384 + 0 * 128 + d] * bf2f((u16)k0[e]) + cw[384 + 1 * 128 + d] * bf2f((u16)k1[e]) + cw[384 + 2 * 128 + d] * bf2f((u16)k2[e]);
        float qv = siluf_(xq);
        kv[e] = siluf_(xk) * kscale;
        if (e & 1) { qo[e >> 1] |= ((uint32_t)f2bf(qv)) << 16; ko[e >> 1] |= ((uint32_t)f2bf(kv[e])) << 16; }
        else { qo[e >> 1] = f2bf(qv); ko[e >> 1] = f2bf(kv[e]); }
        *reinterpret_cast<u16*>(KwT + (d)*TST + u * 2) = f2bf(kv[e] * wend);
        *reinterpret_cast<u16*>(VT + (d)*TST + u * 2) = (u16)rvv[i][e];
      }
      *reinterpret_cast<uint4*>(Qs + u * QST + cc * 16) = make_uint4(qo[0], qo[1], qo[2], qo[3]);
      *reinterpret_cast<uint4*>(Ks + u * QST + cc * 16) = make_uint4(ko[0], ko[1], ko[2], ko[3]);
    }
    __syncthreads();
    if (wid < 4) {
      const int sblk = wid & 1, tblk = wid >> 1;
      f32x16 S;
#pragma unroll
      for (int i = 0; i < 16; ++i) S[i] = 0.f;
#pragma unroll
      for (int ks = 0; ks < 8; ++ks) {
        bf16x8 kf = ld16(Ks + (sblk * 32 + pi32(r)) * QST + (ks * 16 + hh * 8) * 2);
        bf16x8 qf = ld16(Qs + (tblk * 32 + r) * QST + (ks * 16 + hh * 8) * 2);
        S = mfma32(kf, qf, S);
      }
      const int t = tblk * 32 + r;
      const float Mt = sM[t];
      float ds = 0.f, val[16];
#pragma unroll
      for (int i = 0; i < 16; ++i) {
        int s = sblk * 32 + 16 * (i >> 3) + 8 * hh + (i & 7);
        bool ok = dir ? (s >= t) : (s <= t);
        val[i] = ok ? S[i] * __expf(sa[s] - Mt) : 0.f;
        ds += val[i];
      }
      ds += __shfl_xor(ds, 32);
      if (hh == 0) denp[sblk * 64 + t] = ds;
#pragma unroll
      for (int s2 = 0; s2 < 2; ++s2)
        *reinterpret_cast<uint4*>(Sp + t * TST + (sblk * 32 + s2 * 16 + hh * 8) * 2) =
            make_uint4(pack2(val[8 * s2], val[8 * s2 + 1]), pack2(val[8 * s2 + 2], val[8 * s2 + 3]),
                       pack2(val[8 * s2 + 4], val[8 * s2 + 5]), pack2(val[8 * s2 + 6], val[8 * s2 + 7]));
    } else if (wid == 4) {
      float s = 0.f;
      const float* nc = nb + cur * 128;
      for (int k8 = 0; k8 < 16; ++k8) {
        bf16x8 qv = ld16(Qs + lane * QST + k8 * 16);
#pragma unroll
        for (int e = 0; e < 8; ++e) s += nc[k8 * 8 + e] * bf2f((u16)qv[e]);
      }
      qn[lane] = s;
    } else if (wid == 5) {
      const float* nc = nb + cur * 128;
      float* nn = nb + (cur ^ 1) * 128;
#pragma unroll
      for (int q2 = 0; q2 < 2; ++q2) {
        int k = lane + q2 * 64;
        float s = 0.f;
        for (int s8 = 0; s8 < 8; ++s8) {
          bf16x8 kv = ld16(KwT + k * TST + s8 * 16);
#pragma unroll
          for (int e = 0; e < 8; ++e) s += bf2f((u16)kv[e]);
        }
        nn[k] = decay * nc[k] + s;
      }
    }
    __syncthreads();
    {
      bf16x8 vf[4];
      const int vb = wid & 3, tb = wid >> 2;
#pragma unroll
      for (int ks = 0; ks < 4; ++ks) vf[ks] = ld16(VT + (vb * 32 + r) * TST + (ks * 16 + hh * 8) * 2);
      const bool wr_h = (step >= 4) || need_ctx;
      {
        const int t = tb * 32 + r;
        f32x16 acc;
#pragma unroll
        for (int i = 0; i < 16; ++i) acc[i] = 0.f;
#pragma unroll
        for (int kb = 0; kb < 4; ++kb)
#pragma unroll
          for (int s2 = 0; s2 < 2; ++s2) {
            bf16x8 af = mk8(pack2(CT[kb][8 * s2], CT[kb][8 * s2 + 1]), pack2(CT[kb][8 * s2 + 2], CT[kb][8 * s2 + 3]),
                            pack2(CT[kb][8 * s2 + 4], CT[kb][8 * s2 + 5]), pack2(CT[kb][8 * s2 + 6], CT[kb][8 * s2 + 7]));
            uint2 lo = *reinterpret_cast<const uint2*>(Qs + t * QST + (kb * 32 + s2 * 16 + hh * 4) * 2);
            uint2 hi = *reinterpret_cast<const uint2*>(Qs + t * QST + (kb * 32 + s2 * 16 + 8 + hh * 4) * 2);
            acc = mfma32(af, mk8(lo.x, lo.y, hi.x, hi.y), acc);
          }
        const float Mt = sM[t];
        const float winter = __expf(mstate - Mt);
#pragma unroll
        for (int i = 0; i < 16; ++i) acc[i] *= winter;
#pragma unroll
        for (int ks = 0; ks < 4; ++ks) {
          bf16x8 sf = ld16(Sp + t * TST + (ks * 16 + hh * 8) * 2);
          acc = mfma32(vf[ks], sf, acc);
        }
        float den = denp[t] + denp[64 + t] + winter * qn[t];
        float sc = 1.f / fmaxf(fabsf(den), __expf(-(sb[t] + Mt)));
        if (wr_h) {
          u16* dst = hout + (size_t)(rowbase + t) * 512 + hd * 128 + vb * 32;
#pragma unroll
          for (int g4 = 0; g4 < 4; ++g4)
            *reinterpret_cast<uint2*>(dst + g4 * 8 + hh * 4) =
                make_uint2(pack2(acc[g4 * 4] * sc, acc[g4 * 4 + 1] * sc), pack2(acc[g4 * 4 + 2] * sc, acc[g4 * 4 + 3] * sc));
        }
      }
#pragma unroll
      for (int kb = 0; kb < 4; ++kb) {
#pragma unroll
        for (int i = 0; i < 16; ++i) CT[kb][i] *= decay;
#pragma unroll
        for (int ks = 0; ks < 4; ++ks) {
          bf16x8 kf = ld16(KwT + (kb * 32 + r) * TST + (ks * 16 + hh * 8) * 2);
          CT[kb] = mfma32(kf, vf[ks], CT[kb]);
        }
      }
    }
    mstate = bend + Mend;
  }
  __syncthreads();
}

DEV int next_item(unsigned* ctr, int* s_item) {
  __syncthreads();
  if (my_tid() == 0) *s_item = (int)atomicAdd(ctr, 1u);
  __syncthreads();
  return *s_item;
}
DEV void phase_mixers(const Params& P, int l, char* smem) {
  const bool need_ctx = (l == 0);
  __shared__ int s_item;
  const int n_ml = 128, n_diff = 2048, n_win = 2048, n_dc = need_ctx ? 128 : 0, n_wc = need_ctx ? 128 : 0;
  for (;;) {
    int it = next_item(&WS_CTR(P)[l * 4 + 0], &s_item);
    if (it >= n_ml) break;
    mlstm_item(P, l, it >> 3, (it >> 1) & 3, it & 1, need_ctx, smem);
  }
  for (;;) {
    int it = next_item(&WS_CTR(P)[l * 4 + 1], &s_item);
    if (it >= n_diff + n_dc) break;
    bool cq = it >= n_diff;
    int i2 = it - n_diff;
    int b = cq ? i2 >> 3 : it >> 7, hd = cq ? (i2 >> 1) & 3 : (it >> 5) & 3, qt = cq ? i2 & 1 : it & 31;
    diff_item(P, l, b, hd, qt, cq, smem);
  }
  for (;;) {
    int it = next_item(&WS_CTR(P)[l * 4 + 2], &s_item);
    if (it >= n_win + n_wc) break;
    bool cq = it >= n_win;
    int i2 = it - n_win;
    int b = cq ? i2 >> 3 : it >> 7, g = cq ? (i2 >> 2) & 1 : (it >> 6) & 1, qb = cq ? i2 & 3 : it & 63;
    win_item(P, l, b, g, qb, cq, smem);
  }
}

DEV void phase_ya(const Params& P, int l, int nrows) {
  const int lane = my_tid() & 63, wid = my_tid() >> 6;
  const u16* hf = WS_HFB(P);
  const u16* hb = WS_HFB(P) + (size_t)MTOT * 512;
  for (int row = blockIdx.x * 8 + wid; row < nrows; row += gridDim.x * 8) {
    uint4 a = *reinterpret_cast<const uint4*>(hf + (size_t)row * 512 + lane * 8);
    uint4 bq = *reinterpret_cast<const uint4*>(hb + (size_t)row * 512 + lane * 8);
    uint4 o = *reinterpret_cast<const uint4*>(WS_P(P) + (size_t)row * PW + C_MO + lane * 8);
    uint32_t aa[4] = {a.x, a.y, a.z, a.w}, bb[4] = {bq.x, bq.y, bq.z, bq.w}, oo[4] = {o.x, o.y, o.z, o.w};
    float y[8], ss = 0.f;
#pragma unroll
    for (int j = 0; j < 4; ++j) {
      y[2 * j] = (bflo(aa[j]) + bflo(bb[j])) * sigmoidf_(bflo(oo[j]));
      y[2 * j + 1] = (bfhi(aa[j]) + bfhi(bb[j])) * sigmoidf_(bfhi(oo[j]));
      ss += y[2 * j] * y[2 * j] + y[2 * j + 1] * y[2 * j + 1];
    }
#pragma unroll
    for (int of = 1; of < 16; of <<= 1) ss += __shfl_xor(ss, of);
    float rstd = rsqrtf(ss * (1.f / 128.f) + EPS);
    const float* mn = P.m_norm + l * 512 + lane * 8;
    uint32_t w[4];
#pragma unroll
    for (int j = 0; j < 4; ++j) w[j] = pack2(y[2 * j] * rstd * mn[2 * j], y[2 * j + 1] * rstd * mn[2 * j + 1]);
    *reinterpret_cast<uint4*>(WS_P(P) + (size_t)row * PW + C_MO + lane * 8) = make_uint4(w[0], w[1], w[2], w[3]);
  }
}

DEV void phase_merge(const Params& P, int l, int M, char* smem) {
  const u16* Wl = WS_W(P) + (size_t)l * W_LAYER;
  u16* merged = WS_HFB(P);
  const int nM = M / 128, nN = 4;
  const int lane = my_tid() & 63, wid = my_tid() >> 6, wr = wid >> 2, wc = wid & 3, fr = lane & 15, fq = lane >> 4;
  for (int tile = blockIdx.x; tile < nM * nN; tile += gridDim.x) {
    int tm, tn;
    tile_coords(tile, nM * nN, nN, tm, tn);
    f32x4 mg[4][4];
    zero_acc<4, 4>(mg);
#pragma unroll 1
    for (int i = 0; i < 3; ++i) {
      f32x4 acc[4][4];
      zero_acc<4, 4>(acc);
      gemm_mainloop<4, 4>(WS_H(P) + (size_t)tm * 128 * 1024, 1024, Wl + W_G + (size_t)(i * 1024 + tn * 256) * 1024, 1024, 1024, acc, smem);
      uint32_t gp[4][4][2];
#pragma unroll
      for (int mi = 0; mi < 4; ++mi)
#pragma unroll
        for (int ni = 0; ni < 4; ++ni) {
          gp[mi][ni][0] = pack2(sigmoidf_(acc[mi][ni][0]), sigmoidf_(acc[mi][ni][1]));
          gp[mi][ni][1] = pack2(sigmoidf_(acc[mi][ni][2]), sigmoidf_(acc[mi][ni][3]));
        }
      zero_acc<4, 4>(acc);
      int yc = i == 0 ? C_MO : (i == 1 ? C_WQ : C_DQ);
      gemm_mainloop<4, 4>(WS_P(P) + (size_t)tm * 128 * PW + yc, PW, Wl + W_B + (size_t)i * 1024 * 512 + (size_t)(tn * 256) * 512, 512, 512, acc, smem);
#pragma unroll
      for (int mi = 0; mi < 4; ++mi)
#pragma unroll
        for (int ni = 0; ni < 4; ++ni) {
          mg[mi][ni][0] += bflo(gp[mi][ni][0]) * acc[mi][ni][0];
          mg[mi][ni][1] += bfhi(gp[mi][ni][0]) * acc[mi][ni][1];
          mg[mi][ni][2] += bflo(gp[mi][ni][1]) * acc[mi][ni][2];
          mg[mi][ni][3] += bfhi(gp[mi][ni][1]) * acc[mi][ni][3];
        }
    }
    const int row0 = tm * 128 + wr * 64, col0 = tn * 256 + wc * 64;
#pragma unroll
    for (int mi = 0; mi < 4; ++mi)
#pragma unroll
      for (int ni = 0; ni < 4; ++ni)
#pragma unroll
        for (int j = 0; j < 4; ++j)
          merged[(size_t)(row0 + mi * 16 + fq * 4 + j) * 1024 + col0 + ni * 16 + fr] = f2bf(mg[mi][ni][j]);
  }
}

struct EpiResid {
  const Params& P;
  const float* src_lat;
  const float* modl;
  int gt_off;
  DEV void operator()(f32x4 (&acc)[8][4], int row0, int col0) const {
    const int lane = my_tid() & 63, fr = lane & 15, fq = lane >> 4;
#pragma unroll
    for (int mi = 0; mi < 8; ++mi)
#pragma unroll
      for (int j = 0; j < 4; ++j) {
        int row = row0 + mi * 16 + fq * 4 + j;
        const float* src;
        float* dst;
        int cond;
        if (row < NLAT) { src = src_lat + (size_t)row * 1024; dst = P.out + (size_t)row * 1024; cond = row >> 12; }
        else { src = WS_XC(P) + (size_t)(row - NLAT) * 1024; dst = WS_XC(P) + (size_t)(row - NLAT) * 1024; cond = 16; }
        const float* gt = modl + (size_t)cond * 6144 + gt_off;
#pragma unroll
        for (int ni = 0; ni < 4; ++ni) {
          int col = col0 + ni * 16 + fr;
          dst[col] = src[col] + gt[col] * acc[mi][ni][j];
        }
      }
  }
};

struct EpiSwiglu {
  u16* act;
  DEV void operator()(f32x4 (&acc)[8][4], int row0, int col0) const {
    const int lane = my_tid() & 63, fr = lane & 15, fq = lane >> 4;
#pragma unroll
    for (int mi = 0; mi < 8; ++mi)
#pragma unroll
      for (int j = 0; j < 4; ++j) {
        int row = row0 + mi * 16 + fq * 4 + j;
#pragma unroll
        for (int pr = 0; pr < 2; ++pr) {
          float gte = acc[mi][pr * 2][j], up = acc[mi][pr * 2 + 1][j];
          act[(size_t)row * FH + ((col0 + pr * 32) >> 1) + fr] = f2bf(siluf_(gte) * up);
        }
      }
  }
};


namespace pg8 {
#define PG8_LAS __attribute__((address_space(3)))
constexpr int BM = 256, BK = 64, HALF = 128, HTB = HALF * BK * 2, NXCD = 8, WGM = 8;
DEV int lds_byte(int r, int c) { const int st = (r >> 4) * 2 + (c >> 5), rr = r & 15, cc = c & 31, ob = rr * 64 + cc * 2; return st * 1024 + (ob ^ (((ob >> 9) & 1) << 5)); }
DEV void stage_rc(int b, int& R, int& C) { const int st = b / 1024, sb = b % 1024, swz = sb ^ (((sb >> 9) & 1) << 5); R = (st >> 1) * 16 + swz / 64; C = (st & 1) * 32 + (swz % 64) / 2; }
struct Unit { int pm, pn; };
struct StaticOrder {
  int nM, nN, nwg, G, c;
  DEV void init(int M, int N, int G_, int c_) { nM = M / BM; nN = N / BM; nwg = nM * nN; G = G_; c = c_; }
  DEV bool next(int i, Unit& u) const {
    const long L = (long)i * G + c;
    if (L >= nwg) return false;
    int wgid = (int)L;
    { const int q = nwg / NXCD, r = nwg % NXCD, xcd = wgid % NXCD, off = wgid / NXCD; wgid = (xcd < r ? xcd * (q + 1) : r * (q + 1) + (xcd - r) * q) + off; }
    const int nig = WGM * nN, gid = wgid / nig, fm = gid * WGM, gsz = (nM - fm) < WGM ? (nM - fm) : WGM;
    u.pm = fm + ((wgid % nig) % gsz);
    u.pn = (wgid % nig) / gsz;
    return true;
  }
};
template <class Epi>
DEV void gemm_phase(char* smem, const u16* A, int lda, const u16* Bt, int ldb, int M, int N, int K, const Epi& E) {
  PG8_LAS unsigned char* lds = (PG8_LAS unsigned char*)smem;
  const int tid = my_tid(), wid = __builtin_amdgcn_readfirstlane(tid >> 6), lane = tid & 63, wr = wid >> 2, wc = wid & 3, fr = lane & 15, fq = lane >> 4;
  const int nt = K / BK;
  StaticOrder S;
  S.init(M, N, gridDim.x, blockIdx.x);
  unsigned voffA[2], voffB[2];
#pragma unroll
  for (int i = 0; i < 2; ++i) { int R, C; stage_rc(tid * 16 + i * 8192, R, C); voffA[i] = (unsigned)(R * lda + C) * 2u; voffB[i] = (unsigned)(R * ldb + C) * 2u; }
  const size_t kstep = (size_t)(BK * 2);
  const size_t hstepA = (size_t)HALF * lda * 2, hstepB = (size_t)HALF * ldb * 2;
  const size_t tstepA = 2 * hstepA, tstepB = 2 * hstepB;
  const unsigned ldsw = (unsigned)wid * 1024u;
  const int aoff = lds_byte(wr * 64 + fr, fq * 8), boff = lds_byte(wc * 32 + fr, fq * 8);
#define PG8_SA(b, h) (((b) * 2 + (h)) * HTB)
#define PG8_SB(b, h) ((4 + (b) * 2 + (h)) * HTB)
#define PG8_STAGE(bufoff, gbase, voff) do { _Pragma("unroll") for (int _i = 0; _i < 2; ++_i) \
        __builtin_amdgcn_global_load_lds((const unsigned*)((const char*)(gbase) + (voff)[_i]), (PG8_LAS unsigned*)(lds + (bufoff) + ldsw + _i * 8192), 16, 0, 0); } while (0)
#define PG8_LDA(dst, b, h) do { _Pragma("unroll") for (int m = 0; m < 4; ++m) _Pragma("unroll") for (int k = 0; k < 2; ++k) dst[m][k] = *(const PG8_LAS bf16x8*)(lds + PG8_SA(b, h) + aoff + m * 2048 + k * 1024); } while (0)
#define PG8_LDB(dst, b, h) do { _Pragma("unroll") for (int n = 0; n < 2; ++n) _Pragma("unroll") for (int k = 0; k < 2; ++k) dst[n][k] = *(const PG8_LAS bf16x8*)(lds + PG8_SB(b, h) + boff + n * 2048 + k * 1024); } while (0)
#define PG8_MMA(ai, bj, At, Bt_) do { __builtin_amdgcn_s_setprio(1); _Pragma("unroll") for (int m = 0; m < 4; ++m) _Pragma("unroll") for (int n = 0; n < 2; ++n) _Pragma("unroll") for (int k = 0; k < 2; ++k) \
        acc[ai][bj][m][n] = __builtin_amdgcn_mfma_f32_16x16x32_bf16(Bt_[n][k], At[m][k], acc[ai][bj][m][n], 0, 0, 0); __builtin_amdgcn_s_setprio(0); } while (0)
#define PG8_WAIT_V(n) asm volatile("s_waitcnt vmcnt(" #n ")" ::: "memory")
#define PG8_WAIT_L(n) asm volatile("s_waitcnt lgkmcnt(" #n ")" ::: "memory")
#define PG8_BAR __builtin_amdgcn_s_barrier()
#define PG8_SCHED __builtin_amdgcn_sched_barrier(0)
  Unit cur, nxt;
  int ui = 0;
  PG8_WAIT_V(0);
  __syncthreads();
  if (!S.next(0, cur)) return;
  f32x4 acc[2][2][4][2];
#pragma unroll
  for (int a = 0; a < 2; ++a)
#pragma unroll
    for (int b = 0; b < 2; ++b)
#pragma unroll
      for (int m = 0; m < 4; ++m)
#pragma unroll
        for (int n = 0; n < 2; ++n) acc[a][b][m][n] = (f32x4){0.f, 0.f, 0.f, 0.f};
  bf16x8 At[4][2], B0[2][2], B1[2][2];
  const char* cA = (const char*)A + (size_t)cur.pm * tstepA;
  const char* cB = (const char*)Bt + (size_t)cur.pn * tstepB;
  PG8_STAGE(PG8_SB(0, 0), cB, voffB); PG8_STAGE(PG8_SA(0, 0), cA, voffA); PG8_STAGE(PG8_SB(0, 1), cB + hstepB, voffB); PG8_STAGE(PG8_SA(0, 1), cA + hstepA, voffA);
  if (wr == 1) PG8_BAR;
  PG8_WAIT_V(4); PG8_BAR;
  PG8_STAGE(PG8_SB(1, 0), cB + kstep, voffB); PG8_STAGE(PG8_SA(1, 0), cA + kstep, voffA); PG8_STAGE(PG8_SB(1, 1), cB + hstepB + kstep, voffB);
  PG8_WAIT_V(6); PG8_BAR;
  for (;;) {
    const bool has_next = S.next(ui + 1, nxt);
    const char* nA = has_next ? (const char*)A + (size_t)nxt.pm * tstepA : cA;
    const char* nB = has_next ? (const char*)Bt + (size_t)nxt.pn * tstepB : cB;
    for (int t = 0; t < nt; t += 2) {
      const bool last = (t == nt - 2);
      const char* a1 = cA + (size_t)(t + 1) * kstep;
      const char* a2 = last ? nA : cA + (size_t)(t + 2) * kstep;
      const char* b2 = last ? nB : cB + (size_t)(t + 2) * kstep;
      const char* a3 = a2 + kstep;
      const char* b3 = b2 + kstep;
      PG8_LDB(B0, 0, 0); PG8_SCHED; PG8_LDA(At, 0, 0); PG8_STAGE(PG8_SA(1, 1), a1 + hstepA, voffA);
      PG8_WAIT_L(8); PG8_BAR; PG8_WAIT_L(0); PG8_MMA(0, 0, At, B0); PG8_BAR; PG8_SCHED;
      PG8_LDB(B1, 0, 1); PG8_STAGE(PG8_SB(0, 0), b2, voffB);
      PG8_BAR; PG8_WAIT_L(0); PG8_MMA(0, 1, At, B1); PG8_BAR;
      PG8_LDA(At, 0, 1); PG8_STAGE(PG8_SA(0, 0), a2, voffA);
      PG8_BAR; PG8_WAIT_L(0); PG8_MMA(1, 0, At, B0); PG8_BAR; PG8_SCHED;
      PG8_STAGE(PG8_SB(0, 1), b2 + hstepB, voffB);
      PG8_WAIT_V(6); PG8_BAR; PG8_MMA(1, 1, At, B1); PG8_BAR;
      PG8_LDB(B0, 1, 0); PG8_SCHED; PG8_LDA(At, 1, 0); PG8_STAGE(PG8_SA(0, 1), a2 + hstepA, voffA);
      PG8_WAIT_L(8); PG8_BAR; PG8_WAIT_L(0); PG8_MMA(0, 0, At, B0); PG8_BAR; PG8_SCHED;
      PG8_LDB(B1, 1, 1); PG8_STAGE(PG8_SB(1, 0), b3, voffB);
      PG8_BAR; PG8_WAIT_L(0); PG8_MMA(0, 1, At, B1); PG8_BAR;
      PG8_LDA(At, 1, 1); PG8_STAGE(PG8_SA(1, 0), a3, voffA);
      PG8_BAR; PG8_WAIT_L(0); PG8_MMA(1, 0, At, B0); PG8_BAR; PG8_SCHED;
      PG8_STAGE(PG8_SB(1, 1), b3 + hstepB, voffB);
      PG8_WAIT_V(6); PG8_BAR; PG8_MMA(1, 1, At, B1); PG8_BAR;
    }
    E(acc, cur, wr, wc, fr, fq);
    if (!has_next) break;
#pragma unroll
    for (int a = 0; a < 2; ++a)
#pragma unroll
      for (int b = 0; b < 2; ++b)
#pragma unroll
        for (int m = 0; m < 4; ++m)
#pragma unroll
          for (int n = 0; n < 2; ++n) acc[a][b][m][n] = (f32x4){0.f, 0.f, 0.f, 0.f};
    cur = nxt; cA = nA; cB = nB; ++ui;
  }
  PG8_WAIT_V(0);
  if (wr == 0) PG8_BAR;
  PG8_BAR;
#undef PG8_SA
#undef PG8_SB
#undef PG8_STAGE
#undef PG8_LDA
#undef PG8_LDB
#undef PG8_MMA
#undef PG8_WAIT_V
#undef PG8_WAIT_L
#undef PG8_BAR
#undef PG8_SCHED
}

struct EpiInProjT {
  const Params& P;
  int l;
  DEV void operator()(const f32x4 (&acc)[2][2][4][2], const Unit& u, int wr, int wc, int fr, int fq) const {
#pragma unroll
    for (int bj = 0; bj < 2; ++bj) {
      const int cg = u.pn * 256 + bj * 128 + wc * 32;
      if (cg >= 4368) continue;
#pragma unroll
      for (int ai = 0; ai < 2; ++ai)
#pragma unroll
        for (int m = 0; m < 4; ++m) {
          const int row = u.pm * 256 + ai * 128 + wr * 64 + m * 16 + fr;
          const f32x4 v0 = acc[ai][bj][m][0], v1 = acc[ai][bj][m][1];
          if (cg < C_WQ) {
            u16* dst = WS_P(P) + (size_t)row * PW + cg + 4 * fq;
            *reinterpret_cast<uint2*>(dst) = make_uint2(pack2(v0[0], v0[1]), pack2(v0[2], v0[3]));
            *reinterpret_cast<uint2*>(dst + 16) = make_uint2(pack2(v1[0], v1[1]), pack2(v1[2], v1[3]));
          } else if (cg < 3712) {
            const bool isq = (cg < C_WK) || (cg >= C_DQ && cg < C_DK);
            const float qs = isq ? 0.125f : 1.f;
            u16* dst = WS_P(P) + (size_t)row * PW + cg + 4 * fq;
            float o1[4], o2[4];
            if (row < NLAT) {
              const int t = row & (T - 1), hf = (cg >> 5) & 1;
              const float4* rt = reinterpret_cast<const float4*>(WS_ROPE(P) + ((size_t)t * 32 + hf * 16 + 4 * fq) * 2);
              const float4 c01 = rt[0], c23 = rt[1];
              const float cs[4] = {c01.x, c01.z, c23.x, c23.z}, sn[4] = {c01.y, c01.w, c23.y, c23.w};
#pragma unroll
              for (int e = 0; e < 4; ++e) { o1[e] = (v0[e] * cs[e] - v1[e] * sn[e]) * qs; o2[e] = (v1[e] * cs[e] + v0[e] * sn[e]) * qs; }
            } else {
#pragma unroll
              for (int e = 0; e < 4; ++e) { o1[e] = v0[e] * qs; o2[e] = v1[e] * qs; }
            }
            *reinterpret_cast<uint2*>(dst) = make_uint2(pack2(o1[0], o1[1]), pack2(o1[2], o1[3]));
            *reinterpret_cast<uint2*>(dst + 16) = make_uint2(pack2(o2[0], o2[1]), pack2(o2[2], o2[3]));
          } else if (cg < 4352) {
            int b, key;
            if (row < NLAT) { b = row >> 12; key = 256 + (row & (T - 1)); }
            else { b = (row - NLAT) >> 8; key = (row - NLAT) & 255; }
            u16* base;
            int v0i;
            if (cg < 3840) { base = WS_VTW(P) + ((size_t)(b * 2 + ((cg - 3712) >> 6)) * 64) * KEYS; v0i = (cg - 3712) & 63; }
            else { base = WS_VTD(P) + ((size_t)(b * 4 + ((cg - 3840) >> 7)) * 128) * KEYS; v0i = (cg - 3840) & 127; }
#pragma unroll
            for (int e = 0; e < 4; ++e) {
              base[(size_t)(v0i + 4 * fq + e) * KEYS + key] = f2bf(v0[e]);
              base[(size_t)(v0i + 16 + 4 * fq + e) * KEYS + key] = f2bf(v1[e]);
            }
          } else {
            const float4 bg = *reinterpret_cast<const float4*>(P.b_gate + l * 16 + 4 * fq);
            *reinterpret_cast<float4*>(WS_GATES(P) + (size_t)row * 16 + 4 * fq) = make_float4(v0[0] + bg.x, v0[1] + bg.y, v0[2] + bg.z, v0[3] + bg.w);
          }
        }
    }
  }
};
struct EpiResidT {
  const Params& P;
  const float* src_lat;
  const float* modl;
  int gt_off;
  DEV void operator()(const f32x4 (&acc)[2][2][4][2], const Unit& u, int wr, int wc, int fr, int fq) const {
#pragma unroll
    for (int ai = 0; ai < 2; ++ai)
#pragma unroll
      for (int m = 0; m < 4; ++m) {
        const int row = u.pm * 256 + ai * 128 + wr * 64 + m * 16 + fr;
        const float* src;
        float* dst;
        int cond;
        if (row < NLAT) { src = src_lat + (size_t)row * 1024; dst = P.out + (size_t)row * 1024; cond = row >> 12; }
        else { src = WS_XC(P) + (size_t)(row - NLAT) * 1024; dst = WS_XC(P) + (size_t)(row - NLAT) * 1024; cond = 16; }
        const float* gt = modl + (size_t)cond * 6144 + gt_off;
#pragma unroll
        for (int bj = 0; bj < 2; ++bj)
#pragma unroll
          for (int n = 0; n < 2; ++n) {
            const int col = u.pn * 256 + bj * 128 + wc * 32 + n * 16 + 4 * fq;
            const float4 s4 = *reinterpret_cast<const float4*>(src + col), g4 = *reinterpret_cast<const float4*>(gt + col);
            const f32x4 a = acc[ai][bj][m][n];
            *reinterpret_cast<float4*>(dst + col) = make_float4(s4.x + g4.x * a[0], s4.y + g4.y * a[1], s4.z + g4.z * a[2], s4.w + g4.w * a[3]);
          }
      }
  }
};
struct EpiSwigluT {
  u16* act;
  DEV void operator()(const f32x4 (&acc)[2][2][4][2], const Unit& u, int wr, int wc, int fr, int fq) const {
#pragma unroll
    for (int ai = 0; ai < 2; ++ai)
#pragma unroll
      for (int m = 0; m < 4; ++m) {
        const int row = u.pm * 256 + ai * 128 + wr * 64 + m * 16 + fr;
#pragma unroll
        for (int bj = 0; bj < 2; ++bj) {
          const int cg = u.pn * 256 + bj * 128 + wc * 32;
          const f32x4 g = acc[ai][bj][m][0], up = acc[ai][bj][m][1];
          *reinterpret_cast<uint2*>(act + (size_t)row * FH + (cg >> 1) + 4 * fq) =
              make_uint2(pack2(siluf_(g[0]) * up[0], siluf_(g[1]) * up[1]), pack2(siluf_(g[2]) * up[2], siluf_(g[3]) * up[3]));
        }
      }
  }
};
}


#ifdef SELFCHECK
#define DBGF(P) reinterpret_cast<float*>((P).ws + O_XC + (size_t)NCTXR * 1024 * 4)
DEV float blk_reduce(float v, bool ismax, float* red) {
  const int tid = my_tid(), lane = tid & 63, wid = tid >> 6;
#pragma unroll
  for (int o = 32; o > 0; o >>= 1) { float t = __shfl_xor(v, o); v = ismax ? fmaxf(v, t) : v + t; }
  __syncthreads();
  if (lane == 0) red[wid] = v;
  __syncthreads();
  float r = red[0];
  for (int i = 1; i < 8; ++i) r = ismax ? fmaxf(r, red[i]) : r + red[i];
  __syncthreads();
  return r;
}
DEV void chk_sample(int s, int& b, int& hd, int& t) {
  const int ti = s & 7;
  b = (s * 5 + 3) & 15; hd = s & 7;
  t = ti == 0 ? 0 : ti == 1 ? 63 : ti == 2 ? 64 : ti == 3 ? 127 : ti == 4 ? 2048 + 65 : ti == 5 ? 3000 : ti == 6 ? 4032 : 4095;
}
DEV void check_pre(const Params& P, int l, char* smem) {
  const int tid = my_tid();
  float* sc = reinterpret_cast<float*>(smem);
  float* red = sc + 2 * 4352;
  float* ov = red + 16;
  float* dbg = DBGF(P);
  const u16* p = WS_P(P);
  for (int it = blockIdx.x; it < 24; it += gridDim.x) {
    const bool isdiff = it >= 12;
    const int s = isdiff ? it - 12 : it;
    int b, hd, t;
    chk_sample(s, b, hd, t);
    const bool ctxq = s >= 8;
    if (ctxq) t &= 255;
    const size_t row = ctxq ? (size_t)NLAT + b * 256 + t : (size_t)b * T + t;
    __syncthreads();
    if (!isdiff) {
      const int head = hd, g = head >> 2;
      const int lo = ctxq ? 0 : max(0, t - 128), hi = ctxq ? -1 : min(T - 1, t + 128);
      const int nk = 256 + (hi - lo + 1);
      float mx = -1e30f;
      for (int k = tid; k < nk; k += NTHREADS) {
        size_t krow = k < 256 ? (size_t)NLAT + b * 256 + k : (size_t)b * T + lo + (k - 256);
        float a = 0.f;
        for (int d = 0; d < 64; ++d) a += bf2f(p[row * PW + C_WQ + head * 64 + d]) * bf2f(p[krow * PW + C_WK + g * 64 + d]);
        sc[k] = a;
        mx = fmaxf(mx, a);
      }
      mx = blk_reduce(mx, true, red);
      const float sk = P.sink[l * 8 + head];
      mx = fmaxf(mx, sk);
      float sm = 0.f;
      for (int k = tid; k < nk; k += NTHREADS) { float e = expf(sc[k] - mx); sc[k] = e; sm += e; }
      sm = blk_reduce(sm, false, red) + expf(sk - mx);
      if (tid < 64) {
        float o = 0.f;
        for (int k = 0; k < nk; ++k) {
          int kidx = k < 256 ? k : 256 + lo + (k - 256);
          o += sc[k] * bf2f(WS_VTW(P)[((size_t)(b * 2 + g) * 64 + tid) * KEYS + kidx]);
        }
        dbg[it * 128 + tid] = o / sm;
      }
    } else {
      const int h = hd & 3;
      const int nk = ctxq ? 256 : KEYS;
      float mx0 = -1e30f, mx1 = -1e30f;
      for (int k = tid; k < nk; k += NTHREADS) {
        size_t krow = k < 256 ? (size_t)NLAT + b * 256 + k : (size_t)b * T + (k - 256);
        float a0 = 0.f, a1 = 0.f;
        for (int d = 0; d < 64; ++d) {
          a0 += bf2f(p[row * PW + C_DQ + h * 128 + d]) * bf2f(p[krow * PW + C_DK + h * 128 + d]);
          a1 += bf2f(p[row * PW + C_DQ + h * 128 + 64 + d]) * bf2f(p[krow * PW + C_DK + h * 128 + 64 + d]);
        }
        sc[k] = a0; sc[4352 + k] = a1;
        mx0 = fmaxf(mx0, a0); mx1 = fmaxf(mx1, a1);
      }
      mx0 = blk_reduce(mx0, true, red);
      mx1 = blk_reduce(mx1, true, red);
      float s0 = 0.f, s1 = 0.f;
      for (int k = tid; k < nk; k += NTHREADS) {
        float e0 = expf(sc[k] - mx0), e1 = expf(sc[4352 + k] - mx1);
        sc[k] = e0; sc[4352 + k] = e1; s0 += e0; s1 += e1;
      }
      s0 = blk_reduce(s0, false, red);
      s1 = blk_reduce(s1, false, red);
      const float lam = WS_LAM(P)[l], lam_init = 0.8f - 0.6f * expf(-0.3f * (float)l);
      float y = 0.f;
      if (tid < 128) {
        for (int k = 0; k < nk; ++k)
          y += (sc[k] / s0 - lam * sc[4352 + k] / s1) * bf2f(WS_VTD(P)[((size_t)(b * 4 + h) * 128 + tid) * KEYS + k]);
        ov[tid] = y;
      }
      __syncthreads();
      if (tid < 128) {
        float ss = 0.f;
        for (int v = 0; v < 128; ++v) ss += ov[v] * ov[v];
        dbg[it * 128 + tid] = y * rsqrtf(ss / 128.f + EPS) * P.d_norm[l * 512 + h * 128 + tid] * (1.f - lam_init);
      }
    }
  }
}
DEV void check_post(const Params& P, int l, unsigned* flags) {
  const int tid = my_tid();
  const float* dbg = DBGF(P);
  const u16* p = WS_P(P);
  for (int it = blockIdx.x; it < 24; it += gridDim.x) {
    const bool isdiff = it >= 12;
    const int s = isdiff ? it - 12 : it;
    int b, hd, t;
    chk_sample(s, b, hd, t);
    const bool ctxq = s >= 8;
    if (ctxq) t &= 255;
    const size_t row = ctxq ? (size_t)NLAT + b * 256 + t : (size_t)b * T + t;
    if (ctxq && l != 0) continue;
    const int n = isdiff ? 128 : 64;
    if (tid < n) {
      float got = isdiff ? bf2f(p[row * PW + C_DQ + (hd & 3) * 128 + tid]) : bf2f(p[row * PW + C_WQ + hd * 64 + tid]);
      float ex = dbg[it * 128 + tid];
      if (!(fabsf(got - ex) <= 0.03f + 0.03f * fabsf(ex))) atomicOr(flags, isdiff ? (ctxq ? 32u : 2u) : (ctxq ? 16u : 1u));
    }
  }
}
DEV void check_mlstm(const Params& P, int l, char* smem, unsigned* flags) {
  const int tid = my_tid(), lane = tid & 63;
  float* qs = reinterpret_cast<float*>(smem);
  float* ks = qs + 128;
  float* vs = ks + 128;
  float* nn = vs + 128;
  float* sc = nn + 128;
  float* red = sc + 8;
  const u16* p = WS_P(P);
  for (int it = blockIdx.x; it < 4; it += gridDim.x) {
    const int b = (it * 7 + 2) & 15, hd = (it + 1) & 3, dir = it & 1;
    const int v = tid >> 2, kq = tid & 3;
    float C[32];
#pragma unroll
    for (int j = 0; j < 32; ++j) C[j] = 0.f;
    __syncthreads();
    if (tid < 128) nn[tid] = 0.f;
    if (tid == 0) sc[0] = 0.f;
    __syncthreads();
    const int nsteps = (l == 0) ? 256 + T : 256 + T;
    for (int st = 0; st < nsteps; ++st) {
      int seg0, seglen, u;
      if (st < 256) { seg0 = NLAT + b * 256; seglen = 256; u = dir ? 255 - st : st; }
      else { seg0 = b * T; seglen = T; u = dir ? T - 1 - (st - 256) : st - 256; }
      const size_t row = (size_t)seg0 + u;
      if (tid < 128) {
        float xq = 0.f, xk = 0.f;
        for (int tp = 0; tp < 3; ++tp) {
          int uu = u + tp - 1;
          if (uu >= 0 && uu < seglen) {
            xq += P.conv_w[(size_t)l * 3072 + tp * 1024 + hd * 128 + tid] * bf2f(p[((size_t)seg0 + uu) * PW + C_MQ + hd * 128 + tid]);
            xk += P.conv_w[(size_t)l * 3072 + tp * 1024 + 512 + hd * 128 + tid] * bf2f(p[((size_t)seg0 + uu) * PW + C_MK + hd * 128 + tid]);
          }
        }
        qs[tid] = xq / (1.f + expf(-xq));
        ks[tid] = xk / (1.f + expf(-xk)) * 0.08838834764831845f;
        vs[tid] = bf2f(p[row * PW + C_MV + hd * 128 + tid]);
      }
      if (tid == 0) {
        float ig = WS_GATES(P)[row * 16 + dir * 8 + hd], fg = WS_GATES(P)[row * 16 + dir * 8 + 4 + hd];
        float lf = fminf(fg, 0.f) - log1pf(expf(-fabsf(fg)));
        float m = sc[0], mn = fmaxf(lf + m, ig);
        sc[1] = expf(lf + m - mn);
        sc[2] = expf(ig - mn);
        sc[3] = mn;
      }
      __syncthreads();
      const float fd = sc[1], iw = sc[2], mn = sc[3];
      float pd = 0.f;
#pragma unroll
      for (int j = 0; j < 32; ++j) {
        C[j] = fd * C[j] + iw * vs[v] * ks[kq * 32 + j];
        pd += C[j] * qs[kq * 32 + j];
      }
      pd += __shfl_xor(pd, 1);
      pd += __shfl_xor(pd, 2);
      float dn = 0.f;
      if (tid < 128) { float nv = fd * nn[tid] + iw * ks[tid]; nn[tid] = nv; dn = nv * qs[tid]; }
      dn = blk_reduce(dn, false, red);
      if (tid == 0) sc[0] = mn;
      const float hval = pd / fmaxf(fabsf(dn), expf(-mn));
      float sq = (kq == 0) ? hval * hval : 0.f;
      sq = blk_reduce(sq, false, red);
      const float rms = sqrtf(sq / 128.f);
      const bool cmp = (st < 256) ? (l == 0) : true;
      if (cmp && kq == 0 && ((u & 63) == 0 || (u & 63) == 63 || (u % 97) == 0)) {
        float got = bf2f(WS_HFB(P)[(size_t)dir * MTOT * 512 + row * 512 + hd * 128 + v]);
        if (!(fabsf(got - hval) <= 0.05f * rms + 0.05f * fabsf(hval) + 1e-3f)) atomicOr(flags, dir ? 8u : 4u);
      }
    }
  }
}
#endif


#ifdef SELFCHECK
DEV void flag_if(bool bad, unsigned* flags, unsigned bit) { if (bad) atomicOr(flags, bit); }
DEV bool close_(float got, float ex, float tol) { return fabsf(got - ex) <= tol + tol * fabsf(ex); }
DEV void check_inproj(const Params& P, int l, char* smem, unsigned* flags) {
  const int tid = my_tid();
  float* red = reinterpret_cast<float*>(smem);
  float* hrow = red + 16;
  const float* modl = WS_MOD(P) + (size_t)l * 17 * 6144;
  for (int it = blockIdx.x; it < 64; it += gridDim.x) {
    const int ri = it & 7;
    const int row = ri == 0 ? 0 : ri == 1 ? 4095 : ri == 2 ? 4096 + 77 : ri == 3 ? 30000 : ri == 4 ? 65535 : ri == 5 ? NLAT : ri == 6 ? NLAT + 300 : MTOT - 1;
    const int cond = row < NLAT ? row >> 12 : 16;
    {
      int col = (it * 769 + 5) % 6144;
      float a = 0.f;
      for (int k = tid; k < 1024; k += NTHREADS) {
        float cv = cond < 16 ? P.c[cond * 1024 + k] : P.c_ctx[k];
        a += cv / (1.f + expf(-cv)) * P.w_mod[(size_t)l * 1024 * 6144 + (size_t)k * 6144 + col];
      }
      a = blk_reduce(a, false, red) + P.b_mod[l * 6144 + col];
      if (tid == 0) flag_if(!close_(modl[(size_t)cond * 6144 + col], a, 2e-3f), flags, 1u);
    }
    const float* xs = row < NLAT ? ((l == 0 ? P.x : P.out) + (size_t)row * 1024) : (WS_XC(P) + (size_t)(row - NLAT) * 1024);
    float ss = 0.f;
    for (int k = tid; k < 1024; k += NTHREADS) ss += xs[k] * xs[k];
    ss = blk_reduce(ss, false, red);
    const float rstd = rsqrtf(ss / 1024.f + EPS);
    for (int k = tid; k < 1024; k += NTHREADS) {
      float y = xs[k] * rstd * P.g_mix[l * 1024 + k] * (1.f + modl[(size_t)cond * 6144 + 1024 + k]) + modl[(size_t)cond * 6144 + k];
      hrow[k] = y;
      flag_if(!close_(bf2f(WS_H(P)[(size_t)row * 1024 + k]), y, 1e-2f), flags, 2u);
    }
    __syncthreads();
    const int oi = it >> 3;
    const int oj = (oi * 2 + (it & 1)) & 15;
    const int oc = oj == 0 ? 3 : oj == 1 ? 600 : oj == 2 ? 1100 : oj == 3 ? 1999 : oj == 4 ? 2050 : oj == 5 ? 2064 + 70 : oj == 6 ? 2576 + 100 :
                   oj == 7 ? 2704 + 5 : oj == 8 ? 2832 + 200 : oj == 9 ? 2832 + 37 : oj == 10 ? 3344 + 90 : oj == 11 ? 3344 + 300 :
                   oj == 12 ? 3856 + 10 : oj == 13 ? 3856 + 500 : oj == 14 ? 2048 + 15 : 2064 + 500;
    auto dotcol = [&](int c) {
      float a = 0.f;
      for (int k = tid; k < 1024; k += NTHREADS) a += hrow[k] * P.w_in[(size_t)l * 1024 * INW + (size_t)k * INW + c];
      return blk_reduce(a, false, red);
    };
    float val = dotcol(oc);
    const u16* p = WS_P(P);
    const bool lat = row < NLAT;
    const int t = row & (T - 1);
    float got = 0.f, ex = val;
    unsigned bit = 4u;
    if (oc < 2048) { got = bf2f(p[(size_t)row * PW + oc]); }
    else if (oc < 2064) { got = WS_GATES(P)[(size_t)row * 16 + oc - 2048]; ex = val + P.b_gate[l * 16 + oc - 2048]; }
    else if (oc >= 2704 && oc < 2832) {
      int cgi = oc - 2704, g = cgi >> 6, vd = cgi & 63;
      int b = lat ? row >> 12 : (row - NLAT) >> 8, key = lat ? 256 + t : (row - NLAT) & 255;
      got = bf2f(WS_VTW(P)[((size_t)(b * 2 + g) * 64 + vd) * KEYS + key]);
      bit = 8u;
    } else if (oc >= 3856) {
      int cgi = oc - 3856, h = cgi >> 7, vd = cgi & 127;
      int b = lat ? row >> 12 : (row - NLAT) >> 8, key = lat ? 256 + t : (row - NLAT) & 255;
      got = bf2f(WS_VTD(P)[((size_t)(b * 4 + h) * 128 + vd) * KEYS + key]);
      bit = 8u;
    } else {
      int base, nb0;
      bool isq;
      if (oc < 2576) { base = 2064; nb0 = C_WQ; isq = true; }
      else if (oc < 2704) { base = 2576; nb0 = C_WK; isq = false; }
      else if (oc < 3344) { base = 2832; nb0 = C_DQ; isq = true; }
      else { base = 3344; nb0 = C_DK; isq = false; }
      int rel = oc - base, dd = rel & 63, j = dd & 15, second = (dd >> 4) & 1, axis = dd >> 5;
      float other = dotcol(second ? oc - 16 : oc + 16);
      if (lat) {
        int pos = axis ? (t & 63) : (t >> 6);
        float ang = (float)pos * powf(10000.f, -(float)j / 16.f);
        float cs = cosf(ang), sn = sinf(ang);
        ex = second ? (val * cs + other * sn) : (val * cs - other * sn);
      }
      if (isq) ex *= 0.125f;
      got = bf2f(p[(size_t)row * PW + nb0 + rel]);
      bit = 16u;
    }
    if (tid == 0) flag_if(!close_(got, ex, 3e-2f), flags, bit);
    __syncthreads();
  }
}
DEV void check_post6(const Params& P, int l, char* smem, unsigned* flags, const float* xprev) {
  const int tid = my_tid();
  float* red = reinterpret_cast<float*>(smem);
  const u16* Yp = WS_P(P);
  const float* modl = WS_MOD(P) + (size_t)l * 17 * 6144;
  for (int it = blockIdx.x; it < 16; it += gridDim.x) {
    const int ri = it & 7;
    const int row = ri == 0 ? 1 : ri == 1 ? 4097 : ri == 2 ? 12345 : ri == 3 ? 40000 : ri == 4 ? 65534 : ri == 5 ? NLAT + 1 : ri == 6 ? NLAT + 2000 : MTOT - 2;
    if (row >= NLAT && l != 0) continue;
    const int col = (it * 331 + 17) & 1023;
    const int cond = row < NLAT ? row >> 12 : 16;
    float mg = 0.f;
    for (int i = 0; i < 3; ++i) {
      float a = 0.f, z = 0.f;
      for (int k = tid; k < 1024; k += NTHREADS) a += bf2f(WS_H(P)[(size_t)row * 1024 + k]) * P.w_in[(size_t)l * 1024 * INW + (size_t)k * INW + 4368 + i * 1024 + col];
      a = blk_reduce(a, false, red);
      const int yc = i == 0 ? C_MO : (i == 1 ? C_WQ : C_DQ);
      for (int k = tid; k < 512; k += NTHREADS) z += bf2f(Yp[(size_t)row * PW + yc + k]) * P.w_branch[((size_t)l * 3 + i) * 512 * 1024 + (size_t)k * 1024 + col];
      z = blk_reduce(z, false, red);
      mg += z / (1.f + expf(-a));
    }
    if (tid == 0) flag_if(!close_(bf2f(WS_HFB(P)[(size_t)row * 1024 + col]), mg, 3e-2f), flags, 1u);
    float o = 0.f;
    for (int k = tid; k < 1024; k += NTHREADS) o += bf2f(WS_HFB(P)[(size_t)row * 1024 + k]) * P.w_out[(size_t)l * 1024 * 1024 + (size_t)k * 1024 + col];
    o = blk_reduce(o, false, red);
    const float xo = row < NLAT ? xprev[(size_t)row * 1024 + col] : -1e9f;
    const float xn = row < NLAT ? P.out[(size_t)row * 1024 + col] : WS_XC(P)[(size_t)(row - NLAT) * 1024 + col];
    if (tid == 0 && row < NLAT && (l == 0)) flag_if(!close_(xn, xo + modl[(size_t)cond * 6144 + 2048 + col] * o, 2e-2f), flags, 2u);
    if (tid == 0) DBGF(P)[4096 + it] = xn;
  }
}
DEV void check_post9(const Params& P, int l, char* smem, unsigned* flags) {
  const int tid = my_tid();
  float* red = reinterpret_cast<float*>(smem);
  const float* modl = WS_MOD(P) + (size_t)l * 17 * 6144;
  for (int it = blockIdx.x; it < 16; it += gridDim.x) {
    const int ri = it & 7;
    const int row = ri == 0 ? 1 : ri == 1 ? 4097 : ri == 2 ? 12345 : ri == 3 ? 40000 : ri == 4 ? 65534 : ri == 5 ? NLAT + 1 : ri == 6 ? NLAT + 2000 : MTOT - 2;
    if (row >= NLAT && l != 0) continue;
    const int col = (it * 331 + 17) & 1023;
    const int cond = row < NLAT ? row >> 12 : 16;
    const int j = (it * 97 + 13) % FH;
    float g = 0.f, u = 0.f;
    for (int k = tid; k < 1024; k += NTHREADS) {
      float hv = bf2f(WS_H(P)[(size_t)row * 1024 + k]);
      g += hv * P.w_ffn_in[(size_t)l * 1024 * 5632 + (size_t)k * 5632 + j];
      u += hv * P.w_ffn_in[(size_t)l * 1024 * 5632 + (size_t)k * 5632 + FH + j];
    }
    g = blk_reduce(g, false, red);
    u = blk_reduce(u, false, red);
    if (tid == 0) flag_if(!close_(bf2f(WS_P(P)[(size_t)row * FH + j]), g / (1.f + expf(-g)) * u, 3e-2f), flags, 4u);
    float o = 0.f;
    for (int k = tid; k < FH; k += NTHREADS) o += bf2f(WS_P(P)[(size_t)row * FH + k]) * P.w_ffn_out[(size_t)l * FH * 1024 + (size_t)k * 1024 + col];
    o = blk_reduce(o, false, red);
    const float xn = row < NLAT ? P.out[(size_t)row * 1024 + col] : WS_XC(P)[(size_t)(row - NLAT) * 1024 + col];
    if (tid == 0) flag_if(!close_(xn, DBGF(P)[4096 + it] + modl[(size_t)cond * 6144 + 5120 + col] * o, 2e-2f), flags, 8u);
  }
}
#endif

#ifdef DEBUG_STAGE
DEV void debug_dump(const Params& P, int stage) {
  const int tid = my_tid();
  for (size_t idx = (size_t)blockIdx.x * NTHREADS + tid; idx < (size_t)NLAT * 1024; idx += (size_t)gridDim.x * NTHREADS) {
    size_t row = idx >> 10;
    int c = (int)(idx & 1023);
    size_t r2 = row + (row < 4096 ? NLAT : 0);
    float v = 0.f;
    const u16* p = WS_P(P);
    if (stage == 1) {
      v = bf2f(p[row * PW + c]) + bf2f(p[row * PW + 1024 + c]) + bf2f(p[row * PW + 2048 + c]) + (c < 640 ? bf2f(p[row * PW + 3072 + c]) : 0.f);
      v += bf2f(p[r2 * PW + c]) + bf2f(p[r2 * PW + 1024 + c]) + bf2f(p[r2 * PW + 2048 + c]);
      v += bf2f(WS_VTD(P)[r2 * 512 + (c & 511)]) + bf2f(WS_VTW(P)[r2 * 128 + (c & 127)]) + WS_GATES(P)[r2 * 16 + (c & 15)];
      v += bf2f(WS_VTD(P)[row * 512 + (c & 511)]) + bf2f(WS_VTW(P)[row * 128 + (c & 127)]) + WS_GATES(P)[row * 16 + (c & 15)];
    } else if (stage == 21) {
      v = bf2f(WS_HFB(P)[row * 512 + (c & 511)]) + 2.f * bf2f(WS_HFB(P)[(size_t)MTOT * 512 + row * 512 + (c & 511)]);
      v += bf2f(WS_HFB(P)[r2 * 512 + (c & 511)]) + 2.f * bf2f(WS_HFB(P)[(size_t)MTOT * 512 + r2 * 512 + (c & 511)]);
    } else if (stage == 22) {
      v = bf2f(p[row * PW + C_WQ + (c & 511)]) + bf2f(p[r2 * PW + C_WQ + (c & 511)]);
    } else if (stage == 23) {
      v = bf2f(p[row * PW + C_DQ + (c & 511)]) + bf2f(p[r2 * PW + C_DQ + (c & 511)]);
    } else if (stage == 3) {
      v = bf2f(WS_HFB(P)[row * 1024 + c]) + bf2f(WS_HFB(P)[r2 * 1024 + c]);
    } else if (stage == 4) {
      v = P.out[idx] + WS_XC(P)[(row & 4095) * 1024 + c];
    } else if (stage == 5) {
      v = bf2f(WS_H(P)[row * 1024 + c]) + bf2f(WS_H(P)[r2 * 1024 + c]);
    } else if (stage == 6) {
      v = bf2f(p[row * FH + c]) + bf2f(p[row * FH + 1024 + c]) + bf2f(p[r2 * FH + 1792 + c]);
    }
    if (stage != 4) P.out[idx] = v; else P.out[idx] = v;
  }
}
#define DBG(st) if (l == 0 && DEBUG_STAGE == st) { GSYNC_ONLY(); debug_dump(P, st); return true; }
#else
#define DBG(st)
#endif
template <int l>
DEV bool layer_body(const Params& P, unsigned* bar, unsigned& epoch, char* smem) {
  constexpr bool need_ctx = (l == 0);
  const float* modl = WS_MOD(P) + (size_t)l * 17 * 6144;
  const u16* Wl = WS_W(P) + (size_t)l * W_LAYER;
  const float* xlat = l == 0 ? P.x : P.out;
  constexpr int Mtok = need_ctx ? MTOT : NLAT;
  phase_norm_mod(P, xlat, WS_XC(P), MTOT, P.g_mix + l * 1024, modl, 0, 1024);
  GSYNC();
  pg8::gemm_phase(smem, WS_H(P), 1024, Wl + W_IN, 1024, MTOT, NIN, 1024, pg8::EpiInProjT{P, l});
#ifdef REPEAT_GEMMS
  if (l == 1) pg8::gemm_phase(smem, WS_H(P), 1024, Wl + W_IN, 1024, MTOT, NIN, 1024, pg8::EpiInProjT{P, l});
#endif
  GSYNC();
  DBG(1)
#ifdef SELFCHECK
#if SELFCHECK == 2
  check_inproj(P, l, smem, WS_CTR(P) + 16 + l * 3);
#else
  check_pre(P, l, smem);
#endif
  GSYNC();
#endif
  phase_mixers(P, l, smem);
  GSYNC();
#if defined(SELFCHECK) && SELFCHECK == 1
  check_post(P, l, WS_CTR(P) + 17 + l * 3);
  check_mlstm(P, l, smem, WS_CTR(P) + 17 + l * 3);
  GSYNC();
#endif
  DBG(21)
  DBG(22)
  DBG(23)
  phase_ya(P, l, Mtok);
  GSYNC();
  phase_merge(P, l, Mtok, smem);
#ifdef REPEAT_GEMMS
  if (l == 1) phase_merge(P, l, Mtok, smem);
#endif
  GSYNC();
  DBG(3)
  pg8::gemm_phase(smem, WS_HFB(P), 1024, Wl + W_O, 1024, Mtok, 1024, 1024, pg8::EpiResidT{P, xlat, modl, 2048});
  GSYNC();
#if defined(SELFCHECK) && SELFCHECK == 2
  check_post6(P, l, smem, WS_CTR(P) + 18 + l * 3, xlat);
  GSYNC();
#endif
  DBG(4)
  phase_norm_mod(P, P.out, WS_XC(P), Mtok, P.g_ffn + l * 1024, modl, 3072, 4096);
  GSYNC();
  DBG(5)
  pg8::gemm_phase(smem, WS_H(P), 1024, Wl + W_FI, 1024, Mtok, 5632, 1024, pg8::EpiSwigluT{WS_P(P)});
#ifdef REPEAT_GEMMS
  if (l == 1) pg8::gemm_phase(smem, WS_H(P), 1024, Wl + W_FI, 1024, Mtok, 5632, 1024, pg8::EpiSwigluT{WS_P(P)});
#endif
  GSYNC();
  DBG(6)
  pg8::gemm_phase(smem, WS_P(P), FH, Wl + W_FO, FH, Mtok, 1024, FH, pg8::EpiResidT{P, P.out, modl, 5120});
  GSYNC();
#if defined(SELFCHECK) && SELFCHECK == 2
  check_post9(P, l, smem, WS_CTR(P) + 18 + l * 3);
  GSYNC();
#endif
  return false;
}

__global__ void __launch_bounds__(NTHREADS) fwd_megakernel(Params P) {
  extern __shared__ __attribute__((aligned(16))) char smem[];
  cg::grid_group grid = cg::this_grid();
  unsigned* bar = WS_CTR(P) + 64;
  unsigned epoch = 0;
  grid.sync();
  phase_prologue(P, smem);
  GSYNC();
  if (layer_body<0>(P, bar, epoch, smem)) return;
  if (layer_body<1>(P, bar, epoch, smem)) return;
  phase_final_norm(P);
#ifdef SELFCHECK
  GSYNC();
  if (blockIdx.x == 0 && my_tid() == 0) {
    float scale = 1000.f;
    for (int w = 0; w < 6; ++w) {
      unsigned f = WS_CTR(P)[16 + w];
      if (f) { P.out[0] = (10.f + (float)f) * scale; break; }
      scale *= 10.f;
    }
  }
#endif
}

extern "C" void kernel_launch(void* const* d_in, const int* in_sizes, int n_in, void* d_out, int out_size, void* d_ws,
                              size_t ws_size, hipStream_t stream) {
  static int grid_blocks = 0;
  if (!grid_blocks) {
    int dev = 0, cus = 0, per_cu = 0;
    hipGetDevice(&dev);
    hipDeviceGetAttribute(&cus, hipDeviceAttributeMultiprocessorCount, dev);
    hipFuncSetAttribute((const void*)fwd_megakernel, hipFuncAttributeMaxDynamicSharedMemorySize, LDS_BYTES);
    hipOccupancyMaxActiveBlocksPerMultiprocessor(&per_cu, fwd_megakernel, NTHREADS, LDS_BYTES);
    if (per_cu < 1) per_cu = 1;
    if (per_cu > 1) per_cu = 1;
    grid_blocks = cus * per_cu;
  }
  Params P{};
  const float* const* in = reinterpret_cast<const float* const*>(d_in);
  P.x = in[0]; P.c = in[1]; P.ctx = in[2]; P.c_ctx = in[3]; P.w_mod = in[4]; P.b_mod = in[5]; P.g_mix = in[6];
  P.g_ffn = in[7]; P.w_in = in[8]; P.b_gate = in[9]; P.conv_w = in[10]; P.m_norm = in[11]; P.sink = in[12];
  P.lam_q1 = in[13]; P.lam_k1 = in[14]; P.lam_q2 = in[15]; P.lam_k2 = in[16]; P.d_norm = in[17]; P.w_branch = in[18];
  P.w_out = in[19]; P.w_ffn_in = in[20]; P.w_ffn_out = in[21]; P.g_final = in[22];
  P.out = reinterpret_cast<float*>(d_out);
  P.ws = reinterpret_cast<char*>(d_ws);
  if (WS_TOTAL > ws_size) fprintf(stderr, "workspace too small: need %zu have %zu\n", (size_t)WS_TOTAL, ws_size);
  hipMemsetAsync(P.ws + O_CTR, 0, 2048, stream);
  void* args[] = {&P};
  hipError_t e = hipLaunchCooperativeKernel((const void*)fwd_megakernel, dim3(grid_blocks), dim3(NTHREADS), args, LDS_BYTES, stream);
  if (e != hipSuccess) fprintf(stderr, "cooperative launch failed: %s (grid %d)\n", hipGetErrorString(e), grid_blocks);
}
```

```cpp
#include <hip/hip_runtime.h>
#include <hip/hip_cooperative_groups.h>
#include <cstdio>
#include <cstdint>
namespace cg = cooperative_groups;

typedef unsigned short u16;
using bf16x8 = __attribute__((ext_vector_type(8))) short;
using f32x4 = __attribute__((ext_vector_type(4))) float;
using f32x16 = __attribute__((ext_vector_type(16))) float;

#define DEV __device__ __forceinline__

constexpr int D = 1024, NB = 16, T = 4096, TC = 256;
constexpr int NLAT = NB * T;
constexpr int NCTXR = NB * TC;
constexpr int MTOT = NLAT + NCTXR;
constexpr int KEYS = T + TC;
constexpr int INW = 7440;
constexpr int PW = 3712;
constexpr int C_MQ = 0, C_MK = 512, C_MV = 1024, C_MO = 1536, C_WQ = 2048, C_WK = 2560, C_DQ = 2688, C_DK = 3200;
constexpr int NIN = 4608;
constexpr int FH = 2816;
constexpr float EPS = 1e-6f;
constexpr float L2E = 1.4426950408889634f;
constexpr int NTHREADS = 512;
constexpr int LDS_BYTES = 147456;

constexpr size_t W_IN = 0;
constexpr size_t W_G = W_IN + (size_t)NIN * 1024;
constexpr size_t W_B = W_G + (size_t)3072 * 1024;
constexpr size_t W_O = W_B + (size_t)3 * 1024 * 512;
constexpr size_t W_FI = W_O + (size_t)1024 * 1024;
constexpr size_t W_FO = W_FI + (size_t)5632 * 1024;
constexpr size_t W_LAYER = W_FO + (size_t)1024 * FH;

struct Params {
  const float *x, *c, *ctx, *c_ctx, *w_mod, *b_mod, *g_mix, *g_ffn, *w_in, *b_gate, *conv_w, *m_norm, *sink;
  const float *lam_q1, *lam_k1, *lam_q2, *lam_k2, *d_norm, *w_branch, *w_out, *w_ffn_in, *w_ffn_out, *g_final;
  float* out;
  char* ws;
};


constexpr size_t al256(size_t x) { return (x + 255) & ~(size_t)255; }
constexpr size_t O_W = 0;
constexpr size_t O_MOD = O_W + al256(2 * W_LAYER * 2);
constexpr size_t O_ROPE = O_MOD + al256((size_t)2 * 17 * 6144 * 4);
constexpr size_t O_LAM = O_ROPE + al256((size_t)T * 32 * 2 * 4);
constexpr size_t O_CTR = O_LAM + 256;
constexpr size_t O_GATES = O_CTR + 2048;
constexpr size_t O_H = O_GATES + al256((size_t)MTOT * 16 * 4);
constexpr size_t O_P = O_H + al256((size_t)MTOT * 1024 * 2);
constexpr size_t O_VTW = O_P + al256((size_t)MTOT * PW * 2);
constexpr size_t O_VTD = O_VTW + al256((size_t)NB * 2 * 64 * KEYS * 2);
constexpr size_t O_HFB = O_VTD + al256((size_t)NB * 4 * 128 * KEYS * 2);
constexpr size_t O_XC = O_HFB + al256((size_t)2 * MTOT * 512 * 2);
constexpr size_t WS_TOTAL = O_XC + al256((size_t)NCTXR * 1024 * 4) + 65536;
#define WS_W(P) reinterpret_cast<u16*>((P).ws + O_W)
#define WS_MOD(P) reinterpret_cast<float*>((P).ws + O_MOD)
#define WS_ROPE(P) reinterpret_cast<float*>((P).ws + O_ROPE)
#define WS_LAM(P) reinterpret_cast<float*>((P).ws + O_LAM)
#define WS_CTR(P) reinterpret_cast<unsigned*>((P).ws + O_CTR)
#define WS_GATES(P) reinterpret_cast<float*>((P).ws + O_GATES)
#define WS_H(P) reinterpret_cast<u16*>((P).ws + O_H)
#define WS_P(P) reinterpret_cast<u16*>((P).ws + O_P)
#define WS_VTW(P) reinterpret_cast<u16*>((P).ws + O_VTW)
#define WS_VTD(P) reinterpret_cast<u16*>((P).ws + O_VTD)
#define WS_HFB(P) reinterpret_cast<u16*>((P).ws + O_HFB)
#define WS_XC(P) reinterpret_cast<float*>((P).ws + O_XC)

DEV int my_tid() {
  int t = threadIdx.x;
  asm volatile("" : "+v"(t));
  return t;
}
typedef __bf16 bf2_t __attribute__((ext_vector_type(2)));
typedef float f2_t __attribute__((ext_vector_type(2)));
DEV uint32_t pack2(float a, float b) {
  f2_t v = {a, b};
  bf2_t r = __builtin_convertvector(v, bf2_t);
  return *reinterpret_cast<uint32_t*>(&r);
}
DEV u16 f2bf(float f) { return (u16)(pack2(f, 0.f) & 0xffffu); }
DEV float bf2f(u16 h) { return __uint_as_float(((uint32_t)h) << 16); }
DEV float bflo(uint32_t v) { return __uint_as_float(v << 16); }
DEV float bfhi(uint32_t v) { return __uint_as_float(v & 0xffff0000u); }
DEV float fexp2(float x) { return __builtin_amdgcn_exp2f(x); }
DEV float sigmoidf_(float x) { return 1.f / (1.f + __expf(-x)); }
DEV float siluf_(float x) { return x / (1.f + __expf(-x)); }
DEV float wave_sum(float v) {
#pragma unroll
  for (int o = 32; o > 0; o >>= 1) v += __shfl_xor(v, o);
  return v;
}
DEV bf16x8 ld16(const void* p) { return *reinterpret_cast<const bf16x8*>(p); }
DEV bf16x8 mk8(uint32_t a, uint32_t b, uint32_t c, uint32_t d) {
  uint4 u = make_uint4(a, b, c, d);
  return *reinterpret_cast<bf16x8*>(&u);
}
DEV f32x16 mfma32(bf16x8 a, bf16x8 b, f32x16 c) { return __builtin_amdgcn_mfma_f32_32x32x16_bf16(a, b, c, 0, 0, 0); }
DEV f32x4 mfma16(bf16x8 a, bf16x8 b, f32x4 c) { return __builtin_amdgcn_mfma_f32_16x16x32_bf16(a, b, c, 0, 0, 0); }
DEV int pi32(int r) { return (r & ~12) | ((r & 4) << 1) | ((r & 8) >> 1); }


DEV void grid_barrier(unsigned* bar, unsigned& epoch) {
  asm volatile("s_waitcnt vmcnt(0)" ::: "memory");
  __syncthreads();
  epoch += 1;
  if (my_tid() == 0) {
    __builtin_amdgcn_fence(__ATOMIC_RELEASE, "agent");
    unsigned* loc = bar + 32 + (blockIdx.x & 7) * 32;
    const unsigned per = gridDim.x >> 3;
    unsigned old = __hip_atomic_fetch_add(loc, 1u, __ATOMIC_RELAXED, __HIP_MEMORY_SCOPE_AGENT);
    if (old + 1 == per * epoch) __hip_atomic_fetch_add(bar, 1u, __ATOMIC_RELAXED, __HIP_MEMORY_SCOPE_AGENT);
    while (__hip_atomic_load(bar, __ATOMIC_RELAXED, __HIP_MEMORY_SCOPE_AGENT) < 8u * epoch) __builtin_amdgcn_s_sleep(1);
    __builtin_amdgcn_fence(__ATOMIC_ACQUIRE, "agent");
  }
  __syncthreads();
}
#define GSYNC() grid_barrier(bar, epoch)
#define GSYNC_ONLY()

template <int N>
DEV void wait_vm() { asm volatile("s_waitcnt vmcnt(%0)" ::"n"(N) : "memory"); }

template <int MI, int NI>
DEV void gemm_mainloop(const u16* __restrict__ A, int lda, const u16* __restrict__ Bt, int ldb, int K,
                       f32x4 (&acc)[MI][NI], char* smem) {
  constexpr int BM = 32 * MI, BN = 64 * NI;
  constexpr int NA = BM * 4 / NTHREADS, NBL = BN * 4 / NTHREADS;
  constexpr int ABYTES = BM * 64, BBYTES = BN * 64, SBYTES = ABYTES + BBYTES;
  constexpr int NL = NA + NBL;
  const int tid = my_tid(), lane = tid & 63, wid = tid >> 6, wr = wid >> 2, wc = wid & 3, fr = lane & 15, fq = lane >> 4;
  const int nk = K / 32;
  auto stage = [&](int kt) {
    char* base = smem + (kt & 3) * SBYTES;
#pragma unroll
    for (int i = 0; i < NA; ++i) {
      int id = tid + i * NTHREADS, r = id >> 2, c = (id & 3) ^ (((r >> 3) & 1) * 3);
      __builtin_amdgcn_global_load_lds((const unsigned*)(A + (size_t)r * lda + kt * 32 + c * 8), (unsigned*)(base + id * 16), 16, 0, 0);
    }
#pragma unroll
    for (int i = 0; i < NBL; ++i) {
      int id = tid + i * NTHREADS, r = id >> 2, c = (id & 3) ^ (((r >> 3) & 1) * 3);
      __builtin_amdgcn_global_load_lds((const unsigned*)(Bt + (size_t)r * ldb + kt * 32 + c * 8), (unsigned*)(base + ABYTES + id * 16), 16, 0, 0);
    }
  };
  wait_vm<0>();
  __syncthreads();
  stage(0);
  if (nk > 1) stage(1);
  if (nk > 2) stage(2);
  for (int kt = 0; kt < nk; ++kt) {
    if (kt + 2 < nk) wait_vm<2 * NL>();
    else if (kt + 1 < nk) wait_vm<NL>();
    else wait_vm<0>();
    asm volatile("" ::: "memory");
    __builtin_amdgcn_s_barrier();
    asm volatile("" ::: "memory");
    const char* As = smem + (kt & 3) * SBYTES;
    const char* Bs = As + ABYTES;
    bf16x8 bfr[NI], af[MI];
#pragma unroll
    for (int ni = 0; ni < NI; ++ni) {
      int r = wc * (NI * 16) + ni * 16 + fr;
      bfr[ni] = ld16(Bs + r * 64 + ((fq ^ (((r >> 3) & 1) * 3)) << 4));
    }
#pragma unroll
    for (int mi = 0; mi < MI; ++mi) {
      int r = wr * (MI * 16) + mi * 16 + fr;
      af[mi] = ld16(As + r * 64 + ((fq ^ (((r >> 3) & 1) * 3)) << 4));
    }
    if (kt + 3 < nk) stage(kt + 3);
    __builtin_amdgcn_sched_barrier(0);
    __builtin_amdgcn_s_setprio(1);
#pragma unroll
    for (int mi = 0; mi < MI; ++mi)
#pragma unroll
      for (int ni = 0; ni < NI; ++ni) acc[mi][ni] = mfma16(af[mi], bfr[ni], acc[mi][ni]);
    __builtin_amdgcn_s_setprio(0);
    __builtin_amdgcn_sched_barrier(0);
  }
}


DEV void gemm_mainloop64(const u16* __restrict__ A, int lda, const u16* __restrict__ Bt, int ldb, int K, f32x4 (&acc)[4][4], char* smem) {
  constexpr int ABYTES = 128 * 128, BBYTES = 256 * 128, SBYTES = ABYTES + BBYTES;
  constexpr int NA = 2, NBL = 4, NL = NA + NBL;
  const int tid = my_tid(), lane = tid & 63, wid = tid >> 6, wr = wid >> 2, wc = wid & 3, fr = lane & 15, fq = lane >> 4;
  const int nk = K / 64;
  auto stage = [&](int kt) {
    char* base = smem + (kt % 3) * SBYTES;
#pragma unroll
    for (int i = 0; i < NA; ++i) {
      int id = tid + i * NTHREADS, r = id >> 3, c = (id & 7) ^ ((r >> 1) & 7);
      __builtin_amdgcn_global_load_lds((const unsigned*)(A + (size_t)r * lda + kt * 64 + c * 8), (unsigned*)(base + id * 16), 16, 0, 0);
    }
#pragma unroll
    for (int i = 0; i < NBL; ++i) {
      int id = tid + i * NTHREADS, r = id >> 3, c = (id & 7) ^ ((r >> 1) & 7);
      __builtin_amdgcn_global_load_lds((const unsigned*)(Bt + (size_t)r * ldb + kt * 64 + c * 8), (unsigned*)(base + ABYTES + id * 16), 16, 0, 0);
    }
  };
  wait_vm<0>();
  __syncthreads();
  stage(0);
  if (nk > 1) stage(1);
  for (int kt = 0; kt < nk; ++kt) {
    if (kt + 1 < nk) wait_vm<NL>();
    else wait_vm<0>();
    asm volatile("" ::: "memory");
    __builtin_amdgcn_s_barrier();
    asm volatile("" ::: "memory");
    if (kt + 2 < nk) stage(kt + 2);
    const char* As = smem + (kt % 3) * SBYTES;
    const char* Bs = As + ABYTES;
#pragma unroll
    for (int ks = 0; ks < 2; ++ks) {
      bf16x8 bfr[4], af[4];
#pragma unroll
      for (int ni = 0; ni < 4; ++ni) {
        int r = wc * 64 + ni * 16 + fr;
        bfr[ni] = ld16(Bs + r * 128 + (((ks * 4 + fq) ^ ((r >> 1) & 7)) << 4));
      }
#pragma unroll
      for (int mi = 0; mi < 4; ++mi) {
        int r = wr * 64 + mi * 16 + fr;
        af[mi] = ld16(As + r * 128 + (((ks * 4 + fq) ^ ((r >> 1) & 7)) << 4));
      }
#pragma unroll
      for (int mi = 0; mi < 4; ++mi)
#pragma unroll
        for (int ni = 0; ni < 4; ++ni) acc[mi][ni] = mfma16(af[mi], bfr[ni], acc[mi][ni]);
      __builtin_amdgcn_sched_barrier(0);
    }
  }
}

template <int MI, int NI>
DEV void zero_acc(f32x4 (&acc)[MI][NI]) {
#pragma unroll
  for (int mi = 0; mi < MI; ++mi)
#pragma unroll
    for (int ni = 0; ni < NI; ++ni) acc[mi][ni] = f32x4{0.f, 0.f, 0.f, 0.f};
}


DEV void tile_coords(int tile, int total, int nN, int& tm, int& tn) {
  int t = tile;
  if (gridDim.x == 256 && tile < (total & ~255)) {
    int j = tile & 255;
    t = (tile & ~255) + (j & 7) * 32 + (j >> 3);
  }
  int p = t / (4 * nN), q = t - p * (4 * nN);
  tn = q >> 2;
  tm = p * 4 + (q & 3);
}

template <int MI, class Epi>
DEV void gemm_phase(const u16* A, int lda, const u16* Bt, int ldb, int M, int N, int K, Epi epi, char* smem) {
  constexpr int BM = 32 * MI;
  const int nM = M / BM, nN = N / 256;
  const int wid = my_tid() >> 6, wr = wid >> 2, wc = wid & 3;
  for (int tile = blockIdx.x; tile < nM * nN; tile += gridDim.x) {
    int tm, tn;
    tile_coords(tile, nM * nN, nN, tm, tn);
    f32x4 acc[MI][4];
    zero_acc<MI, 4>(acc);
    gemm_mainloop<MI, 4>(A + (size_t)tm * BM * lda, lda, Bt + (size_t)tn * 256 * ldb, ldb, K, acc, smem);
    epi(acc, tm * BM + wr * (MI * 16), tn * 256 + wc * 64);
  }
}

DEV int map_col(int type, int n) {
  if (type == 0) {
    if (n < 2048) return n;
    if (n < 2688) return n + 16;
    if (n < 3712) return n + 144;
    if (n < 3840) return n - 1008;
    if (n < 4352) return n + 16;
    if (n < 4368) return n - 2304;
    return -1;
  }
  if (type == 1) return n + 4368;
  if (type == 2) return n;
  int q = n >> 5, r = n & 31;
  return r < 16 ? (q * 16 + r) : (FH + q * 16 + r - 16);
}

DEV void tr_tile(const float* __restrict__ src, int ldsrc, u16* __restrict__ dst, int K, int n0, int k0, int type, char* smem) {
  float* tile = reinterpret_cast<float*>(smem);
  const int tid = my_tid();
  {
    int n = tid & 63, sc = map_col(type, n0 + n);
#pragma unroll
    for (int i = 0; i < 8; ++i) {
      int k = (tid >> 6) + 8 * i;
      tile[k * 65 + n] = sc >= 0 ? src[(size_t)(k0 + k) * ldsrc + sc] : 0.f;
    }
  }
  __syncthreads();
  {
    int n = tid >> 3, kc = tid & 7;
    uint32_t w[4];
#pragma unroll
    for (int j = 0; j < 4; ++j) w[j] = pack2(tile[(kc * 8 + 2 * j) * 65 + n], tile[(kc * 8 + 2 * j + 1) * 65 + n]);
    *reinterpret_cast<uint4*>(dst + (size_t)(n0 + n) * K + k0 + kc * 8) = make_uint4(w[0], w[1], w[2], w[3]);
  }
  __syncthreads();
}

DEV void phase_prologue(const Params& P, char* smem) {
  const int tid = my_tid();
  constexpr int TPL = 4672;
  for (int it = blockIdx.x; it < 2 * TPL; it += gridDim.x) {
    int l = it / TPL, t = it % TPL;
    u16* Wl = WS_W(P) + (size_t)l * W_LAYER;
    if (t < 1152) {
      tr_tile(P.w_in + (size_t)l * 1024 * INW, INW, Wl + W_IN, 1024, (t / 16) * 64, (t % 16) * 64, 0, smem);
    } else if (t < 1920) {
      t -= 1152;
      tr_tile(P.w_in + (size_t)l * 1024 * INW, INW, Wl + W_G, 1024, (t / 16) * 64, (t % 16) * 64, 1, smem);
    } else if (t < 2304) {
      t -= 1920;
      int i = t / 128;
      t %= 128;
      tr_tile(P.w_branch + ((size_t)l * 3 + i) * 512 * 1024, 1024, Wl + W_B + (size_t)i * 1024 * 512, 512, (t / 8) * 64, (t % 8) * 64, 2, smem);
    } else if (t < 2560) {
      t -= 2304;
      tr_tile(P.w_out + (size_t)l * 1024 * 1024, 1024, Wl + W_O, 1024, (t / 16) * 64, (t % 16) * 64, 2, smem);
    } else if (t < 3968) {
      t -= 2560;
      tr_tile(P.w_ffn_in + (size_t)l * 1024 * 5632, 5632, Wl + W_FI, 1024, (t / 16) * 64, (t % 16) * 64, 3, smem);
    } else {
      t -= 3968;
      tr_tile(P.w_ffn_out + (size_t)l * FH * 1024, 1024, Wl + W_FO, FH, (t / 44) * 64, (t % 44) * 64, 2, smem);
    }
  }
  for (int it = blockIdx.x; it < 384; it += gridDim.x) {
    int l = it / 192, n0 = (it % 192) * 32;
    float* sc = reinterpret_cast<float*>(smem);
    float* red = sc + 17 * 1024;
    __syncthreads();
    for (int idx = tid; idx < 17 * 1024; idx += NTHREADS) {
      int cond = idx >> 10, k = idx & 1023;
      float cv = cond < 16 ? P.c[cond * 1024 + k] : P.c_ctx[k];
      sc[idx] = siluf_(cv);
    }
    __syncthreads();
    int col = tid & 31, ks = tid >> 5;
    float acc[17];
#pragma unroll
    for (int j = 0; j < 17; ++j) acc[j] = 0.f;
    const float* wm = P.w_mod + (size_t)l * 1024 * 6144 + n0 + col;
    for (int k = ks * 64; k < ks * 64 + 64; ++k) {
      float w = wm[(size_t)k * 6144];
#pragma unroll
      for (int j = 0; j < 17; ++j) acc[j] += sc[j * 1024 + k] * w;
    }
#pragma unroll
    for (int j = 0; j < 17; ++j) red[(ks * 17 + j) * 32 + col] = acc[j];
    __syncthreads();
    for (int o = tid; o < 17 * 32; o += NTHREADS) {
      int j = o >> 5, cc = o & 31;
      float s = 0.f;
      for (int q = 0; q < 16; ++q) s += red[(q * 17 + j) * 32 + cc];
      WS_MOD(P)[((size_t)l * 17 + j) * 6144 + n0 + cc] = s + P.b_mod[l * 6144 + n0 + cc];
    }
  }
  for (int idx = blockIdx.x * NTHREADS + tid; idx < T * 32; idx += gridDim.x * NTHREADS) {
    int t = idx >> 5, j = idx & 31;
    int pos = j < 16 ? (t >> 6) : (t & 63);
    float inv = powf(10000.f, -(float)(j & 15) / 16.f);
    float ang = (float)pos * inv;
    WS_ROPE(P)[idx * 2] = cosf(ang);
    WS_ROPE(P)[idx * 2 + 1] = sinf(ang);
  }
  for (int idx = blockIdx.x * NTHREADS + tid; idx < NCTXR * 1024 / 4; idx += gridDim.x * NTHREADS)
    reinterpret_cast<float4*>(WS_XC(P))[idx] = reinterpret_cast<const float4*>(P.ctx)[idx];
  if (blockIdx.x == 0 && tid < 64) {
    for (int l = 0; l < 2; ++l) {
      float a = wave_sum(P.lam_q1[l * 64 + tid] * P.lam_k1[l * 64 + tid]);
      float b = wave_sum(P.lam_q2[l * 64 + tid] * P.lam_k2[l * 64 + tid]);
      float lam_init = 0.8f - 0.6f * expf(-0.3f * (float)l);
      if (tid == 0) WS_LAM(P)[l] = expf(a) - expf(b) + lam_init;
    }
    if (tid < 8) WS_CTR(P)[tid] = 0u;
  }
}

DEV void phase_norm_mod(const Params& P, const float* xlat, const float* xctx, int nrows, const float* g,
                        const float* modl, int sh_off, int sc_off) {
  const int lane = my_tid() & 63, wid = my_tid() >> 6;
  for (int row = blockIdx.x * 8 + wid; row < nrows; row += gridDim.x * 8) {
    const float* src = row < NLAT ? xlat + (size_t)row * 1024 : xctx + (size_t)(row - NLAT) * 1024;
    int cond = row < NLAT ? row >> 12 : 16;
    const float* md = modl + (size_t)cond * 6144;
    float4 v[4];
    float ss = 0.f;
#pragma unroll
    for (int i = 0; i < 4; ++i) {
      v[i] = *reinterpret_cast<const float4*>(src + i * 256 + lane * 4);
      ss += v[i].x * v[i].x + v[i].y * v[i].y + v[i].z * v[i].z + v[i].w * v[i].w;
    }
    ss = wave_sum(ss);
    float rstd = rsqrtf(ss * (1.f / 1024.f) + EPS);
#pragma unroll
    for (int i = 0; i < 4; ++i) {
      int cb = i * 256 + lane * 4;
      float4 gg = *reinterpret_cast<const float4*>(g + cb);
      float4 sh = *reinterpret_cast<const float4*>(md + sh_off + cb);
      float4 sc = *reinterpret_cast<const float4*>(md + sc_off + cb);
      float y0 = v[i].x * rstd * gg.x * (1.f + sc.x) + sh.x;
      float y1 = v[i].y * rstd * gg.y * (1.f + sc.y) + sh.y;
      float y2 = v[i].z * rstd * gg.z * (1.f + sc.z) + sh.z;
      float y3 = v[i].w * rstd * gg.w * (1.f + sc.w) + sh.w;
      *reinterpret_cast<uint2*>(WS_H(P) + (size_t)row * 1024 + cb) = make_uint2(pack2(y0, y1), pack2(y2, y3));
    }
  }
}

DEV void phase_final_norm(const Params& P) {
  const int lane = my_tid() & 63, wid = my_tid() >> 6;
  for (int row = blockIdx.x * 8 + wid; row < NLAT; row += gridDim.x * 8) {
    float* src = P.out + (size_t)row * 1024;
    float4 v[4];
    float ss = 0.f;
#pragma unroll
    for (int i = 0; i < 4; ++i) {
      v[i] = *reinterpret_cast<const float4*>(src + i * 256 + lane * 4);
      ss += v[i].x * v[i].x + v[i].y * v[i].y + v[i].z * v[i].z + v[i].w * v[i].w;
    }
    ss = wave_sum(ss);
    float rstd = rsqrtf(ss * (1.f / 1024.f) + EPS);
#pragma unroll
    for (int i = 0; i < 4; ++i) {
      int cb = i * 256 + lane * 4;
      float4 gg = *reinterpret_cast<const float4*>(P.g_final + cb);
      float4 o = make_float4(v[i].x * rstd * gg.x, v[i].y * rstd * gg.y, v[i].z * rstd * gg.z, v[i].w * rstd * gg.w);
      *reinterpret_cast<float4*>(src + cb) = o;
    }
  }
}

struct EpiInProj {
  const Params& P;
  int l;
  DEV void operator()(f32x4 (&acc)[8][4], int row0, int col0) const {
    const int lane = my_tid() & 63, fr = lane & 15, fq = lane >> 4;
    if (col0 >= 4416) return;
    if (col0 < C_WQ) {
#pragma unroll
      for (int mi = 0; mi < 8; ++mi)
#pragma unroll
        for (int ni = 0; ni < 4; ++ni)
#pragma unroll
          for (int j = 0; j < 4; ++j)
            WS_P(P)[(size_t)(row0 + mi * 16 + fq * 4 + j) * PW + col0 + ni * 16 + fr] = f2bf(acc[mi][ni][j]);
    } else if (col0 < 3712) {
      const bool isq = (col0 < C_WK) || (col0 >= C_DQ && col0 < C_DK);
      const float qs = isq ? 0.125f : 1.f;
#pragma unroll
      for (int mi = 0; mi < 8; ++mi)
#pragma unroll
        for (int j = 0; j < 4; ++j) {
          int row = row0 + mi * 16 + fq * 4 + j;
          u16* dst = WS_P(P) + (size_t)row * PW + col0 + fr;
          if (row < NLAT) {
            int t = row & (T - 1);
            const float2* rt = reinterpret_cast<const float2*>(WS_ROPE(P)) + t * 32;
#pragma unroll
            for (int hf = 0; hf < 2; ++hf) {
              float2 cs = rt[hf * 16 + fr];
              float x1 = acc[mi][hf * 2][j], x2 = acc[mi][hf * 2 + 1][j];
              dst[hf * 32] = f2bf((x1 * cs.x - x2 * cs.y) * qs);
              dst[hf * 32 + 16] = f2bf((x2 * cs.x + x1 * cs.y) * qs);
            }
          } else {
#pragma unroll
            for (int ni = 0; ni < 4; ++ni) dst[ni * 16] = f2bf(acc[mi][ni][j] * qs);
          }
        }
    } else if (col0 < 4352) {
      u16* base;
      int vrow0;
      const int hdW = (col0 - 3712) >> 6;
      const int hdD = (col0 - 3840) >> 7;
      const bool isw = col0 < 3840;
#pragma unroll
      for (int mi = 0; mi < 8; ++mi) {
        int row = row0 + mi * 16 + fq * 4;
        int b, key;
        if (row < NLAT) { b = row >> 12; key = 256 + (row & (T - 1)); }
        else { b = (row - NLAT) >> 8; key = (row - NLAT) & 255; }
        if (isw) { base = WS_VTW(P) + ((size_t)(b * 2 + hdW) * 64) * KEYS; vrow0 = 0; }
        else { base = WS_VTD(P) + ((size_t)(b * 4 + hdD) * 128) * KEYS; vrow0 = (col0 - 3840) & 127; }
#pragma unroll
        for (int ni = 0; ni < 4; ++ni) {
          int v = vrow0 + ni * 16 + fr;
          *reinterpret_cast<uint2*>(base + (size_t)v * KEYS + key) =
              make_uint2(pack2(acc[mi][ni][0], acc[mi][ni][1]), pack2(acc[mi][ni][2], acc[mi][ni][3]));
        }
      }
    } else {
      float bg = P.b_gate[l * 16 + fr];
#pragma unroll
      for (int mi = 0; mi < 8; ++mi)
#pragma unroll
        for (int j = 0; j < 4; ++j) WS_GATES(P)[(size_t)(row0 + mi * 16 + fq * 4 + j) * 16 + fr] = acc[mi][0][j] + bg;
    }
  }
};

template <int QB, int VB, int KW>
struct AttnCore {
  static constexpr int DV = 32 * VB;
  static constexpr int KST = KW * 2 + 16;
  static constexpr int VST = 128 + 16;
  static constexpr int KBYTES = 64 * KST, VBYTES = DV * VST;
  static constexpr int NKL = 64 * (KW / 8) / NTHREADS, NVL = DV * 8 / NTHREADS;
  static constexpr int TOTAL = 2 * (KBYTES + VBYTES);

  static DEV void run(const u16* qptr, int ldq, const u16* kctx, const u16* klat, int ldk, int kcol, const u16* vt,
                      int nctx, int nlat, int lat_t0, bool window, int qtok0, float m_init, float l_init,
                      f32x16 (&O)[QB][VB], char* smem) {
    const int tid = my_tid(), lane = tid & 63, r = lane & 31, hh = lane >> 5;
    char* Ks = smem;
    char* Vs = smem + 2 * KBYTES;
    bf16x8 qf[QB][4];
#pragma unroll
    for (int qb = 0; qb < QB; ++qb)
#pragma unroll
      for (int ks = 0; ks < 4; ++ks) qf[qb][ks] = ld16(qptr + (size_t)(qb * 32 + r) * ldq + ks * 16 + hh * 8);
    float m[QB], lsum[QB];
#pragma unroll
    for (int qb = 0; qb < QB; ++qb) {
      m[qb] = m_init;
      lsum[qb] = hh == 0 ? l_init : 0.f;
#pragma unroll
      for (int vb = 0; vb < VB; ++vb)
#pragma unroll
        for (int i = 0; i < 16; ++i) O[qb][vb][i] = 0.f;
    }
    bf16x8 rk[NKL], rv[NVL];
    const int ntiles = nctx + nlat;
    auto gload = [&](int j) {
      int kidx = j < nctx ? j * 64 : 256 + lat_t0 + (j - nctx) * 64;
      const u16* krow = j < nctx ? kctx + (size_t)(j * 64) * ldk : klat + (size_t)(lat_t0 + (j - nctx) * 64) * ldk;
#pragma unroll
      for (int i = 0; i < NKL; ++i) {
        int id = tid + i * NTHREADS, row = id / (KW / 8), c = id % (KW / 8);
        rk[i] = ld16(krow + (size_t)row * ldk + c * 8);
      }
#pragma unroll
      for (int i = 0; i < NVL; ++i) {
        int id = tid + i * NTHREADS, row = id >> 3, c = id & 7;
        rv[i] = ld16(vt + (size_t)row * KEYS + kidx + c * 8);
      }
    };
    auto lstore = [&](int buf) {
#pragma unroll
      for (int i = 0; i < NKL; ++i) {
        int id = tid + i * NTHREADS, row = id / (KW / 8), c = id % (KW / 8);
        *reinterpret_cast<bf16x8*>(Ks + buf * KBYTES + row * KST + c * 16) = rk[i];
      }
#pragma unroll
      for (int i = 0; i < NVL; ++i) {
        int id = tid + i * NTHREADS, row = id >> 3, c = id & 7;
        *reinterpret_cast<bf16x8*>(Vs + buf * VBYTES + row * VST + c * 16) = rv[i];
      }
    };
    __syncthreads();
    gload(0);
    lstore(0);
    __syncthreads();
    for (int j = 0; j < ntiles; ++j) {
      const int buf = j & 1;
      if (j + 1 < ntiles) gload(j + 1);
      bf16x8 pf[QB][2][2];
#pragma unroll
      for (int qb = 0; qb < QB; ++qb) {
        f32x16 S[2];
#pragma unroll
        for (int kb = 0; kb < 2; ++kb) {
#pragma unroll
          for (int i = 0; i < 16; ++i) S[kb][i] = 0.f;
#pragma unroll
          for (int ks = 0; ks < 4; ++ks) {
            bf16x8 kf = ld16(Ks + buf * KBYTES + (kb * 32 + pi32(r)) * KST + (kcol + ks * 16 + hh * 8) * 2);
            S[kb] = mfma32(kf, qf[qb][ks], S[kb]);
          }
        }
        __builtin_amdgcn_sched_barrier(0);
        if (window && j >= nctx) {
          int kt0 = lat_t0 + (j - nctx) * 64;
          int qt = qtok0 + qb * 32 + r;
#pragma unroll
          for (int kb = 0; kb < 2; ++kb)
#pragma unroll
            for (int i = 0; i < 16; ++i) {
              int kt = kt0 + kb * 32 + 16 * (i >> 3) + 8 * hh + (i & 7);
              int dlt = qt - kt;
              if (dlt > 128 || dlt < -128) S[kb][i] = -1e30f;
            }
        }
        float mloc = -1e30f;
#pragma unroll
        for (int kb = 0; kb < 2; ++kb)
#pragma unroll
          for (int i = 0; i < 16; ++i) mloc = fmaxf(mloc, S[kb][i]);
        mloc = fmaxf(mloc, __shfl_xor(mloc, 32));
        if (__any(mloc > m[qb] + 5.5f)) {
          float mnew = fmaxf(m[qb], mloc);
          float alpha = fexp2((m[qb] - mnew) * L2E);
          m[qb] = mnew;
          lsum[qb] *= alpha;
#pragma unroll
          for (int vb = 0; vb < VB; ++vb)
#pragma unroll
            for (int i = 0; i < 16; ++i) O[qb][vb][i] *= alpha;
        }
        float mb = m[qb] * L2E, ps = 0.f;
#pragma unroll
        for (int kb = 0; kb < 2; ++kb) {
          float pv[16];
#pragma unroll
          for (int i = 0; i < 16; ++i) {
            pv[i] = fexp2(S[kb][i] * L2E - mb);
            ps += pv[i];
          }
#pragma unroll
          for (int s = 0; s < 2; ++s)
            pf[qb][kb][s] = mk8(pack2(pv[8 * s], pv[8 * s + 1]), pack2(pv[8 * s + 2], pv[8 * s + 3]),
                                pack2(pv[8 * s + 4], pv[8 * s + 5]), pack2(pv[8 * s + 6], pv[8 * s + 7]));
        }
        lsum[qb] += ps;
        __builtin_amdgcn_sched_barrier(0);
      }
      __builtin_amdgcn_sched_barrier(0);
#pragma unroll
      for (int vb = 0; vb < VB; ++vb) {
#pragma unroll
        for (int kb = 0; kb < 2; ++kb)
#pragma unroll
          for (int s = 0; s < 2; ++s) {
            bf16x8 vf = ld16(Vs + buf * VBYTES + (vb * 32 + r) * VST + (kb * 32 + s * 16 + hh * 8) * 2);
#pragma unroll
            for (int qb = 0; qb < QB; ++qb) O[qb][vb] = mfma32(vf, pf[qb][kb][s], O[qb][vb]);
          }
        __builtin_amdgcn_sched_barrier(0);
      }
      if (j + 1 < ntiles) lstore(buf ^ 1);
      __syncthreads();
    }
#pragma unroll
    for (int qb = 0; qb < QB; ++qb) {
      float lt = lsum[qb] + __shfl_xor(lsum[qb], 32);
      float inv = 1.f / lt;
#pragma unroll
      for (int vb = 0; vb < VB; ++vb)
#pragma unroll
        for (int i = 0; i < 16; ++i) O[qb][vb][i] *= inv;
    }
  }
};

DEV void diff_item(const Params& P, int l, int b, int h, int qt, bool ctxq, char* smem) {
  const int tid = my_tid(), lane = tid & 63, wid = tid >> 6, r = lane & 31, hh = lane >> 5;
  const int comp = wid >> 2, wq = wid & 3;
  const int rowbase = ctxq ? NLAT + b * 256 + qt * 128 : b * T + qt * 128;
  const u16* qptr = WS_P(P) + (size_t)(rowbase + wq * 32) * PW + C_DQ + h * 128 + comp * 64;
  const u16* kctx = WS_P(P) + (size_t)(NLAT + b * 256) * PW + C_DK + h * 128;
  const u16* klat = WS_P(P) + (size_t)(b * T) * PW + C_DK + h * 128;
  const u16* vt = WS_VTD(P) + ((size_t)(b * 4 + h) * 128) * KEYS;
  f32x16 O[1][4];
  AttnCore<1, 4, 128>::run(qptr, PW, kctx, klat, PW, comp * 64, vt, 4, ctxq ? 0 : 64, 0, false, 0, -1e30f, 0.f, O, smem);
  float* ex = reinterpret_cast<float*>(smem);
  __syncthreads();
  if (comp == 1) {
#pragma unroll
    for (int vb = 0; vb < 4; ++vb)
#pragma unroll
      for (int i = 0; i < 16; ++i) ex[(wq * 64 + vb * 16 + i) * 64 + lane] = O[0][vb][i];
  }
  __syncthreads();
  if (comp == 0) {
    const float lam = WS_LAM(P)[l];
    const float lam_init = 0.8f - 0.6f * expf(-0.3f * (float)l);
    float ss = 0.f;
#pragma unroll
    for (int vb = 0; vb < 4; ++vb)
#pragma unroll
      for (int i = 0; i < 16; ++i) {
        float y = O[0][vb][i] - lam * ex[(wq * 64 + vb * 16 + i) * 64 + lane];
        O[0][vb][i] = y;
        ss += y * y;
      }
    ss += __shfl_xor(ss, 32);
    float sc = rsqrtf(ss * (1.f / 128.f) + EPS) * (1.f - lam_init);
    const float* dn = P.d_norm + l * 512 + h * 128;
    u16* dst = WS_P(P) + (size_t)(rowbase + wq * 32 + r) * PW + C_DQ + h * 128;
#pragma unroll
    for (int vb = 0; vb < 4; ++vb)
#pragma unroll
      for (int g4 = 0; g4 < 4; ++g4) {
        int v = vb * 32 + g4 * 8 + hh * 4;
        float4 w = *reinterpret_cast<const float4*>(dn + v);
        *reinterpret_cast<uint2*>(dst + v) =
            make_uint2(pack2(O[0][vb][g4 * 4] * sc * w.x, O[0][vb][g4 * 4 + 1] * sc * w.y),
                       pack2(O[0][vb][g4 * 4 + 2] * sc * w.z, O[0][vb][g4 * 4 + 3] * sc * w.w));
      }
  }
  __syncthreads();
}

DEV void win_item(const Params& P, int l, int b, int g, int qb, bool ctxq, char* smem) {
  const int tid = my_tid(), lane = tid & 63, wid = tid >> 6, r = lane & 31, hh = lane >> 5;
  const int hr = wid >> 1, qh = wid & 1;
  const int head = g * 4 + hr;
  const int rowbase = (ctxq ? NLAT + b * 256 + qb * 64 : b * T + qb * 64) + qh * 32;
  const u16* qptr = WS_P(P) + (size_t)rowbase * PW + C_WQ + head * 64;
  const u16* kctx = WS_P(P) + (size_t)(NLAT + b * 256) * PW + C_WK + g * 64;
  const u16* klat = WS_P(P) + (size_t)(b * T) * PW + C_WK + g * 64;
  const u16* vt = WS_VTW(P) + ((size_t)(b * 2 + g) * 64) * KEYS;
  int t0 = 0, nlat = 0;
  if (!ctxq) {
    t0 = qb * 64 - 128;
    if (t0 < 0) t0 = 0;
    int t1 = qb * 64 + 192;
    if (t1 > T) t1 = T;
    nlat = (t1 - t0) >> 6;
  }
  f32x16 O[1][2];
  AttnCore<1, 2, 64>::run(qptr, PW, kctx, klat, PW, 0, vt, 4, nlat, t0, !ctxq, qb * 64 + qh * 32, P.sink[l * 8 + head], 1.f, O, smem);
  u16* dst = WS_P(P) + (size_t)(rowbase + r) * PW + C_WQ + head * 64;
#pragma unroll
  for (int vb = 0; vb < 2; ++vb)
#pragma unroll
    for (int g4 = 0; g4 < 4; ++g4) {
      int v = vb * 32 + g4 * 8 + hh * 4;
      *reinterpret_cast<uint2*>(dst + v) = make_uint2(pack2(O[0][vb][g4 * 4], O[0][vb][g4 * 4 + 1]),
                                                        pack2(O[0][vb][g4 * 4 + 2], O[0][vb][g4 * 4 + 3]));
    }
}

DEV void mlstm_item(const Params& P, int l, int b, int hd, int dir, bool need_ctx, char* smem) {
  const int tid = my_tid(), lane = tid & 63, wid = tid >> 6, r = lane & 31, hh = lane >> 5;
  constexpr int QST = 272, TST = 144;
  char* Qs = smem;
  char* Ks = Qs + 64 * QST;
  char* KwT = Ks + 64 * QST;
  char* VT = KwT + 128 * TST;
  char* Sp = VT + 128 * TST;
  char* Rq = Sp + 64 * TST;
  char* Rk = Rq + 66 * QST;
  float* fb = reinterpret_cast<float*>(Rk + 66 * QST);
  float* sb = fb;
  float* sa = fb + 64;
  float* sM = fb + 128;
  float* denp = fb + 192;
  float* qn = fb + 320;
  float* nb = fb + 384;
  float* cw = fb + 640;
  __syncthreads();
  if (tid < 256) nb[tid] = 0.f;
  for (int i = tid; i < 768; i += NTHREADS) {
    int qk = i / 384, tap = (i % 384) / 128, d = i & 127;
    cw[i] = P.conv_w[(size_t)l * 3 * 1024 + tap * 1024 + qk * 512 + hd * 128 + d];
  }
  f32x16 CT[4];
#pragma unroll
  for (int kb = 0; kb < 4; ++kb)
#pragma unroll
    for (int i = 0; i < 16; ++i) CT[kb][i] = 0.f;
  float mstate = 0.f;
  u16* hout = WS_HFB(P) + (size_t)dir * MTOT * 512;
  const float kscale = 0.08838834764831845f;

  auto geom = [&](int step, int& seg0, int& seglen, int& u0) {
    int c;
    if (step < 4) { seg0 = NLAT + b * 256; seglen = 256; c = dir ? 3 - step : step; }
    else { seg0 = b * T; seglen = T; c = dir ? 67 - step : step - 4; }
    u0 = c * 64;
  };
  bf16x8 pq[3], pk[3], pvv[2];
  float pig = 0.f, pfg = 0.f;
  auto issue_loads = [&](int step) {
    int seg0, seglen, u0;
    geom(step, seg0, seglen, u0);
#pragma unroll
    for (int i = 0; i < 3; ++i) {
      int id = tid + i * NTHREADS;
      bf16x8 z = {0, 0, 0, 0, 0, 0, 0, 0};
      pq[i] = z;
      pk[i] = z;
      if (id < 66 * 16) {
        int row = id >> 4, cc = id & 15;
        int uu = u0 + row - 1;
        bool ok = uu >= 0 && uu < seglen;
        const u16* src = WS_P(P) + (size_t)(seg0 + (ok ? uu : 0)) * PW + hd * 128 + cc * 8;
        if (ok) { pq[i] = ld16(src + C_MQ); pk[i] = ld16(src + C_MK); }
      }
    }
#pragma unroll
    for (int i = 0; i < 2; ++i) {
      int id = tid + i * NTHREADS, u = id >> 4, cc = id & 15;
      pvv[i] = ld16(WS_P(P) + (size_t)(seg0 + u0 + u) * PW + C_MV + hd * 128 + cc * 8);
    }
    if (wid == 0) {
      const int pos = dir ? 63 - lane : lane;
      const float* gp = WS_GATES(P) + (size_t)(seg0 + u0 + pos) * 16;
      pig = gp[(dir * 2) * 4 + hd];
      pfg = gp[(dir * 2 + 1) * 4 + hd];
    }
  };
  issue_loads(0);

  for (int step = 0; step < 68; ++step) {
    int seg0, seglen, u0;
    geom(step, seg0, seglen, u0);
    const int rowbase = seg0 + u0;
    const int cur = step & 1;
    __syncthreads();
    bf16x8 rvv[2];
#pragma unroll
    for (int i = 0; i < 3; ++i) {
      int id = tid + i * NTHREADS;
      if (id < 66 * 16) {
        int row = id >> 4, cc = id & 15;
        *reinterpret_cast<bf16x8*>(Rq + row * QST + cc * 16) = pq[i];
        *reinterpret_cast<bf16x8*>(Rk + row * QST + cc * 16) = pk[i];
      }
    }
    rvv[0] = pvv[0];
    rvv[1] = pvv[1];
    const float ig = pig, fg = pfg;
    if (step + 1 < 68) issue_loads(step + 1);
    if (wid == 0) {
      const int pos = dir ? 63 - lane : lane;
      float lf = fminf(fg, 0.f) - log1pf(__expf(-fabsf(fg)));
      float bsum = lf;
#pragma unroll
      for (int o = 1; o < 64; o <<= 1) { float t2 = __shfl_up(bsum, o); if (lane >= o) bsum += t2; }
      float a = ig - bsum, am = a;
#pragma unroll
      for (int o = 1; o < 64; o <<= 1) { float t2 = __shfl_up(am, o); if (lane >= o) am = fmaxf(am, t2); }
      sb[pos] = bsum;
      sa[pos] = a;
      sM[pos] = fmaxf(mstate, am);
    }
    __syncthreads();
    const int eidx = dir ? 0 : 63;
    const float Mend = sM[eidx], bend = sb[eidx];
    const float decay = __expf(mstate - Mend);
#pragma unroll 1
    for (int i = 0; i < 2; ++i) {
      int id = tid + i * NTHREADS, u = id >> 4, cc = id & 15;
      float wend = __expf(sa[u] - Mend);
      uint32_t qo[4], ko[4];
      float kv[8];
      bf16x8 q0 = ld16(Rq + (u)*QST + cc * 16), q1 = ld16(Rq + (u + 1) * QST + cc * 16), q2 = ld16(Rq + (u + 2) * QST + cc * 16);
      bf16x8 k0 = ld16(Rk + (u)*QST + cc * 16), k1 = ld16(Rk + (u + 1) * QST + cc * 16), k2 = ld16(Rk + (u + 2) * QST + cc * 16);
#pragma unroll
      for (int e = 0; e < 8; ++e) {
        int d = cc * 8 + e;
        float xq = cw[0 * 128 + d] * bf2f((u16)q0[e]) + cw[1 * 128 + d] * bf2f((u16)q1[e]) + cw[2 * 128 + d] * bf2f((u16)q2[e]);
        float xk = cw[384 + 0 * 128 + d] * bf2f((u16)k0[e]) + cw[384 + 1 * 128 + d] * bf2f((u16)k1[e]) + cw[384 + 2 * 128 + d] * bf2f((u16)k2[e]);
        float qv = siluf_(xq);
        kv[e] = siluf_(xk) * kscale;
        if (e & 1) { qo[e >> 1] |= ((uint32_t)f2bf(qv)) << 16; ko[e >> 1] |= ((uint32_t)f2bf(kv[e])) << 16; }
        else { qo[e >> 1] = f2bf(qv); ko[e >> 1] = f2bf(kv[e]); }
        *reinterpret_cast<u16*>(KwT + (d)*TST + u * 2) = f2bf(kv[e] * wend);
        *reinterpret_cast<u16*>(VT + (d)*TST + u * 2) = (u16)rvv[i][e];
      }
      *reinterpret_cast<uint4*>(Qs + u * QST + cc * 16) = make_uint4(qo[0], qo[1], qo[2], qo[3]);
      *reinterpret_cast<uint4*>(Ks + u * QST + cc * 16) = make_uint4(ko[0], ko[1], ko[2], ko[3]);
    }
    __syncthreads();
    if (wid < 4) {
      const int sblk = wid & 1, tblk = wid >> 1;
      f32x16 S;
#pragma unroll
      for (int i = 0; i < 16; ++i) S[i] = 0.f;
#pragma unroll
      for (int ks = 0; ks < 8; ++ks) {
        bf16x8 kf = ld16(Ks + (sblk * 32 + pi32(r)) * QST + (ks * 16 + hh * 8) * 2);
        bf16x8 qf = ld16(Qs + (tblk * 32 + r) * QST + (ks * 16 + hh * 8) * 2);
        S = mfma32(kf, qf, S);
      }
      const int t = tblk * 32 + r;
      const float Mt = sM[t];
      float ds = 0.f, val[16];
#pragma unroll
      for (int i = 0; i < 16; ++i) {
        int s = sblk * 32 + 16 * (i >> 3) + 8 * hh + (i & 7);
        bool ok = dir ? (s >= t) : (s <= t);
        val[i] = ok ? S[i] * __expf(sa[s] - Mt) : 0.f;
        ds += val[i];
      }
      ds += __shfl_xor(ds, 32);
      if (hh == 0) denp[sblk * 64 + t] = ds;
#pragma unroll
      for (int s2 = 0; s2 < 2; ++s2)
        *reinterpret_cast<uint4*>(Sp + t * TST + (sblk * 32 + s2 * 16 + hh * 8) * 2) =
            make_uint4(pack2(val[8 * s2], val[8 * s2 + 1]), pack2(val[8 * s2 + 2], val[8 * s2 + 3]),
                       pack2(val[8 * s2 + 4], val[8 * s2 + 5]), pack2(val[8 * s2 + 6], val[8 * s2 + 7]));
    } else if (wid == 4) {
      float s = 0.f;
      const float* nc = nb + cur * 128;
      for (int k8 = 0; k8 < 16; ++k8) {
        bf16x8 qv = ld16(Qs + lane * QST + k8 * 16);
#pragma unroll
        for (int e = 0; e < 8; ++e) s += nc[k8 * 8 + e] * bf2f((u16)qv[e]);
      }
      qn[lane] = s;
    } else if (wid == 5) {
      const float* nc = nb + cur * 128;
      float* nn = nb + (cur ^ 1) * 128;
#pragma unroll
      for (int q2 = 0; q2 < 2; ++q2) {
        int k = lane + q2 * 64;
        float s = 0.f;
        for (int s8 = 0; s8 < 8; ++s8) {
          bf16x8 kv = ld16(KwT + k * TST + s8 * 16);
#pragma unroll
          for (int e = 0; e < 8; ++e) s += bf2f((u16)kv[e]);
        }
        nn[k] = decay * nc[k] + s;
      }
    }
    __syncthreads();
    {
      bf16x8 vf[4];
      const int vb = wid & 3, tb = wid >> 2;
#pragma unroll
      for (int ks = 0; ks < 4; ++ks) vf[ks] = ld16(VT + (vb * 32 + r) * TST + (ks * 16 + hh * 8) * 2);
      const bool wr_h = (step >= 4) || need_ctx;
      {
        const int t = tb * 32 + r;
        f32x16 acc;
#pragma unroll
        for (int i = 0; i < 16; ++i) acc[i] = 0.f;
#pragma unroll
        for (int kb = 0; kb < 4; ++kb)
#pragma unroll
          for (int s2 = 0; s2 < 2; ++s2) {
            bf16x8 af = mk8(pack2(CT[kb][8 * s2], CT[kb][8 * s2 + 1]), pack2(CT[kb][8 * s2 + 2], CT[kb][8 * s2 + 3]),
                            pack2(CT[kb][8 * s2 + 4], CT[kb][8 * s2 + 5]), pack2(CT[kb][8 * s2 + 6], CT[kb][8 * s2 + 7]));
            uint2 lo = *reinterpret_cast<const uint2*>(Qs + t * QST + (kb * 32 + s2 * 16 + hh * 4) * 2);
            uint2 hi = *reinterpret_cast<const uint2*>(Qs + t * QST + (kb * 32 + s2 * 16 + 8 + hh * 4) * 2);
            acc = mfma32(af, mk8(lo.x, lo.y, hi.x, hi.y), acc);
          }
        const float Mt = sM[t];
        const float winter = __expf(mstate - Mt);
#pragma unroll
        for (int i = 0; i < 16; ++i) acc[i] *= winter;
#pragma unroll
        for (int ks = 0; ks < 4; ++ks) {
          bf16x8 sf = ld16(Sp + t * TST + (ks * 16 + hh * 8) * 2);
          acc = mfma32(vf[ks], sf, acc);
        }
        float den = denp[t] + denp[64 + t] + winter * qn[t];
        float sc = 1.f / fmaxf(fabsf(den), __expf(-(sb[t] + Mt)));
        if (wr_h) {
          u16* dst = hout + (size_t)(rowbase + t) * 512 + hd * 128 + vb * 32;
#pragma unroll
          for (int g4 = 0; g4 < 4; ++g4)
            *reinterpret_cast<uint2*>(dst + g4 * 8 + hh * 4) =
                make_uint2(pack2(acc[g4 * 4] * sc, acc[g4 * 4 + 1] * sc), pack2(acc[g4 * 4 + 2] * sc, acc[g4 * 4 + 3] * sc));
        }
      }
#pragma unroll
      for (int kb = 0; kb < 4; ++kb) {
#pragma unroll
        for (int i = 0; i < 16; ++i) CT[kb][i] *= decay;
#pragma unroll
        for (int ks = 0; ks < 4; ++ks) {
          bf16x8 kf = ld16(KwT + (kb * 32 + r) * TST + (ks * 16 + hh * 8) * 2);
          CT[kb] = mfma32(kf, vf[ks], CT[kb]);
        }
      }
    }
    mstate = bend + Mend;
  }
  __syncthreads();
}

DEV int next_item(unsigned* ctr, int* s_item) {
  __syncthreads();
  if (my_tid() == 0) *s_item = (int)atomicAdd(ctr, 1u);
  __syncthreads();
  return *s_item;
}
DEV void phase_mixers(const Params& P, int l, char* smem) {
  const bool need_ctx = (l == 0);
  __shared__ int s_item;
  const int n_ml = 128, n_diff = 2048, n_win = 2048, n_dc = need_ctx ? 128 : 0, n_wc = need_ctx ? 128 : 0;
  for (;;) {
    int it = next_item(&WS_CTR(P)[l * 4 + 0], &s_item);
    if (it >= n_ml) break;
    mlstm_item(P, l, it >> 3, (it >> 1) & 3, it & 1, need_ctx, smem);
  }
  for (;;) {
    int it = next_item(&WS_CTR(P)[l * 4 + 1], &s_item);
    if (it >= n_diff + n_dc) break;
    bool cq = it >= n_diff;
    int i2 = it - n_diff;
    int b = cq ? i2 >> 3 : it >> 7, hd = cq ? (i2 >> 1) & 3 : (it >> 5) & 3, qt = cq ? i2 & 1 : it & 31;
    diff_item(P, l, b, hd, qt, cq, smem);
  }
  for (;;) {
    int it = next_item(&WS_CTR(P)[l * 4 + 2], &s_item);
    if (it >= n_win + n_wc) break;
    bool cq = it >= n_win;
    int i2 = it - n_win;
    int b = cq ? i2 >> 3 : it >> 7, g = cq ? (i2 >> 2) & 1 : (it >> 6) & 1, qb = cq ? i2 & 3 : it & 63;
    win_item(P, l, b, g, qb, cq, smem);
  }
}

DEV void phase_ya(const Params& P, int l, int nrows) {
  const int lane = my_tid() & 63, wid = my_tid() >> 6;
  const u16* hf = WS_HFB(P);
  const u16* hb = WS_HFB(P) + (size_t)MTOT * 512;
  for (int row = blockIdx.x * 8 + wid; row < nrows; row += gridDim.x * 8) {
    uint4 a = *reinterpret_cast<const uint4*>(hf + (size_t)row * 512 + lane * 8);
    uint4 bq = *reinterpret_cast<const uint4*>(hb + (size_t)row * 512 + lane * 8);
    uint4 o = *reinterpret_cast<const uint4*>(WS_P(P) + (size_t)row * PW + C_MO + lane * 8);
    uint32_t aa[4] = {a.x, a.y, a.z, a.w}, bb[4] = {bq.x, bq.y, bq.z, bq.w}, oo[4] = {o.x, o.y, o.z, o.w};
    float y[8], ss = 0.f;
#pragma unroll
    for (int j = 0; j < 4; ++j) {
      y[2 * j] = (bflo(aa[j]) + bflo(bb[j])) * sigmoidf_(bflo(oo[j]));
      y[2 * j + 1] = (bfhi(aa[j]) + bfhi(bb[j])) * sigmoidf_(bfhi(oo[j]));
      ss += y[2 * j] * y[2 * j] + y[2 * j + 1] * y[2 * j + 1];
    }
#pragma unroll
    for (int of = 1; of < 16; of <<= 1) ss += __shfl_xor(ss, of);
    float rstd = rsqrtf(ss * (1.f / 128.f) + EPS);
    const float* mn = P.m_norm + l * 512 + lane * 8;
    uint32_t w[4];
#pragma unroll
    for (int j = 0; j < 4; ++j) w[j] = pack2(y[2 * j] * rstd * mn[2 * j], y[2 * j + 1] * rstd * mn[2 * j + 1]);
    *reinterpret_cast<uint4*>(WS_P(P) + (size_t)row * PW + C_MO + lane * 8) = make_uint4(w[0], w[1], w[2], w[3]);
  }
}

DEV void phase_merge(const Params& P, int l, int M, char* smem) {
  const u16* Wl = WS_W(P) + (size_t)l * W_LAYER;
  u16* merged = WS_HFB(P);
  const int nM = M / 128, nN = 4;
  const int lane = my_tid() & 63, wid = my_tid() >> 6, wr = wid >> 2, wc = wid & 3, fr = lane & 15, fq = lane >> 4;
  for (int tile = blockIdx.x; tile < nM * nN; tile += gridDim.x) {
    int tm, tn;
    tile_coords(tile, nM * nN, nN, tm, tn);
    f32x4 mg[4][4];
    zero_acc<4, 4>(mg);
#pragma unroll 1
    for (int i = 0; i < 3; ++i) {
      f32x4 acc[4][4];
      zero_acc<4, 4>(acc);
      gemm_mainloop64(WS_H(P) + (size_t)tm * 128 * 1024, 1024, Wl + W_G + (size_t)(i * 1024 + tn * 256) * 1024, 1024, 1024, acc, smem);
      uint32_t gp[4][4][2];
#pragma unroll
      for (int mi = 0; mi < 4; ++mi)
#pragma unroll
        for (int ni = 0; ni < 4; ++ni) {
          gp[mi][ni][0] = pack2(sigmoidf_(acc[mi][ni][0]), sigmoidf_(acc[mi][ni][1]));
          gp[mi][ni][1] = pack2(sigmoidf_(acc[mi][ni][2]), sigmoidf_(acc[mi][ni][3]));
        }
      zero_acc<4, 4>(acc);
      int yc = i == 0 ? C_MO : (i == 1 ? C_WQ : C_DQ);
      gemm_mainloop64(WS_P(P) + (size_t)tm * 128 * PW + yc, PW, Wl + W_B + (size_t)i * 1024 * 512 + (size_t)(tn * 256) * 512, 512, 512, acc, smem);
#pragma unroll
      for (int mi = 0; mi < 4; ++mi)
#pragma unroll
        for (int ni = 0; ni < 4; ++ni) {
          mg[mi][ni][0] += bflo(gp[mi][ni][0]) * acc[mi][ni][0];
          mg[mi][ni][1] += bfhi(gp[mi][ni][0]) * acc[mi][ni][1];
          mg[mi][ni][2] += bflo(gp[mi][ni][1]) * acc[mi][ni][2];
          mg[mi][ni][3] += bfhi(gp[mi][ni][1]) * acc[mi][ni][3];
        }
    }
    const int row0 = tm * 128 + wr * 64, col0 = tn * 256 + wc * 64;
#pragma unroll
    for (int mi = 0; mi < 4; ++mi)
#pragma unroll
      for (int ni = 0; ni < 4; ++ni)
#pragma unroll
        for (int j = 0; j < 4; ++j)
          merged[(size_t)(row0 + mi * 16 + fq * 4 + j) * 1024 + col0 + ni * 16 + fr] = f2bf(mg[mi][ni][j]);
  }
}

struct EpiResid {
  const Params& P;
  const float* src_lat;
  const float* modl;
  int gt_off;
  DEV void operator()(f32x4 (&acc)[8][4], int row0, int col0) const {
    const int lane = my_tid() & 63, fr = lane & 15, fq = lane >> 4;
#pragma unroll
    for (int mi = 0; mi < 8; ++mi)
#pragma unroll
      for (int j = 0; j < 4; ++j) {
        int row = row0 + mi * 16 + fq * 4 + j;
        const float* src;
        float* dst;
        int cond;
        if (row < NLAT) { src = src_lat + (size_t)row * 1024; dst = P.out + (size_t)row * 1024; cond = row >> 12; }
        else { src = WS_XC(P) + (size_t)(row - NLAT) * 1024; dst = WS_XC(P) + (size_t)(row - NLAT) * 1024; cond = 16; }
        const float* gt = modl + (size_t)cond * 6144 + gt_off;
#pragma unroll
        for (int ni = 0; ni < 4; ++ni) {
          int col = col0 + ni * 16 + fr;
          dst[col] = src[col] + gt[col] * acc[mi][ni][j];
        }
      }
  }
};

struct EpiSwiglu {
  u16* act;
  DEV void operator()(f32x4 (&acc)[8][4], int row0, int col0) const {
    const int lane = my_tid() & 63, fr = lane & 15, fq = lane >> 4;
#pragma unroll
    for (int mi = 0; mi < 8; ++mi)
#pragma unroll
      for (int j = 0; j < 4; ++j) {
        int row = row0 + mi * 16 + fq * 4 + j;
#pragma unroll
        for (int pr = 0; pr < 2; ++pr) {
          float gte = acc[mi][pr * 2][j], up = acc[mi][pr * 2 + 1][j];
          act[(size_t)row * FH + ((col0 + pr * 32) >> 1) + fr] = f2bf(siluf_(gte) * up);
        }
      }
  }
};


namespace pg8 {
#define PG8_LAS __attribute__((address_space(3)))
constexpr int BM = 256, BK = 64, HALF = 128, HTB = HALF * BK * 2, NXCD = 8, WGM = 8;
DEV int lds_byte(int r, int c) { const int st = (r >> 4) * 2 + (c >> 5), rr = r & 15, cc = c & 31, ob = rr * 64 + cc * 2; return st * 1024 + (ob ^ (((ob >> 9) & 1) << 5)); }
DEV void stage_rc(int b, int& R, int& C) { const int st = b / 1024, sb = b % 1024, swz = sb ^ (((sb >> 9) & 1) << 5); R = (st >> 1) * 16 + swz / 64; C = (st & 1) * 32 + (swz % 64) / 2; }
struct Unit { int pm, pn; };
struct StaticOrder {
  int nM, nN, nwg, G, c;
  DEV void init(int M, int N, int G_, int c_) { nM = M / BM; nN = N / BM; nwg = nM * nN; G = G_; c = c_; }
  DEV bool next(int i, Unit& u) const {
    const long L = (long)i * G + c;
    if (L >= nwg) return false;
    int wgid = (int)L;
    { const int q = nwg / NXCD, r = nwg % NXCD, xcd = wgid % NXCD, off = wgid / NXCD; wgid = (xcd < r ? xcd * (q + 1) : r * (q + 1) + (xcd - r) * q) + off; }
    const int nig = WGM * nN, gid = wgid / nig, fm = gid * WGM, gsz = (nM - fm) < WGM ? (nM - fm) : WGM;
    u.pm = fm + ((wgid % nig) % gsz);
    u.pn = (wgid % nig) / gsz;
    return true;
  }
};
template <class Epi>
DEV void gemm_phase(char* smem, const u16* A, int lda, const u16* Bt, int ldb, int M, int N, int K, const Epi& E) {
  PG8_LAS unsigned char* lds = (PG8_LAS unsigned char*)smem;
  const int tid = my_tid(), wid = __builtin_amdgcn_readfirstlane(tid >> 6), lane = tid & 63, wr = wid >> 2, wc = wid & 3, fr = lane & 15, fq = lane >> 4;
  const int nt = K / BK;
  StaticOrder S;
  S.init(M, N, gridDim.x, blockIdx.x);
  unsigned voffA[2], voffB[2];
#pragma unroll
  for (int i = 0; i < 2; ++i) { int R, C; stage_rc(tid * 16 + i * 8192, R, C); voffA[i] = (unsigned)(R * lda + C) * 2u; voffB[i] = (unsigned)(R * ldb + C) * 2u; }
  const size_t kstep = (size_t)(BK * 2);
  const size_t hstepA = (size_t)HALF * lda * 2, hstepB = (size_t)HALF * ldb * 2;
  const size_t tstepA = 2 * hstepA, tstepB = 2 * hstepB;
  const unsigned ldsw = (unsigned)wid * 1024u;
  const int aoff = lds_byte(wr * 64 + fr, fq * 8), boff = lds_byte(wc * 32 + fr, fq * 8);
#define PG8_SA(b, h) (((b) * 2 + (h)) * HTB)
#define PG8_SB(b, h) ((4 + (b) * 2 + (h)) * HTB)
#define PG8_STAGE(bufoff, gbase, voff) do { _Pragma("unroll") for (int _i = 0; _i < 2; ++_i) \
        __builtin_amdgcn_global_load_lds((const unsigned*)((const char*)(gbase) + (voff)[_i]), (PG8_LAS unsigned*)(lds + (bufoff) + ldsw + _i * 8192), 16, 0, 0); } while (0)
#define PG8_LDA(dst, b, h) do { _Pragma("unroll") for (int m = 0; m < 4; ++m) _Pragma("unroll") for (int k = 0; k < 2; ++k) dst[m][k] = *(const PG8_LAS bf16x8*)(lds + PG8_SA(b, h) + aoff + m * 2048 + k * 1024); } while (0)
#define PG8_LDB(dst, b, h) do { _Pragma("unroll") for (int n = 0; n < 2; ++n) _Pragma("unroll") for (int k = 0; k < 2; ++k) dst[n][k] = *(const PG8_LAS bf16x8*)(lds + PG8_SB(b, h) + boff + n * 2048 + k * 1024); } while (0)
#define PG8_MMA(ai, bj, At, Bt_) do { __builtin_amdgcn_s_setprio(1); _Pragma("unroll") for (int m = 0; m < 4; ++m) _Pragma("unroll") for (int n = 0; n < 2; ++n) _Pragma("unroll") for (int k = 0; k < 2; ++k) \
        acc[ai][bj][m][n] = __builtin_amdgcn_mfma_f32_16x16x32_bf16(Bt_[n][k], At[m][k], acc[ai][bj][m][n], 0, 0, 0); __builtin_amdgcn_s_setprio(0); } while (0)
#define PG8_WAIT_V(n) asm volatile("s_waitcnt vmcnt(" #n ")" ::: "memory")
#define PG8_WAIT_L(n) asm volatile("s_waitcnt lgkmcnt(" #n ")" ::: "memory")
#define PG8_BAR __builtin_amdgcn_s_barrier()
#define PG8_SCHED __builtin_amdgcn_sched_barrier(0)
  Unit cur, nxt;
  int ui = 0;
  PG8_WAIT_V(0);
  __syncthreads();
  if (!S.next(0, cur)) return;
  f32x4 acc[2][2][4][2];
#pragma unroll
  for (int a = 0; a < 2; ++a)
#pragma unroll
    for (int b = 0; b < 2; ++b)
#pragma unroll
      for (int m = 0; m < 4; ++m)
#pragma unroll
        for (int n = 0; n < 2; ++n) acc[a][b][m][n] = (f32x4){0.f, 0.f, 0.f, 0.f};
  bf16x8 At[4][2], B0[2][2], B1[2][2];
  const char* cA = (const char*)A + (size_t)cur.pm * tstepA;
  const char* cB = (const char*)Bt + (size_t)cur.pn * tstepB;
  PG8_STAGE(PG8_SB(0, 0), cB, voffB); PG8_STAGE(PG8_SA(0, 0), cA, voffA); PG8_STAGE(PG8_SB(0, 1), cB + hstepB, voffB); PG8_STAGE(PG8_SA(0, 1), cA + hstepA, voffA);
  if (wr == 1) PG8_BAR;
  PG8_WAIT_V(4); PG8_BAR;
  PG8_STAGE(PG8_SB(1, 0), cB + kstep, voffB); PG8_STAGE(PG8_SA(1, 0), cA + kstep, voffA); PG8_STAGE(PG8_SB(1, 1), cB + hstepB + kstep, voffB);
  PG8_WAIT_V(6); PG8_BAR;
  for (;;) {
    const bool has_next = S.next(ui + 1, nxt);
    const char* nA = has_next ? (const char*)A + (size_t)nxt.pm * tstepA : cA;
    const char* nB = has_next ? (const char*)Bt + (size_t)nxt.pn * tstepB : cB;
    for (int t = 0; t < nt; t += 2) {
      const bool last = (t == nt - 2);
      const char* a1 = cA + (size_t)(t + 1) * kstep;
      const char* a2 = last ? nA : cA + (size_t)(t + 2) * kstep;
      const char* b2 = last ? nB : cB + (size_t)(t + 2) * kstep;
      const char* a3 = a2 + kstep;
      const char* b3 = b2 + kstep;
      PG8_LDB(B0, 0, 0); PG8_SCHED; PG8_LDA(At, 0, 0); PG8_STAGE(PG8_SA(1, 1), a1 + hstepA, voffA);
      PG8_WAIT_L(8); PG8_BAR; PG8_WAIT_L(0); PG8_MMA(0, 0, At, B0); PG8_BAR; PG8_SCHED;
      PG8_LDB(B1, 0, 1); PG8_STAGE(PG8_SB(0, 0), b2, voffB);
      PG8_BAR; PG8_WAIT_L(0); PG8_MMA(0, 1, At, B1); PG8_BAR;
      PG8_LDA(At, 0, 1); PG8_STAGE(PG8_SA(0, 0), a2, voffA);
      PG8_BAR; PG8_WAIT_L(0); PG8_MMA(1, 0, At, B0); PG8_BAR; PG8_SCHED;
      PG8_STAGE(PG8_SB(0, 1), b2 + hstepB, voffB);
      PG8_WAIT_V(6); PG8_BAR; PG8_MMA(1, 1, At, B1); PG8_BAR;
      PG8_LDB(B0, 1, 0); PG8_SCHED; PG8_LDA(At, 1, 0); PG8_STAGE(PG8_SA(0, 1), a2 + hstepA, voffA);
      PG8_WAIT_L(8); PG8_BAR; PG8_WAIT_L(0); PG8_MMA(0, 0, At, B0); PG8_BAR; PG8_SCHED;
      PG8_LDB(B1, 1, 1); PG8_STAGE(PG8_SB(1, 0), b3, voffB);
      PG8_BAR; PG8_WAIT_L(0); PG8_MMA(0, 1, At, B1); PG8_BAR;
      PG8_LDA(At, 1, 1); PG8_STAGE(PG8_SA(1, 0), a3, voffA);
      PG8_BAR; PG8_WAIT_L(0); PG8_MMA(1, 0, At, B0); PG8_BAR; PG8_SCHED;
      PG8_STAGE(PG8_SB(1, 1), b3 + hstepB, voffB);
      PG8_WAIT_V(6); PG8_BAR; PG8_MMA(1, 1, At, B1); PG8_BAR;
    }
    E(acc, cur, wr, wc, fr, fq);
    if (!has_next) break;
#pragma unroll
    for (int a = 0; a < 2; ++a)
#pragma unroll
      for (int b = 0; b < 2; ++b)
#pragma unroll
        for (int m = 0; m < 4; ++m)
#pragma unroll
          for (int n = 0; n < 2; ++n) acc[a][b][m][n] = (f32x4){0.f, 0.f, 0.f, 0.f};
    cur = nxt; cA = nA; cB = nB; ++ui;
  }
  PG8_WAIT_V(0);
  if (wr == 0) PG8_BAR;
  PG8_BAR;
#undef PG8_SA
#undef PG8_SB
#undef PG8_STAGE
#undef PG8_LDA
#undef PG8_LDB
#undef PG8_MMA
#undef PG8_WAIT_V
#undef PG8_WAIT_L
#undef PG8_BAR
#undef PG8_SCHED
}

struct EpiInProjT {
  const Params& P;
  int l;
  DEV void operator()(const f32x4 (&acc)[2][2][4][2], const Unit& u, int wr, int wc, int fr, int fq) const {
#pragma unroll
    for (int bj = 0; bj < 2; ++bj) {
      const int cg = u.pn * 256 + bj * 128 + wc * 32;
      if (cg >= 4368) continue;
#pragma unroll
      for (int ai = 0; ai < 2; ++ai)
#pragma unroll
        for (int m = 0; m < 4; ++m) {
          const int row = u.pm * 256 + ai * 128 + wr * 64 + m * 16 + fr;
          const f32x4 v0 = acc[ai][bj][m][0], v1 = acc[ai][bj][m][1];
          if (cg < C_WQ) {
            u16* dst = WS_P(P) + (size_t)row * PW + cg + 4 * fq;
            *reinterpret_cast<uint2*>(dst) = make_uint2(pack2(v0[0], v0[1]), pack2(v0[2], v0[3]));
            *reinterpret_cast<uint2*>(dst + 16) = make_uint2(pack2(v1[0], v1[1]), pack2(v1[2], v1[3]));
          } else if (cg < 3712) {
            const bool isq = (cg < C_WK) || (cg >= C_DQ && cg < C_DK);
            const float qs = isq ? 0.125f : 1.f;
            u16* dst = WS_P(P) + (size_t)row * PW + cg + 4 * fq;
            float o1[4], o2[4];
            if (row < NLAT) {
              const int t = row & (T - 1), hf = (cg >> 5) & 1;
              const float4* rt = reinterpret_cast<const float4*>(WS_ROPE(P) + ((size_t)t * 32 + hf * 16 + 4 * fq) * 2);
              const float4 c01 = rt[0], c23 = rt[1];
              const float cs[4] = {c01.x, c01.z, c23.x, c23.z}, sn[4] = {c01.y, c01.w, c23.y, c23.w};
#pragma unroll
              for (int e = 0; e < 4; ++e) { o1[e] = (v0[e] * cs[e] - v1[e] * sn[e]) * qs; o2[e] = (v1[e] * cs[e] + v0[e] * sn[e]) * qs; }
            } else {
#pragma unroll
              for (int e = 0; e < 4; ++e) { o1[e] = v0[e] * qs; o2[e] = v1[e] * qs; }
            }
            *reinterpret_cast<uint2*>(dst) = make_uint2(pack2(o1[0], o1[1]), pack2(o1[2], o1[3]));
            *reinterpret_cast<uint2*>(dst + 16) = make_uint2(pack2(o2[0], o2[1]), pack2(o2[2], o2[3]));
          } else if (cg < 4352) {
            int b, key;
            if (row < NLAT) { b = row >> 12; key = 256 + (row & (T - 1)); }
            else { b = (row - NLAT) >> 8; key = (row - NLAT) & 255; }
            u16* base;
            int v0i;
            if (cg < 3840) { base = WS_VTW(P) + ((size_t)(b * 2 + ((cg - 3712) >> 6)) * 64) * KEYS; v0i = (cg - 3712) & 63; }
            else { base = WS_VTD(P) + ((size_t)(b * 4 + ((cg - 3840) >> 7)) * 128) * KEYS; v0i = (cg - 3840) & 127; }
#pragma unroll
            for (int e = 0; e < 4; ++e) {
              base[(size_t)(v0i + 4 * fq + e) * KEYS + key] = f2bf(v0[e]);
              base[(size_t)(v0i + 16 + 4 * fq + e) * KEYS + key] = f2bf(v1[e]);
            }
          } else {
            const float4 bg = *reinterpret_cast<const float4*>(P.b_gate + l * 16 + 4 * fq);
            *reinterpret_cast<float4*>(WS_GATES(P) + (size_t)row * 16 + 4 * fq) = make_float4(v0[0] + bg.x, v0[1] + bg.y, v0[2] + bg.z, v0[3] + bg.w);
          }
        }
    }
  }
};
struct EpiResidT {
  const Params& P;
  const float* src_lat;
  const float* modl;
  int gt_off;
  DEV void operator()(const f32x4 (&acc)[2][2][4][2], const Unit& u, int wr, int wc, int fr, int fq) const {
#pragma unroll
    for (int ai = 0; ai < 2; ++ai)
#pragma unroll
      for (int m = 0; m < 4; ++m) {
        const int row = u.pm * 256 + ai * 128 + wr * 64 + m * 16 + fr;
        const float* src;
        float* dst;
        int cond;
        if (row < NLAT) { src = src_lat + (size_t)row * 1024; dst = P.out + (size_t)row * 1024; cond = row >> 12; }
        else { src = WS_XC(P) + (size_t)(row - NLAT) * 1024; dst = WS_XC(P) + (size_t)(row - NLAT) * 1024; cond = 16; }
        const float* gt = modl + (size_t)cond * 6144 + gt_off;
#pragma unroll
        for (int bj = 0; bj < 2; ++bj)
#pragma unroll
          for (int n = 0; n < 2; ++n) {
            const int col = u.pn * 256 + bj * 128 + wc * 32 + n * 16 + 4 * fq;
            const float4 s4 = *reinterpret_cast<const float4*>(src + col), g4 = *reinterpret_cast<const float4*>(gt + col);
            const f32x4 a = acc[ai][bj][m][n];
            *reinterpret_cast<float4*>(dst + col) = make_float4(s4.x + g4.x * a[0], s4.y + g4.y * a[1], s4.z + g4.z * a[2], s4.w + g4.w * a[3]);
          }
      }
  }
};
struct EpiSwigluT {
  u16* act;
  DEV void operator()(const f32x4 (&acc)[2][2][4][2], const Unit& u, int wr, int wc, int fr, int fq) const {
#pragma unroll
    for (int ai = 0; ai < 2; ++ai)
#pragma unroll
      for (int m = 0; m < 4; ++m) {
        const int row = u.pm * 256 + ai * 128 + wr * 64 + m * 16 + fr;
#pragma unroll
        for (int bj = 0; bj < 2; ++bj) {
          const int cg = u.pn * 256 + bj * 128 + wc * 32;
          const f32x4 g = acc[ai][bj][m][0], up = acc[ai][bj][m][1];
          *reinterpret_cast<uint2*>(act + (size_t)row * FH + (cg >> 1) + 4 * fq) =
              make_uint2(pack2(siluf_(g[0]) * up[0], siluf_(g[1]) * up[1]), pack2(siluf_(g[2]) * up[2], siluf_(g[3]) * up[3]));
        }
      }
  }
};
}


#ifdef SELFCHECK
#define DBGF(P) reinterpret_cast<float*>((P).ws + O_XC + (size_t)NCTXR * 1024 * 4)
DEV float blk_reduce(float v, bool ismax, float* red) {
  const int tid = my_tid(), lane = tid & 63, wid = tid >> 6;
#pragma unroll
  for (int o = 32; o > 0; o >>= 1) { float t = __shfl_xor(v, o); v = ismax ? fmaxf(v, t) : v + t; }
  __syncthreads();
  if (lane == 0) red[wid] = v;
  __syncthreads();
  float r = red[0];
  for (int i = 1; i < 8; ++i) r = ismax ? fmaxf(r, red[i]) : r + red[i];
  __syncthreads();
  return r;
}
DEV void chk_sample(int s, int& b, int& hd, int& t) {
  const int ti = s & 7;
  b = (s * 5 + 3) & 15; hd = s & 7;
  t = ti == 0 ? 0 : ti == 1 ? 63 : ti == 2 ? 64 : ti == 3 ? 127 : ti == 4 ? 2048 + 65 : ti == 5 ? 3000 : ti == 6 ? 4032 : 4095;
}
DEV void check_pre(const Params& P, int l, char* smem) {
  const int tid = my_tid();
  float* sc = reinterpret_cast<float*>(smem);
  float* red = sc + 2 * 4352;
  float* ov = red + 16;
  float* dbg = DBGF(P);
  const u16* p = WS_P(P);
  for (int it = blockIdx.x; it < 24; it += gridDim.x) {
    const bool isdiff = it >= 12;
    const int s = isdiff ? it - 12 : it;
    int b, hd, t;
    chk_sample(s, b, hd, t);
    const bool ctxq = s >= 8;
    if (ctxq) t &= 255;
    const size_t row = ctxq ? (size_t)NLAT + b * 256 + t : (size_t)b * T + t;
    __syncthreads();
    if (!isdiff) {
      const int head = hd, g = head >> 2;
      const int lo = ctxq ? 0 : max(0, t - 128), hi = ctxq ? -1 : min(T - 1, t + 128);
      const int nk = 256 + (hi - lo + 1);
      float mx = -1e30f;
      for (int k = tid; k < nk; k += NTHREADS) {
        size_t krow = k < 256 ? (size_t)NLAT + b * 256 + k : (size_t)b * T + lo + (k - 256);
        float a = 0.f;
        for (int d = 0; d < 64; ++d) a += bf2f(p[row * PW + C_WQ + head * 64 + d]) * bf2f(p[krow * PW + C_WK + g * 64 + d]);
        sc[k] = a;
        mx = fmaxf(mx, a);
      }
      mx = blk_reduce(mx, true, red);
      const float sk = P.sink[l * 8 + head];
      mx = fmaxf(mx, sk);
      float sm = 0.f;
      for (int k = tid; k < nk; k += NTHREADS) { float e = expf(sc[k] - mx); sc[k] = e; sm += e; }
      sm = blk_reduce(sm, false, red) + expf(sk - mx);
      if (tid < 64) {
        float o = 0.f;
        for (int k = 0; k < nk; ++k) {
          int kidx = k < 256 ? k : 256 + lo + (k - 256);
          o += sc[k] * bf2f(WS_VTW(P)[((size_t)(b * 2 + g) * 64 + tid) * KEYS + kidx]);
        }
        dbg[it * 128 + tid] = o / sm;
      }
    } else {
      const int h = hd & 3;
      const int nk = ctxq ? 256 : KEYS;
      float mx0 = -1e30f, mx1 = -1e30f;
      for (int k = tid; k < nk; k += NTHREADS) {
        size_t krow = k < 256 ? (size_t)NLAT + b * 256 + k : (size_t)b * T + (k - 256);
        float a0 = 0.f, a1 = 0.f;
        for (int d = 0; d < 64; ++d) {
          a0 += bf2f(p[row * PW + C_DQ + h * 128 + d]) * bf2f(p[krow * PW + C_DK + h * 128 + d]);
          a1 += bf2f(p[row * PW + C_DQ + h * 128 + 64 + d]) * bf2f(p[krow * PW + C_DK + h * 128 + 64 + d]);
        }
        sc[k] = a0; sc[4352 + k] = a1;
        mx0 = fmaxf(mx0, a0); mx1 = fmaxf(mx1, a1);
      }
      mx0 = blk_reduce(mx0, true, red);
      mx1 = blk_reduce(mx1, true, red);
      float s0 = 0.f, s1 = 0.f;
      for (int k = tid; k < nk; k += NTHREADS) {
        float e0 = expf(sc[k] - mx0), e1 = expf(sc[4352 + k] - mx1);
        sc[k] = e0; sc[4352 + k] = e1; s0 += e0; s1 += e1;
      }
      s0 = blk_reduce(s0, false, red);
      s1 = blk_reduce(s1, false, red);
      const float lam = WS_LAM(P)[l], lam_init = 0.8f - 0.6f * expf(-0.3f * (float)l);
      float y = 0.f;
      if (tid < 128) {
        for (int k = 0; k < nk; ++k)
          y += (sc[k] / s0 - lam * sc[4352 + k] / s1) * bf2f(WS_VTD(P)[((size_t)(b * 4 + h) * 128 + tid) * KEYS + k]);
        ov[tid] = y;
      }
      __syncthreads();
      if (tid < 128) {
        float ss = 0.f;
        for (int v = 0; v < 128; ++v) ss += ov[v] * ov[v];
        dbg[it * 128 + tid] = y * rsqrtf(ss / 128.f + EPS) * P.d_norm[l * 512 + h * 128 + tid] * (1.f - lam_init);
      }
    }
  }
}
DEV void check_post(const Params& P, int l, unsigned* flags) {
  const int tid = my_tid();
  const float* dbg = DBGF(P);
  const u16* p = WS_P(P);
  for (int it = blockIdx.x; it < 24; it += gridDim.x) {
    const bool isdiff = it >= 12;
    const int s = isdiff ? it - 12 : it;
    int b, hd, t;
    chk_sample(s, b, hd, t);
    const bool ctxq = s >= 8;
    if (ctxq) t &= 255;
    const size_t row = ctxq ? (size_t)NLAT + b * 256 + t : (size_t)b * T + t;
    if (ctxq && l != 0) continue;
    const int n = isdiff ? 128 : 64;
    if (tid < n) {
      float got = isdiff ? bf2f(p[row * PW + C_DQ + (hd & 3) * 128 + tid]) : bf2f(p[row * PW + C_WQ + hd * 64 + tid]);
      float ex = dbg[it * 128 + tid];
      if (!(fabsf(got - ex) <= 0.03f + 0.03f * fabsf(ex))) atomicOr(flags, isdiff ? (ctxq ? 32u : 2u) : (ctxq ? 16u : 1u));
    }
  }
}
DEV void check_mlstm(const Params& P, int l, char* smem, unsigned* flags) {
  const int tid = my_tid(), lane = tid & 63;
  float* qs = reinterpret_cast<float*>(smem);
  float* ks = qs + 128;
  float* vs = ks + 128;
  float* nn = vs + 128;
  float* sc = nn + 128;
  float* red = sc + 8;
  const u16* p = WS_P(P);
  for (int it = blockIdx.x; it < 4; it += gridDim.x) {
    const int b = (it * 7 + 2) & 15, hd = (it + 1) & 3, dir = it & 1;
    const int v = tid >> 2, kq = tid & 3;
    float C[32];
#pragma unroll
    for (int j = 0; j < 32; ++j) C[j] = 0.f;
    __syncthreads();
    if (tid < 128) nn[tid] = 0.f;
    if (tid == 0) sc[0] = 0.f;
    __syncthreads();
    const int nsteps = (l == 0) ? 256 + T : 256 + T;
    for (int st = 0; st < nsteps; ++st) {
      int seg0, seglen, u;
      if (st < 256) { seg0 = NLAT + b * 256; seglen = 256; u = dir ? 255 - st : st; }
      else { seg0 = b * T; seglen = T; u = dir ? T - 1 - (st - 256) : st - 256; }
      const size_t row = (size_t)seg0 + u;
      if (tid < 128) {
        float xq = 0.f, xk = 0.f;
        for (int tp = 0; tp < 3; ++tp) {
          int uu = u + tp - 1;
          if (uu >= 0 && uu < seglen) {
            xq += P.conv_w[(size_t)l * 3072 + tp * 1024 + hd * 128 + tid] * bf2f(p[((size_t)seg0 + uu) * PW + C_MQ + hd * 128 + tid]);
            xk += P.conv_w[(size_t)l * 3072 + tp * 1024 + 512 + hd * 128 + tid] * bf2f(p[((size_t)seg0 + uu) * PW + C_MK + hd * 128 + tid]);
          }
        }
        qs[tid] = xq / (1.f + expf(-xq));
        ks[tid] = xk / (1.f + expf(-xk)) * 0.08838834764831845f;
        vs[tid] = bf2f(p[row * PW + C_MV + hd * 128 + tid]);
      }
      if (tid == 0) {
        float ig = WS_GATES(P)[row * 16 + dir * 8 + hd], fg = WS_GATES(P)[row * 16 + dir * 8 + 4 + hd];
        float lf = fminf(fg, 0.f) - log1pf(expf(-fabsf(fg)));
        float m = sc[0], mn = fmaxf(lf + m, ig);
        sc[1] = expf(lf + m - mn);
        sc[2] = expf(ig - mn);
        sc[3] = mn;
      }
      __syncthreads();
      const float fd = sc[1], iw = sc[2], mn = sc[3];
      float pd = 0.f;
#pragma unroll
      for (int j = 0; j < 32; ++j) {
        C[j] = fd * C[j] + iw * vs[v] * ks[kq * 32 + j];
        pd += C[j] * qs[kq * 32 + j];
      }
      pd += __shfl_xor(pd, 1);
      pd += __shfl_xor(pd, 2);
      float dn = 0.f;
      if (tid < 128) { float nv = fd * nn[tid] + iw * ks[tid]; nn[tid] = nv; dn = nv * qs[tid]; }
      dn = blk_reduce(dn, false, red);
      if (tid == 0) sc[0] = mn;
      const float hval = pd / fmaxf(fabsf(dn), expf(-mn));
      float sq = (kq == 0) ? hval * hval : 0.f;
      sq = blk_reduce(sq, false, red);
      const float rms = sqrtf(sq / 128.f);
      const bool cmp = (st < 256) ? (l == 0) : true;
      if (cmp && kq == 0 && ((u & 63) == 0 || (u & 63) == 63 || (u % 97) == 0)) {
        float got = bf2f(WS_HFB(P)[(size_t)dir * MTOT * 512 + row * 512 + hd * 128 + v]);
        if (!(fabsf(got - hval) <= 0.05f * rms + 0.05f * fabsf(hval) + 1e-3f)) atomicOr(flags, dir ? 8u : 4u);
      }
    }
  }
}
#endif


#ifdef SELFCHECK
DEV void flag_if(bool bad, unsigned* flags, unsigned bit) { if (bad) atomicOr(flags, bit); }
DEV bool close_(float got, float ex, float tol) { return fabsf(got - ex) <= tol + tol * fabsf(ex); }
DEV void check_inproj(const Params& P, int l, char* smem, unsigned* flags) {
  const int tid = my_tid();
  float* red = reinterpret_cast<float*>(smem);
  float* hrow = red + 16;
  const float* modl = WS_MOD(P) + (size_t)l * 17 * 6144;
  for (int it = blockIdx.x; it < 64; it += gridDim.x) {
    const int ri = it & 7;
    const int row = ri == 0 ? 0 : ri == 1 ? 4095 : ri == 2 ? 4096 + 77 : ri == 3 ? 30000 : ri == 4 ? 65535 : ri == 5 ? NLAT : ri == 6 ? NLAT + 300 : MTOT - 1;
    const int cond = row < NLAT ? row >> 12 : 16;
    {
      int col = (it * 769 + 5) % 6144;
      float a = 0.f;
      for (int k = tid; k < 1024; k += NTHREADS) {
        float cv = cond < 16 ? P.c[cond * 1024 + k] : P.c_ctx[k];
        a += cv / (1.f + expf(-cv)) * P.w_mod[(size_t)l * 1024 * 6144 + (size_t)k * 6144 + col];
      }
      a = blk_reduce(a, false, red) + P.b_mod[l * 6144 + col];
      if (tid == 0) flag_if(!close_(modl[(size_t)cond * 6144 + col], a, 2e-3f), flags, 1u);
    }
    const float* xs = row < NLAT ? ((l == 0 ? P.x : P.out) + (size_t)row * 1024) : (WS_XC(P) + (size_t)(row - NLAT) * 1024);
    float ss = 0.f;
    for (int k = tid; k < 1024; k += NTHREADS) ss += xs[k] * xs[k];
    ss = blk_reduce(ss, false, red);
    const float rstd = rsqrtf(ss / 1024.f + EPS);
    for (int k = tid; k < 1024; k += NTHREADS) {
      float y = xs[k] * rstd * P.g_mix[l * 1024 + k] * (1.f + modl[(size_t)cond * 6144 + 1024 + k]) + modl[(size_t)cond * 6144 + k];
      hrow[k] = y;
      flag_if(!close_(bf2f(WS_H(P)[(size_t)row * 1024 + k]), y, 1e-2f), flags, 2u);
    }
    __syncthreads();
    const int oi = it >> 3;
    const int oj = (oi * 2 + (it & 1)) & 15;
    const int oc = oj == 0 ? 3 : oj == 1 ? 600 : oj == 2 ? 1100 : oj == 3 ? 1999 : oj == 4 ? 2050 : oj == 5 ? 2064 + 70 : oj == 6 ? 2576 + 100 :
                   oj == 7 ? 2704 + 5 : oj == 8 ? 2832 + 200 : oj == 9 ? 2832 + 37 : oj == 10 ? 3344 + 90 : oj == 11 ? 3344 + 300 :
                   oj == 12 ? 3856 + 10 : oj == 13 ? 3856 + 500 : oj == 14 ? 2048 + 15 : 2064 + 500;
    auto dotcol = [&](int c) {
      float a = 0.f;
      for (int k = tid; k < 1024; k += NTHREADS) a += hrow[k] * P.w_in[(size_t)l * 1024 * INW + (size_t)k * INW + c];
      return blk_reduce(a, false, red);
    };
    float val = dotcol(oc);
    const u16* p = WS_P(P);
    const bool lat = row < NLAT;
    const int t = row & (T - 1);
    float got = 0.f, ex = val;
    unsigned bit = 4u;
    if (oc < 2048) { got = bf2f(p[(size_t)row * PW + oc]); }
    else if (oc < 2064) { got = WS_GATES(P)[(size_t)row * 16 + oc - 2048]; ex = val + P.b_gate[l * 16 + oc - 2048]; }
    else if (oc >= 2704 && oc < 2832) {
      int cgi = oc - 2704, g = cgi >> 6, vd = cgi & 63;
      int b = lat ? row >> 12 : (row - NLAT) >> 8, key = lat ? 256 + t : (row - NLAT) & 255;
      got = bf2f(WS_VTW(P)[((size_t)(b * 2 + g) * 64 + vd) * KEYS + key]);
      bit = 8u;
    } else if (oc >= 3856) {
      int cgi = oc - 3856, h = cgi >> 7, vd = cgi & 127;
      int b = lat ? row >> 12 : (row - NLAT) >> 8, key = lat ? 256 + t : (row - NLAT) & 255;
      got = bf2f(WS_VTD(P)[((size_t)(b * 4 + h) * 128 + vd) * KEYS + key]);
      bit = 8u;
    } else {
      int base, nb0;
      bool isq;
      if (oc < 2576) { base = 2064; nb0 = C_WQ; isq = true; }
      else if (oc < 2704) { base = 2576; nb0 = C_WK; isq = false; }
      else if (oc < 3344) { base = 2832; nb0 = C_DQ; isq = true; }
      else { base = 3344; nb0 = C_DK; isq = false; }
      int rel = oc - base, dd = rel & 63, j = dd & 15, second = (dd >> 4) & 1, axis = dd >> 5;
      float other = dotcol(second ? oc - 16 : oc + 16);
      if (lat) {
        int pos = axis ? (t & 63) : (t >> 6);
        float ang = (float)pos * powf(10000.f, -(float)j / 16.f);
        float cs = cosf(ang), sn = sinf(ang);
        ex = second ? (val * cs + other * sn) : (val * cs - other * sn);
      }
      if (isq) ex *= 0.125f;
      got = bf2f(p[(size_t)row * PW + nb0 + rel]);
      bit = 16u;
    }
    if (tid == 0) flag_if(!close_(got, ex, 3e-2f), flags, bit);
    __syncthreads();
  }
}
DEV void check_post6(const Params& P, int l, char* smem, unsigned* flags, const float* xprev) {
  const int tid = my_tid();
  float* red = reinterpret_cast<float*>(smem);
  const u16* Yp = WS_P(P);
  const float* modl = WS_MOD(P) + (size_t)l * 17 * 6144;
  for (int it = blockIdx.x; it < 16; it += gridDim.x) {
    const int ri = it & 7;
    const int row = ri == 0 ? 1 : ri == 1 ? 4097 : ri == 2 ? 12345 : ri == 3 ? 40000 : ri == 4 ? 65534 : ri == 5 ? NLAT + 1 : ri == 6 ? NLAT + 2000 : MTOT - 2;
    if (row >= NLAT && l != 0) continue;
    const int col = (it * 331 + 17) & 1023;
    const int cond = row < NLAT ? row >> 12 : 16;
    float mg = 0.f;
    for (int i = 0; i < 3; ++i) {
      float a = 0.f, z = 0.f;
      for (int k = tid; k < 1024; k += NTHREADS) a += bf2f(WS_H(P)[(size_t)row * 1024 + k]) * P.w_in[(size_t)l * 1024 * INW + (size_t)k * INW + 4368 + i * 1024 + col];
      a = blk_reduce(a, false, red);
      const int yc = i == 0 ? C_MO : (i == 1 ? C_WQ : C_DQ);
      for (int k = tid; k < 512; k += NTHREADS) z += bf2f(Yp[(size_t)row * PW + yc + k]) * P.w_branch[((size_t)l * 3 + i) * 512 * 1024 + (size_t)k * 1024 + col];
      z = blk_reduce(z, false, red);
      mg += z / (1.f + expf(-a));
    }
    if (tid == 0) flag_if(!close_(bf2f(WS_HFB(P)[(size_t)row * 1024 + col]), mg, 3e-2f), flags, 1u);
    float o = 0.f;
    for (int k = tid; k < 1024; k += NTHREADS) o += bf2f(WS_HFB(P)[(size_t)row * 1024 + k]) * P.w_out[(size_t)l * 1024 * 1024 + (size_t)k * 1024 + col];
    o = blk_reduce(o, false, red);
    const float xo = row < NLAT ? xprev[(size_t)row * 1024 + col] : -1e9f;
    const float xn = row < NLAT ? P.out[(size_t)row * 1024 + col] : WS_XC(P)[(size_t)(row - NLAT) * 1024 + col];
    if (tid == 0 && row < NLAT && (l == 0)) flag_if(!close_(xn, xo + modl[(size_t)cond * 6144 + 2048 + col] * o, 2e-2f), flags, 2u);
    if (tid == 0) DBGF(P)[4096 + it] = xn;
  }
}
DEV void check_post9(const Params& P, int l, char* smem, unsigned* flags) {
  const int tid = my_tid();
  float* red = reinterpret_cast<float*>(smem);
  const float* modl = WS_MOD(P) + (size_t)l * 17 * 6144;
  for (int it = blockIdx.x; it < 16; it += gridDim.x) {
    const int ri = it & 7;
    const int row = ri == 0 ? 1 : ri == 1 ? 4097 : ri == 2 ? 12345 : ri == 3 ? 40000 : ri == 4 ? 65534 : ri == 5 ? NLAT + 1 : ri == 6 ? NLAT + 2000 : MTOT - 2;
    if (row >= NLAT && l != 0) continue;
    const int col = (it * 331 + 17) & 1023;
    const int cond = row < NLAT ? row >> 12 : 16;
    const int j = (it * 97 + 13) % FH;
    float g = 0.f, u = 0.f;
    for (int k = tid; k < 1024; k += NTHREADS) {
      float hv = bf2f(WS_H(P)[(size_t)row * 1024 + k]);
      g += hv * P.w_ffn_in[(size_t)l * 1024 * 5632 + (size_t)k * 5632 + j];
      u += hv * P.w_ffn_in[(size_t)l * 1024 * 5632 + (size_t)k * 5632 + FH + j];
    }
    g = blk_reduce(g, false, red);
    u = blk_reduce(u, false, red);
    if (tid == 0) flag_if(!close_(bf2f(WS_P(P)[(size_t)row * FH + j]), g / (1.f + expf(-g)) * u, 3e-2f), flags, 4u);
    float o = 0.f;
    for (int k = tid; k < FH; k += NTHREADS) o += bf2f(WS_P(P)[(size_t)row * FH + k]) * P.w_ffn_out[(size_t)l * FH * 1024 + (size_t)k * 1024 + col];
    o = blk_reduce(o, false, red);
    const float xn = row < NLAT ? P.out[(size_t)row * 1024 + col] : WS_XC(P)[(size_t)(row - NLAT) * 1024 + col];
    if (tid == 0) flag_if(!close_(xn, DBGF(P)[4096 + it] + modl[(size_t)cond * 6144 + 5120 + col] * o, 2e-2f), flags, 8u);
  }
}
#endif

#ifdef DEBUG_STAGE
DEV void debug_dump(const Params& P, int stage) {
  const int tid = my_tid();
  for (size_t idx = (size_t)blockIdx.x * NTHREADS + tid; idx < (size_t)NLAT * 1024; idx += (size_t)gridDim.x * NTHREADS) {
    size_t row = idx >> 10;
    int c = (int)(idx & 1023);
    size_t r2 = row + (row < 4096 ? NLAT : 0);
    float v = 0.f;
    const u16* p = WS_P(P);
    if (stage == 1) {
      v = bf2f(p[row * PW + c]) + bf2f(p[row * PW + 1024 + c]) + bf2f(p[row * PW + 2048 + c]) + (c < 640 ? bf2f(p[row * PW + 3072 + c]) : 0.f);
      v += bf2f(p[r2 * PW + c]) + bf2f(p[r2 * PW + 1024 + c]) + bf2f(p[r2 * PW + 2048 + c]);
      v += bf2f(WS_VTD(P)[r2 * 512 + (c & 511)]) + bf2f(WS_VTW(P)[r2 * 128 + (c & 127)]) + WS_GATES(P)[r2 * 16 + (c & 15)];
      v += bf2f(WS_VTD(P)[row * 512 + (c & 511)]) + bf2f(WS_VTW(P)[row * 128 + (c & 127)]) + WS_GATES(P)[row * 16 + (c & 15)];
    } else if (stage == 21) {
      v = bf2f(WS_HFB(P)[row * 512 + (c & 511)]) + 2.f * bf2f(WS_HFB(P)[(size_t)MTOT * 512 + row * 512 + (c & 511)]);
      v += bf2f(WS_HFB(P)[r2 * 512 + (c & 511)]) + 2.f * bf2f(WS_HFB(P)[(size_t)MTOT * 512 + r2 * 512 + (c & 511)]);
    } else if (stage == 22) {
      v = bf2f(p[row * PW + C_WQ + (c & 511)]) + bf2f(p[r2 * PW + C_WQ + (c & 511)]);
    } else if (stage == 23) {
      v = bf2f(p[row * PW + C_DQ + (c & 511)]) + bf2f(p[r2 * PW + C_DQ + (c & 511)]);
    } else if (stage == 3) {
      v = bf2f(WS_HFB(P)[row * 1024 + c]) + bf2f(WS_HFB(P)[r2 * 1024 + c]);
    } else if (stage == 4) {
      v = P.out[idx] + WS_XC(P)[(row & 4095) * 1024 + c];
    } else if (stage == 5) {
      v = bf2f(WS_H(P)[row * 1024 + c]) + bf2f(WS_H(P)[r2 * 1024 + c]);
    } else if (stage == 6) {
      v = bf2f(p[row * FH + c]) + bf2f(p[row * FH + 1024 + c]) + bf2f(p[r2 * FH + 1792 + c]);
    }
    if (stage != 4) P.out[idx] = v; else P.out[idx] = v;
  }
}
#define DBG(st) if (l == 0 && DEBUG_STAGE == st) { GSYNC_ONLY(); debug_dump(P, st); return true; }
#else
#define DBG(st)
#endif
template <int l>
DEV bool layer_body(const Params& P, unsigned* bar, unsigned& epoch, char* smem) {
  constexpr bool need_ctx = (l == 0);
  const float* modl = WS_MOD(P) + (size_t)l * 17 * 6144;
  const u16* Wl = WS_W(P) + (size_t)l * W_LAYER;
  const float* xlat = l == 0 ? P.x : P.out;
  constexpr int Mtok = need_ctx ? MTOT : NLAT;
  phase_norm_mod(P, xlat, WS_XC(P), MTOT, P.g_mix + l * 1024, modl, 0, 1024);
  GSYNC();
  pg8::gemm_phase(smem, WS_H(P), 1024, Wl + W_IN, 1024, MTOT, NIN, 1024, pg8::EpiInProjT{P, l});
#ifdef REPEAT_GEMMS
  if (l == 1) pg8::gemm_phase(smem, WS_H(P), 1024, Wl + W_IN, 1024, MTOT, NIN, 1024, pg8::EpiInProjT{P, l});
#endif
  GSYNC();
  DBG(1)
#ifdef SELFCHECK
#if SELFCHECK == 2
  check_inproj(P, l, smem, WS_CTR(P) + 16 + l * 3);
#else
  check_pre(P, l, smem);
#endif
  GSYNC();
#endif
  phase_mixers(P, l, smem);
  GSYNC();
#if defined(SELFCHECK) && SELFCHECK == 1
  check_post(P, l, WS_CTR(P) + 17 + l * 3);
  check_mlstm(P, l, smem, WS_CTR(P) + 17 + l * 3);
  GSYNC();
#endif
  DBG(21)
  DBG(22)
  DBG(23)
  phase_ya(P, l, Mtok);
  GSYNC();
  phase_merge(P, l, Mtok, smem);
#ifdef REPEAT_GEMMS
  if (l == 1) phase_merge(P, l, Mtok, smem);
#endif
  GSYNC();
  DBG(3)
  pg8::gemm_phase(smem, WS_HFB(P), 1024, Wl + W_O, 1024, Mtok, 1024, 1024, pg8::EpiResidT{P, xlat, modl, 2048});
  GSYNC();
#if defined(SELFCHECK) && SELFCHECK == 2
  check_post6(P, l, smem, WS_CTR(P) + 18 + l * 3, xlat);
  GSYNC();
#endif
  DBG(4)
  phase_norm_mod(P, P.out, WS_XC(P), Mtok, P.g_ffn + l * 1024, modl, 3072, 4096);
  GSYNC();
  DBG(5)
  pg8::gemm_phase(smem, WS_H(P), 1024, Wl + W_FI, 1024, Mtok, 5632, 1024, pg8::EpiSwigluT{WS_P(P)});
#ifdef REPEAT_GEMMS
  if (l == 1) pg8::gemm_phase(smem, WS_H(P), 1024, Wl + W_FI, 1024, Mtok, 5632, 1024, pg8::EpiSwigluT{WS_P(P)});
#endif
  GSYNC();
  DBG(6)
  pg8::gemm_phase(smem, WS_P(P), FH, Wl + W_FO, FH, Mtok, 1024, FH, pg8::EpiResidT{P, P.out, modl, 5120});
  GSYNC();
#if defined(SELFCHECK) && SELFCHECK == 2
  check_post9(P, l, smem, WS_CTR(P) + 18 + l * 3);
  GSYNC();
#endif
  return false;
}

__global__ void __launch_bounds__(NTHREADS) fwd_megakernel(Params P) {
  extern __shared__ __attribute__((aligned(16))) char smem[];
  cg::grid_group grid = cg::this_grid();
  unsigned* bar = WS_CTR(P) + 64;
  unsigned epoch = 0;
  grid.sync();
  phase_prologue(P, smem);
  GSYNC();
  if (layer_body<0>(P, bar, epoch, smem)) return;
  if (layer_body<1>(P, bar, epoch, smem)) return;
  phase_final_norm(P);
#ifdef SELFCHECK
  GSYNC();
  if (blockIdx.x == 0 && my_tid() == 0) {
    float scale = 1000.f;
    for (int w = 0; w < 6; ++w) {
      unsigned f = WS_CTR(P)[16 + w];
      if (f) { P.out[0] = (10.f + (float)f) * scale; break; }
      scale *= 10.f;
    }
  }
#endif
}

extern "C" void kernel_launch(void* const* d_in, const int* in_sizes, int n_in, void* d_out, int out_size, void* d_ws,
                              size_t ws_size, hipStream_t stream) {
  static int grid_blocks = 0;
  if (!grid_blocks) {
    int dev = 0, cus = 0, per_cu = 0;
    hipGetDevice(&dev);
    hipDeviceGetAttribute(&cus, hipDeviceAttributeMultiprocessorCount, dev);
    hipFuncSetAttribute((const void*)fwd_megakernel, hipFuncAttributeMaxDynamicSharedMemorySize, LDS_BYTES);
    hipOccupancyMaxActiveBlocksPerMultiprocessor(&per_cu, fwd_megakernel, NTHREADS, LDS_BYTES);
    if (per_cu < 1) per_cu = 1;
    if (per_cu > 1) per_cu = 1;
    grid_blocks = cus * per_cu;
  }
  Params P{};
  const float* const* in = reinterpret_cast<const float* const*>(d_in);
  P.x = in[0]; P.c = in[1]; P.ctx = in[2]; P.c_ctx = in[3]; P.w_mod = in[4]; P.b_mod = in[5]; P.g_mix = in[6];
  P.g_ffn = in[7]; P.w_in = in[8]; P.b_gate = in[9]; P.conv_w = in[10]; P.m_norm = in[11]; P.sink = in[12];
  P.lam_q1 = in[13]; P.lam_k1 = in[14]; P.lam_q2 = in[15]; P.lam_k2 = in[16]; P.d_norm = in[17]; P.w_branch = in[18];
  P.w_out = in[19]; P.w_ffn_in = in[20]; P.w_ffn_out = in[21]; P.g_final = in[22];
  P.out = reinterpret_cast<float*>(d_out);
  P.ws = reinterpret_cast<char*>(d_ws);
  if (WS_TOTAL > ws_size) fprintf(stderr, "workspace too small: need %zu have %zu\n", (size_t)WS_TOTAL, ws_size);
  hipMemsetAsync(P.ws + O_CTR, 0, 2048, stream);
  void* args[] = {&P};
  hipError_t e = hipLaunchCooperativeKernel((const void*)fwd_megakernel, dim3(grid_blocks), dim3(NTHREADS), args, LDS_BYTES, stream);
  if (e != hipSuccess) fprintf(stderr, "cooperative launch failed: %s (grid %d)\n", hipGetErrorString(e), grid_blocks);
}
```

```cpp
#include <hip/hip_runtime.h>
#include <hip/hip_cooperative_groups.h>
#include <cstdio>
#include <cstdint>
namespace cg = cooperative_groups;

typedef unsigned short u16;
using bf16x8 = __attribute__((ext_vector_type(8))) short;
using f32x4 = __attribute__((ext_vector_type(4))) float;
using f32x16 = __attribute__((ext_vector_type(16))) float;

#define DEV __device__ __forceinline__

constexpr int D = 1024, NB = 16, T = 4096, TC = 256;
constexpr int NLAT = NB * T;
constexpr int NCTXR = NB * TC;
constexpr int MTOT = NLAT + NCTXR;
constexpr int KEYS = T + TC;
constexpr int INW = 7440;
constexpr int PW = 3712;
constexpr int C_MQ = 0, C_MK = 512, C_MV = 1024, C_MO = 1536, C_WQ = 2048, C_WK = 2560, C_DQ = 2688, C_DK = 3200;
constexpr int NIN = 4608;
constexpr int FH = 2816;
constexpr float EPS = 1e-6f;
constexpr float L2E = 1.4426950408889634f;
constexpr int NTHREADS = 512;
constexpr int LDS_BYTES = 147456;

constexpr size_t W_IN = 0;
constexpr size_t W_G = W_IN + (size_t)NIN * 1024;
constexpr size_t W_B = W_G + (size_t)3072 * 1024;
constexpr size_t W_O = W_B + (size_t)3 * 1024 * 512;
constexpr size_t W_FI = W_O + (size_t)1024 * 1024;
constexpr size_t W_FO = W_FI + (size_t)5632 * 1024;
constexpr size_t W_LAYER = W_FO + (size_t)1024 * FH;

struct Params {
  const float *x, *c, *ctx, *c_ctx, *w_mod, *b_mod, *g_mix, *g_ffn, *w_in, *b_gate, *conv_w, *m_norm, *sink;
  const float *lam_q1, *lam_k1, *lam_q2, *lam_k2, *d_norm, *w_branch, *w_out, *w_ffn_in, *w_ffn_out, *g_final;
  float* out;
  char* ws;
};


constexpr size_t al256(size_t x) { return (x + 255) & ~(size_t)255; }
constexpr size_t O_W = 0;
constexpr size_t O_MOD = O_W + al256(2 * W_LAYER * 2);
constexpr size_t O_ROPE = O_MOD + al256((size_t)2 * 17 * 6144 * 4);
constexpr size_t O_LAM = O_ROPE + al256((size_t)T * 32 * 2 * 4);
constexpr size_t O_CTR = O_LAM + 256;
constexpr size_t O_GATES = O_CTR + 2048;
constexpr size_t O_H = O_GATES + al256((size_t)MTOT * 16 * 4);
constexpr size_t O_P = O_H + al256((size_t)MTOT * 1024 * 2);
constexpr size_t O_VTW = O_P + al256((size_t)MTOT * PW * 2);
constexpr size_t O_VTD = O_VTW + al256((size_t)NB * 2 * 64 * KEYS * 2);
constexpr size_t O_HFB = O_VTD + al256((size_t)NB * 4 * 128 * KEYS * 2);
constexpr size_t O_XC = O_HFB + al256((size_t)2 * MTOT * 512 * 2);
constexpr size_t WS_TOTAL = O_XC + al256((size_t)NCTXR * 1024 * 4) + 65536;
#define WS_W(P) reinterpret_cast<u16*>((P).ws + O_W)
#define WS_MOD(P) reinterpret_cast<float*>((P).ws + O_MOD)
#define WS_ROPE(P) reinterpret_cast<float*>((P).ws + O_ROPE)
#define WS_LAM(P) reinterpret_cast<float*>((P).ws + O_LAM)
#define WS_CTR(P) reinterpret_cast<unsigned*>((P).ws + O_CTR)
#define WS_GATES(P) reinterpret_cast<float*>((P).ws + O_GATES)
#define WS_H(P) reinterpret_cast<u16*>((P).ws + O_H)
#define WS_P(P) reinterpret_cast<u16*>((P).ws + O_P)
#define WS_VTW(P) reinterpret_cast<u16*>((P).ws + O_VTW)
#define WS_VTD(P) reinterpret_cast<u16*>((P).ws + O_VTD)
#define WS_HFB(P) reinterpret_cast<u16*>((P).ws + O_HFB)
#define WS_XC(P) reinterpret_cast<float*>((P).ws + O_XC)

DEV int my_tid() {
  int t = threadIdx.x;
  asm volatile("" : "+v"(t));
  return t;
}
typedef __bf16 bf2_t __attribute__((ext_vector_type(2)));
typedef float f2_t __attribute__((ext_vector_type(2)));
DEV uint32_t pack2(float a, float b) {
  f2_t v = {a, b};
  bf2_t r = __builtin_convertvector(v, bf2_t);
  return *reinterpret_cast<uint32_t*>(&r);
}
DEV u16 f2bf(float f) { return (u16)(pack2(f, 0.f) & 0xffffu); }
DEV float bf2f(u16 h) { return __uint_as_float(((uint32_t)h) << 16); }
DEV float bflo(uint32_t v) { return __uint_as_float(v << 16); }
DEV float bfhi(uint32_t v) { return __uint_as_float(v & 0xffff0000u); }
DEV float fexp2(float x) { return __builtin_amdgcn_exp2f(x); }
DEV float sigmoidf_(float x) { return 1.f / (1.f + __expf(-x)); }
DEV float siluf_(float x) { return x / (1.f + __expf(-x)); }
DEV float wave_sum(float v) {
#pragma unroll
  for (int o = 32; o > 0; o >>= 1) v += __shfl_xor(v, o);
  return v;
}
DEV bf16x8 ld16(const void* p) { return *reinterpret_cast<const bf16x8*>(p); }
DEV bf16x8 mk8(uint32_t a, uint32_t b, uint32_t c, uint32_t d) {
  uint4 u = make_uint4(a, b, c, d);
  return *reinterpret_cast<bf16x8*>(&u);
}
DEV f32x16 mfma32(bf16x8 a, bf16x8 b, f32x16 c) { return __builtin_amdgcn_mfma_f32_32x32x16_bf16(a, b, c, 0, 0, 0); }
DEV f32x4 mfma16(bf16x8 a, bf16x8 b, f32x4 c) { return __builtin_amdgcn_mfma_f32_16x16x32_bf16(a, b, c, 0, 0, 0); }
DEV int pi32(int r) { return (r & ~12) | ((r & 4) << 1) | ((r & 8) >> 1); }


DEV void grid_barrier(unsigned* bar, unsigned& epoch) {
  asm volatile("s_waitcnt vmcnt(0)" ::: "memory");
  __syncthreads();
  epoch += 1;
  if (my_tid() == 0) {
    __builtin_amdgcn_fence(__ATOMIC_RELEASE, "agent");
    unsigned* loc = bar + 32 + (blockIdx.x & 7) * 32;
    const unsigned per = gridDim.x >> 3;
    unsigned old = __hip_atomic_fetch_add(loc, 1u, __ATOMIC_RELAXED, __HIP_MEMORY_SCOPE_AGENT);
    if (old + 1 == per * epoch) __hip_atomic_fetch_add(bar, 1u, __ATOMIC_RELAXED, __HIP_MEMORY_SCOPE_AGENT);
    while (__hip_atomic_load(bar, __ATOMIC_RELAXED, __HIP_MEMORY_SCOPE_AGENT) < 8u * epoch) __builtin_amdgcn_s_sleep(1);
    __builtin_amdgcn_fence(__ATOMIC_ACQUIRE, "agent");
  }
  __syncthreads();
}
#define GSYNC() grid_barrier(bar, epoch)
#define GSYNC_ONLY()

template <int N>
DEV void wait_vm() { asm volatile("s_waitcnt vmcnt(%0)" ::"n"(N) : "memory"); }

template <int MI, int NI>
DEV void gemm_mainloop(const u16* __restrict__ A, int lda, const u16* __restrict__ Bt, int ldb, int K,
                       f32x4 (&acc)[MI][NI], char* smem) {
  constexpr int BM = 32 * MI, BN = 64 * NI;
  constexpr int NA = BM * 4 / NTHREADS, NBL = BN * 4 / NTHREADS;
  constexpr int ABYTES = BM * 64, BBYTES = BN * 64, SBYTES = ABYTES + BBYTES;
  constexpr int NL = NA + NBL;
  const int tid = my_tid(), lane = tid & 63, wid = tid >> 6, wr = wid >> 2, wc = wid & 3, fr = lane & 15, fq = lane >> 4;
  const int nk = K / 32;
  auto stage = [&](int kt) {
    char* base = smem + (kt & 3) * SBYTES;
#pragma unroll
    for (int i = 0; i < NA; ++i) {
      int id = tid + i * NTHREADS, r = id >> 2, c = (id & 3) ^ (((r >> 3) & 1) * 3);
      __builtin_amdgcn_global_load_lds((const unsigned*)(A + (size_t)r * lda + kt * 32 + c * 8), (unsigned*)(base + id * 16), 16, 0, 0);
    }
#pragma unroll
    for (int i = 0; i < NBL; ++i) {
      int id = tid + i * NTHREADS, r = id >> 2, c = (id & 3) ^ (((r >> 3) & 1) * 3);
      __builtin_amdgcn_global_load_lds((const unsigned*)(Bt + (size_t)r * ldb + kt * 32 + c * 8), (unsigned*)(base + ABYTES + id * 16), 16, 0, 0);
    }
  };
  wait_vm<0>();
  __syncthreads();
  stage(0);
  if (nk > 1) stage(1);
  if (nk > 2) stage(2);
  for (int kt = 0; kt < nk; ++kt) {
    if (kt + 2 < nk) wait_vm<2 * NL>();
    else if (kt + 1 < nk) wait_vm<NL>();
    else wait_vm<0>();
    asm volatile("" ::: "memory");
    __builtin_amdgcn_s_barrier();
    asm volatile("" ::: "memory");
    const char* As = smem + (kt & 3) * SBYTES;
    const char* Bs = As + ABYTES;
    bf16x8 bfr[NI], af[MI];
#pragma unroll
    for (int ni = 0; ni < NI; ++ni) {
      int r = wc * (NI * 16) + ni * 16 + fr;
      bfr[ni] = ld16(Bs + r * 64 + ((fq ^ (((r >> 3) & 1) * 3)) << 4));
    }
#pragma unroll
    for (int mi = 0; mi < MI; ++mi) {
      int r = wr * (MI * 16) + mi * 16 + fr;
      af[mi] = ld16(As + r * 64 + ((fq ^ (((r >> 3) & 1) * 3)) << 4));
    }
    if (kt + 3 < nk) stage(kt + 3);
    __builtin_amdgcn_sched_barrier(0);
    __builtin_amdgcn_s_setprio(1);
#pragma unroll
    for (int mi = 0; mi < MI; ++mi)
#pragma unroll
      for (int ni = 0; ni < NI; ++ni) acc[mi][ni] = mfma16(af[mi], bfr[ni], acc[mi][ni]);
    __builtin_amdgcn_s_setprio(0);
    __builtin_amdgcn_sched_barrier(0);
  }
}


DEV void gemm_mainloop64(const u16* __restrict__ A, int lda, const u16* __restrict__ Bt, int ldb, int K, f32x4 (&acc)[4][4], char* smem) {
  constexpr int ABYTES = 128 * 128, BBYTES = 256 * 128, SBYTES = ABYTES + BBYTES;
  constexpr int NA = 2, NBL = 4, NL = NA + NBL;
  const int tid = my_tid(), lane = tid & 63, wid = tid >> 6, wr = wid >> 2, wc = wid & 3, fr = lane & 15, fq = lane >> 4;
  const int nk = K / 64;
  auto stage = [&](int kt) {
    char* base = smem + (kt % 3) * SBYTES;
#pragma unroll
    for (int i = 0; i < NA; ++i) {
      int id = tid + i * NTHREADS, r = id >> 3, c = (id & 7) ^ ((r >> 1) & 7);
      __builtin_amdgcn_global_load_lds((const unsigned*)(A + (size_t)r * lda + kt * 64 + c * 8), (unsigned*)(base + id * 16), 16, 0, 0);
    }
#pragma unroll
    for (int i = 0; i < NBL; ++i) {
      int id = tid + i * NTHREADS, r = id >> 3, c = (id & 7) ^ ((r >> 1) & 7);
      __builtin_amdgcn_global_load_lds((const unsigned*)(Bt + (size_t)r * ldb + kt * 64 + c * 8), (unsigned*)(base + ABYTES + id * 16), 16, 0, 0);
    }
  };
  wait_vm<0>();
  __syncthreads();
  stage(0);
  if (nk > 1) stage(1);
  for (int kt = 0; kt < nk; ++kt) {
    if (kt + 1 < nk) wait_vm<NL>();
    else wait_vm<0>();
    asm volatile("" ::: "memory");
    __builtin_amdgcn_s_barrier();
    asm volatile("" ::: "memory");
    if (kt + 2 < nk) stage(kt + 2);
    const char* As = smem + (kt % 3) * SBYTES;
    const char* Bs = As + ABYTES;
#pragma unroll
    for (int ks = 0; ks < 2; ++ks) {
      bf16x8 bfr[4], af[4];
#pragma unroll
      for (int ni = 0; ni < 4; ++ni) {
        int r = wc * 64 + ni * 16 + fr;
        bfr[ni] = ld16(Bs + r * 128 + (((ks * 4 + fq) ^ ((r >> 1) & 7)) << 4));
      }
#pragma unroll
      for (int mi = 0; mi < 4; ++mi) {
        int r = wr * 64 + mi * 16 + fr;
        af[mi] = ld16(As + r * 128 + (((ks * 4 + fq) ^ ((r >> 1) & 7)) << 4));
      }
#pragma unroll
      for (int mi = 0; mi < 4; ++mi)
#pragma unroll
        for (int ni = 0; ni < 4; ++ni) acc[mi][ni] = mfma16(af[mi], bfr[ni], acc[mi][ni]);
      __builtin_amdgcn_sched_barrier(0);
    }
  }
}

template <int MI, int NI>
DEV void zero_acc(f32x4 (&acc)[MI][NI]) {
#pragma unroll
  for (int mi = 0; mi < MI; ++mi)
#pragma unroll
    for (int ni = 0; ni < NI; ++ni) acc[mi][ni] = f32x4{0.f, 0.f, 0.f, 0.f};
}


DEV void tile_coords(int tile, int total, int nN, int& tm, int& tn) {
  int t = tile;
  if (gridDim.x == 256 && tile < (total & ~255)) {
    int j = tile & 255;
    t = (tile & ~255) + (j & 7) * 32 + (j >> 3);
  }
  int p = t / (4 * nN), q = t - p * (4 * nN);
  tn = q >> 2;
  tm = p * 4 + (q & 3);
}

template <int MI, class Epi>
DEV void gemm_phase(const u16* A, int lda, const u16* Bt, int ldb, int M, int N, int K, Epi epi, char* smem) {
  constexpr int BM = 32 * MI;
  const int nM = M / BM, nN = N / 256;
  const int wid = my_tid() >> 6, wr = wid >> 2, wc = wid & 3;
  for (int tile = blockIdx.x; tile < nM * nN; tile += gridDim.x) {
    int tm, tn;
    tile_coords(tile, nM * nN, nN, tm, tn);
    f32x4 acc[MI][4];
    zero_acc<MI, 4>(acc);
    gemm_mainloop<MI, 4>(A + (size_t)tm * BM * lda, lda, Bt + (size_t)tn * 256 * ldb, ldb, K, acc, smem);
    epi(acc, tm * BM + wr * (MI * 16), tn * 256 + wc * 64);
  }
}

DEV int map_col(int type, int n) {
  if (type == 0) {
    if (n < 2048) return n;
    if (n < 2688) return n + 16;
    if (n < 3712) return n + 144;
    if (n < 3840) return n - 1008;
    if (n < 4352) return n + 16;
    if (n < 4368) return n - 2304;
    return -1;
  }
  if (type == 1) return n + 4368;
  if (type == 2) return n;
  int q = n >> 5, r = n & 31;
  return r < 16 ? (q * 16 + r) : (FH + q * 16 + r - 16);
}

DEV void tr_tile(const float* __restrict__ src, int ldsrc, u16* __restrict__ dst, int K, int n0, int k0, int type, char* smem) {
  float* tile = reinterpret_cast<float*>(smem);
  const int tid = my_tid();
  {
    int n = tid & 63, sc = map_col(type, n0 + n);
#pragma unroll
    for (int i = 0; i < 8; ++i) {
      int k = (tid >> 6) + 8 * i;
      tile[k * 65 + n] = sc >= 0 ? src[(size_t)(k0 + k) * ldsrc + sc] : 0.f;
    }
  }
  __syncthreads();
  {
    int n = tid >> 3, kc = tid & 7;
    uint32_t w[4];
#pragma unroll
    for (int j = 0; j < 4; ++j) w[j] = pack2(tile[(kc * 8 + 2 * j) * 65 + n], tile[(kc * 8 + 2 * j + 1) * 65 + n]);
    *reinterpret_cast<uint4*>(dst + (size_t)(n0 + n) * K + k0 + kc * 8) = make_uint4(w[0], w[1], w[2], w[3]);
  }
  __syncthreads();
}

DEV void phase_prologue(const Params& P, char* smem) {
  const int tid = my_tid();
  constexpr int TPL = 4672;
  for (int it = blockIdx.x; it < 2 * TPL; it += gridDim.x) {
    int l = it / TPL, t = it % TPL;
    u16* Wl = WS_W(P) + (size_t)l * W_LAYER;
    if (t < 1152) {
      tr_tile(P.w_in + (size_t)l * 1024 * INW, INW, Wl + W_IN, 1024, (t / 16) * 64, (t % 16) * 64, 0, smem);
    } else if (t < 1920) {
      t -= 1152;
      tr_tile(P.w_in + (size_t)l * 1024 * INW, INW, Wl + W_G, 1024, (t / 16) * 64, (t % 16) * 64, 1, smem);
    } else if (t < 2304) {
      t -= 1920;
      int i = t / 128;
      t %= 128;
      tr_tile(P.w_branch + ((size_t)l * 3 + i) * 512 * 1024, 1024, Wl + W_B + (size_t)i * 1024 * 512, 512, (t / 8) * 64, (t % 8) * 64, 2, smem);
    } else if (t < 2560) {
      t -= 2304;
      tr_tile(P.w_out + (size_t)l * 1024 * 1024, 1024, Wl + W_O, 1024, (t / 16) * 64, (t % 16) * 64, 2, smem);
    } else if (t < 3968) {
      t -= 2560;
      tr_tile(P.w_ffn_in + (size_t)l * 1024 * 5632, 5632, Wl + W_FI, 1024, (t / 16) * 64, (t % 16) * 64, 3, smem);
    } else {
      t -= 3968;
      tr_tile(P.w_ffn_out + (size_t)l * FH * 1024, 1024, Wl + W_FO, FH, (t / 44) * 64, (t % 44) * 64, 2, smem);
    }
  }
  for (int it = blockIdx.x; it < 384; it += gridDim.x) {
    int l = it / 192, n0 = (it % 192) * 32;
    float* sc = reinterpret_cast<float*>(smem);
    float* red = sc + 17 * 1024;
    __syncthreads();
    for (int idx = tid; idx < 17 * 1024; idx += NTHREADS) {
      int cond = idx >> 10, k = idx & 1023;
      float cv = cond < 16 ? P.c[cond * 1024 + k] : P.c_ctx[k];
      sc[idx] = siluf_(cv);
    }
    __syncthreads();
    int col = tid & 31, ks = tid >> 5;
    float acc[17];
#pragma unroll
    for (int j = 0; j < 17; ++j) acc[j] = 0.f;
    const float* wm = P.w_mod + (size_t)l * 1024 * 6144 + n0 + col;
    for (int k = ks * 64; k < ks * 64 + 64; ++k) {
      float w = wm[(size_t)k * 6144];
#pragma unroll
      for (int j = 0; j < 17; ++j) acc[j] += sc[j * 1024 + k] * w;
    }
#pragma unroll
    for (int j = 0; j < 17; ++j) red[(ks * 17 + j) * 32 + col] = acc[j];
    __syncthreads();
    for (int o = tid; o < 17 * 32; o += NTHREADS) {
      int j = o >> 5, cc = o & 31;
      float s = 0.f;
      for (int q = 0; q < 16; ++q) s += red[(q * 17 + j) * 32 + cc];
      WS_MOD(P)[((size_t)l * 17 + j) * 6144 + n0 + cc] = s + P.b_mod[l * 6144 + n0 + cc];
    }
  }
  for (int idx = blockIdx.x * NTHREADS + tid; idx < T * 32; idx += gridDim.x * NTHREADS) {
    int t = idx >> 5, j = idx & 31;
    int pos = j < 16 ? (t >> 6) : (t & 63);
    float inv = powf(10000.f, -(float)(j & 15) / 16.f);
    float ang = (float)pos * inv;
    WS_ROPE(P)[idx * 2] = cosf(ang);
    WS_ROPE(P)[idx * 2 + 1] = sinf(ang);
  }
  for (int idx = blockIdx.x * NTHREADS + tid; idx < NCTXR * 1024 / 4; idx += gridDim.x * NTHREADS)
    reinterpret_cast<float4*>(WS_XC(P))[idx] = reinterpret_cast<const float4*>(P.ctx)[idx];
  if (blockIdx.x == 0 && tid < 64) {
    for (int l = 0; l < 2; ++l) {
      float a = wave_sum(P.lam_q1[l * 64 + tid] * P.lam_k1[l * 64 + tid]);
      float b = wave_sum(P.lam_q2[l * 64 + tid] * P.lam_k2[l * 64 + tid]);
      float lam_init = 0.8f - 0.6f * expf(-0.3f * (float)l);
      if (tid == 0) WS_LAM(P)[l] = expf(a) - expf(b) + lam_init;
    }
    if (tid < 8) WS_CTR(P)[tid] = 0u;
  }
}

DEV void phase_norm_mod(const Params& P, const float* xlat, const float* xctx, int nrows, const float* g,
                        const float* modl, int sh_off, int sc_off) {
  const int lane = my_tid() & 63, wid = my_tid() >> 6;
  for (int row = blockIdx.x * 8 + wid; row < nrows; row += gridDim.x * 8) {
    const float* src = row < NLAT ? xlat + (size_t)row * 1024 : xctx + (size_t)(row - NLAT) * 1024;
    int cond = row < NLAT ? row >> 12 : 16;
    const float* md = modl + (size_t)cond * 6144;
    float4 v[4];
    float ss = 0.f;
#pragma unroll
    for (int i = 0; i < 4; ++i) {
      v[i] = *reinterpret_cast<const float4*>(src + i * 256 + lane * 4);
      ss += v[i].x * v[i].x + v[i].y * v[i].y + v[i].z * v[i].z + v[i].w * v[i].w;
    }
    ss = wave_sum(ss);
    float rstd = rsqrtf(ss * (1.f / 1024.f) + EPS);
#pragma unroll
    for (int i = 0; i < 4; ++i) {
      int cb = i * 256 + lane * 4;
      float4 gg = *reinterpret_cast<const float4*>(g + cb);
      float4 sh = *reinterpret_cast<const float4*>(md + sh_off + cb);
      float4 sc = *reinterpret_cast<const float4*>(md + sc_off + cb);
      float y0 = v[i].x * rstd * gg.x * (1.f + sc.x) + sh.x;
      float y1 = v[i].y * rstd * gg.y * (1.f + sc.y) + sh.y;
      float y2 = v[i].z * rstd * gg.z * (1.f + sc.z) + sh.z;
      float y3 = v[i].w * rstd * gg.w * (1.f + sc.w) + sh.w;
      *reinterpret_cast<uint2*>(WS_H(P) + (size_t)row * 1024 + cb) = make_uint2(pack2(y0, y1), pack2(y2, y3));
    }
  }
}

DEV void phase_final_norm(const Params& P) {
  const int lane = my_tid() & 63, wid = my_tid() >> 6;
  for (int row = blockIdx.x * 8 + wid; row < NLAT; row += gridDim.x * 8) {
    float* src = P.out + (size_t)row * 1024;
    float4 v[4];
    float ss = 0.f;
#pragma unroll
    for (int i = 0; i < 4; ++i) {
      v[i] = *reinterpret_cast<const float4*>(src + i * 256 + lane * 4);
      ss += v[i].x * v[i].x + v[i].y * v[i].y + v[i].z * v[i].z + v[i].w * v[i].w;
    }
    ss = wave_sum(ss);
    float rstd = rsqrtf(ss * (1.f / 1024.f) + EPS);
#pragma unroll
    for (int i = 0; i < 4; ++i) {
      int cb = i * 256 + lane * 4;
      float4 gg = *reinterpret_cast<const float4*>(P.g_final + cb);
      float4 o = make_float4(v[i].x * rstd * gg.x, v[i].y * rstd * gg.y, v[i].z * rstd * gg.z, v[i].w * rstd * gg.w);
      *reinterpret_cast<float4*>(src + cb) = o;
    }
  }
}

struct EpiInProj {
  const Params& P;
  int l;
  DEV void operator()(f32x4 (&acc)[8][4], int row0, int col0) const {
    const int lane = my_tid() & 63, fr = lane & 15, fq = lane >> 4;
    if (col0 >= 4416) return;
    if (col0 < C_WQ) {
#pragma unroll
      for (int mi = 0; mi < 8; ++mi)
#pragma unroll
        for (int ni = 0; ni < 4; ++ni)
#pragma unroll
          for (int j = 0; j < 4; ++j)
            WS_P(P)[(size_t)(row0 + mi * 16 + fq * 4 + j) * PW + col0 + ni * 16 + fr] = f2bf(acc[mi][ni][j]);
    } else if (col0 < 3712) {
      const bool isq = (col0 < C_WK) || (col0 >= C_DQ && col0 < C_DK);
      const float qs = isq ? 0.125f : 1.f;
#pragma unroll
      for (int mi = 0; mi < 8; ++mi)
#pragma unroll
        for (int j = 0; j < 4; ++j) {
          int row = row0 + mi * 16 + fq * 4 + j;
          u16* dst = WS_P(P) + (size_t)row * PW + col0 + fr;
          if (row < NLAT) {
            int t = row & (T - 1);
            const float2* rt = reinterpret_cast<const float2*>(WS_ROPE(P)) + t * 32;
#pragma unroll
            for (int hf = 0; hf < 2; ++hf) {
              float2 cs = rt[hf * 16 + fr];
              float x1 = acc[mi][hf * 2][j], x2 = acc[mi][hf * 2 + 1][j];
              dst[hf * 32] = f2bf((x1 * cs.x - x2 * cs.y) * qs);
              dst[hf * 32 + 16] = f2bf((x2 * cs.x + x1 * cs.y) * qs);
            }
          } else {
#pragma unroll
            for (int ni = 0; ni < 4; ++ni) dst[ni * 16] = f2bf(acc[mi][ni][j] * qs);
          }
        }
    } else if (col0 < 4352) {
      u16* base;
      int vrow0;
      const int hdW = (col0 - 3712) >> 6;
      const int hdD = (col0 - 3840) >> 7;
      const bool isw = col0 < 3840;
#pragma unroll
      for (int mi = 0; mi < 8; ++mi) {
        int row = row0 + mi * 16 + fq * 4;
        int b, key;
        if (row < NLAT) { b = row >> 12; key = 256 + (row & (T - 1)); }
        else { b = (row - NLAT) >> 8; key = (row - NLAT) & 255; }
        if (isw) { base = WS_VTW(P) + ((size_t)(b * 2 + hdW) * 64) * KEYS; vrow0 = 0; }
        else { base = WS_VTD(P) + ((size_t)(b * 4 + hdD) * 128) * KEYS; vrow0 = (col0 - 3840) & 127; }
#pragma unroll
        for (int ni = 0; ni < 4; ++ni) {
          int v = vrow0 + ni * 16 + fr;
          *reinterpret_cast<uint2*>(base + (size_t)v * KEYS + key) =
              make_uint2(pack2(acc[mi][ni][0], acc[mi][ni][1]), pack2(acc[mi][ni][2], acc[mi][ni][3]));
        }
      }
    } else {
      float bg = P.b_gate[l * 16 + fr];
#pragma unroll
      for (int mi = 0; mi < 8; ++mi)
#pragma unroll
        for (int j = 0; j < 4; ++j) WS_GATES(P)[(size_t)(row0 + mi * 16 + fq * 4 + j) * 16 + fr] = acc[mi][0][j] + bg;
    }
  }
};

template <int QB, int VB, int KW>
struct AttnCore {
  static constexpr int DV = 32 * VB;
  static constexpr int KST = KW * 2 + 16;
  static constexpr int VST = 128 + 16;
  static constexpr int KBYTES = 64 * KST, VBYTES = DV * VST;
  static constexpr int NKL = 64 * (KW / 8) / NTHREADS, NVL = DV * 8 / NTHREADS;
  static constexpr int TOTAL = 2 * (KBYTES + VBYTES);

  static DEV void run(const u16* qptr, int ldq, const u16* kctx, const u16* klat, int ldk, int kcol, const u16* vt,
                      int nctx, int nlat, int lat_t0, bool window, int qtok0, float m_init, float l_init,
                      f32x16 (&O)[QB][VB], char* smem) {
    const int tid = my_tid(), lane = tid & 63, r = lane & 31, hh = lane >> 5;
    char* Ks = smem;
    char* Vs = smem + 2 * KBYTES;
    bf16x8 qf[QB][4];
#pragma unroll
    for (int qb = 0; qb < QB; ++qb)
#pragma unroll
      for (int ks = 0; ks < 4; ++ks) qf[qb][ks] = ld16(qptr + (size_t)(qb * 32 + r) * ldq + ks * 16 + hh * 8);
    float m[QB], lsum[QB];
#pragma unroll
    for (int qb = 0; qb < QB; ++qb) {
      m[qb] = m_init;
      lsum[qb] = hh == 0 ? l_init : 0.f;
#pragma unroll
      for (int vb = 0; vb < VB; ++vb)
#pragma unroll
        for (int i = 0; i < 16; ++i) O[qb][vb][i] = 0.f;
    }
    bf16x8 rk[NKL], rv[NVL];
    const int ntiles = nctx + nlat;
    auto gload = [&](int j) {
      int kidx = j < nctx ? j * 64 : 256 + lat_t0 + (j - nctx) * 64;
      const u16* krow = j < nctx ? kctx + (size_t)(j * 64) * ldk : klat + (size_t)(lat_t0 + (j - nctx) * 64) * ldk;
#pragma unroll
      for (int i = 0; i < NKL; ++i) {
        int id = tid + i * NTHREADS, row = id / (KW / 8), c = id % (KW / 8);
        rk[i] = ld16(krow + (size_t)row * ldk + c * 8);
      }
#pragma unroll
      for (int i = 0; i < NVL; ++i) {
        int id = tid + i * NTHREADS, row = id >> 3, c = id & 7;
        rv[i] = ld16(vt + (size_t)row * KEYS + kidx + c * 8);
      }
    };
    auto lstore = [&](int buf) {
#pragma unroll
      for (int i = 0; i < NKL; ++i) {
        int id = tid + i * NTHREADS, row = id / (KW / 8), c = id % (KW / 8);
        *reinterpret_cast<bf16x8*>(Ks + buf * KBYTES + row * KST + c * 16) = rk[i];
      }
#pragma unroll
      for (int i = 0; i < NVL; ++i) {
        int id = tid + i * NTHREADS, row = id >> 3, c = id & 7;
        *reinterpret_cast<bf16x8*>(Vs + buf * VBYTES + row * VST + c * 16) = rv[i];
      }
    };
    __syncthreads();
    gload(0);
    lstore(0);
    __syncthreads();
    for (int j = 0; j < ntiles; ++j) {
      const int buf = j & 1;
      if (j + 1 < ntiles) gload(j + 1);
      bf16x8 pf[QB][2][2];
#pragma unroll
      for (int qb = 0; qb < QB; ++qb) {
        f32x16 S[2];
#pragma unroll
        for (int kb = 0; kb < 2; ++kb) {
#pragma unroll
          for (int i = 0; i < 16; ++i) S[kb][i] = 0.f;
#pragma unroll
          for (int ks = 0; ks < 4; ++ks) {
            bf16x8 kf = ld16(Ks + buf * KBYTES + (kb * 32 + pi32(r)) * KST + (kcol + ks * 16 + hh * 8) * 2);
            S[kb] = mfma32(kf, qf[qb][ks], S[kb]);
          }
        }
        __builtin_amdgcn_sched_barrier(0);
        if (window && j >= nctx) {
          int kt0 = lat_t0 + (j - nctx) * 64;
          int qt = qtok0 + qb * 32 + r;
#pragma unroll
          for (int kb = 0; kb < 2; ++kb)
#pragma unroll
            for (int i = 0; i < 16; ++i) {
              int kt = kt0 + kb * 32 + 16 * (i >> 3) + 8 * hh + (i & 7);
              int dlt = qt - kt;
              if (dlt > 128 || dlt < -128) S[kb][i] = -1e30f;
            }
        }
        float mloc = -1e30f;
#pragma unroll
        for (int kb = 0; kb < 2; ++kb)
#pragma unroll
          for (int i = 0; i < 16; ++i) mloc = fmaxf(mloc, S[kb][i]);
        mloc = fmaxf(mloc, __shfl_xor(mloc, 32));
        if (__any(mloc > m[qb] + 5.5f)) {
          float mnew = fmaxf(m[qb], mloc);
          float alpha = fexp2((m[qb] - mnew) * L2E);
          m[qb] = mnew;
          lsum[qb] *= alpha;
#pragma unroll
          for (int vb = 0; vb < VB; ++vb)
#pragma unroll
            for (int i = 0; i < 16; ++i) O[qb][vb][i] *= alpha;
        }
        float mb = m[qb] * L2E, ps = 0.f;
#pragma unroll
        for (int kb = 0; kb < 2; ++kb) {
          float pv[16];
#pragma unroll
          for (int i = 0; i < 16; ++i) {
            pv[i] = fexp2(S[kb][i] * L2E - mb);
            ps += pv[i];
          }
#pragma unroll
          for (int s = 0; s < 2; ++s)
            pf[qb][kb][s] = mk8(pack2(pv[8 * s], pv[8 * s + 1]), pack2(pv[8 * s + 2], pv[8 * s + 3]),
                                pack2(pv[8 * s + 4], pv[8 * s + 5]), pack2(pv[8 * s + 6], pv[8 * s + 7]));
        }
        lsum[qb] += ps;
        __builtin_amdgcn_sched_barrier(0);
      }
      __builtin_amdgcn_sched_barrier(0);
#pragma unroll
      for (int vb = 0; vb < VB; ++vb) {
#pragma unroll
        for (int kb = 0; kb < 2; ++kb)
#pragma unroll
          for (int s = 0; s < 2; ++s) {
            bf16x8 vf = ld16(Vs + buf * VBYTES + (vb * 32 + r) * VST + (kb * 32 + s * 16 + hh * 8) * 2);
#pragma unroll
            for (int qb = 0; qb < QB; ++qb) O[qb][vb] = mfma32(vf, pf[qb][kb][s], O[qb][vb]);
          }
        __builtin_amdgcn_sched_barrier(0);
      }
      if (j + 1 < ntiles) lstore(buf ^ 1);
      __syncthreads();
    }
#pragma unroll
    for (int qb = 0; qb < QB; ++qb) {
      float lt = lsum[qb] + __shfl_xor(lsum[qb], 32);
      float inv = 1.f / lt;
#pragma unroll
      for (int vb = 0; vb < VB; ++vb)
#pragma unroll
        for (int i = 0; i < 16; ++i) O[qb][vb][i] *= inv;
    }
  }
};

DEV void diff_item(const Params& P, int l, int b, int h, int qt, bool ctxq, char* smem) {
  const int tid = my_tid(), lane = tid & 63, wid = tid >> 6, r = lane & 31, hh = lane >> 5;
  const int comp = wid >> 2, wq = wid & 3;
  const int rowbase = ctxq ? NLAT + b * 256 + qt * 128 : b * T + qt * 128;
  const u16* qptr = WS_P(P) + (size_t)(rowbase + wq * 32) * PW + C_DQ + h * 128 + comp * 64;
  const u16* kctx = WS_P(P) + (size_t)(NLAT + b * 256) * PW + C_DK + h * 128;
  const u16* klat = WS_P(P) + (size_t)(b * T) * PW + C_DK + h * 128;
  const u16* vt = WS_VTD(P) + ((size_t)(b * 4 + h) * 128) * KEYS;
  f32x16 O[1][4];
  AttnCore<1, 4, 128>::run(qptr, PW, kctx, klat, PW, comp * 64, vt, 4, ctxq ? 0 : 64, 0, false, 0, -1e30f, 0.f, O, smem);
  float* ex = reinterpret_cast<float*>(smem);
  __syncthreads();
  if (comp == 1) {
#pragma unroll
    for (int vb = 0; vb < 4; ++vb)
#pragma unroll
      for (int i = 0; i < 16; ++i) ex[(wq * 64 + vb * 16 + i) * 64 + lane] = O[0][vb][i];
  }
  __syncthreads();
  if (comp == 0) {
    const float lam = WS_LAM(P)[l];
    const float lam_init = 0.8f - 0.6f * expf(-0.3f * (float)l);
    float ss = 0.f;
#pragma unroll
    for (int vb = 0; vb < 4; ++vb)
#pragma unroll
      for (int i = 0; i < 16; ++i) {
        float y = O[0][vb][i] - lam * ex[(wq * 64 + vb * 16 + i) * 64 + lane];
        O[0][vb][i] = y;
        ss += y * y;
      }
    ss += __shfl_xor(ss, 32);
    float sc = rsqrtf(ss * (1.f / 128.f) + EPS) * (1.f - lam_init);
    const float* dn = P.d_norm + l * 512 + h * 128;
    u16* dst = WS_P(P) + (size_t)(rowbase + wq * 32 + r) * PW + C_DQ + h * 128;
#pragma unroll
    for (int vb = 0; vb < 4; ++vb)
#pragma unroll
      for (int g4 = 0; g4 < 4; ++g4) {
        int v = vb * 32 + g4 * 8 + hh * 4;
        float4 w = *reinterpret_cast<const float4*>(dn + v);
        *reinterpret_cast<uint2*>(dst + v) =
            make_uint2(pack2(O[0][vb][g4 * 4] * sc * w.x, O[0][vb][g4 * 4 + 1] * sc * w.y),
                       pack2(O[0][vb][g4 * 4 + 2] * sc * w.z, O[0][vb][g4 * 4 + 3] * sc * w.w));
      }
  }
  __syncthreads();
}

DEV void win_item(const Params& P, int l, int b, int g, int qb, bool ctxq, char* smem) {
  const int tid = my_tid(), lane = tid & 63, wid = tid >> 6, r = lane & 31, hh = lane >> 5;
  const int hr = wid >> 1, qh = wid & 1;
  const int head = g * 4 + hr;
  const int rowbase = (ctxq ? NLAT + b * 256 + qb * 64 : b * T + qb * 64) + qh * 32;
  const u16* qptr = WS_P(P) + (size_t)rowbase * PW + C_WQ + head * 64;
  const u16* kctx = WS_P(P) + (size_t)(NLAT + b * 256) * PW + C_WK + g * 64;
  const u16* klat = WS_P(P) + (size_t)(b * T) * PW + C_WK + g * 64;
  const u16* vt = WS_VTW(P) + ((size_t)(b * 2 + g) * 64) * KEYS;
  int t0 = 0, nlat = 0;
  if (!ctxq) {
    t0 = qb * 64 - 128;
    if (t0 < 0) t0 = 0;
    int t1 = qb * 64 + 192;
    if (t1 > T) t1 = T;
    nlat = (t1 - t0) >> 6;
  }
  f32x16 O[1][2];
  AttnCore<1, 2, 64>::run(qptr, PW, kctx, klat, PW, 0, vt, 4, nlat, t0, !ctxq, qb * 64 + qh * 32, P.sink[l * 8 + head], 1.f, O, smem);
  u16* dst = WS_P(P) + (size_t)(rowbase + r) * PW + C_WQ + head * 64;
#pragma unroll
  for (int vb = 0; vb < 2; ++vb)
#pragma unroll
    for (int g4 = 0; g4 < 4; ++g4) {
      int v = vb * 32 + g4 * 8 + hh * 4;
      *reinterpret_cast<uint2*>(dst + v) = make_uint2(pack2(O[0][vb][g4 * 4], O[0][vb][g4 * 4 + 1]),
                                                        pack2(O[0][vb][g4 * 4 + 2], O[0][vb][g4 * 4 + 3]));
    }
}

DEV void mlstm_item(const Params& P, int l, int b, int hd, int dir, bool need_ctx, char* smem) {
  const int tid = my_tid(), lane = tid & 63, wid = tid >> 6, r = lane & 31, hh = lane >> 5;
  constexpr int QST = 272, TST = 144;
  char* Qs = smem;
  char* Ks = Qs + 64 * QST;
  char* KwT = Ks + 64 * QST;
  char* VT = KwT + 128 * TST;
  char* Sp = VT + 128 * TST;
  char* Rq = Sp + 64 * TST;
  char* Rk = Rq + 66 * QST;
  float* fb = reinterpret_cast<float*>(Rk + 66 * QST);
  float* sb = fb;
  float* sa = fb + 64;
  float* sM = fb + 128;
  float* denp = fb + 192;
  float* qn = fb + 320;
  float* nb = fb + 384;
  float* cw = fb + 640;
  __syncthreads();
  if (tid < 256) nb[tid] = 0.f;
  for (int i = tid; i < 768; i += NTHREADS) {
    int qk = i / 384, tap = (i % 384) / 128, d = i & 127;
    cw[i] = P.conv_w[(size_t)l * 3 * 1024 + tap * 1024 + qk * 512 + hd * 128 + d];
  }
  f32x16 CT[4];
#pragma unroll
  for (int kb = 0; kb < 4; ++kb)
#pragma unroll
    for (int i = 0; i < 16; ++i) CT[kb][i] = 0.f;
  float mstate = 0.f;
  u16* hout = WS_HFB(P) + (size_t)dir * MTOT * 512;
  const float kscale = 0.08838834764831845f;

  auto geom = [&](int step, int& seg0, int& seglen, int& u0) {
    int c;
    if (step < 4) { seg0 = NLAT + b * 256; seglen = 256; c = dir ? 3 - step : step; }
    else { seg0 = b * T; seglen = T; c = dir ? 67 - step : step - 4; }
    u0 = c * 64;
  };
  bf16x8 pq[3], pk[3], pvv[2];
  float pig = 0.f, pfg = 0.f;
  auto issue_loads = [&](int step) {
    int seg0, seglen, u0;
    geom(step, seg0, seglen, u0);
#pragma unroll
    for (int i = 0; i < 3; ++i) {
      int id = tid + i * NTHREADS;
      bf16x8 z = {0, 0, 0, 0, 0, 0, 0, 0};
      pq[i] = z;
      pk[i] = z;
      if (id < 66 * 16) {
        int row = id >> 4, cc = id & 15;
        int uu = u0 + row - 1;
        bool ok = uu >= 0 && uu < seglen;
        const u16* src = WS_P(P) + (size_t)(seg0 + (ok ? uu : 0)) * PW + hd * 128 + cc * 8;
        if (ok) { pq[i] = ld16(src + C_MQ); pk[i] = ld16(src + C_MK); }
      }
    }
#pragma unroll
    for (int i = 0; i < 2; ++i) {
      int id = tid + i * NTHREADS, u = id >> 4, cc = id & 15;
      pvv[i] = ld16(WS_P(P) + (size_t)(seg0 + u0 + u) * PW + C_MV + hd * 128 + cc * 8);
    }
    if (wid == 0) {
      const int pos = dir ? 63 - lane : lane;
      const float* gp = WS_GATES(P) + (size_t)(seg0 + u0 + pos) * 16;
      pig = gp[(dir * 2) * 4 + hd];
      pfg = gp[(dir * 2 + 1) * 4 + hd];
    }
  };
  issue_loads(0);

  for (int step = 0; step < 68; ++step) {
    int seg0, seglen, u0;
    geom(step, seg0, seglen, u0);
    const int rowbase = seg0 + u0;
    const int cur = step & 1;
    __syncthreads();
    bf16x8 rvv[2];
#pragma unroll
    for (int i = 0; i < 3; ++i) {
      int id = tid + i * NTHREADS;
      if (id < 66 * 16) {
        int row = id >> 4, cc = id & 15;
        *reinterpret_cast<bf16x8*>(Rq + row * QST + cc * 16) = pq[i];
        *reinterpret_cast<bf16x8*>(Rk + row * QST + cc * 16) = pk[i];
      }
    }
    rvv[0] = pvv[0];
    rvv[1] = pvv[1];
    const float ig = pig, fg = pfg;
    if (step + 1 < 68) issue_loads(step + 1);
    if (wid == 0) {
      const int pos = dir ? 63 - lane : lane;
      float lf = fminf(fg, 0.f) - log1pf(__expf(-fabsf(fg)));
      float bsum = lf;
#pragma unroll
      for (int o = 1; o < 64; o <<= 1) { float t2 = __shfl_up(bsum, o); if (lane >= o) bsum += t2; }
      float a = ig - bsum, am = a;
#pragma unroll
      for (int o = 1; o < 64; o <<= 1) { float t2 = __shfl_up(am, o); if (lane >= o) am = fmaxf(am, t2); }
      sb[pos] = bsum;
      sa[pos] = a;
      sM[pos] = fmaxf(mstate, am);
    }
    __syncthreads();
    const int eidx = dir ? 0 : 63;
    const float Mend = sM[eidx], bend = sb[eidx];
    const float decay = __expf(mstate - Mend);
#pragma unroll 1
    for (int i = 0; i < 2; ++i) {
      int id = tid + i * NTHREADS, u = id >> 4, cc = id & 15;
      float wend = __expf(sa[u] - Mend);
      const int tbase = cc * 8 * TST + (((u >> 3) ^ (cc & 7)) << 4) + (u & 7) * 2;
      uint32_t qo[4], ko[4];
      float kv[8];
      bf16x8 q0 = ld16(Rq + (u)*QST + cc * 16), q1 = ld16(Rq + (u + 1) * QST + cc * 16), q2 = ld16(Rq + (u + 2) * QST + cc * 16);
      bf16x8 k0 = ld16(Rk + (u)*QST + cc * 16), k1 = ld16(Rk + (u + 1) * QST + cc * 16), k2 = ld16(Rk + (u + 2) * QST + cc * 16);
#pragma unroll
      for (int e = 0; e < 8; ++e) {
        int d = cc * 8 + e;
        float xq = cw[0 * 128 + d] * bf2f((u16)q0[e]) + cw[1 * 128 + d] * bf2f((u16)q1[e]) + cw[2 * 128 + d] * bf2f((u16)q2[e]);
        float xk = cw[384 + 0 * 128 + d] * bf2f((u16)k0[e]) + cw[384 + 1 * 128 + d] * bf2f((u16)k1[e]) + cw[384 + 2 * 128 + d] * bf2f((u16)k2[e]);
        float qv = xq * __builtin_amdgcn_rcpf(1.f + __expf(-xq));
        kv[e] = xk * __builtin_amdgcn_rcpf(1.f + __expf(-xk)) * kscale;
        if (e & 1) { qo[e >> 1] |= ((uint32_t)f2bf(qv)) << 16; ko[e >> 1] |= ((uint32_t)f2bf(kv[e])) << 16; }
        else { qo[e >> 1] = f2bf(qv); ko[e >> 1] = f2bf(kv[e]); }
        *reinterpret_cast<u16*>(KwT + tbase + e * TST) = f2bf(kv[e] * wend);
        *reinterpret_cast<u16*>(VT + tbase + e * TST) = (u16)rvv[i][e];
      }
      *reinterpret_cast<uint4*>(Qs + u * QST + cc * 16) = make_uint4(qo[0], qo[1], qo[2], qo[3]);
      *reinterpret_cast<uint4*>(Ks + u * QST + cc * 16) = make_uint4(ko[0], ko[1], ko[2], ko[3]);
    }
    __syncthreads();
    if (wid < 4) {
      const int sblk = wid & 1, tblk = wid >> 1;
      f32x16 S;
#pragma unroll
      for (int i = 0; i < 16; ++i) S[i] = 0.f;
#pragma unroll
      for (int ks = 0; ks < 8; ++ks) {
        bf16x8 kf = ld16(Ks + (sblk * 32 + pi32(r)) * QST + (ks * 16 + hh * 8) * 2);
        bf16x8 qf = ld16(Qs + (tblk * 32 + r) * QST + (ks * 16 + hh * 8) * 2);
        S = mfma32(kf, qf, S);
      }
      const int t = tblk * 32 + r;
      const float Mt = sM[t];
      float ds = 0.f, val[16];
#pragma unroll
      for (int i = 0; i < 16; ++i) {
        int s = sblk * 32 + 16 * (i >> 3) + 8 * hh + (i & 7);
        bool ok = dir ? (s >= t) : (s <= t);
        val[i] = ok ? S[i] * __expf(sa[s] - Mt) : 0.f;
        ds += val[i];
      }
      ds += __shfl_xor(ds, 32);
      if (hh == 0) denp[sblk * 64 + t] = ds;
#pragma unroll
      for (int s2 = 0; s2 < 2; ++s2)
        *reinterpret_cast<uint4*>(Sp + t * TST + (sblk * 32 + s2 * 16 + hh * 8) * 2) =
            make_uint4(pack2(val[8 * s2], val[8 * s2 + 1]), pack2(val[8 * s2 + 2], val[8 * s2 + 3]),
                       pack2(val[8 * s2 + 4], val[8 * s2 + 5]), pack2(val[8 * s2 + 6], val[8 * s2 + 7]));
    } else if (wid == 4) {
      float s = 0.f;
      const float* nc = nb + cur * 128;
      for (int k8 = 0; k8 < 16; ++k8) {
        bf16x8 qv = ld16(Qs + lane * QST + k8 * 16);
#pragma unroll
        for (int e = 0; e < 8; ++e) s += nc[k8 * 8 + e] * bf2f((u16)qv[e]);
      }
      qn[lane] = s;
    } else if (wid == 5) {
      const float* nc = nb + cur * 128;
      float* nn = nb + (cur ^ 1) * 128;
#pragma unroll
      for (int q2 = 0; q2 < 2; ++q2) {
        int k = lane + q2 * 64;
        float s = 0.f;
        for (int s8 = 0; s8 < 8; ++s8) {
          bf16x8 kv = ld16(KwT + k * TST + s8 * 16);
#pragma unroll
          for (int e = 0; e < 8; ++e) s += bf2f((u16)kv[e]);
        }
        nn[k] = decay * nc[k] + s;
      }
    }
    __syncthreads();
    {
      bf16x8 vf[4];
      const int vb = wid & 3, tb = wid >> 2;
#pragma unroll
      for (int ks = 0; ks < 4; ++ks) vf[ks] = ld16(VT + (vb * 32 + r) * TST + (((ks * 2 + hh) ^ ((r >> 3) | ((vb & 1) << 2))) << 4));
      const bool wr_h = (step >= 4) || need_ctx;
      {
        const int t = tb * 32 + r;
        f32x16 acc;
#pragma unroll
        for (int i = 0; i < 16; ++i) acc[i] = 0.f;
#pragma unroll
        for (int kb = 0; kb < 4; ++kb)
#pragma unroll
          for (int s2 = 0; s2 < 2; ++s2) {
            bf16x8 af = mk8(pack2(CT[kb][8 * s2], CT[kb][8 * s2 + 1]), pack2(CT[kb][8 * s2 + 2], CT[kb][8 * s2 + 3]),
                            pack2(CT[kb][8 * s2 + 4], CT[kb][8 * s2 + 5]), pack2(CT[kb][8 * s2 + 6], CT[kb][8 * s2 + 7]));
            uint2 lo = *reinterpret_cast<const uint2*>(Qs + t * QST + (kb * 32 + s2 * 16 + hh * 4) * 2);
            uint2 hi = *reinterpret_cast<const uint2*>(Qs + t * QST + (kb * 32 + s2 * 16 + 8 + hh * 4) * 2);
            acc = mfma32(af, mk8(lo.x, lo.y, hi.x, hi.y), acc);
          }
        const float Mt = sM[t];
        const float winter = __expf(mstate - Mt);
#pragma unroll
        for (int i = 0; i < 16; ++i) acc[i] *= winter;
#pragma unroll
        for (int ks = 0; ks < 4; ++ks) {
          bf16x8 sf = ld16(Sp + t * TST + (ks * 16 + hh * 8) * 2);
          acc = mfma32(vf[ks], sf, acc);
        }
        float den = denp[t] + denp[64 + t] + winter * qn[t];
        float sc = 1.f / fmaxf(fabsf(den), __expf(-(sb[t] + Mt)));
        if (wr_h) {
          u16* dst = hout + (size_t)(rowbase + t) * 512 + hd * 128 + vb * 32;
#pragma unroll
          for (int g4 = 0; g4 < 4; ++g4)
            *reinterpret_cast<uint2*>(dst + g4 * 8 + hh * 4) =
                make_uint2(pack2(acc[g4 * 4] * sc, acc[g4 * 4 + 1] * sc), pack2(acc[g4 * 4 + 2] * sc, acc[g4 * 4 + 3] * sc));
        }
      }
#pragma unroll
      for (int kb = 0; kb < 4; ++kb) {
#pragma unroll
        for (int i = 0; i < 16; ++i) CT[kb][i] *= decay;
#pragma unroll
        for (int ks = 0; ks < 4; ++ks) {
          bf16x8 kf = ld16(KwT + (kb * 32 + r) * TST + (((ks * 2 + hh) ^ ((r >> 3) | ((kb & 1) << 2))) << 4));
          CT[kb] = mfma32(kf, vf[ks], CT[kb]);
        }
      }
    }
    mstate = bend + Mend;
  }
  __syncthreads();
}

DEV int next_item(unsigned* ctr, int* s_item) {
  __syncthreads();
  if (my_tid() == 0) *s_item = (int)atomicAdd(ctr, 1u);
  __syncthreads();
  return *s_item;
}
DEV void phase_mixers(const Params& P, int l, char* smem) {
  const bool need_ctx = (l == 0);
  __shared__ int s_item;
  const int n_ml = 128, n_diff = 2048, n_win = 2048, n_dc = need_ctx ? 128 : 0, n_wc = need_ctx ? 128 : 0;
  for (;;) {
    int it = next_item(&WS_CTR(P)[l * 4 + 0], &s_item);
    if (it >= n_ml) break;
    mlstm_item(P, l, it >> 3, (it >> 1) & 3, it & 1, need_ctx, smem);
  }
  for (;;) {
    int it = next_item(&WS_CTR(P)[l * 4 + 1], &s_item);
    if (it >= n_diff + n_dc) break;
    bool cq = it >= n_diff;
    int i2 = it - n_diff;
    int b = cq ? i2 >> 3 : it >> 7, hd = cq ? (i2 >> 1) & 3 : (it >> 5) & 3, qt = cq ? i2 & 1 : it & 31;
    diff_item(P, l, b, hd, qt, cq, smem);
  }
  for (;;) {
    int it = next_item(&WS_CTR(P)[l * 4 + 2], &s_item);
    if (it >= n_win + n_wc) break;
    bool cq = it >= n_win;
    int i2 = it - n_win;
    int b = cq ? i2 >> 3 : it >> 7, g = cq ? (i2 >> 2) & 1 : (it >> 6) & 1, qb = cq ? i2 & 3 : it & 63;
    win_item(P, l, b, g, qb, cq, smem);
  }
}

DEV void phase_ya(const Params& P, int l, int nrows) {
  const int lane = my_tid() & 63, wid = my_tid() >> 6;
  const u16* hf = WS_HFB(P);
  const u16* hb = WS_HFB(P) + (size_t)MTOT * 512;
  for (int row = blockIdx.x * 8 + wid; row < nrows; row += gridDim.x * 8) {
    uint4 a = *reinterpret_cast<const uint4*>(hf + (size_t)row * 512 + lane * 8);
    uint4 bq = *reinterpret_cast<const uint4*>(hb + (size_t)row * 512 + lane * 8);
    uint4 o = *reinterpret_cast<const uint4*>(WS_P(P) + (size_t)row * PW + C_MO + lane * 8);
    uint32_t aa[4] = {a.x, a.y, a.z, a.w}, bb[4] = {bq.x, bq.y, bq.z, bq.w}, oo[4] = {o.x, o.y, o.z, o.w};
    float y[8], ss = 0.f;
#pragma unroll
    for (int j = 0; j < 4; ++j) {
      y[2 * j] = (bflo(aa[j]) + bflo(bb[j])) * sigmoidf_(bflo(oo[j]));
      y[2 * j + 1] = (bfhi(aa[j]) + bfhi(bb[j])) * sigmoidf_(bfhi(oo[j]));
      ss += y[2 * j] * y[2 * j] + y[2 * j + 1] * y[2 * j + 1];
    }
#pragma unroll
    for (int of = 1; of < 16; of <<= 1) ss += __shfl_xor(ss, of);
    float rstd = rsqrtf(ss * (1.f / 128.f) + EPS);
    const float* mn = P.m_norm + l * 512 + lane * 8;
    uint32_t w[4];
#pragma unroll
    for (int j = 0; j < 4; ++j) w[j] = pack2(y[2 * j] * rstd * mn[2 * j], y[2 * j + 1] * rstd * mn[2 * j + 1]);
    *reinterpret_cast<uint4*>(WS_P(P) + (size_t)row * PW + C_MO + lane * 8) = make_uint4(w[0], w[1], w[2], w[3]);
  }
}

DEV void phase_merge(const Params& P, int l, int M, char* smem) {
  const u16* Wl = WS_W(P) + (size_t)l * W_LAYER;
  u16* merged = WS_HFB(P);
  const int nM = M / 128, nN = 4;
  const int lane = my_tid() & 63, wid = my_tid() >> 6, wr = wid >> 2, wc = wid & 3, fr = lane & 15, fq = lane >> 4;
  for (int tile = blockIdx.x; tile < nM * nN; tile += gridDim.x) {
    int tm, tn;
    tile_coords(tile, nM * nN, nN, tm, tn);
    f32x4 mg[4][4];
    zero_acc<4, 4>(mg);
#pragma unroll 1
    for (int i = 0; i < 3; ++i) {
      f32x4 acc[4][4];
      zero_acc<4, 4>(acc);
      gemm_mainloop64(WS_H(P) + (size_t)tm * 128 * 1024, 1024, Wl + W_G + (size_t)(i * 1024 + tn * 256) * 1024, 1024, 1024, acc, smem);
      uint32_t gp[4][4][2];
#pragma unroll
      for (int mi = 0; mi < 4; ++mi)
#pragma unroll
        for (int ni = 0; ni < 4; ++ni) {
          gp[mi][ni][0] = pack2(sigmoidf_(acc[mi][ni][0]), sigmoidf_(acc[mi][ni][1]));
          gp[mi][ni][1] = pack2(sigmoidf_(acc[mi][ni][2]), sigmoidf_(acc[mi][ni][3]));
        }
      zero_acc<4, 4>(acc);
      int yc = i == 0 ? C_MO : (i == 1 ? C_WQ : C_DQ);
      gemm_mainloop64(WS_P(P) + (size_t)tm * 128 * PW + yc, PW, Wl + W_B + (size_t)i * 1024 * 512 + (size_t)(tn * 256) * 512, 512, 512, acc, smem);
#pragma unroll
      for (int mi = 0; mi < 4; ++mi)
#pragma unroll
        for (int ni = 0; ni < 4; ++ni) {
          mg[mi][ni][0] += bflo(gp[mi][ni][0]) * acc[mi][ni][0];
          mg[mi][ni][1] += bfhi(gp[mi][ni][0]) * acc[mi][ni][1];
          mg[mi][ni][2] += bflo(gp[mi][ni][1]) * acc[mi][ni][2];
          mg[mi][ni][3] += bfhi(gp[mi][ni][1]) * acc[mi][ni][3];
        }
    }
    const int row0 = tm * 128 + wr * 64, col0 = tn * 256 + wc * 64;
#pragma unroll
    for (int mi = 0; mi < 4; ++mi)
#pragma unroll
      for (int ni = 0; ni < 4; ++ni)
#pragma unroll
        for (int j = 0; j < 4; ++j)
          merged[(size_t)(row0 + mi * 16 + fq * 4 + j) * 1024 + col0 + ni * 16 + fr] = f2bf(mg[mi][ni][j]);
  }
}

struct EpiResid {
  const Params& P;
  const float* src_lat;
  const float* modl;
  int gt_off;
  DEV void operator()(f32x4 (&acc)[8][4], int row0, int col0) const {
    const int lane = my_tid() & 63, fr = lane & 15, fq = lane >> 4;
#pragma unroll
    for (int mi = 0; mi < 8; ++mi)
#pragma unroll
      for (int j = 0; j < 4; ++j) {
        int row = row0 + mi * 16 + fq * 4 + j;
        const float* src;
        float* dst;
        int cond;
        if (row < NLAT) { src = src_lat + (size_t)row * 1024; dst = P.out + (size_t)row * 1024; cond = row >> 12; }
        else { src = WS_XC(P) + (size_t)(row - NLAT) * 1024; dst = WS_XC(P) + (size_t)(row - NLAT) * 1024; cond = 16; }
        const float* gt = modl + (size_t)cond * 6144 + gt_off;
#pragma unroll
        for (int ni = 0; ni < 4; ++ni) {
          int col = col0 + ni * 16 + fr;
          dst[col] = src[col] + gt[col] * acc[mi][ni][j];
        }
      }
  }
};

struct EpiSwiglu {
  u16* act;
  DEV void operator()(f32x4 (&acc)[8][4], int row0, int col0) const {
    const int lane = my_tid() & 63, fr = lane & 15, fq = lane >> 4;
#pragma unroll
    for (int mi = 0; mi < 8; ++mi)
#pragma unroll
      for (int j = 0; j < 4; ++j) {
        int row = row0 + mi * 16 + fq * 4 + j;
#pragma unroll
        for (int pr = 0; pr < 2; ++pr) {
          float gte = acc[mi][pr * 2][j], up = acc[mi][pr * 2 + 1][j];
          act[(size_t)row * FH + ((col0 + pr * 32) >> 1) + fr] = f2bf(siluf_(gte) * up);
        }
      }
  }
};


namespace pg8 {
#define PG8_LAS __attribute__((address_space(3)))
constexpr int BM = 256, BK = 64, HALF = 128, HTB = HALF * BK * 2, NXCD = 8, WGM = 8;
DEV int lds_byte(int r, int c) { const int st = (r >> 4) * 2 + (c >> 5), rr = r & 15, cc = c & 31, ob = rr * 64 + cc * 2; return st * 1024 + (ob ^ (((ob >> 9) & 1) << 5)); }
DEV void stage_rc(int b, int& R, int& C) { const int st = b / 1024, sb = b % 1024, swz = sb ^ (((sb >> 9) & 1) << 5); R = (st >> 1) * 16 + swz / 64; C = (st & 1) * 32 + (swz % 64) / 2; }
struct Unit { int pm, pn; };
struct StaticOrder {
  int nM, nN, nwg, G, c;
  DEV void init(int M, int N, int G_, int c_) { nM = M / BM; nN = N / BM; nwg = nM * nN; G = G_; c = c_; }
  DEV bool next(int i, Unit& u) const {
    const long L = (long)i * G + c;
    if (L >= nwg) return false;
    int wgid = (int)L;
    { const int q = nwg / NXCD, r = nwg % NXCD, xcd = wgid % NXCD, off = wgid / NXCD; wgid = (xcd < r ? xcd * (q + 1) : r * (q + 1) + (xcd - r) * q) + off; }
    const int nig = WGM * nN, gid = wgid / nig, fm = gid * WGM, gsz = (nM - fm) < WGM ? (nM - fm) : WGM;
    u.pm = fm + ((wgid % nig) % gsz);
    u.pn = (wgid % nig) / gsz;
    return true;
  }
};
template <class Epi>
DEV void gemm_phase(char* smem, const u16* A, int lda, const u16* Bt, int ldb, int M, int N, int K, const Epi& E) {
  PG8_LAS unsigned char* lds = (PG8_LAS unsigned char*)smem;
  const int tid = my_tid(), wid = __builtin_amdgcn_readfirstlane(tid >> 6), lane = tid & 63, wr = wid >> 2, wc = wid & 3, fr = lane & 15, fq = lane >> 4;
  const int nt = K / BK;
  StaticOrder S;
  S.init(M, N, gridDim.x, blockIdx.x);
  unsigned voffA[2], voffB[2];
#pragma unroll
  for (int i = 0; i < 2; ++i) { int R, C; stage_rc(tid * 16 + i * 8192, R, C); voffA[i] = (unsigned)(R * lda + C) * 2u; voffB[i] = (unsigned)(R * ldb + C) * 2u; }
  const size_t kstep = (size_t)(BK * 2);
  const size_t hstepA = (size_t)HALF * lda * 2, hstepB = (size_t)HALF * ldb * 2;
  const size_t tstepA = 2 * hstepA, tstepB = 2 * hstepB;
  const unsigned ldsw = (unsigned)wid * 1024u;
  const int aoff = lds_byte(wr * 64 + fr, fq * 8), boff = lds_byte(wc * 32 + fr, fq * 8);
#define PG8_SA(b, h) (((b) * 2 + (h)) * HTB)
#define PG8_SB(b, h) ((4 + (b) * 2 + (h)) * HTB)
#define PG8_STAGE(bufoff, gbase, voff) do { _Pragma("unroll") for (int _i = 0; _i < 2; ++_i) \
        __builtin_amdgcn_global_load_lds((const unsigned*)((const char*)(gbase) + (voff)[_i]), (PG8_LAS unsigned*)(lds + (bufoff) + ldsw + _i * 8192), 16, 0, 0); } while (0)
#define PG8_LDA(dst, b, h) do { _Pragma("unroll") for (int m = 0; m < 4; ++m) _Pragma("unroll") for (int k = 0; k < 2; ++k) dst[m][k] = *(const PG8_LAS bf16x8*)(lds + PG8_SA(b, h) + aoff + m * 2048 + k * 1024); } while (0)
#define PG8_LDB(dst, b, h) do { _Pragma("unroll") for (int n = 0; n < 2; ++n) _Pragma("unroll") for (int k = 0; k < 2; ++k) dst[n][k] = *(const PG8_LAS bf16x8*)(lds + PG8_SB(b, h) + boff + n * 2048 + k * 1024); } while (0)
#define PG8_MMA(ai, bj, At, Bt_) do { __builtin_amdgcn_s_setprio(1); _Pragma("unroll") for (int m = 0; m < 4; ++m) _Pragma("unroll") for (int n = 0; n < 2; ++n) _Pragma("unroll") for (int k = 0; k < 2; ++k) \
        acc[ai][bj][m][n] = __builtin_amdgcn_mfma_f32_16x16x32_bf16(Bt_[n][k], At[m][k], acc[ai][bj][m][n], 0, 0, 0); __builtin_amdgcn_s_setprio(0); } while (0)
#define PG8_WAIT_V(n) asm volatile("s_waitcnt vmcnt(" #n ")" ::: "memory")
#define PG8_WAIT_L(n) asm volatile("s_waitcnt lgkmcnt(" #n ")" ::: "memory")
#define PG8_BAR __builtin_amdgcn_s_barrier()
#define PG8_SCHED __builtin_amdgcn_sched_barrier(0)
  Unit cur, nxt;
  int ui = 0;
  PG8_WAIT_V(0);
  __syncthreads();
  if (!S.next(0, cur)) return;
  f32x4 acc[2][2][4][2];
#pragma unroll
  for (int a = 0; a < 2; ++a)
#pragma unroll
    for (int b = 0; b < 2; ++b)
#pragma unroll
      for (int m = 0; m < 4; ++m)
#pragma unroll
        for (int n = 0; n < 2; ++n) acc[a][b][m][n] = (f32x4){0.f, 0.f, 0.f, 0.f};
  bf16x8 At[4][2], B0[2][2], B1[2][2];
  const char* cA = (const char*)A + (size_t)cur.pm * tstepA;
  const char* cB = (const char*)Bt + (size_t)cur.pn * tstepB;
  PG8_STAGE(PG8_SB(0, 0), cB, voffB); PG8_STAGE(PG8_SA(0, 0), cA, voffA); PG8_STAGE(PG8_SB(0, 1), cB + hstepB, voffB); PG8_STAGE(PG8_SA(0, 1), cA + hstepA, voffA);
  if (wr == 1) PG8_BAR;
  PG8_WAIT_V(4); PG8_BAR;
  PG8_STAGE(PG8_SB(1, 0), cB + kstep, voffB); PG8_STAGE(PG8_SA(1, 0), cA + kstep, voffA); PG8_STAGE(PG8_SB(1, 1), cB + hstepB + kstep, voffB);
  PG8_WAIT_V(6); PG8_BAR;
  for (;;) {
    const bool has_next = S.next(ui + 1, nxt);
    const char* nA = has_next ? (const char*)A + (size_t)nxt.pm * tstepA : cA;
    const char* nB = has_next ? (const char*)Bt + (size_t)nxt.pn * tstepB : cB;
    for (int t = 0; t < nt; t += 2) {
      const bool last = (t == nt - 2);
      const char* a1 = cA + (size_t)(t + 1) * kstep;
      const char* a2 = last ? nA : cA + (size_t)(t + 2) * kstep;
      const char* b2 = last ? nB : cB + (size_t)(t + 2) * kstep;
      const char* a3 = a2 + kstep;
      const char* b3 = b2 + kstep;
      PG8_LDB(B0, 0, 0); PG8_SCHED; PG8_LDA(At, 0, 0); PG8_STAGE(PG8_SA(1, 1), a1 + hstepA, voffA);
      PG8_WAIT_L(8); PG8_BAR; PG8_WAIT_L(0); PG8_MMA(0, 0, At, B0); PG8_BAR; PG8_SCHED;
      PG8_LDB(B1, 0, 1); PG8_STAGE(PG8_SB(0, 0), b2, voffB);
      PG8_BAR; PG8_WAIT_L(0); PG8_MMA(0, 1, At, B1); PG8_BAR;
      PG8_LDA(At, 0, 1); PG8_STAGE(PG8_SA(0, 0), a2, voffA);
      PG8_BAR; PG8_WAIT_L(0); PG8_MMA(1, 0, At, B0); PG8_BAR; PG8_SCHED;
      PG8_STAGE(PG8_SB(0, 1), b2 + hstepB, voffB);
      PG8_WAIT_V(6); PG8_BAR; PG8_MMA(1, 1, At, B1); PG8_BAR;
      PG8_LDB(B0, 1, 0); PG8_SCHED; PG8_LDA(At, 1, 0); PG8_STAGE(PG8_SA(0, 1), a2 + hstepA, voffA);
      PG8_WAIT_L(8); PG8_BAR; PG8_WAIT_L(0); PG8_MMA(0, 0, At, B0); PG8_BAR; PG8_SCHED;
      PG8_LDB(B1, 1, 1); PG8_STAGE(PG8_SB(1, 0), b3, voffB);
      PG8_BAR; PG8_WAIT_L(0); PG8_MMA(0, 1, At, B1); PG8_BAR;
      PG8_LDA(At, 1, 1); PG8_STAGE(PG8_SA(1, 0), a3, voffA);
      PG8_BAR; PG8_WAIT_L(0); PG8_MMA(1, 0, At, B0); PG8_BAR; PG8_SCHED;
      PG8_STAGE(PG8_SB(1, 1), b3 + hstepB, voffB);
      PG8_WAIT_V(6); PG8_BAR; PG8_MMA(1, 1, At, B1); PG8_BAR;
    }
    E(acc, cur, wr, wc, fr, fq);
    if (!has_next) break;
#pragma unroll
    for (int a = 0; a < 2; ++a)
#pragma unroll
      for (int b = 0; b < 2; ++b)
#pragma unroll
        for (int m = 0; m < 4; ++m)
#pragma unroll
          for (int n = 0; n < 2; ++n) acc[a][b][m][n] = (f32x4){0.f, 0.f, 0.f, 0.f};
    cur = nxt; cA = nA; cB = nB; ++ui;
  }
  PG8_WAIT_V(0);
  if (wr == 0) PG8_BAR;
  PG8_BAR;
#undef PG8_SA
#undef PG8_SB
#undef PG8_STAGE
#undef PG8_LDA
#undef PG8_LDB
#undef PG8_MMA
#undef PG8_WAIT_V
#undef PG8_WAIT_L
#undef PG8_BAR
#undef PG8_SCHED
}

struct EpiInProjT {
  const Params& P;
  int l;
  DEV void operator()(const f32x4 (&acc)[2][2][4][2], const Unit& u, int wr, int wc, int fr, int fq) const {
#pragma unroll
    for (int bj = 0; bj < 2; ++bj) {
      const int cg = u.pn * 256 + bj * 128 + wc * 32;
      if (cg >= 4368) continue;
#pragma unroll
      for (int ai = 0; ai < 2; ++ai)
#pragma unroll
        for (int m = 0; m < 4; ++m) {
          const int row = u.pm * 256 + ai * 128 + wr * 64 + m * 16 + fr;
          const f32x4 v0 = acc[ai][bj][m][0], v1 = acc[ai][bj][m][1];
          if (cg < C_WQ) {
            u16* dst = WS_P(P) + (size_t)row * PW + cg + 4 * fq;
            *reinterpret_cast<uint2*>(dst) = make_uint2(pack2(v0[0], v0[1]), pack2(v0[2], v0[3]));
            *reinterpret_cast<uint2*>(dst + 16) = make_uint2(pack2(v1[0], v1[1]), pack2(v1[2], v1[3]));
          } else if (cg < 3712) {
            const bool isq = (cg < C_WK) || (cg >= C_DQ && cg < C_DK);
            const float qs = isq ? 0.125f : 1.f;
            u16* dst = WS_P(P) + (size_t)row * PW + cg + 4 * fq;
            float o1[4], o2[4];
            if (row < NLAT) {
              const int t = row & (T - 1), hf = (cg >> 5) & 1;
              const float4* rt = reinterpret_cast<const float4*>(WS_ROPE(P) + ((size_t)t * 32 + hf * 16 + 4 * fq) * 2);
              const float4 c01 = rt[0], c23 = rt[1];
              const float cs[4] = {c01.x, c01.z, c23.x, c23.z}, sn[4] = {c01.y, c01.w, c23.y, c23.w};
#pragma unroll
              for (int e = 0; e < 4; ++e) { o1[e] = (v0[e] * cs[e] - v1[e] * sn[e]) * qs; o2[e] = (v1[e] * cs[e] + v0[e] * sn[e]) * qs; }
            } else {
#pragma unroll
              for (int e = 0; e < 4; ++e) { o1[e] = v0[e] * qs; o2[e] = v1[e] * qs; }
            }
            *reinterpret_cast<uint2*>(dst) = make_uint2(pack2(o1[0], o1[1]), pack2(o1[2], o1[3]));
            *reinterpret_cast<uint2*>(dst + 16) = make_uint2(pack2(o2[0], o2[1]), pack2(o2[2], o2[3]));
          } else if (cg < 4352) {
            int b, key;
            if (row < NLAT) { b = row >> 12; key = 256 + (row & (T - 1)); }
            else { b = (row - NLAT) >> 8; key = (row - NLAT) & 255; }
            u16* base;
            int v0i;
            if (cg < 3840) { base = WS_VTW(P) + ((size_t)(b * 2 + ((cg - 3712) >> 6)) * 64) * KEYS; v0i = (cg - 3712) & 63; }
            else { base = WS_VTD(P) + ((size_t)(b * 4 + ((cg - 3840) >> 7)) * 128) * KEYS; v0i = (cg - 3840) & 127; }
#pragma unroll
            for (int e = 0; e < 4; ++e) {
              base[(size_t)(v0i + 4 * fq + e) * KEYS + key] = f2bf(v0[e]);
              base[(size_t)(v0i + 16 + 4 * fq + e) * KEYS + key] = f2bf(v1[e]);
            }
          } else {
            const float4 bg = *reinterpret_cast<const float4*>(P.b_gate + l * 16 + 4 * fq);
            *reinterpret_cast<float4*>(WS_GATES(P) + (size_t)row * 16 + 4 * fq) = make_float4(v0[0] + bg.x, v0[1] + bg.y, v0[2] + bg.z, v0[3] + bg.w);
          }
        }
    }
  }
};
struct EpiResidT {
  const Params& P;
  const float* src_lat;
  const float* modl;
  int gt_off;
  DEV void operator()(const f32x4 (&acc)[2][2][4][2], const Unit& u, int wr, int wc, int fr, int fq) const {
#pragma unroll
    for (int ai = 0; ai < 2; ++ai)
#pragma unroll
      for (int m = 0; m < 4; ++m) {
        const int row = u.pm * 256 + ai * 128 + wr * 64 + m * 16 + fr;
        const float* src;
        float* dst;
        int cond;
        if (row < NLAT) { src = src_lat + (size_t)row * 1024; dst = P.out + (size_t)row * 1024; cond = row >> 12; }
        else { src = WS_XC(P) + (size_t)(row - NLAT) * 1024; dst = WS_XC(P) + (size_t)(row - NLAT) * 1024; cond = 16; }
        const float* gt = modl + (size_t)cond * 6144 + gt_off;
#pragma unroll
        for (int bj = 0; bj < 2; ++bj)
#pragma unroll
          for (int n = 0; n < 2; ++n) {
            const int col = u.pn * 256 + bj * 128 + wc * 32 + n * 16 + 4 * fq;
            const float4 s4 = *reinterpret_cast<const float4*>(src + col), g4 = *reinterpret_cast<const float4*>(gt + col);
            const f32x4 a = acc[ai][bj][m][n];
            *reinterpret_cast<float4*>(dst + col) = make_float4(s4.x + g4.x * a[0], s4.y + g4.y * a[1], s4.z + g4.z * a[2], s4.w + g4.w * a[3]);
          }
      }
  }
};
struct EpiSwigluT {
  u16* act;
  DEV void operator()(const f32x4 (&acc)[2][2][4][2], const Unit& u, int wr, int wc, int fr, int fq) const {
#pragma unroll
    for (int ai = 0; ai < 2; ++ai)
#pragma unroll
      for (int m = 0; m < 4; ++m) {
        const int row = u.pm * 256 + ai * 128 + wr * 64 + m * 16 + fr;
#pragma unroll
        for (int bj = 0; bj < 2; ++bj) {
          const int cg = u.pn * 256 + bj * 128 + wc * 32;
          const f32x4 g = acc[ai][bj][m][0], up = acc[ai][bj][m][1];
          *reinterpret_cast<uint2*>(act + (size_t)row * FH + (cg >> 1) + 4 * fq) =
              make_uint2(pack2(siluf_(g[0]) * up[0], siluf_(g[1]) * up[1]), pack2(siluf_(g[2]) * up[2], siluf_(g[3]) * up[3]));
        }
      }
  }
};
}


#ifdef SELFCHECK
#define DBGF(P) reinterpret_cast<float*>((P).ws + O_XC + (size_t)NCTXR * 1024 * 4)
DEV float blk_reduce(float v, bool ismax, float* red) {
  const int tid = my_tid(), lane = tid & 63, wid = tid >> 6;
#pragma unroll
  for (int o = 32; o > 0; o >>= 1) { float t = __shfl_xor(v, o); v = ismax ? fmaxf(v, t) : v + t; }
  __syncthreads();
  if (lane == 0) red[wid] = v;
  __syncthreads();
  float r = red[0];
  for (int i = 1; i < 8; ++i) r = ismax ? fmaxf(r, red[i]) : r + red[i];
  __syncthreads();
  return r;
}
DEV void chk_sample(int s, int& b, int& hd, int& t) {
  const int ti = s & 7;
  b = (s * 5 + 3) & 15; hd = s & 7;
  t = ti == 0 ? 0 : ti == 1 ? 63 : ti == 2 ? 64 : ti == 3 ? 127 : ti == 4 ? 2048 + 65 : ti == 5 ? 3000 : ti == 6 ? 4032 : 4095;
}
DEV void check_pre(const Params& P, int l, char* smem) {
  const int tid = my_tid();
  float* sc = reinterpret_cast<float*>(smem);
  float* red = sc + 2 * 4352;
  float* ov = red + 16;
  float* dbg = DBGF(P);
  const u16* p = WS_P(P);
  for (int it = blockIdx.x; it < 24; it += gridDim.x) {
    const bool isdiff = it >= 12;
    const int s = isdiff ? it - 12 : it;
    int b, hd, t;
    chk_sample(s, b, hd, t);
    const bool ctxq = s >= 8;
    if (ctxq) t &= 255;
    const size_t row = ctxq ? (size_t)NLAT + b * 256 + t : (size_t)b * T + t;
    __syncthreads();
    if (!isdiff) {
      const int head = hd, g = head >> 2;
      const int lo = ctxq ? 0 : max(0, t - 128), hi = ctxq ? -1 : min(T - 1, t + 128);
      const int nk = 256 + (hi - lo + 1);
      float mx = -1e30f;
      for (int k = tid; k < nk; k += NTHREADS) {
        size_t krow = k < 256 ? (size_t)NLAT + b * 256 + k : (size_t)b * T + lo + (k - 256);
        float a = 0.f;
        for (int d = 0; d < 64; ++d) a += bf2f(p[row * PW + C_WQ + head * 64 + d]) * bf2f(p[krow * PW + C_WK + g * 64 + d]);
        sc[k] = a;
        mx = fmaxf(mx, a);
      }
      mx = blk_reduce(mx, true, red);
      const float sk = P.sink[l * 8 + head];
      mx = fmaxf(mx, sk);
      float sm = 0.f;
      for (int k = tid; k < nk; k += NTHREADS) { float e = expf(sc[k] - mx); sc[k] = e; sm += e; }
      sm = blk_reduce(sm, false, red) + expf(sk - mx);
      if (tid < 64) {
        float o = 0.f;
        for (int k = 0; k < nk; ++k) {
          int kidx = k < 256 ? k : 256 + lo + (k - 256);
          o += sc[k] * bf2f(WS_VTW(P)[((size_t)(b * 2 + g) * 64 + tid) * KEYS + kidx]);
        }
        dbg[it * 128 + tid] = o / sm;
      }
    } else {
      const int h = hd & 3;
      const int nk = ctxq ? 256 : KEYS;
      float mx0 = -1e30f, mx1 = -1e30f;
      for (int k = tid; k < nk; k += NTHREADS) {
        size_t krow = k < 256 ? (size_t)NLAT + b * 256 + k : (size_t)b * T + (k - 256);
        float a0 = 0.f, a1 = 0.f;
        for (int d = 0; d < 64; ++d) {
          a0 += bf2f(p[row * PW + C_DQ + h * 128 + d]) * bf2f(p[krow * PW + C_DK + h * 128 + d]);
          a1 += bf2f(p[row * PW + C_DQ + h * 128 + 64 + d]) * bf2f(p[krow * PW + C_DK + h * 128 + 64 + d]);
        }
        sc[k] = a0; sc[4352 + k] = a1;
        mx0 = fmaxf(mx0, a0); mx1 = fmaxf(mx1, a1);
      }
      mx0 = blk_reduce(mx0, true, red);
      mx1 = blk_reduce(mx1, true, red);
      float s0 = 0.f, s1 = 0.f;
      for (int k = tid; k < nk; k += NTHREADS) {
        float e0 = expf(sc[k] - mx0), e1 = expf(sc[4352 + k] - mx1);
        sc[k] = e0; sc[4352 + k] = e1; s0 += e0; s1 += e1;
      }
      s0 = blk_reduce(s0, false, red);
      s1 = blk_reduce(s1, false, red);
      const float lam = WS_LAM(P)[l], lam_init = 0.8f - 0.6f * expf(-0.3f * (float)l);
      float y = 0.f;
      if (tid < 128) {
        for (int k = 0; k < nk; ++k)
          y += (sc[k] / s0 - lam * sc[4352 + k] / s1) * bf2f(WS_VTD(P)[((size_t)(b * 4 + h) * 128 + tid) * KEYS + k]);
        ov[tid] = y;
      }
      __syncthreads();
      if (tid < 128) {
        float ss = 0.f;
        for (int v = 0; v < 128; ++v) ss += ov[v] * ov[v];
        dbg[it * 128 + tid] = y * rsqrtf(ss / 128.f + EPS) * P.d_norm[l * 512 + h * 128 + tid] * (1.f - lam_init);
      }
    }
  }
}
DEV void check_post(const Params& P, int l, unsigned* flags) {
  const int tid = my_tid();
  const float* dbg = DBGF(P);
  const u16* p = WS_P(P);
  for (int it = blockIdx.x; it < 24; it += gridDim.x) {
    const bool isdiff = it >= 12;
    const int s = isdiff ? it - 12 : it;
    int b, hd, t;
    chk_sample(s, b, hd, t);
    const bool ctxq = s >= 8;
    if (ctxq) t &= 255;
    const size_t row = ctxq ? (size_t)NLAT + b * 256 + t : (size_t)b * T + t;
    if (ctxq && l != 0) continue;
    const int n = isdiff ? 128 : 64;
    if (tid < n) {
      float got = isdiff ? bf2f(p[row * PW + C_DQ + (hd & 3) * 128 + tid]) : bf2f(p[row * PW + C_WQ + hd * 64 + tid]);
      float ex = dbg[it * 128 + tid];
      if (!(fabsf(got - ex) <= 0.03f + 0.03f * fabsf(ex))) atomicOr(flags, isdiff ? (ctxq ? 32u : 2u) : (ctxq ? 16u : 1u));
    }
  }
}
DEV void check_mlstm(const Params& P, int l, char* smem, unsigned* flags) {
  const int tid = my_tid(), lane = tid & 63;
  float* qs = reinterpret_cast<float*>(smem);
  float* ks = qs + 128;
  float* vs = ks + 128;
  float* nn = vs + 128;
  float* sc = nn + 128;
  float* red = sc + 8;
  const u16* p = WS_P(P);
  for (int it = blockIdx.x; it < 4; it += gridDim.x) {
    const int b = (it * 7 + 2) & 15, hd = (it + 1) & 3, dir = it & 1;
    const int v = tid >> 2, kq = tid & 3;
    float C[32];
#pragma unroll
    for (int j = 0; j < 32; ++j) C[j] = 0.f;
    __syncthreads();
    if (tid < 128) nn[tid] = 0.f;
    if (tid == 0) sc[0] = 0.f;
    __syncthreads();
    const int nsteps = (l == 0) ? 256 + T : 256 + T;
    for (int st = 0; st < nsteps; ++st) {
      int seg0, seglen, u;
      if (st < 256) { seg0 = NLAT + b * 256; seglen = 256; u = dir ? 255 - st : st; }
      else { seg0 = b * T; seglen = T; u = dir ? T - 1 - (st - 256) : st - 256; }
      const size_t row = (size_t)seg0 + u;
      if (tid < 128) {
        float xq = 0.f, xk = 0.f;
        for (int tp = 0; tp < 3; ++tp) {
          int uu = u + tp - 1;
          if (uu >= 0 && uu < seglen) {
            xq += P.conv_w[(size_t)l * 3072 + tp * 1024 + hd * 128 + tid] * bf2f(p[((size_t)seg0 + uu) * PW + C_MQ + hd * 128 + tid]);
            xk += P.conv_w[(size_t)l * 3072 + tp * 1024 + 512 + hd * 128 + tid] * bf2f(p[((size_t)seg0 + uu) * PW + C_MK + hd * 128 + tid]);
          }
        }
        qs[tid] = xq / (1.f + expf(-xq));
        ks[tid] = xk / (1.f + expf(-xk)) * 0.08838834764831845f;
        vs[tid] = bf2f(p[row * PW + C_MV + hd * 128 + tid]);
      }
      if (tid == 0) {
        float ig = WS_GATES(P)[row * 16 + dir * 8 + hd], fg = WS_GATES(P)[row * 16 + dir * 8 + 4 + hd];
        float lf = fminf(fg, 0.f) - log1pf(expf(-fabsf(fg)));
        float m = sc[0], mn = fmaxf(lf + m, ig);
        sc[1] = expf(lf + m - mn);
        sc[2] = expf(ig - mn);
        sc[3] = mn;
      }
      __syncthreads();
      const float fd = sc[1], iw = sc[2], mn = sc[3];
      float pd = 0.f;
#pragma unroll
      for (int j = 0; j < 32; ++j) {
        C[j] = fd * C[j] + iw * vs[v] * ks[kq * 32 + j];
        pd += C[j] * qs[kq * 32 + j];
      }
      pd += __shfl_xor(pd, 1);
      pd += __shfl_xor(pd, 2);
      float dn = 0.f;
      if (tid < 128) { float nv = fd * nn[tid] + iw * ks[tid]; nn[tid] = nv; dn = nv * qs[tid]; }
      dn = blk_reduce(dn, false, red);
      if (tid == 0) sc[0] = mn;
      const float hval = pd / fmaxf(fabsf(dn), expf(-mn));
      float sq = (kq == 0) ? hval * hval : 0.f;
      sq = blk_reduce(sq, false, red);
      const float rms = sqrtf(sq / 128.f);
      const bool cmp = (st < 256) ? (l == 0) : true;
      if (cmp && kq == 0 && ((u & 63) == 0 || (u & 63) == 63 || (u % 97) == 0)) {
        float got = bf2f(WS_HFB(P)[(size_t)dir * MTOT * 512 + row * 512 + hd * 128 + v]);
        if (!(fabsf(got - hval) <= 0.05f * rms + 0.05f * fabsf(hval) + 1e-3f)) atomicOr(flags, dir ? 8u : 4u);
      }
    }
  }
}
#endif


#ifdef SELFCHECK
DEV void flag_if(bool bad, unsigned* flags, unsigned bit) { if (bad) atomicOr(flags, bit); }
DEV bool close_(float got, float ex, float tol) { return fabsf(got - ex) <= tol + tol * fabsf(ex); }
DEV void check_inproj(const Params& P, int l, char* smem, unsigned* flags) {
  const int tid = my_tid();
  float* red = reinterpret_cast<float*>(smem);
  float* hrow = red + 16;
  const float* modl = WS_MOD(P) + (size_t)l * 17 * 6144;
  for (int it = blockIdx.x; it < 64; it += gridDim.x) {
    const int ri = it & 7;
    const int row = ri == 0 ? 0 : ri == 1 ? 4095 : ri == 2 ? 4096 + 77 : ri == 3 ? 30000 : ri == 4 ? 65535 : ri == 5 ? NLAT : ri == 6 ? NLAT + 300 : MTOT - 1;
    const int cond = row < NLAT ? row >> 12 : 16;
    {
      int col = (it * 769 + 5) % 6144;
      float a = 0.f;
      for (int k = tid; k < 1024; k += NTHREADS) {
        float cv = cond < 16 ? P.c[cond * 1024 + k] : P.c_ctx[k];
        a += cv / (1.f + expf(-cv)) * P.w_mod[(size_t)l * 1024 * 6144 + (size_t)k * 6144 + col];
      }
      a = blk_reduce(a, false, red) + P.b_mod[l * 6144 + col];
      if (tid == 0) flag_if(!close_(modl[(size_t)cond * 6144 + col], a, 2e-3f), flags, 1u);
    }
    const float* xs = row < NLAT ? ((l == 0 ? P.x : P.out) + (size_t)row * 1024) : (WS_XC(P) + (size_t)(row - NLAT) * 1024);
    float ss = 0.f;
    for (int k = tid; k < 1024; k += NTHREADS) ss += xs[k] * xs[k];
    ss = blk_reduce(ss, false, red);
    const float rstd = rsqrtf(ss / 1024.f + EPS);
    for (int k = tid; k < 1024; k += NTHREADS) {
      float y = xs[k] * rstd * P.g_mix[l * 1024 + k] * (1.f + modl[(size_t)cond * 6144 + 1024 + k]) + modl[(size_t)cond * 6144 + k];
      hrow[k] = y;
      flag_if(!close_(bf2f(WS_H(P)[(size_t)row * 1024 + k]), y, 1e-2f), flags, 2u);
    }
    __syncthreads();
    const int oi = it >> 3;
    const int oj = (oi * 2 + (it & 1)) & 15;
    const int oc = oj == 0 ? 3 : oj == 1 ? 600 : oj == 2 ? 1100 : oj == 3 ? 1999 : oj == 4 ? 2050 : oj == 5 ? 2064 + 70 : oj == 6 ? 2576 + 100 :
                   oj == 7 ? 2704 + 5 : oj == 8 ? 2832 + 200 : oj == 9 ? 2832 + 37 : oj == 10 ? 3344 + 90 : oj == 11 ? 3344 + 300 :
                   oj == 12 ? 3856 + 10 : oj == 13 ? 3856 + 500 : oj == 14 ? 2048 + 15 : 2064 + 500;
    auto dotcol = [&](int c) {
      float a = 0.f;
      for (int k = tid; k < 1024; k += NTHREADS) a += hrow[k] * P.w_in[(size_t)l * 1024 * INW + (size_t)k * INW + c];
      return blk_reduce(a, false, red);
    };
    float val = dotcol(oc);
    const u16* p = WS_P(P);
    const bool lat = row < NLAT;
    const int t = row & (T - 1);
    float got = 0.f, ex = val;
    unsigned bit = 4u;
    if (oc < 2048) { got = bf2f(p[(size_t)row * PW + oc]); }
    else if (oc < 2064) { got = WS_GATES(P)[(size_t)row * 16 + oc - 2048]; ex = val + P.b_gate[l * 16 + oc - 2048]; }
    else if (oc >= 2704 && oc < 2832) {
      int cgi = oc - 2704, g = cgi >> 6, vd = cgi & 63;
      int b = lat ? row >> 12 : (row - NLAT) >> 8, key = lat ? 256 + t : (row - NLAT) & 255;
      got = bf2f(WS_VTW(P)[((size_t)(b * 2 + g) * 64 + vd) * KEYS + key]);
      bit = 8u;
    } else if (oc >= 3856) {
      int cgi = oc - 3856, h = cgi >> 7, vd = cgi & 127;
      int b = lat ? row >> 12 : (row - NLAT) >> 8, key = lat ? 256 + t : (row - NLAT) & 255;
      got = bf2f(WS_VTD(P)[((size_t)(b * 4 + h) * 128 + vd) * KEYS + key]);
      bit = 8u;
    } else {
      int base, nb0;
      bool isq;
      if (oc < 2576) { base = 2064; nb0 = C_WQ; isq = true; }
      else if (oc < 2704) { base = 2576; nb0 = C_WK; isq = false; }
      else if (oc < 3344) { base = 2832; nb0 = C_DQ; isq = true; }
      else { base = 3344; nb0 = C_DK; isq = false; }
      int rel = oc - base, dd = rel & 63, j = dd & 15, second = (dd >> 4) & 1, axis = dd >> 5;
      float other = dotcol(second ? oc - 16 : oc + 16);
      if (lat) {
        int pos = axis ? (t & 63) : (t >> 6);
        float ang = (float)pos * powf(10000.f, -(float)j / 16.f);
        float cs = cosf(ang), sn = sinf(ang);
        ex = second ? (val * cs + other * sn) : (val * cs - other * sn);
      }
      if (isq) ex *= 0.125f;
      got = bf2f(p[(size_t)row * PW + nb0 + rel]);
      bit = 16u;
    }
    if (tid == 0) flag_if(!close_(got, ex, 3e-2f), flags, bit);
    __syncthreads();
  }
}
DEV void check_post6(const Params& P, int l, char* smem, unsigned* flags, const float* xprev) {
  const int tid = my_tid();
  float* red = reinterpret_cast<float*>(smem);
  const u16* Yp = WS_P(P);
  const float* modl = WS_MOD(P) + (size_t)l * 17 * 6144;
  for (int it = blockIdx.x; it < 16; it += gridDim.x) {
    const int ri = it & 7;
    const int row = ri == 0 ? 1 : ri == 1 ? 4097 : ri == 2 ? 12345 : ri == 3 ? 40000 : ri == 4 ? 65534 : ri == 5 ? NLAT + 1 : ri == 6 ? NLAT + 2000 : MTOT - 2;
    if (row >= NLAT && l != 0) continue;
    const int col = (it * 331 + 17) & 1023;
    const int cond = row < NLAT ? row >> 12 : 16;
    float mg = 0.f;
    for (int i = 0; i < 3; ++i) {
      float a = 0.f, z = 0.f;
      for (int k = tid; k < 1024; k += NTHREADS) a += bf2f(WS_H(P)[(size_t)row * 1024 + k]) * P.w_in[(size_t)l * 1024 * INW + (size_t)k * INW + 4368 + i * 1024 + col];
      a = blk_reduce(a, false, red);
      const int yc = i == 0 ? C_MO : (i == 1 ? C_WQ : C_DQ);
      for (int k = tid; k < 512; k += NTHREADS) z += bf2f(Yp[(size_t)row * PW + yc + k]) * P.w_branch[((size_t)l * 3 + i) * 512 * 1024 + (size_t)k * 1024 + col];
      z = blk_reduce(z, false, red);
      mg += z / (1.f + expf(-a));
    }
    if (tid == 0) flag_if(!close_(bf2f(WS_HFB(P)[(size_t)row * 1024 + col]), mg, 3e-2f), flags, 1u);
    float o = 0.f;
    for (int k = tid; k < 1024; k += NTHREADS) o += bf2f(WS_HFB(P)[(size_t)row * 1024 + k]) * P.w_out[(size_t)l * 1024 * 1024 + (size_t)k * 1024 + col];
    o = blk_reduce(o, false, red);
    const float xo = row < NLAT ? xprev[(size_t)row * 1024 + col] : -1e9f;
    const float xn = row < NLAT ? P.out[(size_t)row * 1024 + col] : WS_XC(P)[(size_t)(row - NLAT) * 1024 + col];
    if (tid == 0 && row < NLAT && (l == 0)) flag_if(!close_(xn, xo + modl[(size_t)cond * 6144 + 2048 + col] * o, 2e-2f), flags, 2u);
    if (tid == 0) DBGF(P)[4096 + it] = xn;
  }
}
DEV void check_post9(const Params& P, int l, char* smem, unsigned* flags) {
  const int tid = my_tid();
  float* red = reinterpret_cast<float*>(smem);
  const float* modl = WS_MOD(P) + (size_t)l * 17 * 6144;
  for (int it = blockIdx.x; it < 16; it += gridDim.x) {
    const int ri = it & 7;
    const int row = ri == 0 ? 1 : ri == 1 ? 4097 : ri == 2 ? 12345 : ri == 3 ? 40000 : ri == 4 ? 65534 : ri == 5 ? NLAT + 1 : ri == 6 ? NLAT + 2000 : MTOT - 2;
    if (row >= NLAT && l != 0) continue;
    const int col = (it * 331 + 17) & 1023;
    const int cond = row < NLAT ? row >> 12 : 16;
    const int j = (it * 97 + 13) % FH;
    float g = 0.f, u = 0.f;
    for (int k = tid; k < 1024; k += NTHREADS) {
      float hv = bf2f(WS_H(P)[(size_t)row * 1024 + k]);
      g += hv * P.w_ffn_in[(size_t)l * 1024 * 5632 + (size_t)k * 5632 + j];
      u += hv * P.w_ffn_in[(size_t)l * 1024 * 5632 + (size_t)k * 5632 + FH + j];
    }
    g = blk_reduce(g, false, red);
    u = blk_reduce(u, false, red);
    if (tid == 0) flag_if(!close_(bf2f(WS_P(P)[(size_t)row * FH + j]), g / (1.f + expf(-g)) * u, 3e-2f), flags, 4u);
    float o = 0.f;
    for (int k = tid; k < FH; k += NTHREADS) o += bf2f(WS_P(P)[(size_t)row * FH + k]) * P.w_ffn_out[(size_t)l * FH * 1024 + (size_t)k * 1024 + col];
    o = blk_reduce(o, false, red);
    const float xn = row < NLAT ? P.out[(size_t)row * 1024 + col] : WS_XC(P)[(size_t)(row - NLAT) * 1024 + col];
    if (tid == 0) flag_if(!close_(xn, DBGF(P)[4096 + it] + modl[(size_t)cond * 6144 + 5120 + col] * o, 2e-2f), flags, 8u);
  }
}
#endif

#ifdef DEBUG_STAGE
DEV void debug_dump(const Params& P, int stage) {
  const int tid = my_tid();
  for (size_t idx = (size_t)blockIdx.x * NTHREADS + tid; idx < (size_t)NLAT * 1024; idx += (size_t)gridDim.x * NTHREADS) {
    size_t row = idx >> 10;
    int c = (int)(idx & 1023);
    size_t r2 = row + (row < 4096 ? NLAT : 0);
    float v = 0.f;
    const u16* p = WS_P(P);
    if (stage == 1) {
      v = bf2f(p[row * PW + c]) + bf2f(p[row * PW + 1024 + c]) + bf2f(p[row * PW + 2048 + c]) + (c < 640 ? bf2f(p[row * PW + 3072 + c]) : 0.f);
      v += bf2f(p[r2 * PW + c]) + bf2f(p[r2 * PW + 1024 + c]) + bf2f(p[r2 * PW + 2048 + c]);
      v += bf2f(WS_VTD(P)[r2 * 512 + (c & 511)]) + bf2f(WS_VTW(P)[r2 * 128 + (c & 127)]) + WS_GATES(P)[r2 * 16 + (c & 15)];
      v += bf2f(WS_VTD(P)[row * 512 + (c & 511)]) + bf2f(WS_VTW(P)[row * 128 + (c & 127)]) + WS_GATES(P)[row * 16 + (c & 15)];
    } else if (stage == 21) {
      v = bf2f(WS_HFB(P)[row * 512 + (c & 511)]) + 2.f * bf2f(WS_HFB(P)[(size_t)MTOT * 512 + row * 512 + (c & 511)]);
      v += bf2f(WS_HFB(P)[r2 * 512 + (c & 511)]) + 2.f * bf2f(WS_HFB(P)[(size_t)MTOT * 512 + r2 * 512 + (c & 511)]);
    } else if (stage == 22) {
      v = bf2f(p[row * PW + C_WQ + (c & 511)]) + bf2f(p[r2 * PW + C_WQ + (c & 511)]);
    } else if (stage == 23) {
      v = bf2f(p[row * PW + C_DQ + (c & 511)]) + bf2f(p[r2 * PW + C_DQ + (c & 511)]);
    } else if (stage == 3) {
      v = bf2f(WS_HFB(P)[row * 1024 + c]) + bf2f(WS_HFB(P)[r2 * 1024 + c]);
    } else if (stage == 4) {
      v = P.out[idx] + WS_XC(P)[(row & 4095) * 1024 + c];
    } else if (stage == 5) {
      v = bf2f(WS_H(P)[row * 1024 + c]) + bf2f(WS_H(P)[r2 * 1024 + c]);
    } else if (stage == 6) {
      v = bf2f(p[row * FH + c]) + bf2f(p[row * FH + 1024 + c]) + bf2f(p[r2 * FH + 1792 + c]);
    }
    if (stage != 4) P.out[idx] = v; else P.out[idx] = v;
  }
}
#define DBG(st) if (l == 0 && DEBUG_STAGE == st) { GSYNC_ONLY(); debug_dump(P, st); return true; }
#else
#define DBG(st)
#endif
template <int l>
DEV bool layer_body(const Params& P, unsigned* bar, unsigned& epoch, char* smem) {
  constexpr bool need_ctx = (l == 0);
  const float* modl = WS_MOD(P) + (size_t)l * 17 * 6144;
  const u16* Wl = WS_W(P) + (size_t)l * W_LAYER;
  const float* xlat = l == 0 ? P.x : P.out;
  constexpr int Mtok = need_ctx ? MTOT : NLAT;
  phase_norm_mod(P, xlat, WS_XC(P), MTOT, P.g_mix + l * 1024, modl, 0, 1024);
  GSYNC();
  pg8::gemm_phase(smem, WS_H(P), 1024, Wl + W_IN, 1024, MTOT, NIN, 1024, pg8::EpiInProjT{P, l});
#ifdef REPEAT_GEMMS
  if (l == 1) pg8::gemm_phase(smem, WS_H(P), 1024, Wl + W_IN, 1024, MTOT, NIN, 1024, pg8::EpiInProjT{P, l});
#endif
  GSYNC();
  DBG(1)
#ifdef SELFCHECK
#if SELFCHECK == 2
  check_inproj(P, l, smem, WS_CTR(P) + 16 + l * 3);
#else
  check_pre(P, l, smem);
#endif
  GSYNC();
#endif
  phase_mixers(P, l, smem);
  GSYNC();
#if defined(SELFCHECK) && SELFCHECK == 1
  check_post(P, l, WS_CTR(P) + 17 + l * 3);
  check_mlstm(P, l, smem, WS_CTR(P) + 17 + l * 3);
  GSYNC();
#endif
  DBG(21)
  DBG(22)
  DBG(23)
  phase_ya(P, l, Mtok);
  GSYNC();
  phase_merge(P, l, Mtok, smem);
#ifdef REPEAT_GEMMS
  if (l == 1) phase_merge(P, l, Mtok, smem);
#endif
  GSYNC();
  DBG(3)
  pg8::gemm_phase(smem, WS_HFB(P), 1024, Wl + W_O, 1024, Mtok, 1024, 1024, pg8::EpiResidT{P, xlat, modl, 2048});
  GSYNC();
#if defined(SELFCHECK) && SELFCHECK == 2
  check_post6(P, l, smem, WS_CTR(P) + 18 + l * 3, xlat);
  GSYNC();
#endif
  DBG(4)
  phase_norm_mod(P, P.out, WS_XC(P), Mtok, P.g_ffn + l * 1024, modl, 3072, 4096);
  GSYNC();
  DBG(5)
  pg8::gemm_phase(smem, WS_H(P), 1024, Wl + W_FI, 1024, Mtok, 5632, 1024, pg8::EpiSwigluT{WS_P(P)});
#ifdef REPEAT_GEMMS
  if (l == 1) pg8::gemm_phase(smem, WS_H(P), 1024, Wl + W_FI, 1024, Mtok, 5632, 1024, pg8::EpiSwigluT{WS_P(P)});
#endif
  GSYNC();
  DBG(6)
  pg8::gemm_phase(smem, WS_P(P), FH, Wl + W_FO, FH, Mtok, 1024, FH, pg8::EpiResidT{P, P.out, modl, 5120});
  GSYNC();
#if defined(SELFCHECK) && SELFCHECK == 2
  check_post9(P, l, smem, WS_CTR(P) + 18 + l * 3);
  GSYNC();
#endif
  return false;
}

__global__ void __launch_bounds__(NTHREADS) fwd_megakernel(Params P) {
  extern __shared__ __attribute__((aligned(16))) char smem[];
  cg::grid_group grid = cg::this_grid();
  unsigned* bar = WS_CTR(P) + 64;
  unsigned epoch = 0;
  grid.sync();
  phase_prologue(P, smem);
  GSYNC();
  if (layer_body<0>(P, bar, epoch, smem)) return;
  if (layer_body<1>(P, bar, epoch, smem)) return;
  phase_final_norm(P);
#ifdef SELFCHECK
  GSYNC();
  if (blockIdx.x == 0 && my_tid() == 0) {
    float scale = 1000.f;
    for (int w = 0; w < 6; ++w) {
      unsigned f = WS_CTR(P)[16 + w];
      if (f) { P.out[0] = (10.f + (float)f) * scale; break; }
      scale *= 10.f;
    }
  }
#endif
}

extern "C" void kernel_launch(void* const* d_in, const int* in_sizes, int n_in, void* d_out, int out_size, void* d_ws,
                              size_t ws_size, hipStream_t stream) {
  static int grid_blocks = 0;
  if (!grid_blocks) {
    int dev = 0, cus = 0, per_cu = 0;
    hipGetDevice(&dev);
    hipDeviceGetAttribute(&cus, hipDeviceAttributeMultiprocessorCount, dev);
    hipFuncSetAttribute((const void*)fwd_megakernel, hipFuncAttributeMaxDynamicSharedMemorySize, LDS_BYTES);
    hipOccupancyMaxActiveBlocksPerMultiprocessor(&per_cu, fwd_megakernel, NTHREADS, LDS_BYTES);
    if (per_cu < 1) per_cu = 1;
    if (per_cu > 1) per_cu = 1;
    grid_blocks = cus * per_cu;
  }
  Params P{};
  const float* const* in = reinterpret_cast<const float* const*>(d_in);
  P.x = in[0]; P.c = in[1]; P.ctx = in[2]; P.c_ctx = in[3]; P.w_mod = in[4]; P.b_mod = in[5]; P.g_mix = in[6];
  P.g_ffn = in[7]; P.w_in = in[8]; P.b_gate = in[9]; P.conv_w = in[10]; P.m_norm = in[11]; P.sink = in[12];
  P.lam_q1 = in[13]; P.lam_k1 = in[14]; P.lam_q2 = in[15]; P.lam_k2 = in[16]; P.d_norm = in[17]; P.w_branch = in[18];
  P.w_out = in[19]; P.w_ffn_in = in[20]; P.w_ffn_out = in[21]; P.g_final = in[22];
  P.out = reinterpret_cast<float*>(d_out);
  P.ws = reinterpret_cast<char*>(d_ws);
  if (WS_TOTAL > ws_size) fprintf(stderr, "workspace too small: need %zu have %zu\n", (size_t)WS_TOTAL, ws_size);
  hipMemsetAsync(P.ws + O_CTR, 0, 2048, stream);
  void* args[] = {&P};
  hipError_t e = hipLaunchCooperativeKernel((const void*)fwd_megakernel, dim3(grid_blocks), dim3(NTHREADS), args, LDS_BYTES, stream);
  if (e != hipSuccess) fprintf(stderr, "cooperative launch failed: %s (grid %d)\n", hipGetErrorString(e), grid_blocks);
}
```

```cpp
#include <hip/hip_runtime.h>
#include <hip/hip_cooperative_groups.h>
#include <cstdio>
#include <cstdint>
namespace cg = cooperative_groups;

typedef unsigned short u16;
using bf16x8 = __attribute__((ext_vector_type(8))) short;
using f32x4 = __attribute__((ext_vector_type(4))) float;
using f32x16 = __attribute__((ext_vector_type(16))) float;

#define DEV __device__ __forceinline__

constexpr int D = 1024, NB = 16, T = 4096, TC = 256;
constexpr int NLAT = NB * T;
constexpr int NCTXR = NB * TC;
constexpr int MTOT = NLAT + NCTXR;
constexpr int KEYS = T + TC;
constexpr int INW = 7440;
constexpr int PW = 3712;
constexpr int C_MQ = 0, C_MK = 512, C_MV = 1024, C_MO = 1536, C_WQ = 2048, C_WK = 2560, C_DQ = 2688, C_DK = 3200;
constexpr int NIN = 4608;
constexpr int FH = 2816;
constexpr float EPS = 1e-6f;
constexpr float L2E = 1.4426950408889634f;
constexpr int NTHREADS = 512;
constexpr int LDS_BYTES = 147456;

constexpr size_t W_IN = 0;
constexpr size_t W_G = W_IN + (size_t)NIN * 1024;
constexpr size_t W_B = W_G + (size_t)3072 * 1024;
constexpr size_t W_O = W_B + (size_t)3 * 1024 * 512;
constexpr size_t W_FI = W_O + (size_t)1024 * 1024;
constexpr size_t W_FO = W_FI + (size_t)5632 * 1024;
constexpr size_t W_LAYER = W_FO + (size_t)1024 * FH;

struct Params {
  const float *x, *c, *ctx, *c_ctx, *w_mod, *b_mod, *g_mix, *g_ffn, *w_in, *b_gate, *conv_w, *m_norm, *sink;
  const float *lam_q1, *lam_k1, *lam_q2, *lam_k2, *d_norm, *w_branch, *w_out, *w_ffn_in, *w_ffn_out, *g_final;
  float* out;
  char* ws;
};


constexpr size_t al256(size_t x) { return (x + 255) & ~(size_t)255; }
constexpr size_t O_W = 0;
constexpr size_t O_MOD = O_W + al256(2 * W_LAYER * 2);
constexpr size_t O_ROPE = O_MOD + al256((size_t)2 * 17 * 6144 * 4);
constexpr size_t O_LAM = O_ROPE + al256((size_t)T * 32 * 2 * 4);
constexpr size_t O_CTR = O_LAM + 256;
constexpr size_t O_GATES = O_CTR + 2048;
constexpr size_t O_H = O_GATES + al256((size_t)MTOT * 16 * 4);
constexpr size_t O_P = O_H + al256((size_t)MTOT * 1024 * 2);
constexpr size_t O_VTW = O_P + al256((size_t)MTOT * PW * 2);
constexpr size_t O_VTD = O_VTW + al256((size_t)NB * 2 * 64 * KEYS * 2);
constexpr size_t O_HFB = O_VTD + al256((size_t)NB * 4 * 128 * KEYS * 2);
constexpr size_t O_XC = O_HFB + al256((size_t)2 * MTOT * 512 * 2);
constexpr size_t WS_TOTAL = O_XC + al256((size_t)NCTXR * 1024 * 4) + 65536;
#define WS_W(P) reinterpret_cast<u16*>((P).ws + O_W)
#define WS_MOD(P) reinterpret_cast<float*>((P).ws + O_MOD)
#define WS_ROPE(P) reinterpret_cast<float*>((P).ws + O_ROPE)
#define WS_LAM(P) reinterpret_cast<float*>((P).ws + O_LAM)
#define WS_CTR(P) reinterpret_cast<unsigned*>((P).ws + O_CTR)
#define WS_GATES(P) reinterpret_cast<float*>((P).ws + O_GATES)
#define WS_H(P) reinterpret_cast<u16*>((P).ws + O_H)
#define WS_P(P) reinterpret_cast<u16*>((P).ws + O_P)
#define WS_VTW(P) reinterpret_cast<u16*>((P).ws + O_VTW)
#define WS_VTD(P) reinterpret_cast<u16*>((P).ws + O_VTD)
#define WS_HFB(P) reinterpret_cast<u16*>((P).ws + O_HFB)
#define WS_XC(P) reinterpret_cast<float*>((P).ws + O_XC)

DEV int my_tid() {
  int t = threadIdx.x;
  asm volatile("" : "+v"(t));
  return t;
}
typedef __bf16 bf2_t __attribute__((ext_vector_type(2)));
typedef float f2_t __attribute__((ext_vector_type(2)));
DEV uint32_t pack2(float a, float b) {
  f2_t v = {a, b};
  bf2_t r = __builtin_convertvector(v, bf2_t);
  return *reinterpret_cast<uint32_t*>(&r);
}
DEV u16 f2bf(float f) { return (u16)(pack2(f, 0.f) & 0xffffu); }
DEV float bf2f(u16 h) { return __uint_as_float(((uint32_t)h) << 16); }
DEV float bflo(uint32_t v) { return __uint_as_float(v << 16); }
DEV float bfhi(uint32_t v) { return __uint_as_float(v & 0xffff0000u); }
DEV float fexp2(float x) { return __builtin_amdgcn_exp2f(x); }
DEV float sigmoidf_(float x) { return 1.f / (1.f + __expf(-x)); }
DEV float siluf_(float x) { return x / (1.f + __expf(-x)); }
DEV float wave_sum(float v) {
#pragma unroll
  for (int o = 32; o > 0; o >>= 1) v += __shfl_xor(v, o);
  return v;
}
DEV bf16x8 ld16(const void* p) { return *reinterpret_cast<const bf16x8*>(p); }
DEV bf16x8 mk8(uint32_t a, uint32_t b, uint32_t c, uint32_t d) {
  uint4 u = make_uint4(a, b, c, d);
  return *reinterpret_cast<bf16x8*>(&u);
}
DEV f32x16 mfma32(bf16x8 a, bf16x8 b, f32x16 c) { return __builtin_amdgcn_mfma_f32_32x32x16_bf16(a, b, c, 0, 0, 0); }
DEV f32x4 mfma16(bf16x8 a, bf16x8 b, f32x4 c) { return __builtin_amdgcn_mfma_f32_16x16x32_bf16(a, b, c, 0, 0, 0); }
DEV int pi32(int r) { return (r & ~12) | ((r & 4) << 1) | ((r & 8) >> 1); }


DEV void grid_barrier(unsigned* bar, unsigned& epoch) {
  asm volatile("s_waitcnt vmcnt(0)" ::: "memory");
  __syncthreads();
  epoch += 1;
  if (my_tid() == 0) {
    __builtin_amdgcn_fence(__ATOMIC_RELEASE, "agent");
    unsigned* loc = bar + 32 + (blockIdx.x & 7) * 32;
    const unsigned per = gridDim.x >> 3;
    unsigned old = __hip_atomic_fetch_add(loc, 1u, __ATOMIC_RELAXED, __HIP_MEMORY_SCOPE_AGENT);
    if (old + 1 == per * epoch) __hip_atomic_fetch_add(bar, 1u, __ATOMIC_RELAXED, __HIP_MEMORY_SCOPE_AGENT);
    while (__hip_atomic_load(bar, __ATOMIC_RELAXED, __HIP_MEMORY_SCOPE_AGENT) < 8u * epoch) __builtin_amdgcn_s_sleep(1);
    __builtin_amdgcn_fence(__ATOMIC_ACQUIRE, "agent");
  }
  __syncthreads();
}
#define GSYNC() grid_barrier(bar, epoch)
#define GSYNC_ONLY()

template <int N>
DEV void wait_vm() { asm volatile("s_waitcnt vmcnt(%0)" ::"n"(N) : "memory"); }

template <int MI, int NI>
DEV void gemm_mainloop(const u16* __restrict__ A, int lda, const u16* __restrict__ Bt, int ldb, int K,
                       f32x4 (&acc)[MI][NI], char* smem) {
  constexpr int BM = 32 * MI, BN = 64 * NI;
  constexpr int NA = BM * 4 / NTHREADS, NBL = BN * 4 / NTHREADS;
  constexpr int ABYTES = BM * 64, BBYTES = BN * 64, SBYTES = ABYTES + BBYTES;
  constexpr int NL = NA + NBL;
  const int tid = my_tid(), lane = tid & 63, wid = tid >> 6, wr = wid >> 2, wc = wid & 3, fr = lane & 15, fq = lane >> 4;
  const int nk = K / 32;
  auto stage = [&](int kt) {
    char* base = smem + (kt & 3) * SBYTES;
#pragma unroll
    for (int i = 0; i < NA; ++i) {
      int id = tid + i * NTHREADS, r = id >> 2, c = (id & 3) ^ (((r >> 3) & 1) * 3);
      __builtin_amdgcn_global_load_lds((const unsigned*)(A + (size_t)r * lda + kt * 32 + c * 8), (unsigned*)(base + id * 16), 16, 0, 0);
    }
#pragma unroll
    for (int i = 0; i < NBL; ++i) {
      int id = tid + i * NTHREADS, r = id >> 2, c = (id & 3) ^ (((r >> 3) & 1) * 3);
      __builtin_amdgcn_global_load_lds((const unsigned*)(Bt + (size_t)r * ldb + kt * 32 + c * 8), (unsigned*)(base + ABYTES + id * 16), 16, 0, 0);
    }
  };
  wait_vm<0>();
  __syncthreads();
  stage(0);
  if (nk > 1) stage(1);
  if (nk > 2) stage(2);
  for (int kt = 0; kt < nk; ++kt) {
    if (kt + 2 < nk) wait_vm<2 * NL>();
    else if (kt + 1 < nk) wait_vm<NL>();
    else wait_vm<0>();
    asm volatile("" ::: "memory");
    __builtin_amdgcn_s_barrier();
    asm volatile("" ::: "memory");
    const char* As = smem + (kt & 3) * SBYTES;
    const char* Bs = As + ABYTES;
    bf16x8 bfr[NI], af[MI];
#pragma unroll
    for (int ni = 0; ni < NI; ++ni) {
      int r = wc * (NI * 16) + ni * 16 + fr;
      bfr[ni] = ld16(Bs + r * 64 + ((fq ^ (((r >> 3) & 1) * 3)) << 4));
    }
#pragma unroll
    for (int mi = 0; mi < MI; ++mi) {
      int r = wr * (MI * 16) + mi * 16 + fr;
      af[mi] = ld16(As + r * 64 + ((fq ^ (((r >> 3) & 1) * 3)) << 4));
    }
    if (kt + 3 < nk) stage(kt + 3);
    __builtin_amdgcn_sched_barrier(0);
    __builtin_amdgcn_s_setprio(1);
#pragma unroll
    for (int mi = 0; mi < MI; ++mi)
#pragma unroll
      for (int ni = 0; ni < NI; ++ni) acc[mi][ni] = mfma16(af[mi], bfr[ni], acc[mi][ni]);
    __builtin_amdgcn_s_setprio(0);
    __builtin_amdgcn_sched_barrier(0);
  }
}


DEV void gemm_mainloop64(const u16* __restrict__ A, int lda, const u16* __restrict__ Bt, int ldb, int K, f32x4 (&acc)[4][4], char* smem) {
  constexpr int ABYTES = 128 * 128, BBYTES = 256 * 128, SBYTES = ABYTES + BBYTES;
  constexpr int NA = 2, NBL = 4, NL = NA + NBL;
  const int tid = my_tid(), lane = tid & 63, wid = tid >> 6, wr = wid >> 2, wc = wid & 3, fr = lane & 15, fq = lane >> 4;
  const int nk = K / 64;
  auto stage = [&](int kt) {
    char* base = smem + (kt % 3) * SBYTES;
#pragma unroll
    for (int i = 0; i < NA; ++i) {
      int id = tid + i * NTHREADS, r = id >> 3, c = (id & 7) ^ ((r >> 1) & 7);
      __builtin_amdgcn_global_load_lds((const unsigned*)(A + (size_t)r * lda + kt * 64 + c * 8), (unsigned*)(base + id * 16), 16, 0, 0);
    }
#pragma unroll
    for (int i = 0; i < NBL; ++i) {
      int id = tid + i * NTHREADS, r = id >> 3, c = (id & 7) ^ ((r >> 1) & 7);
      __builtin_amdgcn_global_load_lds((const unsigned*)(Bt + (size_t)r * ldb + kt * 64 + c * 8), (unsigned*)(base + ABYTES + id * 16), 16, 0, 0);
    }
  };
  wait_vm<0>();
  __syncthreads();
  stage(0);
  if (nk > 1) stage(1);
  for (int kt = 0; kt < nk; ++kt) {
    if (kt + 1 < nk) wait_vm<NL>();
    else wait_vm<0>();
    asm volatile("" ::: "memory");
    __builtin_amdgcn_s_barrier();
    asm volatile("" ::: "memory");
    if (kt + 2 < nk) stage(kt + 2);
    const char* As = smem + (kt % 3) * SBYTES;
    const char* Bs = As + ABYTES;
#pragma unroll
    for (int ks = 0; ks < 2; ++ks) {
      bf16x8 bfr[4], af[4];
#pragma unroll
      for (int ni = 0; ni < 4; ++ni) {
        int r = wc * 64 + ni * 16 + fr;
        bfr[ni] = ld16(Bs + r * 128 + (((ks * 4 + fq) ^ ((r >> 1) & 7)) << 4));
      }
#pragma unroll
      for (int mi = 0; mi < 4; ++mi) {
        int r = wr * 64 + mi * 16 + fr;
        af[mi] = ld16(As + r * 128 + (((ks * 4 + fq) ^ ((r >> 1) & 7)) << 4));
      }
#pragma unroll
      for (int mi = 0; mi < 4; ++mi)
#pragma unroll
        for (int ni = 0; ni < 4; ++ni) acc[mi][ni] = mfma16(af[mi], bfr[ni], acc[mi][ni]);
      __builtin_amdgcn_sched_barrier(0);
    }
  }
}

template <int MI, int NI>
DEV void zero_acc(f32x4 (&acc)[MI][NI]) {
#pragma unroll
  for (int mi = 0; mi < MI; ++mi)
#pragma unroll
    for (int ni = 0; ni < NI; ++ni) acc[mi][ni] = f32x4{0.f, 0.f, 0.f, 0.f};
}


DEV void tile_coords(int tile, int total, int nN, int& tm, int& tn) {
  int t = tile;
  if (gridDim.x == 256 && tile < (total & ~255)) {
    int j = tile & 255;
    t = (tile & ~255) + (j & 7) * 32 + (j >> 3);
  }
  int p = t / (4 * nN), q = t - p * (4 * nN);
  tn = q >> 2;
  tm = p * 4 + (q & 3);
}

template <int MI, class Epi>
DEV void gemm_phase(const u16* A, int lda, const u16* Bt, int ldb, int M, int N, int K, Epi epi, char* smem) {
  constexpr int BM = 32 * MI;
  const int nM = M / BM, nN = N / 256;
  const int wid = my_tid() >> 6, wr = wid >> 2, wc = wid & 3;
  for (int tile = blockIdx.x; tile < nM * nN; tile += gridDim.x) {
    int tm, tn;
    tile_coords(tile, nM * nN, nN, tm, tn);
    f32x4 acc[MI][4];
    zero_acc<MI, 4>(acc);
    gemm_mainloop<MI, 4>(A + (size_t)tm * BM * lda, lda, Bt + (size_t)tn * 256 * ldb, ldb, K, acc, smem);
    epi(acc, tm * BM + wr * (MI * 16), tn * 256 + wc * 64);
  }
}

DEV int map_col(int type, int n) {
  if (type == 0) {
    if (n < 2048) return n;
    if (n < 2688) return n + 16;
    if (n < 3712) return n + 144;
    if (n < 3840) return n - 1008;
    if (n < 4352) return n + 16;
    if (n < 4368) return n - 2304;
    return -1;
  }
  if (type == 1) return n + 4368;
  if (type == 2) return n;
  int q = n >> 5, r = n & 31;
  return r < 16 ? (q * 16 + r) : (FH + q * 16 + r - 16);
}

DEV void tr_tile(const float* __restrict__ src, int ldsrc, u16* __restrict__ dst, int K, int n0, int k0, int type, char* smem) {
  float* tile = reinterpret_cast<float*>(smem);
  const int tid = my_tid();
  {
    int n = tid & 63, sc = map_col(type, n0 + n);
#pragma unroll
    for (int i = 0; i < 8; ++i) {
      int k = (tid >> 6) + 8 * i;
      tile[k * 65 + n] = sc >= 0 ? src[(size_t)(k0 + k) * ldsrc + sc] : 0.f;
    }
  }
  __syncthreads();
  {
    int n = tid >> 3, kc = tid & 7;
    uint32_t w[4];
#pragma unroll
    for (int j = 0; j < 4; ++j) w[j] = pack2(tile[(kc * 8 + 2 * j) * 65 + n], tile[(kc * 8 + 2 * j + 1) * 65 + n]);
    *reinterpret_cast<uint4*>(dst + (size_t)(n0 + n) * K + k0 + kc * 8) = make_uint4(w[0], w[1], w[2], w[3]);
  }
  __syncthreads();
}

DEV void phase_prologue(const Params& P, char* smem) {
  const int tid = my_tid();
  constexpr int TPL = 4672;
  for (int it = blockIdx.x; it < 2 * TPL; it += gridDim.x) {
    int l = it / TPL, t = it % TPL;
    u16* Wl = WS_W(P) + (size_t)l * W_LAYER;
    if (t < 1152) {
      tr_tile(P.w_in + (size_t)l * 1024 * INW, INW, Wl + W_IN, 1024, (t / 16) * 64, (t % 16) * 64, 0, smem);
    } else if (t < 1920) {
      t -= 1152;
      tr_tile(P.w_in + (size_t)l * 1024 * INW, INW, Wl + W_G, 1024, (t / 16) * 64, (t % 16) * 64, 1, smem);
    } else if (t < 2304) {
      t -= 1920;
      int i = t / 128;
      t %= 128;
      tr_tile(P.w_branch + ((size_t)l * 3 + i) * 512 * 1024, 1024, Wl + W_B + (size_t)i * 1024 * 512, 512, (t / 8) * 64, (t % 8) * 64, 2, smem);
    } else if (t < 2560) {
      t -= 2304;
      tr_tile(P.w_out + (size_t)l * 1024 * 1024, 1024, Wl + W_O, 1024, (t / 16) * 64, (t % 16) * 64, 2, smem);
    } else if (t < 3968) {
      t -= 2560;
      tr_tile(P.w_ffn_in + (size_t)l * 1024 * 5632, 5632, Wl + W_FI, 1024, (t / 16) * 64, (t % 16) * 64, 3, smem);
    } else {
      t -= 3968;
      tr_tile(P.w_ffn_out + (size_t)l * FH * 1024, 1024, Wl + W_FO, FH, (t / 44) * 64, (t % 44) * 64, 2, smem);
    }
  }
  for (int it = blockIdx.x; it < 384; it += gridDim.x) {
    int l = it / 192, n0 = (it % 192) * 32;
    float* sc = reinterpret_cast<float*>(smem);
    float* red = sc + 17 * 1024;
    __syncthreads();
    for (int idx = tid; idx < 17 * 1024; idx += NTHREADS) {
      int cond = idx >> 10, k = idx & 1023;
      float cv = cond < 16 ? P.c[cond * 1024 + k] : P.c_ctx[k];
      sc[idx] = siluf_(cv);
    }
    __syncthreads();
    int col = tid & 31, ks = tid >> 5;
    float acc[17];
#pragma unroll
    for (int j = 0; j < 17; ++j) acc[j] = 0.f;
    const float* wm = P.w_mod + (size_t)l * 1024 * 6144 + n0 + col;
    for (int k = ks * 64; k < ks * 64 + 64; ++k) {
      float w = wm[(size_t)k * 6144];
#pragma unroll
      for (int j = 0; j < 17; ++j) acc[j] += sc[j * 1024 + k] * w;
    }
#pragma unroll
    for (int j = 0; j < 17; ++j) red[(ks * 17 + j) * 32 + col] = acc[j];
    __syncthreads();
    for (int o = tid; o < 17 * 32; o += NTHREADS) {
      int j = o >> 5, cc = o & 31;
      float s = 0.f;
      for (int q = 0; q < 16; ++q) s += red[(q * 17 + j) * 32 + cc];
      WS_MOD(P)[((size_t)l * 17 + j) * 6144 + n0 + cc] = s + P.b_mod[l * 6144 + n0 + cc];
    }
  }
  for (int idx = blockIdx.x * NTHREADS + tid; idx < T * 32; idx += gridDim.x * NTHREADS) {
    int t = idx >> 5, j = idx & 31;
    int pos = j < 16 ? (t >> 6) : (t & 63);
    float inv = powf(10000.f, -(float)(j & 15) / 16.f);
    float ang = (float)pos * inv;
    WS_ROPE(P)[idx * 2] = cosf(ang);
    WS_ROPE(P)[idx * 2 + 1] = sinf(ang);
  }
  for (int idx = blockIdx.x * NTHREADS + tid; idx < NCTXR * 1024 / 4; idx += gridDim.x * NTHREADS)
    reinterpret_cast<float4*>(WS_XC(P))[idx] = reinterpret_cast<const float4*>(P.ctx)[idx];
  if (blockIdx.x == 0 && tid < 64) {
    for (int l = 0; l < 2; ++l) {
      float a = wave_sum(P.lam_q1[l * 64 + tid] * P.lam_k1[l * 64 + tid]);
      float b = wave_sum(P.lam_q2[l * 64 + tid] * P.lam_k2[l * 64 + tid]);
      float lam_init = 0.8f - 0.6f * expf(-0.3f * (float)l);
      if (tid == 0) WS_LAM(P)[l] = expf(a) - expf(b) + lam_init;
    }
    if (tid < 8) WS_CTR(P)[tid] = 0u;
  }
}

DEV void phase_norm_mod(const Params& P, const float* xlat, const float* xctx, int nrows, const float* g,
                        const float* modl, int sh_off, int sc_off) {
  const int lane = my_tid() & 63, wid = my_tid() >> 6;
  for (int row = blockIdx.x * 8 + wid; row < nrows; row += gridDim.x * 8) {
    const float* src = row < NLAT ? xlat + (size_t)row * 1024 : xctx + (size_t)(row - NLAT) * 1024;
    int cond = row < NLAT ? row >> 12 : 16;
    const float* md = modl + (size_t)cond * 6144;
    float4 v[4];
    float ss = 0.f;
#pragma unroll
    for (int i = 0; i < 4; ++i) {
      v[i] = *reinterpret_cast<const float4*>(src + i * 256 + lane * 4);
      ss += v[i].x * v[i].x + v[i].y * v[i].y + v[i].z * v[i].z + v[i].w * v[i].w;
    }
    ss = wave_sum(ss);
    float rstd = rsqrtf(ss * (1.f / 1024.f) + EPS);
#pragma unroll
    for (int i = 0; i < 4; ++i) {
      int cb = i * 256 + lane * 4;
      float4 gg = *reinterpret_cast<const float4*>(g + cb);
      float4 sh = *reinterpret_cast<const float4*>(md + sh_off + cb);
      float4 sc = *reinterpret_cast<const float4*>(md + sc_off + cb);
      float y0 = v[i].x * rstd * gg.x * (1.f + sc.x) + sh.x;
      float y1 = v[i].y * rstd * gg.y * (1.f + sc.y) + sh.y;
      float y2 = v[i].z * rstd * gg.z * (1.f + sc.z) + sh.z;
      float y3 = v[i].w * rstd * gg.w * (1.f + sc.w) + sh.w;
      *reinterpret_cast<uint2*>(WS_H(P) + (size_t)row * 1024 + cb) = make_uint2(pack2(y0, y1), pack2(y2, y3));
    }
  }
}

DEV void phase_final_norm(const Params& P) {
  const int lane = my_tid() & 63, wid = my_tid() >> 6;
  for (int row = blockIdx.x * 8 + wid; row < NLAT; row += gridDim.x * 8) {
    float* src = P.out + (size_t)row * 1024;
    float4 v[4];
    float ss = 0.f;
#pragma unroll
    for (int i = 0; i < 4; ++i) {
      v[i] = *reinterpret_cast<const float4*>(src + i * 256 + lane * 4);
      ss += v[i].x * v[i].x + v[i].y * v[i].y + v[i].z * v[i].z + v[i].w * v[i].w;
    }
    ss = wave_sum(ss);
    float rstd = rsqrtf(ss * (1.f / 1024.f) + EPS);
#pragma unroll
    for (int i = 0; i < 4; ++i) {
      int cb = i * 256 + lane * 4;
      float4 gg = *reinterpret_cast<const float4*>(P.g_final + cb);
      float4 o = make_float4(v[i].x * rstd * gg.x, v[i].y * rstd * gg.y, v[i].z * rstd * gg.z, v[i].w * rstd * gg.w);
      *reinterpret_cast<float4*>(src + cb) = o;
    }
  }
}

struct EpiInProj {
  const Params& P;
  int l;
  DEV void operator()(f32x4 (&acc)[8][4], int row0, int col0) const {
    const int lane = my_tid() & 63, fr = lane & 15, fq = lane >> 4;
    if (col0 >= 4416) return;
    if (col0 < C_WQ) {
#pragma unroll
      for (int mi = 0; mi < 8; ++mi)
#pragma unroll
        for (int ni = 0; ni < 4; ++ni)
#pragma unroll
          for (int j = 0; j < 4; ++j)
            WS_P(P)[(size_t)(row0 + mi * 16 + fq * 4 + j) * PW + col0 + ni * 16 + fr] = f2bf(acc[mi][ni][j]);
    } else if (col0 < 3712) {
      const bool isq = (col0 < C_WK) || (col0 >= C_DQ && col0 < C_DK);
      const float qs = isq ? 0.125f : 1.f;
#pragma unroll
      for (int mi = 0; mi < 8; ++mi)
#pragma unroll
        for (int j = 0; j < 4; ++j) {
          int row = row0 + mi * 16 + fq * 4 + j;
          u16* dst = WS_P(P) + (size_t)row * PW + col0 + fr;
          if (row < NLAT) {
            int t = row & (T - 1);
            const float2* rt = reinterpret_cast<const float2*>(WS_ROPE(P)) + t * 32;
#pragma unroll
            for (int hf = 0; hf < 2; ++hf) {
              float2 cs = rt[hf * 16 + fr];
              float x1 = acc[mi][hf * 2][j], x2 = acc[mi][hf * 2 + 1][j];
              dst[hf * 32] = f2bf((x1 * cs.x - x2 * cs.y) * qs);
              dst[hf * 32 + 16] = f2bf((x2 * cs.x + x1 * cs.y) * qs);
            }
          } else {
#pragma unroll
            for (int ni = 0; ni < 4; ++ni) dst[ni * 16] = f2bf(acc[mi][ni][j] * qs);
          }
        }
    } else if (col0 < 4352) {
      u16* base;
      int vrow0;
      const int hdW = (col0 - 3712) >> 6;
      const int hdD = (col0 - 3840) >> 7;
      const bool isw = col0 < 3840;
#pragma unroll
      for (int mi = 0; mi < 8; ++mi) {
        int row = row0 + mi * 16 + fq * 4;
        int b, key;
        if (row < NLAT) { b = row >> 12; key = 256 + (row & (T - 1)); }
        else { b = (row - NLAT) >> 8; key = (row - NLAT) & 255; }
        if (isw) { base = WS_VTW(P) + ((size_t)(b * 2 + hdW) * 64) * KEYS; vrow0 = 0; }
        else { base = WS_VTD(P) + ((size_t)(b * 4 + hdD) * 128) * KEYS; vrow0 = (col0 - 3840) & 127; }
#pragma unroll
        for (int ni = 0; ni < 4; ++ni) {
          int v = vrow0 + ni * 16 + fr;
          *reinterpret_cast<uint2*>(base + (size_t)v * KEYS + key) =
              make_uint2(pack2(acc[mi][ni][0], acc[mi][ni][1]), pack2(acc[mi][ni][2], acc[mi][ni][3]));
        }
      }
    } else {
      float bg = P.b_gate[l * 16 + fr];
#pragma unroll
      for (int mi = 0; mi < 8; ++mi)
#pragma unroll
        for (int j = 0; j < 4; ++j) WS_GATES(P)[(size_t)(row0 + mi * 16 + fq * 4 + j) * 16 + fr] = acc[mi][0][j] + bg;
    }
  }
};

template <int QB, int VB, int KW>
struct AttnCore {
  static constexpr int DV = 32 * VB;
  static constexpr int KST = KW * 2 + 16;
  static constexpr int VST = 128 + 16;
  static constexpr int KBYTES = 64 * KST, VBYTES = DV * VST;
  static constexpr int NKL = 64 * (KW / 8) / NTHREADS, NVL = DV * 8 / NTHREADS;
  static constexpr int TOTAL = 2 * (KBYTES + VBYTES);

  static DEV void run(const u16* qptr, int ldq, const u16* kctx, const u16* klat, int ldk, int kcol, const u16* vt,
                      int nctx, int nlat, int lat_t0, bool window, int qtok0, float m_init, float l_init,
                      f32x16 (&O)[QB][VB], char* smem) {
    const int tid = my_tid(), lane = tid & 63, r = lane & 31, hh = lane >> 5;
    char* Ks = smem;
    char* Vs = smem + 2 * KBYTES;
    bf16x8 qf[QB][4];
#pragma unroll
    for (int qb = 0; qb < QB; ++qb)
#pragma unroll
      for (int ks = 0; ks < 4; ++ks) qf[qb][ks] = ld16(qptr + (size_t)(qb * 32 + r) * ldq + ks * 16 + hh * 8);
    float m[QB], lsum[QB];
#pragma unroll
    for (int qb = 0; qb < QB; ++qb) {
      m[qb] = m_init;
      lsum[qb] = hh == 0 ? l_init : 0.f;
#pragma unroll
      for (int vb = 0; vb < VB; ++vb)
#pragma unroll
        for (int i = 0; i < 16; ++i) O[qb][vb][i] = 0.f;
    }
    bf16x8 rk[NKL], rv[NVL];
    const int ntiles = nctx + nlat;
    auto gload = [&](int j) {
      int kidx = j < nctx ? j * 64 : 256 + lat_t0 + (j - nctx) * 64;
      const u16* krow = j < nctx ? kctx + (size_t)(j * 64) * ldk : klat + (size_t)(lat_t0 + (j - nctx) * 64) * ldk;
#pragma unroll
      for (int i = 0; i < NKL; ++i) {
        int id = tid + i * NTHREADS, row = id / (KW / 8), c = id % (KW / 8);
        rk[i] = ld16(krow + (size_t)row * ldk + c * 8);
      }
#pragma unroll
      for (int i = 0; i < NVL; ++i) {
        int id = tid + i * NTHREADS, row = id >> 3, c = id & 7;
        rv[i] = ld16(vt + (size_t)row * KEYS + kidx + c * 8);
      }
    };
    auto lstore = [&](int buf) {
#pragma unroll
      for (int i = 0; i < NKL; ++i) {
        int id = tid + i * NTHREADS, row = id / (KW / 8), c = id % (KW / 8);
        *reinterpret_cast<bf16x8*>(Ks + buf * KBYTES + row * KST + c * 16) = rk[i];
      }
#pragma unroll
      for (int i = 0; i < NVL; ++i) {
        int id = tid + i * NTHREADS, row = id >> 3, c = id & 7;
        *reinterpret_cast<bf16x8*>(Vs + buf * VBYTES + row * VST + c * 16) = rv[i];
      }
    };
    __syncthreads();
    gload(0);
    lstore(0);
    __syncthreads();
    for (int j = 0; j < ntiles; ++j) {
      const int buf = j & 1;
      if (j + 1 < ntiles) gload(j + 1);
      bf16x8 pf[QB][2][2];
#pragma unroll
      for (int qb = 0; qb < QB; ++qb) {
        f32x16 S[2];
#pragma unroll
        for (int kb = 0; kb < 2; ++kb) {
#pragma unroll
          for (int i = 0; i < 16; ++i) S[kb][i] = 0.f;
#pragma unroll
          for (int ks = 0; ks < 4; ++ks) {
            bf16x8 kf = ld16(Ks + buf * KBYTES + (kb * 32 + pi32(r)) * KST + (kcol + ks * 16 + hh * 8) * 2);
            S[kb] = mfma32(kf, qf[qb][ks], S[kb]);
          }
        }
        __builtin_amdgcn_sched_barrier(0);
        if (window && j >= nctx) {
          int kt0 = lat_t0 + (j - nctx) * 64;
          int qt = qtok0 + qb * 32 + r;
#pragma unroll
          for (int kb = 0; kb < 2; ++kb)
#pragma unroll
            for (int i = 0; i < 16; ++i) {
              int kt = kt0 + kb * 32 + 16 * (i >> 3) + 8 * hh + (i & 7);
              int dlt = qt - kt;
              if (dlt > 128 || dlt < -128) S[kb][i] = -1e30f;
            }
        }
        float mloc = -1e30f;
#pragma unroll
        for (int kb = 0; kb < 2; ++kb)
#pragma unroll
          for (int i = 0; i < 16; ++i) mloc = fmaxf(mloc, S[kb][i]);
        mloc = fmaxf(mloc, __shfl_xor(mloc, 32));
        if (__any(mloc > m[qb] + 5.5f)) {
          float mnew = fmaxf(m[qb], mloc);
          float alpha = fexp2((m[qb] - mnew) * L2E);
          m[qb] = mnew;
          lsum[qb] *= alpha;
#pragma unroll
          for (int vb = 0; vb < VB; ++vb)
#pragma unroll
            for (int i = 0; i < 16; ++i) O[qb][vb][i] *= alpha;
        }
        float mb = m[qb] * L2E, ps = 0.f;
#pragma unroll
        for (int kb = 0; kb < 2; ++kb) {
          float pv[16];
#pragma unroll
          for (int i = 0; i < 16; ++i) {
            pv[i] = fexp2(S[kb][i] * L2E - mb);
            ps += pv[i];
          }
#pragma unroll
          for (int s = 0; s < 2; ++s)
            pf[qb][kb][s] = mk8(pack2(pv[8 * s], pv[8 * s + 1]), pack2(pv[8 * s + 2], pv[8 * s + 3]),
                                pack2(pv[8 * s + 4], pv[8 * s + 5]), pack2(pv[8 * s + 6], pv[8 * s + 7]));
        }
        lsum[qb] += ps;
        __builtin_amdgcn_sched_barrier(0);
      }
      __builtin_amdgcn_sched_barrier(0);
#pragma unroll
      for (int vb = 0; vb < VB; ++vb) {
#pragma unroll
        for (int kb = 0; kb < 2; ++kb)
#pragma unroll
          for (int s = 0; s < 2; ++s) {
            bf16x8 vf = ld16(Vs + buf * VBYTES + (vb * 32 + r) * VST + (kb * 32 + s * 16 + hh * 8) * 2);
#pragma unroll
            for (int qb = 0; qb < QB; ++qb) O[qb][vb] = mfma32(vf, pf[qb][kb][s], O[qb][vb]);
          }
        __builtin_amdgcn_sched_barrier(0);
      }
      if (j + 1 < ntiles) lstore(buf ^ 1);
      __syncthreads();
    }
#pragma unroll
    for (int qb = 0; qb < QB; ++qb) {
      float lt = lsum[qb] + __shfl_xor(lsum[qb], 32);
      float inv = 1.f / lt;
#pragma unroll
      for (int vb = 0; vb < VB; ++vb)
#pragma unroll
        for (int i = 0; i < 16; ++i) O[qb][vb][i] *= inv;
    }
  }
};

DEV void diff_item(const Params& P, int l, int b, int h, int qt, bool ctxq, char* smem) {
  const int tid = my_tid(), lane = tid & 63, wid = tid >> 6, r = lane & 31, hh = lane >> 5;
  const int comp = wid >> 2, wq = wid & 3;
  const int rowbase = ctxq ? NLAT + b * 256 + qt * 128 : b * T + qt * 128;
  const u16* qptr = WS_P(P) + (size_t)(rowbase + wq * 32) * PW + C_DQ + h * 128 + comp * 64;
  const u16* kctx = WS_P(P) + (size_t)(NLAT + b * 256) * PW + C_DK + h * 128;
  const u16* klat = WS_P(P) + (size_t)(b * T) * PW + C_DK + h * 128;
  const u16* vt = WS_VTD(P) + ((size_t)(b * 4 + h) * 128) * KEYS;
  f32x16 O[1][4];
  AttnCore<1, 4, 128>::run(qptr, PW, kctx, klat, PW, comp * 64, vt, 4, ctxq ? 0 : 64, 0, false, 0, -1e30f, 0.f, O, smem);
  float* ex = reinterpret_cast<float*>(smem);
  __syncthreads();
  if (comp == 1) {
#pragma unroll
    for (int vb = 0; vb < 4; ++vb)
#pragma unroll
      for (int i = 0; i < 16; ++i) ex[(wq * 64 + vb * 16 + i) * 64 + lane] = O[0][vb][i];
  }
  __syncthreads();
  if (comp == 0) {
    const float lam = WS_LAM(P)[l];
    const float lam_init = 0.8f - 0.6f * expf(-0.3f * (float)l);
    float ss = 0.f;
#pragma unroll
    for (int vb = 0; vb < 4; ++vb)
#pragma unroll
      for (int i = 0; i < 16; ++i) {
        float y = O[0][vb][i] - lam * ex[(wq * 64 + vb * 16 + i) * 64 + lane];
        O[0][vb][i] = y;
        ss += y * y;
      }
    ss += __shfl_xor(ss, 32);
    float sc = rsqrtf(ss * (1.f / 128.f) + EPS) * (1.f - lam_init);
    const float* dn = P.d_norm + l * 512 + h * 128;
    u16* dst = WS_P(P) + (size_t)(rowbase + wq * 32 + r) * PW + C_DQ + h * 128;
#pragma unroll
    for (int vb = 0; vb < 4; ++vb)
#pragma unroll
      for (int g4 = 0; g4 < 4; ++g4) {
        int v = vb * 32 + g4 * 8 + hh * 4;
        float4 w = *reinterpret_cast<const float4*>(dn + v);
        *reinterpret_cast<uint2*>(dst + v) =
            make_uint2(pack2(O[0][vb][g4 * 4] * sc * w.x, O[0][vb][g4 * 4 + 1] * sc * w.y),
                       pack2(O[0][vb][g4 * 4 + 2] * sc * w.z, O[0][vb][g4 * 4 + 3] * sc * w.w));
      }
  }
  __syncthreads();
}

DEV void win_item(const Params& P, int l, int b, int g, int qb, bool ctxq, char* smem) {
  const int tid = my_tid(), lane = tid & 63, wid = tid >> 6, r = lane & 31, hh = lane >> 5;
  const int hr = wid >> 1, qh = wid & 1;
  const int head = g * 4 + hr;
  const int rowbase = (ctxq ? NLAT + b * 256 + qb * 64 : b * T + qb * 64) + qh * 32;
  const u16* qptr = WS_P(P) + (size_t)rowbase * PW + C_WQ + head * 64;
  const u16* kctx = WS_P(P) + (size_t)(NLAT + b * 256) * PW + C_WK + g * 64;
  const u16* klat = WS_P(P) + (size_t)(b * T) * PW + C_WK + g * 64;
  const u16* vt = WS_VTW(P) + ((size_t)(b * 2 + g) * 64) * KEYS;
  int t0 = 0, nlat = 0;
  if (!ctxq) {
    t0 = qb * 64 - 128;
    if (t0 < 0) t0 = 0;
    int t1 = qb * 64 + 192;
    if (t1 > T) t1 = T;
    nlat = (t1 - t0) >> 6;
  }
  f32x16 O[1][2];
  AttnCore<1, 2, 64>::run(qptr, PW, kctx, klat, PW, 0, vt, 4, nlat, t0, !ctxq, qb * 64 + qh * 32, P.sink[l * 8 + head], 1.f, O, smem);
  u16* dst = WS_P(P) + (size_t)(rowbase + r) * PW + C_WQ + head * 64;
#pragma unroll
  for (int vb = 0; vb < 2; ++vb)
#pragma unroll
    for (int g4 = 0; g4 < 4; ++g4) {
      int v = vb * 32 + g4 * 8 + hh * 4;
      *reinterpret_cast<uint2*>(dst + v) = make_uint2(pack2(O[0][vb][g4 * 4], O[0][vb][g4 * 4 + 1]),
                                                        pack2(O[0][vb][g4 * 4 + 2], O[0][vb][g4 * 4 + 3]));
    }
}

DEV void mlstm_item(const Params& P, int l, int b, int hd, int dir, bool need_ctx, char* smem) {
  const int tid = my_tid(), lane = tid & 63, wid = tid >> 6, r = lane & 31, hh = lane >> 5;
  constexpr int QST = 272, TST = 144;
  char* Qs = smem;
  char* Ks = Qs + 64 * QST;
  char* KwT = Ks + 64 * QST;
  char* VT = KwT + 128 * TST;
  char* Sp = VT + 128 * TST;
  char* Rq = Sp + 64 * TST;
  char* Rk = Rq + 66 * QST;
  float* fb = reinterpret_cast<float*>(Rk + 66 * QST);
  float* sb = fb;
  float* sa = fb + 64;
  float* sM = fb + 128;
  float* denp = fb + 192;
  float* qn = fb + 320;
  float* nb = fb + 384;
  float* cw = fb + 640;
  __syncthreads();
  if (tid < 256) nb[tid] = 0.f;
  for (int i = tid; i < 768; i += NTHREADS) {
    int qk = i / 384, tap = (i % 384) / 128, d = i & 127;
    cw[i] = P.conv_w[(size_t)l * 3 * 1024 + tap * 1024 + qk * 512 + hd * 128 + d];
  }
  f32x16 CT[4];
#pragma unroll
  for (int kb = 0; kb < 4; ++kb)
#pragma unroll
    for (int i = 0; i < 16; ++i) CT[kb][i] = 0.f;
  float mstate = 0.f;
  u16* hout = WS_HFB(P) + (size_t)dir * MTOT * 512;
  const float kscale = 0.08838834764831845f;

  auto geom = [&](int step, int& seg0, int& seglen, int& u0) {
    int c;
    if (step < 4) { seg0 = NLAT + b * 256; seglen = 256; c = dir ? 3 - step : step; }
    else { seg0 = b * T; seglen = T; c = dir ? 67 - step : step - 4; }
    u0 = c * 64;
  };
  bf16x8 pq[3], pk[3], pvv[2];
  float pig = 0.f, pfg = 0.f;
  auto issue_loads = [&](int step) {
    int seg0, seglen, u0;
    geom(step, seg0, seglen, u0);
#pragma unroll
    for (int i = 0; i < 3; ++i) {
      int id = tid + i * NTHREADS;
      bf16x8 z = {0, 0, 0, 0, 0, 0, 0, 0};
      pq[i] = z;
      pk[i] = z;
      if (id < 66 * 16) {
        int row = id >> 4, cc = id & 15;
        int uu = u0 + row - 1;
        bool ok = uu >= 0 && uu < seglen;
        const u16* src = WS_P(P) + (size_t)(seg0 + (ok ? uu : 0)) * PW + hd * 128 + cc * 8;
        if (ok) { pq[i] = ld16(src + C_MQ); pk[i] = ld16(src + C_MK); }
      }
    }
#pragma unroll
    for (int i = 0; i < 2; ++i) {
      int id = tid + i * NTHREADS, u = id >> 4, cc = id & 15;
      pvv[i] = ld16(WS_P(P) + (size_t)(seg0 + u0 + u) * PW + C_MV + hd * 128 + cc * 8);
    }
    if (wid == 0) {
      const int pos = dir ? 63 - lane : lane;
      const float* gp = WS_GATES(P) + (size_t)(seg0 + u0 + pos) * 16;
      pig = gp[(dir * 2) * 4 + hd];
      pfg = gp[(dir * 2 + 1) * 4 + hd];
    }
  };
  issue_loads(0);

  for (int step = 0; step < 68; ++step) {
    int seg0, seglen, u0;
    geom(step, seg0, seglen, u0);
    const int rowbase = seg0 + u0;
    const int cur = step & 1;
    __syncthreads();
    bf16x8 rvv[2];
#pragma unroll
    for (int i = 0; i < 3; ++i) {
      int id = tid + i * NTHREADS;
      if (id < 66 * 16) {
        int row = id >> 4, cc = id & 15;
        *reinterpret_cast<bf16x8*>(Rq + row * QST + cc * 16) = pq[i];
        *reinterpret_cast<bf16x8*>(Rk + row * QST + cc * 16) = pk[i];
      }
    }
    rvv[0] = pvv[0];
    rvv[1] = pvv[1];
    const float ig = pig, fg = pfg;
    if (step + 1 < 68) issue_loads(step + 1);
    if (wid == 0) {
      const int pos = dir ? 63 - lane : lane;
      float lf = fminf(fg, 0.f) - log1pf(__expf(-fabsf(fg)));
      float bsum = lf;
#pragma unroll
      for (int o = 1; o < 64; o <<= 1) { float t2 = __shfl_up(bsum, o); if (lane >= o) bsum += t2; }
      float a = ig - bsum, am = a;
#pragma unroll
      for (int o = 1; o < 64; o <<= 1) { float t2 = __shfl_up(am, o); if (lane >= o) am = fmaxf(am, t2); }
      sb[pos] = bsum;
      sa[pos] = a;
      sM[pos] = fmaxf(mstate, am);
    }
    __syncthreads();
    const int eidx = dir ? 0 : 63;
    const float Mend = sM[eidx], bend = sb[eidx];
    const float decay = __expf(mstate - Mend);
#pragma unroll
    for (int i = 0; i < 2; ++i) {
      int id = tid + i * NTHREADS, u = id >> 4, cc = id & 15;
      float wend = __expf(sa[u] - Mend);
      const int tbase = cc * 8 * TST + (((u >> 3) ^ (cc & 7)) << 4) + (u & 7) * 2;
      uint32_t qo[4], ko[4];
      float kv[8], xq[8], xk[8];
#pragma unroll
      for (int e = 0; e < 8; ++e) { xq[e] = 0.f; xk[e] = 0.f; }
#pragma unroll
      for (int tap = 0; tap < 3; ++tap) {
        const bf16x8 qr = ld16(Rq + (u + tap) * QST + cc * 16), kr = ld16(Rk + (u + tap) * QST + cc * 16);
        const float4 wq0 = *reinterpret_cast<const float4*>(cw + tap * 128 + cc * 8), wq1 = *reinterpret_cast<const float4*>(cw + tap * 128 + cc * 8 + 4);
        const float4 wk0 = *reinterpret_cast<const float4*>(cw + 384 + tap * 128 + cc * 8), wk1 = *reinterpret_cast<const float4*>(cw + 384 + tap * 128 + cc * 8 + 4);
        const float wq[8] = {wq0.x, wq0.y, wq0.z, wq0.w, wq1.x, wq1.y, wq1.z, wq1.w};
        const float wk[8] = {wk0.x, wk0.y, wk0.z, wk0.w, wk1.x, wk1.y, wk1.z, wk1.w};
#pragma unroll
        for (int e = 0; e < 8; ++e) {
          xq[e] += wq[e] * bf2f((u16)qr[e]);
          xk[e] += wk[e] * bf2f((u16)kr[e]);
        }
      }
#pragma unroll
      for (int e = 0; e < 8; ++e) {
        float qv = xq[e] * __builtin_amdgcn_rcpf(1.f + __expf(-xq[e]));
        kv[e] = xk[e] * __builtin_amdgcn_rcpf(1.f + __expf(-xk[e])) * kscale;
        if (e & 1) { qo[e >> 1] |= ((uint32_t)f2bf(qv)) << 16; ko[e >> 1] |= ((uint32_t)f2bf(kv[e])) << 16; }
        else { qo[e >> 1] = f2bf(qv); ko[e >> 1] = f2bf(kv[e]); }
        *reinterpret_cast<u16*>(KwT + tbase + e * TST) = f2bf(kv[e] * wend);
        *reinterpret_cast<u16*>(VT + tbase + e * TST) = (u16)rvv[i][e];
      }
      *reinterpret_cast<uint4*>(Qs + u * QST + cc * 16) = make_uint4(qo[0], qo[1], qo[2], qo[3]);
      *reinterpret_cast<uint4*>(Ks + u * QST + cc * 16) = make_uint4(ko[0], ko[1], ko[2], ko[3]);
    }
    __syncthreads();
    if (wid < 4) {
      const int sblk = wid & 1, tblk = wid >> 1;
      f32x16 S;
#pragma unroll
      for (int i = 0; i < 16; ++i) S[i] = 0.f;
#pragma unroll
      for (int ks = 0; ks < 8; ++ks) {
        bf16x8 kf = ld16(Ks + (sblk * 32 + pi32(r)) * QST + (ks * 16 + hh * 8) * 2);
        bf16x8 qf = ld16(Qs + (tblk * 32 + r) * QST + (ks * 16 + hh * 8) * 2);
        S = mfma32(kf, qf, S);
      }
      const int t = tblk * 32 + r;
      const float Mt = sM[t];
      float ds = 0.f, val[16];
#pragma unroll
      for (int i = 0; i < 16; ++i) {
        int s = sblk * 32 + 16 * (i >> 3) + 8 * hh + (i & 7);
        bool ok = dir ? (s >= t) : (s <= t);
        val[i] = ok ? S[i] * __expf(sa[s] - Mt) : 0.f;
        ds += val[i];
      }
      ds += __shfl_xor(ds, 32);
      if (hh == 0) denp[sblk * 64 + t] = ds;
#pragma unroll
      for (int s2 = 0; s2 < 2; ++s2)
        *reinterpret_cast<uint4*>(Sp + t * TST + (sblk * 32 + s2 * 16 + hh * 8) * 2) =
            make_uint4(pack2(val[8 * s2], val[8 * s2 + 1]), pack2(val[8 * s2 + 2], val[8 * s2 + 3]),
                       pack2(val[8 * s2 + 4], val[8 * s2 + 5]), pack2(val[8 * s2 + 6], val[8 * s2 + 7]));
    } else if (wid == 4) {
      float s = 0.f;
      const float* nc = nb + cur * 128;
      for (int k8 = 0; k8 < 16; ++k8) {
        bf16x8 qv = ld16(Qs + lane * QST + k8 * 16);
#pragma unroll
        for (int e = 0; e < 8; ++e) s += nc[k8 * 8 + e] * bf2f((u16)qv[e]);
      }
      qn[lane] = s;
    } else if (wid == 5) {
      const float* nc = nb + cur * 128;
      float* nn = nb + (cur ^ 1) * 128;
#pragma unroll
      for (int q2 = 0; q2 < 2; ++q2) {
        int k = lane + q2 * 64;
        float s = 0.f;
        for (int s8 = 0; s8 < 8; ++s8) {
          bf16x8 kv = ld16(KwT + k * TST + s8 * 16);
#pragma unroll
          for (int e = 0; e < 8; ++e) s += bf2f((u16)kv[e]);
        }
        nn[k] = decay * nc[k] + s;
      }
    }
    __syncthreads();
    {
      bf16x8 vf[4];
      const int vb = wid & 3, tb = wid >> 2;
#pragma unroll
      for (int ks = 0; ks < 4; ++ks) vf[ks] = ld16(VT + (vb * 32 + r) * TST + (((ks * 2 + hh) ^ ((r >> 3) | ((vb & 1) << 2))) << 4));
      const bool wr_h = (step >= 4) || need_ctx;
      {
        const int t = tb * 32 + r;
        f32x16 acc;
#pragma unroll
        for (int i = 0; i < 16; ++i) acc[i] = 0.f;
#pragma unroll
        for (int kb = 0; kb < 4; ++kb)
#pragma unroll
          for (int s2 = 0; s2 < 2; ++s2) {
            bf16x8 af = mk8(pack2(CT[kb][8 * s2], CT[kb][8 * s2 + 1]), pack2(CT[kb][8 * s2 + 2], CT[kb][8 * s2 + 3]),
                            pack2(CT[kb][8 * s2 + 4], CT[kb][8 * s2 + 5]), pack2(CT[kb][8 * s2 + 6], CT[kb][8 * s2 + 7]));
            uint2 lo = *reinterpret_cast<const uint2*>(Qs + t * QST + (kb * 32 + s2 * 16 + hh * 4) * 2);
            uint2 hi = *reinterpret_cast<const uint2*>(Qs + t * QST + (kb * 32 + s2 * 16 + 8 + hh * 4) * 2);
            acc = mfma32(af, mk8(lo.x, lo.y, hi.x, hi.y), acc);
          }
        const float Mt = sM[t];
        const float winter = __expf(mstate - Mt);
#pragma unroll
        for (int i = 0; i < 16; ++i) acc[i] *= winter;
#pragma unroll
        for (int ks = 0; ks < 4; ++ks) {
          bf16x8 sf = ld16(Sp + t * TST + (ks * 16 + hh * 8) * 2);
          acc = mfma32(vf[ks], sf, acc);
        }
        float den = denp[t] + denp[64 + t] + winter * qn[t];
        float sc = 1.f / fmaxf(fabsf(den), __expf(-(sb[t] + Mt)));
        if (wr_h) {
          u16* dst = hout + (size_t)(rowbase + t) * 512 + hd * 128 + vb * 32;
#pragma unroll
          for (int g4 = 0; g4 < 4; ++g4)
            *reinterpret_cast<uint2*>(dst + g4 * 8 + hh * 4) =
                make_uint2(pack2(acc[g4 * 4] * sc, acc[g4 * 4 + 1] * sc), pack2(acc[g4 * 4 + 2] * sc, acc[g4 * 4 + 3] * sc));
        }
      }
#pragma unroll
      for (int kb = 0; kb < 4; ++kb) {
#pragma unroll
        for (int i = 0; i < 16; ++i) CT[kb][i] *= decay;
#pragma unroll
        for (int ks = 0; ks < 4; ++ks) {
          bf16x8 kf = ld16(KwT + (kb * 32 + r) * TST + (((ks * 2 + hh) ^ ((r >> 3) | ((kb & 1) << 2))) << 4));
          CT[kb] = mfma32(kf, vf[ks], CT[kb]);
        }
      }
    }
    mstate = bend + Mend;
  }
  __syncthreads();
}

DEV int next_item(unsigned* ctr, int* s_item) {
  __syncthreads();
  if (my_tid() == 0) *s_item = (int)atomicAdd(ctr, 1u);
  __syncthreads();
  return *s_item;
}
DEV void phase_mixers(const Params& P, int l, char* smem) {
  const bool need_ctx = (l == 0);
  __shared__ int s_item;
  const int n_ml = 128, n_diff = 2048, n_win = 2048, n_dc = need_ctx ? 128 : 0, n_wc = need_ctx ? 128 : 0;
  for (;;) {
    int it = next_item(&WS_CTR(P)[l * 4 + 0], &s_item);
    if (it >= n_ml) break;
    mlstm_item(P, l, it >> 3, (it >> 1) & 3, it & 1, need_ctx, smem);
  }
  for (;;) {
    int it = next_item(&WS_CTR(P)[l * 4 + 1], &s_item);
    if (it >= n_diff + n_dc) break;
    bool cq = it >= n_diff;
    int i2 = it - n_diff;
    int b = cq ? i2 >> 3 : it >> 7, hd = cq ? (i2 >> 1) & 3 : (it >> 5) & 3, qt = cq ? i2 & 1 : it & 31;
    diff_item(P, l, b, hd, qt, cq, smem);
  }
  for (;;) {
    int it = next_item(&WS_CTR(P)[l * 4 + 2], &s_item);
    if (it >= n_win + n_wc) break;
    bool cq = it >= n_win;
    int i2 = it - n_win;
    int b = cq ? i2 >> 3 : it >> 7, g = cq ? (i2 >> 2) & 1 : (it >> 6) & 1, qb = cq ? i2 & 3 : it & 63;
    win_item(P, l, b, g, qb, cq, smem);
  }
}

DEV void phase_ya(const Params& P, int l, int nrows) {
  const int lane = my_tid() & 63, wid = my_tid() >> 6;
  const u16* hf = WS_HFB(P);
  const u16* hb = WS_HFB(P) + (size_t)MTOT * 512;
  for (int row = blockIdx.x * 8 + wid; row < nrows; row += gridDim.x * 8) {
    uint4 a = *reinterpret_cast<const uint4*>(hf + (size_t)row * 512 + lane * 8);
    uint4 bq = *reinterpret_cast<const uint4*>(hb + (size_t)row * 512 + lane * 8);
    uint4 o = *reinterpret_cast<const uint4*>(WS_P(P) + (size_t)row * PW + C_MO + lane * 8);
    uint32_t aa[4] = {a.x, a.y, a.z, a.w}, bb[4] = {bq.x, bq.y, bq.z, bq.w}, oo[4] = {o.x, o.y, o.z, o.w};
    float y[8], ss = 0.f;
#pragma unroll
    for (int j = 0; j < 4; ++j) {
      y[2 * j] = (bflo(aa[j]) + bflo(bb[j])) * sigmoidf_(bflo(oo[j]));
      y[2 * j + 1] = (bfhi(aa[j]) + bfhi(bb[j])) * sigmoidf_(bfhi(oo[j]));
      ss += y[2 * j] * y[2 * j] + y[2 * j + 1] * y[2 * j + 1];
    }
#pragma unroll
    for (int of = 1; of < 16; of <<= 1) ss += __shfl_xor(ss, of);
    float rstd = rsqrtf(ss * (1.f / 128.f) + EPS);
    const float* mn = P.m_norm + l * 512 + lane * 8;
    uint32_t w[4];
#pragma unroll
    for (int j = 0; j < 4; ++j) w[j] = pack2(y[2 * j] * rstd * mn[2 * j], y[2 * j + 1] * rstd * mn[2 * j + 1]);
    *reinterpret_cast<uint4*>(WS_P(P) + (size_t)row * PW + C_MO + lane * 8) = make_uint4(w[0], w[1], w[2], w[3]);
  }
}

DEV void phase_merge(const Params& P, int l, int M, char* smem) {
  const u16* Wl = WS_W(P) + (size_t)l * W_LAYER;
  u16* merged = WS_HFB(P);
  const int nM = M / 128, nN = 4;
  const int lane = my_tid() & 63, wid = my_tid() >> 6, wr = wid >> 2, wc = wid & 3, fr = lane & 15, fq = lane >> 4;
  for (int tile = blockIdx.x; tile < nM * nN; tile += gridDim.x) {
    int tm, tn;
    tile_coords(tile, nM * nN, nN, tm, tn);
    f32x4 mg[4][4];
    zero_acc<4, 4>(mg);
#pragma unroll 1
    for (int i = 0; i < 3; ++i) {
      f32x4 acc[4][4];
      zero_acc<4, 4>(acc);
      gemm_mainloop64(WS_H(P) + (size_t)tm * 128 * 1024, 1024, Wl + W_G + (size_t)(i * 1024 + tn * 256) * 1024, 1024, 1024, acc, smem);
      uint32_t gp[4][4][2];
#pragma unroll
      for (int mi = 0; mi < 4; ++mi)
#pragma unroll
        for (int ni = 0; ni < 4; ++ni) {
          gp[mi][ni][0] = pack2(sigmoidf_(acc[mi][ni][0]), sigmoidf_(acc[mi][ni][1]));
          gp[mi][ni][1] = pack2(sigmoidf_(acc[mi][ni][2]), sigmoidf_(acc[mi][ni][3]));
        }
      zero_acc<4, 4>(acc);
      int yc = i == 0 ? C_MO : (i == 1 ? C_WQ : C_DQ);
      gemm_mainloop64(WS_P(P) + (size_t)tm * 128 * PW + yc, PW, Wl + W_B + (size_t)i * 1024 * 512 + (size_t)(tn * 256) * 512, 512, 512, acc, smem);
#pragma unroll
      for (int mi = 0; mi < 4; ++mi)
#pragma unroll
        for (int ni = 0; ni < 4; ++ni) {
          mg[mi][ni][0] += bflo(gp[mi][ni][0]) * acc[mi][ni][0];
          mg[mi][ni][1] += bfhi(gp[mi][ni][0]) * acc[mi][ni][1];
          mg[mi][ni][2] += bflo(gp[mi][ni][1]) * acc[mi][ni][2];
          mg[mi][ni][3] += bfhi(gp[mi][ni][1]) * acc[mi][ni][3];
        }
    }
    const int row0 = tm * 128 + wr * 64, col0 = tn * 256 + wc * 64;
#pragma unroll
    for (int mi = 0; mi < 4; ++mi)
#pragma unroll
      for (int ni = 0; ni < 4; ++ni)
#pragma unroll
        for (int j = 0; j < 4; ++j)
          merged[(size_t)(row0 + mi * 16 + fq * 4 + j) * 1024 + col0 + ni * 16 + fr] = f2bf(mg[mi][ni][j]);
  }
}

struct EpiResid {
  const Params& P;
  const float* src_lat;
  const float* modl;
  int gt_off;
  DEV void operator()(f32x4 (&acc)[8][4], int row0, int col0) const {
    const int lane = my_tid() & 63, fr = lane & 15, fq = lane >> 4;
#pragma unroll
    for (int mi = 0; mi < 8; ++mi)
#pragma unroll
      for (int j = 0; j < 4; ++j) {
        int row = row0 + mi * 16 + fq * 4 + j;
        const float* src;
        float* dst;
        int cond;
        if (row < NLAT) { src = src_lat + (size_t)row * 1024; dst = P.out + (size_t)row * 1024; cond = row >> 12; }
        else { src = WS_XC(P) + (size_t)(row - NLAT) * 1024; dst = WS_XC(P) + (size_t)(row - NLAT) * 1024; cond = 16; }
        const float* gt = modl + (size_t)cond * 6144 + gt_off;
#pragma unroll
        for (int ni = 0; ni < 4; ++ni) {
          int col = col0 + ni * 16 + fr;
          dst[col] = src[col] + gt[col] * acc[mi][ni][j];
        }
      }
  }
};

struct EpiSwiglu {
  u16* act;
  DEV void operator()(f32x4 (&acc)[8][4], int row0, int col0) const {
    const int lane = my_tid() & 63, fr = lane & 15, fq = lane >> 4;
#pragma unroll
    for (int mi = 0; mi < 8; ++mi)
#pragma unroll
      for (int j = 0; j < 4; ++j) {
        int row = row0 + mi * 16 + fq * 4 + j;
#pragma unroll
        for (int pr = 0; pr < 2; ++pr) {
          float gte = acc[mi][pr * 2][j], up = acc[mi][pr * 2 + 1][j];
          act[(size_t)row * FH + ((col0 + pr * 32) >> 1) + fr] = f2bf(siluf_(gte) * up);
        }
      }
  }
};


namespace pg8 {
#define PG8_LAS __attribute__((address_space(3)))
constexpr int BM = 256, BK = 64, HALF = 128, HTB = HALF * BK * 2, NXCD = 8, WGM = 8;
DEV int lds_byte(int r, int c) { const int st = (r >> 4) * 2 + (c >> 5), rr = r & 15, cc = c & 31, ob = rr * 64 + cc * 2; return st * 1024 + (ob ^ (((ob >> 9) & 1) << 5)); }
DEV void stage_rc(int b, int& R, int& C) { const int st = b / 1024, sb = b % 1024, swz = sb ^ (((sb >> 9) & 1) << 5); R = (st >> 1) * 16 + swz / 64; C = (st & 1) * 32 + (swz % 64) / 2; }
struct Unit { int pm, pn; };
struct StaticOrder {
  int nM, nN, nwg, G, c;
  DEV void init(int M, int N, int G_, int c_) { nM = M / BM; nN = N / BM; nwg = nM * nN; G = G_; c = c_; }
  DEV bool next(int i, Unit& u) const {
    const long L = (long)i * G + c;
    if (L >= nwg) return false;
    int wgid = (int)L;
    { const int q = nwg / NXCD, r = nwg % NXCD, xcd = wgid % NXCD, off = wgid / NXCD; wgid = (xcd < r ? xcd * (q + 1) : r * (q + 1) + (xcd - r) * q) + off; }
    const int nig = WGM * nN, gid = wgid / nig, fm = gid * WGM, gsz = (nM - fm) < WGM ? (nM - fm) : WGM;
    u.pm = fm + ((wgid % nig) % gsz);
    u.pn = (wgid % nig) / gsz;
    return true;
  }
};
template <class Epi>
DEV void gemm_phase(char* smem, const u16* A, int lda, const u16* Bt, int ldb, int M, int N, int K, const Epi& E) {
  PG8_LAS unsigned char* lds = (PG8_LAS unsigned char*)smem;
  const int tid = my_tid(), wid = __builtin_amdgcn_readfirstlane(tid >> 6), lane = tid & 63, wr = wid >> 2, wc = wid & 3, fr = lane & 15, fq = lane >> 4;
  const int nt = K / BK;
  StaticOrder S;
  S.init(M, N, gridDim.x, blockIdx.x);
  unsigned voffA[2], voffB[2];
#pragma unroll
  for (int i = 0; i < 2; ++i) { int R, C; stage_rc(tid * 16 + i * 8192, R, C); voffA[i] = (unsigned)(R * lda + C) * 2u; voffB[i] = (unsigned)(R * ldb + C) * 2u; }
  const size_t kstep = (size_t)(BK * 2);
  const size_t hstepA = (size_t)HALF * lda * 2, hstepB = (size_t)HALF * ldb * 2;
  const size_t tstepA = 2 * hstepA, tstepB = 2 * hstepB;
  const unsigned ldsw = (unsigned)wid * 1024u;
  const int aoff = lds_byte(wr * 64 + fr, fq * 8), boff = lds_byte(wc * 32 + fr, fq * 8);
#define PG8_SA(b, h) (((b) * 2 + (h)) * HTB)
#define PG8_SB(b, h) ((4 + (b) * 2 + (h)) * HTB)
#define PG8_STAGE(bufoff, gbase, voff) do { _Pragma("unroll") for (int _i = 0; _i < 2; ++_i) \
        __builtin_amdgcn_global_load_lds((const unsigned*)((const char*)(gbase) + (voff)[_i]), (PG8_LAS unsigned*)(lds + (bufoff) + ldsw + _i * 8192), 16, 0, 0); } while (0)
#define PG8_LDA(dst, b, h) do { _Pragma("unroll") for (int m = 0; m < 4; ++m) _Pragma("unroll") for (int k = 0; k < 2; ++k) dst[m][k] = *(const PG8_LAS bf16x8*)(lds + PG8_SA(b, h) + aoff + m * 2048 + k * 1024); } while (0)
#define PG8_LDB(dst, b, h) do { _Pragma("unroll") for (int n = 0; n < 2; ++n) _Pragma("unroll") for (int k = 0; k < 2; ++k) dst[n][k] = *(const PG8_LAS bf16x8*)(lds + PG8_SB(b, h) + boff + n * 2048 + k * 1024); } while (0)
#define PG8_MMA(ai, bj, At, Bt_) do { __builtin_amdgcn_s_setprio(1); _Pragma("unroll") for (int m = 0; m < 4; ++m) _Pragma("unroll") for (int n = 0; n < 2; ++n) _Pragma("unroll") for (int k = 0; k < 2; ++k) \
        acc[ai][bj][m][n] = __builtin_amdgcn_mfma_f32_16x16x32_bf16(Bt_[n][k], At[m][k], acc[ai][bj][m][n], 0, 0, 0); __builtin_amdgcn_s_setprio(0); } while (0)
#define PG8_WAIT_V(n) asm volatile("s_waitcnt vmcnt(" #n ")" ::: "memory")
#define PG8_WAIT_L(n) asm volatile("s_waitcnt lgkmcnt(" #n ")" ::: "memory")
#define PG8_BAR __builtin_amdgcn_s_barrier()
#define PG8_SCHED __builtin_amdgcn_sched_barrier(0)
  Unit cur, nxt;
  int ui = 0;
  PG8_WAIT_V(0);
  __syncthreads();
  if (!S.next(0, cur)) return;
  f32x4 acc[2][2][4][2];
#pragma unroll
  for (int a = 0; a < 2; ++a)
#pragma unroll
    for (int b = 0; b < 2; ++b)
#pragma unroll
      for (int m = 0; m < 4; ++m)
#pragma unroll
        for (int n = 0; n < 2; ++n) acc[a][b][m][n] = (f32x4){0.f, 0.f, 0.f, 0.f};
  bf16x8 At[4][2], B0[2][2], B1[2][2];
  const char* cA = (const char*)A + (size_t)cur.pm * tstepA;
  const char* cB = (const char*)Bt + (size_t)cur.pn * tstepB;
  PG8_STAGE(PG8_SB(0, 0), cB, voffB); PG8_STAGE(PG8_SA(0, 0), cA, voffA); PG8_STAGE(PG8_SB(0, 1), cB + hstepB, voffB); PG8_STAGE(PG8_SA(0, 1), cA + hstepA, voffA);
  if (wr == 1) PG8_BAR;
  PG8_WAIT_V(4); PG8_BAR;
  PG8_STAGE(PG8_SB(1, 0), cB + kstep, voffB); PG8_STAGE(PG8_SA(1, 0), cA + kstep, voffA); PG8_STAGE(PG8_SB(1, 1), cB + hstepB + kstep, voffB);
  PG8_WAIT_V(6); PG8_BAR;
  for (;;) {
    const bool has_next = S.next(ui + 1, nxt);
    const char* nA = has_next ? (const char*)A + (size_t)nxt.pm * tstepA : cA;
    const char* nB = has_next ? (const char*)Bt + (size_t)nxt.pn * tstepB : cB;
    for (int t = 0; t < nt; t += 2) {
      const bool last = (t == nt - 2);
      const char* a1 = cA + (size_t)(t + 1) * kstep;
      const char* a2 = last ? nA : cA + (size_t)(t + 2) * kstep;
      const char* b2 = last ? nB : cB + (size_t)(t + 2) * kstep;
      const char* a3 = a2 + kstep;
      const char* b3 = b2 + kstep;
      PG8_LDB(B0, 0, 0); PG8_SCHED; PG8_LDA(At, 0, 0); PG8_STAGE(PG8_SA(1, 1), a1 + hstepA, voffA);
      PG8_WAIT_L(8); PG8_BAR; PG8_WAIT_L(0); PG8_MMA(0, 0, At, B0); PG8_BAR; PG8_SCHED;
      PG8_LDB(B1, 0, 1); PG8_STAGE(PG8_SB(0, 0), b2, voffB);
      PG8_BAR; PG8_WAIT_L(0); PG8_MMA(0, 1, At, B1); PG8_BAR;
      PG8_LDA(At, 0, 1); PG8_STAGE(PG8_SA(0, 0), a2, voffA);
      PG8_BAR; PG8_WAIT_L(0); PG8_MMA(1, 0, At, B0); PG8_BAR; PG8_SCHED;
      PG8_STAGE(PG8_SB(0, 1), b2 + hstepB, voffB);
      PG8_WAIT_V(6); PG8_BAR; PG8_MMA(1, 1, At, B1); PG8_BAR;
      PG8_LDB(B0, 1, 0); PG8_SCHED; PG8_LDA(At, 1, 0); PG8_STAGE(PG8_SA(0, 1), a2 + hstepA, voffA);
      PG8_WAIT_L(8); PG8_BAR; PG8_WAIT_L(0); PG8_MMA(0, 0, At, B0); PG8_BAR; PG8_SCHED;
      PG8_LDB(B1, 1, 1); PG8_STAGE(PG8_SB(1, 0), b3, voffB);
      PG8_BAR; PG8_WAIT_L(0); PG8_MMA(0, 1, At, B1); PG8_BAR;
      PG8_LDA(At, 1, 1); PG8_STAGE(PG8_SA(1, 0), a3, voffA);
      PG8_BAR; PG8_WAIT_L(0); PG8_MMA(1, 0, At, B0); PG8_BAR; PG8_SCHED;
      PG8_STAGE(PG8_SB(1, 1), b3 + hstepB, voffB);
      PG8_WAIT_V(6); PG8_BAR; PG8_MMA(1, 1, At, B1); PG8_BAR;
    }
    E(acc, cur, wr, wc, fr, fq);
    if (!has_next) break;
#pragma unroll
    for (int a = 0; a < 2; ++a)
#pragma unroll
      for (int b = 0; b < 2; ++b)
#pragma unroll
        for (int m = 0; m < 4; ++m)
#pragma unroll
          for (int n = 0; n < 2; ++n) acc[a][b][m][n] = (f32x4){0.f, 0.f, 0.f, 0.f};
    cur = nxt; cA = nA; cB = nB; ++ui;
  }
  PG8_WAIT_V(0);
  if (wr == 0) PG8_BAR;
  PG8_BAR;
#undef PG8_SA
#undef PG8_SB
#undef PG8_STAGE
#undef PG8_LDA
#undef PG8_LDB
#undef PG8_MMA
#undef PG8_WAIT_V
#undef PG8_WAIT_L
#undef PG8_BAR
#undef PG8_SCHED
}

struct EpiInProjT {
  const Params& P;
  int l;
  DEV void operator()(const f32x4 (&acc)[2][2][4][2], const Unit& u, int wr, int wc, int fr, int fq) const {
#pragma unroll
    for (int bj = 0; bj < 2; ++bj) {
      const int cg = u.pn * 256 + bj * 128 + wc * 32;
      if (cg >= 4368) continue;
#pragma unroll
      for (int ai = 0; ai < 2; ++ai)
#pragma unroll
        for (int m = 0; m < 4; ++m) {
          const int row = u.pm * 256 + ai * 128 + wr * 64 + m * 16 + fr;
          const f32x4 v0 = acc[ai][bj][m][0], v1 = acc[ai][bj][m][1];
          if (cg < C_WQ) {
            u16* dst = WS_P(P) + (size_t)row * PW + cg + 4 * fq;
            *reinterpret_cast<uint2*>(dst) = make_uint2(pack2(v0[0], v0[1]), pack2(v0[2], v0[3]));
            *reinterpret_cast<uint2*>(dst + 16) = make_uint2(pack2(v1[0], v1[1]), pack2(v1[2], v1[3]));
          } else if (cg < 3712) {
            const bool isq = (cg < C_WK) || (cg >= C_DQ && cg < C_DK);
            const float qs = isq ? 0.125f : 1.f;
            u16* dst = WS_P(P) + (size_t)row * PW + cg + 4 * fq;
            float o1[4], o2[4];
            if (row < NLAT) {
              const int t = row & (T - 1), hf = (cg >> 5) & 1;
              const float4* rt = reinterpret_cast<const float4*>(WS_ROPE(P) + ((size_t)t * 32 + hf * 16 + 4 * fq) * 2);
              const float4 c01 = rt[0], c23 = rt[1];
              const float cs[4] = {c01.x, c01.z, c23.x, c23.z}, sn[4] = {c01.y, c01.w, c23.y, c23.w};
#pragma unroll
              for (int e = 0; e < 4; ++e) { o1[e] = (v0[e] * cs[e] - v1[e] * sn[e]) * qs; o2[e] = (v1[e] * cs[e] + v0[e] * sn[e]) * qs; }
            } else {
#pragma unroll
              for (int e = 0; e < 4; ++e) { o1[e] = v0[e] * qs; o2[e] = v1[e] * qs; }
            }
            *reinterpret_cast<uint2*>(dst) = make_uint2(pack2(o1[0], o1[1]), pack2(o1[2], o1[3]));
            *reinterpret_cast<uint2*>(dst + 16) = make_uint2(pack2(o2[0], o2[1]), pack2(o2[2], o2[3]));
          } else if (cg < 4352) {
            int b, key;
            if (row < NLAT) { b = row >> 12; key = 256 + (row & (T - 1)); }
            else { b = (row - NLAT) >> 8; key = (row - NLAT) & 255; }
            u16* base;
            int v0i;
            if (cg < 3840) { base = WS_VTW(P) + ((size_t)(b * 2 + ((cg - 3712) >> 6)) * 64) * KEYS; v0i = (cg - 3712) & 63; }
            else { base = WS_VTD(P) + ((size_t)(b * 4 + ((cg - 3840) >> 7)) * 128) * KEYS; v0i = (cg - 3840) & 127; }
#pragma unroll
            for (int e = 0; e < 4; ++e) {
              base[(size_t)(v0i + 4 * fq + e) * KEYS + key] = f2bf(v0[e]);
              base[(size_t)(v0i + 16 + 4 * fq + e) * KEYS + key] = f2bf(v1[e]);
            }
          } else {
            const float4 bg = *reinterpret_cast<const float4*>(P.b_gate + l * 16 + 4 * fq);
            *reinterpret_cast<float4*>(WS_GATES(P) + (size_t)row * 16 + 4 * fq) = make_float4(v0[0] + bg.x, v0[1] + bg.y, v0[2] + bg.z, v0[3] + bg.w);
          }
        }
    }
  }
};
struct EpiResidT {
  const Params& P;
  const float* src_lat;
  const float* modl;
  int gt_off;
  DEV void operator()(const f32x4 (&acc)[2][2][4][2], const Unit& u, int wr, int wc, int fr, int fq) const {
#pragma unroll
    for (int ai = 0; ai < 2; ++ai)
#pragma unroll
      for (int m = 0; m < 4; ++m) {
        const int row = u.pm * 256 + ai * 128 + wr * 64 + m * 16 + fr;
        const float* src;
        float* dst;
        int cond;
        if (row < NLAT) { src = src_lat + (size_t)row * 1024; dst = P.out + (size_t)row * 1024; cond = row >> 12; }
        else { src = WS_XC(P) + (size_t)(row - NLAT) * 1024; dst = WS_XC(P) + (size_t)(row - NLAT) * 1024; cond = 16; }
        const float* gt = modl + (size_t)cond * 6144 + gt_off;
#pragma unroll
        for (int bj = 0; bj < 2; ++bj)
#pragma unroll
          for (int n = 0; n < 2; ++n) {
            const int col = u.pn * 256 + bj * 128 + wc * 32 + n * 16 + 4 * fq;
            const float4 s4 = *reinterpret_cast<const float4*>(src + col), g4 = *reinterpret_cast<const float4*>(gt + col);
            const f32x4 a = acc[ai][bj][m][n];
            *reinterpret_cast<float4*>(dst + col) = make_float4(s4.x + g4.x * a[0], s4.y + g4.y * a[1], s4.z + g4.z * a[2], s4.w + g4.w * a[3]);
          }
      }
  }
};
struct EpiSwigluT {
  u16* act;
  DEV void operator()(const f32x4 (&acc)[2][2][4][2], const Unit& u, int wr, int wc, int fr, int fq) const {
#pragma unroll
    for (int ai = 0; ai < 2; ++ai)
#pragma unroll
      for (int m = 0; m < 4; ++m) {
        const int row = u.pm * 256 + ai * 128 + wr * 64 + m * 16 + fr;
#pragma unroll
        for (int bj = 0; bj < 2; ++bj) {
          const int cg = u.pn * 256 + bj * 128 + wc * 32;
          const f32x4 g = acc[ai][bj][m][0], up = acc[ai][bj][m][1];
          *reinterpret_cast<uint2*>(act + (size_t)row * FH + (cg >> 1) + 4 * fq) =
              make_uint2(pack2(siluf_(g[0]) * up[0], siluf_(g[1]) * up[1]), pack2(siluf_(g[2]) * up[2], siluf_(g[3]) * up[3]));
        }
      }
  }
};
}


#ifdef SELFCHECK
#define DBGF(P) reinterpret_cast<float*>((P).ws + O_XC + (size_t)NCTXR * 1024 * 4)
DEV float blk_reduce(float v, bool ismax, float* red) {
  const int tid = my_tid(), lane = tid & 63, wid = tid >> 6;
#pragma unroll
  for (int o = 32; o > 0; o >>= 1) { float t = __shfl_xor(v, o); v = ismax ? fmaxf(v, t) : v + t; }
  __syncthreads();
  if (lane == 0) red[wid] = v;
  __syncthreads();
  float r = red[0];
  for (int i = 1; i < 8; ++i) r = ismax ? fmaxf(r, red[i]) : r + red[i];
  __syncthreads();
  return r;
}
DEV void chk_sample(int s, int& b, int& hd, int& t) {
  const int ti = s & 7;
  b = (s * 5 + 3) & 15; hd = s & 7;
  t = ti == 0 ? 0 : ti == 1 ? 63 : ti == 2 ? 64 : ti == 3 ? 127 : ti == 4 ? 2048 + 65 : ti == 5 ? 3000 : ti == 6 ? 4032 : 4095;
}
DEV void check_pre(const Params& P, int l, char* smem) {
  const int tid = my_tid();
  float* sc = reinterpret_cast<float*>(smem);
  float* red = sc + 2 * 4352;
  float* ov = red + 16;
  float* dbg = DBGF(P);
  const u16* p = WS_P(P);
  for (int it = blockIdx.x; it < 24; it += gridDim.x) {
    const bool isdiff = it >= 12;
    const int s = isdiff ? it - 12 : it;
    int b, hd, t;
    chk_sample(s, b, hd, t);
    const bool ctxq = s >= 8;
    if (ctxq) t &= 255;
    const size_t row = ctxq ? (size_t)NLAT + b * 256 + t : (size_t)b * T + t;
    __syncthreads();
    if (!isdiff) {
      const int head = hd, g = head >> 2;
      const int lo = ctxq ? 0 : max(0, t - 128), hi = ctxq ? -1 : min(T - 1, t + 128);
      const int nk = 256 + (hi - lo + 1);
      float mx = -1e30f;
      for (int k = tid; k < nk; k += NTHREADS) {
        size_t krow = k < 256 ? (size_t)NLAT + b * 256 + k : (size_t)b * T + lo + (k - 256);
        float a = 0.f;
        for (int d = 0; d < 64; ++d) a += bf2f(p[row * PW + C_WQ + head * 64 + d]) * bf2f(p[krow * PW + C_WK + g * 64 + d]);
        sc[k] = a;
        mx = fmaxf(mx, a);
      }
      mx = blk_reduce(mx, true, red);
      const float sk = P.sink[l * 8 + head];
      mx = fmaxf(mx, sk);
      float sm = 0.f;
      for (int k = tid; k < nk; k += NTHREADS) { float e = expf(sc[k] - mx); sc[k] = e; sm += e; }
      sm = blk_reduce(sm, false, red) + expf(sk - mx);
      if (tid < 64) {
        float o = 0.f;
        for (int k = 0; k < nk; ++k) {
          int kidx = k < 256 ? k : 256 + lo + (k - 256);
          o += sc[k] * bf2f(WS_VTW(P)[((size_t)(b * 2 + g) * 64 + tid) * KEYS + kidx]);
        }
        dbg[it * 128 + tid] = o / sm;
      }
    } else {
      const int h = hd & 3;
      const int nk = ctxq ? 256 : KEYS;
      float mx0 = -1e30f, mx1 = -1e30f;
      for (int k = tid; k < nk; k += NTHREADS) {
        size_t krow = k < 256 ? (size_t)NLAT + b * 256 + k : (size_t)b * T + (k - 256);
        float a0 = 0.f, a1 = 0.f;
        for (int d = 0; d < 64; ++d) {
          a0 += bf2f(p[row * PW + C_DQ + h * 128 + d]) * bf2f(p[krow * PW + C_DK + h * 128 + d]);
          a1 += bf2f(p[row * PW + C_DQ + h * 128 + 64 + d]) * bf2f(p[krow * PW + C_DK + h * 128 + 64 + d]);
        }
        sc[k] = a0; sc[4352 + k] = a1;
        mx0 = fmaxf(mx0, a0); mx1 = fmaxf(mx1, a1);
      }
      mx0 = blk_reduce(mx0, true, red);
      mx1 = blk_reduce(mx1, true, red);
      float s0 = 0.f, s1 = 0.f;
      for (int k = tid; k < nk; k += NTHREADS) {
        float e0 = expf(sc[k] - mx0), e1 = expf(sc[4352 + k] - mx1);
        sc[k] = e0; sc[4352 + k] = e1; s0 += e0; s1 += e1;
      }
      s0 = blk_reduce(s0, false, red);
      s1 = blk_reduce(s1, false, red);
      const float lam = WS_LAM(P)[l], lam_init = 0.8f - 0.6f * expf(-0.3f * (float)l);
      float y = 0.f;
      if (tid < 128) {
        for (int k = 0; k < nk; ++k)
          y += (sc[k] / s0 - lam * sc[4352 + k] / s1) * bf2f(WS_VTD(P)[((size_t)(b * 4 + h) * 128 + tid) * KEYS + k]);
        ov[tid] = y;
      }
      __syncthreads();
      if (tid < 128) {
        float ss = 0.f;
        for (int v = 0; v < 128; ++v) ss += ov[v] * ov[v];
        dbg[it * 128 + tid] = y * rsqrtf(ss / 128.f + EPS) * P.d_norm[l * 512 + h * 128 + tid] * (1.f - lam_init);
      }
    }
  }
}
DEV void check_post(const Params& P, int l, unsigned* flags) {
  const int tid = my_tid();
  const float* dbg = DBGF(P);
  const u16* p = WS_P(P);
  for (int it = blockIdx.x; it < 24; it += gridDim.x) {
    const bool isdiff = it >= 12;
    const int s = isdiff ? it - 12 : it;
    int b, hd, t;
    chk_sample(s, b, hd, t);
    const bool ctxq = s >= 8;
    if (ctxq) t &= 255;
    const size_t row = ctxq ? (size_t)NLAT + b * 256 + t : (size_t)b * T + t;
    if (ctxq && l != 0) continue;
    const int n = isdiff ? 128 : 64;
    if (tid < n) {
      float got = isdiff ? bf2f(p[row * PW + C_DQ + (hd & 3) * 128 + tid]) : bf2f(p[row * PW + C_WQ + hd * 64 + tid]);
      float ex = dbg[it * 128 + tid];
      if (!(fabsf(got - ex) <= 0.03f + 0.03f * fabsf(ex))) atomicOr(flags, isdiff ? (ctxq ? 32u : 2u) : (ctxq ? 16u : 1u));
    }
  }
}
DEV void check_mlstm(const Params& P, int l, char* smem, unsigned* flags) {
  const int tid = my_tid(), lane = tid & 63;
  float* qs = reinterpret_cast<float*>(smem);
  float* ks = qs + 128;
  float* vs = ks + 128;
  float* nn = vs + 128;
  float* sc = nn + 128;
  float* red = sc + 8;
  const u16* p = WS_P(P);
  for (int it = blockIdx.x; it < 4; it += gridDim.x) {
    const int b = (it * 7 + 2) & 15, hd = (it + 1) & 3, dir = it & 1;
    const int v = tid >> 2, kq = tid & 3;
    float C[32];
#pragma unroll
    for (int j = 0; j < 32; ++j) C[j] = 0.f;
    __syncthreads();
    if (tid < 128) nn[tid] = 0.f;
    if (tid == 0) sc[0] = 0.f;
    __syncthreads();
    const int nsteps = (l == 0) ? 256 + T : 256 + T;
    for (int st = 0; st < nsteps; ++st) {
      int seg0, seglen, u;
      if (st < 256) { seg0 = NLAT + b * 256; seglen = 256; u = dir ? 255 - st : st; }
      else { seg0 = b * T; seglen = T; u = dir ? T - 1 - (st - 256) : st - 256; }
      const size_t row = (size_t)seg0 + u;
      if (tid < 128) {
        float xq = 0.f, xk = 0.f;
        for (int tp = 0; tp < 3; ++tp) {
          int uu = u + tp - 1;
          if (uu >= 0 && uu < seglen) {
            xq += P.conv_w[(size_t)l * 3072 + tp * 1024 + hd * 128 + tid] * bf2f(p[((size_t)seg0 + uu) * PW + C_MQ + hd * 128 + tid]);
            xk += P.conv_w[(size_t)l * 3072 + tp * 1024 + 512 + hd * 128 + tid] * bf2f(p[((size_t)seg0 + uu) * PW + C_MK + hd * 128 + tid]);
          }
        }
        qs[tid] = xq / (1.f + expf(-xq));
        ks[tid] = xk / (1.f + expf(-xk)) * 0.08838834764831845f;
        vs[tid] = bf2f(p[row * PW + C_MV + hd * 128 + tid]);
      }
      if (tid == 0) {
        float ig = WS_GATES(P)[row * 16 + dir * 8 + hd], fg = WS_GATES(P)[row * 16 + dir * 8 + 4 + hd];
        float lf = fminf(fg, 0.f) - log1pf(expf(-fabsf(fg)));
        float m = sc[0], mn = fmaxf(lf + m, ig);
        sc[1] = expf(lf + m - mn);
        sc[2] = expf(ig - mn);
        sc[3] = mn;
      }
      __syncthreads();
      const float fd = sc[1], iw = sc[2], mn = sc[3];
      float pd = 0.f;
#pragma unroll
      for (int j = 0; j < 32; ++j) {
        C[j] = fd * C[j] + iw * vs[v] * ks[kq * 32 + j];
        pd += C[j] * qs[kq * 32 + j];
      }
      pd += __shfl_xor(pd, 1);
      pd += __shfl_xor(pd, 2);
      float dn = 0.f;
      if (tid < 128) { float nv = fd * nn[tid] + iw * ks[tid]; nn[tid] = nv; dn = nv * qs[tid]; }
      dn = blk_reduce(dn, false, red);
      if (tid == 0) sc[0] = mn;
      const float hval = pd / fmaxf(fabsf(dn), expf(-mn));
      float sq = (kq == 0) ? hval * hval : 0.f;
      sq = blk_reduce(sq, false, red);
      const float rms = sqrtf(sq / 128.f);
      const bool cmp = (st < 256) ? (l == 0) : true;
      if (cmp && kq == 0 && ((u & 63) == 0 || (u & 63) == 63 || (u % 97) == 0)) {
        float got = bf2f(WS_HFB(P)[(size_t)dir * MTOT * 512 + row * 512 + hd * 128 + v]);
        if (!(fabsf(got - hval) <= 0.05f * rms + 0.05f * fabsf(hval) + 1e-3f)) atomicOr(flags, dir ? 8u : 4u);
      }
    }
  }
}
#endif


#ifdef SELFCHECK
DEV void flag_if(bool bad, unsigned* flags, unsigned bit) { if (bad) atomicOr(flags, bit); }
DEV bool close_(float got, float ex, float tol) { return fabsf(got - ex) <= tol + tol * fabsf(ex); }
DEV void check_inproj(const Params& P, int l, char* smem, unsigned* flags) {
  const int tid = my_tid();
  float* red = reinterpret_cast<float*>(smem);
  float* hrow = red + 16;
  const float* modl = WS_MOD(P) + (size_t)l * 17 * 6144;
  for (int it = blockIdx.x; it < 64; it += gridDim.x) {
    const int ri = it & 7;
    const int row = ri == 0 ? 0 : ri == 1 ? 4095 : ri == 2 ? 4096 + 77 : ri == 3 ? 30000 : ri == 4 ? 65535 : ri == 5 ? NLAT : ri == 6 ? NLAT + 300 : MTOT - 1;
    const int cond = row < NLAT ? row >> 12 : 16;
    {
      int col = (it * 769 + 5) % 6144;
      float a = 0.f;
      for (int k = tid; k < 1024; k += NTHREADS) {
        float cv = cond < 16 ? P.c[cond * 1024 + k] : P.c_ctx[k];
        a += cv / (1.f + expf(-cv)) * P.w_mod[(size_t)l * 1024 * 6144 + (size_t)k * 6144 + col];
      }
      a = blk_reduce(a, false, red) + P.b_mod[l * 6144 + col];
      if (tid == 0) flag_if(!close_(modl[(size_t)cond * 6144 + col], a, 2e-3f), flags, 1u);
    }
    const float* xs = row < NLAT ? ((l == 0 ? P.x : P.out) + (size_t)row * 1024) : (WS_XC(P) + (size_t)(row - NLAT) * 1024);
    float ss = 0.f;
    for (int k = tid; k < 1024; k += NTHREADS) ss += xs[k] * xs[k];
    ss = blk_reduce(ss, false, red);
    const float rstd = rsqrtf(ss / 1024.f + EPS);
    for (int k = tid; k < 1024; k += NTHREADS) {
      float y = xs[k] * rstd * P.g_mix[l * 1024 + k] * (1.f + modl[(size_t)cond * 6144 + 1024 + k]) + modl[(size_t)cond * 6144 + k];
      hrow[k] = y;
      flag_if(!close_(bf2f(WS_H(P)[(size_t)row * 1024 + k]), y, 1e-2f), flags, 2u);
    }
    __syncthreads();
    const int oi = it >> 3;
    const int oj = (oi * 2 + (it & 1)) & 15;
    const int oc = oj == 0 ? 3 : oj == 1 ? 600 : oj == 2 ? 1100 : oj == 3 ? 1999 : oj == 4 ? 2050 : oj == 5 ? 2064 + 70 : oj == 6 ? 2576 + 100 :
                   oj == 7 ? 2704 + 5 : oj == 8 ? 2832 + 200 : oj == 9 ? 2832 + 37 : oj == 10 ? 3344 + 90 : oj == 11 ? 3344 + 300 :
                   oj == 12 ? 3856 + 10 : oj == 13 ? 3856 + 500 : oj == 14 ? 2048 + 15 : 2064 + 500;
    auto dotcol = [&](int c) {
      float a = 0.f;
      for (int k = tid; k < 1024; k += NTHREADS) a += hrow[k] * P.w_in[(size_t)l * 1024 * INW + (size_t)k * INW + c];
      return blk_reduce(a, false, red);
    };
    float val = dotcol(oc);
    const u16* p = WS_P(P);
    const bool lat = row < NLAT;
    const int t = row & (T - 1);
    float got = 0.f, ex = val;
    unsigned bit = 4u;
    if (oc < 2048) { got = bf2f(p[(size_t)row * PW + oc]); }
    else if (oc < 2064) { got = WS_GATES(P)[(size_t)row * 16 + oc - 2048]; ex = val + P.b_gate[l * 16 + oc - 2048]; }
    else if (oc >= 2704 && oc < 2832) {
      int cgi = oc - 2704, g = cgi >> 6, vd = cgi & 63;
      int b = lat ? row >> 12 : (row - NLAT) >> 8, key = lat ? 256 + t : (row - NLAT) & 255;
      got = bf2f(WS_VTW(P)[((size_t)(b * 2 + g) * 64 + vd) * KEYS + key]);
      bit = 8u;
    } else if (oc >= 3856) {
      int cgi = oc - 3856, h = cgi >> 7, vd = cgi & 127;
      int b = lat ? row >> 12 : (row - NLAT) >> 8, key = lat ? 256 + t : (row - NLAT) & 255;
      got = bf2f(WS_VTD(P)[((size_t)(b * 4 + h) * 128 + vd) * KEYS + key]);
      bit = 8u;
    } else {
      int base, nb0;
      bool isq;
      if (oc < 2576) { base = 2064; nb0 = C_WQ; isq = true; }
      else if (oc < 2704) { base = 2576; nb0 = C_WK; isq = false; }
      else if (oc < 3344) { base = 2832; nb0 = C_DQ; isq = true; }
      else { base = 3344; nb0 = C_DK; isq = false; }
      int rel = oc - base, dd = rel & 63, j = dd & 15, second = (dd >> 4) & 1, axis = dd >> 5;
      float other = dotcol(second ? oc - 16 : oc + 16);
      if (lat) {
        int pos = axis ? (t & 63) : (t >> 6);
        float ang = (float)pos * powf(10000.f, -(float)j / 16.f);
        float cs = cosf(ang), sn = sinf(ang);
        ex = second ? (val * cs + other * sn) : (val * cs - other * sn);
      }
      if (isq) ex *= 0.125f;
      got = bf2f(p[(size_t)row * PW + nb0 + rel]);
      bit = 16u;
    }
    if (tid == 0) flag_if(!close_(got, ex, 3e-2f), flags, bit);
    __syncthreads();
  }
}
DEV void check_post6(const Params& P, int l, char* smem, unsigned* flags, const float* xprev) {
  const int tid = my_tid();
  float* red = reinterpret_cast<float*>(smem);
  const u16* Yp = WS_P(P);
  const float* modl = WS_MOD(P) + (size_t)l * 17 * 6144;
  for (int it = blockIdx.x; it < 16; it += gridDim.x) {
    const int ri = it & 7;
    const int row = ri == 0 ? 1 : ri == 1 ? 4097 : ri == 2 ? 12345 : ri == 3 ? 40000 : ri == 4 ? 65534 : ri == 5 ? NLAT + 1 : ri == 6 ? NLAT + 2000 : MTOT - 2;
    if (row >= NLAT && l != 0) continue;
    const int col = (it * 331 + 17) & 1023;
    const int cond = row < NLAT ? row >> 12 : 16;
    float mg = 0.f;
    for (int i = 0; i < 3; ++i) {
      float a = 0.f, z = 0.f;
      for (int k = tid; k < 1024; k += NTHREADS) a += bf2f(WS_H(P)[(size_t)row * 1024 + k]) * P.w_in[(size_t)l * 1024 * INW + (size_t)k * INW + 4368 + i * 1024 + col];
      a = blk_reduce(a, false, red);
      const int yc = i == 0 ? C_MO : (i == 1 ? C_WQ : C_DQ);
      for (int k = tid; k < 512; k += NTHREADS) z += bf2f(Yp[(size_t)row * PW + yc + k]) * P.w_branch[((size_t)l * 3 + i) * 512 * 1024 + (size_t)k * 1024 + col];
      z = blk_reduce(z, false, red);
      mg += z / (1.f + expf(-a));
    }
    if (tid == 0) flag_if(!close_(bf2f(WS_HFB(P)[(size_t)row * 1024 + col]), mg, 3e-2f), flags, 1u);
    float o = 0.f;
    for (int k = tid; k < 1024; k += NTHREADS) o += bf2f(WS_HFB(P)[(size_t)row * 1024 + k]) * P.w_out[(size_t)l * 1024 * 1024 + (size_t)k * 1024 + col];
    o = blk_reduce(o, false, red);
    const float xo = row < NLAT ? xprev[(size_t)row * 1024 + col] : -1e9f;
    const float xn = row < NLAT ? P.out[(size_t)row * 1024 + col] : WS_XC(P)[(size_t)(row - NLAT) * 1024 + col];
    if (tid == 0 && row < NLAT && (l == 0)) flag_if(!close_(xn, xo + modl[(size_t)cond * 6144 + 2048 + col] * o, 2e-2f), flags, 2u);
    if (tid == 0) DBGF(P)[4096 + it] = xn;
  }
}
DEV void check_post9(const Params& P, int l, char* smem, unsigned* flags) {
  const int tid = my_tid();
  float* red = reinterpret_cast<float*>(smem);
  const float* modl = WS_MOD(P) + (size_t)l * 17 * 6144;
  for (int it = blockIdx.x; it < 16; it += gridDim.x) {
    const int ri = it & 7;
    const int row = ri == 0 ? 1 : ri == 1 ? 4097 : ri == 2 ? 12345 : ri == 3 ? 40000 : ri == 4 ? 65534 : ri == 5 ? NLAT + 1 : ri == 6 ? NLAT + 2000 : MTOT - 2;
    if (row >= NLAT && l != 0) continue;
    const int col = (it * 331 + 17) & 1023;
    const int cond = row < NLAT ? row >> 12 : 16;
    const int j = (it * 97 + 13) % FH;
    float g = 0.f, u = 0.f;
    for (int k = tid; k < 1024; k += NTHREADS) {
      float hv = bf2f(WS_H(P)[(size_t)row * 1024 + k]);
      g += hv * P.w_ffn_in[(size_t)l * 1024 * 5632 + (size_t)k * 5632 + j];
      u += hv * P.w_ffn_in[(size_t)l * 1024 * 5632 + (size_t)k * 5632 + FH + j];
    }
    g = blk_reduce(g, false, red);
    u = blk_reduce(u, false, red);
    if (tid == 0) flag_if(!close_(bf2f(WS_P(P)[(size_t)row * FH + j]), g / (1.f + expf(-g)) * u, 3e-2f), flags, 4u);
    float o = 0.f;
    for (int k = tid; k < FH; k += NTHREADS) o += bf2f(WS_P(P)[(size_t)row * FH + k]) * P.w_ffn_out[(size_t)l * FH * 1024 + (size_t)k * 1024 + col];
    o = blk_reduce(o, false, red);
    const float xn = row < NLAT ? P.out[(size_t)row * 1024 + col] : WS_XC(P)[(size_t)(row - NLAT) * 1024 + col];
    if (tid == 0) flag_if(!close_(xn, DBGF(P)[4096 + it] + modl[(size_t)cond * 6144 + 5120 + col] * o, 2e-2f), flags, 8u);
  }
}
#endif

#ifdef DEBUG_STAGE
DEV void debug_dump(const Params& P, int stage) {
  const int tid = my_tid();
  for (size_t idx = (size_t)blockIdx.x * NTHREADS + tid; idx < (size_t)NLAT * 1024; idx += (size_t)gridDim.x * NTHREADS) {
    size_t row = idx >> 10;
    int c = (int)(idx & 1023);
    size_t r2 = row + (row < 4096 ? NLAT : 0);
    float v = 0.f;
    const u16* p = WS_P(P);
    if (stage == 1) {
      v = bf2f(p[row * PW + c]) + bf2f(p[row * PW + 1024 + c]) + bf2f(p[row * PW + 2048 + c]) + (c < 640 ? bf2f(p[row * PW + 3072 + c]) : 0.f);
      v += bf2f(p[r2 * PW + c]) + bf2f(p[r2 * PW + 1024 + c]) + bf2f(p[r2 * PW + 2048 + c]);
      v += bf2f(WS_VTD(P)[r2 * 512 + (c & 511)]) + bf2f(WS_VTW(P)[r2 * 128 + (c & 127)]) + WS_GATES(P)[r2 * 16 + (c & 15)];
      v += bf2f(WS_VTD(P)[row * 512 + (c & 511)]) + bf2f(WS_VTW(P)[row * 128 + (c & 127)]) + WS_GATES(P)[row * 16 + (c & 15)];
    } else if (stage == 21) {
      v = bf2f(WS_HFB(P)[row * 512 + (c & 511)]) + 2.f * bf2f(WS_HFB(P)[(size_t)MTOT * 512 + row * 512 + (c & 511)]);
      v += bf2f(WS_HFB(P)[r2 * 512 + (c & 511)]) + 2.f * bf2f(WS_HFB(P)[(size_t)MTOT * 512 + r2 * 512 + (c & 511)]);
    } else if (stage == 22) {
      v = bf2f(p[row * PW + C_WQ + (c & 511)]) + bf2f(p[r2 * PW + C_WQ + (c & 511)]);
    } else if (stage == 23) {
      v = bf2f(p[row * PW + C_DQ + (c & 511)]) + bf2f(p[r2 * PW + C_DQ + (c & 511)]);
    } else if (stage == 3) {
      v = bf2f(WS_HFB(P)[row * 1024 + c]) + bf2f(WS_HFB(P)[r2 * 1024 + c]);
    } else if (stage == 4) {
      v = P.out[idx] + WS_XC(P)[(row & 4095) * 1024 + c];
    } else if (stage == 5) {
      v = bf2f(WS_H(P)[row * 1024 + c]) + bf2f(WS_H(P)[r2 * 1024 + c]);
    } else if (stage == 6) {
      v = bf2f(p[row * FH + c]) + bf2f(p[row * FH + 1024 + c]) + bf2f(p[r2 * FH + 1792 + c]);
    }
    if (stage != 4) P.out[idx] = v; else P.out[idx] = v;
  }
}
#define DBG(st) if (l == 0 && DEBUG_STAGE == st) { GSYNC_ONLY(); debug_dump(P, st); return true; }
#else
#define DBG(st)
#endif
template <int l>
DEV bool layer_body(const Params& P, unsigned* bar, unsigned& epoch, char* smem) {
  constexpr bool need_ctx = (l == 0);
  const float* modl = WS_MOD(P) + (size_t)l * 17 * 6144;
  const u16* Wl = WS_W(P) + (size_t)l * W_LAYER;
  const float* xlat = l == 0 ? P.x : P.out;
  constexpr int Mtok = need_ctx ? MTOT : NLAT;
  phase_norm_mod(P, xlat, WS_XC(P), MTOT, P.g_mix + l * 1024, modl, 0, 1024);
  GSYNC();
  pg8::gemm_phase(smem, WS_H(P), 1024, Wl + W_IN, 1024, MTOT, NIN, 1024, pg8::EpiInProjT{P, l});
#ifdef REPEAT_GEMMS
  if (l == 1) pg8::gemm_phase(smem, WS_H(P), 1024, Wl + W_IN, 1024, MTOT, NIN, 1024, pg8::EpiInProjT{P, l});
#endif
  GSYNC();
  DBG(1)
#ifdef SELFCHECK
#if SELFCHECK == 2
  check_inproj(P, l, smem, WS_CTR(P) + 16 + l * 3);
#else
  check_pre(P, l, smem);
#endif
  GSYNC();
#endif
  phase_mixers(P, l, smem);
  GSYNC();
#if defined(SELFCHECK) && SELFCHECK == 1
  check_post(P, l, WS_CTR(P) + 17 + l * 3);
  check_mlstm(P, l, smem, WS_CTR(P) + 17 + l * 3);
  GSYNC();
#endif
  DBG(21)
  DBG(22)
  DBG(23)
  phase_ya(P, l, Mtok);
  GSYNC();
  phase_merge(P, l, Mtok, smem);
#ifdef REPEAT_GEMMS
  if (l == 1) phase_merge(P, l, Mtok, smem);
#endif
  GSYNC();
  DBG(3)
  pg8::gemm_phase(smem, WS_HFB(P), 1024, Wl + W_O, 1024, Mtok, 1024, 1024, pg8::EpiResidT{P, xlat, modl, 2048});
  GSYNC();
#if defined(SELFCHECK) && SELFCHECK == 2
  check_post6(P, l, smem, WS_CTR(P) + 18 + l * 3, xlat);
  GSYNC();
#endif
  DBG(4)
  phase_norm_mod(P, P.out, WS_XC(P), Mtok, P.g_ffn + l * 1024, modl, 3072, 4096);
  GSYNC();
  DBG(5)
  pg8::gemm_phase(smem, WS_H(P), 1024, Wl + W_FI, 1024, Mtok, 5632, 1024, pg8::EpiSwigluT{WS_P(P)});
#ifdef REPEAT_GEMMS
  if (l == 1) pg8::gemm_phase(smem, WS_H(P), 1024, Wl + W_FI, 1024, Mtok, 5632, 1024, pg8::EpiSwigluT{WS_P(P)});
#endif
  GSYNC();
  DBG(6)
  pg8::gemm_phase(smem, WS_P(P), FH, Wl + W_FO, FH, Mtok, 1024, FH, pg8::EpiResidT{P, P.out, modl, 5120});
  GSYNC();
#if defined(SELFCHECK) && SELFCHECK == 2
  check_post9(P, l, smem, WS_CTR(P) + 18 + l * 3);
  GSYNC();
#endif
  return false;
}

__global__ void __launch_bounds__(NTHREADS) fwd_megakernel(Params P) {
  extern __shared__ __attribute__((aligned(16))) char smem[];
  cg::grid_group grid = cg::this_grid();
  unsigned* bar = WS_CTR(P) + 64;
  unsigned epoch = 0;
  grid.sync();
  phase_prologue(P, smem);
  GSYNC();
  if (layer_body<0>(P, bar, epoch, smem)) return;
  if (layer_body<1>(P, bar, epoch, smem)) return;
  phase_final_norm(P);
#ifdef SELFCHECK
  GSYNC();
  if (blockIdx.x == 0 && my_tid() == 0) {
    float scale = 1000.f;
    for (int w = 0; w < 6; ++w) {
      unsigned f = WS_CTR(P)[16 + w];
      if (f) { P.out[0] = (10.f + (float)f) * scale; break; }
      scale *= 10.f;
    }
  }
#endif
}

extern "C" void kernel_launch(void* const* d_in, const int* in_sizes, int n_in, void* d_out, int out_size, void* d_ws,
                              size_t ws_size, hipStream_t stream) {
  static int grid_blocks = 0;
  if (!grid_blocks) {
    int dev = 0, cus = 0, per_cu = 0;
    hipGetDevice(&dev);
    hipDeviceGetAttribute(&cus, hipDeviceAttributeMultiprocessorCount, dev);
    hipFuncSetAttribute((const void*)fwd_megakernel, hipFuncAttributeMaxDynamicSharedMemorySize, LDS_BYTES);
    hipOccupancyMaxActiveBlocksPerMultiprocessor(&per_cu, fwd_megakernel, NTHREADS, LDS_BYTES);
    if (per_cu < 1) per_cu = 1;
    if (per_cu > 1) per_cu = 1;
    grid_blocks = cus * per_cu;
  }
  Params P{};
  const float* const* in = reinterpret_cast<const float* const*>(d_in);
  P.x = in[0]; P.c = in[1]; P.ctx = in[2]; P.c_ctx = in[3]; P.w_mod = in[4]; P.b_mod = in[5]; P.g_mix = in[6];
  P.g_ffn = in[7]; P.w_in = in[8]; P.b_gate = in[9]; P.conv_w = in[10]; P.m_norm = in[11]; P.sink = in[12];
  P.lam_q1 = in[13]; P.lam_k1 = in[14]; P.lam_q2 = in[15]; P.lam_k2 = in[16]; P.d_norm = in[17]; P.w_branch = in[18];
  P.w_out = in[19]; P.w_ffn_in = in[20]; P.w_ffn_out = in[21]; P.g_final = in[22];
  P.out = reinterpret_cast<float*>(d_out);
  P.ws = reinterpret_cast<char*>(d_ws);
  if (WS_TOTAL > ws_size) fprintf(stderr, "workspace too small: need %zu have %zu\n", (size_t)WS_TOTAL, ws_size);
  hipMemsetAsync(P.ws + O_CTR, 0, 2048, stream);
  void* args[] = {&P};
  hipError_t e = hipLaunchCooperativeKernel((const void*)fwd_megakernel, dim3(grid_blocks), dim3(NTHREADS), args, LDS_BYTES, stream);
  if (e != hipSuccess) fprintf(stderr, "cooperative launch failed: %s (grid %d)\n", hipGetErrorString(e), grid_blocks);
}
```

```cpp
#include <hip/hip_runtime.h>
#include <hip/hip_cooperative_groups.h>
#include <cstdio>
#include <cstdint>
namespace cg = cooperative_groups;

typedef unsigned short u16;
using bf16x8 = __attribute__((ext_vector_type(8))) short;
using f32x4 = __attribute__((ext_vector_type(4))) float;
using f32x16 = __attribute__((ext_vector_type(16))) float;

#define DEV __device__ __forceinline__

constexpr int D = 1024, NB = 16, T = 4096, TC = 256;
constexpr int NLAT = NB * T;
constexpr int NCTXR = NB * TC;
constexpr int MTOT = NLAT + NCTXR;
constexpr int KEYS = T + TC;
constexpr int INW = 7440;
constexpr int PW = 3712;
constexpr int C_MQ = 0, C_MK = 512, C_MV = 1024, C_MO = 1536, C_WQ = 2048, C_WK = 2560, C_DQ = 2688, C_DK = 3200;
constexpr int NIN = 4608;
constexpr int FH = 2816;
constexpr float EPS = 1e-6f;
constexpr float L2E = 1.4426950408889634f;
constexpr int NTHREADS = 512;
constexpr int LDS_BYTES = 147456;

constexpr size_t W_IN = 0;
constexpr size_t W_G = W_IN + (size_t)NIN * 1024;
constexpr size_t W_B = W_G + (size_t)3072 * 1024;
constexpr size_t W_O = W_B + (size_t)3 * 1024 * 512;
constexpr size_t W_FI = W_O + (size_t)1024 * 1024;
constexpr size_t W_FO = W_FI + (size_t)5632 * 1024;
constexpr size_t W_LAYER = W_FO + (size_t)1024 * FH;

struct Params {
  const float *x, *c, *ctx, *c_ctx, *w_mod, *b_mod, *g_mix, *g_ffn, *w_in, *b_gate, *conv_w, *m_norm, *sink;
  const float *lam_q1, *lam_k1, *lam_q2, *lam_k2, *d_norm, *w_branch, *w_out, *w_ffn_in, *w_ffn_out, *g_final;
  float* out;
  char* ws;
};


constexpr size_t al256(size_t x) { return (x + 255) & ~(size_t)255; }
constexpr size_t O_W = 0;
constexpr size_t O_MOD = O_W + al256(2 * W_LAYER * 2);
constexpr size_t O_ROPE = O_MOD + al256((size_t)2 * 17 * 6144 * 4);
constexpr size_t O_LAM = O_ROPE + al256((size_t)T * 32 * 2 * 4);
constexpr size_t O_CTR = O_LAM + 256;
constexpr size_t O_GATES = O_CTR + 2048;
constexpr size_t O_H = O_GATES + al256((size_t)MTOT * 16 * 4);
constexpr size_t O_P = O_H + al256((size_t)MTOT * 1024 * 2);
constexpr size_t O_VTW = O_P + al256((size_t)MTOT * PW * 2);
constexpr size_t O_VTD = O_VTW + al256((size_t)NB * 2 * 64 * KEYS * 2);
constexpr size_t O_HFB = O_VTD + al256((size_t)NB * 4 * 128 * KEYS * 2);
constexpr size_t O_XC = O_HFB + al256((size_t)2 * MTOT * 512 * 2);
constexpr size_t WS_TOTAL = O_XC + al256((size_t)NCTXR * 1024 * 4) + 65536;
#define WS_W(P) reinterpret_cast<u16*>((P).ws + O_W)
#define WS_MOD(P) reinterpret_cast<float*>((P).ws + O_MOD)
#define WS_ROPE(P) reinterpret_cast<float*>((P).ws + O_ROPE)
#define WS_LAM(P) reinterpret_cast<float*>((P).ws + O_LAM)
#define WS_CTR(P) reinterpret_cast<unsigned*>((P).ws + O_CTR)
#define WS_GATES(P) reinterpret_cast<float*>((P).ws + O_GATES)
#define WS_H(P) reinterpret_cast<u16*>((P).ws + O_H)
#define WS_P(P) reinterpret_cast<u16*>((P).ws + O_P)
#define WS_VTW(P) reinterpret_cast<u16*>((P).ws + O_VTW)
#define WS_VTD(P) reinterpret_cast<u16*>((P).ws + O_VTD)
#define WS_HFB(P) reinterpret_cast<u16*>((P).ws + O_HFB)
#define WS_XC(P) reinterpret_cast<float*>((P).ws + O_XC)

DEV int my_tid() {
  int t = threadIdx.x;
  asm volatile("" : "+v"(t));
  return t;
}
typedef __bf16 bf2_t __attribute__((ext_vector_type(2)));
typedef float f2_t __attribute__((ext_vector_type(2)));
DEV uint32_t pack2(float a, float b) {
  f2_t v = {a, b};
  bf2_t r = __builtin_convertvector(v, bf2_t);
  return *reinterpret_cast<uint32_t*>(&r);
}
DEV u16 f2bf(float f) { return (u16)(pack2(f, 0.f) & 0xffffu); }
DEV float bf2f(u16 h) { return __uint_as_float(((uint32_t)h) << 16); }
DEV float bflo(uint32_t v) { return __uint_as_float(v << 16); }
DEV float bfhi(uint32_t v) { return __uint_as_float(v & 0xffff0000u); }
DEV float fexp2(float x) { return __builtin_amdgcn_exp2f(x); }
DEV float sigmoidf_(float x) { return 1.f / (1.f + __expf(-x)); }
DEV float siluf_(float x) { return x / (1.f + __expf(-x)); }
DEV float wave_sum(float v) {
#pragma unroll
  for (int o = 32; o > 0; o >>= 1) v += __shfl_xor(v, o);
  return v;
}
DEV bf16x8 ld16(const void* p) { return *reinterpret_cast<const bf16x8*>(p); }
DEV bf16x8 mk8(uint32_t a, uint32_t b, uint32_t c, uint32_t d) {
  uint4 u = make_uint4(a, b, c, d);
  return *reinterpret_cast<bf16x8*>(&u);
}
DEV f32x16 mfma32(bf16x8 a, bf16x8 b, f32x16 c) { return __builtin_amdgcn_mfma_f32_32x32x16_bf16(a, b, c, 0, 0, 0); }
DEV f32x4 mfma16(bf16x8 a, bf16x8 b, f32x4 c) { return __builtin_amdgcn_mfma_f32_16x16x32_bf16(a, b, c, 0, 0, 0); }
DEV int pi32(int r) { return (r & ~12) | ((r & 4) << 1) | ((r & 8) >> 1); }


DEV void grid_barrier(unsigned* bar, unsigned& epoch) {
  asm volatile("s_waitcnt vmcnt(0)" ::: "memory");
  __syncthreads();
  epoch += 1;
  if (my_tid() == 0) {
    __builtin_amdgcn_fence(__ATOMIC_RELEASE, "agent");
    unsigned* loc = bar + 32 + (blockIdx.x & 7) * 32;
    const unsigned per = gridDim.x >> 3;
    unsigned old = __hip_atomic_fetch_add(loc, 1u, __ATOMIC_RELAXED, __HIP_MEMORY_SCOPE_AGENT);
    if (old + 1 == per * epoch) __hip_atomic_fetch_add(bar, 1u, __ATOMIC_RELAXED, __HIP_MEMORY_SCOPE_AGENT);
    while (__hip_atomic_load(bar, __ATOMIC_RELAXED, __HIP_MEMORY_SCOPE_AGENT) < 8u * epoch) __builtin_amdgcn_s_sleep(1);
    __builtin_amdgcn_fence(__ATOMIC_ACQUIRE, "agent");
  }
  __syncthreads();
}
#define GSYNC() grid_barrier(bar, epoch)
#define GSYNC_ONLY()

template <int N>
DEV void wait_vm() { asm volatile("s_waitcnt vmcnt(%0)" ::"n"(N) : "memory"); }

template <int MI, int NI>
DEV void gemm_mainloop(const u16* __restrict__ A, int lda, const u16* __restrict__ Bt, int ldb, int K,
                       f32x4 (&acc)[MI][NI], char* smem) {
  constexpr int BM = 32 * MI, BN = 64 * NI;
  constexpr int NA = BM * 4 / NTHREADS, NBL = BN * 4 / NTHREADS;
  constexpr int ABYTES = BM * 64, BBYTES = BN * 64, SBYTES = ABYTES + BBYTES;
  constexpr int NL = NA + NBL;
  const int tid = my_tid(), lane = tid & 63, wid = tid >> 6, wr = wid >> 2, wc = wid & 3, fr = lane & 15, fq = lane >> 4;
  const int nk = K / 32;
  auto stage = [&](int kt) {
    char* base = smem + (kt & 3) * SBYTES;
#pragma unroll
    for (int i = 0; i < NA; ++i) {
      int id = tid + i * NTHREADS, r = id >> 2, c = (id & 3) ^ (((r >> 3) & 1) * 3);
      __builtin_amdgcn_global_load_lds((const unsigned*)(A + (size_t)r * lda + kt * 32 + c * 8), (unsigned*)(base + id * 16), 16, 0, 0);
    }
#pragma unroll
    for (int i = 0; i < NBL; ++i) {
      int id = tid + i * NTHREADS, r = id >> 2, c = (id & 3) ^ (((r >> 3) & 1) * 3);
      __builtin_amdgcn_global_load_lds((const unsigned*)(Bt + (size_t)r * ldb + kt * 32 + c * 8), (unsigned*)(base + ABYTES + id * 16), 16, 0, 0);
    }
  };
  wait_vm<0>();
  __syncthreads();
  stage(0);
  if (nk > 1) stage(1);
  if (nk > 2) stage(2);
  for (int kt = 0; kt < nk; ++kt) {
    if (kt + 2 < nk) wait_vm<2 * NL>();
    else if (kt + 1 < nk) wait_vm<NL>();
    else wait_vm<0>();
    asm volatile("" ::: "memory");
    __builtin_amdgcn_s_barrier();
    asm volatile("" ::: "memory");
    const char* As = smem + (kt & 3) * SBYTES;
    const char* Bs = As + ABYTES;
    bf16x8 bfr[NI], af[MI];
#pragma unroll
    for (int ni = 0; ni < NI; ++ni) {
      int r = wc * (NI * 16) + ni * 16 + fr;
      bfr[ni] = ld16(Bs + r * 64 + ((fq ^ (((r >> 3) & 1) * 3)) << 4));
    }
#pragma unroll
    for (int mi = 0; mi < MI; ++mi) {
      int r = wr * (MI * 16) + mi * 16 + fr;
      af[mi] = ld16(As + r * 64 + ((fq ^ (((r >> 3) & 1) * 3)) << 4));
    }
    if (kt + 3 < nk) stage(kt + 3);
    __builtin_amdgcn_sched_barrier(0);
    __builtin_amdgcn_s_setprio(1);
#pragma unroll
    for (int mi = 0; mi < MI; ++mi)
#pragma unroll
      for (int ni = 0; ni < NI; ++ni) acc[mi][ni] = mfma16(af[mi], bfr[ni], acc[mi][ni]);
    __builtin_amdgcn_s_setprio(0);
    __builtin_amdgcn_sched_barrier(0);
  }
}


DEV void gemm_mainloop64(const u16* __restrict__ A, int lda, const u16* __restrict__ Bt, int ldb, int K, f32x4 (&acc)[4][4], char* smem) {
  constexpr int ABYTES = 128 * 128, BBYTES = 256 * 128, SBYTES = ABYTES + BBYTES;
  constexpr int NA = 2, NBL = 4, NL = NA + NBL;
  const int tid = my_tid(), lane = tid & 63, wid = tid >> 6, wr = wid >> 2, wc = wid & 3, fr = lane & 15, fq = lane >> 4;
  const int nk = K / 64;
  auto stage = [&](int kt) {
    char* base = smem + (kt % 3) * SBYTES;
#pragma unroll
    for (int i = 0; i < NA; ++i) {
      int id = tid + i * NTHREADS, r = id >> 3, c = (id & 7) ^ ((r >> 1) & 7);
      __builtin_amdgcn_global_load_lds((const unsigned*)(A + (size_t)r * lda + kt * 64 + c * 8), (unsigned*)(base + id * 16), 16, 0, 0);
    }
#pragma unroll
    for (int i = 0; i < NBL; ++i) {
      int id = tid + i * NTHREADS, r = id >> 3, c = (id & 7) ^ ((r >> 1) & 7);
      __builtin_amdgcn_global_load_lds((const unsigned*)(Bt + (size_t)r * ldb + kt * 64 + c * 8), (unsigned*)(base + ABYTES + id * 16), 16, 0, 0);
    }
  };
  wait_vm<0>();
  __syncthreads();
  stage(0);
  if (nk > 1) stage(1);
  for (int kt = 0; kt < nk; ++kt) {
    if (kt + 1 < nk) wait_vm<NL>();
    else wait_vm<0>();
    asm volatile("" ::: "memory");
    __builtin_amdgcn_s_barrier();
    asm volatile("" ::: "memory");
    if (kt + 2 < nk) stage(kt + 2);
    const char* As = smem + (kt % 3) * SBYTES;
    const char* Bs = As + ABYTES;
#pragma unroll
    for (int ks = 0; ks < 2; ++ks) {
      bf16x8 bfr[4], af[4];
#pragma unroll
      for (int ni = 0; ni < 4; ++ni) {
        int r = wc * 64 + ni * 16 + fr;
        bfr[ni] = ld16(Bs + r * 128 + (((ks * 4 + fq) ^ ((r >> 1) & 7)) << 4));
      }
#pragma unroll
      for (int mi = 0; mi < 4; ++mi) {
        int r = wr * 64 + mi * 16 + fr;
        af[mi] = ld16(As + r * 128 + (((ks * 4 + fq) ^ ((r >> 1) & 7)) << 4));
      }
#pragma unroll
      for (int mi = 0; mi < 4; ++mi)
#pragma unroll
        for (int ni = 0; ni < 4; ++ni) acc[mi][ni] = mfma16(af[mi], bfr[ni], acc[mi][ni]);
      __builtin_amdgcn_sched_barrier(0);
    }
  }
}

template <int MI, int NI>
DEV void zero_acc(f32x4 (&acc)[MI][NI]) {
#pragma unroll
  for (int mi = 0; mi < MI; ++mi)
#pragma unroll
    for (int ni = 0; ni < NI; ++ni) acc[mi][ni] = f32x4{0.f, 0.f, 0.f, 0.f};
}


DEV void tile_coords(int tile, int total, int nN, int& tm, int& tn) {
  int t = tile;
  if (gridDim.x == 256 && tile < (total & ~255)) {
    int j = tile & 255;
    t = (tile & ~255) + (j & 7) * 32 + (j >> 3);
  }
  int p = t / (4 * nN), q = t - p * (4 * nN);
  tn = q >> 2;
  tm = p * 4 + (q & 3);
}

template <int MI, class Epi>
DEV void gemm_phase(const u16* A, int lda, const u16* Bt, int ldb, int M, int N, int K, Epi epi, char* smem) {
  constexpr int BM = 32 * MI;
  const int nM = M / BM, nN = N / 256;
  const int wid = my_tid() >> 6, wr = wid >> 2, wc = wid & 3;
  for (int tile = blockIdx.x; tile < nM * nN; tile += gridDim.x) {
    int tm, tn;
    tile_coords(tile, nM * nN, nN, tm, tn);
    f32x4 acc[MI][4];
    zero_acc<MI, 4>(acc);
    gemm_mainloop<MI, 4>(A + (size_t)tm * BM * lda, lda, Bt + (size_t)tn * 256 * ldb, ldb, K, acc, smem);
    epi(acc, tm * BM + wr * (MI * 16), tn * 256 + wc * 64);
  }
}

DEV int map_col(int type, int n) {
  if (type == 0) {
    if (n < 2048) return n;
    if (n < 2688) return n + 16;
    if (n < 3712) return n + 144;
    if (n < 3840) return n - 1008;
    if (n < 4352) return n + 16;
    if (n < 4368) return n - 2304;
    return -1;
  }
  if (type == 1) return n + 4368;
  if (type == 2) return n;
  int q = n >> 5, r = n & 31;
  return r < 16 ? (q * 16 + r) : (FH + q * 16 + r - 16);
}

DEV void tr_tile(const float* __restrict__ src, int ldsrc, u16* __restrict__ dst, int K, int n0, int k0, int type, char* smem) {
  float* tile = reinterpret_cast<float*>(smem);
  const int tid = my_tid();
  {
    int n = tid & 63, sc = map_col(type, n0 + n);
#pragma unroll
    for (int i = 0; i < 8; ++i) {
      int k = (tid >> 6) + 8 * i;
      tile[k * 65 + n] = sc >= 0 ? src[(size_t)(k0 + k) * ldsrc + sc] : 0.f;
    }
  }
  __syncthreads();
  {
    int n = tid >> 3, kc = tid & 7;
    uint32_t w[4];
#pragma unroll
    for (int j = 0; j < 4; ++j) w[j] = pack2(tile[(kc * 8 + 2 * j) * 65 + n], tile[(kc * 8 + 2 * j + 1) * 65 + n]);
    *reinterpret_cast<uint4*>(dst + (size_t)(n0 + n) * K + k0 + kc * 8) = make_uint4(w[0], w[1], w[2], w[3]);
  }
  __syncthreads();
}

DEV void phase_prologue(const Params& P, char* smem) {
  const int tid = my_tid();
  constexpr int TPL = 4672;
  for (int it = blockIdx.x; it < 2 * TPL; it += gridDim.x) {
    int l = it / TPL, t = it % TPL;
    u16* Wl = WS_W(P) + (size_t)l * W_LAYER;
    if (t < 1152) {
      tr_tile(P.w_in + (size_t)l * 1024 * INW, INW, Wl + W_IN, 1024, (t / 16) * 64, (t % 16) * 64, 0, smem);
    } else if (t < 1920) {
      t -= 1152;
      tr_tile(P.w_in + (size_t)l * 1024 * INW, INW, Wl + W_G, 1024, (t / 16) * 64, (t % 16) * 64, 1, smem);
    } else if (t < 2304) {
      t -= 1920;
      int i = t / 128;
      t %= 128;
      tr_tile(P.w_branch + ((size_t)l * 3 + i) * 512 * 1024, 1024, Wl + W_B + (size_t)i * 1024 * 512, 512, (t / 8) * 64, (t % 8) * 64, 2, smem);
    } else if (t < 2560) {
      t -= 2304;
      tr_tile(P.w_out + (size_t)l * 1024 * 1024, 1024, Wl + W_O, 1024, (t / 16) * 64, (t % 16) * 64, 2, smem);
    } else if (t < 3968) {
      t -= 2560;
      tr_tile(P.w_ffn_in + (size_t)l * 1024 * 5632, 5632, Wl + W_FI, 1024, (t / 16) * 64, (t % 16) * 64, 3, smem);
    } else {
      t -= 3968;
      tr_tile(P.w_ffn_out + (size_t)l * FH * 1024, 1024, Wl + W_FO, FH, (t / 44) * 64, (t % 44) * 64, 2, smem);
    }
  }
  for (int it = blockIdx.x; it < 384; it += gridDim.x) {
    int l = it / 192, n0 = (it % 192) * 32;
    float* sc = reinterpret_cast<float*>(smem);
    float* red = sc + 17 * 1024;
    __syncthreads();
    for (int idx = tid; idx < 17 * 1024; idx += NTHREADS) {
      int cond = idx >> 10, k = idx & 1023;
      float cv = cond < 16 ? P.c[cond * 1024 + k] : P.c_ctx[k];
      sc[idx] = siluf_(cv);
    }
    __syncthreads();
    int col = tid & 31, ks = tid >> 5;
    float acc[17];
#pragma unroll
    for (int j = 0; j < 17; ++j) acc[j] = 0.f;
    const float* wm = P.w_mod + (size_t)l * 1024 * 6144 + n0 + col;
    for (int k = ks * 64; k < ks * 64 + 64; ++k) {
      float w = wm[(size_t)k * 6144];
#pragma unroll
      for (int j = 0; j < 17; ++j) acc[j] += sc[j * 1024 + k] * w;
    }
#pragma unroll
    for (int j = 0; j < 17; ++j) red[(ks * 17 + j) * 32 + col] = acc[j];
    __syncthreads();
    for (int o = tid; o < 17 * 32; o += NTHREADS) {
      int j = o >> 5, cc = o & 31;
      float s = 0.f;
      for (int q = 0; q < 16; ++q) s += red[(q * 17 + j) * 32 + cc];
      WS_MOD(P)[((size_t)l * 17 + j) * 6144 + n0 + cc] = s + P.b_mod[l * 6144 + n0 + cc];
    }
  }
  for (int idx = blockIdx.x * NTHREADS + tid; idx < T * 32; idx += gridDim.x * NTHREADS) {
    int t = idx >> 5, j = idx & 31;
    int pos = j < 16 ? (t >> 6) : (t & 63);
    float inv = powf(10000.f, -(float)(j & 15) / 16.f);
    float ang = (float)pos * inv;
    WS_ROPE(P)[idx * 2] = cosf(ang);
    WS_ROPE(P)[idx * 2 + 1] = sinf(ang);
  }
  for (int idx = blockIdx.x * NTHREADS + tid; idx < NCTXR * 1024 / 4; idx += gridDim.x * NTHREADS)
    reinterpret_cast<float4*>(WS_XC(P))[idx] = reinterpret_cast<const float4*>(P.ctx)[idx];
  if (blockIdx.x == 0 && tid < 64) {
    for (int l = 0; l < 2; ++l) {
      float a = wave_sum(P.lam_q1[l * 64 + tid] * P.lam_k1[l * 64 + tid]);
      float b = wave_sum(P.lam_q2[l * 64 + tid] * P.lam_k2[l * 64 + tid]);
      float lam_init = 0.8f - 0.6f * expf(-0.3f * (float)l);
      if (tid == 0) WS_LAM(P)[l] = expf(a) - expf(b) + lam_init;
    }
    if (tid < 8) WS_CTR(P)[tid] = 0u;
  }
}

DEV void phase_norm_mod(const Params& P, const float* xlat, const float* xctx, int nrows, const float* g,
                        const float* modl, int sh_off, int sc_off) {
  const int lane = my_tid() & 63, wid = my_tid() >> 6;
  for (int row = blockIdx.x * 8 + wid; row < nrows; row += gridDim.x * 8) {
    const float* src = row < NLAT ? xlat + (size_t)row * 1024 : xctx + (size_t)(row - NLAT) * 1024;
    int cond = row < NLAT ? row >> 12 : 16;
    const float* md = modl + (size_t)cond * 6144;
    float4 v[4];
    float ss = 0.f;
#pragma unroll
    for (int i = 0; i < 4; ++i) {
      { f32x4 t4 = __builtin_nontemporal_load(reinterpret_cast<const f32x4*>(src + i * 256 + lane * 4)); v[i] = make_float4(t4[0], t4[1], t4[2], t4[3]); }
      ss += v[i].x * v[i].x + v[i].y * v[i].y + v[i].z * v[i].z + v[i].w * v[i].w;
    }
    ss = wave_sum(ss);
    float rstd = rsqrtf(ss * (1.f / 1024.f) + EPS);
#pragma unroll
    for (int i = 0; i < 4; ++i) {
      int cb = i * 256 + lane * 4;
      float4 gg = *reinterpret_cast<const float4*>(g + cb);
      float4 sh = *reinterpret_cast<const float4*>(md + sh_off + cb);
      float4 sc = *reinterpret_cast<const float4*>(md + sc_off + cb);
      float y0 = v[i].x * rstd * gg.x * (1.f + sc.x) + sh.x;
      float y1 = v[i].y * rstd * gg.y * (1.f + sc.y) + sh.y;
      float y2 = v[i].z * rstd * gg.z * (1.f + sc.z) + sh.z;
      float y3 = v[i].w * rstd * gg.w * (1.f + sc.w) + sh.w;
      *reinterpret_cast<uint2*>(WS_H(P) + (size_t)row * 1024 + cb) = make_uint2(pack2(y0, y1), pack2(y2, y3));
    }
  }
}

DEV void phase_final_norm(const Params& P) {
  const int lane = my_tid() & 63, wid = my_tid() >> 6;
  for (int row = blockIdx.x * 8 + wid; row < NLAT; row += gridDim.x * 8) {
    float* src = P.out + (size_t)row * 1024;
    float4 v[4];
    float ss = 0.f;
#pragma unroll
    for (int i = 0; i < 4; ++i) {
      { f32x4 t4 = __builtin_nontemporal_load(reinterpret_cast<const f32x4*>(src + i * 256 + lane * 4)); v[i] = make_float4(t4[0], t4[1], t4[2], t4[3]); }
      ss += v[i].x * v[i].x + v[i].y * v[i].y + v[i].z * v[i].z + v[i].w * v[i].w;
    }
    ss = wave_sum(ss);
    float rstd = rsqrtf(ss * (1.f / 1024.f) + EPS);
#pragma unroll
    for (int i = 0; i < 4; ++i) {
      int cb = i * 256 + lane * 4;
      float4 gg = *reinterpret_cast<const float4*>(P.g_final + cb);
      float4 o = make_float4(v[i].x * rstd * gg.x, v[i].y * rstd * gg.y, v[i].z * rstd * gg.z, v[i].w * rstd * gg.w);
      { f32x4 t4 = {o.x, o.y, o.z, o.w}; __builtin_nontemporal_store(t4, reinterpret_cast<f32x4*>(src + cb)); }
    }
  }
}

struct EpiInProj {
  const Params& P;
  int l;
  DEV void operator()(f32x4 (&acc)[8][4], int row0, int col0) const {
    const int lane = my_tid() & 63, fr = lane & 15, fq = lane >> 4;
    if (col0 >= 4416) return;
    if (col0 < C_WQ) {
#pragma unroll
      for (int mi = 0; mi < 8; ++mi)
#pragma unroll
        for (int ni = 0; ni < 4; ++ni)
#pragma unroll
          for (int j = 0; j < 4; ++j)
            WS_P(P)[(size_t)(row0 + mi * 16 + fq * 4 + j) * PW + col0 + ni * 16 + fr] = f2bf(acc[mi][ni][j]);
    } else if (col0 < 3712) {
      const bool isq = (col0 < C_WK) || (col0 >= C_DQ && col0 < C_DK);
      const float qs = isq ? 0.125f : 1.f;
#pragma unroll
      for (int mi = 0; mi < 8; ++mi)
#pragma unroll
        for (int j = 0; j < 4; ++j) {
          int row = row0 + mi * 16 + fq * 4 + j;
          u16* dst = WS_P(P) + (size_t)row * PW + col0 + fr;
          if (row < NLAT) {
            int t = row & (T - 1);
            const float2* rt = reinterpret_cast<const float2*>(WS_ROPE(P)) + t * 32;
#pragma unroll
            for (int hf = 0; hf < 2; ++hf) {
              float2 cs = rt[hf * 16 + fr];
              float x1 = acc[mi][hf * 2][j], x2 = acc[mi][hf * 2 + 1][j];
              dst[hf * 32] = f2bf((x1 * cs.x - x2 * cs.y) * qs);
              dst[hf * 32 + 16] = f2bf((x2 * cs.x + x1 * cs.y) * qs);
            }
          } else {
#pragma unroll
            for (int ni = 0; ni < 4; ++ni) dst[ni * 16] = f2bf(acc[mi][ni][j] * qs);
          }
        }
    } else if (col0 < 4352) {
      u16* base;
      int vrow0;
      const int hdW = (col0 - 3712) >> 6;
      const int hdD = (col0 - 3840) >> 7;
      const bool isw = col0 < 3840;
#pragma unroll
      for (int mi = 0; mi < 8; ++mi) {
        int row = row0 + mi * 16 + fq * 4;
        int b, key;
        if (row < NLAT) { b = row >> 12; key = 256 + (row & (T - 1)); }
        else { b = (row - NLAT) >> 8; key = (row - NLAT) & 255; }
        if (isw) { base = WS_VTW(P) + ((size_t)(b * 2 + hdW) * 64) * KEYS; vrow0 = 0; }
        else { base = WS_VTD(P) + ((size_t)(b * 4 + hdD) * 128) * KEYS; vrow0 = (col0 - 3840) & 127; }
#pragma unroll
        for (int ni = 0; ni < 4; ++ni) {
          int v = vrow0 + ni * 16 + fr;
          *reinterpret_cast<uint2*>(base + (size_t)v * KEYS + key) =
              make_uint2(pack2(acc[mi][ni][0], acc[mi][ni][1]), pack2(acc[mi][ni][2], acc[mi][ni][3]));
        }
      }
    } else {
      float bg = P.b_gate[l * 16 + fr];
#pragma unroll
      for (int mi = 0; mi < 8; ++mi)
#pragma unroll
        for (int j = 0; j < 4; ++j) WS_GATES(P)[(size_t)(row0 + mi * 16 + fq * 4 + j) * 16 + fr] = acc[mi][0][j] + bg;
    }
  }
};

template <int QB, int VB, int KW>
struct AttnCore {
  static constexpr int DV = 32 * VB;
  static constexpr int KST = KW * 2 + 16;
  static constexpr int VST = 128 + 16;
  static constexpr int KBYTES = 64 * KST, VBYTES = DV * VST;
  static constexpr int NKL = 64 * (KW / 8) / NTHREADS, NVL = DV * 8 / NTHREADS;
  static constexpr int TOTAL = 2 * (KBYTES + VBYTES);

  static DEV void run(const u16* qptr, int ldq, const u16* kctx, const u16* klat, int ldk, int kcol, const u16* vt,
                      int nctx, int nlat, int lat_t0, bool window, int qtok0, float m_init, float l_init,
                      f32x16 (&O)[QB][VB], char* smem) {
    const int tid = my_tid(), lane = tid & 63, r = lane & 31, hh = lane >> 5;
    char* Ks = smem;
    char* Vs = smem + 2 * KBYTES;
    bf16x8 qf[QB][4];
#pragma unroll
    for (int qb = 0; qb < QB; ++qb)
#pragma unroll
      for (int ks = 0; ks < 4; ++ks) qf[qb][ks] = ld16(qptr + (size_t)(qb * 32 + r) * ldq + ks * 16 + hh * 8);
    float m[QB], lsum[QB];
#pragma unroll
    for (int qb = 0; qb < QB; ++qb) {
      m[qb] = m_init;
      lsum[qb] = hh == 0 ? l_init : 0.f;
#pragma unroll
      for (int vb = 0; vb < VB; ++vb)
#pragma unroll
        for (int i = 0; i < 16; ++i) O[qb][vb][i] = 0.f;
    }
    bf16x8 rk[NKL], rv[NVL];
    const int ntiles = nctx + nlat;
    auto gload = [&](int j) {
      int kidx = j < nctx ? j * 64 : 256 + lat_t0 + (j - nctx) * 64;
      const u16* krow = j < nctx ? kctx + (size_t)(j * 64) * ldk : klat + (size_t)(lat_t0 + (j - nctx) * 64) * ldk;
#pragma unroll
      for (int i = 0; i < NKL; ++i) {
        int id = tid + i * NTHREADS, row = id / (KW / 8), c = id % (KW / 8);
        rk[i] = ld16(krow + (size_t)row * ldk + c * 8);
      }
#pragma unroll
      for (int i = 0; i < NVL; ++i) {
        int id = tid + i * NTHREADS, row = id >> 3, c = id & 7;
        rv[i] = ld16(vt + (size_t)row * KEYS + kidx + c * 8);
      }
    };
    auto lstore = [&](int buf) {
#pragma unroll
      for (int i = 0; i < NKL; ++i) {
        int id = tid + i * NTHREADS, row = id / (KW / 8), c = id % (KW / 8);
        *reinterpret_cast<bf16x8*>(Ks + buf * KBYTES + row * KST + c * 16) = rk[i];
      }
#pragma unroll
      for (int i = 0; i < NVL; ++i) {
        int id = tid + i * NTHREADS, row = id >> 3, c = id & 7;
        *reinterpret_cast<bf16x8*>(Vs + buf * VBYTES + row * VST + c * 16) = rv[i];
      }
    };
    __syncthreads();
    gload(0);
    lstore(0);
    __syncthreads();
    for (int j = 0; j < ntiles; ++j) {
      const int buf = j & 1;
      if (j + 1 < ntiles) gload(j + 1);
      bf16x8 pf[QB][2][2];
#pragma unroll
      for (int qb = 0; qb < QB; ++qb) {
        f32x16 S[2];
#pragma unroll
        for (int kb = 0; kb < 2; ++kb) {
#pragma unroll
          for (int i = 0; i < 16; ++i) S[kb][i] = 0.f;
#pragma unroll
          for (int ks = 0; ks < 4; ++ks) {
            bf16x8 kf = ld16(Ks + buf * KBYTES + (kb * 32 + pi32(r)) * KST + (kcol + ks * 16 + hh * 8) * 2);
            S[kb] = mfma32(kf, qf[qb][ks], S[kb]);
          }
        }
        __builtin_amdgcn_sched_barrier(0);
        if (window && j >= nctx) {
          int kt0 = lat_t0 + (j - nctx) * 64;
          int qt = qtok0 + qb * 32 + r;
#pragma unroll
          for (int kb = 0; kb < 2; ++kb)
#pragma unroll
            for (int i = 0; i < 16; ++i) {
              int kt = kt0 + kb * 32 + 16 * (i >> 3) + 8 * hh + (i & 7);
              int dlt = qt - kt;
              if (dlt > 128 || dlt < -128) S[kb][i] = -1e30f;
            }
        }
        float mloc = -1e30f;
#pragma unroll
        for (int kb = 0; kb < 2; ++kb)
#pragma unroll
          for (int i = 0; i < 16; ++i) mloc = fmaxf(mloc, S[kb][i]);
        mloc = fmaxf(mloc, __shfl_xor(mloc, 32));
        if (__any(mloc > m[qb] + 5.5f)) {
          float mnew = fmaxf(m[qb], mloc);
          float alpha = fexp2((m[qb] - mnew) * L2E);
          m[qb] = mnew;
          lsum[qb] *= alpha;
#pragma unroll
          for (int vb = 0; vb < VB; ++vb)
#pragma unroll
            for (int i = 0; i < 16; ++i) O[qb][vb][i] *= alpha;
        }
        float mb = m[qb] * L2E, ps = 0.f;
#pragma unroll
        for (int kb = 0; kb < 2; ++kb) {
          float pv[16];
#pragma unroll
          for (int i = 0; i < 16; ++i) {
            pv[i] = fexp2(S[kb][i] * L2E - mb);
            ps += pv[i];
          }
#pragma unroll
          for (int s = 0; s < 2; ++s)
            pf[qb][kb][s] = mk8(pack2(pv[8 * s], pv[8 * s + 1]), pack2(pv[8 * s + 2], pv[8 * s + 3]),
                                pack2(pv[8 * s + 4], pv[8 * s + 5]), pack2(pv[8 * s + 6], pv[8 * s + 7]));
        }
        lsum[qb] += ps;
        __builtin_amdgcn_sched_barrier(0);
      }
      __builtin_amdgcn_sched_barrier(0);
#pragma unroll
      for (int vb = 0; vb < VB; ++vb) {
#pragma unroll
        for (int kb = 0; kb < 2; ++kb)
#pragma unroll
          for (int s = 0; s < 2; ++s) {
            bf16x8 vf = ld16(Vs + buf * VBYTES + (vb * 32 + r) * VST + (kb * 32 + s * 16 + hh * 8) * 2);
#pragma unroll
            for (int qb = 0; qb < QB; ++qb) O[qb][vb] = mfma32(vf, pf[qb][kb][s], O[qb][vb]);
          }
        __builtin_amdgcn_sched_barrier(0);
      }
      if (j + 1 < ntiles) lstore(buf ^ 1);
      __syncthreads();
    }
#pragma unroll
    for (int qb = 0; qb < QB; ++qb) {
      float lt = lsum[qb] + __shfl_xor(lsum[qb], 32);
      float inv = 1.f / lt;
#pragma unroll
      for (int vb = 0; vb < VB; ++vb)
#pragma unroll
        for (int i = 0; i < 16; ++i) O[qb][vb][i] *= inv;
    }
  }
};

DEV void diff_item(const Params& P, int l, int b, int h, int qt, bool ctxq, char* smem) {
  const int tid = my_tid(), lane = tid & 63, wid = tid >> 6, r = lane & 31, hh = lane >> 5;
  const int comp = wid >> 2, wq = wid & 3;
  const int rowbase = ctxq ? NLAT + b * 256 + qt * 128 : b * T + qt * 128;
  const u16* qptr = WS_P(P) + (size_t)(rowbase + wq * 32) * PW + C_DQ + h * 128 + comp * 64;
  const u16* kctx = WS_P(P) + (size_t)(NLAT + b * 256) * PW + C_DK + h * 128;
  const u16* klat = WS_P(P) + (size_t)(b * T) * PW + C_DK + h * 128;
  const u16* vt = WS_VTD(P) + ((size_t)(b * 4 + h) * 128) * KEYS;
  f32x16 O[1][4];
  AttnCore<1, 4, 128>::run(qptr, PW, kctx, klat, PW, comp * 64, vt, 4, ctxq ? 0 : 64, 0, false, 0, -1e30f, 0.f, O, smem);
  float* ex = reinterpret_cast<float*>(smem);
  __syncthreads();
  if (comp == 1) {
#pragma unroll
    for (int vb = 0; vb < 4; ++vb)
#pragma unroll
      for (int i = 0; i < 16; ++i) ex[(wq * 64 + vb * 16 + i) * 64 + lane] = O[0][vb][i];
  }
  __syncthreads();
  if (comp == 0) {
    const float lam = WS_LAM(P)[l];
    const float lam_init = 0.8f - 0.6f * expf(-0.3f * (float)l);
    float ss = 0.f;
#pragma unroll
    for (int vb = 0; vb < 4; ++vb)
#pragma unroll
      for (int i = 0; i < 16; ++i) {
        float y = O[0][vb][i] - lam * ex[(wq * 64 + vb * 16 + i) * 64 + lane];
        O[0][vb][i] = y;
        ss += y * y;
      }
    ss += __shfl_xor(ss, 32);
    float sc = rsqrtf(ss * (1.f / 128.f) + EPS) * (1.f - lam_init);
    const float* dn = P.d_norm + l * 512 + h * 128;
    u16* dst = WS_P(P) + (size_t)(rowbase + wq * 32 + r) * PW + C_DQ + h * 128;
#pragma unroll
    for (int vb = 0; vb < 4; ++vb)
#pragma unroll
      for (int g4 = 0; g4 < 4; ++g4) {
        int v = vb * 32 + g4 * 8 + hh * 4;
        float4 w = *reinterpret_cast<const float4*>(dn + v);
        *reinterpret_cast<uint2*>(dst + v) =
            make_uint2(pack2(O[0][vb][g4 * 4] * sc * w.x, O[0][vb][g4 * 4 + 1] * sc * w.y),
                       pack2(O[0][vb][g4 * 4 + 2] * sc * w.z, O[0][vb][g4 * 4 + 3] * sc * w.w));
      }
  }
  __syncthreads();
}

DEV void win_item(const Params& P, int l, int b, int g, int qb, bool ctxq, char* smem) {
  const int tid = my_tid(), lane = tid & 63, wid = tid >> 6, r = lane & 31, hh = lane >> 5;
  const int hr = wid >> 1, qh = wid & 1;
  const int head = g * 4 + hr;
  const int rowbase = (ctxq ? NLAT + b * 256 + qb * 64 : b * T + qb * 64) + qh * 32;
  const u16* qptr = WS_P(P) + (size_t)rowbase * PW + C_WQ + head * 64;
  const u16* kctx = WS_P(P) + (size_t)(NLAT + b * 256) * PW + C_WK + g * 64;
  const u16* klat = WS_P(P) + (size_t)(b * T) * PW + C_WK + g * 64;
  const u16* vt = WS_VTW(P) + ((size_t)(b * 2 + g) * 64) * KEYS;
  int t0 = 0, nlat = 0;
  if (!ctxq) {
    t0 = qb * 64 - 128;
    if (t0 < 0) t0 = 0;
    int t1 = qb * 64 + 192;
    if (t1 > T) t1 = T;
    nlat = (t1 - t0) >> 6;
  }
  f32x16 O[1][2];
  AttnCore<1, 2, 64>::run(qptr, PW, kctx, klat, PW, 0, vt, 4, nlat, t0, !ctxq, qb * 64 + qh * 32, P.sink[l * 8 + head], 1.f, O, smem);
  u16* dst = WS_P(P) + (size_t)(rowbase + r) * PW + C_WQ + head * 64;
#pragma unroll
  for (int vb = 0; vb < 2; ++vb)
#pragma unroll
    for (int g4 = 0; g4 < 4; ++g4) {
      int v = vb * 32 + g4 * 8 + hh * 4;
      *reinterpret_cast<uint2*>(dst + v) = make_uint2(pack2(O[0][vb][g4 * 4], O[0][vb][g4 * 4 + 1]),
                                                        pack2(O[0][vb][g4 * 4 + 2], O[0][vb][g4 * 4 + 3]));
    }
}

DEV void mlstm_item(const Params& P, int l, int b, int hd, int dir, bool need_ctx, char* smem) {
  const int tid = my_tid(), lane = tid & 63, wid = tid >> 6, r = lane & 31, hh = lane >> 5;
  constexpr int QST = 272, TST = 144;
  char* Qs = smem;
  char* Ks = Qs + 64 * QST;
  char* KwT = Ks + 64 * QST;
  char* VT = KwT + 128 * TST;
  char* Sp = VT + 128 * TST;
  char* Rq = Sp + 64 * TST;
  char* Rk = Rq + 66 * QST;
  float* fb = reinterpret_cast<float*>(Rk + 66 * QST);
  float* sb = fb;
  float* sa = fb + 64;
  float* sM = fb + 128;
  float* denp = fb + 192;
  float* qn = fb + 320;
  float* nb = fb + 384;
  float* cw = fb + 640;
  __syncthreads();
  if (tid < 256) nb[tid] = 0.f;
  for (int i = tid; i < 768; i += NTHREADS) {
    int qk = i / 384, tap = (i % 384) / 128, d = i & 127;
    cw[i] = P.conv_w[(size_t)l * 3 * 1024 + tap * 1024 + qk * 512 + hd * 128 + d];
  }
  f32x16 CT[4];
#pragma unroll
  for (int kb = 0; kb < 4; ++kb)
#pragma unroll
    for (int i = 0; i < 16; ++i) CT[kb][i] = 0.f;
  float mstate = 0.f;
  u16* hout = WS_HFB(P) + (size_t)dir * MTOT * 512;
  const float kscale = 0.08838834764831845f;

  auto geom = [&](int step, int& seg0, int& seglen, int& u0) {
    int c;
    if (step < 4) { seg0 = NLAT + b * 256; seglen = 256; c = dir ? 3 - step : step; }
    else { seg0 = b * T; seglen = T; c = dir ? 67 - step : step - 4; }
    u0 = c * 64;
  };
  bf16x8 pq[3], pk[3], pvv[2];
  float pig = 0.f, pfg = 0.f;
  auto issue_loads = [&](int step) {
    int seg0, seglen, u0;
    geom(step, seg0, seglen, u0);
#pragma unroll
    for (int i = 0; i < 3; ++i) {
      int id = tid + i * NTHREADS;
      bf16x8 z = {0, 0, 0, 0, 0, 0, 0, 0};
      pq[i] = z;
      pk[i] = z;
      if (id < 66 * 16) {
        int row = id >> 4, cc = id & 15;
        int uu = u0 + row - 1;
        bool ok = uu >= 0 && uu < seglen;
        const u16* src = WS_P(P) + (size_t)(seg0 + (ok ? uu : 0)) * PW + hd * 128 + cc * 8;
        if (ok) { pq[i] = ld16(src + C_MQ); pk[i] = ld16(src + C_MK); }
      }
    }
#pragma unroll
    for (int i = 0; i < 2; ++i) {
      int id = tid + i * NTHREADS, u = id >> 4, cc = id & 15;
      pvv[i] = ld16(WS_P(P) + (size_t)(seg0 + u0 + u) * PW + C_MV + hd * 128 + cc * 8);
    }
    if (wid == 0) {
      const int pos = dir ? 63 - lane : lane;
      const float* gp = WS_GATES(P) + (size_t)(seg0 + u0 + pos) * 16;
      pig = gp[(dir * 2) * 4 + hd];
      pfg = gp[(dir * 2 + 1) * 4 + hd];
    }
  };
  issue_loads(0);

  for (int step = 0; step < 68; ++step) {
    int seg0, seglen, u0;
    geom(step, seg0, seglen, u0);
    const int rowbase = seg0 + u0;
    const int cur = step & 1;
    __syncthreads();
    bf16x8 rvv[2];
#pragma unroll
    for (int i = 0; i < 3; ++i) {
      int id = tid + i * NTHREADS;
      if (id < 66 * 16) {
        int row = id >> 4, cc = id & 15;
        *reinterpret_cast<bf16x8*>(Rq + row * QST + cc * 16) = pq[i];
        *reinterpret_cast<bf16x8*>(Rk + row * QST + cc * 16) = pk[i];
      }
    }
    rvv[0] = pvv[0];
    rvv[1] = pvv[1];
    const float ig = pig, fg = pfg;
    if (step + 1 < 68) issue_loads(step + 1);
    if (wid == 0) {
      const int pos = dir ? 63 - lane : lane;
      float lf = fminf(fg, 0.f) - log1pf(__expf(-fabsf(fg)));
      float bsum = lf;
#pragma unroll
      for (int o = 1; o < 64; o <<= 1) { float t2 = __shfl_up(bsum, o); if (lane >= o) bsum += t2; }
      float a = ig - bsum, am = a;
#pragma unroll
      for (int o = 1; o < 64; o <<= 1) { float t2 = __shfl_up(am, o); if (lane >= o) am = fmaxf(am, t2); }
      sb[pos] = bsum;
      sa[pos] = a;
      sM[pos] = fmaxf(mstate, am);
    }
    __syncthreads();
    const int eidx = dir ? 0 : 63;
    const float Mend = sM[eidx], bend = sb[eidx];
    const float decay = __expf(mstate - Mend);
#pragma unroll
    for (int i = 0; i < 2; ++i) {
      int id = tid + i * NTHREADS, u = id >> 4, cc = id & 15;
      float wend = __expf(sa[u] - Mend);
      const int tbase = cc * 8 * TST + (((u >> 3) ^ (cc & 7)) << 4) + (u & 7) * 2;
      uint32_t qo[4], ko[4];
      float kv[8], xq[8], xk[8];
#pragma unroll
      for (int e = 0; e < 8; ++e) { xq[e] = 0.f; xk[e] = 0.f; }
#pragma unroll
      for (int tap = 0; tap < 3; ++tap) {
        const bf16x8 qr = ld16(Rq + (u + tap) * QST + cc * 16), kr = ld16(Rk + (u + tap) * QST + cc * 16);
        const float4 wq0 = *reinterpret_cast<const float4*>(cw + tap * 128 + cc * 8), wq1 = *reinterpret_cast<const float4*>(cw + tap * 128 + cc * 8 + 4);
        const float4 wk0 = *reinterpret_cast<const float4*>(cw + 384 + tap * 128 + cc * 8), wk1 = *reinterpret_cast<const float4*>(cw + 384 + tap * 128 + cc * 8 + 4);
        const float wq[8] = {wq0.x, wq0.y, wq0.z, wq0.w, wq1.x, wq1.y, wq1.z, wq1.w};
        const float wk[8] = {wk0.x, wk0.y, wk0.z, wk0.w, wk1.x, wk1.y, wk1.z, wk1.w};
#pragma unroll
        for (int e = 0; e < 8; ++e) {
          xq[e] += wq[e] * bf2f((u16)qr[e]);
          xk[e] += wk[e] * bf2f((u16)kr[e]);
        }
      }
#pragma unroll
      for (int e = 0; e < 8; ++e) {
        float qv = xq[e] * __builtin_amdgcn_rcpf(1.f + __expf(-xq[e]));
        kv[e] = xk[e] * __builtin_amdgcn_rcpf(1.f + __expf(-xk[e])) * kscale;
        if (e & 1) { qo[e >> 1] |= ((uint32_t)f2bf(qv)) << 16; ko[e >> 1] |= ((uint32_t)f2bf(kv[e])) << 16; }
        else { qo[e >> 1] = f2bf(qv); ko[e >> 1] = f2bf(kv[e]); }
        *reinterpret_cast<u16*>(KwT + tbase + e * TST) = f2bf(kv[e] * wend);
        *reinterpret_cast<u16*>(VT + tbase + e * TST) = (u16)rvv[i][e];
      }
      *reinterpret_cast<uint4*>(Qs + u * QST + cc * 16) = make_uint4(qo[0], qo[1], qo[2], qo[3]);
      *reinterpret_cast<uint4*>(Ks + u * QST + cc * 16) = make_uint4(ko[0], ko[1], ko[2], ko[3]);
    }
    __syncthreads();
    if (wid < 4) {
      const int sblk = wid & 1, tblk = wid >> 1;
      f32x16 S;
#pragma unroll
      for (int i = 0; i < 16; ++i) S[i] = 0.f;
#pragma unroll
      for (int ks = 0; ks < 8; ++ks) {
        bf16x8 kf = ld16(Ks + (sblk * 32 + pi32(r)) * QST + (ks * 16 + hh * 8) * 2);
        bf16x8 qf = ld16(Qs + (tblk * 32 + r) * QST + (ks * 16 + hh * 8) * 2);
        S = mfma32(kf, qf, S);
      }
      const int t = tblk * 32 + r;
      const float Mt = sM[t];
      float ds = 0.f, val[16];
#pragma unroll
      for (int i = 0; i < 16; ++i) {
        int s = sblk * 32 + 16 * (i >> 3) + 8 * hh + (i & 7);
        bool ok = dir ? (s >= t) : (s <= t);
        val[i] = ok ? S[i] * __expf(sa[s] - Mt) : 0.f;
        ds += val[i];
      }
      ds += __shfl_xor(ds, 32);
      if (hh == 0) denp[sblk * 64 + t] = ds;
#pragma unroll
      for (int s2 = 0; s2 < 2; ++s2)
        *reinterpret_cast<uint4*>(Sp + t * TST + (sblk * 32 + s2 * 16 + hh * 8) * 2) =
            make_uint4(pack2(val[8 * s2], val[8 * s2 + 1]), pack2(val[8 * s2 + 2], val[8 * s2 + 3]),
                       pack2(val[8 * s2 + 4], val[8 * s2 + 5]), pack2(val[8 * s2 + 6], val[8 * s2 + 7]));
    } else if (wid == 4) {
      float s = 0.f;
      const float* nc = nb + cur * 128;
      for (int k8 = 0; k8 < 16; ++k8) {
        bf16x8 qv = ld16(Qs + lane * QST + k8 * 16);
#pragma unroll
        for (int e = 0; e < 8; ++e) s += nc[k8 * 8 + e] * bf2f((u16)qv[e]);
      }
      qn[lane] = s;
    } else if (wid == 5) {
      const float* nc = nb + cur * 128;
      float* nn = nb + (cur ^ 1) * 128;
#pragma unroll
      for (int q2 = 0; q2 < 2; ++q2) {
        int k = lane + q2 * 64;
        float s = 0.f;
        for (int s8 = 0; s8 < 8; ++s8) {
          bf16x8 kv = ld16(KwT + k * TST + s8 * 16);
#pragma unroll
          for (int e = 0; e < 8; ++e) s += bf2f((u16)kv[e]);
        }
        nn[k] = decay * nc[k] + s;
      }
    }
    __syncthreads();
    {
      bf16x8 vf[4];
      const int vb = wid & 3, tb = wid >> 2;
#pragma unroll
      for (int ks = 0; ks < 4; ++ks) vf[ks] = ld16(VT + (vb * 32 + r) * TST + (((ks * 2 + hh) ^ ((r >> 3) | ((vb & 1) << 2))) << 4));
      const bool wr_h = (step >= 4) || need_ctx;
      {
        const int t = tb * 32 + r;
        f32x16 acc;
#pragma unroll
        for (int i = 0; i < 16; ++i) acc[i] = 0.f;
#pragma unroll
        for (int kb = 0; kb < 4; ++kb)
#pragma unroll
          for (int s2 = 0; s2 < 2; ++s2) {
            bf16x8 af = mk8(pack2(CT[kb][8 * s2], CT[kb][8 * s2 + 1]), pack2(CT[kb][8 * s2 + 2], CT[kb][8 * s2 + 3]),
                            pack2(CT[kb][8 * s2 + 4], CT[kb][8 * s2 + 5]), pack2(CT[kb][8 * s2 + 6], CT[kb][8 * s2 + 7]));
            uint2 lo = *reinterpret_cast<const uint2*>(Qs + t * QST + (kb * 32 + s2 * 16 + hh * 4) * 2);
            uint2 hi = *reinterpret_cast<const uint2*>(Qs + t * QST + (kb * 32 + s2 * 16 + 8 + hh * 4) * 2);
            acc = mfma32(af, mk8(lo.x, lo.y, hi.x, hi.y), acc);
          }
        const float Mt = sM[t];
        const float winter = __expf(mstate - Mt);
#pragma unroll
        for (int i = 0; i < 16; ++i) acc[i] *= winter;
#pragma unroll
        for (int ks = 0; ks < 4; ++ks) {
          bf16x8 sf = ld16(Sp + t * TST + (ks * 16 + hh * 8) * 2);
          acc = mfma32(vf[ks], sf, acc);
        }
        float den = denp[t] + denp[64 + t] + winter * qn[t];
        float sc = 1.f / fmaxf(fabsf(den), __expf(-(sb[t] + Mt)));
        if (wr_h) {
          u16* dst = hout + (size_t)(rowbase + t) * 512 + hd * 128 + vb * 32;
#pragma unroll
          for (int g4 = 0; g4 < 4; ++g4)
            *reinterpret_cast<uint2*>(dst + g4 * 8 + hh * 4) =
                make_uint2(pack2(acc[g4 * 4] * sc, acc[g4 * 4 + 1] * sc), pack2(acc[g4 * 4 + 2] * sc, acc[g4 * 4 + 3] * sc));
        }
      }
#pragma unroll
      for (int kb = 0; kb < 4; ++kb) {
#pragma unroll
        for (int i = 0; i < 16; ++i) CT[kb][i] *= decay;
#pragma unroll
        for (int ks = 0; ks < 4; ++ks) {
          bf16x8 kf = ld16(KwT + (kb * 32 + r) * TST + (((ks * 2 + hh) ^ ((r >> 3) | ((kb & 1) << 2))) << 4));
          CT[kb] = mfma32(kf, vf[ks], CT[kb]);
        }
      }
    }
    mstate = bend + Mend;
  }
  __syncthreads();
}

DEV int next_item(unsigned* ctr, int* s_item) {
  __syncthreads();
  if (my_tid() == 0) *s_item = (int)atomicAdd(ctr, 1u);
  __syncthreads();
  return *s_item;
}
DEV void phase_mixers(const Params& P, int l, char* smem) {
  const bool need_ctx = (l == 0);
  __shared__ int s_item;
  const int n_ml = 128, n_diff = 2048, n_win = 2048, n_dc = need_ctx ? 128 : 0, n_wc = need_ctx ? 128 : 0;
  for (;;) {
    int it = next_item(&WS_CTR(P)[l * 4 + 0], &s_item);
    if (it >= n_ml) break;
    mlstm_item(P, l, it >> 3, (it >> 1) & 3, it & 1, need_ctx, smem);
  }
  for (;;) {
    int it = next_item(&WS_CTR(P)[l * 4 + 1], &s_item);
    if (it >= n_diff + n_dc) break;
    bool cq = it >= n_diff;
    int i2 = it - n_diff;
    int b = cq ? i2 >> 3 : it >> 7, hd = cq ? (i2 >> 1) & 3 : (it >> 5) & 3, qt = cq ? i2 & 1 : it & 31;
    diff_item(P, l, b, hd, qt, cq, smem);
  }
  for (;;) {
    int it = next_item(&WS_CTR(P)[l * 4 + 2], &s_item);
    if (it >= n_win + n_wc) break;
    bool cq = it >= n_win;
    int i2 = it - n_win;
    int b = cq ? i2 >> 3 : it >> 7, g = cq ? (i2 >> 2) & 1 : (it >> 6) & 1, qb = cq ? i2 & 3 : it & 63;
    win_item(P, l, b, g, qb, cq, smem);
  }
}

DEV void phase_ya(const Params& P, int l, int nrows) {
  const int lane = my_tid() & 63, wid = my_tid() >> 6;
  const u16* hf = WS_HFB(P);
  const u16* hb = WS_HFB(P) + (size_t)MTOT * 512;
  for (int row = blockIdx.x * 8 + wid; row < nrows; row += gridDim.x * 8) {
    uint4 a = *reinterpret_cast<const uint4*>(hf + (size_t)row * 512 + lane * 8);
    uint4 bq = *reinterpret_cast<const uint4*>(hb + (size_t)row * 512 + lane * 8);
    uint4 o = *reinterpret_cast<const uint4*>(WS_P(P) + (size_t)row * PW + C_MO + lane * 8);
    uint32_t aa[4] = {a.x, a.y, a.z, a.w}, bb[4] = {bq.x, bq.y, bq.z, bq.w}, oo[4] = {o.x, o.y, o.z, o.w};
    float y[8], ss = 0.f;
#pragma unroll
    for (int j = 0; j < 4; ++j) {
      y[2 * j] = (bflo(aa[j]) + bflo(bb[j])) * sigmoidf_(bflo(oo[j]));
      y[2 * j + 1] = (bfhi(aa[j]) + bfhi(bb[j])) * sigmoidf_(bfhi(oo[j]));
      ss += y[2 * j] * y[2 * j] + y[2 * j + 1] * y[2 * j + 1];
    }
#pragma unroll
    for (int of = 1; of < 16; of <<= 1) ss += __shfl_xor(ss, of);
    float rstd = rsqrtf(ss * (1.f / 128.f) + EPS);
    const float* mn = P.m_norm + l * 512 + lane * 8;
    uint32_t w[4];
#pragma unroll
    for (int j = 0; j < 4; ++j) w[j] = pack2(y[2 * j] * rstd * mn[2 * j], y[2 * j + 1] * rstd * mn[2 * j + 1]);
    *reinterpret_cast<uint4*>(WS_P(P) + (size_t)row * PW + C_MO + lane * 8) = make_uint4(w[0], w[1], w[2], w[3]);
  }
}

DEV void phase_merge(const Params& P, int l, int M, char* smem) {
  const u16* Wl = WS_W(P) + (size_t)l * W_LAYER;
  u16* merged = WS_HFB(P);
  const int nM = M / 128, nN = 4;
  const int lane = my_tid() & 63, wid = my_tid() >> 6, wr = wid >> 2, wc = wid & 3, fr = lane & 15, fq = lane >> 4;
  for (int tile = blockIdx.x; tile < nM * nN; tile += gridDim.x) {
    int tm, tn;
    tile_coords(tile, nM * nN, nN, tm, tn);
    f32x4 mg[4][4];
    zero_acc<4, 4>(mg);
#pragma unroll 1
    for (int i = 0; i < 3; ++i) {
      f32x4 acc[4][4];
      zero_acc<4, 4>(acc);
      gemm_mainloop64(WS_H(P) + (size_t)tm * 128 * 1024, 1024, Wl + W_G + (size_t)(i * 1024 + tn * 256) * 1024, 1024, 1024, acc, smem);
      uint32_t gp[4][4][2];
#pragma unroll
      for (int mi = 0; mi < 4; ++mi)
#pragma unroll
        for (int ni = 0; ni < 4; ++ni) {
          gp[mi][ni][0] = pack2(sigmoidf_(acc[mi][ni][0]), sigmoidf_(acc[mi][ni][1]));
          gp[mi][ni][1] = pack2(sigmoidf_(acc[mi][ni][2]), sigmoidf_(acc[mi][ni][3]));
        }
      zero_acc<4, 4>(acc);
      int yc = i == 0 ? C_MO : (i == 1 ? C_WQ : C_DQ);
      gemm_mainloop64(WS_P(P) + (size_t)tm * 128 * PW + yc, PW, Wl + W_B + (size_t)i * 1024 * 512 + (size_t)(tn * 256) * 512, 512, 512, acc, smem);
#pragma unroll
      for (int mi = 0; mi < 4; ++mi)
#pragma unroll
        for (int ni = 0; ni < 4; ++ni) {
          mg[mi][ni][0] += bflo(gp[mi][ni][0]) * acc[mi][ni][0];
          mg[mi][ni][1] += bfhi(gp[mi][ni][0]) * acc[mi][ni][1];
          mg[mi][ni][2] += bflo(gp[mi][ni][1]) * acc[mi][ni][2];
          mg[mi][ni][3] += bfhi(gp[mi][ni][1]) * acc[mi][ni][3];
        }
    }
    const int row0 = tm * 128 + wr * 64, col0 = tn * 256 + wc * 64;
#pragma unroll
    for (int mi = 0; mi < 4; ++mi)
#pragma unroll
      for (int ni = 0; ni < 4; ++ni)
#pragma unroll
        for (int j = 0; j < 4; ++j)
          merged[(size_t)(row0 + mi * 16 + fq * 4 + j) * 1024 + col0 + ni * 16 + fr] = f2bf(mg[mi][ni][j]);
  }
}

struct EpiResid {
  const Params& P;
  const float* src_lat;
  const float* modl;
  int gt_off;
  DEV void operator()(f32x4 (&acc)[8][4], int row0, int col0) const {
    const int lane = my_tid() & 63, fr = lane & 15, fq = lane >> 4;
#pragma unroll
    for (int mi = 0; mi < 8; ++mi)
#pragma unroll
      for (int j = 0; j < 4; ++j) {
        int row = row0 + mi * 16 + fq * 4 + j;
        const float* src;
        float* dst;
        int cond;
        if (row < NLAT) { src = src_lat + (size_t)row * 1024; dst = P.out + (size_t)row * 1024; cond = row >> 12; }
        else { src = WS_XC(P) + (size_t)(row - NLAT) * 1024; dst = WS_XC(P) + (size_t)(row - NLAT) * 1024; cond = 16; }
        const float* gt = modl + (size_t)cond * 6144 + gt_off;
#pragma unroll
        for (int ni = 0; ni < 4; ++ni) {
          int col = col0 + ni * 16 + fr;
          dst[col] = src[col] + gt[col] * acc[mi][ni][j];
        }
      }
  }
};

struct EpiSwiglu {
  u16* act;
  DEV void operator()(f32x4 (&acc)[8][4], int row0, int col0) const {
    const int lane = my_tid() & 63, fr = lane & 15, fq = lane >> 4;
#pragma unroll
    for (int mi = 0; mi < 8; ++mi)
#pragma unroll
      for (int j = 0; j < 4; ++j) {
        int row = row0 + mi * 16 + fq * 4 + j;
#pragma unroll
        for (int pr = 0; pr < 2; ++pr) {
          float gte = acc[mi][pr * 2][j], up = acc[mi][pr * 2 + 1][j];
          act[(size_t)row * FH + ((col0 + pr * 32) >> 1) + fr] = f2bf(siluf_(gte) * up);
        }
      }
  }
};


namespace pg8 {
#define PG8_LAS __attribute__((address_space(3)))
constexpr int BM = 256, BK = 64, HALF = 128, HTB = HALF * BK * 2, NXCD = 8, WGM = 8;
DEV int lds_byte(int r, int c) { const int st = (r >> 4) * 2 + (c >> 5), rr = r & 15, cc = c & 31, ob = rr * 64 + cc * 2; return st * 1024 + (ob ^ (((ob >> 9) & 1) << 5)); }
DEV void stage_rc(int b, int& R, int& C) { const int st = b / 1024, sb = b % 1024, swz = sb ^ (((sb >> 9) & 1) << 5); R = (st >> 1) * 16 + swz / 64; C = (st & 1) * 32 + (swz % 64) / 2; }
struct Unit { int pm, pn; };
struct StaticOrder {
  int nM, nN, nwg, G, c;
  DEV void init(int M, int N, int G_, int c_) { nM = M / BM; nN = N / BM; nwg = nM * nN; G = G_; c = c_; }
  DEV bool next(int i, Unit& u) const {
    const long L = (long)i * G + c;
    if (L >= nwg) return false;
    int wgid = (int)L;
    { const int q = nwg / NXCD, r = nwg % NXCD, xcd = wgid % NXCD, off = wgid / NXCD; wgid = (xcd < r ? xcd * (q + 1) : r * (q + 1) + (xcd - r) * q) + off; }
    const int nig = WGM * nN, gid = wgid / nig, fm = gid * WGM, gsz = (nM - fm) < WGM ? (nM - fm) : WGM;
    u.pm = fm + ((wgid % nig) % gsz);
    u.pn = (wgid % nig) / gsz;
    return true;
  }
};
template <class Epi>
DEV void gemm_phase(char* smem, const u16* A, int lda, const u16* Bt, int ldb, int M, int N, int K, const Epi& E) {
  PG8_LAS unsigned char* lds = (PG8_LAS unsigned char*)smem;
  const int tid = my_tid(), wid = __builtin_amdgcn_readfirstlane(tid >> 6), lane = tid & 63, wr = wid >> 2, wc = wid & 3, fr = lane & 15, fq = lane >> 4;
  const int nt = K / BK;
  StaticOrder S;
  S.init(M, N, gridDim.x, blockIdx.x);
  unsigned voffA[2], voffB[2];
#pragma unroll
  for (int i = 0; i < 2; ++i) { int R, C; stage_rc(tid * 16 + i * 8192, R, C); voffA[i] = (unsigned)(R * lda + C) * 2u; voffB[i] = (unsigned)(R * ldb + C) * 2u; }
  const size_t kstep = (size_t)(BK * 2);
  const size_t hstepA = (size_t)HALF * lda * 2, hstepB = (size_t)HALF * ldb * 2;
  const size_t tstepA = 2 * hstepA, tstepB = 2 * hstepB;
  const unsigned ldsw = (unsigned)wid * 1024u;
  const int aoff = lds_byte(wr * 64 + fr, fq * 8), boff = lds_byte(wc * 32 + fr, fq * 8);
#define PG8_SA(b, h) (((b) * 2 + (h)) * HTB)
#define PG8_SB(b, h) ((4 + (b) * 2 + (h)) * HTB)
#define PG8_STAGE(bufoff, gbase, voff) do { _Pragma("unroll") for (int _i = 0; _i < 2; ++_i) \
        __builtin_amdgcn_global_load_lds((const unsigned*)((const char*)(gbase) + (voff)[_i]), (PG8_LAS unsigned*)(lds + (bufoff) + ldsw + _i * 8192), 16, 0, 0); } while (0)
#define PG8_LDA(dst, b, h) do { _Pragma("unroll") for (int m = 0; m < 4; ++m) _Pragma("unroll") for (int k = 0; k < 2; ++k) dst[m][k] = *(const PG8_LAS bf16x8*)(lds + PG8_SA(b, h) + aoff + m * 2048 + k * 1024); } while (0)
#define PG8_LDB(dst, b, h) do { _Pragma("unroll") for (int n = 0; n < 2; ++n) _Pragma("unroll") for (int k = 0; k < 2; ++k) dst[n][k] = *(const PG8_LAS bf16x8*)(lds + PG8_SB(b, h) + boff + n * 2048 + k * 1024); } while (0)
#define PG8_MMA(ai, bj, At, Bt_) do { __builtin_amdgcn_s_setprio(1); _Pragma("unroll") for (int m = 0; m < 4; ++m) _Pragma("unroll") for (int n = 0; n < 2; ++n) _Pragma("unroll") for (int k = 0; k < 2; ++k) \
        acc[ai][bj][m][n] = __builtin_amdgcn_mfma_f32_16x16x32_bf16(Bt_[n][k], At[m][k], acc[ai][bj][m][n], 0, 0, 0); __builtin_amdgcn_s_setprio(0); } while (0)
#define PG8_WAIT_V(n) asm volatile("s_waitcnt vmcnt(" #n ")" ::: "memory")
#define PG8_WAIT_L(n) asm volatile("s_waitcnt lgkmcnt(" #n ")" ::: "memory")
#define PG8_BAR __builtin_amdgcn_s_barrier()
#define PG8_SCHED __builtin_amdgcn_sched_barrier(0)
  Unit cur, nxt;
  int ui = 0;
  PG8_WAIT_V(0);
  __syncthreads();
  if (!S.next(0, cur)) return;
  f32x4 acc[2][2][4][2];
#pragma unroll
  for (int a = 0; a < 2; ++a)
#pragma unroll
    for (int b = 0; b < 2; ++b)
#pragma unroll
      for (int m = 0; m < 4; ++m)
#pragma unroll
        for (int n = 0; n < 2; ++n) acc[a][b][m][n] = (f32x4){0.f, 0.f, 0.f, 0.f};
  bf16x8 At[4][2], B0[2][2], B1[2][2];
  const char* cA = (const char*)A + (size_t)cur.pm * tstepA;
  const char* cB = (const char*)Bt + (size_t)cur.pn * tstepB;
  PG8_STAGE(PG8_SB(0, 0), cB, voffB); PG8_STAGE(PG8_SA(0, 0), cA, voffA); PG8_STAGE(PG8_SB(0, 1), cB + hstepB, voffB); PG8_STAGE(PG8_SA(0, 1), cA + hstepA, voffA);
  if (wr == 1) PG8_BAR;
  PG8_WAIT_V(4); PG8_BAR;
  PG8_STAGE(PG8_SB(1, 0), cB + kstep, voffB); PG8_STAGE(PG8_SA(1, 0), cA + kstep, voffA); PG8_STAGE(PG8_SB(1, 1), cB + hstepB + kstep, voffB);
  PG8_WAIT_V(6); PG8_BAR;
  for (;;) {
    const bool has_next = S.next(ui + 1, nxt);
    const char* nA = has_next ? (const char*)A + (size_t)nxt.pm * tstepA : cA;
    const char* nB = has_next ? (const char*)Bt + (size_t)nxt.pn * tstepB : cB;
    for (int t = 0; t < nt; t += 2) {
      const bool last = (t == nt - 2);
      const char* a1 = cA + (size_t)(t + 1) * kstep;
      const char* a2 = last ? nA : cA + (size_t)(t + 2) * kstep;
      const char* b2 = last ? nB : cB + (size_t)(t + 2) * kstep;
      const char* a3 = a2 + kstep;
      const char* b3 = b2 + kstep;
      PG8_LDB(B0, 0, 0); PG8_SCHED; PG8_LDA(At, 0, 0); PG8_STAGE(PG8_SA(1, 1), a1 + hstepA, voffA);
      PG8_WAIT_L(8); PG8_BAR; PG8_WAIT_L(0); PG8_MMA(0, 0, At, B0); PG8_BAR; PG8_SCHED;
      PG8_LDB(B1, 0, 1); PG8_STAGE(PG8_SB(0, 0), b2, voffB);
      PG8_BAR; PG8_WAIT_L(0); PG8_MMA(0, 1, At, B1); PG8_BAR;
      PG8_LDA(At, 0, 1); PG8_STAGE(PG8_SA(0, 0), a2, voffA);
      PG8_BAR; PG8_WAIT_L(0); PG8_MMA(1, 0, At, B0); PG8_BAR; PG8_SCHED;
      PG8_STAGE(PG8_SB(0, 1), b2 + hstepB, voffB);
      PG8_WAIT_V(6); PG8_BAR; PG8_MMA(1, 1, At, B1); PG8_BAR;
      PG8_LDB(B0, 1, 0); PG8_SCHED; PG8_LDA(At, 1, 0); PG8_STAGE(PG8_SA(0, 1), a2 + hstepA, voffA);
      PG8_WAIT_L(8); PG8_BAR; PG8_WAIT_L(0); PG8_MMA(0, 0, At, B0); PG8_BAR; PG8_SCHED;
      PG8_LDB(B1, 1, 1); PG8_STAGE(PG8_SB(1, 0), b3, voffB);
      PG8_BAR; PG8_WAIT_L(0); PG8_MMA(0, 1, At, B1); PG8_BAR;
      PG8_LDA(At, 1, 1); PG8_STAGE(PG8_SA(1, 0), a3, voffA);
      PG8_BAR; PG8_WAIT_L(0); PG8_MMA(1, 0, At, B0); PG8_BAR; PG8_SCHED;
      PG8_STAGE(PG8_SB(1, 1), b3 + hstepB, voffB);
      PG8_WAIT_V(6); PG8_BAR; PG8_MMA(1, 1, At, B1); PG8_BAR;
    }
    E(acc, cur, wr, wc, fr, fq);
    if (!has_next) break;
#pragma unroll
    for (int a = 0; a < 2; ++a)
#pragma unroll
      for (int b = 0; b < 2; ++b)
#pragma unroll
        for (int m = 0; m < 4; ++m)
#pragma unroll
          for (int n = 0; n < 2; ++n) acc[a][b][m][n] = (f32x4){0.f, 0.f, 0.f, 0.f};
    cur = nxt; cA = nA; cB = nB; ++ui;
  }
  PG8_WAIT_V(0);
  if (wr == 0) PG8_BAR;
  PG8_BAR;
#undef PG8_SA
#undef PG8_SB
#undef PG8_STAGE
#undef PG8_LDA
#undef PG8_LDB
#undef PG8_MMA
#undef PG8_WAIT_V
#undef PG8_WAIT_L
#undef PG8_BAR
#undef PG8_SCHED
}

struct EpiInProjT {
  const Params& P;
  int l;
  DEV void operator()(const f32x4 (&acc)[2][2][4][2], const Unit& u, int wr, int wc, int fr, int fq) const {
#pragma unroll
    for (int bj = 0; bj < 2; ++bj) {
      const int cg = u.pn * 256 + bj * 128 + wc * 32;
      if (cg >= 4368) continue;
#pragma unroll
      for (int ai = 0; ai < 2; ++ai)
#pragma unroll
        for (int m = 0; m < 4; ++m) {
          const int row = u.pm * 256 + ai * 128 + wr * 64 + m * 16 + fr;
          const f32x4 v0 = acc[ai][bj][m][0], v1 = acc[ai][bj][m][1];
          if (cg < C_WQ) {
            u16* dst = WS_P(P) + (size_t)row * PW + cg + 4 * fq;
            *reinterpret_cast<uint2*>(dst) = make_uint2(pack2(v0[0], v0[1]), pack2(v0[2], v0[3]));
            *reinterpret_cast<uint2*>(dst + 16) = make_uint2(pack2(v1[0], v1[1]), pack2(v1[2], v1[3]));
          } else if (cg < 3712) {
            const bool isq = (cg < C_WK) || (cg >= C_DQ && cg < C_DK);
            const float qs = isq ? 0.125f : 1.f;
            u16* dst = WS_P(P) + (size_t)row * PW + cg + 4 * fq;
            float o1[4], o2[4];
            if (row < NLAT) {
              const int t = row & (T - 1), hf = (cg >> 5) & 1;
              const float4* rt = reinterpret_cast<const float4*>(WS_ROPE(P) + ((size_t)t * 32 + hf * 16 + 4 * fq) * 2);
              const float4 c01 = rt[0], c23 = rt[1];
              const float cs[4] = {c01.x, c01.z, c23.x, c23.z}, sn[4] = {c01.y, c01.w, c23.y, c23.w};
#pragma unroll
              for (int e = 0; e < 4; ++e) { o1[e] = (v0[e] * cs[e] - v1[e] * sn[e]) * qs; o2[e] = (v1[e] * cs[e] + v0[e] * sn[e]) * qs; }
            } else {
#pragma unroll
              for (int e = 0; e < 4; ++e) { o1[e] = v0[e] * qs; o2[e] = v1[e] * qs; }
            }
            *reinterpret_cast<uint2*>(dst) = make_uint2(pack2(o1[0], o1[1]), pack2(o1[2], o1[3]));
            *reinterpret_cast<uint2*>(dst + 16) = make_uint2(pack2(o2[0], o2[1]), pack2(o2[2], o2[3]));
          } else if (cg < 4352) {
            int b, key;
            if (row < NLAT) { b = row >> 12; key = 256 + (row & (T - 1)); }
            else { b = (row - NLAT) >> 8; key = (row - NLAT) & 255; }
            u16* base;
            int v0i;
            if (cg < 3840) { base = WS_VTW(P) + ((size_t)(b * 2 + ((cg - 3712) >> 6)) * 64) * KEYS; v0i = (cg - 3712) & 63; }
            else { base = WS_VTD(P) + ((size_t)(b * 4 + ((cg - 3840) >> 7)) * 128) * KEYS; v0i = (cg - 3840) & 127; }
#pragma unroll
            for (int e = 0; e < 4; ++e) {
              base[(size_t)(v0i + 4 * fq + e) * KEYS + key] = f2bf(v0[e]);
              base[(size_t)(v0i + 16 + 4 * fq + e) * KEYS + key] = f2bf(v1[e]);
            }
          } else {
            const float4 bg = *reinterpret_cast<const float4*>(P.b_gate + l * 16 + 4 * fq);
            *reinterpret_cast<float4*>(WS_GATES(P) + (size_t)row * 16 + 4 * fq) = make_float4(v0[0] + bg.x, v0[1] + bg.y, v0[2] + bg.z, v0[3] + bg.w);
          }
        }
    }
  }
};
struct EpiResidT {
  const Params& P;
  const float* src_lat;
  const float* modl;
  int gt_off;
  DEV void operator()(const f32x4 (&acc)[2][2][4][2], const Unit& u, int wr, int wc, int fr, int fq) const {
#pragma unroll
    for (int ai = 0; ai < 2; ++ai)
#pragma unroll
      for (int m = 0; m < 4; ++m) {
        const int row = u.pm * 256 + ai * 128 + wr * 64 + m * 16 + fr;
        const float* src;
        float* dst;
        int cond;
        if (row < NLAT) { src = src_lat + (size_t)row * 1024; dst = P.out + (size_t)row * 1024; cond = row >> 12; }
        else { src = WS_XC(P) + (size_t)(row - NLAT) * 1024; dst = WS_XC(P) + (size_t)(row - NLAT) * 1024; cond = 16; }
        const float* gt = modl + (size_t)cond * 6144 + gt_off;
#pragma unroll
        for (int bj = 0; bj < 2; ++bj)
#pragma unroll
          for (int n = 0; n < 2; ++n) {
            const int col = u.pn * 256 + bj * 128 + wc * 32 + n * 16 + 4 * fq;
            const float4 s4 = *reinterpret_cast<const float4*>(src + col), g4 = *reinterpret_cast<const float4*>(gt + col);
            const f32x4 a = acc[ai][bj][m][n];
            *reinterpret_cast<float4*>(dst + col) = make_float4(s4.x + g4.x * a[0], s4.y + g4.y * a[1], s4.z + g4.z * a[2], s4.w + g4.w * a[3]);
          }
      }
  }
};
struct EpiSwigluT {
  u16* act;
  DEV void operator()(const f32x4 (&acc)[2][2][4][2], const Unit& u, int wr, int wc, int fr, int fq) const {
#pragma unroll
    for (int ai = 0; ai < 2; ++ai)
#pragma unroll
      for (int m = 0; m < 4; ++m) {
        const int row = u.pm * 256 + ai * 128 + wr * 64 + m * 16 + fr;
#pragma unroll
        for (int bj = 0; bj < 2; ++bj) {
          const int cg = u.pn * 256 + bj * 128 + wc * 32;
          const f32x4 g = acc[ai][bj][m][0], up = acc[ai][bj][m][1];
          *reinterpret_cast<uint2*>(act + (size_t)row * FH + (cg >> 1) + 4 * fq) =
              make_uint2(pack2(siluf_(g[0]) * up[0], siluf_(g[1]) * up[1]), pack2(siluf_(g[2]) * up[2], siluf_(g[3]) * up[3]));
        }
      }
  }
};
}


#ifdef SELFCHECK
#define DBGF(P) reinterpret_cast<float*>((P).ws + O_XC + (size_t)NCTXR * 1024 * 4)
DEV float blk_reduce(float v, bool ismax, float* red) {
  const int tid = my_tid(), lane = tid & 63, wid = tid >> 6;
#pragma unroll
  for (int o = 32; o > 0; o >>= 1) { float t = __shfl_xor(v, o); v = ismax ? fmaxf(v, t) : v + t; }
  __syncthreads();
  if (lane == 0) red[wid] = v;
  __syncthreads();
  float r = red[0];
  for (int i = 1; i < 8; ++i) r = ismax ? fmaxf(r, red[i]) : r + red[i];
  __syncthreads();
  return r;
}
DEV void chk_sample(int s, int& b, int& hd, int& t) {
  const int ti = s & 7;
  b = (s * 5 + 3) & 15; hd = s & 7;
  t = ti == 0 ? 0 : ti == 1 ? 63 : ti == 2 ? 64 : ti == 3 ? 127 : ti == 4 ? 2048 + 65 : ti == 5 ? 3000 : ti == 6 ? 4032 : 4095;
}
DEV void check_pre(const Params& P, int l, char* smem) {
  const int tid = my_tid();
  float* sc = reinterpret_cast<float*>(smem);
  float* red = sc + 2 * 4352;
  float* ov = red + 16;
  float* dbg = DBGF(P);
  const u16* p = WS_P(P);
  for (int it = blockIdx.x; it < 24; it += gridDim.x) {
    const bool isdiff = it >= 12;
    const int s = isdiff ? it - 12 : it;
    int b, hd, t;
    chk_sample(s, b, hd, t);
    const bool ctxq = s >= 8;
    if (ctxq) t &= 255;
    const size_t row = ctxq ? (size_t)NLAT + b * 256 + t : (size_t)b * T + t;
    __syncthreads();
    if (!isdiff) {
      const int head = hd, g = head >> 2;
      const int lo = ctxq ? 0 : max(0, t - 128), hi = ctxq ? -1 : min(T - 1, t + 128);
      const int nk = 256 + (hi - lo + 1);
      float mx = -1e30f;
      for (int k = tid; k < nk; k += NTHREADS) {
        size_t krow = k < 256 ? (size_t)NLAT + b * 256 + k : (size_t)b * T + lo + (k - 256);
        float a = 0.f;
        for (int d = 0; d < 64; ++d) a += bf2f(p[row * PW + C_WQ + head * 64 + d]) * bf2f(p[krow * PW + C_WK + g * 64 + d]);
        sc[k] = a;
        mx = fmaxf(mx, a);
      }
      mx = blk_reduce(mx, true, red);
      const float sk = P.sink[l * 8 + head];
      mx = fmaxf(mx, sk);
      float sm = 0.f;
      for (int k = tid; k < nk; k += NTHREADS) { float e = expf(sc[k] - mx); sc[k] = e; sm += e; }
      sm = blk_reduce(sm, false, red) + expf(sk - mx);
      if (tid < 64) {
        float o = 0.f;
        for (int k = 0; k < nk; ++k) {
          int kidx = k < 256 ? k : 256 + lo + (k - 256);
          o += sc[k] * bf2f(WS_VTW(P)[((size_t)(b * 2 + g) * 64 + tid) * KEYS + kidx]);
        }
        dbg[it * 128 + tid] = o / sm;
      }
    } else {
      const int h = hd & 3;
      const int nk = ctxq ? 256 : KEYS;
      float mx0 = -1e30f, mx1 = -1e30f;
      for (int k = tid; k < nk; k += NTHREADS) {
        size_t krow = k < 256 ? (size_t)NLAT + b * 256 + k : (size_t)b * T + (k - 256);
        float a0 = 0.f, a1 = 0.f;
        for (int d = 0; d < 64; ++d) {
          a0 += bf2f(p[row * PW + C_DQ + h * 128 + d]) * bf2f(p[krow * PW + C_DK + h * 128 + d]);
          a1 += bf2f(p[row * PW + C_DQ + h * 128 + 64 + d]) * bf2f(p[krow * PW + C_DK + h * 128 + 64 + d]);
        }
        sc[k] = a0; sc[4352 + k] = a1;
        mx0 = fmaxf(mx0, a0); mx1 = fmaxf(mx1, a1);
      }
      mx0 = blk_reduce(mx0, true, red);
      mx1 = blk_reduce(mx1, true, red);
      float s0 = 0.f, s1 = 0.f;
      for (int k = tid; k < nk; k += NTHREADS) {
        float e0 = expf(sc[k] - mx0), e1 = expf(sc[4352 + k] - mx1);
        sc[k] = e0; sc[4352 + k] = e1; s0 += e0; s1 += e1;
      }
      s0 = blk_reduce(s0, false, red);
      s1 = blk_reduce(s1, false, red);
      const float lam = WS_LAM(P)[l], lam_init = 0.8f - 0.6f * expf(-0.3f * (float)l);
      float y = 0.f;
      if (tid < 128) {
        for (int k = 0; k < nk; ++k)
          y += (sc[k] / s0 - lam * sc[4352 + k] / s1) * bf2f(WS_VTD(P)[((size_t)(b * 4 + h) * 128 + tid) * KEYS + k]);
        ov[tid] = y;
      }
      __syncthreads();
      if (tid < 128) {
        float ss = 0.f;
        for (int v = 0; v < 128; ++v) ss += ov[v] * ov[v];
        dbg[it * 128 + tid] = y * rsqrtf(ss / 128.f + EPS) * P.d_norm[l * 512 + h * 128 + tid] * (1.f - lam_init);
      }
    }
  }
}
DEV void check_post(const Params& P, int l, unsigned* flags) {
  const int tid = my_tid();
  const float* dbg = DBGF(P);
  const u16* p = WS_P(P);
  for (int it = blockIdx.x; it < 24; it += gridDim.x) {
    const bool isdiff = it >= 12;
    const int s = isdiff ? it - 12 : it;
    int b, hd, t;
    chk_sample(s, b, hd, t);
    const bool ctxq = s >= 8;
    if (ctxq) t &= 255;
    const size_t row = ctxq ? (size_t)NLAT + b * 256 + t : (size_t)b * T + t;
    if (ctxq && l != 0) continue;
    const int n = isdiff ? 128 : 64;
    if (tid < n) {
      float got = isdiff ? bf2f(p[row * PW + C_DQ + (hd & 3) * 128 + tid]) : bf2f(p[row * PW + C_WQ + hd * 64 + tid]);
      float ex = dbg[it * 128 + tid];
      if (!(fabsf(got - ex) <= 0.03f + 0.03f * fabsf(ex))) atomicOr(flags, isdiff ? (ctxq ? 32u : 2u) : (ctxq ? 16u : 1u));
    }
  }
}
DEV void check_mlstm(const Params& P, int l, char* smem, unsigned* flags) {
  const int tid = my_tid(), lane = tid & 63;
  float* qs = reinterpret_cast<float*>(smem);
  float* ks = qs + 128;
  float* vs = ks + 128;
  float* nn = vs + 128;
  float* sc = nn + 128;
  float* red = sc + 8;
  const u16* p = WS_P(P);
  for (int it = blockIdx.x; it < 4; it += gridDim.x) {
    const int b = (it * 7 + 2) & 15, hd = (it + 1) & 3, dir = it & 1;
    const int v = tid >> 2, kq = tid & 3;
    float C[32];
#pragma unroll
    for (int j = 0; j < 32; ++j) C[j] = 0.f;
    __syncthreads();
    if (tid < 128) nn[tid] = 0.f;
    if (tid == 0) sc[0] = 0.f;
    __syncthreads();
    const int nsteps = (l == 0) ? 256 + T : 256 + T;
    for (int st = 0; st < nsteps; ++st) {
      int seg0, seglen, u;
      if (st < 256) { seg0 = NLAT + b * 256; seglen = 256; u = dir ? 255 - st : st; }
      else { seg0 = b * T; seglen = T; u = dir ? T - 1 - (st - 256) : st - 256; }
      const size_t row = (size_t)seg0 + u;
      if (tid < 128) {
        float xq = 0.f, xk = 0.f;
        for (int tp = 0; tp < 3; ++tp) {
          int uu = u + tp - 1;
          if (uu >= 0 && uu < seglen) {
            xq += P.conv_w[(size_t)l * 3072 + tp * 1024 + hd * 128 + tid] * bf2f(p[((size_t)seg0 + uu) * PW + C_MQ + hd * 128 + tid]);
            xk += P.conv_w[(size_t)l * 3072 + tp * 1024 + 512 + hd * 128 + tid] * bf2f(p[((size_t)seg0 + uu) * PW + C_MK + hd * 128 + tid]);
          }
        }
        qs[tid] = xq / (1.f + expf(-xq));
        ks[tid] = xk / (1.f + expf(-xk)) * 0.08838834764831845f;
        vs[tid] = bf2f(p[row * PW + C_MV + hd * 128 + tid]);
      }
      if (tid == 0) {
        float ig = WS_GATES(P)[row * 16 + dir * 8 + hd], fg = WS_GATES(P)[row * 16 + dir * 8 + 4 + hd];
        float lf = fminf(fg, 0.f) - log1pf(expf(-fabsf(fg)));
        float m = sc[0], mn = fmaxf(lf + m, ig);
        sc[1] = expf(lf + m - mn);
        sc[2] = expf(ig - mn);
        sc[3] = mn;
      }
      __syncthreads();
      const float fd = sc[1], iw = sc[2], mn = sc[3];
      float pd = 0.f;
#pragma unroll
      for (int j = 0; j < 32; ++j) {
        C[j] = fd * C[j] + iw * vs[v] * ks[kq * 32 + j];
        pd += C[j] * qs[kq * 32 + j];
      }
      pd += __shfl_xor(pd, 1);
      pd += __shfl_xor(pd, 2);
      float dn = 0.f;
      if (tid < 128) { float nv = fd * nn[tid] + iw * ks[tid]; nn[tid] = nv; dn = nv * qs[tid]; }
      dn = blk_reduce(dn, false, red);
      if (tid == 0) sc[0] = mn;
      const float hval = pd / fmaxf(fabsf(dn), expf(-mn));
      float sq = (kq == 0) ? hval * hval : 0.f;
      sq = blk_reduce(sq, false, red);
      const float rms = sqrtf(sq / 128.f);
      const bool cmp = (st < 256) ? (l == 0) : true;
      if (cmp && kq == 0 && ((u & 63) == 0 || (u & 63) == 63 || (u % 97) == 0)) {
        float got = bf2f(WS_HFB(P)[(size_t)dir * MTOT * 512 + row * 512 + hd * 128 + v]);
        if (!(fabsf(got - hval) <= 0.05f * rms + 0.05f * fabsf(hval) + 1e-3f)) atomicOr(flags, dir ? 8u : 4u);
      }
    }
  }
}
#endif


#ifdef SELFCHECK
DEV void flag_if(bool bad, unsigned* flags, unsigned bit) { if (bad) atomicOr(flags, bit); }
DEV bool close_(float got, float ex, float tol) { return fabsf(got - ex) <= tol + tol * fabsf(ex); }
DEV void check_inproj(const Params& P, int l, char* smem, unsigned* flags) {
  const int tid = my_tid();
  float* red = reinterpret_cast<float*>(smem);
  float* hrow = red + 16;
  const float* modl = WS_MOD(P) + (size_t)l * 17 * 6144;
  for (int it = blockIdx.x; it < 64; it += gridDim.x) {
    const int ri = it & 7;
    const int row = ri == 0 ? 0 : ri == 1 ? 4095 : ri == 2 ? 4096 + 77 : ri == 3 ? 30000 : ri == 4 ? 65535 : ri == 5 ? NLAT : ri == 6 ? NLAT + 300 : MTOT - 1;
    const int cond = row < NLAT ? row >> 12 : 16;
    {
      int col = (it * 769 + 5) % 6144;
      float a = 0.f;
      for (int k = tid; k < 1024; k += NTHREADS) {
        float cv = cond < 16 ? P.c[cond * 1024 + k] : P.c_ctx[k];
        a += cv / (1.f + expf(-cv)) * P.w_mod[(size_t)l * 1024 * 6144 + (size_t)k * 6144 + col];
      }
      a = blk_reduce(a, false, red) + P.b_mod[l * 6144 + col];
      if (tid == 0) flag_if(!close_(modl[(size_t)cond * 6144 + col], a, 2e-3f), flags, 1u);
    }
    const float* xs = row < NLAT ? ((l == 0 ? P.x : P.out) + (size_t)row * 1024) : (WS_XC(P) + (size_t)(row - NLAT) * 1024);
    float ss = 0.f;
    for (int k = tid; k < 1024; k += NTHREADS) ss += xs[k] * xs[k];
    ss = blk_reduce(ss, false, red);
    const float rstd = rsqrtf(ss / 1024.f + EPS);
    for (int k = tid; k < 1024; k += NTHREADS) {
      float y = xs[k] * rstd * P.g_mix[l * 1024 + k] * (1.f + modl[(size_t)cond * 6144 + 1024 + k]) + modl[(size_t)cond * 6144 + k];
      hrow[k] = y;
      flag_if(!close_(bf2f(WS_H(P)[(size_t)row * 1024 + k]), y, 1e-2f), flags, 2u);
    }
    __syncthreads();
    const int oi = it >> 3;
    const int oj = (oi * 2 + (it & 1)) & 15;
    const int oc = oj == 0 ? 3 : oj == 1 ? 600 : oj == 2 ? 1100 : oj == 3 ? 1999 : oj == 4 ? 2050 : oj == 5 ? 2064 + 70 : oj == 6 ? 2576 + 100 :
                   oj == 7 ? 2704 + 5 : oj == 8 ? 2832 + 200 : oj == 9 ? 2832 + 37 : oj == 10 ? 3344 + 90 : oj == 11 ? 3344 + 300 :
                   oj == 12 ? 3856 + 10 : oj == 13 ? 3856 + 500 : oj == 14 ? 2048 + 15 : 2064 + 500;
    auto dotcol = [&](int c) {
      float a = 0.f;
      for (int k = tid; k < 1024; k += NTHREADS) a += hrow[k] * P.w_in[(size_t)l * 1024 * INW + (size_t)k * INW + c];
      return blk_reduce(a, false, red);
    };
    float val = dotcol(oc);
    const u16* p = WS_P(P);
    const bool lat = row < NLAT;
    const int t = row & (T - 1);
    float got = 0.f, ex = val;
    unsigned bit = 4u;
    if (oc < 2048) { got = bf2f(p[(size_t)row * PW + oc]); }
    else if (oc < 2064) { got = WS_GATES(P)[(size_t)row * 16 + oc - 2048]; ex = val + P.b_gate[l * 16 + oc - 2048]; }
    else if (oc >= 2704 && oc < 2832) {
      int cgi = oc - 2704, g = cgi >> 6, vd = cgi & 63;
      int b = lat ? row >> 12 : (row - NLAT) >> 8, key = lat ? 256 + t : (row - NLAT) & 255;
      got = bf2f(WS_VTW(P)[((size_t)(b * 2 + g) * 64 + vd) * KEYS + key]);
      bit = 8u;
    } else if (oc >= 3856) {
      int cgi = oc - 3856, h = cgi >> 7, vd = cgi & 127;
      int b = lat ? row >> 12 : (row - NLAT) >> 8, key = lat ? 256 + t : (row - NLAT) & 255;
      got = bf2f(WS_VTD(P)[((size_t)(b * 4 + h) * 128 + vd) * KEYS + key]);
      bit = 8u;
    } else {
      int base, nb0;
      bool isq;
      if (oc < 2576) { base = 2064; nb0 = C_WQ; isq = true; }
      else if (oc < 2704) { base = 2576; nb0 = C_WK; isq = false; }
      else if (oc < 3344) { base = 2832; nb0 = C_DQ; isq = true; }
      else { base = 3344; nb0 = C_DK; isq = false; }
      int rel = oc - base, dd = rel & 63, j = dd & 15, second = (dd >> 4) & 1, axis = dd >> 5;
      float other = dotcol(second ? oc - 16 : oc + 16);
      if (lat) {
        int pos = axis ? (t & 63) : (t >> 6);
        float ang = (float)pos * powf(10000.f, -(float)j / 16.f);
        float cs = cosf(ang), sn = sinf(ang);
        ex = second ? (val * cs + other * sn) : (val * cs - other * sn);
      }
      if (isq) ex *= 0.125f;
      got = bf2f(p[(size_t)row * PW + nb0 + rel]);
      bit = 16u;
    }
    if (tid == 0) flag_if(!close_(got, ex, 3e-2f), flags, bit);
    __syncthreads();
  }
}
DEV void check_post6(const Params& P, int l, char* smem, unsigned* flags, const float* xprev) {
  const int tid = my_tid();
  float* red = reinterpret_cast<float*>(smem);
  const u16* Yp = WS_P(P);
  const float* modl = WS_MOD(P) + (size_t)l * 17 * 6144;
  for (int it = blockIdx.x; it < 16; it += gridDim.x) {
    const int ri = it & 7;
    const int row = ri == 0 ? 1 : ri == 1 ? 4097 : ri == 2 ? 12345 : ri == 3 ? 40000 : ri == 4 ? 65534 : ri == 5 ? NLAT + 1 : ri == 6 ? NLAT + 2000 : MTOT - 2;
    if (row >= NLAT && l != 0) continue;
    const int col = (it * 331 + 17) & 1023;
    const int cond = row < NLAT ? row >> 12 : 16;
    float mg = 0.f;
    for (int i = 0; i < 3; ++i) {
      float a = 0.f, z = 0.f;
      for (int k = tid; k < 1024; k += NTHREADS) a += bf2f(WS_H(P)[(size_t)row * 1024 + k]) * P.w_in[(size_t)l * 1024 * INW + (size_t)k * INW + 4368 + i * 1024 + col];
      a = blk_reduce(a, false, red);
      const int yc = i == 0 ? C_MO : (i == 1 ? C_WQ : C_DQ);
      for (int k = tid; k < 512; k += NTHREADS) z += bf2f(Yp[(size_t)row * PW + yc + k]) * P.w_branch[((size_t)l * 3 + i) * 512 * 1024 + (size_t)k * 1024 + col];
      z = blk_reduce(z, false, red);
      mg += z / (1.f + expf(-a));
    }
    if (tid == 0) flag_if(!close_(bf2f(WS_HFB(P)[(size_t)row * 1024 + col]), mg, 3e-2f), flags, 1u);
    float o = 0.f;
    for (int k = tid; k < 1024; k += NTHREADS) o += bf2f(WS_HFB(P)[(size_t)row * 1024 + k]) * P.w_out[(size_t)l * 1024 * 1024 + (size_t)k * 1024 + col];
    o = blk_reduce(o, false, red);
    const float xo = row < NLAT ? xprev[(size_t)row * 1024 + col] : -1e9f;
    const float xn = row < NLAT ? P.out[(size_t)row * 1024 + col] : WS_XC(P)[(size_t)(row - NLAT) * 1024 + col];
    if (tid == 0 && row < NLAT && (l == 0)) flag_if(!close_(xn, xo + modl[(size_t)cond * 6144 + 2048 + col] * o, 2e-2f), flags, 2u);
    if (tid == 0) DBGF(P)[4096 + it] = xn;
  }
}
DEV void check_post9(const Params& P, int l, char* smem, unsigned* flags) {
  const int tid = my_tid();
  float* red = reinterpret_cast<float*>(smem);
  const float* modl = WS_MOD(P) + (size_t)l * 17 * 6144;
  for (int it = blockIdx.x; it < 16; it += gridDim.x) {
    const int ri = it & 7;
    const int row = ri == 0 ? 1 : ri == 1 ? 4097 : ri == 2 ? 12345 : ri == 3 ? 40000 : ri == 4 ? 65534 : ri == 5 ? NLAT + 1 : ri == 6 ? NLAT + 2000 : MTOT - 2;
    if (row >= NLAT && l != 0) continue;
    const int col = (it * 331 + 17) & 1023;
    const int cond = row < NLAT ? row >> 12 : 16;
    const int j = (it * 97 + 13) % FH;
    float g = 0.f, u = 0.f;
    for (int k = tid; k < 1024; k += NTHREADS) {
      float hv = bf2f(WS_H(P)[(size_t)row * 1024 + k]);
      g += hv * P.w_ffn_in[(size_t)l * 1024 * 5632 + (size_t)k * 5632 + j];
      u += hv * P.w_ffn_in[(size_t)l * 1024 * 5632 + (size_t)k * 5632 + FH + j];
    }
    g = blk_reduce(g, false, red);
    u = blk_reduce(u, false, red);
    if (tid == 0) flag_if(!close_(bf2f(WS_P(P)[(size_t)row * FH + j]), g / (1.f + expf(-g)) * u, 3e-2f), flags, 4u);
    float o = 0.f;
    for (int k = tid; k < FH; k += NTHREADS) o += bf2f(WS_P(P)[(size_t)row * FH + k]) * P.w_ffn_out[(size_t)l * FH * 1024 + (size_t)k * 1024 + col];
    o = blk_reduce(o, false, red);
    const float xn = row < NLAT ? P.out[(size_t)row * 1024 + col] : WS_XC(P)[(size_t)(row - NLAT) * 1024 + col];
    if (tid == 0) flag_if(!close_(xn, DBGF(P)[4096 + it] + modl[(size_t)cond * 6144 + 5120 + col] * o, 2e-2f), flags, 8u);
  }
}
#endif

#ifdef DEBUG_STAGE
DEV void debug_dump(const Params& P, int stage) {
  const int tid = my_tid();
  for (size_t idx = (size_t)blockIdx.x * NTHREADS + tid; idx < (size_t)NLAT * 1024; idx += (size_t)gridDim.x * NTHREADS) {
    size_t row = idx >> 10;
    int c = (int)(idx & 1023);
    size_t r2 = row + (row < 4096 ? NLAT : 0);
    float v = 0.f;
    const u16* p = WS_P(P);
    if (stage == 1) {
      v = bf2f(p[row * PW + c]) + bf2f(p[row * PW + 1024 + c]) + bf2f(p[row * PW + 2048 + c]) + (c < 640 ? bf2f(p[row * PW + 3072 + c]) : 0.f);
      v += bf2f(p[r2 * PW + c]) + bf2f(p[r2 * PW + 1024 + c]) + bf2f(p[r2 * PW + 2048 + c]);
      v += bf2f(WS_VTD(P)[r2 * 512 + (c & 511)]) + bf2f(WS_VTW(P)[r2 * 128 + (c & 127)]) + WS_GATES(P)[r2 * 16 + (c & 15)];
      v += bf2f(WS_VTD(P)[row * 512 + (c & 511)]) + bf2f(WS_VTW(P)[row * 128 + (c & 127)]) + WS_GATES(P)[row * 16 + (c & 15)];
    } else if (stage == 21) {
      v = bf2f(WS_HFB(P)[row * 512 + (c & 511)]) + 2.f * bf2f(WS_HFB(P)[(size_t)MTOT * 512 + row * 512 + (c & 511)]);
      v += bf2f(WS_HFB(P)[r2 * 512 + (c & 511)]) + 2.f * bf2f(WS_HFB(P)[(size_t)MTOT * 512 + r2 * 512 + (c & 511)]);
    } else if (stage == 22) {
      v = bf2f(p[row * PW + C_WQ + (c & 511)]) + bf2f(p[r2 * PW + C_WQ + (c & 511)]);
    } else if (stage == 23) {
      v = bf2f(p[row * PW + C_DQ + (c & 511)]) + bf2f(p[r2 * PW + C_DQ + (c & 511)]);
    } else if (stage == 3) {
      v = bf2f(WS_HFB(P)[row * 1024 + c]) + bf2f(WS_HFB(P)[r2 * 1024 + c]);
    } else if (stage == 4) {
      v = P.out[idx] + WS_XC(P)[(row & 4095) * 1024 + c];
    } else if (stage == 5) {
      v = bf2f(WS_H(P)[row * 1024 + c]) + bf2f(WS_H(P)[r2 * 1024 + c]);
    } else if (stage == 6) {
      v = bf2f(p[row * FH + c]) + bf2f(p[row * FH + 1024 + c]) + bf2f(p[r2 * FH + 1792 + c]);
    }
    if (stage != 4) P.out[idx] = v; else P.out[idx] = v;
  }
}
#define DBG(st) if (l == 0 && DEBUG_STAGE == st) { GSYNC_ONLY(); debug_dump(P, st); return true; }
#else
#define DBG(st)
#endif
template <int l>
DEV bool layer_body(const Params& P, unsigned* bar, unsigned& epoch, char* smem) {
  constexpr bool need_ctx = (l == 0);
  const float* modl = WS_MOD(P) + (size_t)l * 17 * 6144;
  const u16* Wl = WS_W(P) + (size_t)l * W_LAYER;
  const float* xlat = l == 0 ? P.x : P.out;
  constexpr int Mtok = need_ctx ? MTOT : NLAT;
  phase_norm_mod(P, xlat, WS_XC(P), MTOT, P.g_mix + l * 1024, modl, 0, 1024);
  GSYNC();
  pg8::gemm_phase(smem, WS_H(P), 1024, Wl + W_IN, 1024, MTOT, NIN, 1024, pg8::EpiInProjT{P, l});
#ifdef REPEAT_GEMMS
  if (l == 1) pg8::gemm_phase(smem, WS_H(P), 1024, Wl + W_IN, 1024, MTOT, NIN, 1024, pg8::EpiInProjT{P, l});
#endif
  GSYNC();
  DBG(1)
#ifdef SELFCHECK
#if SELFCHECK == 2
  check_inproj(P, l, smem, WS_CTR(P) + 16 + l * 3);
#else
  check_pre(P, l, smem);
#endif
  GSYNC();
#endif
  phase_mixers(P, l, smem);
  GSYNC();
#if defined(SELFCHECK) && SELFCHECK == 1
  check_post(P, l, WS_CTR(P) + 17 + l * 3);
  check_mlstm(P, l, smem, WS_CTR(P) + 17 + l * 3);
  GSYNC();
#endif
  DBG(21)
  DBG(22)
  DBG(23)
  phase_ya(P, l, Mtok);
  GSYNC();
  phase_merge(P, l, Mtok, smem);
#ifdef REPEAT_GEMMS
  if (l == 1) phase_merge(P, l, Mtok, smem);
#endif
  GSYNC();
  DBG(3)
  pg8::gemm_phase(smem, WS_HFB(P), 1024, Wl + W_O, 1024, Mtok, 1024, 1024, pg8::EpiResidT{P, xlat, modl, 2048});
  GSYNC();
#if defined(SELFCHECK) && SELFCHECK == 2
  check_post6(P, l, smem, WS_CTR(P) + 18 + l * 3, xlat);
  GSYNC();
#endif
  DBG(4)
  phase_norm_mod(P, P.out, WS_XC(P), Mtok, P.g_ffn + l * 1024, modl, 3072, 4096);
  GSYNC();
  DBG(5)
  pg8::gemm_phase(smem, WS_H(P), 1024, Wl + W_FI, 1024, Mtok, 5632, 1024, pg8::EpiSwigluT{WS_P(P)});
#ifdef REPEAT_GEMMS
  if (l == 1) pg8::gemm_phase(smem, WS_H(P), 1024, Wl + W_FI, 1024, Mtok, 5632, 1024, pg8::EpiSwigluT{WS_P(P)});
#endif
  GSYNC();
  DBG(6)
  pg8::gemm_phase(smem, WS_P(P), FH, Wl + W_FO, FH, Mtok, 1024, FH, pg8::EpiResidT{P, P.out, modl, 5120});
  GSYNC();
#if defined(SELFCHECK) && SELFCHECK == 2
  check_post9(P, l, smem, WS_CTR(P) + 18 + l * 3);
  GSYNC();
#endif
  return false;
}

__global__ void __launch_bounds__(NTHREADS) fwd_megakernel(Params P) {
  extern __shared__ __attribute__((aligned(16))) char smem[];
  cg::grid_group grid = cg::this_grid();
  unsigned* bar = WS_CTR(P) + 64;
  unsigned epoch = 0;
  grid.sync();
  phase_prologue(P, smem);
  GSYNC();
  if (layer_body<0>(P, bar, epoch, smem)) return;
  if (layer_body<1>(P, bar, epoch, smem)) return;
  phase_final_norm(P);
#ifdef SELFCHECK
  GSYNC();
  if (blockIdx.x == 0 && my_tid() == 0) {
    float scale = 1000.f;
    for (int w = 0; w < 6; ++w) {
      unsigned f = WS_CTR(P)[16 + w];
      if (f) { P.out[0] = (10.f + (float)f) * scale; break; }
      scale *= 10.f;
    }
  }
#endif
}

extern "C" void kernel_launch(void* const* d_in, const int* in_sizes, int n_in, void* d_out, int out_size, void* d_ws,
                              size_t ws_size, hipStream_t stream) {
  static int grid_blocks = 0;
  if (!grid_blocks) {
    int dev = 0, cus = 0, per_cu = 0;
    hipGetDevice(&dev);
    hipDeviceGetAttribute(&cus, hipDeviceAttributeMultiprocessorCount, dev);
    hipFuncSetAttribute((const void*)fwd_megakernel, hipFuncAttributeMaxDynamicSharedMemorySize, LDS_BYTES);
    hipOccupancyMaxActiveBlocksPerMultiprocessor(&per_cu, fwd_megakernel, NTHREADS, LDS_BYTES);
    if (per_cu < 1) per_cu = 1;
    if (per_cu > 1) per_cu = 1;
    grid_blocks = cus * per_cu;
  }
  Params P{};
  const float* const* in = reinterpret_cast<const float* const*>(d_in);
  P.x = in[0]; P.c = in[1]; P.ctx = in[2]; P.c_ctx = in[3]; P.w_mod = in[4]; P.b_mod = in[5]; P.g_mix = in[6];
  P.g_ffn = in[7]; P.w_in = in[8]; P.b_gate = in[9]; P.conv_w = in[10]; P.m_norm = in[11]; P.sink = in[12];
  P.lam_q1 = in[13]; P.lam_k1 = in[14]; P.lam_q2 = in[15]; P.lam_k2 = in[16]; P.d_norm = in[17]; P.w_branch = in[18];
  P.w_out = in[19]; P.w_ffn_in = in[20]; P.w_ffn_out = in[21]; P.g_final = in[22];
  P.out = reinterpret_cast<float*>(d_out);
  P.ws = reinterpret_cast<char*>(d_ws);
  if (WS_TOTAL > ws_size) fprintf(stderr, "workspace too small: need %zu have %zu\n", (size_t)WS_TOTAL, ws_size);
  hipMemsetAsync(P.ws + O_CTR, 0, 2048, stream);
  void* args[] = {&P};
  hipError_t e = hipLaunchCooperativeKernel((const void*)fwd_megakernel, dim3(grid_blocks), dim3(NTHREADS), args, LDS_BYTES, stream);
  if (e != hipSuccess) fprintf(stderr, "cooperative launch failed: %s (grid %d)\n", hipGetErrorString(e), grid_blocks);
}
```

```cpp
#include <hip/hip_runtime.h>
#include <hip/hip_cooperative_groups.h>
#include <cstdio>
#include <cstdint>
namespace cg = cooperative_groups;

typedef unsigned short u16;
using bf16x8 = __attribute__((ext_vector_type(8))) short;
using f32x4 = __attribute__((ext_vector_type(4))) float;
using f32x16 = __attribute__((ext_vector_type(16))) float;

#define DEV __device__ __forceinline__

constexpr int D = 1024, NB = 16, T = 4096, TC = 256;
constexpr int NLAT = NB * T;
constexpr int NCTXR = NB * TC;
constexpr int MTOT = NLAT + NCTXR;
constexpr int KEYS = T + TC;
constexpr int INW = 7440;
constexpr int PW = 3712;
constexpr int C_MQ = 0, C_MK = 512, C_MV = 1024, C_MO = 1536, C_WQ = 2048, C_WK = 2560, C_DQ = 2688, C_DK = 3200;
constexpr int NIN = 4608;
constexpr int FH = 2816;
constexpr float EPS = 1e-6f;
constexpr float L2E = 1.4426950408889634f;
constexpr int NTHREADS = 512;
constexpr int LDS_BYTES = 147456;

constexpr size_t W_IN = 0;
constexpr size_t W_G = W_IN + (size_t)NIN * 1024;
constexpr size_t W_B = W_G + (size_t)3072 * 1024;
constexpr size_t W_O = W_B + (size_t)3 * 1024 * 512;
constexpr size_t W_FI = W_O + (size_t)1024 * 1024;
constexpr size_t W_FO = W_FI + (size_t)5632 * 1024;
constexpr size_t W_LAYER = W_FO + (size_t)1024 * FH;

struct Params {
  const float *x, *c, *ctx, *c_ctx, *w_mod, *b_mod, *g_mix, *g_ffn, *w_in, *b_gate, *conv_w, *m_norm, *sink;
  const float *lam_q1, *lam_k1, *lam_q2, *lam_k2, *d_norm, *w_branch, *w_out, *w_ffn_in, *w_ffn_out, *g_final;
  float* out;
  char* ws;
};


constexpr size_t al256(size_t x) { return (x + 255) & ~(size_t)255; }
constexpr size_t O_W = 0;
constexpr size_t O_MOD = O_W + al256(2 * W_LAYER * 2);
constexpr size_t O_ROPE = O_MOD + al256((size_t)2 * 17 * 6144 * 4);
constexpr size_t O_LAM = O_ROPE + al256((size_t)T * 32 * 2 * 4);
constexpr size_t O_CTR = O_LAM + 256;
constexpr size_t O_GATES = O_CTR + 2048;
constexpr size_t O_H = O_GATES + al256((size_t)MTOT * 16 * 4);
constexpr size_t O_P = O_H + al256((size_t)MTOT * 1024 * 2);
constexpr size_t O_VTW = O_P + al256((size_t)MTOT * PW * 2);
constexpr size_t O_VTD = O_VTW + al256((size_t)NB * 2 * 64 * KEYS * 2);
constexpr size_t O_HFB = O_VTD + al256((size_t)NB * 4 * 128 * KEYS * 2);
constexpr size_t O_XC = O_HFB + al256((size_t)2 * MTOT * 512 * 2);
constexpr size_t WS_TOTAL = O_XC + al256((size_t)NCTXR * 1024 * 4) + 65536;
#define WS_W(P) reinterpret_cast<u16*>((P).ws + O_W)
#define WS_MOD(P) reinterpret_cast<float*>((P).ws + O_MOD)
#define WS_ROPE(P) reinterpret_cast<float*>((P).ws + O_ROPE)
#define WS_LAM(P) reinterpret_cast<float*>((P).ws + O_LAM)
#define WS_CTR(P) reinterpret_cast<unsigned*>((P).ws + O_CTR)
#define WS_GATES(P) reinterpret_cast<float*>((P).ws + O_GATES)
#define WS_H(P) reinterpret_cast<u16*>((P).ws + O_H)
#define WS_P(P) reinterpret_cast<u16*>((P).ws + O_P)
#define WS_VTW(P) reinterpret_cast<u16*>((P).ws + O_VTW)
#define WS_VTD(P) reinterpret_cast<u16*>((P).ws + O_VTD)
#define WS_HFB(P) reinterpret_cast<u16*>((P).ws + O_HFB)
#define WS_XC(P) reinterpret_cast<float*>((P).ws + O_XC)

DEV int my_tid() {
  int t = threadIdx.x;
  asm volatile("" : "+v"(t));
  return t;
}
typedef __bf16 bf2_t __attribute__((ext_vector_type(2)));
typedef float f2_t __attribute__((ext_vector_type(2)));
DEV uint32_t pack2(float a, float b) {
  f2_t v = {a, b};
  bf2_t r = __builtin_convertvector(v, bf2_t);
  return *reinterpret_cast<uint32_t*>(&r);
}
DEV u16 f2bf(float f) { return (u16)(pack2(f, 0.f) & 0xffffu); }
DEV float bf2f(u16 h) { return __uint_as_float(((uint32_t)h) << 16); }
DEV float bflo(uint32_t v) { return __uint_as_float(v << 16); }
DEV float bfhi(uint32_t v) { return __uint_as_float(v & 0xffff0000u); }
DEV float fexp2(float x) { return __builtin_amdgcn_exp2f(x); }
DEV float sigmoidf_(float x) { return __builtin_amdgcn_rcpf(1.f + __expf(-x)); }
DEV float siluf_(float x) { return x * __builtin_amdgcn_rcpf(1.f + __expf(-x)); }
DEV float wave_sum(float v) {
#pragma unroll
  for (int o = 32; o > 0; o >>= 1) v += __shfl_xor(v, o);
  return v;
}
DEV bf16x8 ld16(const void* p) { return *reinterpret_cast<const bf16x8*>(p); }
DEV bf16x8 mk8(uint32_t a, uint32_t b, uint32_t c, uint32_t d) {
  uint4 u = make_uint4(a, b, c, d);
  return *reinterpret_cast<bf16x8*>(&u);
}
DEV f32x16 mfma32(bf16x8 a, bf16x8 b, f32x16 c) { return __builtin_amdgcn_mfma_f32_32x32x16_bf16(a, b, c, 0, 0, 0); }
DEV f32x4 mfma16(bf16x8 a, bf16x8 b, f32x4 c) { return __builtin_amdgcn_mfma_f32_16x16x32_bf16(a, b, c, 0, 0, 0); }
DEV int pi32(int r) { return (r & ~12) | ((r & 4) << 1) | ((r & 8) >> 1); }


DEV void grid_barrier(unsigned* bar, unsigned& epoch) {
  asm volatile("s_waitcnt vmcnt(0)" ::: "memory");
  __syncthreads();
  epoch += 1;
  if (my_tid() == 0) {
    __builtin_amdgcn_fence(__ATOMIC_RELEASE, "agent");
    unsigned* loc = bar + 32 + (blockIdx.x & 7) * 32;
    const unsigned per = gridDim.x >> 3;
    unsigned old = __hip_atomic_fetch_add(loc, 1u, __ATOMIC_RELAXED, __HIP_MEMORY_SCOPE_AGENT);
    if (old + 1 == per * epoch) __hip_atomic_fetch_add(bar, 1u, __ATOMIC_RELAXED, __HIP_MEMORY_SCOPE_AGENT);
    while (__hip_atomic_load(bar, __ATOMIC_RELAXED, __HIP_MEMORY_SCOPE_AGENT) < 8u * epoch) __builtin_amdgcn_s_sleep(1);
    __builtin_amdgcn_fence(__ATOMIC_ACQUIRE, "agent");
  }
  __syncthreads();
}
#define GSYNC() grid_barrier(bar, epoch)
#define GSYNC_ONLY()

template <int N>
DEV void wait_vm() { asm volatile("s_waitcnt vmcnt(%0)" ::"n"(N) : "memory"); }

template <int MI, int NI>
DEV void gemm_mainloop(const u16* __restrict__ A, int lda, const u16* __restrict__ Bt, int ldb, int K,
                       f32x4 (&acc)[MI][NI], char* smem) {
  constexpr int BM = 32 * MI, BN = 64 * NI;
  constexpr int NA = BM * 4 / NTHREADS, NBL = BN * 4 / NTHREADS;
  constexpr int ABYTES = BM * 64, BBYTES = BN * 64, SBYTES = ABYTES + BBYTES;
  constexpr int NL = NA + NBL;
  const int tid = my_tid(), lane = tid & 63, wid = tid >> 6, wr = wid >> 2, wc = wid & 3, fr = lane & 15, fq = lane >> 4;
  const int nk = K / 32;
  auto stage = [&](int kt) {
    char* base = smem + (kt & 3) * SBYTES;
#pragma unroll
    for (int i = 0; i < NA; ++i) {
      int id = tid + i * NTHREADS, r = id >> 2, c = (id & 3) ^ (((r >> 3) & 1) * 3);
      __builtin_amdgcn_global_load_lds((const unsigned*)(A + (size_t)r * lda + kt * 32 + c * 8), (unsigned*)(base + id * 16), 16, 0, 0);
    }
#pragma unroll
    for (int i = 0; i < NBL; ++i) {
      int id = tid + i * NTHREADS, r = id >> 2, c = (id & 3) ^ (((r >> 3) & 1) * 3);
      __builtin_amdgcn_global_load_lds((const unsigned*)(Bt + (size_t)r * ldb + kt * 32 + c * 8), (unsigned*)(base + ABYTES + id * 16), 16, 0, 0);
    }
  };
  wait_vm<0>();
  __syncthreads();
  stage(0);
  if (nk > 1) stage(1);
  if (nk > 2) stage(2);
  for (int kt = 0; kt < nk; ++kt) {
    if (kt + 2 < nk) wait_vm<2 * NL>();
    else if (kt + 1 < nk) wait_vm<NL>();
    else wait_vm<0>();
    asm volatile("" ::: "memory");
    __builtin_amdgcn_s_barrier();
    asm volatile("" ::: "memory");
    const char* As = smem + (kt & 3) * SBYTES;
    const char* Bs = As + ABYTES;
    bf16x8 bfr[NI], af[MI];
#pragma unroll
    for (int ni = 0; ni < NI; ++ni) {
      int r = wc * (NI * 16) + ni * 16 + fr;
      bfr[ni] = ld16(Bs + r * 64 + ((fq ^ (((r >> 3) & 1) * 3)) << 4));
    }
#pragma unroll
    for (int mi = 0; mi < MI; ++mi) {
      int r = wr * (MI * 16) + mi * 16 + fr;
      af[mi] = ld16(As + r * 64 + ((fq ^ (((r >> 3) & 1) * 3)) << 4));
    }
    if (kt + 3 < nk) stage(kt + 3);
    __builtin_amdgcn_sched_barrier(0);
    __builtin_amdgcn_s_setprio(1);
#pragma unroll
    for (int mi = 0; mi < MI; ++mi)
#pragma unroll
      for (int ni = 0; ni < NI; ++ni) acc[mi][ni] = mfma16(af[mi], bfr[ni], acc[mi][ni]);
    __builtin_amdgcn_s_setprio(0);
    __builtin_amdgcn_sched_barrier(0);
  }
}


DEV void gemm_mainloop64(const u16* __restrict__ A, int lda, const u16* __restrict__ Bt, int ldb, int K, f32x4 (&acc)[4][4], char* smem) {
  constexpr int ABYTES = 128 * 128, BBYTES = 256 * 128, SBYTES = ABYTES + BBYTES;
  constexpr int NA = 2, NBL = 4, NL = NA + NBL;
  const int tid = my_tid(), lane = tid & 63, wid = tid >> 6, wr = wid >> 2, wc = wid & 3, fr = lane & 15, fq = lane >> 4;
  const int nk = K / 64;
  auto stage = [&](int kt) {
    char* base = smem + (kt % 3) * SBYTES;
#pragma unroll
    for (int i = 0; i < NA; ++i) {
      int id = tid + i * NTHREADS, r = id >> 3, c = (id & 7) ^ ((r >> 1) & 7);
      __builtin_amdgcn_global_load_lds((const unsigned*)(A + (size_t)r * lda + kt * 64 + c * 8), (unsigned*)(base + id * 16), 16, 0, 0);
    }
#pragma unroll
    for (int i = 0; i < NBL; ++i) {
      int id = tid + i * NTHREADS, r = id >> 3, c = (id & 7) ^ ((r >> 1) & 7);
      __builtin_amdgcn_global_load_lds((const unsigned*)(Bt + (size_t)r * ldb + kt * 64 + c * 8), (unsigned*)(base + ABYTES + id * 16), 16, 0, 0);
    }
  };
  wait_vm<0>();
  __syncthreads();
  stage(0);
  if (nk > 1) stage(1);
  for (int kt = 0; kt < nk; ++kt) {
    if (kt + 1 < nk) wait_vm<NL>();
    else wait_vm<0>();
    asm volatile("" ::: "memory");
    __builtin_amdgcn_s_barrier();
    asm volatile("" ::: "memory");
    if (kt + 2 < nk) stage(kt + 2);
    const char* As = smem + (kt % 3) * SBYTES;
    const char* Bs = As + ABYTES;
#pragma unroll
    for (int ks = 0; ks < 2; ++ks) {
      bf16x8 bfr[4], af[4];
#pragma unroll
      for (int ni = 0; ni < 4; ++ni) {
        int r = wc * 64 + ni * 16 + fr;
        bfr[ni] = ld16(Bs + r * 128 + (((ks * 4 + fq) ^ ((r >> 1) & 7)) << 4));
      }
#pragma unroll
      for (int mi = 0; mi < 4; ++mi) {
        int r = wr * 64 + mi * 16 + fr;
        af[mi] = ld16(As + r * 128 + (((ks * 4 + fq) ^ ((r >> 1) & 7)) << 4));
      }
#pragma unroll
      for (int mi = 0; mi < 4; ++mi)
#pragma unroll
        for (int ni = 0; ni < 4; ++ni) acc[mi][ni] = mfma16(af[mi], bfr[ni], acc[mi][ni]);
      __builtin_amdgcn_sched_barrier(0);
    }
  }
}

template <int MI, int NI>
DEV void zero_acc(f32x4 (&acc)[MI][NI]) {
#pragma unroll
  for (int mi = 0; mi < MI; ++mi)
#pragma unroll
    for (int ni = 0; ni < NI; ++ni) acc[mi][ni] = f32x4{0.f, 0.f, 0.f, 0.f};
}


DEV void tile_coords(int tile, int total, int nN, int& tm, int& tn) {
  int t = tile;
  if (gridDim.x == 256 && tile < (total & ~255)) {
    int j = tile & 255;
    t = (tile & ~255) + (j & 7) * 32 + (j >> 3);
  }
  int p = t / (4 * nN), q = t - p * (4 * nN);
  tn = q >> 2;
  tm = p * 4 + (q & 3);
}

template <int MI, class Epi>
DEV void gemm_phase(const u16* A, int lda, const u16* Bt, int ldb, int M, int N, int K, Epi epi, char* smem) {
  constexpr int BM = 32 * MI;
  const int nM = M / BM, nN = N / 256;
  const int wid = my_tid() >> 6, wr = wid >> 2, wc = wid & 3;
  for (int tile = blockIdx.x; tile < nM * nN; tile += gridDim.x) {
    int tm, tn;
    tile_coords(tile, nM * nN, nN, tm, tn);
    f32x4 acc[MI][4];
    zero_acc<MI, 4>(acc);
    gemm_mainloop<MI, 4>(A + (size_t)tm * BM * lda, lda, Bt + (size_t)tn * 256 * ldb, ldb, K, acc, smem);
    epi(acc, tm * BM + wr * (MI * 16), tn * 256 + wc * 64);
  }
}

DEV int map_col(int type, int n) {
  if (type == 0) {
    if (n < 2048) return n;
    if (n < 2688) return n + 16;
    if (n < 3712) return n + 144;
    if (n < 3840) return n - 1008;
    if (n < 4352) return n + 16;
    if (n < 4368) return n - 2304;
    return -1;
  }
  if (type == 1) return n + 4368;
  if (type == 2) return n;
  int q = n >> 5, r = n & 31;
  return r < 16 ? (q * 16 + r) : (FH + q * 16 + r - 16);
}

DEV void tr_tile(const float* __restrict__ src, int ldsrc, u16* __restrict__ dst, int K, int n0, int k0, int type, char* smem) {
  float* tile = reinterpret_cast<float*>(smem);
  const int tid = my_tid();
  {
    int n = tid & 63, sc = map_col(type, n0 + n);
#pragma unroll
    for (int i = 0; i < 8; ++i) {
      int k = (tid >> 6) + 8 * i;
      tile[k * 65 + n] = sc >= 0 ? src[(size_t)(k0 + k) * ldsrc + sc] : 0.f;
    }
  }
  __syncthreads();
  {
    int n = tid >> 3, kc = tid & 7;
    uint32_t w[4];
#pragma unroll
    for (int j = 0; j < 4; ++j) w[j] = pack2(tile[(kc * 8 + 2 * j) * 65 + n], tile[(kc * 8 + 2 * j + 1) * 65 + n]);
    *reinterpret_cast<uint4*>(dst + (size_t)(n0 + n) * K + k0 + kc * 8) = make_uint4(w[0], w[1], w[2], w[3]);
  }
  __syncthreads();
}

DEV void phase_prologue(const Params& P, char* smem) {
  const int tid = my_tid();
  constexpr int TPL = 4672;
  for (int it = blockIdx.x; it < 2 * TPL; it += gridDim.x) {
    int l = it / TPL, t = it % TPL;
    u16* Wl = WS_W(P) + (size_t)l * W_LAYER;
    if (t < 1152) {
      tr_tile(P.w_in + (size_t)l * 1024 * INW, INW, Wl + W_IN, 1024, (t / 16) * 64, (t % 16) * 64, 0, smem);
    } else if (t < 1920) {
      t -= 1152;
      tr_tile(P.w_in + (size_t)l * 1024 * INW, INW, Wl + W_G, 1024, (t / 16) * 64, (t % 16) * 64, 1, smem);
    } else if (t < 2304) {
      t -= 1920;
      int i = t / 128;
      t %= 128;
      tr_tile(P.w_branch + ((size_t)l * 3 + i) * 512 * 1024, 1024, Wl + W_B + (size_t)i * 1024 * 512, 512, (t / 8) * 64, (t % 8) * 64, 2, smem);
    } else if (t < 2560) {
      t -= 2304;
      tr_tile(P.w_out + (size_t)l * 1024 * 1024, 1024, Wl + W_O, 1024, (t / 16) * 64, (t % 16) * 64, 2, smem);
    } else if (t < 3968) {
      t -= 2560;
      tr_tile(P.w_ffn_in + (size_t)l * 1024 * 5632, 5632, Wl + W_FI, 1024, (t / 16) * 64, (t % 16) * 64, 3, smem);
    } else {
      t -= 3968;
      tr_tile(P.w_ffn_out + (size_t)l * FH * 1024, 1024, Wl + W_FO, FH, (t / 44) * 64, (t % 44) * 64, 2, smem);
    }
  }
  for (int it = blockIdx.x; it < 384; it += gridDim.x) {
    int l = it / 192, n0 = (it % 192) * 32;
    float* sc = reinterpret_cast<float*>(smem);
    float* red = sc + 17 * 1024;
    __syncthreads();
    for (int idx = tid; idx < 17 * 1024; idx += NTHREADS) {
      int cond = idx >> 10, k = idx & 1023;
      float cv = cond < 16 ? P.c[cond * 1024 + k] : P.c_ctx[k];
      sc[idx] = siluf_(cv);
    }
    __syncthreads();
    int col = tid & 31, ks = tid >> 5;
    float acc[17];
#pragma unroll
    for (int j = 0; j < 17; ++j) acc[j] = 0.f;
    const float* wm = P.w_mod + (size_t)l * 1024 * 6144 + n0 + col;
    for (int k = ks * 64; k < ks * 64 + 64; ++k) {
      float w = wm[(size_t)k * 6144];
#pragma unroll
      for (int j = 0; j < 17; ++j) acc[j] += sc[j * 1024 + k] * w;
    }
#pragma unroll
    for (int j = 0; j < 17; ++j) red[(ks * 17 + j) * 32 + col] = acc[j];
    __syncthreads();
    for (int o = tid; o < 17 * 32; o += NTHREADS) {
      int j = o >> 5, cc = o & 31;
      float s = 0.f;
      for (int q = 0; q < 16; ++q) s += red[(q * 17 + j) * 32 + cc];
      WS_MOD(P)[((size_t)l * 17 + j) * 6144 + n0 + cc] = s + P.b_mod[l * 6144 + n0 + cc];
    }
  }
  for (int idx = blockIdx.x * NTHREADS + tid; idx < T * 32; idx += gridDim.x * NTHREADS) {
    int t = idx >> 5, j = idx & 31;
    int pos = j < 16 ? (t >> 6) : (t & 63);
    float inv = powf(10000.f, -(float)(j & 15) / 16.f);
    float ang = (float)pos * inv;
    WS_ROPE(P)[idx * 2] = cosf(ang);
    WS_ROPE(P)[idx * 2 + 1] = sinf(ang);
  }
  for (int idx = blockIdx.x * NTHREADS + tid; idx < NCTXR * 1024 / 4; idx += gridDim.x * NTHREADS)
    reinterpret_cast<float4*>(WS_XC(P))[idx] = reinterpret_cast<const float4*>(P.ctx)[idx];
  if (blockIdx.x == 0 && tid < 64) {
    for (int l = 0; l < 2; ++l) {
      float a = wave_sum(P.lam_q1[l * 64 + tid] * P.lam_k1[l * 64 + tid]);
      float b = wave_sum(P.lam_q2[l * 64 + tid] * P.lam_k2[l * 64 + tid]);
      float lam_init = 0.8f - 0.6f * expf(-0.3f * (float)l);
      if (tid == 0) WS_LAM(P)[l] = expf(a) - expf(b) + lam_init;
    }
    if (tid < 8) WS_CTR(P)[tid] = 0u;
  }
}

DEV void phase_norm_mod(const Params& P, const float* xlat, const float* xctx, int nrows, const float* g,
                        const float* modl, int sh_off, int sc_off) {
  const int lane = my_tid() & 63, wid = my_tid() >> 6;
  for (int row = blockIdx.x * 8 + wid; row < nrows; row += gridDim.x * 8) {
    const float* src = row < NLAT ? xlat + (size_t)row * 1024 : xctx + (size_t)(row - NLAT) * 1024;
    int cond = row < NLAT ? row >> 12 : 16;
    const float* md = modl + (size_t)cond * 6144;
    float4 v[4];
    float ss = 0.f;
#pragma unroll
    for (int i = 0; i < 4; ++i) {
      { f32x4 t4 = __builtin_nontemporal_load(reinterpret_cast<const f32x4*>(src + i * 256 + lane * 4)); v[i] = make_float4(t4[0], t4[1], t4[2], t4[3]); }
      ss += v[i].x * v[i].x + v[i].y * v[i].y + v[i].z * v[i].z + v[i].w * v[i].w;
    }
    ss = wave_sum(ss);
    float rstd = rsqrtf(ss * (1.f / 1024.f) + EPS);
#pragma unroll
    for (int i = 0; i < 4; ++i) {
      int cb = i * 256 + lane * 4;
      float4 gg = *reinterpret_cast<const float4*>(g + cb);
      float4 sh = *reinterpret_cast<const float4*>(md + sh_off + cb);
      float4 sc = *reinterpret_cast<const float4*>(md + sc_off + cb);
      float y0 = v[i].x * rstd * gg.x * (1.f + sc.x) + sh.x;
      float y1 = v[i].y * rstd * gg.y * (1.f + sc.y) + sh.y;
      float y2 = v[i].z * rstd * gg.z * (1.f + sc.z) + sh.z;
      float y3 = v[i].w * rstd * gg.w * (1.f + sc.w) + sh.w;
      *reinterpret_cast<uint2*>(WS_H(P) + (size_t)row * 1024 + cb) = make_uint2(pack2(y0, y1), pack2(y2, y3));
    }
  }
}

DEV void phase_final_norm(const Params& P) {
  const int lane = my_tid() & 63, wid = my_tid() >> 6;
  for (int row = blockIdx.x * 8 + wid; row < NLAT; row += gridDim.x * 8) {
    float* src = P.out + (size_t)row * 1024;
    float4 v[4];
    float ss = 0.f;
#pragma unroll
    for (int i = 0; i < 4; ++i) {
      { f32x4 t4 = __builtin_nontemporal_load(reinterpret_cast<const f32x4*>(src + i * 256 + lane * 4)); v[i] = make_float4(t4[0], t4[1], t4[2], t4[3]); }
      ss += v[i].x * v[i].x + v[i].y * v[i].y + v[i].z * v[i].z + v[i].w * v[i].w;
    }
    ss = wave_sum(ss);
    float rstd = rsqrtf(ss * (1.f / 1024.f) + EPS);
#pragma unroll
    for (int i = 0; i < 4; ++i) {
      int cb = i * 256 + lane * 4;
      float4 gg = *reinterpret_cast<const float4*>(P.g_final + cb);
      float4 o = make_float4(v[i].x * rstd * gg.x, v[i].y * rstd * gg.y, v[i].z * rstd * gg.z, v[i].w * rstd * gg.w);
      { f32x4 t4 = {o.x, o.y, o.z, o.w}; __builtin_nontemporal_store(t4, reinterpret_cast<f32x4*>(src + cb)); }
    }
  }
}

struct EpiInProj {
  const Params& P;
  int l;
  DEV void operator()(f32x4 (&acc)[8][4], int row0, int col0) const {
    const int lane = my_tid() & 63, fr = lane & 15, fq = lane >> 4;
    if (col0 >= 4416) return;
    if (col0 < C_WQ) {
#pragma unroll
      for (int mi = 0; mi < 8; ++mi)
#pragma unroll
        for (int ni = 0; ni < 4; ++ni)
#pragma unroll
          for (int j = 0; j < 4; ++j)
            WS_P(P)[(size_t)(row0 + mi * 16 + fq * 4 + j) * PW + col0 + ni * 16 + fr] = f2bf(acc[mi][ni][j]);
    } else if (col0 < 3712) {
      const bool isq = (col0 < C_WK) || (col0 >= C_DQ && col0 < C_DK);
      const float qs = isq ? 0.125f : 1.f;
#pragma unroll
      for (int mi = 0; mi < 8; ++mi)
#pragma unroll
        for (int j = 0; j < 4; ++j) {
          int row = row0 + mi * 16 + fq * 4 + j;
          u16* dst = WS_P(P) + (size_t)row * PW + col0 + fr;
          if (row < NLAT) {
            int t = row & (T - 1);
            const float2* rt = reinterpret_cast<const float2*>(WS_ROPE(P)) + t * 32;
#pragma unroll
            for (int hf = 0; hf < 2; ++hf) {
              float2 cs = rt[hf * 16 + fr];
              float x1 = acc[mi][hf * 2][j], x2 = acc[mi][hf * 2 + 1][j];
              dst[hf * 32] = f2bf((x1 * cs.x - x2 * cs.y) * qs);
              dst[hf * 32 + 16] = f2bf((x2 * cs.x + x1 * cs.y) * qs);
            }
          } else {
#pragma unroll
            for (int ni = 0; ni < 4; ++ni) dst[ni * 16] = f2bf(acc[mi][ni][j] * qs);
          }
        }
    } else if (col0 < 4352) {
      u16* base;
      int vrow0;
      const int hdW = (col0 - 3712) >> 6;
      const int hdD = (col0 - 3840) >> 7;
      const bool isw = col0 < 3840;
#pragma unroll
      for (int mi = 0; mi < 8; ++mi) {
        int row = row0 + mi * 16 + fq * 4;
        int b, key;
        if (row < NLAT) { b = row >> 12; key = 256 + (row & (T - 1)); }
        else { b = (row - NLAT) >> 8; key = (row - NLAT) & 255; }
        if (isw) { base = WS_VTW(P) + ((size_t)(b * 2 + hdW) * 64) * KEYS; vrow0 = 0; }
        else { base = WS_VTD(P) + ((size_t)(b * 4 + hdD) * 128) * KEYS; vrow0 = (col0 - 3840) & 127; }
#pragma unroll
        for (int ni = 0; ni < 4; ++ni) {
          int v = vrow0 + ni * 16 + fr;
          *reinterpret_cast<uint2*>(base + (size_t)v * KEYS + key) =
              make_uint2(pack2(acc[mi][ni][0], acc[mi][ni][1]), pack2(acc[mi][ni][2], acc[mi][ni][3]));
        }
      }
    } else {
      float bg = P.b_gate[l * 16 + fr];
#pragma unroll
      for (int mi = 0; mi < 8; ++mi)
#pragma unroll
        for (int j = 0; j < 4; ++j) WS_GATES(P)[(size_t)(row0 + mi * 16 + fq * 4 + j) * 16 + fr] = acc[mi][0][j] + bg;
    }
  }
};

template <int QB, int VB, int KW>
struct AttnCore {
  static constexpr int DV = 32 * VB;
  static constexpr int KST = KW * 2 + 16;
  static constexpr int VST = 128 + 16;
  static constexpr int KBYTES = 64 * KST, VBYTES = DV * VST;
  static constexpr int NKL = 64 * (KW / 8) / NTHREADS, NVL = DV * 8 / NTHREADS;
  static constexpr int TOTAL = 2 * (KBYTES + VBYTES);

  static DEV void run(const u16* qptr, int ldq, const u16* kctx, const u16* klat, int ldk, int kcol, const u16* vt,
                      int nctx, int nlat, int lat_t0, bool window, int qtok0, float m_init, float l_init,
                      f32x16 (&O)[QB][VB], char* smem) {
    const int tid = my_tid(), lane = tid & 63, r = lane & 31, hh = lane >> 5;
    char* Ks = smem;
    char* Vs = smem + 2 * KBYTES;
    bf16x8 qf[QB][4];
#pragma unroll
    for (int qb = 0; qb < QB; ++qb)
#pragma unroll
      for (int ks = 0; ks < 4; ++ks) qf[qb][ks] = ld16(qptr + (size_t)(qb * 32 + r) * ldq + ks * 16 + hh * 8);
    float m[QB], lsum[QB];
#pragma unroll
    for (int qb = 0; qb < QB; ++qb) {
      m[qb] = m_init;
      lsum[qb] = hh == 0 ? l_init : 0.f;
#pragma unroll
      for (int vb = 0; vb < VB; ++vb)
#pragma unroll
        for (int i = 0; i < 16; ++i) O[qb][vb][i] = 0.f;
    }
    bf16x8 rk[NKL], rv[NVL];
    const int ntiles = nctx + nlat;
    auto gload = [&](int j) {
      int kidx = j < nctx ? j * 64 : 256 + lat_t0 + (j - nctx) * 64;
      const u16* krow = j < nctx ? kctx + (size_t)(j * 64) * ldk : klat + (size_t)(lat_t0 + (j - nctx) * 64) * ldk;
#pragma unroll
      for (int i = 0; i < NKL; ++i) {
        int id = tid + i * NTHREADS, row = id / (KW / 8), c = id % (KW / 8);
        rk[i] = ld16(krow + (size_t)row * ldk + c * 8);
      }
#pragma unroll
      for (int i = 0; i < NVL; ++i) {
        int id = tid + i * NTHREADS, row = id >> 3, c = id & 7;
        rv[i] = ld16(vt + (size_t)row * KEYS + kidx + c * 8);
      }
    };
    auto lstore = [&](int buf) {
#pragma unroll
      for (int i = 0; i < NKL; ++i) {
        int id = tid + i * NTHREADS, row = id / (KW / 8), c = id % (KW / 8);
        *reinterpret_cast<bf16x8*>(Ks + buf * KBYTES + row * KST + c * 16) = rk[i];
      }
#pragma unroll
      for (int i = 0; i < NVL; ++i) {
        int id = tid + i * NTHREADS, row = id >> 3, c = id & 7;
        *reinterpret_cast<bf16x8*>(Vs + buf * VBYTES + row * VST + c * 16) = rv[i];
      }
    };
    __syncthreads();
    gload(0);
    lstore(0);
    __syncthreads();
    for (int j = 0; j < ntiles; ++j) {
      const int buf = j & 1;
      if (j + 1 < ntiles) gload(j + 1);
      bf16x8 pf[QB][2][2];
#pragma unroll
      for (int qb = 0; qb < QB; ++qb) {
        f32x16 S[2];
#pragma unroll
        for (int kb = 0; kb < 2; ++kb) {
#pragma unroll
          for (int i = 0; i < 16; ++i) S[kb][i] = 0.f;
#pragma unroll
          for (int ks = 0; ks < 4; ++ks) {
            bf16x8 kf = ld16(Ks + buf * KBYTES + (kb * 32 + pi32(r)) * KST + (kcol + ks * 16 + hh * 8) * 2);
            S[kb] = mfma32(kf, qf[qb][ks], S[kb]);
          }
        }
        __builtin_amdgcn_sched_barrier(0);
        if (window && j >= nctx) {
          int kt0 = lat_t0 + (j - nctx) * 64;
          int qt = qtok0 + qb * 32 + r;
#pragma unroll
          for (int kb = 0; kb < 2; ++kb)
#pragma unroll
            for (int i = 0; i < 16; ++i) {
              int kt = kt0 + kb * 32 + 16 * (i >> 3) + 8 * hh + (i & 7);
              int dlt = qt - kt;
              if (dlt > 128 || dlt < -128) S[kb][i] = -1e30f;
            }
        }
        float mloc = -1e30f;
#pragma unroll
        for (int kb = 0; kb < 2; ++kb)
#pragma unroll
          for (int i = 0; i < 16; ++i) mloc = fmaxf(mloc, S[kb][i]);
        mloc = fmaxf(mloc, __shfl_xor(mloc, 32));
        if (__any(mloc > m[qb] + 5.5f)) {
          float mnew = fmaxf(m[qb], mloc);
          float alpha = fexp2((m[qb] - mnew) * L2E);
          m[qb] = mnew;
          lsum[qb] *= alpha;
#pragma unroll
          for (int vb = 0; vb < VB; ++vb)
#pragma unroll
            for (int i = 0; i < 16; ++i) O[qb][vb][i] *= alpha;
        }
        float mb = m[qb] * L2E, ps = 0.f;
#pragma unroll
        for (int kb = 0; kb < 2; ++kb) {
          float pv[16];
#pragma unroll
          for (int i = 0; i < 16; ++i) {
            pv[i] = fexp2(S[kb][i] * L2E - mb);
            ps += pv[i];
          }
#pragma unroll
          for (int s = 0; s < 2; ++s)
            pf[qb][kb][s] = mk8(pack2(pv[8 * s], pv[8 * s + 1]), pack2(pv[8 * s + 2], pv[8 * s + 3]),
                                pack2(pv[8 * s + 4], pv[8 * s + 5]), pack2(pv[8 * s + 6], pv[8 * s + 7]));
        }
        lsum[qb] += ps;
        __builtin_amdgcn_sched_barrier(0);
      }
      __builtin_amdgcn_sched_barrier(0);
#pragma unroll
      for (int vb = 0; vb < VB; ++vb) {
#pragma unroll
        for (int kb = 0; kb < 2; ++kb)
#pragma unroll
          for (int s = 0; s < 2; ++s) {
            bf16x8 vf = ld16(Vs + buf * VBYTES + (vb * 32 + r) * VST + (kb * 32 + s * 16 + hh * 8) * 2);
#pragma unroll
            for (int qb = 0; qb < QB; ++qb) O[qb][vb] = mfma32(vf, pf[qb][kb][s], O[qb][vb]);
          }
        __builtin_amdgcn_sched_barrier(0);
      }
      if (j + 1 < ntiles) lstore(buf ^ 1);
      __syncthreads();
    }
#pragma unroll
    for (int qb = 0; qb < QB; ++qb) {
      float lt = lsum[qb] + __shfl_xor(lsum[qb], 32);
      float inv = 1.f / lt;
#pragma unroll
      for (int vb = 0; vb < VB; ++vb)
#pragma unroll
        for (int i = 0; i < 16; ++i) O[qb][vb][i] *= inv;
    }
  }
};

DEV void diff_item(const Params& P, int l, int b, int h, int qt, bool ctxq, char* smem) {
  const int tid = my_tid(), lane = tid & 63, wid = tid >> 6, r = lane & 31, hh = lane >> 5;
  const int comp = wid >> 2, wq = wid & 3;
  const int rowbase = ctxq ? NLAT + b * 256 + qt * 128 : b * T + qt * 128;
  const u16* qptr = WS_P(P) + (size_t)(rowbase + wq * 32) * PW + C_DQ + h * 128 + comp * 64;
  const u16* kctx = WS_P(P) + (size_t)(NLAT + b * 256) * PW + C_DK + h * 128;
  const u16* klat = WS_P(P) + (size_t)(b * T) * PW + C_DK + h * 128;
  const u16* vt = WS_VTD(P) + ((size_t)(b * 4 + h) * 128) * KEYS;
  f32x16 O[1][4];
  AttnCore<1, 4, 128>::run(qptr, PW, kctx, klat, PW, comp * 64, vt, 4, ctxq ? 0 : 64, 0, false, 0, -1e30f, 0.f, O, smem);
  float* ex = reinterpret_cast<float*>(smem);
  __syncthreads();
  if (comp == 1) {
#pragma unroll
    for (int vb = 0; vb < 4; ++vb)
#pragma unroll
      for (int i = 0; i < 16; ++i) ex[(wq * 64 + vb * 16 + i) * 64 + lane] = O[0][vb][i];
  }
  __syncthreads();
  if (comp == 0) {
    const float lam = WS_LAM(P)[l];
    const float lam_init = 0.8f - 0.6f * expf(-0.3f * (float)l);
    float ss = 0.f;
#pragma unroll
    for (int vb = 0; vb < 4; ++vb)
#pragma unroll
      for (int i = 0; i < 16; ++i) {
        float y = O[0][vb][i] - lam * ex[(wq * 64 + vb * 16 + i) * 64 + lane];
        O[0][vb][i] = y;
        ss += y * y;
      }
    ss += __shfl_xor(ss, 32);
    float sc = rsqrtf(ss * (1.f / 128.f) + EPS) * (1.f - lam_init);
    const float* dn = P.d_norm + l * 512 + h * 128;
    u16* dst = WS_P(P) + (size_t)(rowbase + wq * 32 + r) * PW + C_DQ + h * 128;
#pragma unroll
    for (int vb = 0; vb < 4; ++vb)
#pragma unroll
      for (int g4 = 0; g4 < 4; ++g4) {
        int v = vb * 32 + g4 * 8 + hh * 4;
        float4 w = *reinterpret_cast<const float4*>(dn + v);
        *reinterpret_cast<uint2*>(dst + v) =
            make_uint2(pack2(O[0][vb][g4 * 4] * sc * w.x, O[0][vb][g4 * 4 + 1] * sc * w.y),
                       pack2(O[0][vb][g4 * 4 + 2] * sc * w.z, O[0][vb][g4 * 4 + 3] * sc * w.w));
      }
  }
  __syncthreads();
}

DEV void win_item(const Params& P, int l, int b, int g, int qb, bool ctxq, char* smem) {
  const int tid = my_tid(), lane = tid & 63, wid = tid >> 6, r = lane & 31, hh = lane >> 5;
  const int hr = wid >> 1, qh = wid & 1;
  const int head = g * 4 + hr;
  const int rowbase = (ctxq ? NLAT + b * 256 + qb * 64 : b * T + qb * 64) + qh * 32;
  const u16* qptr = WS_P(P) + (size_t)rowbase * PW + C_WQ + head * 64;
  const u16* kctx = WS_P(P) + (size_t)(NLAT + b * 256) * PW + C_WK + g * 64;
  const u16* klat = WS_P(P) + (size_t)(b * T) * PW + C_WK + g * 64;
  const u16* vt = WS_VTW(P) + ((size_t)(b * 2 + g) * 64) * KEYS;
  int t0 = 0, nlat = 0;
  if (!ctxq) {
    t0 = qb * 64 - 128;
    if (t0 < 0) t0 = 0;
    int t1 = qb * 64 + 192;
    if (t1 > T) t1 = T;
    nlat = (t1 - t0) >> 6;
  }
  f32x16 O[1][2];
  AttnCore<1, 2, 64>::run(qptr, PW, kctx, klat, PW, 0, vt, 4, nlat, t0, !ctxq, qb * 64 + qh * 32, P.sink[l * 8 + head], 1.f, O, smem);
  u16* dst = WS_P(P) + (size_t)(rowbase + r) * PW + C_WQ + head * 64;
#pragma unroll
  for (int vb = 0; vb < 2; ++vb)
#pragma unroll
    for (int g4 = 0; g4 < 4; ++g4) {
      int v = vb * 32 + g4 * 8 + hh * 4;
      *reinterpret_cast<uint2*>(dst + v) = make_uint2(pack2(O[0][vb][g4 * 4], O[0][vb][g4 * 4 + 1]),
                                                        pack2(O[0][vb][g4 * 4 + 2], O[0][vb][g4 * 4 + 3]));
    }
}

DEV void mlstm_item(const Params& P, int l, int b, int hd, int dir, bool need_ctx, char* smem) {
  const int tid = my_tid(), lane = tid & 63, wid = tid >> 6, r = lane & 31, hh = lane >> 5;
  constexpr int QST = 272, TST = 144;
  char* Qs = smem;
  char* Ks = Qs + 64 * QST;
  char* KwT = Ks + 64 * QST;
  char* VT = KwT + 128 * TST;
  char* Sp = VT + 128 * TST;
  char* Rq = Sp + 64 * TST;
  char* Rk = Rq + 66 * QST;
  float* fb = reinterpret_cast<float*>(Rk + 66 * QST);
  float* sb = fb;
  float* sa = fb + 64;
  float* sM = fb + 128;
  float* denp = fb + 192;
  float* qn = fb + 320;
  float* nb = fb + 384;
  float* cw = fb + 640;
  __syncthreads();
  if (tid < 256) nb[tid] = 0.f;
  for (int i = tid; i < 768; i += NTHREADS) {
    int qk = i / 384, tap = (i % 384) / 128, d = i & 127;
    cw[i] = P.conv_w[(size_t)l * 3 * 1024 + tap * 1024 + qk * 512 + hd * 128 + d];
  }
  f32x16 CT[4];
#pragma unroll
  for (int kb = 0; kb < 4; ++kb)
#pragma unroll
    for (int i = 0; i < 16; ++i) CT[kb][i] = 0.f;
  float mstate = 0.f;
  u16* hout = WS_HFB(P) + (size_t)dir * MTOT * 512;
  const float kscale = 0.08838834764831845f;

  auto geom = [&](int step, int& seg0, int& seglen, int& u0) {
    int c;
    if (step < 4) { seg0 = NLAT + b * 256; seglen = 256; c = dir ? 3 - step : step; }
    else { seg0 = b * T; seglen = T; c = dir ? 67 - step : step - 4; }
    u0 = c * 64;
  };
  bf16x8 pq[3], pk[3], pvv[2];
  float pig = 0.f, pfg = 0.f;
  auto issue_loads = [&](int step) {
    int seg0, seglen, u0;
    geom(step, seg0, seglen, u0);
#pragma unroll
    for (int i = 0; i < 3; ++i) {
      int id = tid + i * NTHREADS;
      bf16x8 z = {0, 0, 0, 0, 0, 0, 0, 0};
      pq[i] = z;
      pk[i] = z;
      if (id < 66 * 16) {
        int row = id >> 4, cc = id & 15;
        int uu = u0 + row - 1;
        bool ok = uu >= 0 && uu < seglen;
        const u16* src = WS_P(P) + (size_t)(seg0 + (ok ? uu : 0)) * PW + hd * 128 + cc * 8;
        if (ok) { pq[i] = ld16(src + C_MQ); pk[i] = ld16(src + C_MK); }
      }
    }
#pragma unroll
    for (int i = 0; i < 2; ++i) {
      int id = tid + i * NTHREADS, u = id >> 4, cc = id & 15;
      pvv[i] = ld16(WS_P(P) + (size_t)(seg0 + u0 + u) * PW + C_MV + hd * 128 + cc * 8);
    }
    if (wid == 0) {
      const int pos = dir ? 63 - lane : lane;
      const float* gp = WS_GATES(P) + (size_t)(seg0 + u0 + pos) * 16;
      pig = gp[(dir * 2) * 4 + hd];
      pfg = gp[(dir * 2 + 1) * 4 + hd];
    }
  };
  issue_loads(0);

  for (int step = 0; step < 68; ++step) {
    int seg0, seglen, u0;
    geom(step, seg0, seglen, u0);
    const int rowbase = seg0 + u0;
    const int cur = step & 1;
    __syncthreads();
    bf16x8 rvv[2];
#pragma unroll
    for (int i = 0; i < 3; ++i) {
      int id = tid + i * NTHREADS;
      if (id < 66 * 16) {
        int row = id >> 4, cc = id & 15;
        *reinterpret_cast<bf16x8*>(Rq + row * QST + cc * 16) = pq[i];
        *reinterpret_cast<bf16x8*>(Rk + row * QST + cc * 16) = pk[i];
      }
    }
    rvv[0] = pvv[0];
    rvv[1] = pvv[1];
    const float ig = pig, fg = pfg;
    if (step + 1 < 68) issue_loads(step + 1);
    if (wid == 0) {
      const int pos = dir ? 63 - lane : lane;
      float lf = fminf(fg, 0.f) - log1pf(__expf(-fabsf(fg)));
      float bsum = lf;
#pragma unroll
      for (int o = 1; o < 64; o <<= 1) { float t2 = __shfl_up(bsum, o); if (lane >= o) bsum += t2; }
      float a = ig - bsum, am = a;
#pragma unroll
      for (int o = 1; o < 64; o <<= 1) { float t2 = __shfl_up(am, o); if (lane >= o) am = fmaxf(am, t2); }
      sb[pos] = bsum;
      sa[pos] = a;
      sM[pos] = fmaxf(mstate, am);
    }
    __syncthreads();
    const int eidx = dir ? 0 : 63;
    const float Mend = sM[eidx], bend = sb[eidx];
    const float decay = __expf(mstate - Mend);
#pragma unroll
    for (int i = 0; i < 2; ++i) {
      int id = tid + i * NTHREADS, u = id >> 4, cc = id & 15;
      float wend = __expf(sa[u] - Mend);
      const int tbase = cc * 8 * TST + (((u >> 3) ^ (cc & 7)) << 4) + (u & 7) * 2;
      uint32_t qo[4], ko[4];
      float kv[8], xq[8], xk[8];
#pragma unroll
      for (int e = 0; e < 8; ++e) { xq[e] = 0.f; xk[e] = 0.f; }
#pragma unroll
      for (int tap = 0; tap < 3; ++tap) {
        const bf16x8 qr = ld16(Rq + (u + tap) * QST + cc * 16), kr = ld16(Rk + (u + tap) * QST + cc * 16);
        const float4 wq0 = *reinterpret_cast<const float4*>(cw + tap * 128 + cc * 8), wq1 = *reinterpret_cast<const float4*>(cw + tap * 128 + cc * 8 + 4);
        const float4 wk0 = *reinterpret_cast<const float4*>(cw + 384 + tap * 128 + cc * 8), wk1 = *reinterpret_cast<const float4*>(cw + 384 + tap * 128 + cc * 8 + 4);
        const float wq[8] = {wq0.x, wq0.y, wq0.z, wq0.w, wq1.x, wq1.y, wq1.z, wq1.w};
        const float wk[8] = {wk0.x, wk0.y, wk0.z, wk0.w, wk1.x, wk1.y, wk1.z, wk1.w};
#pragma unroll
        for (int e = 0; e < 8; ++e) {
          xq[e] += wq[e] * bf2f((u16)qr[e]);
          xk[e] += wk[e] * bf2f((u16)kr[e]);
        }
      }
#pragma unroll
      for (int e = 0; e < 8; ++e) {
        float qv = xq[e] * __builtin_amdgcn_rcpf(1.f + __expf(-xq[e]));
        kv[e] = xk[e] * __builtin_amdgcn_rcpf(1.f + __expf(-xk[e])) * kscale;
        if (e & 1) { qo[e >> 1] |= ((uint32_t)f2bf(qv)) << 16; ko[e >> 1] |= ((uint32_t)f2bf(kv[e])) << 16; }
        else { qo[e >> 1] = f2bf(qv); ko[e >> 1] = f2bf(kv[e]); }
        *reinterpret_cast<u16*>(KwT + tbase + e * TST) = f2bf(kv[e] * wend);
        *reinterpret_cast<u16*>(VT + tbase + e * TST) = (u16)rvv[i][e];
      }
      *reinterpret_cast<uint4*>(Qs + u * QST + cc * 16) = make_uint4(qo[0], qo[1], qo[2], qo[3]);
      *reinterpret_cast<uint4*>(Ks + u * QST + cc * 16) = make_uint4(ko[0], ko[1], ko[2], ko[3]);
    }
    __syncthreads();
    if (wid < 4) {
      const int sblk = wid & 1, tblk = wid >> 1;
      f32x16 S;
#pragma unroll
      for (int i = 0; i < 16; ++i) S[i] = 0.f;
#pragma unroll
      for (int ks = 0; ks < 8; ++ks) {
        bf16x8 kf = ld16(Ks + (sblk * 32 + pi32(r)) * QST + (ks * 16 + hh * 8) * 2);
        bf16x8 qf = ld16(Qs + (tblk * 32 + r) * QST + (ks * 16 + hh * 8) * 2);
        S = mfma32(kf, qf, S);
      }
      const int t = tblk * 32 + r;
      const float Mt = sM[t];
      float ds = 0.f, val[16];
#pragma unroll
      for (int i = 0; i < 16; ++i) {
        int s = sblk * 32 + 16 * (i >> 3) + 8 * hh + (i & 7);
        bool ok = dir ? (s >= t) : (s <= t);
        val[i] = ok ? S[i] * __expf(sa[s] - Mt) : 0.f;
        ds += val[i];
      }
      ds += __shfl_xor(ds, 32);
      if (hh == 0) denp[sblk * 64 + t] = ds;
#pragma unroll
      for (int s2 = 0; s2 < 2; ++s2)
        *reinterpret_cast<uint4*>(Sp + t * TST + (sblk * 32 + s2 * 16 + hh * 8) * 2) =
            make_uint4(pack2(val[8 * s2], val[8 * s2 + 1]), pack2(val[8 * s2 + 2], val[8 * s2 + 3]),
                       pack2(val[8 * s2 + 4], val[8 * s2 + 5]), pack2(val[8 * s2 + 6], val[8 * s2 + 7]));
    } else if (wid == 4) {
      float s = 0.f;
      const float* nc = nb + cur * 128;
      for (int k8 = 0; k8 < 16; ++k8) {
        bf16x8 qv = ld16(Qs + lane * QST + k8 * 16);
#pragma unroll
        for (int e = 0; e < 8; ++e) s += nc[k8 * 8 + e] * bf2f((u16)qv[e]);
      }
      qn[lane] = s;
    } else if (wid == 5) {
      const float* nc = nb + cur * 128;
      float* nn = nb + (cur ^ 1) * 128;
#pragma unroll
      for (int q2 = 0; q2 < 2; ++q2) {
        int k = lane + q2 * 64;
        float s = 0.f;
        for (int s8 = 0; s8 < 8; ++s8) {
          bf16x8 kv = ld16(KwT + k * TST + s8 * 16);
#pragma unroll
          for (int e = 0; e < 8; ++e) s += bf2f((u16)kv[e]);
        }
        nn[k] = decay * nc[k] + s;
      }
    }
    __syncthreads();
    {
      bf16x8 vf[4];
      const int vb = wid & 3, tb = wid >> 2;
#pragma unroll
      for (int ks = 0; ks < 4; ++ks) vf[ks] = ld16(VT + (vb * 32 + r) * TST + (((ks * 2 + hh) ^ ((r >> 3) | ((vb & 1) << 2))) << 4));
      const bool wr_h = (step >= 4) || need_ctx;
      {
        const int t = tb * 32 + r;
        f32x16 acc;
#pragma unroll
        for (int i = 0; i < 16; ++i) acc[i] = 0.f;
#pragma unroll
        for (int kb = 0; kb < 4; ++kb)
#pragma unroll
          for (int s2 = 0; s2 < 2; ++s2) {
            bf16x8 af = mk8(pack2(CT[kb][8 * s2], CT[kb][8 * s2 + 1]), pack2(CT[kb][8 * s2 + 2], CT[kb][8 * s2 + 3]),
                            pack2(CT[kb][8 * s2 + 4], CT[kb][8 * s2 + 5]), pack2(CT[kb][8 * s2 + 6], CT[kb][8 * s2 + 7]));
            uint2 lo = *reinterpret_cast<const uint2*>(Qs + t * QST + (kb * 32 + s2 * 16 + hh * 4) * 2);
            uint2 hi = *reinterpret_cast<const uint2*>(Qs + t * QST + (kb * 32 + s2 * 16 + 8 + hh * 4) * 2);
            acc = mfma32(af, mk8(lo.x, lo.y, hi.x, hi.y), acc);
          }
        const float Mt = sM[t];
        const float winter = __expf(mstate - Mt);
#pragma unroll
        for (int i = 0; i < 16; ++i) acc[i] *= winter;
#pragma unroll
        for (int ks = 0; ks < 4; ++ks) {
          bf16x8 sf = ld16(Sp + t * TST + (ks * 16 + hh * 8) * 2);
          acc = mfma32(vf[ks], sf, acc);
        }
        float den = denp[t] + denp[64 + t] + winter * qn[t];
        float sc = 1.f / fmaxf(fabsf(den), __expf(-(sb[t] + Mt)));
        if (wr_h) {
          u16* dst = hout + (size_t)(rowbase + t) * 512 + hd * 128 + vb * 32;
#pragma unroll
          for (int g4 = 0; g4 < 4; ++g4)
            *reinterpret_cast<uint2*>(dst + g4 * 8 + hh * 4) =
                make_uint2(pack2(acc[g4 * 4] * sc, acc[g4 * 4 + 1] * sc), pack2(acc[g4 * 4 + 2] * sc, acc[g4 * 4 + 3] * sc));
        }
      }
#pragma unroll
      for (int kb = 0; kb < 4; ++kb) {
#pragma unroll
        for (int i = 0; i < 16; ++i) CT[kb][i] *= decay;
#pragma unroll
        for (int ks = 0; ks < 4; ++ks) {
          bf16x8 kf = ld16(KwT + (kb * 32 + r) * TST + (((ks * 2 + hh) ^ ((r >> 3) | ((kb & 1) << 2))) << 4));
          CT[kb] = mfma32(kf, vf[ks], CT[kb]);
        }
      }
    }
    mstate = bend + Mend;
  }
  __syncthreads();
}

DEV int next_item(unsigned* ctr, int* s_item) {
  __syncthreads();
  if (my_tid() == 0) *s_item = (int)atomicAdd(ctr, 1u);
  __syncthreads();
  return *s_item;
}
DEV void phase_mixers(const Params& P, int l, char* smem) {
  const bool need_ctx = (l == 0);
  __shared__ int s_item;
  const int n_ml = 128, n_diff = 2048, n_win = 2048, n_dc = need_ctx ? 128 : 0, n_wc = need_ctx ? 128 : 0;
  for (;;) {
    int it = next_item(&WS_CTR(P)[l * 4 + 0], &s_item);
    if (it >= n_ml) break;
    mlstm_item(P, l, it >> 3, (it >> 1) & 3, it & 1, need_ctx, smem);
  }
  for (;;) {
    int it = next_item(&WS_CTR(P)[l * 4 + 1], &s_item);
    if (it >= n_diff + n_dc) break;
    bool cq = it >= n_diff;
    int i2 = it - n_diff;
    int b = cq ? i2 >> 3 : it >> 7, hd = cq ? (i2 >> 1) & 3 : (it >> 5) & 3, qt = cq ? i2 & 1 : it & 31;
    diff_item(P, l, b, hd, qt, cq, smem);
  }
  for (;;) {
    int it = next_item(&WS_CTR(P)[l * 4 + 2], &s_item);
    if (it >= n_win + n_wc) break;
    bool cq = it >= n_win;
    int i2 = it - n_win;
    int b = cq ? i2 >> 3 : it >> 7, g = cq ? (i2 >> 2) & 1 : (it >> 6) & 1, qb = cq ? i2 & 3 : it & 63;
    win_item(P, l, b, g, qb, cq, smem);
  }
}

DEV void phase_ya(const Params& P, int l, int nrows) {
  const int lane = my_tid() & 63, wid = my_tid() >> 6;
  const u16* hf = WS_HFB(P);
  const u16* hb = WS_HFB(P) + (size_t)MTOT * 512;
  for (int row = blockIdx.x * 8 + wid; row < nrows; row += gridDim.x * 8) {
    uint4 a = *reinterpret_cast<const uint4*>(hf + (size_t)row * 512 + lane * 8);
    uint4 bq = *reinterpret_cast<const uint4*>(hb + (size_t)row * 512 + lane * 8);
    uint4 o = *reinterpret_cast<const uint4*>(WS_P(P) + (size_t)row * PW + C_MO + lane * 8);
    uint32_t aa[4] = {a.x, a.y, a.z, a.w}, bb[4] = {bq.x, bq.y, bq.z, bq.w}, oo[4] = {o.x, o.y, o.z, o.w};
    float y[8], ss = 0.f;
#pragma unroll
    for (int j = 0; j < 4; ++j) {
      y[2 * j] = (bflo(aa[j]) + bflo(bb[j])) * sigmoidf_(bflo(oo[j]));
      y[2 * j + 1] = (bfhi(aa[j]) + bfhi(bb[j])) * sigmoidf_(bfhi(oo[j]));
      ss += y[2 * j] * y[2 * j] + y[2 * j + 1] * y[2 * j + 1];
    }
#pragma unroll
    for (int of = 1; of < 16; of <<= 1) ss += __shfl_xor(ss, of);
    float rstd = rsqrtf(ss * (1.f / 128.f) + EPS);
    const float* mn = P.m_norm + l * 512 + lane * 8;
    uint32_t w[4];
#pragma unroll
    for (int j = 0; j < 4; ++j) w[j] = pack2(y[2 * j] * rstd * mn[2 * j], y[2 * j + 1] * rstd * mn[2 * j + 1]);
    *reinterpret_cast<uint4*>(WS_P(P) + (size_t)row * PW + C_MO + lane * 8) = make_uint4(w[0], w[1], w[2], w[3]);
  }
}

DEV void phase_merge(const Params& P, int l, int M, char* smem) {
  const u16* Wl = WS_W(P) + (size_t)l * W_LAYER;
  u16* merged = WS_HFB(P);
  const int nM = M / 128, nN = 4;
  const int lane = my_tid() & 63, wid = my_tid() >> 6, wr = wid >> 2, wc = wid & 3, fr = lane & 15, fq = lane >> 4;
  for (int tile = blockIdx.x; tile < nM * nN; tile += gridDim.x) {
    int tm, tn;
    tile_coords(tile, nM * nN, nN, tm, tn);
    f32x4 mg[4][4];
    zero_acc<4, 4>(mg);
#pragma unroll 1
    for (int i = 0; i < 3; ++i) {
      f32x4 acc[4][4];
      zero_acc<4, 4>(acc);
      gemm_mainloop64(WS_H(P) + (size_t)tm * 128 * 1024, 1024, Wl + W_G + (size_t)(i * 1024 + tn * 256) * 1024, 1024, 1024, acc, smem);
      uint32_t gp[4][4][2];
#pragma unroll
      for (int mi = 0; mi < 4; ++mi)
#pragma unroll
        for (int ni = 0; ni < 4; ++ni) {
          gp[mi][ni][0] = pack2(sigmoidf_(acc[mi][ni][0]), sigmoidf_(acc[mi][ni][1]));
          gp[mi][ni][1] = pack2(sigmoidf_(acc[mi][ni][2]), sigmoidf_(acc[mi][ni][3]));
        }
      zero_acc<4, 4>(acc);
      int yc = i == 0 ? C_MO : (i == 1 ? C_WQ : C_DQ);
      gemm_mainloop64(WS_P(P) + (size_t)tm * 128 * PW + yc, PW, Wl + W_B + (size_t)i * 1024 * 512 + (size_t)(tn * 256) * 512, 512, 512, acc, smem);
#pragma unroll
      for (int mi = 0; mi < 4; ++mi)
#pragma unroll
        for (int ni = 0; ni < 4; ++ni) {
          mg[mi][ni][0] += bflo(gp[mi][ni][0]) * acc[mi][ni][0];
          mg[mi][ni][1] += bfhi(gp[mi][ni][0]) * acc[mi][ni][1];
          mg[mi][ni][2] += bflo(gp[mi][ni][1]) * acc[mi][ni][2];
          mg[mi][ni][3] += bfhi(gp[mi][ni][1]) * acc[mi][ni][3];
        }
    }
    const int row0 = tm * 128 + wr * 64, col0 = tn * 256 + wc * 64;
#pragma unroll
    for (int mi = 0; mi < 4; ++mi)
#pragma unroll
      for (int ni = 0; ni < 4; ++ni)
#pragma unroll
        for (int j = 0; j < 4; ++j)
          merged[(size_t)(row0 + mi * 16 + fq * 4 + j) * 1024 + col0 + ni * 16 + fr] = f2bf(mg[mi][ni][j]);
  }
}

struct EpiResid {
  const Params& P;
  const float* src_lat;
  const float* modl;
  int gt_off;
  DEV void operator()(f32x4 (&acc)[8][4], int row0, int col0) const {
    const int lane = my_tid() & 63, fr = lane & 15, fq = lane >> 4;
#pragma unroll
    for (int mi = 0; mi < 8; ++mi)
#pragma unroll
      for (int j = 0; j < 4; ++j) {
        int row = row0 + mi * 16 + fq * 4 + j;
        const float* src;
        float* dst;
        int cond;
        if (row < NLAT) { src = src_lat + (size_t)row * 1024; dst = P.out + (size_t)row * 1024; cond = row >> 12; }
        else { src = WS_XC(P) + (size_t)(row - NLAT) * 1024; dst = WS_XC(P) + (size_t)(row - NLAT) * 1024; cond = 16; }
        const float* gt = modl + (size_t)cond * 6144 + gt_off;
#pragma unroll
        for (int ni = 0; ni < 4; ++ni) {
          int col = col0 + ni * 16 + fr;
          dst[col] = src[col] + gt[col] * acc[mi][ni][j];
        }
      }
  }
};

struct EpiSwiglu {
  u16* act;
  DEV void operator()(f32x4 (&acc)[8][4], int row0, int col0) const {
    const int lane = my_tid() & 63, fr = lane & 15, fq = lane >> 4;
#pragma unroll
    for (int mi = 0; mi < 8; ++mi)
#pragma unroll
      for (int j = 0; j < 4; ++j) {
        int row = row0 + mi * 16 + fq * 4 + j;
#pragma unroll
        for (int pr = 0; pr < 2; ++pr) {
          float gte = acc[mi][pr * 2][j], up = acc[mi][pr * 2 + 1][j];
          act[(size_t)row * FH + ((col0 + pr * 32) >> 1) + fr] = f2bf(siluf_(gte) * up);
        }
      }
  }
};


namespace pg8 {
#define PG8_LAS __attribute__((address_space(3)))
constexpr int BM = 256, BK = 64, HALF = 128, HTB = HALF * BK * 2, NXCD = 8, WGM = 8;
DEV int lds_byte(int r, int c) { const int st = (r >> 4) * 2 + (c >> 5), rr = r & 15, cc = c & 31, ob = rr * 64 + cc * 2; return st * 1024 + (ob ^ (((ob >> 9) & 1) << 5)); }
DEV void stage_rc(int b, int& R, int& C) { const int st = b / 1024, sb = b % 1024, swz = sb ^ (((sb >> 9) & 1) << 5); R = (st >> 1) * 16 + swz / 64; C = (st & 1) * 32 + (swz % 64) / 2; }
struct Unit { int pm, pn; };
struct StaticOrder {
  int nM, nN, nwg, G, c;
  DEV void init(int M, int N, int G_, int c_) { nM = M / BM; nN = N / BM; nwg = nM * nN; G = G_; c = c_; }
  DEV bool next(int i, Unit& u) const {
    const long L = (long)i * G + c;
    if (L >= nwg) return false;
    int wgid = (int)L;
    { const int q = nwg / NXCD, r = nwg % NXCD, xcd = wgid % NXCD, off = wgid / NXCD; wgid = (xcd < r ? xcd * (q + 1) : r * (q + 1) + (xcd - r) * q) + off; }
    const int nig = WGM * nN, gid = wgid / nig, fm = gid * WGM, gsz = (nM - fm) < WGM ? (nM - fm) : WGM;
    u.pm = fm + ((wgid % nig) % gsz);
    u.pn = (wgid % nig) / gsz;
    return true;
  }
};
template <class Epi>
DEV void gemm_phase(char* smem, const u16* A, int lda, const u16* Bt, int ldb, int M, int N, int K, const Epi& E) {
  PG8_LAS unsigned char* lds = (PG8_LAS unsigned char*)smem;
  const int tid = my_tid(), wid = __builtin_amdgcn_readfirstlane(tid >> 6), lane = tid & 63, wr = wid >> 2, wc = wid & 3, fr = lane & 15, fq = lane >> 4;
  const int nt = K / BK;
  StaticOrder S;
  S.init(M, N, gridDim.x, blockIdx.x);
  unsigned voffA[2], voffB[2];
#pragma unroll
  for (int i = 0; i < 2; ++i) { int R, C; stage_rc(tid * 16 + i * 8192, R, C); voffA[i] = (unsigned)(R * lda + C) * 2u; voffB[i] = (unsigned)(R * ldb + C) * 2u; }
  const size_t kstep = (size_t)(BK * 2);
  const size_t hstepA = (size_t)HALF * lda * 2, hstepB = (size_t)HALF * ldb * 2;
  const size_t tstepA = 2 * hstepA, tstepB = 2 * hstepB;
  const unsigned ldsw = (unsigned)wid * 1024u;
  const int aoff = lds_byte(wr * 64 + fr, fq * 8), boff = lds_byte(wc * 32 + fr, fq * 8);
#define PG8_SA(b, h) (((b) * 2 + (h)) * HTB)
#define PG8_SB(b, h) ((4 + (b) * 2 + (h)) * HTB)
#define PG8_STAGE(bufoff, gbase, voff) do { _Pragma("unroll") for (int _i = 0; _i < 2; ++_i) \
        __builtin_amdgcn_global_load_lds((const unsigned*)((const char*)(gbase) + (voff)[_i]), (PG8_LAS unsigned*)(lds + (bufoff) + ldsw + _i * 8192), 16, 0, 0); } while (0)
#define PG8_LDA(dst, b, h) do { _Pragma("unroll") for (int m = 0; m < 4; ++m) _Pragma("unroll") for (int k = 0; k < 2; ++k) dst[m][k] = *(const PG8_LAS bf16x8*)(lds + PG8_SA(b, h) + aoff + m * 2048 + k * 1024); } while (0)
#define PG8_LDB(dst, b, h) do { _Pragma("unroll") for (int n = 0; n < 2; ++n) _Pragma("unroll") for (int k = 0; k < 2; ++k) dst[n][k] = *(const PG8_LAS bf16x8*)(lds + PG8_SB(b, h) + boff + n * 2048 + k * 1024); } while (0)
#define PG8_MMA(ai, bj, At, Bt_) do { __builtin_amdgcn_s_setprio(1); _Pragma("unroll") for (int m = 0; m < 4; ++m) _Pragma("unroll") for (int n = 0; n < 2; ++n) _Pragma("unroll") for (int k = 0; k < 2; ++k) \
        acc[ai][bj][m][n] = __builtin_amdgcn_mfma_f32_16x16x32_bf16(Bt_[n][k], At[m][k], acc[ai][bj][m][n], 0, 0, 0); __builtin_amdgcn_s_setprio(0); } while (0)
#define PG8_WAIT_V(n) asm volatile("s_waitcnt vmcnt(" #n ")" ::: "memory")
#define PG8_WAIT_L(n) asm volatile("s_waitcnt lgkmcnt(" #n ")" ::: "memory")
#define PG8_BAR __builtin_amdgcn_s_barrier()
#define PG8_SCHED __builtin_amdgcn_sched_barrier(0)
  Unit cur, nxt;
  int ui = 0;
  PG8_WAIT_V(0);
  __syncthreads();
  if (!S.next(0, cur)) return;
  f32x4 acc[2][2][4][2];
#pragma unroll
  for (int a = 0; a < 2; ++a)
#pragma unroll
    for (int b = 0; b < 2; ++b)
#pragma unroll
      for (int m = 0; m < 4; ++m)
#pragma unroll
        for (int n = 0; n < 2; ++n) acc[a][b][m][n] = (f32x4){0.f, 0.f, 0.f, 0.f};
  bf16x8 At[4][2], B0[2][2], B1[2][2];
  const char* cA = (const char*)A + (size_t)cur.pm * tstepA;
  const char* cB = (const char*)Bt + (size_t)cur.pn * tstepB;
  PG8_STAGE(PG8_SB(0, 0), cB, voffB); PG8_STAGE(PG8_SA(0, 0), cA, voffA); PG8_STAGE(PG8_SB(0, 1), cB + hstepB, voffB); PG8_STAGE(PG8_SA(0, 1), cA + hstepA, voffA);
  if (wr == 1) PG8_BAR;
  PG8_WAIT_V(4); PG8_BAR;
  PG8_STAGE(PG8_SB(1, 0), cB + kstep, voffB); PG8_STAGE(PG8_SA(1, 0), cA + kstep, voffA); PG8_STAGE(PG8_SB(1, 1), cB + hstepB + kstep, voffB);
  PG8_WAIT_V(6); PG8_BAR;
  for (;;) {
    const bool has_next = S.next(ui + 1, nxt);
    const char* nA = has_next ? (const char*)A + (size_t)nxt.pm * tstepA : cA;
    const char* nB = has_next ? (const char*)Bt + (size_t)nxt.pn * tstepB : cB;
    for (int t = 0; t < nt; t += 2) {
      const bool last = (t == nt - 2);
      const char* a1 = cA + (size_t)(t + 1) * kstep;
      const char* a2 = last ? nA : cA + (size_t)(t + 2) * kstep;
      const char* b2 = last ? nB : cB + (size_t)(t + 2) * kstep;
      const char* a3 = a2 + kstep;
      const char* b3 = b2 + kstep;
      PG8_LDB(B0, 0, 0); PG8_SCHED; PG8_LDA(At, 0, 0); PG8_STAGE(PG8_SA(1, 1), a1 + hstepA, voffA);
      PG8_WAIT_L(8); PG8_BAR; PG8_WAIT_L(0); PG8_MMA(0, 0, At, B0); PG8_BAR; PG8_SCHED;
      PG8_LDB(B1, 0, 1); PG8_STAGE(PG8_SB(0, 0), b2, voffB);
      PG8_BAR; PG8_WAIT_L(0); PG8_MMA(0, 1, At, B1); PG8_BAR;
      PG8_LDA(At, 0, 1); PG8_STAGE(PG8_SA(0, 0), a2, voffA);
      PG8_BAR; PG8_WAIT_L(0); PG8_MMA(1, 0, At, B0); PG8_BAR; PG8_SCHED;
      PG8_STAGE(PG8_SB(0, 1), b2 + hstepB, voffB);
      PG8_WAIT_V(6); PG8_BAR; PG8_MMA(1, 1, At, B1); PG8_BAR;
      PG8_LDB(B0, 1, 0); PG8_SCHED; PG8_LDA(At, 1, 0); PG8_STAGE(PG8_SA(0, 1), a2 + hstepA, voffA);
      PG8_WAIT_L(8); PG8_BAR; PG8_WAIT_L(0); PG8_MMA(0, 0, At, B0); PG8_BAR; PG8_SCHED;
      PG8_LDB(B1, 1, 1); PG8_STAGE(PG8_SB(1, 0), b3, voffB);
      PG8_BAR; PG8_WAIT_L(0); PG8_MMA(0, 1, At, B1); PG8_BAR;
      PG8_LDA(At, 1, 1); PG8_STAGE(PG8_SA(1, 0), a3, voffA);
      PG8_BAR; PG8_WAIT_L(0); PG8_MMA(1, 0, At, B0); PG8_BAR; PG8_SCHED;
      PG8_STAGE(PG8_SB(1, 1), b3 + hstepB, voffB);
      PG8_WAIT_V(6); PG8_BAR; PG8_MMA(1, 1, At, B1); PG8_BAR;
    }
    E(acc, cur, wr, wc, fr, fq);
    if (!has_next) break;
#pragma unroll
    for (int a = 0; a < 2; ++a)
#pragma unroll
      for (int b = 0; b < 2; ++b)
#pragma unroll
        for (int m = 0; m < 4; ++m)
#pragma unroll
          for (int n = 0; n < 2; ++n) acc[a][b][m][n] = (f32x4){0.f, 0.f, 0.f, 0.f};
    cur = nxt; cA = nA; cB = nB; ++ui;
  }
  PG8_WAIT_V(0);
  if (wr == 0) PG8_BAR;
  PG8_BAR;
#undef PG8_SA
#undef PG8_SB
#undef PG8_STAGE
#undef PG8_LDA
#undef PG8_LDB
#undef PG8_MMA
#undef PG8_WAIT_V
#undef PG8_WAIT_L
#undef PG8_BAR
#undef PG8_SCHED
}

struct EpiInProjT {
  const Params& P;
  int l;
  DEV void operator()(const f32x4 (&acc)[2][2][4][2], const Unit& u, int wr, int wc, int fr, int fq) const {
#pragma unroll
    for (int bj = 0; bj < 2; ++bj) {
      const int cg = u.pn * 256 + bj * 128 + wc * 32;
      if (cg >= 4368) continue;
#pragma unroll
      for (int ai = 0; ai < 2; ++ai)
#pragma unroll
        for (int m = 0; m < 4; ++m) {
          const int row = u.pm * 256 + ai * 128 + wr * 64 + m * 16 + fr;
          const f32x4 v0 = acc[ai][bj][m][0], v1 = acc[ai][bj][m][1];
          if (cg < C_WQ) {
            u16* dst = WS_P(P) + (size_t)row * PW + cg + 4 * fq;
            *reinterpret_cast<uint2*>(dst) = make_uint2(pack2(v0[0], v0[1]), pack2(v0[2], v0[3]));
            *reinterpret_cast<uint2*>(dst + 16) = make_uint2(pack2(v1[0], v1[1]), pack2(v1[2], v1[3]));
          } else if (cg < 3712) {
            const bool isq = (cg < C_WK) || (cg >= C_DQ && cg < C_DK);
            const float qs = isq ? 0.125f : 1.f;
            u16* dst = WS_P(P) + (size_t)row * PW + cg + 4 * fq;
            float o1[4], o2[4];
            if (row < NLAT) {
              const int t = row & (T - 1), hf = (cg >> 5) & 1;
              const float4* rt = reinterpret_cast<const float4*>(WS_ROPE(P) + ((size_t)t * 32 + hf * 16 + 4 * fq) * 2);
              const float4 c01 = rt[0], c23 = rt[1];
              const float cs[4] = {c01.x, c01.z, c23.x, c23.z}, sn[4] = {c01.y, c01.w, c23.y, c23.w};
#pragma unroll
              for (int e = 0; e < 4; ++e) { o1[e] = (v0[e] * cs[e] - v1[e] * sn[e]) * qs; o2[e] = (v1[e] * cs[e] + v0[e] * sn[e]) * qs; }
            } else {
#pragma unroll
              for (int e = 0; e < 4; ++e) { o1[e] = v0[e] * qs; o2[e] = v1[e] * qs; }
            }
            *reinterpret_cast<uint2*>(dst) = make_uint2(pack2(o1[0], o1[1]), pack2(o1[2], o1[3]));
            *reinterpret_cast<uint2*>(dst + 16) = make_uint2(pack2(o2[0], o2[1]), pack2(o2[2], o2[3]));
          } else if (cg < 4352) {
            int b, key;
            if (row < NLAT) { b = row >> 12; key = 256 + (row & (T - 1)); }
            else { b = (row - NLAT) >> 8; key = (row - NLAT) & 255; }
            u16* base;
            int v0i;
            if (cg < 3840) { base = WS_VTW(P) + ((size_t)(b * 2 + ((cg - 3712) >> 6)) * 64) * KEYS; v0i = (cg - 3712) & 63; }
            else { base = WS_VTD(P) + ((size_t)(b * 4 + ((cg - 3840) >> 7)) * 128) * KEYS; v0i = (cg - 3840) & 127; }
#pragma unroll
            for (int e = 0; e < 4; ++e) {
              base[(size_t)(v0i + 4 * fq + e) * KEYS + key] = f2bf(v0[e]);
              base[(size_t)(v0i + 16 + 4 * fq + e) * KEYS + key] = f2bf(v1[e]);
            }
          } else {
            const float4 bg = *reinterpret_cast<const float4*>(P.b_gate + l * 16 + 4 * fq);
            *reinterpret_cast<float4*>(WS_GATES(P) + (size_t)row * 16 + 4 * fq) = make_float4(v0[0] + bg.x, v0[1] + bg.y, v0[2] + bg.z, v0[3] + bg.w);
          }
        }
    }
  }
};
struct EpiResidT {
  const Params& P;
  const float* src_lat;
  const float* modl;
  int gt_off;
  DEV void operator()(const f32x4 (&acc)[2][2][4][2], const Unit& u, int wr, int wc, int fr, int fq) const {
#pragma unroll
    for (int ai = 0; ai < 2; ++ai)
#pragma unroll
      for (int m = 0; m < 4; ++m) {
        const int row = u.pm * 256 + ai * 128 + wr * 64 + m * 16 + fr;
        const float* src;
        float* dst;
        int cond;
        if (row < NLAT) { src = src_lat + (size_t)row * 1024; dst = P.out + (size_t)row * 1024; cond = row >> 12; }
        else { src = WS_XC(P) + (size_t)(row - NLAT) * 1024; dst = WS_XC(P) + (size_t)(row - NLAT) * 1024; cond = 16; }
        const float* gt = modl + (size_t)cond * 6144 + gt_off;
#pragma unroll
        for (int bj = 0; bj < 2; ++bj)
#pragma unroll
          for (int n = 0; n < 2; ++n) {
            const int col = u.pn * 256 + bj * 128 + wc * 32 + n * 16 + 4 * fq;
            const float4 s4 = *reinterpret_cast<const float4*>(src + col), g4 = *reinterpret_cast<const float4*>(gt + col);
            const f32x4 a = acc[ai][bj][m][n];
            *reinterpret_cast<float4*>(dst + col) = make_float4(s4.x + g4.x * a[0], s4.y + g4.y * a[1], s4.z + g4.z * a[2], s4.w + g4.w * a[3]);
          }
      }
  }
};
struct EpiSwigluT {
  u16* act;
  DEV void operator()(const f32x4 (&acc)[2][2][4][2], const Unit& u, int wr, int wc, int fr, int fq) const {
#pragma unroll
    for (int ai = 0; ai < 2; ++ai)
#pragma unroll
      for (int m = 0; m < 4; ++m) {
        const int row = u.pm * 256 + ai * 128 + wr * 64 + m * 16 + fr;
#pragma unroll
        for (int bj = 0; bj < 2; ++bj) {
          const int cg = u.pn * 256 + bj * 128 + wc * 32;
          const f32x4 g = acc[ai][bj][m][0], up = acc[ai][bj][m][1];
          *reinterpret_cast<uint2*>(act + (size_t)row * FH + (cg >> 1) + 4 * fq) =
              make_uint2(pack2(siluf_(g[0]) * up[0], siluf_(g[1]) * up[1]), pack2(siluf_(g[2]) * up[2], siluf_(g[3]) * up[3]));
        }
      }
  }
};
}


#ifdef SELFCHECK
#define DBGF(P) reinterpret_cast<float*>((P).ws + O_XC + (size_t)NCTXR * 1024 * 4)
DEV float blk_reduce(float v, bool ismax, float* red) {
  const int tid = my_tid(), lane = tid & 63, wid = tid >> 6;
#pragma unroll
  for (int o = 32; o > 0; o >>= 1) { float t = __shfl_xor(v, o); v = ismax ? fmaxf(v, t) : v + t; }
  __syncthreads();
  if (lane == 0) red[wid] = v;
  __syncthreads();
  float r = red[0];
  for (int i = 1; i < 8; ++i) r = ismax ? fmaxf(r, red[i]) : r + red[i];
  __syncthreads();
  return r;
}
DEV void chk_sample(int s, int& b, int& hd, int& t) {
  const int ti = s & 7;
  b = (s * 5 + 3) & 15; hd = s & 7;
  t = ti == 0 ? 0 : ti == 1 ? 63 : ti == 2 ? 64 : ti == 3 ? 127 : ti == 4 ? 2048 + 65 : ti == 5 ? 3000 : ti == 6 ? 4032 : 4095;
}
DEV void check_pre(const Params& P, int l, char* smem) {
  const int tid = my_tid();
  float* sc = reinterpret_cast<float*>(smem);
  float* red = sc + 2 * 4352;
  float* ov = red + 16;
  float* dbg = DBGF(P);
  const u16* p = WS_P(P);
  for (int it = blockIdx.x; it < 24; it += gridDim.x) {
    const bool isdiff = it >= 12;
    const int s = isdiff ? it - 12 : it;
    int b, hd, t;
    chk_sample(s, b, hd, t);
    const bool ctxq = s >= 8;
    if (ctxq) t &= 255;
    const size_t row = ctxq ? (size_t)NLAT + b * 256 + t : (size_t)b * T + t;
    __syncthreads();
    if (!isdiff) {
      const int head = hd, g = head >> 2;
      const int lo = ctxq ? 0 : max(0, t - 128), hi = ctxq ? -1 : min(T - 1, t + 128);
      const int nk = 256 + (hi - lo + 1);
      float mx = -1e30f;
      for (int k = tid; k < nk; k += NTHREADS) {
        size_t krow = k < 256 ? (size_t)NLAT + b * 256 + k : (size_t)b * T + lo + (k - 256);
        float a = 0.f;
        for (int d = 0; d < 64; ++d) a += bf2f(p[row * PW + C_WQ + head * 64 + d]) * bf2f(p[krow * PW + C_WK + g * 64 + d]);
        sc[k] = a;
        mx = fmaxf(mx, a);
      }
      mx = blk_reduce(mx, true, red);
      const float sk = P.sink[l * 8 + head];
      mx = fmaxf(mx, sk);
      float sm = 0.f;
      for (int k = tid; k < nk; k += NTHREADS) { float e = expf(sc[k] - mx); sc[k] = e; sm += e; }
      sm = blk_reduce(sm, false, red) + expf(sk - mx);
      if (tid < 64) {
        float o = 0.f;
        for (int k = 0; k < nk; ++k) {
          int kidx = k < 256 ? k : 256 + lo + (k - 256);
          o += sc[k] * bf2f(WS_VTW(P)[((size_t)(b * 2 + g) * 64 + tid) * KEYS + kidx]);
        }
        dbg[it * 128 + tid] = o / sm;
      }
    } else {
      const int h = hd & 3;
      const int nk = ctxq ? 256 : KEYS;
      float mx0 = -1e30f, mx1 = -1e30f;
      for (int k = tid; k < nk; k += NTHREADS) {
        size_t krow = k < 256 ? (size_t)NLAT + b * 256 + k : (size_t)b * T + (k - 256);
        float a0 = 0.f, a1 = 0.f;
        for (int d = 0; d < 64; ++d) {
          a0 += bf2f(p[row * PW + C_DQ + h * 128 + d]) * bf2f(p[krow * PW + C_DK + h * 128 + d]);
          a1 += bf2f(p[row * PW + C_DQ + h * 128 + 64 + d]) * bf2f(p[krow * PW + C_DK + h * 128 + 64 + d]);
        }
        sc[k] = a0; sc[4352 + k] = a1;
        mx0 = fmaxf(mx0, a0); mx1 = fmaxf(mx1, a1);
      }
      mx0 = blk_reduce(mx0, true, red);
      mx1 = blk_reduce(mx1, true, red);
      float s0 = 0.f, s1 = 0.f;
      for (int k = tid; k < nk; k += NTHREADS) {
        float e0 = expf(sc[k] - mx0), e1 = expf(sc[4352 + k] - mx1);
        sc[k] = e0; sc[4352 + k] = e1; s0 += e0; s1 += e1;
      }
      s0 = blk_reduce(s0, false, red);
      s1 = blk_reduce(s1, false, red);
      const float lam = WS_LAM(P)[l], lam_init = 0.8f - 0.6f * expf(-0.3f * (float)l);
      float y = 0.f;
      if (tid < 128) {
        for (int k = 0; k < nk; ++k)
          y += (sc[k] / s0 - lam * sc[4352 + k] / s1) * bf2f(WS_VTD(P)[((size_t)(b * 4 + h) * 128 + tid) * KEYS + k]);
        ov[tid] = y;
      }
      __syncthreads();
      if (tid < 128) {
        float ss = 0.f;
        for (int v = 0; v < 128; ++v) ss += ov[v] * ov[v];
        dbg[it * 128 + tid] = y * rsqrtf(ss / 128.f + EPS) * P.d_norm[l * 512 + h * 128 + tid] * (1.f - lam_init);
      }
    }
  }
}
DEV void check_post(const Params& P, int l, unsigned* flags) {
  const int tid = my_tid();
  const float* dbg = DBGF(P);
  const u16* p = WS_P(P);
  for (int it = blockIdx.x; it < 24; it += gridDim.x) {
    const bool isdiff = it >= 12;
    const int s = isdiff ? it - 12 : it;
    int b, hd, t;
    chk_sample(s, b, hd, t);
    const bool ctxq = s >= 8;
    if (ctxq) t &= 255;
    const size_t row = ctxq ? (size_t)NLAT + b * 256 + t : (size_t)b * T + t;
    if (ctxq && l != 0) continue;
    const int n = isdiff ? 128 : 64;
    if (tid < n) {
      float got = isdiff ? bf2f(p[row * PW + C_DQ + (hd & 3) * 128 + tid]) : bf2f(p[row * PW + C_WQ + hd * 64 + tid]);
      float ex = dbg[it * 128 + tid];
      if (!(fabsf(got - ex) <= 0.03f + 0.03f * fabsf(ex))) atomicOr(flags, isdiff ? (ctxq ? 32u : 2u) : (ctxq ? 16u : 1u));
    }
  }
}
DEV void check_mlstm(const Params& P, int l, char* smem, unsigned* flags) {
  const int tid = my_tid(), lane = tid & 63;
  float* qs = reinterpret_cast<float*>(smem);
  float* ks = qs + 128;
  float* vs = ks + 128;
  float* nn = vs + 128;
  float* sc = nn + 128;
  float* red = sc + 8;
  const u16* p = WS_P(P);
  for (int it = blockIdx.x; it < 4; it += gridDim.x) {
    const int b = (it * 7 + 2) & 15, hd = (it + 1) & 3, dir = it & 1;
    const int v = tid >> 2, kq = tid & 3;
    float C[32];
#pragma unroll
    for (int j = 0; j < 32; ++j) C[j] = 0.f;
    __syncthreads();
    if (tid < 128) nn[tid] = 0.f;
    if (tid == 0) sc[0] = 0.f;
    __syncthreads();
    const int nsteps = (l == 0) ? 256 + T : 256 + T;
    for (int st = 0; st < nsteps; ++st) {
      int seg0, seglen, u;
      if (st < 256) { seg0 = NLAT + b * 256; seglen = 256; u = dir ? 255 - st : st; }
      else { seg0 = b * T; seglen = T; u = dir ? T - 1 - (st - 256) : st - 256; }
      const size_t row = (size_t)seg0 + u;
      if (tid < 128) {
        float xq = 0.f, xk = 0.f;
        for (int tp = 0; tp < 3; ++tp) {
          int uu = u + tp - 1;
          if (uu >= 0 && uu < seglen) {
            xq += P.conv_w[(size_t)l * 3072 + tp * 1024 + hd * 128 + tid] * bf2f(p[((size_t)seg0 + uu) * PW + C_MQ + hd * 128 + tid]);
            xk += P.conv_w[(size_t)l * 3072 + tp * 1024 + 512 + hd * 128 + tid] * bf2f(p[((size_t)seg0 + uu) * PW + C_MK + hd * 128 + tid]);
          }
        }
        qs[tid] = xq / (1.f + expf(-xq));
        ks[tid] = xk / (1.f + expf(-xk)) * 0.08838834764831845f;
        vs[tid] = bf2f(p[row * PW + C_MV + hd * 128 + tid]);
      }
      if (tid == 0) {
        float ig = WS_GATES(P)[row * 16 + dir * 8 + hd], fg = WS_GATES(P)[row * 16 + dir * 8 + 4 + hd];
        float lf = fminf(fg, 0.f) - log1pf(expf(-fabsf(fg)));
        float m = sc[0], mn = fmaxf(lf + m, ig);
        sc[1] = expf(lf + m - mn);
        sc[2] = expf(ig - mn);
        sc[3] = mn;
      }
      __syncthreads();
      const float fd = sc[1], iw = sc[2], mn = sc[3];
      float pd = 0.f;
#pragma unroll
      for (int j = 0; j < 32; ++j) {
        C[j] = fd * C[j] + iw * vs[v] * ks[kq * 32 + j];
        pd += C[j] * qs[kq * 32 + j];
      }
      pd += __shfl_xor(pd, 1);
      pd += __shfl_xor(pd, 2);
      float dn = 0.f;
      if (tid < 128) { float nv = fd * nn[tid] + iw * ks[tid]; nn[tid] = nv; dn = nv * qs[tid]; }
      dn = blk_reduce(dn, false, red);
      if (tid == 0) sc[0] = mn;
      const float hval = pd / fmaxf(fabsf(dn), expf(-mn));
      float sq = (kq == 0) ? hval * hval : 0.f;
      sq = blk_reduce(sq, false, red);
      const float rms = sqrtf(sq / 128.f);
      const bool cmp = (st < 256) ? (l == 0) : true;
      if (cmp && kq == 0 && ((u & 63) == 0 || (u & 63) == 63 || (u % 97) == 0)) {
        float got = bf2f(WS_HFB(P)[(size_t)dir * MTOT * 512 + row * 512 + hd * 128 + v]);
        if (!(fabsf(got - hval) <= 0.05f * rms + 0.05f * fabsf(hval) + 1e-3f)) atomicOr(flags, dir ? 8u : 4u);
      }
    }
  }
}
#endif


#ifdef SELFCHECK
DEV void flag_if(bool bad, unsigned* flags, unsigned bit) { if (bad) atomicOr(flags, bit); }
DEV bool close_(float got, float ex, float tol) { return fabsf(got - ex) <= tol + tol * fabsf(ex); }
DEV void check_inproj(const Params& P, int l, char* smem, unsigned* flags) {
  const int tid = my_tid();
  float* red = reinterpret_cast<float*>(smem);
  float* hrow = red + 16;
  const float* modl = WS_MOD(P) + (size_t)l * 17 * 6144;
  for (int it = blockIdx.x; it < 64; it += gridDim.x) {
    const int ri = it & 7;
    const int row = ri == 0 ? 0 : ri == 1 ? 4095 : ri == 2 ? 4096 + 77 : ri == 3 ? 30000 : ri == 4 ? 65535 : ri == 5 ? NLAT : ri == 6 ? NLAT + 300 : MTOT - 1;
    const int cond = row < NLAT ? row >> 12 : 16;
    {
      int col = (it * 769 + 5) % 6144;
      float a = 0.f;
      for (int k = tid; k < 1024; k += NTHREADS) {
        float cv = cond < 16 ? P.c[cond * 1024 + k] : P.c_ctx[k];
        a += cv / (1.f + expf(-cv)) * P.w_mod[(size_t)l * 1024 * 6144 + (size_t)k * 6144 + col];
      }
      a = blk_reduce(a, false, red) + P.b_mod[l * 6144 + col];
      if (tid == 0) flag_if(!close_(modl[(size_t)cond * 6144 + col], a, 2e-3f), flags, 1u);
    }
    const float* xs = row < NLAT ? ((l == 0 ? P.x : P.out) + (size_t)row * 1024) : (WS_XC(P) + (size_t)(row - NLAT) * 1024);
    float ss = 0.f;
    for (int k = tid; k < 1024; k += NTHREADS) ss += xs[k] * xs[k];
    ss = blk_reduce(ss, false, red);
    const float rstd = rsqrtf(ss / 1024.f + EPS);
    for (int k = tid; k < 1024; k += NTHREADS) {
      float y = xs[k] * rstd * P.g_mix[l * 1024 + k] * (1.f + modl[(size_t)cond * 6144 + 1024 + k]) + modl[(size_t)cond * 6144 + k];
      hrow[k] = y;
      flag_if(!close_(bf2f(WS_H(P)[(size_t)row * 1024 + k]), y, 1e-2f), flags, 2u);
    }
    __syncthreads();
    const int oi = it >> 3;
    const int oj = (oi * 2 + (it & 1)) & 15;
    const int oc = oj == 0 ? 3 : oj == 1 ? 600 : oj == 2 ? 1100 : oj == 3 ? 1999 : oj == 4 ? 2050 : oj == 5 ? 2064 + 70 : oj == 6 ? 2576 + 100 :
                   oj == 7 ? 2704 + 5 : oj == 8 ? 2832 + 200 : oj == 9 ? 2832 + 37 : oj == 10 ? 3344 + 90 : oj == 11 ? 3344 + 300 :
                   oj == 12 ? 3856 + 10 : oj == 13 ? 3856 + 500 : oj == 14 ? 2048 + 15 : 2064 + 500;
    auto dotcol = [&](int c) {
      float a = 0.f;
      for (int k = tid; k < 1024; k += NTHREADS) a += hrow[k] * P.w_in[(size_t)l * 1024 * INW + (size_t)k * INW + c];
      return blk_reduce(a, false, red);
    };
    float val = dotcol(oc);
    const u16* p = WS_P(P);
    const bool lat = row < NLAT;
    const int t = row & (T - 1);
    float got = 0.f, ex = val;
    unsigned bit = 4u;
    if (oc < 2048) { got = bf2f(p[(size_t)row * PW + oc]); }
    else if (oc < 2064) { got = WS_GATES(P)[(size_t)row * 16 + oc - 2048]; ex = val + P.b_gate[l * 16 + oc - 2048]; }
    else if (oc >= 2704 && oc < 2832) {
      int cgi = oc - 2704, g = cgi >> 6, vd = cgi & 63;
      int b = lat ? row >> 12 : (row - NLAT) >> 8, key = lat ? 256 + t : (row - NLAT) & 255;
      got = bf2f(WS_VTW(P)[((size_t)(b * 2 + g) * 64 + vd) * KEYS + key]);
      bit = 8u;
    } else if (oc >= 3856) {
      int cgi = oc - 3856, h = cgi >> 7, vd = cgi & 127;
      int b = lat ? row >> 12 : (row - NLAT) >> 8, key = lat ? 256 + t : (row - NLAT) & 255;
      got = bf2f(WS_VTD(P)[((size_t)(b * 4 + h) * 128 + vd) * KEYS + key]);
      bit = 8u;
    } else {
      int base, nb0;
      bool isq;
      if (oc < 2576) { base = 2064; nb0 = C_WQ; isq = true; }
      else if (oc < 2704) { base = 2576; nb0 = C_WK; isq = false; }
      else if (oc < 3344) { base = 2832; nb0 = C_DQ; isq = true; }
      else { base = 3344; nb0 = C_DK; isq = false; }
      int rel = oc - base, dd = rel & 63, j = dd & 15, second = (dd >> 4) & 1, axis = dd >> 5;
      float other = dotcol(second ? oc - 16 : oc + 16);
      if (lat) {
        int pos = axis ? (t & 63) : (t >> 6);
        float ang = (float)pos * powf(10000.f, -(float)j / 16.f);
        float cs = cosf(ang), sn = sinf(ang);
        ex = second ? (val * cs + other * sn) : (val * cs - other * sn);
      }
      if (isq) ex *= 0.125f;
      got = bf2f(p[(size_t)row * PW + nb0 + rel]);
      bit = 16u;
    }
    if (tid == 0) flag_if(!close_(got, ex, 3e-2f), flags, bit);
    __syncthreads();
  }
}
DEV void check_post6(const Params& P, int l, char* smem, unsigned* flags, const float* xprev) {
  const int tid = my_tid();
  float* red = reinterpret_cast<float*>(smem);
  const u16* Yp = WS_P(P);
  const float* modl = WS_MOD(P) + (size_t)l * 17 * 6144;
  for (int it = blockIdx.x; it < 16; it += gridDim.x) {
    const int ri = it & 7;
    const int row = ri == 0 ? 1 : ri == 1 ? 4097 : ri == 2 ? 12345 : ri == 3 ? 40000 : ri == 4 ? 65534 : ri == 5 ? NLAT + 1 : ri == 6 ? NLAT + 2000 : MTOT - 2;
    if (row >= NLAT && l != 0) continue;
    const int col = (it * 331 + 17) & 1023;
    const int cond = row < NLAT ? row >> 12 : 16;
    float mg = 0.f;
    for (int i = 0; i < 3; ++i) {
      float a = 0.f, z = 0.f;
      for (int k = tid; k < 1024; k += NTHREADS) a += bf2f(WS_H(P)[(size_t)row * 1024 + k]) * P.w_in[(size_t)l * 1024 * INW + (size_t)k * INW + 4368 + i * 1024 + col];
      a = blk_reduce(a, false, red);
      const int yc = i == 0 ? C_MO : (i == 1 ? C_WQ : C_DQ);
      for (int k = tid; k < 512; k += NTHREADS) z += bf2f(Yp[(size_t)row * PW + yc + k]) * P.w_branch[((size_t)l * 3 + i) * 512 * 1024 + (size_t)k * 1024 + col];
      z = blk_reduce(z, false, red);
      mg += z / (1.f + expf(-a));
    }
    if (tid == 0) flag_if(!close_(bf2f(WS_HFB(P)[(size_t)row * 1024 + col]), mg, 3e-2f), flags, 1u);
    float o = 0.f;
    for (int k = tid; k < 1024; k += NTHREADS) o += bf2f(WS_HFB(P)[(size_t)row * 1024 + k]) * P.w_out[(size_t)l * 1024 * 1024 + (size_t)k * 1024 + col];
    o = blk_reduce(o, false, red);
    const float xo = row < NLAT ? xprev[(size_t)row * 1024 + col] : -1e9f;
    const float xn = row < NLAT ? P.out[(size_t)row * 1024 + col] : WS_XC(P)[(size_t)(row - NLAT) * 1024 + col];
    if (tid == 0 && row < NLAT && (l == 0)) flag_if(!close_(xn, xo + modl[(size_t)cond * 6144 + 2048 + col] * o, 2e-2f), flags, 2u);
    if (tid == 0) DBGF(P)[4096 + it] = xn;
  }
}
DEV void check_post9(const Params& P, int l, char* smem, unsigned* flags) {
  const int tid = my_tid();
  float* red = reinterpret_cast<float*>(smem);
  const float* modl = WS_MOD(P) + (size_t)l * 17 * 6144;
  for (int it = blockIdx.x; it < 16; it += gridDim.x) {
    const int ri = it & 7;
    const int row = ri == 0 ? 1 : ri == 1 ? 4097 : ri == 2 ? 12345 : ri == 3 ? 40000 : ri == 4 ? 65534 : ri == 5 ? NLAT + 1 : ri == 6 ? NLAT + 2000 : MTOT - 2;
    if (row >= NLAT && l != 0) continue;
    const int col = (it * 331 + 17) & 1023;
    const int cond = row < NLAT ? row >> 12 : 16;
    const int j = (it * 97 + 13) % FH;
    float g = 0.f, u = 0.f;
    for (int k = tid; k < 1024; k += NTHREADS) {
      float hv = bf2f(WS_H(P)[(size_t)row * 1024 + k]);
      g += hv * P.w_ffn_in[(size_t)l * 1024 * 5632 + (size_t)k * 5632 + j];
      u += hv * P.w_ffn_in[(size_t)l * 1024 * 5632 + (size_t)k * 5632 + FH + j];
    }
    g = blk_reduce(g, false, red);
    u = blk_reduce(u, false, red);
    if (tid == 0) flag_if(!close_(bf2f(WS_P(P)[(size_t)row * FH + j]), g / (1.f + expf(-g)) * u, 3e-2f), flags, 4u);
    float o = 0.f;
    for (int k = tid; k < FH; k += NTHREADS) o += bf2f(WS_P(P)[(size_t)row * FH + k]) * P.w_ffn_out[(size_t)l * FH * 1024 + (size_t)k * 1024 + col];
    o = blk_reduce(o, false, red);
    const float xn = row < NLAT ? P.out[(size_t)row * 1024 + col] : WS_XC(P)[(size_t)(row - NLAT) * 1024 + col];
    if (tid == 0) flag_if(!close_(xn, DBGF(P)[4096 + it] + modl[(size_t)cond * 6144 + 5120 + col] * o, 2e-2f), flags, 8u);
  }
}
#endif

#ifdef DEBUG_STAGE
DEV void debug_dump(const Params& P, int stage) {
  const int tid = my_tid();
  for (size_t idx = (size_t)blockIdx.x * NTHREADS + tid; idx < (size_t)NLAT * 1024; idx += (size_t)gridDim.x * NTHREADS) {
    size_t row = idx >> 10;
    int c = (int)(idx & 1023);
    size_t r2 = row + (row < 4096 ? NLAT : 0);
    float v = 0.f;
    const u16* p = WS_P(P);
    if (stage == 1) {
      v = bf2f(p[row * PW + c]) + bf2f(p[row * PW + 1024 + c]) + bf2f(p[row * PW + 2048 + c]) + (c < 640 ? bf2f(p[row * PW + 3072 + c]) : 0.f);
      v += bf2f(p[r2 * PW + c]) + bf2f(p[r2 * PW + 1024 + c]) + bf2f(p[r2 * PW + 2048 + c]);
      v += bf2f(WS_VTD(P)[r2 * 512 + (c & 511)]) + bf2f(WS_VTW(P)[r2 * 128 + (c & 127)]) + WS_GATES(P)[r2 * 16 + (c & 15)];
      v += bf2f(WS_VTD(P)[row * 512 + (c & 511)]) + bf2f(WS_VTW(P)[row * 128 + (c & 127)]) + WS_GATES(P)[row * 16 + (c & 15)];
    } else if (stage == 21) {
      v = bf2f(WS_HFB(P)[row * 512 + (c & 511)]) + 2.f * bf2f(WS_HFB(P)[(size_t)MTOT * 512 + row * 512 + (c & 511)]);
      v += bf2f(WS_HFB(P)[r2 * 512 + (c & 511)]) + 2.f * bf2f(WS_HFB(P)[(size_t)MTOT * 512 + r2 * 512 + (c & 511)]);
    } else if (stage == 22) {
      v = bf2f(p[row * PW + C_WQ + (c & 511)]) + bf2f(p[r2 * PW + C_WQ + (c & 511)]);
    } else if (stage == 23) {
      v = bf2f(p[row * PW + C_DQ + (c & 511)]) + bf2f(p[r2 * PW + C_DQ + (c & 511)]);
    } else if (stage == 3) {
      v = bf2f(WS_HFB(P)[row * 1024 + c]) + bf2f(WS_HFB(P)[r2 * 1024 + c]);
    } else if (stage == 4) {
      v = P.out[idx] + WS_XC(P)[(row & 4095) * 1024 + c];
    } else if (stage == 5) {
      v = bf2f(WS_H(P)[row * 1024 + c]) + bf2f(WS_H(P)[r2 * 1024 + c]);
    } else if (stage == 6) {
      v = bf2f(p[row * FH + c]) + bf2f(p[row * FH + 1024 + c]) + bf2f(p[r2 * FH + 1792 + c]);
    }
    if (stage != 4) P.out[idx] = v; else P.out[idx] = v;
  }
}
#define DBG(st) if (l == 0 && DEBUG_STAGE == st) { GSYNC_ONLY(); debug_dump(P, st); return true; }
#else
#define DBG(st)
#endif
template <int l>
DEV bool layer_body(const Params& P, unsigned* bar, unsigned& epoch, char* smem) {
  constexpr bool need_ctx = (l == 0);
  const float* modl = WS_MOD(P) + (size_t)l * 17 * 6144;
  const u16* Wl = WS_W(P) + (size_t)l * W_LAYER;
  const float* xlat = l == 0 ? P.x : P.out;
  constexpr int Mtok = need_ctx ? MTOT : NLAT;
  phase_norm_mod(P, xlat, WS_XC(P), MTOT, P.g_mix + l * 1024, modl, 0, 1024);
  GSYNC();
  pg8::gemm_phase(smem, WS_H(P), 1024, Wl + W_IN, 1024, MTOT, NIN, 1024, pg8::EpiInProjT{P, l});
#ifdef REPEAT_GEMMS
  if (l == 1) pg8::gemm_phase(smem, WS_H(P), 1024, Wl + W_IN, 1024, MTOT, NIN, 1024, pg8::EpiInProjT{P, l});
#endif
  GSYNC();
  DBG(1)
#ifdef SELFCHECK
#if SELFCHECK == 2
  check_inproj(P, l, smem, WS_CTR(P) + 16 + l * 3);
#else
  check_pre(P, l, smem);
#endif
  GSYNC();
#endif
  phase_mixers(P, l, smem);
  GSYNC();
#if defined(SELFCHECK) && SELFCHECK == 1
  check_post(P, l, WS_CTR(P) + 17 + l * 3);
  check_mlstm(P, l, smem, WS_CTR(P) + 17 + l * 3);
  GSYNC();
#endif
  DBG(21)
  DBG(22)
  DBG(23)
  phase_ya(P, l, Mtok);
  GSYNC();
  phase_merge(P, l, Mtok, smem);
#ifdef REPEAT_GEMMS
  if (l == 1) phase_merge(P, l, Mtok, smem);
#endif
  GSYNC();
  DBG(3)
  pg8::gemm_phase(smem, WS_HFB(P), 1024, Wl + W_O, 1024, Mtok, 1024, 1024, pg8::EpiResidT{P, xlat, modl, 2048});
  GSYNC();
#if defined(SELFCHECK) && SELFCHECK == 2
  check_post6(P, l, smem, WS_CTR(P) + 18 + l * 3, xlat);
  GSYNC();
#endif
  DBG(4)
  phase_norm_mod(P, P.out, WS_XC(P), Mtok, P.g_ffn + l * 1024, modl, 3072, 4096);
  GSYNC();
  DBG(5)
  pg8::gemm_phase(smem, WS_H(P), 1024, Wl + W_FI, 1024, Mtok, 5632, 1024, pg8::EpiSwigluT{WS_P(P)});
#ifdef REPEAT_GEMMS
  if (l == 1) pg8::gemm_phase(smem, WS_H(P), 1024, Wl + W_FI, 1024, Mtok, 5632, 1024, pg8::EpiSwigluT{WS_P(P)});
#endif
  GSYNC();
  DBG(6)
  pg8::gemm_phase(smem, WS_P(P), FH, Wl + W_FO, FH, Mtok, 1024, FH, pg8::EpiResidT{P, P.out, modl, 5120});
  GSYNC();
#if defined(SELFCHECK) && SELFCHECK == 2
  check_post9(P, l, smem, WS_CTR(P) + 18 + l * 3);
  GSYNC();
#endif
  return false;
}

__global__ void __launch_bounds__(NTHREADS) fwd_megakernel(Params P) {
  extern __shared__ __attribute__((aligned(16))) char smem[];
  cg::grid_group grid = cg::this_grid();
  unsigned* bar = WS_CTR(P) + 64;
  unsigned epoch = 0;
  grid.sync();
  phase_prologue(P, smem);
  GSYNC();
  if (layer_body<0>(P, bar, epoch, smem)) return;
  if (layer_body<1>(P, bar, epoch, smem)) return;
  phase_final_norm(P);
#ifdef SELFCHECK
  GSYNC();
  if (blockIdx.x == 0 && my_tid() == 0) {
    float scale = 1000.f;
    for (int w = 0; w < 6; ++w) {
      unsigned f = WS_CTR(P)[16 + w];
      if (f) { P.out[0] = (10.f + (float)f) * scale; break; }
      scale *= 10.f;
    }
  }
#endif
}

extern "C" void kernel_launch(void* const* d_in, const int* in_sizes, int n_in, void* d_out, int out_size, void* d_ws,
                              size_t ws_size, hipStream_t stream) {
  static int grid_blocks = 0;
  if (!grid_blocks) {
    int dev = 0, cus = 0, per_cu = 0;
    hipGetDevice(&dev);
    hipDeviceGetAttribute(&cus, hipDeviceAttributeMultiprocessorCount, dev);
    hipFuncSetAttribute((const void*)fwd_megakernel, hipFuncAttributeMaxDynamicSharedMemorySize, LDS_BYTES);
    hipOccupancyMaxActiveBlocksPerMultiprocessor(&per_cu, fwd_megakernel, NTHREADS, LDS_BYTES);
    if (per_cu < 1) per_cu = 1;
    if (per_cu > 1) per_cu = 1;
    grid_blocks = cus * per_cu;
  }
  Params P{};
  const float* const* in = reinterpret_cast<const float* const*>(d_in);
  P.x = in[0]; P.c = in[1]; P.ctx = in[2]; P.c_ctx = in[3]; P.w_mod = in[4]; P.b_mod = in[5]; P.g_mix = in[6];
  P.g_ffn = in[7]; P.w_in = in[8]; P.b_gate = in[9]; P.conv_w = in[10]; P.m_norm = in[11]; P.sink = in[12];
  P.lam_q1 = in[13]; P.lam_k1 = in[14]; P.lam_q2 = in[15]; P.lam_k2 = in[16]; P.d_norm = in[17]; P.w_branch = in[18];
  P.w_out = in[19]; P.w_ffn_in = in[20]; P.w_ffn_out = in[21]; P.g_final = in[22];
  P.out = reinterpret_cast<float*>(d_out);
  P.ws = reinterpret_cast<char*>(d_ws);
  if (WS_TOTAL > ws_size) fprintf(stderr, "workspace too small: need %zu have %zu\n", (size_t)WS_TOTAL, ws_size);
  hipMemsetAsync(P.ws + O_CTR, 0, 2048, stream);
  void* args[] = {&P};
  hipError_t e = hipLaunchCooperativeKernel((const void*)fwd_megakernel, dim3(grid_blocks), dim3(NTHREADS), args, LDS_BYTES, stream);
  if (e != hipSuccess) fprintf(stderr, "cooperative launch failed: %s (grid %d)\n", hipGetErrorString(e), grid_blocks);
}
```

```cpp
#include <hip/hip_runtime.h>
#include <hip/hip_cooperative_groups.h>
#include <cstdio>
#include <cstdint>
namespace cg = cooperative_groups;

typedef unsigned short u16;
using bf16x8 = __attribute__((ext_vector_type(8))) short;
using f32x4 = __attribute__((ext_vector_type(4))) float;
using f32x16 = __attribute__((ext_vector_type(16))) float;

#define DEV __device__ __forceinline__

constexpr int D = 1024, NB = 16, T = 4096, TC = 256;
constexpr int NLAT = NB * T;
constexpr int NCTXR = NB * TC;
constexpr int MTOT = NLAT + NCTXR;
constexpr int KEYS = T + TC;
constexpr int INW = 7440;
constexpr int PW = 3712;
constexpr int C_MQ = 0, C_MK = 512, C_MV = 1024, C_MO = 1536, C_WQ = 2048, C_WK = 2560, C_DQ = 2688, C_DK = 3200;
constexpr int NIN = 4608;
constexpr int FH = 2816;
constexpr float EPS = 1e-6f;
constexpr float L2E = 1.4426950408889634f;
constexpr int NTHREADS = 512;
constexpr int LDS_BYTES = 147456;

constexpr size_t W_IN = 0;
constexpr size_t W_G = W_IN + (size_t)NIN * 1024;
constexpr size_t W_B = W_G + (size_t)3072 * 1024;
constexpr size_t W_O = W_B + (size_t)3 * 1024 * 512;
constexpr size_t W_FI = W_O + (size_t)1024 * 1024;
constexpr size_t W_FO = W_FI + (size_t)5632 * 1024;
constexpr size_t W_LAYER = W_FO + (size_t)1024 * FH;

struct Params {
  const float *x, *c, *ctx, *c_ctx, *w_mod, *b_mod, *g_mix, *g_ffn, *w_in, *b_gate, *conv_w, *m_norm, *sink;
  const float *lam_q1, *lam_k1, *lam_q2, *lam_k2, *d_norm, *w_branch, *w_out, *w_ffn_in, *w_ffn_out, *g_final;
  float* out;
  char* ws;
};


constexpr size_t al256(size_t x) { return (x + 255) & ~(size_t)255; }
constexpr size_t O_W = 0;
constexpr size_t O_MOD = O_W + al256(2 * W_LAYER * 2);
constexpr size_t O_ROPE = O_MOD + al256((size_t)2 * 17 * 6144 * 4);
constexpr size_t O_LAM = O_ROPE + al256((size_t)T * 32 * 2 * 4);
constexpr size_t O_CTR = O_LAM + 256;
constexpr size_t O_GATES = O_CTR + 2048;
constexpr size_t O_H = O_GATES + al256((size_t)MTOT * 16 * 4);
constexpr size_t O_P = O_H + al256((size_t)MTOT * 1024 * 2);
constexpr size_t O_VTW = O_P + al256((size_t)MTOT * PW * 2);
constexpr size_t O_VTD = O_VTW + al256((size_t)NB * 2 * 64 * KEYS * 2);
constexpr size_t O_HFB = O_VTD + al256((size_t)NB * 4 * 128 * KEYS * 2);
constexpr size_t O_XC = O_HFB + al256((size_t)2 * MTOT * 512 * 2);
constexpr size_t WS_TOTAL = O_XC + al256((size_t)NCTXR * 1024 * 4) + 65536;
#define WS_W(P) reinterpret_cast<u16*>((P).ws + O_W)
#define WS_MOD(P) reinterpret_cast<float*>((P).ws + O_MOD)
#define WS_ROPE(P) reinterpret_cast<float*>((P).ws + O_ROPE)
#define WS_LAM(P) reinterpret_cast<float*>((P).ws + O_LAM)
#define WS_CTR(P) reinterpret_cast<unsigned*>((P).ws + O_CTR)
#define WS_GATES(P) reinterpret_cast<float*>((P).ws + O_GATES)
#define WS_H(P) reinterpret_cast<u16*>((P).ws + O_H)
#define WS_P(P) reinterpret_cast<u16*>((P).ws + O_P)
#define WS_VTW(P) reinterpret_cast<u16*>((P).ws + O_VTW)
#define WS_VTD(P) reinterpret_cast<u16*>((P).ws + O_VTD)
#define WS_HFB(P) reinterpret_cast<u16*>((P).ws + O_HFB)
#define WS_XC(P) reinterpret_cast<float*>((P).ws + O_XC)

DEV int my_tid() {
  int t = threadIdx.x;
  asm volatile("" : "+v"(t));
  return t;
}
typedef __bf16 bf2_t __attribute__((ext_vector_type(2)));
typedef float f2_t __attribute__((ext_vector_type(2)));
DEV uint32_t pack2(float a, float b) {
  f2_t v = {a, b};
  bf2_t r = __builtin_convertvector(v, bf2_t);
  return *reinterpret_cast<uint32_t*>(&r);
}
DEV u16 f2bf(float f) { return (u16)(pack2(f, 0.f) & 0xffffu); }
DEV float bf2f(u16 h) { return __uint_as_float(((uint32_t)h) << 16); }
DEV float bflo(uint32_t v) { return __uint_as_float(v << 16); }
DEV float bfhi(uint32_t v) { return __uint_as_float(v & 0xffff0000u); }
DEV float fexp2(float x) { return __builtin_amdgcn_exp2f(x); }
DEV float sigmoidf_(float x) { return __builtin_amdgcn_rcpf(1.f + __expf(-x)); }
DEV float siluf_(float x) { return x * __builtin_amdgcn_rcpf(1.f + __expf(-x)); }
DEV float wave_sum(float v) {
#pragma unroll
  for (int o = 32; o > 0; o >>= 1) v += __shfl_xor(v, o);
  return v;
}
DEV bf16x8 ld16(const void* p) { return *reinterpret_cast<const bf16x8*>(p); }
DEV bf16x8 mk8(uint32_t a, uint32_t b, uint32_t c, uint32_t d) {
  uint4 u = make_uint4(a, b, c, d);
  return *reinterpret_cast<bf16x8*>(&u);
}
DEV f32x16 mfma32(bf16x8 a, bf16x8 b, f32x16 c) { return __builtin_amdgcn_mfma_f32_32x32x16_bf16(a, b, c, 0, 0, 0); }
DEV f32x4 mfma16(bf16x8 a, bf16x8 b, f32x4 c) { return __builtin_amdgcn_mfma_f32_16x16x32_bf16(a, b, c, 0, 0, 0); }
DEV int pi32(int r) { return (r & ~12) | ((r & 4) << 1) | ((r & 8) >> 1); }


DEV void grid_barrier(unsigned* bar, unsigned& epoch) {
  asm volatile("s_waitcnt vmcnt(0)" ::: "memory");
  __syncthreads();
  epoch += 1;
  if (my_tid() == 0) {
    __builtin_amdgcn_fence(__ATOMIC_RELEASE, "agent");
    unsigned* loc = bar + 32 + (blockIdx.x & 7) * 32;
    const unsigned per = gridDim.x >> 3;
    unsigned old = __hip_atomic_fetch_add(loc, 1u, __ATOMIC_RELAXED, __HIP_MEMORY_SCOPE_AGENT);
    if (old + 1 == per * epoch) __hip_atomic_fetch_add(bar, 1u, __ATOMIC_RELAXED, __HIP_MEMORY_SCOPE_AGENT);
    while (__hip_atomic_load(bar, __ATOMIC_RELAXED, __HIP_MEMORY_SCOPE_AGENT) < 8u * epoch) __builtin_amdgcn_s_sleep(1);
    __builtin_amdgcn_fence(__ATOMIC_ACQUIRE, "agent");
  }
  __syncthreads();
}
#define GSYNC() grid_barrier(bar, epoch)
#define GSYNC_ONLY()

template <int N>
DEV void wait_vm() { asm volatile("s_waitcnt vmcnt(%0)" ::"n"(N) : "memory"); }

template <int MI, int NI>
DEV void gemm_mainloop(const u16* __restrict__ A, int lda, const u16* __restrict__ Bt, int ldb, int K,
                       f32x4 (&acc)[MI][NI], char* smem) {
  constexpr int BM = 32 * MI, BN = 64 * NI;
  constexpr int NA = BM * 4 / NTHREADS, NBL = BN * 4 / NTHREADS;
  constexpr int ABYTES = BM * 64, BBYTES = BN * 64, SBYTES = ABYTES + BBYTES;
  constexpr int NL = NA + NBL;
  const int tid = my_tid(), lane = tid & 63, wid = tid >> 6, wr = wid >> 2, wc = wid & 3, fr = lane & 15, fq = lane >> 4;
  const int nk = K / 32;
  auto stage = [&](int kt) {
    char* base = smem + (kt & 3) * SBYTES;
#pragma unroll
    for (int i = 0; i < NA; ++i) {
      int id = tid + i * NTHREADS, r = id >> 2, c = (id & 3) ^ (((r >> 3) & 1) * 3);
      __builtin_amdgcn_global_load_lds((const unsigned*)(A + (size_t)r * lda + kt * 32 + c * 8), (unsigned*)(base + id * 16), 16, 0, 0);
    }
#pragma unroll
    for (int i = 0; i < NBL; ++i) {
      int id = tid + i * NTHREADS, r = id >> 2, c = (id & 3) ^ (((r >> 3) & 1) * 3);
      __builtin_amdgcn_global_load_lds((const unsigned*)(Bt + (size_t)r * ldb + kt * 32 + c * 8), (unsigned*)(base + ABYTES + id * 16), 16, 0, 0);
    }
  };
  wait_vm<0>();
  __syncthreads();
  stage(0);
  if (nk > 1) stage(1);
  if (nk > 2) stage(2);
  for (int kt = 0; kt < nk; ++kt) {
    if (kt + 2 < nk) wait_vm<2 * NL>();
    else if (kt + 1 < nk) wait_vm<NL>();
    else wait_vm<0>();
    asm volatile("" ::: "memory");
    __builtin_amdgcn_s_barrier();
    asm volatile("" ::: "memory");
    const char* As = smem + (kt & 3) * SBYTES;
    const char* Bs = As + ABYTES;
    bf16x8 bfr[NI], af[MI];
#pragma unroll
    for (int ni = 0; ni < NI; ++ni) {
      int r = wc * (NI * 16) + ni * 16 + fr;
      bfr[ni] = ld16(Bs + r * 64 + ((fq ^ (((r >> 3) & 1) * 3)) << 4));
    }
#pragma unroll
    for (int mi = 0; mi < MI; ++mi) {
      int r = wr * (MI * 16) + mi * 16 + fr;
      af[mi] = ld16(As + r * 64 + ((fq ^ (((r >> 3) & 1) * 3)) << 4));
    }
    if (kt + 3 < nk) stage(kt + 3);
    __builtin_amdgcn_sched_barrier(0);
    __builtin_amdgcn_s_setprio(1);
#pragma unroll
    for (int mi = 0; mi < MI; ++mi)
#pragma unroll
      for (int ni = 0; ni < NI; ++ni) acc[mi][ni] = mfma16(af[mi], bfr[ni], acc[mi][ni]);
    __builtin_amdgcn_s_setprio(0);
    __builtin_amdgcn_sched_barrier(0);
  }
}


DEV void gemm_mainloop64(const u16* __restrict__ A, int lda, const u16* __restrict__ Bt, int ldb, int K, f32x4 (&acc)[4][4], char* smem) {
  constexpr int ABYTES = 128 * 128, BBYTES = 256 * 128, SBYTES = ABYTES + BBYTES;
  constexpr int NA = 2, NBL = 4, NL = NA + NBL;
  const int tid = my_tid(), lane = tid & 63, wid = tid >> 6, wr = wid >> 2, wc = wid & 3, fr = lane & 15, fq = lane >> 4;
  const int nk = K / 64;
  auto stage = [&](int kt) {
    char* base = smem + (kt % 3) * SBYTES;
#pragma unroll
    for (int i = 0; i < NA; ++i) {
      int id = tid + i * NTHREADS, r = id >> 3, c = (id & 7) ^ ((r >> 1) & 7);
      __builtin_amdgcn_global_load_lds((const unsigned*)(A + (size_t)r * lda + kt * 64 + c * 8), (unsigned*)(base + id * 16), 16, 0, 0);
    }
#pragma unroll
    for (int i = 0; i < NBL; ++i) {
      int id = tid + i * NTHREADS, r = id >> 3, c = (id & 7) ^ ((r >> 1) & 7);
      __builtin_amdgcn_global_load_lds((const unsigned*)(Bt + (size_t)r * ldb + kt * 64 + c * 8), (unsigned*)(base + ABYTES + id * 16), 16, 0, 0);
    }
  };
  wait_vm<0>();
  __syncthreads();
  stage(0);
  if (nk > 1) stage(1);
  for (int kt = 0; kt < nk; ++kt) {
    if (kt + 1 < nk) wait_vm<NL>();
    else wait_vm<0>();
    asm volatile("" ::: "memory");
    __builtin_amdgcn_s_barrier();
    asm volatile("" ::: "memory");
    if (kt + 2 < nk) stage(kt + 2);
    const char* As = smem + (kt % 3) * SBYTES;
    const char* Bs = As + ABYTES;
#pragma unroll
    for (int ks = 0; ks < 2; ++ks) {
      bf16x8 bfr[4], af[4];
#pragma unroll
      for (int ni = 0; ni < 4; ++ni) {
        int r = wc * 64 + ni * 16 + fr;
        bfr[ni] = ld16(Bs + r * 128 + (((ks * 4 + fq) ^ ((r >> 1) & 7)) << 4));
      }
#pragma unroll
      for (int mi = 0; mi < 4; ++mi) {
        int r = wr * 64 + mi * 16 + fr;
        af[mi] = ld16(As + r * 128 + (((ks * 4 + fq) ^ ((r >> 1) & 7)) << 4));
      }
#pragma unroll
      for (int mi = 0; mi < 4; ++mi)
#pragma unroll
        for (int ni = 0; ni < 4; ++ni) acc[mi][ni] = mfma16(af[mi], bfr[ni], acc[mi][ni]);
      __builtin_amdgcn_sched_barrier(0);
    }
  }
}

template <int MI, int NI>
DEV void zero_acc(f32x4 (&acc)[MI][NI]) {
#pragma unroll
  for (int mi = 0; mi < MI; ++mi)
#pragma unroll
    for (int ni = 0; ni < NI; ++ni) acc[mi][ni] = f32x4{0.f, 0.f, 0.f, 0.f};
}


DEV void tile_coords(int tile, int total, int nN, int& tm, int& tn) {
  int t = tile;
  if (gridDim.x == 256 && tile < (total & ~255)) {
    int j = tile & 255;
    t = (tile & ~255) + (j & 7) * 32 + (j >> 3);
  }
  int p = t / (4 * nN), q = t - p * (4 * nN);
  tn = q >> 2;
  tm = p * 4 + (q & 3);
}

template <int MI, class Epi>
DEV void gemm_phase(const u16* A, int lda, const u16* Bt, int ldb, int M, int N, int K, Epi epi, char* smem) {
  constexpr int BM = 32 * MI;
  const int nM = M / BM, nN = N / 256;
  const int wid = my_tid() >> 6, wr = wid >> 2, wc = wid & 3;
  for (int tile = blockIdx.x; tile < nM * nN; tile += gridDim.x) {
    int tm, tn;
    tile_coords(tile, nM * nN, nN, tm, tn);
    f32x4 acc[MI][4];
    zero_acc<MI, 4>(acc);
    gemm_mainloop<MI, 4>(A + (size_t)tm * BM * lda, lda, Bt + (size_t)tn * 256 * ldb, ldb, K, acc, smem);
    epi(acc, tm * BM + wr * (MI * 16), tn * 256 + wc * 64);
  }
}

DEV int map_col(int type, int n) {
  if (type == 0) {
    if (n < 2048) return n;
    if (n < 2688) return n + 16;
    if (n < 3712) return n + 144;
    if (n < 3840) return n - 1008;
    if (n < 4352) return n + 16;
    if (n < 4368) return n - 2304;
    return -1;
  }
  if (type == 1) return n + 4368;
  if (type == 2) return n;
  int q = n >> 5, r = n & 31;
  return r < 16 ? (q * 16 + r) : (FH + q * 16 + r - 16);
}

DEV void tr_tile(const float* __restrict__ src, int ldsrc, u16* __restrict__ dst, int K, int n0, int k0, int type, char* smem) {
  float* tile = reinterpret_cast<float*>(smem);
  const int tid = my_tid();
  {
    int n = tid & 63, sc = map_col(type, n0 + n);
#pragma unroll
    for (int i = 0; i < 8; ++i) {
      int k = (tid >> 6) + 8 * i;
      tile[k * 65 + n] = sc >= 0 ? src[(size_t)(k0 + k) * ldsrc + sc] : 0.f;
    }
  }
  __syncthreads();
  {
    int n = tid >> 3, kc = tid & 7;
    uint32_t w[4];
#pragma unroll
    for (int j = 0; j < 4; ++j) w[j] = pack2(tile[(kc * 8 + 2 * j) * 65 + n], tile[(kc * 8 + 2 * j + 1) * 65 + n]);
    *reinterpret_cast<uint4*>(dst + (size_t)(n0 + n) * K + k0 + kc * 8) = make_uint4(w[0], w[1], w[2], w[3]);
  }
  __syncthreads();
}

DEV void phase_prologue(const Params& P, char* smem) {
  const int tid = my_tid();
  constexpr int TPL = 4672;
  for (int it = blockIdx.x; it < 2 * TPL; it += gridDim.x) {
    int l = it / TPL, t = it % TPL;
    u16* Wl = WS_W(P) + (size_t)l * W_LAYER;
    if (t < 1152) {
      tr_tile(P.w_in + (size_t)l * 1024 * INW, INW, Wl + W_IN, 1024, (t / 16) * 64, (t % 16) * 64, 0, smem);
    } else if (t < 1920) {
      t -= 1152;
      tr_tile(P.w_in + (size_t)l * 1024 * INW, INW, Wl + W_G, 1024, (t / 16) * 64, (t % 16) * 64, 1, smem);
    } else if (t < 2304) {
      t -= 1920;
      int i = t / 128;
      t %= 128;
      tr_tile(P.w_branch + ((size_t)l * 3 + i) * 512 * 1024, 1024, Wl + W_B + (size_t)i * 1024 * 512, 512, (t / 8) * 64, (t % 8) * 64, 2, smem);
    } else if (t < 2560) {
      t -= 2304;
      tr_tile(P.w_out + (size_t)l * 1024 * 1024, 1024, Wl + W_O, 1024, (t / 16) * 64, (t % 16) * 64, 2, smem);
    } else if (t < 3968) {
      t -= 2560;
      tr_tile(P.w_ffn_in + (size_t)l * 1024 * 5632, 5632, Wl + W_FI, 1024, (t / 16) * 64, (t % 16) * 64, 3, smem);
    } else {
      t -= 3968;
      tr_tile(P.w_ffn_out + (size_t)l * FH * 1024, 1024, Wl + W_FO, FH, (t / 44) * 64, (t % 44) * 64, 2, smem);
    }
  }
  for (int it = blockIdx.x; it < 384; it += gridDim.x) {
    int l = it / 192, n0 = (it % 192) * 32;
    float* sc = reinterpret_cast<float*>(smem);
    float* red = sc + 17 * 1024;
    __syncthreads();
    for (int idx = tid; idx < 17 * 1024; idx += NTHREADS) {
      int cond = idx >> 10, k = idx & 1023;
      float cv = cond < 16 ? P.c[cond * 1024 + k] : P.c_ctx[k];
      sc[idx] = siluf_(cv);
    }
    __syncthreads();
    int col = tid & 31, ks = tid >> 5;
    float acc[17];
#pragma unroll
    for (int j = 0; j < 17; ++j) acc[j] = 0.f;
    const float* wm = P.w_mod + (size_t)l * 1024 * 6144 + n0 + col;
    for (int k = ks * 64; k < ks * 64 + 64; ++k) {
      float w = wm[(size_t)k * 6144];
#pragma unroll
      for (int j = 0; j < 17; ++j) acc[j] += sc[j * 1024 + k] * w;
    }
#pragma unroll
    for (int j = 0; j < 17; ++j) red[(ks * 17 + j) * 32 + col] = acc[j];
    __syncthreads();
    for (int o = tid; o < 17 * 32; o += NTHREADS) {
      int j = o >> 5, cc = o & 31;
      float s = 0.f;
      for (int q = 0; q < 16; ++q) s += red[(q * 17 + j) * 32 + cc];
      WS_MOD(P)[((size_t)l * 17 + j) * 6144 + n0 + cc] = s + P.b_mod[l * 6144 + n0 + cc];
    }
  }
  for (int idx = blockIdx.x * NTHREADS + tid; idx < T * 32; idx += gridDim.x * NTHREADS) {
    int t = idx >> 5, j = idx & 31;
    int pos = j < 16 ? (t >> 6) : (t & 63);
    float inv = powf(10000.f, -(float)(j & 15) / 16.f);
    float ang = (float)pos * inv;
    WS_ROPE(P)[idx * 2] = cosf(ang);
    WS_ROPE(P)[idx * 2 + 1] = sinf(ang);
  }
  for (int idx = blockIdx.x * NTHREADS + tid; idx < NCTXR * 1024 / 4; idx += gridDim.x * NTHREADS)
    reinterpret_cast<float4*>(WS_XC(P))[idx] = reinterpret_cast<const float4*>(P.ctx)[idx];
  if (blockIdx.x == 0 && tid < 64) {
    for (int l = 0; l < 2; ++l) {
      float a = wave_sum(P.lam_q1[l * 64 + tid] * P.lam_k1[l * 64 + tid]);
      float b = wave_sum(P.lam_q2[l * 64 + tid] * P.lam_k2[l * 64 + tid]);
      float lam_init = 0.8f - 0.6f * expf(-0.3f * (float)l);
      if (tid == 0) WS_LAM(P)[l] = expf(a) - expf(b) + lam_init;
    }
    if (tid < 8) WS_CTR(P)[tid] = 0u;
  }
}

DEV void phase_norm_mod(const Params& P, const float* xlat, const float* xctx, int nrows, const float* g,
                        const float* modl, int sh_off, int sc_off) {
  const int lane = my_tid() & 63, wid = my_tid() >> 6;
  for (int row = blockIdx.x * 8 + wid; row < nrows; row += gridDim.x * 8) {
    const float* src = row < NLAT ? xlat + (size_t)row * 1024 : xctx + (size_t)(row - NLAT) * 1024;
    int cond = row < NLAT ? row >> 12 : 16;
    const float* md = modl + (size_t)cond * 6144;
    float4 v[4];
    float ss = 0.f;
#pragma unroll
    for (int i = 0; i < 4; ++i) {
      { f32x4 t4 = __builtin_nontemporal_load(reinterpret_cast<const f32x4*>(src + i * 256 + lane * 4)); v[i] = make_float4(t4[0], t4[1], t4[2], t4[3]); }
      ss += v[i].x * v[i].x + v[i].y * v[i].y + v[i].z * v[i].z + v[i].w * v[i].w;
    }
    ss = wave_sum(ss);
    float rstd = rsqrtf(ss * (1.f / 1024.f) + EPS);
#pragma unroll
    for (int i = 0; i < 4; ++i) {
      int cb = i * 256 + lane * 4;
      float4 gg = *reinterpret_cast<const float4*>(g + cb);
      float4 sh = *reinterpret_cast<const float4*>(md + sh_off + cb);
      float4 sc = *reinterpret_cast<const float4*>(md + sc_off + cb);
      float y0 = v[i].x * rstd * gg.x * (1.f + sc.x) + sh.x;
      float y1 = v[i].y * rstd * gg.y * (1.f + sc.y) + sh.y;
      float y2 = v[i].z * rstd * gg.z * (1.f + sc.z) + sh.z;
      float y3 = v[i].w * rstd * gg.w * (1.f + sc.w) + sh.w;
      *reinterpret_cast<uint2*>(WS_H(P) + (size_t)row * 1024 + cb) = make_uint2(pack2(y0, y1), pack2(y2, y3));
    }
  }
}

DEV void phase_final_norm(const Params& P) {
  const int lane = my_tid() & 63, wid = my_tid() >> 6;
  for (int row = blockIdx.x * 8 + wid; row < NLAT; row += gridDim.x * 8) {
    float* src = P.out + (size_t)row * 1024;
    float4 v[4];
    float ss = 0.f;
#pragma unroll
    for (int i = 0; i < 4; ++i) {
      { f32x4 t4 = __builtin_nontemporal_load(reinterpret_cast<const f32x4*>(src + i * 256 + lane * 4)); v[i] = make_float4(t4[0], t4[1], t4[2], t4[3]); }
      ss += v[i].x * v[i].x + v[i].y * v[i].y + v[i].z * v[i].z + v[i].w * v[i].w;
    }
    ss = wave_sum(ss);
    float rstd = rsqrtf(ss * (1.f / 1024.f) + EPS);
#pragma unroll
    for (int i = 0; i < 4; ++i) {
      int cb = i * 256 + lane * 4;
      float4 gg = *reinterpret_cast<const float4*>(P.g_final + cb);
      float4 o = make_float4(v[i].x * rstd * gg.x, v[i].y * rstd * gg.y, v[i].z * rstd * gg.z, v[i].w * rstd * gg.w);
      { f32x4 t4 = {o.x, o.y, o.z, o.w}; __builtin_nontemporal_store(t4, reinterpret_cast<f32x4*>(src + cb)); }
    }
  }
}

struct EpiInProj {
  const Params& P;
  int l;
  DEV void operator()(f32x4 (&acc)[8][4], int row0, int col0) const {
    const int lane = my_tid() & 63, fr = lane & 15, fq = lane >> 4;
    if (col0 >= 4416) return;
    if (col0 < C_WQ) {
#pragma unroll
      for (int mi = 0; mi < 8; ++mi)
#pragma unroll
        for (int ni = 0; ni < 4; ++ni)
#pragma unroll
          for (int j = 0; j < 4; ++j)
            WS_P(P)[(size_t)(row0 + mi * 16 + fq * 4 + j) * PW + col0 + ni * 16 + fr] = f2bf(acc[mi][ni][j]);
    } else if (col0 < 3712) {
      const bool isq = (col0 < C_WK) || (col0 >= C_DQ && col0 < C_DK);
      const float qs = isq ? 0.125f : 1.f;
#pragma unroll
      for (int mi = 0; mi < 8; ++mi)
#pragma unroll
        for (int j = 0; j < 4; ++j) {
          int row = row0 + mi * 16 + fq * 4 + j;
          u16* dst = WS_P(P) + (size_t)row * PW + col0 + fr;
          if (row < NLAT) {
            int t = row & (T - 1);
            const float2* rt = reinterpret_cast<const float2*>(WS_ROPE(P)) + t * 32;
#pragma unroll
            for (int hf = 0; hf < 2; ++hf) {
              float2 cs = rt[hf * 16 + fr];
              float x1 = acc[mi][hf * 2][j], x2 = acc[mi][hf * 2 + 1][j];
              dst[hf * 32] = f2bf((x1 * cs.x - x2 * cs.y) * qs);
              dst[hf * 32 + 16] = f2bf((x2 * cs.x + x1 * cs.y) * qs);
            }
          } else {
#pragma unroll
            for (int ni = 0; ni < 4; ++ni) dst[ni * 16] = f2bf(acc[mi][ni][j] * qs);
          }
        }
    } else if (col0 < 4352) {
      u16* base;
      int vrow0;
      const int hdW = (col0 - 3712) >> 6;
      const int hdD = (col0 - 3840) >> 7;
      const bool isw = col0 < 3840;
#pragma unroll
      for (int mi = 0; mi < 8; ++mi) {
        int row = row0 + mi * 16 + fq * 4;
        int b, key;
        if (row < NLAT) { b = row >> 12; key = 256 + (row & (T - 1)); }
        else { b = (row - NLAT) >> 8; key = (row - NLAT) & 255; }
        if (isw) { base = WS_VTW(P) + ((size_t)(b * 2 + hdW) * 64) * KEYS; vrow0 = 0; }
        else { base = WS_VTD(P) + ((size_t)(b * 4 + hdD) * 128) * KEYS; vrow0 = (col0 - 3840) & 127; }
#pragma unroll
        for (int ni = 0; ni < 4; ++ni) {
          int v = vrow0 + ni * 16 + fr;
          *reinterpret_cast<uint2*>(base + (size_t)v * KEYS + key) =
              make_uint2(pack2(acc[mi][ni][0], acc[mi][ni][1]), pack2(acc[mi][ni][2], acc[mi][ni][3]));
        }
      }
    } else {
      float bg = P.b_gate[l * 16 + fr];
#pragma unroll
      for (int mi = 0; mi < 8; ++mi)
#pragma unroll
        for (int j = 0; j < 4; ++j) WS_GATES(P)[(size_t)(row0 + mi * 16 + fq * 4 + j) * 16 + fr] = acc[mi][0][j] + bg;
    }
  }
};

template <int QB, int VB, int KW>
struct AttnCore {
  static constexpr int DV = 32 * VB;
  static constexpr int KST = KW * 2 + 16;
  static constexpr int VST = 128 + 16;
  static constexpr int KBYTES = 64 * KST, VBYTES = DV * VST;
  static constexpr int NKL = 64 * (KW / 8) / NTHREADS, NVL = DV * 8 / NTHREADS;
  static constexpr int TOTAL = 2 * (KBYTES + VBYTES);

  static DEV void run(const u16* qptr, int ldq, const u16* kctx, const u16* klat, int ldk, int kcol, const u16* vt,
                      int nctx, int nlat, int lat_t0, bool window, int qtok0, float m_init, float l_init,
                      f32x16 (&O)[QB][VB], char* smem) {
    const int tid = my_tid(), lane = tid & 63, r = lane & 31, hh = lane >> 5;
    char* Ks = smem;
    char* Vs = smem + 2 * KBYTES;
    bf16x8 qf[QB][4];
#pragma unroll
    for (int qb = 0; qb < QB; ++qb)
#pragma unroll
      for (int ks = 0; ks < 4; ++ks) qf[qb][ks] = ld16(qptr + (size_t)(qb * 32 + r) * ldq + ks * 16 + hh * 8);
    float m[QB], lsum[QB];
#pragma unroll
    for (int qb = 0; qb < QB; ++qb) {
      m[qb] = m_init;
      lsum[qb] = hh == 0 ? l_init : 0.f;
#pragma unroll
      for (int vb = 0; vb < VB; ++vb)
#pragma unroll
        for (int i = 0; i < 16; ++i) O[qb][vb][i] = 0.f;
    }
    bf16x8 rk[NKL], rv[NVL];
    const int ntiles = nctx + nlat;
    auto gload = [&](int j) {
      int kidx = j < nctx ? j * 64 : 256 + lat_t0 + (j - nctx) * 64;
      const u16* krow = j < nctx ? kctx + (size_t)(j * 64) * ldk : klat + (size_t)(lat_t0 + (j - nctx) * 64) * ldk;
#pragma unroll
      for (int i = 0; i < NKL; ++i) {
        int id = tid + i * NTHREADS, row = id / (KW / 8), c = id % (KW / 8);
        rk[i] = ld16(krow + (size_t)row * ldk + c * 8);
      }
#pragma unroll
      for (int i = 0; i < NVL; ++i) {
        int id = tid + i * NTHREADS, row = id >> 3, c = id & 7;
        rv[i] = ld16(vt + (size_t)row * KEYS + kidx + c * 8);
      }
    };
    auto lstore = [&](int buf) {
#pragma unroll
      for (int i = 0; i < NKL; ++i) {
        int id = tid + i * NTHREADS, row = id / (KW / 8), c = id % (KW / 8);
        *reinterpret_cast<bf16x8*>(Ks + buf * KBYTES + row * KST + c * 16) = rk[i];
      }
#pragma unroll
      for (int i = 0; i < NVL; ++i) {
        int id = tid + i * NTHREADS, row = id >> 3, c = id & 7;
        *reinterpret_cast<bf16x8*>(Vs + buf * VBYTES + row * VST + c * 16) = rv[i];
      }
    };
    __syncthreads();
    gload(0);
    lstore(0);
    __syncthreads();
    for (int j = 0; j < ntiles; ++j) {
      const int buf = j & 1;
      if (j + 1 < ntiles) gload(j + 1);
      bf16x8 pf[QB][2][2];
#pragma unroll
      for (int qb = 0; qb < QB; ++qb) {
        f32x16 S[2];
#pragma unroll
        for (int kb = 0; kb < 2; ++kb) {
#pragma unroll
          for (int i = 0; i < 16; ++i) S[kb][i] = 0.f;
#pragma unroll
          for (int ks = 0; ks < 4; ++ks) {
            bf16x8 kf = ld16(Ks + buf * KBYTES + (kb * 32 + pi32(r)) * KST + (kcol + ks * 16 + hh * 8) * 2);
            S[kb] = mfma32(kf, qf[qb][ks], S[kb]);
          }
        }
        __builtin_amdgcn_sched_barrier(0);
        if (window && j >= nctx) {
          int kt0 = lat_t0 + (j - nctx) * 64;
          int qt = qtok0 + qb * 32 + r;
#pragma unroll
          for (int kb = 0; kb < 2; ++kb)
#pragma unroll
            for (int i = 0; i < 16; ++i) {
              int kt = kt0 + kb * 32 + 16 * (i >> 3) + 8 * hh + (i & 7);
              int dlt = qt - kt;
              if (dlt > 128 || dlt < -128) S[kb][i] = -1e30f;
            }
        }
        float mloc = -1e30f;
#pragma unroll
        for (int kb = 0; kb < 2; ++kb)
#pragma unroll
          for (int i = 0; i < 16; ++i) mloc = fmaxf(mloc, S[kb][i]);
        mloc = fmaxf(mloc, __shfl_xor(mloc, 32));
        if (__any(mloc > m[qb] + 5.5f)) {
          float mnew = fmaxf(m[qb], mloc);
          float alpha = fexp2((m[qb] - mnew) * L2E);
          m[qb] = mnew;
          lsum[qb] *= alpha;
#pragma unroll
          for (int vb = 0; vb < VB; ++vb)
#pragma unroll
            for (int i = 0; i < 16; ++i) O[qb][vb][i] *= alpha;
        }
        float mb = m[qb] * L2E, ps = 0.f;
#pragma unroll
        for (int kb = 0; kb < 2; ++kb) {
          float pv[16];
#pragma unroll
          for (int i = 0; i < 16; ++i) {
            pv[i] = fexp2(S[kb][i] * L2E - mb);
            ps += pv[i];
          }
#pragma unroll
          for (int s = 0; s < 2; ++s)
            pf[qb][kb][s] = mk8(pack2(pv[8 * s], pv[8 * s + 1]), pack2(pv[8 * s + 2], pv[8 * s + 3]),
                                pack2(pv[8 * s + 4], pv[8 * s + 5]), pack2(pv[8 * s + 6], pv[8 * s + 7]));
        }
        lsum[qb] += ps;
        __builtin_amdgcn_sched_barrier(0);
      }
      __builtin_amdgcn_sched_barrier(0);
#pragma unroll
      for (int vb = 0; vb < VB; ++vb) {
#pragma unroll
        for (int kb = 0; kb < 2; ++kb)
#pragma unroll
          for (int s = 0; s < 2; ++s) {
            bf16x8 vf = ld16(Vs + buf * VBYTES + (vb * 32 + r) * VST + (kb * 32 + s * 16 + hh * 8) * 2);
#pragma unroll
            for (int qb = 0; qb < QB; ++qb) O[qb][vb] = mfma32(vf, pf[qb][kb][s], O[qb][vb]);
          }
        __builtin_amdgcn_sched_barrier(0);
      }
      if (j + 1 < ntiles) lstore(buf ^ 1);
      __syncthreads();
    }
#pragma unroll
    for (int qb = 0; qb < QB; ++qb) {
      float lt = lsum[qb] + __shfl_xor(lsum[qb], 32);
      float inv = __builtin_amdgcn_rcpf(lt);
#pragma unroll
      for (int vb = 0; vb < VB; ++vb)
#pragma unroll
        for (int i = 0; i < 16; ++i) O[qb][vb][i] *= inv;
    }
  }
};

DEV void diff_item(const Params& P, int l, int b, int h, int qt, bool ctxq, char* smem) {
  const int tid = my_tid(), lane = tid & 63, wid = tid >> 6, r = lane & 31, hh = lane >> 5;
  const int comp = wid >> 2, wq = wid & 3;
  const int rowbase = ctxq ? NLAT + b * 256 + qt * 128 : b * T + qt * 128;
  const u16* qptr = WS_P(P) + (size_t)(rowbase + wq * 32) * PW + C_DQ + h * 128 + comp * 64;
  const u16* kctx = WS_P(P) + (size_t)(NLAT + b * 256) * PW + C_DK + h * 128;
  const u16* klat = WS_P(P) + (size_t)(b * T) * PW + C_DK + h * 128;
  const u16* vt = WS_VTD(P) + ((size_t)(b * 4 + h) * 128) * KEYS;
  f32x16 O[1][4];
  AttnCore<1, 4, 128>::run(qptr, PW, kctx, klat, PW, comp * 64, vt, 4, ctxq ? 0 : 64, 0, false, 0, -1e30f, 0.f, O, smem);
  float* ex = reinterpret_cast<float*>(smem);
  __syncthreads();
  if (comp == 1) {
#pragma unroll
    for (int vb = 0; vb < 4; ++vb)
#pragma unroll
      for (int i = 0; i < 16; ++i) ex[(wq * 64 + vb * 16 + i) * 64 + lane] = O[0][vb][i];
  }
  __syncthreads();
  if (comp == 0) {
    const float lam = WS_LAM(P)[l];
    const float lam_init = 0.8f - 0.6f * expf(-0.3f * (float)l);
    float ss = 0.f;
#pragma unroll
    for (int vb = 0; vb < 4; ++vb)
#pragma unroll
      for (int i = 0; i < 16; ++i) {
        float y = O[0][vb][i] - lam * ex[(wq * 64 + vb * 16 + i) * 64 + lane];
        O[0][vb][i] = y;
        ss += y * y;
      }
    ss += __shfl_xor(ss, 32);
    float sc = rsqrtf(ss * (1.f / 128.f) + EPS) * (1.f - lam_init);
    const float* dn = P.d_norm + l * 512 + h * 128;
    u16* dst = WS_P(P) + (size_t)(rowbase + wq * 32 + r) * PW + C_DQ + h * 128;
#pragma unroll
    for (int vb = 0; vb < 4; ++vb)
#pragma unroll
      for (int g4 = 0; g4 < 4; ++g4) {
        int v = vb * 32 + g4 * 8 + hh * 4;
        float4 w = *reinterpret_cast<const float4*>(dn + v);
        *reinterpret_cast<uint2*>(dst + v) =
            make_uint2(pack2(O[0][vb][g4 * 4] * sc * w.x, O[0][vb][g4 * 4 + 1] * sc * w.y),
                       pack2(O[0][vb][g4 * 4 + 2] * sc * w.z, O[0][vb][g4 * 4 + 3] * sc * w.w));
      }
  }
  __syncthreads();
}

DEV void win_item(const Params& P, int l, int b, int g, int qb, bool ctxq, char* smem) {
  const int tid = my_tid(), lane = tid & 63, wid = tid >> 6, r = lane & 31, hh = lane >> 5;
  const int hr = wid >> 1, qh = wid & 1;
  const int head = g * 4 + hr;
  const int rowbase = (ctxq ? NLAT + b * 256 + qb * 64 : b * T + qb * 64) + qh * 32;
  const u16* qptr = WS_P(P) + (size_t)rowbase * PW + C_WQ + head * 64;
  const u16* kctx = WS_P(P) + (size_t)(NLAT + b * 256) * PW + C_WK + g * 64;
  const u16* klat = WS_P(P) + (size_t)(b * T) * PW + C_WK + g * 64;
  const u16* vt = WS_VTW(P) + ((size_t)(b * 2 + g) * 64) * KEYS;
  int t0 = 0, nlat = 0;
  if (!ctxq) {
    t0 = qb * 64 - 128;
    if (t0 < 0) t0 = 0;
    int t1 = qb * 64 + 192;
    if (t1 > T) t1 = T;
    nlat = (t1 - t0) >> 6;
  }
  f32x16 O[1][2];
  AttnCore<1, 2, 64>::run(qptr, PW, kctx, klat, PW, 0, vt, 4, nlat, t0, !ctxq, qb * 64 + qh * 32, P.sink[l * 8 + head], 1.f, O, smem);
  u16* dst = WS_P(P) + (size_t)(rowbase + r) * PW + C_WQ + head * 64;
#pragma unroll
  for (int vb = 0; vb < 2; ++vb)
#pragma unroll
    for (int g4 = 0; g4 < 4; ++g4) {
      int v = vb * 32 + g4 * 8 + hh * 4;
      *reinterpret_cast<uint2*>(dst + v) = make_uint2(pack2(O[0][vb][g4 * 4], O[0][vb][g4 * 4 + 1]),
                                                        pack2(O[0][vb][g4 * 4 + 2], O[0][vb][g4 * 4 + 3]));
    }
}

DEV void mlstm_item(const Params& P, int l, int b, int hd, int dir, bool need_ctx, char* smem) {
  const int tid = my_tid(), lane = tid & 63, wid = tid >> 6, r = lane & 31, hh = lane >> 5;
  constexpr int QST = 272, TST = 144;
  char* Qs = smem;
  char* Ks = Qs + 64 * QST;
  char* KwT = Ks + 64 * QST;
  char* VT = KwT + 128 * TST;
  char* Sp = VT + 128 * TST;
  char* Rq = Sp + 64 * TST;
  char* Rk = Rq + 66 * QST;
  float* fb = reinterpret_cast<float*>(Rk + 66 * QST);
  float* sb = fb;
  float* sa = fb + 64;
  float* sM = fb + 128;
  float* denp = fb + 192;
  float* qn = fb + 320;
  float* nb = fb + 384;
  float* cw = fb + 640;
  __syncthreads();
  if (tid < 256) nb[tid] = 0.f;
  for (int i = tid; i < 768; i += NTHREADS) {
    int qk = i / 384, tap = (i % 384) / 128, d = i & 127;
    cw[i] = P.conv_w[(size_t)l * 3 * 1024 + tap * 1024 + qk * 512 + hd * 128 + d];
  }
  f32x16 CT[4];
#pragma unroll
  for (int kb = 0; kb < 4; ++kb)
#pragma unroll
    for (int i = 0; i < 16; ++i) CT[kb][i] = 0.f;
  float mstate = 0.f;
  u16* hout = WS_HFB(P) + (size_t)dir * MTOT * 512;
  const float kscale = 0.08838834764831845f;

  auto geom = [&](int step, int& seg0, int& seglen, int& u0) {
    int c;
    if (step < 4) { seg0 = NLAT + b * 256; seglen = 256; c = dir ? 3 - step : step; }
    else { seg0 = b * T; seglen = T; c = dir ? 67 - step : step - 4; }
    u0 = c * 64;
  };
  bf16x8 pq[3], pk[3], pvv[2];
  float pig = 0.f, pfg = 0.f;
  auto issue_loads = [&](int step) {
    int seg0, seglen, u0;
    geom(step, seg0, seglen, u0);
#pragma unroll
    for (int i = 0; i < 3; ++i) {
      int id = tid + i * NTHREADS;
      bf16x8 z = {0, 0, 0, 0, 0, 0, 0, 0};
      pq[i] = z;
      pk[i] = z;
      if (id < 66 * 16) {
        int row = id >> 4, cc = id & 15;
        int uu = u0 + row - 1;
        bool ok = uu >= 0 && uu < seglen;
        const u16* src = WS_P(P) + (size_t)(seg0 + (ok ? uu : 0)) * PW + hd * 128 + cc * 8;
        if (ok) { pq[i] = ld16(src + C_MQ); pk[i] = ld16(src + C_MK); }
      }
    }
#pragma unroll
    for (int i = 0; i < 2; ++i) {
      int id = tid + i * NTHREADS, u = id >> 4, cc = id & 15;
      pvv[i] = ld16(WS_P(P) + (size_t)(seg0 + u0 + u) * PW + C_MV + hd * 128 + cc * 8);
    }
    if (wid == 0) {
      const int pos = dir ? 63 - lane : lane;
      const float* gp = WS_GATES(P) + (size_t)(seg0 + u0 + pos) * 16;
      pig = gp[(dir * 2) * 4 + hd];
      pfg = gp[(dir * 2 + 1) * 4 + hd];
    }
  };
  issue_loads(0);

  for (int step = 0; step < 68; ++step) {
    int seg0, seglen, u0;
    geom(step, seg0, seglen, u0);
    const int rowbase = seg0 + u0;
    const int cur = step & 1;
    __syncthreads();
    bf16x8 rvv[2];
#pragma unroll
    for (int i = 0; i < 3; ++i) {
      int id = tid + i * NTHREADS;
      if (id < 66 * 16) {
        int row = id >> 4, cc = id & 15;
        *reinterpret_cast<bf16x8*>(Rq + row * QST + cc * 16) = pq[i];
        *reinterpret_cast<bf16x8*>(Rk + row * QST + cc * 16) = pk[i];
      }
    }
    rvv[0] = pvv[0];
    rvv[1] = pvv[1];
    const float ig = pig, fg = pfg;
    if (step + 1 < 68) issue_loads(step + 1);
    if (wid == 0) {
      const int pos = dir ? 63 - lane : lane;
      float lf = fminf(fg, 0.f) - __logf(1.f + __expf(-fabsf(fg)));
      float bsum = lf;
#pragma unroll
      for (int o = 1; o < 64; o <<= 1) { float t2 = __shfl_up(bsum, o); if (lane >= o) bsum += t2; }
      float a = ig - bsum, am = a;
#pragma unroll
      for (int o = 1; o < 64; o <<= 1) { float t2 = __shfl_up(am, o); if (lane >= o) am = fmaxf(am, t2); }
      sb[pos] = bsum;
      sa[pos] = a;
      sM[pos] = fmaxf(mstate, am);
    }
    __syncthreads();
    const int eidx = dir ? 0 : 63;
    const float Mend = sM[eidx], bend = sb[eidx];
    const float decay = __expf(mstate - Mend);
#pragma unroll
    for (int i = 0; i < 2; ++i) {
      int id = tid + i * NTHREADS, u = id >> 4, cc = id & 15;
      float wend = __expf(sa[u] - Mend);
      const int tbase = cc * 8 * TST + (((u >> 3) ^ (cc & 7)) << 4) + (u & 7) * 2;
      uint32_t qo[4], ko[4];
      float kv[8], xq[8], xk[8];
#pragma unroll
      for (int e = 0; e < 8; ++e) { xq[e] = 0.f; xk[e] = 0.f; }
#pragma unroll
      for (int tap = 0; tap < 3; ++tap) {
        const bf16x8 qr = ld16(Rq + (u + tap) * QST + cc * 16), kr = ld16(Rk + (u + tap) * QST + cc * 16);
        const float4 wq0 = *reinterpret_cast<const float4*>(cw + tap * 128 + cc * 8), wq1 = *reinterpret_cast<const float4*>(cw + tap * 128 + cc * 8 + 4);
        const float4 wk0 = *reinterpret_cast<const float4*>(cw + 384 + tap * 128 + cc * 8), wk1 = *reinterpret_cast<const float4*>(cw + 384 + tap * 128 + cc * 8 + 4);
        const float wq[8] = {wq0.x, wq0.y, wq0.z, wq0.w, wq1.x, wq1.y, wq1.z, wq1.w};
        const float wk[8] = {wk0.x, wk0.y, wk0.z, wk0.w, wk1.x, wk1.y, wk1.z, wk1.w};
#pragma unroll
        for (int e = 0; e < 8; ++e) {
          xq[e] += wq[e] * bf2f((u16)qr[e]);
          xk[e] += wk[e] * bf2f((u16)kr[e]);
        }
      }
#pragma unroll
      for (int e = 0; e < 8; ++e) {
        float qv = xq[e] * __builtin_amdgcn_rcpf(1.f + __expf(-xq[e]));
        kv[e] = xk[e] * __builtin_amdgcn_rcpf(1.f + __expf(-xk[e])) * kscale;
        if (e & 1) { qo[e >> 1] |= ((uint32_t)f2bf(qv)) << 16; ko[e >> 1] |= ((uint32_t)f2bf(kv[e])) << 16; }
        else { qo[e >> 1] = f2bf(qv); ko[e >> 1] = f2bf(kv[e]); }
        *reinterpret_cast<u16*>(KwT + tbase + e * TST) = f2bf(kv[e] * wend);
        *reinterpret_cast<u16*>(VT + tbase + e * TST) = (u16)rvv[i][e];
      }
      *reinterpret_cast<uint4*>(Qs + u * QST + cc * 16) = make_uint4(qo[0], qo[1], qo[2], qo[3]);
      *reinterpret_cast<uint4*>(Ks + u * QST + cc * 16) = make_uint4(ko[0], ko[1], ko[2], ko[3]);
    }
    __syncthreads();
    if (wid < 4) {
      const int sblk = wid & 1, tblk = wid >> 1;
      f32x16 S;
#pragma unroll
      for (int i = 0; i < 16; ++i) S[i] = 0.f;
#pragma unroll
      for (int ks = 0; ks < 8; ++ks) {
        bf16x8 kf = ld16(Ks + (sblk * 32 + pi32(r)) * QST + (ks * 16 + hh * 8) * 2);
        bf16x8 qf = ld16(Qs + (tblk * 32 + r) * QST + (ks * 16 + hh * 8) * 2);
        S = mfma32(kf, qf, S);
      }
      const int t = tblk * 32 + r;
      const float Mt = sM[t];
      float ds = 0.f, val[16];
#pragma unroll
      for (int i = 0; i < 16; ++i) {
        int s = sblk * 32 + 16 * (i >> 3) + 8 * hh + (i & 7);
        bool ok = dir ? (s >= t) : (s <= t);
        val[i] = ok ? S[i] * __expf(sa[s] - Mt) : 0.f;
        ds += val[i];
      }
      ds += __shfl_xor(ds, 32);
      if (hh == 0) denp[sblk * 64 + t] = ds;
#pragma unroll
      for (int s2 = 0; s2 < 2; ++s2)
        *reinterpret_cast<uint4*>(Sp + t * TST + (sblk * 32 + s2 * 16 + hh * 8) * 2) =
            make_uint4(pack2(val[8 * s2], val[8 * s2 + 1]), pack2(val[8 * s2 + 2], val[8 * s2 + 3]),
                       pack2(val[8 * s2 + 4], val[8 * s2 + 5]), pack2(val[8 * s2 + 6], val[8 * s2 + 7]));
    } else if (wid == 4) {
      float s = 0.f;
      const float* nc = nb + cur * 128;
      for (int k8 = 0; k8 < 16; ++k8) {
        bf16x8 qv = ld16(Qs + lane * QST + k8 * 16);
#pragma unroll
        for (int e = 0; e < 8; ++e) s += nc[k8 * 8 + e] * bf2f((u16)qv[e]);
      }
      qn[lane] = s;
    } else if (wid == 5) {
      const float* nc = nb + cur * 128;
      float* nn = nb + (cur ^ 1) * 128;
#pragma unroll
      for (int q2 = 0; q2 < 2; ++q2) {
        int k = lane + q2 * 64;
        float s = 0.f;
        for (int s8 = 0; s8 < 8; ++s8) {
          bf16x8 kv = ld16(KwT + k * TST + s8 * 16);
#pragma unroll
          for (int e = 0; e < 8; ++e) s += bf2f((u16)kv[e]);
        }
        nn[k] = decay * nc[k] + s;
      }
    }
    __syncthreads();
    {
      bf16x8 vf[4];
      const int vb = wid & 3, tb = wid >> 2;
#pragma unroll
      for (int ks = 0; ks < 4; ++ks) vf[ks] = ld16(VT + (vb * 32 + r) * TST + (((ks * 2 + hh) ^ ((r >> 3) | ((vb & 1) << 2))) << 4));
      const bool wr_h = (step >= 4) || need_ctx;
      {
        const int t = tb * 32 + r;
        f32x16 acc;
#pragma unroll
        for (int i = 0; i < 16; ++i) acc[i] = 0.f;
#pragma unroll
        for (int kb = 0; kb < 4; ++kb)
#pragma unroll
          for (int s2 = 0; s2 < 2; ++s2) {
            bf16x8 af = mk8(pack2(CT[kb][8 * s2], CT[kb][8 * s2 + 1]), pack2(CT[kb][8 * s2 + 2], CT[kb][8 * s2 + 3]),
                            pack2(CT[kb][8 * s2 + 4], CT[kb][8 * s2 + 5]), pack2(CT[kb][8 * s2 + 6], CT[kb][8 * s2 + 7]));
            uint2 lo = *reinterpret_cast<const uint2*>(Qs + t * QST + (kb * 32 + s2 * 16 + hh * 4) * 2);
            uint2 hi = *reinterpret_cast<const uint2*>(Qs + t * QST + (kb * 32 + s2 * 16 + 8 + hh * 4) * 2);
            acc = mfma32(af, mk8(lo.x, lo.y, hi.x, hi.y), acc);
          }
        const float Mt = sM[t];
        const float winter = __expf(mstate - Mt);
#pragma unroll
        for (int i = 0; i < 16; ++i) acc[i] *= winter;
#pragma unroll
        for (int ks = 0; ks < 4; ++ks) {
          bf16x8 sf = ld16(Sp + t * TST + (ks * 16 + hh * 8) * 2);
          acc = mfma32(vf[ks], sf, acc);
        }
        float den = denp[t] + denp[64 + t] + winter * qn[t];
        float sc = __builtin_amdgcn_rcpf(fmaxf(fabsf(den), __expf(-(sb[t] + Mt))));
        if (wr_h) {
          u16* dst = hout + (size_t)(rowbase + t) * 512 + hd * 128 + vb * 32;
#pragma unroll
          for (int g4 = 0; g4 < 4; ++g4)
            *reinterpret_cast<uint2*>(dst + g4 * 8 + hh * 4) =
                make_uint2(pack2(acc[g4 * 4] * sc, acc[g4 * 4 + 1] * sc), pack2(acc[g4 * 4 + 2] * sc, acc[g4 * 4 + 3] * sc));
        }
      }
#pragma unroll
      for (int kb = 0; kb < 4; ++kb) {
#pragma unroll
        for (int i = 0; i < 16; ++i) CT[kb][i] *= decay;
#pragma unroll
        for (int ks = 0; ks < 4; ++ks) {
          bf16x8 kf = ld16(KwT + (kb * 32 + r) * TST + (((ks * 2 + hh) ^ ((r >> 3) | ((kb & 1) << 2))) << 4));
          CT[kb] = mfma32(kf, vf[ks], CT[kb]);
        }
      }
    }
    mstate = bend + Mend;
  }
  __syncthreads();
}

DEV int next_item(unsigned* ctr, int* s_item) {
  __syncthreads();
  if (my_tid() == 0) *s_item = (int)atomicAdd(ctr, 1u);
  __syncthreads();
  return *s_item;
}
DEV void phase_mixers(const Params& P, int l, char* smem) {
  const bool need_ctx = (l == 0);
  __shared__ int s_item;
  const int n_ml = 128, n_diff = 2048, n_win = 2048, n_dc = need_ctx ? 128 : 0, n_wc = need_ctx ? 128 : 0;
  for (;;) {
    int it = next_item(&WS_CTR(P)[l * 4 + 0], &s_item);
    if (it >= n_ml) break;
    mlstm_item(P, l, it >> 3, (it >> 1) & 3, it & 1, need_ctx, smem);
  }
  for (;;) {
    int it = next_item(&WS_CTR(P)[l * 4 + 1], &s_item);
    if (it >= n_diff + n_dc) break;
    bool cq = it >= n_diff;
    int i2 = it - n_diff;
    int b = cq ? i2 >> 3 : it >> 7, hd = cq ? (i2 >> 1) & 3 : (it >> 5) & 3, qt = cq ? i2 & 1 : it & 31;
    diff_item(P, l, b, hd, qt, cq, smem);
  }
  for (;;) {
    int it = next_item(&WS_CTR(P)[l * 4 + 2], &s_item);
    if (it >= n_win + n_wc) break;
    bool cq = it >= n_win;
    int i2 = it - n_win;
    int b = cq ? i2 >> 3 : it >> 7, g = cq ? (i2 >> 2) & 1 : (it >> 6) & 1, qb = cq ? i2 & 3 : it & 63;
    win_item(P, l, b, g, qb, cq, smem);
  }
}

DEV void phase_ya(const Params& P, int l, int nrows) {
  const int lane = my_tid() & 63, wid = my_tid() >> 6;
  const u16* hf = WS_HFB(P);
  const u16* hb = WS_HFB(P) + (size_t)MTOT * 512;
  for (int row = blockIdx.x * 8 + wid; row < nrows; row += gridDim.x * 8) {
    uint4 a = *reinterpret_cast<const uint4*>(hf + (size_t)row * 512 + lane * 8);
    uint4 bq = *reinterpret_cast<const uint4*>(hb + (size_t)row * 512 + lane * 8);
    uint4 o = *reinterpret_cast<const uint4*>(WS_P(P) + (size_t)row * PW + C_MO + lane * 8);
    uint32_t aa[4] = {a.x, a.y, a.z, a.w}, bb[4] = {bq.x, bq.y, bq.z, bq.w}, oo[4] = {o.x, o.y, o.z, o.w};
    float y[8], ss = 0.f;
#pragma unroll
    for (int j = 0; j < 4; ++j) {
      y[2 * j] = (bflo(aa[j]) + bflo(bb[j])) * sigmoidf_(bflo(oo[j]));
      y[2 * j + 1] = (bfhi(aa[j]) + bfhi(bb[j])) * sigmoidf_(bfhi(oo[j]));
      ss += y[2 * j] * y[2 * j] + y[2 * j + 1] * y[2 * j + 1];
    }
#pragma unroll
    for (int of = 1; of < 16; of <<= 1) ss += __shfl_xor(ss, of);
    float rstd = rsqrtf(ss * (1.f / 128.f) + EPS);
    const float* mn = P.m_norm + l * 512 + lane * 8;
    uint32_t w[4];
#pragma unroll
    for (int j = 0; j < 4; ++j) w[j] = pack2(y[2 * j] * rstd * mn[2 * j], y[2 * j + 1] * rstd * mn[2 * j + 1]);
    *reinterpret_cast<uint4*>(WS_P(P) + (size_t)row * PW + C_MO + lane * 8) = make_uint4(w[0], w[1], w[2], w[3]);
  }
}

DEV void phase_merge(const Params& P, int l, int M, char* smem) {
  const u16* Wl = WS_W(P) + (size_t)l * W_LAYER;
  u16* merged = WS_HFB(P);
  const int nM = M / 128, nN = 4;
  const int lane = my_tid() & 63, wid = my_tid() >> 6, wr = wid >> 2, wc = wid & 3, fr = lane & 15, fq = lane >> 4;
  for (int tile = blockIdx.x; tile < nM * nN; tile += gridDim.x) {
    int tm, tn;
    tile_coords(tile, nM * nN, nN, tm, tn);
    f32x4 mg[4][4];
    zero_acc<4, 4>(mg);
#pragma unroll 1
    for (int i = 0; i < 3; ++i) {
      f32x4 acc[4][4];
      zero_acc<4, 4>(acc);
      gemm_mainloop64(WS_H(P) + (size_t)tm * 128 * 1024, 1024, Wl + W_G + (size_t)(i * 1024 + tn * 256) * 1024, 1024, 1024, acc, smem);
      uint32_t gp[4][4][2];
#pragma unroll
      for (int mi = 0; mi < 4; ++mi)
#pragma unroll
        for (int ni = 0; ni < 4; ++ni) {
          gp[mi][ni][0] = pack2(sigmoidf_(acc[mi][ni][0]), sigmoidf_(acc[mi][ni][1]));
          gp[mi][ni][1] = pack2(sigmoidf_(acc[mi][ni][2]), sigmoidf_(acc[mi][ni][3]));
        }
      zero_acc<4, 4>(acc);
      int yc = i == 0 ? C_MO : (i == 1 ? C_WQ : C_DQ);
      gemm_mainloop64(WS_P(P) + (size_t)tm * 128 * PW + yc, PW, Wl + W_B + (size_t)i * 1024 * 512 + (size_t)(tn * 256) * 512, 512, 512, acc, smem);
#pragma unroll
      for (int mi = 0; mi < 4; ++mi)
#pragma unroll
        for (int ni = 0; ni < 4; ++ni) {
          mg[mi][ni][0] += bflo(gp[mi][ni][0]) * acc[mi][ni][0];
          mg[mi][ni][1] += bfhi(gp[mi][ni][0]) * acc[mi][ni][1];
          mg[mi][ni][2] += bflo(gp[mi][ni][1]) * acc[mi][ni][2];
          mg[mi][ni][3] += bfhi(gp[mi][ni][1]) * acc[mi][ni][3];
        }
    }
    const int row0 = tm * 128 + wr * 64, col0 = tn * 256 + wc * 64;
#pragma unroll
    for (int mi = 0; mi < 4; ++mi)
#pragma unroll
      for (int ni = 0; ni < 4; ++ni)
#pragma unroll
        for (int j = 0; j < 4; ++j)
          merged[(size_t)(row0 + mi * 16 + fq * 4 + j) * 1024 + col0 + ni * 16 + fr] = f2bf(mg[mi][ni][j]);
  }
}

struct EpiResid {
  const Params& P;
  const float* src_lat;
  const float* modl;
  int gt_off;
  DEV void operator()(f32x4 (&acc)[8][4], int row0, int col0) const {
    const int lane = my_tid() & 63, fr = lane & 15, fq = lane >> 4;
#pragma unroll
    for (int mi = 0; mi < 8; ++mi)
#pragma unroll
      for (int j = 0; j < 4; ++j) {
        int row = row0 + mi * 16 + fq * 4 + j;
        const float* src;
        float* dst;
        int cond;
        if (row < NLAT) { src = src_lat + (size_t)row * 1024; dst = P.out + (size_t)row * 1024; cond = row >> 12; }
        else { src = WS_XC(P) + (size_t)(row - NLAT) * 1024; dst = WS_XC(P) + (size_t)(row - NLAT) * 1024; cond = 16; }
        const float* gt = modl + (size_t)cond * 6144 + gt_off;
#pragma unroll
        for (int ni = 0; ni < 4; ++ni) {
          int col = col0 + ni * 16 + fr;
          dst[col] = src[col] + gt[col] * acc[mi][ni][j];
        }
      }
  }
};

struct EpiSwiglu {
  u16* act;
  DEV void operator()(f32x4 (&acc)[8][4], int row0, int col0) const {
    const int lane = my_tid() & 63, fr = lane & 15, fq = lane >> 4;
#pragma unroll
    for (int mi = 0; mi < 8; ++mi)
#pragma unroll
      for (int j = 0; j < 4; ++j) {
        int row = row0 + mi * 16 + fq * 4 + j;
#pragma unroll
        for (int pr = 0; pr < 2; ++pr) {
          float gte = acc[mi][pr * 2][j], up = acc[mi][pr * 2 + 1][j];
          act[(size_t)row * FH + ((col0 + pr * 32) >> 1) + fr] = f2bf(siluf_(gte) * up);
        }
      }
  }
};


namespace pg8 {
#define PG8_LAS __attribute__((address_space(3)))
constexpr int BM = 256, BK = 64, HALF = 128, HTB = HALF * BK * 2, NXCD = 8, WGM = 8;
DEV int lds_byte(int r, int c) { const int st = (r >> 4) * 2 + (c >> 5), rr = r & 15, cc = c & 31, ob = rr * 64 + cc * 2; return st * 1024 + (ob ^ (((ob >> 9) & 1) << 5)); }
DEV void stage_rc(int b, int& R, int& C) { const int st = b / 1024, sb = b % 1024, swz = sb ^ (((sb >> 9) & 1) << 5); R = (st >> 1) * 16 + swz / 64; C = (st & 1) * 32 + (swz % 64) / 2; }
struct Unit { int pm, pn; };
struct StaticOrder {
  int nM, nN, nwg, G, c;
  DEV void init(int M, int N, int G_, int c_) { nM = M / BM; nN = N / BM; nwg = nM * nN; G = G_; c = c_; }
  DEV bool next(int i, Unit& u) const {
    const long L = (long)i * G + c;
    if (L >= nwg) return false;
    int wgid = (int)L;
    { const int q = nwg / NXCD, r = nwg % NXCD, xcd = wgid % NXCD, off = wgid / NXCD; wgid = (xcd < r ? xcd * (q + 1) : r * (q + 1) + (xcd - r) * q) + off; }
    const int nig = WGM * nN, gid = wgid / nig, fm = gid * WGM, gsz = (nM - fm) < WGM ? (nM - fm) : WGM;
    u.pm = fm + ((wgid % nig) % gsz);
    u.pn = (wgid % nig) / gsz;
    return true;
  }
};
template <class Epi>
DEV void gemm_phase(char* smem, const u16* A, int lda, const u16* Bt, int ldb, int M, int N, int K, const Epi& E) {
  PG8_LAS unsigned char* lds = (PG8_LAS unsigned char*)smem;
  const int tid = my_tid(), wid = __builtin_amdgcn_readfirstlane(tid >> 6), lane = tid & 63, wr = wid >> 2, wc = wid & 3, fr = lane & 15, fq = lane >> 4;
  const int nt = K / BK;
  StaticOrder S;
  S.init(M, N, gridDim.x, blockIdx.x);
  unsigned voffA[2], voffB[2];
#pragma unroll
  for (int i = 0; i < 2; ++i) { int R, C; stage_rc(tid * 16 + i * 8192, R, C); voffA[i] = (unsigned)(R * lda + C) * 2u; voffB[i] = (unsigned)(R * ldb + C) * 2u; }
  const size_t kstep = (size_t)(BK * 2);
  const size_t hstepA = (size_t)HALF * lda * 2, hstepB = (size_t)HALF * ldb * 2;
  const size_t tstepA = 2 * hstepA, tstepB = 2 * hstepB;
  const unsigned ldsw = (unsigned)wid * 1024u;
  const int aoff = lds_byte(wr * 64 + fr, fq * 8), boff = lds_byte(wc * 32 + fr, fq * 8);
#define PG8_SA(b, h) (((b) * 2 + (h)) * HTB)
#define PG8_SB(b, h) ((4 + (b) * 2 + (h)) * HTB)
#define PG8_STAGE(bufoff, gbase, voff) do { _Pragma("unroll") for (int _i = 0; _i < 2; ++_i) \
        __builtin_amdgcn_global_load_lds((const unsigned*)((const char*)(gbase) + (voff)[_i]), (PG8_LAS unsigned*)(lds + (bufoff) + ldsw + _i * 8192), 16, 0, 0); } while (0)
#define PG8_LDA(dst, b, h) do { _Pragma("unroll") for (int m = 0; m < 4; ++m) _Pragma("unroll") for (int k = 0; k < 2; ++k) dst[m][k] = *(const PG8_LAS bf16x8*)(lds + PG8_SA(b, h) + aoff + m * 2048 + k * 1024); } while (0)
#define PG8_LDB(dst, b, h) do { _Pragma("unroll") for (int n = 0; n < 2; ++n) _Pragma("unroll") for (int k = 0; k < 2; ++k) dst[n][k] = *(const PG8_LAS bf16x8*)(lds + PG8_SB(b, h) + boff + n * 2048 + k * 1024); } while (0)
#define PG8_MMA(ai, bj, At, Bt_) do { __builtin_amdgcn_s_setprio(1); _Pragma("unroll") for (int m = 0; m < 4; ++m) _Pragma("unroll") for (int n = 0; n < 2; ++n) _Pragma("unroll") for (int k = 0; k < 2; ++k) \
        acc[ai][bj][m][n] = __builtin_amdgcn_mfma_f32_16x16x32_bf16(Bt_[n][k], At[m][k], acc[ai][bj][m][n], 0, 0, 0); __builtin_amdgcn_s_setprio(0); } while (0)
#define PG8_WAIT_V(n) asm volatile("s_waitcnt vmcnt(" #n ")" ::: "memory")
#define PG8_WAIT_L(n) asm volatile("s_waitcnt lgkmcnt(" #n ")" ::: "memory")
#define PG8_BAR __builtin_amdgcn_s_barrier()
#define PG8_SCHED __builtin_amdgcn_sched_barrier(0)
  Unit cur, nxt;
  int ui = 0;
  PG8_WAIT_V(0);
  __syncthreads();
  if (!S.next(0, cur)) return;
  f32x4 acc[2][2][4][2];
#pragma unroll
  for (int a = 0; a < 2; ++a)
#pragma unroll
    for (int b = 0; b < 2; ++b)
#pragma unroll
      for (int m = 0; m < 4; ++m)
#pragma unroll
        for (int n = 0; n < 2; ++n) acc[a][b][m][n] = (f32x4){0.f, 0.f, 0.f, 0.f};
  bf16x8 At[4][2], B0[2][2], B1[2][2];
  const char* cA = (const char*)A + (size_t)cur.pm * tstepA;
  const char* cB = (const char*)Bt + (size_t)cur.pn * tstepB;
  PG8_STAGE(PG8_SB(0, 0), cB, voffB); PG8_STAGE(PG8_SA(0, 0), cA, voffA); PG8_STAGE(PG8_SB(0, 1), cB + hstepB, voffB); PG8_STAGE(PG8_SA(0, 1), cA + hstepA, voffA);
  if (wr == 1) PG8_BAR;
  PG8_WAIT_V(4); PG8_BAR;
  PG8_STAGE(PG8_SB(1, 0), cB + kstep, voffB); PG8_STAGE(PG8_SA(1, 0), cA + kstep, voffA); PG8_STAGE(PG8_SB(1, 1), cB + hstepB + kstep, voffB);
  PG8_WAIT_V(6); PG8_BAR;
  for (;;) {
    const bool has_next = S.next(ui + 1, nxt);
    const char* nA = has_next ? (const char*)A + (size_t)nxt.pm * tstepA : cA;
    const char* nB = has_next ? (const char*)Bt + (size_t)nxt.pn * tstepB : cB;
    for (int t = 0; t < nt; t += 2) {
      const bool last = (t == nt - 2);
      const char* a1 = cA + (size_t)(t + 1) * kstep;
      const char* a2 = last ? nA : cA + (size_t)(t + 2) * kstep;
      const char* b2 = last ? nB : cB + (size_t)(t + 2) * kstep;
      const char* a3 = a2 + kstep;
      const char* b3 = b2 + kstep;
      PG8_LDB(B0, 0, 0); PG8_SCHED; PG8_LDA(At, 0, 0); PG8_STAGE(PG8_SA(1, 1), a1 + hstepA, voffA);
      PG8_WAIT_L(8); PG8_BAR; PG8_WAIT_L(0); PG8_MMA(0, 0, At, B0); PG8_BAR; PG8_SCHED;
      PG8_LDB(B1, 0, 1); PG8_STAGE(PG8_SB(0, 0), b2, voffB);
      PG8_BAR; PG8_WAIT_L(0); PG8_MMA(0, 1, At, B1); PG8_BAR;
      PG8_LDA(At, 0, 1); PG8_STAGE(PG8_SA(0, 0), a2, voffA);
      PG8_BAR; PG8_WAIT_L(0); PG8_MMA(1, 0, At, B0); PG8_BAR; PG8_SCHED;
      PG8_STAGE(PG8_SB(0, 1), b2 + hstepB, voffB);
      PG8_WAIT_V(6); PG8_BAR; PG8_MMA(1, 1, At, B1); PG8_BAR;
      PG8_LDB(B0, 1, 0); PG8_SCHED; PG8_LDA(At, 1, 0); PG8_STAGE(PG8_SA(0, 1), a2 + hstepA, voffA);
      PG8_WAIT_L(8); PG8_BAR; PG8_WAIT_L(0); PG8_MMA(0, 0, At, B0); PG8_BAR; PG8_SCHED;
      PG8_LDB(B1, 1, 1); PG8_STAGE(PG8_SB(1, 0), b3, voffB);
      PG8_BAR; PG8_WAIT_L(0); PG8_MMA(0, 1, At, B1); PG8_BAR;
      PG8_LDA(At, 1, 1); PG8_STAGE(PG8_SA(1, 0), a3, voffA);
      PG8_BAR; PG8_WAIT_L(0); PG8_MMA(1, 0, At, B0); PG8_BAR; PG8_SCHED;
      PG8_STAGE(PG8_SB(1, 1), b3 + hstepB, voffB);
      PG8_WAIT_V(6); PG8_BAR; PG8_MMA(1, 1, At, B1); PG8_BAR;
    }
    E(acc, cur, wr, wc, fr, fq);
    if (!has_next) break;
#pragma unroll
    for (int a = 0; a < 2; ++a)
#pragma unroll
      for (int b = 0; b < 2; ++b)
#pragma unroll
        for (int m = 0; m < 4; ++m)
#pragma unroll
          for (int n = 0; n < 2; ++n) acc[a][b][m][n] = (f32x4){0.f, 0.f, 0.f, 0.f};
    cur = nxt; cA = nA; cB = nB; ++ui;
  }
  PG8_WAIT_V(0);
  if (wr == 0) PG8_BAR;
  PG8_BAR;
#undef PG8_SA
#undef PG8_SB
#undef PG8_STAGE
#undef PG8_LDA
#undef PG8_LDB
#undef PG8_MMA
#undef PG8_WAIT_V
#undef PG8_WAIT_L
#undef PG8_BAR
#undef PG8_SCHED
}

struct EpiInProjT {
  const Params& P;
  int l;
  DEV void operator()(const f32x4 (&acc)[2][2][4][2], const Unit& u, int wr, int wc, int fr, int fq) const {
#pragma unroll
    for (int bj = 0; bj < 2; ++bj) {
      const int cg = u.pn * 256 + bj * 128 + wc * 32;
      if (cg >= 4368) continue;
#pragma unroll
      for (int ai = 0; ai < 2; ++ai)
#pragma unroll
        for (int m = 0; m < 4; ++m) {
          const int row = u.pm * 256 + ai * 128 + wr * 64 + m * 16 + fr;
          const f32x4 v0 = acc[ai][bj][m][0], v1 = acc[ai][bj][m][1];
          if (cg < C_WQ) {
            u16* dst = WS_P(P) + (size_t)row * PW + cg + 4 * fq;
            *reinterpret_cast<uint2*>(dst) = make_uint2(pack2(v0[0], v0[1]), pack2(v0[2], v0[3]));
            *reinterpret_cast<uint2*>(dst + 16) = make_uint2(pack2(v1[0], v1[1]), pack2(v1[2], v1[3]));
          } else if (cg < 3712) {
            const bool isq = (cg < C_WK) || (cg >= C_DQ && cg < C_DK);
            const float qs = isq ? 0.125f : 1.f;
            u16* dst = WS_P(P) + (size_t)row * PW + cg + 4 * fq;
            float o1[4], o2[4];
            if (row < NLAT) {
              const int t = row & (T - 1), hf = (cg >> 5) & 1;
              const float4* rt = reinterpret_cast<const float4*>(WS_ROPE(P) + ((size_t)t * 32 + hf * 16 + 4 * fq) * 2);
              const float4 c01 = rt[0], c23 = rt[1];
              const float cs[4] = {c01.x, c01.z, c23.x, c23.z}, sn[4] = {c01.y, c01.w, c23.y, c23.w};
#pragma unroll
              for (int e = 0; e < 4; ++e) { o1[e] = (v0[e] * cs[e] - v1[e] * sn[e]) * qs; o2[e] = (v1[e] * cs[e] + v0[e] * sn[e]) * qs; }
            } else {
#pragma unroll
              for (int e = 0; e < 4; ++e) { o1[e] = v0[e] * qs; o2[e] = v1[e] * qs; }
            }
            *reinterpret_cast<uint2*>(dst) = make_uint2(pack2(o1[0], o1[1]), pack2(o1[2], o1[3]));
            *reinterpret_cast<uint2*>(dst + 16) = make_uint2(pack2(o2[0], o2[1]), pack2(o2[2], o2[3]));
          } else if (cg < 4352) {
            int b, key;
            if (row < NLAT) { b = row >> 12; key = 256 + (row & (T - 1)); }
            else { b = (row - NLAT) >> 8; key = (row - NLAT) & 255; }
            u16* base;
            int v0i;
            if (cg < 3840) { base = WS_VTW(P) + ((size_t)(b * 2 + ((cg - 3712) >> 6)) * 64) * KEYS; v0i = (cg - 3712) & 63; }
            else { base = WS_VTD(P) + ((size_t)(b * 4 + ((cg - 3840) >> 7)) * 128) * KEYS; v0i = (cg - 3840) & 127; }
#pragma unroll
            for (int e = 0; e < 4; ++e) {
              base[(size_t)(v0i + 4 * fq + e) * KEYS + key] = f2bf(v0[e]);
              base[(size_t)(v0i + 16 + 4 * fq + e) * KEYS + key] = f2bf(v1[e]);
            }
          } else {
            const float4 bg = *reinterpret_cast<const float4*>(P.b_gate + l * 16 + 4 * fq);
            *reinterpret_cast<float4*>(WS_GATES(P) + (size_t)row * 16 + 4 * fq) = make_float4(v0[0] + bg.x, v0[1] + bg.y, v0[2] + bg.z, v0[3] + bg.w);
          }
        }
    }
  }
};
struct EpiResidT {
  const Params& P;
  const float* src_lat;
  const float* modl;
  int gt_off;
  DEV void operator()(const f32x4 (&acc)[2][2][4][2], const Unit& u, int wr, int wc, int fr, int fq) const {
#pragma unroll
    for (int ai = 0; ai < 2; ++ai)
#pragma unroll
      for (int m = 0; m < 4; ++m) {
        const int row = u.pm * 256 + ai * 128 + wr * 64 + m * 16 + fr;
        const float* src;
        float* dst;
        int cond;
        if (row < NLAT) { src = src_lat + (size_t)row * 1024; dst = P.out + (size_t)row * 1024; cond = row >> 12; }
        else { src = WS_XC(P) + (size_t)(row - NLAT) * 1024; dst = WS_XC(P) + (size_t)(row - NLAT) * 1024; cond = 16; }
        const float* gt = modl + (size_t)cond * 6144 + gt_off;
#pragma unroll
        for (int bj = 0; bj < 2; ++bj)
#pragma unroll
          for (int n = 0; n < 2; ++n) {
            const int col = u.pn * 256 + bj * 128 + wc * 32 + n * 16 + 4 * fq;
            const float4 s4 = *reinterpret_cast<const float4*>(src + col), g4 = *reinterpret_cast<const float4*>(gt + col);
            const f32x4 a = acc[ai][bj][m][n];
            *reinterpret_cast<float4*>(dst + col) = make_float4(s4.x + g4.x * a[0], s4.y + g4.y * a[1], s4.z + g4.z * a[2], s4.w + g4.w * a[3]);
          }
      }
  }
};
struct EpiSwigluT {
  u16* act;
  DEV void operator()(const f32x4 (&acc)[2][2][4][2], const Unit& u, int wr, int wc, int fr, int fq) const {
#pragma unroll
    for (int ai = 0; ai < 2; ++ai)
#pragma unroll
      for (int m = 0; m < 4; ++m) {
        const int row = u.pm * 256 + ai * 128 + wr * 64 + m * 16 + fr;
#pragma unroll
        for (int bj = 0; bj < 2; ++bj) {
          const int cg = u.pn * 256 + bj * 128 + wc * 32;
          const f32x4 g = acc[ai][bj][m][0], up = acc[ai][bj][m][1];
          *reinterpret_cast<uint2*>(act + (size_t)row * FH + (cg >> 1) + 4 * fq) =
              make_uint2(pack2(siluf_(g[0]) * up[0], siluf_(g[1]) * up[1]), pack2(siluf_(g[2]) * up[2], siluf_(g[3]) * up[3]));
        }
      }
  }
};
}


#ifdef SELFCHECK
#define DBGF(P) reinterpret_cast<float*>((P).ws + O_XC + (size_t)NCTXR * 1024 * 4)
DEV float blk_reduce(float v, bool ismax, float* red) {
  const int tid = my_tid(), lane = tid & 63, wid = tid >> 6;
#pragma unroll
  for (int o = 32; o > 0; o >>= 1) { float t = __shfl_xor(v, o); v = ismax ? fmaxf(v, t) : v + t; }
  __syncthreads();
  if (lane == 0) red[wid] = v;
  __syncthreads();
  float r = red[0];
  for (int i = 1; i < 8; ++i) r = ismax ? fmaxf(r, red[i]) : r + red[i];
  __syncthreads();
  return r;
}
DEV void chk_sample(int s, int& b, int& hd, int& t) {
  const int ti = s & 7;
  b = (s * 5 + 3) & 15; hd = s & 7;
  t = ti == 0 ? 0 : ti == 1 ? 63 : ti == 2 ? 64 : ti == 3 ? 127 : ti == 4 ? 2048 + 65 : ti == 5 ? 3000 : ti == 6 ? 4032 : 4095;
}
DEV void check_pre(const Params& P, int l, char* smem) {
  const int tid = my_tid();
  float* sc = reinterpret_cast<float*>(smem);
  float* red = sc + 2 * 4352;
  float* ov = red + 16;
  float* dbg = DBGF(P);
  const u16* p = WS_P(P);
  for (int it = blockIdx.x; it < 24; it += gridDim.x) {
    const bool isdiff = it >= 12;
    const int s = isdiff ? it - 12 : it;
    int b, hd, t;
    chk_sample(s, b, hd, t);
    const bool ctxq = s >= 8;
    if (ctxq) t &= 255;
    const size_t row = ctxq ? (size_t)NLAT + b * 256 + t : (size_t)b * T + t;
    __syncthreads();
    if (!isdiff) {
      const int head = hd, g = head >> 2;
      const int lo = ctxq ? 0 : max(0, t - 128), hi = ctxq ? -1 : min(T - 1, t + 128);
      const int nk = 256 + (hi - lo + 1);
      float mx = -1e30f;
      for (int k = tid; k < nk; k += NTHREADS) {
        size_t krow = k < 256 ? (size_t)NLAT + b * 256 + k : (size_t)b * T + lo + (k - 256);
        float a = 0.f;
        for (int d = 0; d < 64; ++d) a += bf2f(p[row * PW + C_WQ + head * 64 + d]) * bf2f(p[krow * PW + C_WK + g * 64 + d]);
        sc[k] = a;
        mx = fmaxf(mx, a);
      }
      mx = blk_reduce(mx, true, red);
      const float sk = P.sink[l * 8 + head];
      mx = fmaxf(mx, sk);
      float sm = 0.f;
      for (int k = tid; k < nk; k += NTHREADS) { float e = expf(sc[k] - mx); sc[k] = e; sm += e; }
      sm = blk_reduce(sm, false, red) + expf(sk - mx);
      if (tid < 64) {
        float o = 0.f;
        for (int k = 0; k < nk; ++k) {
          int kidx = k < 256 ? k : 256 + lo + (k - 256);
          o += sc[k] * bf2f(WS_VTW(P)[((size_t)(b * 2 + g) * 64 + tid) * KEYS + kidx]);
        }
        dbg[it * 128 + tid] = o / sm;
      }
    } else {
      const int h = hd & 3;
      const int nk = ctxq ? 256 : KEYS;
      float mx0 = -1e30f, mx1 = -1e30f;
      for (int k = tid; k < nk; k += NTHREADS) {
        size_t krow = k < 256 ? (size_t)NLAT + b * 256 + k : (size_t)b * T + (k - 256);
        float a0 = 0.f, a1 = 0.f;
        for (int d = 0; d < 64; ++d) {
          a0 += bf2f(p[row * PW + C_DQ + h * 128 + d]) * bf2f(p[krow * PW + C_DK + h * 128 + d]);
          a1 += bf2f(p[row * PW + C_DQ + h * 128 + 64 + d]) * bf2f(p[krow * PW + C_DK + h * 128 + 64 + d]);
        }
        sc[k] = a0; sc[4352 + k] = a1;
        mx0 = fmaxf(mx0, a0); mx1 = fmaxf(mx1, a1);
      }
      mx0 = blk_reduce(mx0, true, red);
      mx1 = blk_reduce(mx1, true, red);
      float s0 = 0.f, s1 = 0.f;
      for (int k = tid; k < nk; k += NTHREADS) {
        float e0 = expf(sc[k] - mx0), e1 = expf(sc[4352 + k] - mx1);
        sc[k] = e0; sc[4352 + k] = e1; s0 += e0; s1 += e1;
      }
      s0 = blk_reduce(s0, false, red);
      s1 = blk_reduce(s1, false, red);
      const float lam = WS_LAM(P)[l], lam_init = 0.8f - 0.6f * expf(-0.3f * (float)l);
      float y = 0.f;
      if (tid < 128) {
        for (int k = 0; k < nk; ++k)
          y += (sc[k] / s0 - lam * sc[4352 + k] / s1) * bf2f(WS_VTD(P)[((size_t)(b * 4 + h) * 128 + tid) * KEYS + k]);
        ov[tid] = y;
      }
      __syncthreads();
      if (tid < 128) {
        float ss = 0.f;
        for (int v = 0; v < 128; ++v) ss += ov[v] * ov[v];
        dbg[it * 128 + tid] = y * rsqrtf(ss / 128.f + EPS) * P.d_norm[l * 512 + h * 128 + tid] * (1.f - lam_init);
      }
    }
  }
}
DEV void check_post(const Params& P, int l, unsigned* flags) {
  const int tid = my_tid();
  const float* dbg = DBGF(P);
  const u16* p = WS_P(P);
  for (int it = blockIdx.x; it < 24; it += gridDim.x) {
    const bool isdiff = it >= 12;
    const int s = isdiff ? it - 12 : it;
    int b, hd, t;
    chk_sample(s, b, hd, t);
    const bool ctxq = s >= 8;
    if (ctxq) t &= 255;
    const size_t row = ctxq ? (size_t)NLAT + b * 256 + t : (size_t)b * T + t;
    if (ctxq && l != 0) continue;
    const int n = isdiff ? 128 : 64;
    if (tid < n) {
      float got = isdiff ? bf2f(p[row * PW + C_DQ + (hd & 3) * 128 + tid]) : bf2f(p[row * PW + C_WQ + hd * 64 + tid]);
      float ex = dbg[it * 128 + tid];
      if (!(fabsf(got - ex) <= 0.03f + 0.03f * fabsf(ex))) atomicOr(flags, isdiff ? (ctxq ? 32u : 2u) : (ctxq ? 16u : 1u));
    }
  }
}
DEV void check_mlstm(const Params& P, int l, char* smem, unsigned* flags) {
  const int tid = my_tid(), lane = tid & 63;
  float* qs = reinterpret_cast<float*>(smem);
  float* ks = qs + 128;
  float* vs = ks + 128;
  float* nn = vs + 128;
  float* sc = nn + 128;
  float* red = sc + 8;
  const u16* p = WS_P(P);
  for (int it = blockIdx.x; it < 4; it += gridDim.x) {
    const int b = (it * 7 + 2) & 15, hd = (it + 1) & 3, dir = it & 1;
    const int v = tid >> 2, kq = tid & 3;
    float C[32];
#pragma unroll
    for (int j = 0; j < 32; ++j) C[j] = 0.f;
    __syncthreads();
    if (tid < 128) nn[tid] = 0.f;
    if (tid == 0) sc[0] = 0.f;
    __syncthreads();
    const int nsteps = (l == 0) ? 256 + T : 256 + T;
    for (int st = 0; st < nsteps; ++st) {
      int seg0, seglen, u;
      if (st < 256) { seg0 = NLAT + b * 256; seglen = 256; u = dir ? 255 - st : st; }
      else { seg0 = b * T; seglen = T; u = dir ? T - 1 - (st - 256) : st - 256; }
      const size_t row = (size_t)seg0 + u;
      if (tid < 128) {
        float xq = 0.f, xk = 0.f;
        for (int tp = 0; tp < 3; ++tp) {
          int uu = u + tp - 1;
          if (uu >= 0 && uu < seglen) {
            xq += P.conv_w[(size_t)l * 3072 + tp * 1024 + hd * 128 + tid] * bf2f(p[((size_t)seg0 + uu) * PW + C_MQ + hd * 128 + tid]);
            xk += P.conv_w[(size_t)l * 3072 + tp * 1024 + 512 + hd * 128 + tid] * bf2f(p[((size_t)seg0 + uu) * PW + C_MK + hd * 128 + tid]);
          }
        }
        qs[tid] = xq / (1.f + expf(-xq));
        ks[tid] = xk / (1.f + expf(-xk)) * 0.08838834764831845f;
        vs[tid] = bf2f(p[row * PW + C_MV + hd * 128 + tid]);
      }
      if (tid == 0) {
        float ig = WS_GATES(P)[row * 16 + dir * 8 + hd], fg = WS_GATES(P)[row * 16 + dir * 8 + 4 + hd];
        float lf = fminf(fg, 0.f) - log1pf(expf(-fabsf(fg)));
        float m = sc[0], mn = fmaxf(lf + m, ig);
        sc[1] = expf(lf + m - mn);
        sc[2] = expf(ig - mn);
        sc[3] = mn;
      }
      __syncthreads();
      const float fd = sc[1], iw = sc[2], mn = sc[3];
      float pd = 0.f;
#pragma unroll
      for (int j = 0; j < 32; ++j) {
        C[j] = fd * C[j] + iw * vs[v] * ks[kq * 32 + j];
        pd += C[j] * qs[kq * 32 + j];
      }
      pd += __shfl_xor(pd, 1);
      pd += __shfl_xor(pd, 2);
      float dn = 0.f;
      if (tid < 128) { float nv = fd * nn[tid] + iw * ks[tid]; nn[tid] = nv; dn = nv * qs[tid]; }
      dn = blk_reduce(dn, false, red);
      if (tid == 0) sc[0] = mn;
      const float hval = pd / fmaxf(fabsf(dn), expf(-mn));
      float sq = (kq == 0) ? hval * hval : 0.f;
      sq = blk_reduce(sq, false, red);
      const float rms = sqrtf(sq / 128.f);
      const bool cmp = (st < 256) ? (l == 0) : true;
      if (cmp && kq == 0 && ((u & 63) == 0 || (u & 63) == 63 || (u % 97) == 0)) {
        float got = bf2f(WS_HFB(P)[(size_t)dir * MTOT * 512 + row * 512 + hd * 128 + v]);
        if (!(fabsf(got - hval) <= 0.05f * rms + 0.05f * fabsf(hval) + 1e-3f)) atomicOr(flags, dir ? 8u : 4u);
      }
    }
  }
}
#endif


#ifdef SELFCHECK
DEV void flag_if(bool bad, unsigned* flags, unsigned bit) { if (bad) atomicOr(flags, bit); }
DEV bool close_(float got, float ex, float tol) { return fabsf(got - ex) <= tol + tol * fabsf(ex); }
DEV void check_inproj(const Params& P, int l, char* smem, unsigned* flags) {
  const int tid = my_tid();
  float* red = reinterpret_cast<float*>(smem);
  float* hrow = red + 16;
  const float* modl = WS_MOD(P) + (size_t)l * 17 * 6144;
  for (int it = blockIdx.x; it < 64; it += gridDim.x) {
    const int ri = it & 7;
    const int row = ri == 0 ? 0 : ri == 1 ? 4095 : ri == 2 ? 4096 + 77 : ri == 3 ? 30000 : ri == 4 ? 65535 : ri == 5 ? NLAT : ri == 6 ? NLAT + 300 : MTOT - 1;
    const int cond = row < NLAT ? row >> 12 : 16;
    {
      int col = (it * 769 + 5) % 6144;
      float a = 0.f;
      for (int k = tid; k < 1024; k += NTHREADS) {
        float cv = cond < 16 ? P.c[cond * 1024 + k] : P.c_ctx[k];
        a += cv / (1.f + expf(-cv)) * P.w_mod[(size_t)l * 1024 * 6144 + (size_t)k * 6144 + col];
      }
      a = blk_reduce(a, false, red) + P.b_mod[l * 6144 + col];
      if (tid == 0) flag_if(!close_(modl[(size_t)cond * 6144 + col], a, 2e-3f), flags, 1u);
    }
    const float* xs = row < NLAT ? ((l == 0 ? P.x : P.out) + (size_t)row * 1024) : (WS_XC(P) + (size_t)(row - NLAT) * 1024);
    float ss = 0.f;
    for (int k = tid; k < 1024; k += NTHREADS) ss += xs[k] * xs[k];
    ss = blk_reduce(ss, false, red);
    const float rstd = rsqrtf(ss / 1024.f + EPS);
    for (int k = tid; k < 1024; k += NTHREADS) {
      float y = xs[k] * rstd * P.g_mix[l * 1024 + k] * (1.f + modl[(size_t)cond * 6144 + 1024 + k]) + modl[(size_t)cond * 6144 + k];
      hrow[k] = y;
      flag_if(!close_(bf2f(WS_H(P)[(size_t)row * 1024 + k]), y, 1e-2f), flags, 2u);
    }
    __syncthreads();
    const int oi = it >> 3;
    const int oj = (oi * 2 + (it & 1)) & 15;
    const int oc = oj == 0 ? 3 : oj == 1 ? 600 : oj == 2 ? 1100 : oj == 3 ? 1999 : oj == 4 ? 2050 : oj == 5 ? 2064 + 70 : oj == 6 ? 2576 + 100 :
                   oj == 7 ? 2704 + 5 : oj == 8 ? 2832 + 200 : oj == 9 ? 2832 + 37 : oj == 10 ? 3344 + 90 : oj == 11 ? 3344 + 300 :
                   oj == 12 ? 3856 + 10 : oj == 13 ? 3856 + 500 : oj == 14 ? 2048 + 15 : 2064 + 500;
    auto dotcol = [&](int c) {
      float a = 0.f;
      for (int k = tid; k < 1024; k += NTHREADS) a += hrow[k] * P.w_in[(size_t)l * 1024 * INW + (size_t)k * INW + c];
      return blk_reduce(a, false, red);
    };
    float val = dotcol(oc);
    const u16* p = WS_P(P);
    const bool lat = row < NLAT;
    const int t = row & (T - 1);
    float got = 0.f, ex = val;
    unsigned bit = 4u;
    if (oc < 2048) { got = bf2f(p[(size_t)row * PW + oc]); }
    else if (oc < 2064) { got = WS_GATES(P)[(size_t)row * 16 + oc - 2048]; ex = val + P.b_gate[l * 16 + oc - 2048]; }
    else if (oc >= 2704 && oc < 2832) {
      int cgi = oc - 2704, g = cgi >> 6, vd = cgi & 63;
      int b = lat ? row >> 12 : (row - NLAT) >> 8, key = lat ? 256 + t : (row - NLAT) & 255;
      got = bf2f(WS_VTW(P)[((size_t)(b * 2 + g) * 64 + vd) * KEYS + key]);
      bit = 8u;
    } else if (oc >= 3856) {
      int cgi = oc - 3856, h = cgi >> 7, vd = cgi & 127;
      int b = lat ? row >> 12 : (row - NLAT) >> 8, key = lat ? 256 + t : (row - NLAT) & 255;
      got = bf2f(WS_VTD(P)[((size_t)(b * 4 + h) * 128 + vd) * KEYS + key]);
      bit = 8u;
    } else {
      int base, nb0;
      bool isq;
      if (oc < 2576) { base = 2064; nb0 = C_WQ; isq = true; }
      else if (oc < 2704) { base = 2576; nb0 = C_WK; isq = false; }
      else if (oc < 3344) { base = 2832; nb0 = C_DQ; isq = true; }
      else { base = 3344; nb0 = C_DK; isq = false; }
      int rel = oc - base, dd = rel & 63, j = dd & 15, second = (dd >> 4) & 1, axis = dd >> 5;
      float other = dotcol(second ? oc - 16 : oc + 16);
      if (lat) {
        int pos = axis ? (t & 63) : (t >> 6);
        float ang = (float)pos * powf(10000.f, -(float)j / 16.f);
        float cs = cosf(ang), sn = sinf(ang);
        ex = second ? (val * cs + other * sn) : (val * cs - other * sn);
      }
      if (isq) ex *= 0.125f;
      got = bf2f(p[(size_t)row * PW + nb0 + rel]);
      bit = 16u;
    }
    if (tid == 0) flag_if(!close_(got, ex, 3e-2f), flags, bit);
    __syncthreads();
  }
}
DEV void check_post6(const Params& P, int l, char* smem, unsigned* flags, const float* xprev) {
  const int tid = my_tid();
  float* red = reinterpret_cast<float*>(smem);
  const u16* Yp = WS_P(P);
  const float* modl = WS_MOD(P) + (size_t)l * 17 * 6144;
  for (int it = blockIdx.x; it < 16; it += gridDim.x) {
    const int ri = it & 7;
    const int row = ri == 0 ? 1 : ri == 1 ? 4097 : ri == 2 ? 12345 : ri == 3 ? 40000 : ri == 4 ? 65534 : ri == 5 ? NLAT + 1 : ri == 6 ? NLAT + 2000 : MTOT - 2;
    if (row >= NLAT && l != 0) continue;
    const int col = (it * 331 + 17) & 1023;
    const int cond = row < NLAT ? row >> 12 : 16;
    float mg = 0.f;
    for (int i = 0; i < 3; ++i) {
      float a = 0.f, z = 0.f;
      for (int k = tid; k < 1024; k += NTHREADS) a += bf2f(WS_H(P)[(size_t)row * 1024 + k]) * P.w_in[(size_t)l * 1024 * INW + (size_t)k * INW + 4368 + i * 1024 + col];
      a = blk_reduce(a, false, red);
      const int yc = i == 0 ? C_MO : (i == 1 ? C_WQ : C_DQ);
      for (int k = tid; k < 512; k += NTHREADS) z += bf2f(Yp[(size_t)row * PW + yc + k]) * P.w_branch[((size_t)l * 3 + i) * 512 * 1024 + (size_t)k * 1024 + col];
      z = blk_reduce(z, false, red);
      mg += z / (1.f + expf(-a));
    }
    if (tid == 0) flag_if(!close_(bf2f(WS_HFB(P)[(size_t)row * 1024 + col]), mg, 3e-2f), flags, 1u);
    float o = 0.f;
    for (int k = tid; k < 1024; k += NTHREADS) o += bf2f(WS_HFB(P)[(size_t)row * 1024 + k]) * P.w_out[(size_t)l * 1024 * 1024 + (size_t)k * 1024 + col];
    o = blk_reduce(o, false, red);
    const float xo = row < NLAT ? xprev[(size_t)row * 1024 + col] : -1e9f;
    const float xn = row < NLAT ? P.out[(size_t)row * 1024 + col] : WS_XC(P)[(size_t)(row - NLAT) * 1024 + col];
    if (tid == 0 && row < NLAT && (l == 0)) flag_if(!close_(xn, xo + modl[(size_t)cond * 6144 + 2048 + col] * o, 2e-2f), flags, 2u);
    if (tid == 0) DBGF(P)[4096 + it] = xn;
  }
}
DEV void check_post9(const Params& P, int l, char* smem, unsigned* flags) {
  const int tid = my_tid();
  float* red = reinterpret_cast<float*>(smem);
  const float* modl = WS_MOD(P) + (size_t)l * 17 * 6144;
  for (int it = blockIdx.x; it < 16; it += gridDim.x) {
    const int ri = it & 7;
    const int row = ri == 0 ? 1 : ri == 1 ? 4097 : ri == 2 ? 12345 : ri == 3 ? 40000 : ri == 4 ? 65534 : ri == 5 ? NLAT + 1 : ri == 6 ? NLAT + 2000 : MTOT - 2;
    if (row >= NLAT && l != 0) continue;
    const int col = (it * 331 + 17) & 1023;
    const int cond = row < NLAT ? row >> 12 : 16;
    const int j = (it * 97 + 13) % FH;
    float g = 0.f, u = 0.f;
    for (int k = tid; k < 1024; k += NTHREADS) {
      float hv = bf2f(WS_H(P)[(size_t)row * 1024 + k]);
      g += hv * P.w_ffn_in[(size_t)l * 1024 * 5632 + (size_t)k * 5632 + j];
      u += hv * P.w_ffn_in[(size_t)l * 1024 * 5632 + (size_t)k * 5632 + FH + j];
    }
    g = blk_reduce(g, false, red);
    u = blk_reduce(u, false, red);
    if (tid == 0) flag_if(!close_(bf2f(WS_P(P)[(size_t)row * FH + j]), g / (1.f + expf(-g)) * u, 3e-2f), flags, 4u);
    float o = 0.f;
    for (int k = tid; k < FH; k += NTHREADS) o += bf2f(WS_P(P)[(size_t)row * FH + k]) * P.w_ffn_out[(size_t)l * FH * 1024 + (size_t)k * 1024 + col];
    o = blk_reduce(o, false, red);
    const float xn = row < NLAT ? P.out[(size_t)row * 1024 + col] : WS_XC(P)[(size_t)(row - NLAT) * 1024 + col];
    if (tid == 0) flag_if(!close_(xn, DBGF(P)[4096 + it] + modl[(size_t)cond * 6144 + 5120 + col] * o, 2e-2f), flags, 8u);
  }
}
#endif

#ifdef DEBUG_STAGE
DEV void debug_dump(const Params& P, int stage) {
  const int tid = my_tid();
  for (size_t idx = (size_t)blockIdx.x * NTHREADS + tid; idx < (size_t)NLAT * 1024; idx += (size_t)gridDim.x * NTHREADS) {
    size_t row = idx >> 10;
    int c = (int)(idx & 1023);
    size_t r2 = row + (row < 4096 ? NLAT : 0);
    float v = 0.f;
    const u16* p = WS_P(P);
    if (stage == 1) {
      v = bf2f(p[row * PW + c]) + bf2f(p[row * PW + 1024 + c]) + bf2f(p[row * PW + 2048 + c]) + (c < 640 ? bf2f(p[row * PW + 3072 + c]) : 0.f);
      v += bf2f(p[r2 * PW + c]) + bf2f(p[r2 * PW + 1024 + c]) + bf2f(p[r2 * PW + 2048 + c]);
      v += bf2f(WS_VTD(P)[r2 * 512 + (c & 511)]) + bf2f(WS_VTW(P)[r2 * 128 + (c & 127)]) + WS_GATES(P)[r2 * 16 + (c & 15)];
      v += bf2f(WS_VTD(P)[row * 512 + (c & 511)]) + bf2f(WS_VTW(P)[row * 128 + (c & 127)]) + WS_GATES(P)[row * 16 + (c & 15)];
    } else if (stage == 21) {
      v = bf2f(WS_HFB(P)[row * 512 + (c & 511)]) + 2.f * bf2f(WS_HFB(P)[(size_t)MTOT * 512 + row * 512 + (c & 511)]);
      v += bf2f(WS_HFB(P)[r2 * 512 + (c & 511)]) + 2.f * bf2f(WS_HFB(P)[(size_t)MTOT * 512 + r2 * 512 + (c & 511)]);
    } else if (stage == 22) {
      v = bf2f(p[row * PW + C_WQ + (c & 511)]) + bf2f(p[r2 * PW + C_WQ + (c & 511)]);
    } else if (stage == 23) {
      v = bf2f(p[row * PW + C_DQ + (c & 511)]) + bf2f(p[r2 * PW + C_DQ + (c & 511)]);
    } else if (stage == 3) {
      v = bf2f(WS_HFB(P)[row * 1024 + c]) + bf2f(WS_HFB(P)[r2 * 1024 + c]);
    } else if (stage == 4) {
      v = P.out[idx] + WS_XC(P)[(row & 4095) * 1024 + c];
    } else if (stage == 5) {
      v = bf2f(WS_H(P)[row * 1024 + c]) + bf2f(WS_H(P)[r2 * 1024 + c]);
    } else if (stage == 6) {
      v = bf2f(p[row * FH + c]) + bf2f(p[row * FH + 1024 + c]) + bf2f(p[r2 * FH + 1792 + c]);
    }
    if (stage != 4) P.out[idx] = v; else P.out[idx] = v;
  }
}
#define DBG(st) if (l == 0 && DEBUG_STAGE == st) { GSYNC_ONLY(); debug_dump(P, st); return true; }
#else
#define DBG(st)
#endif
template <int l>
DEV bool layer_body(const Params& P, unsigned* bar, unsigned& epoch, char* smem) {
  constexpr bool need_ctx = (l == 0);
  const float* modl = WS_MOD(P) + (size_t)l * 17 * 6144;
  const u16* Wl = WS_W(P) + (size_t)l * W_LAYER;
  const float* xlat = l == 0 ? P.x : P.out;
  constexpr int Mtok = need_ctx ? MTOT : NLAT;
  phase_norm_mod(P, xlat, WS_XC(P), MTOT, P.g_mix + l * 1024, modl, 0, 1024);
  GSYNC();
  pg8::gemm_phase(smem, WS_H(P), 1024, Wl + W_IN, 1024, MTOT, NIN, 1024, pg8::EpiInProjT{P, l});
#ifdef REPEAT_GEMMS
  if (l == 1) pg8::gemm_phase(smem, WS_H(P), 1024, Wl + W_IN, 1024, MTOT, NIN, 1024, pg8::EpiInProjT{P, l});
#endif
  GSYNC();
  DBG(1)
#ifdef SELFCHECK
#if SELFCHECK == 2
  check_inproj(P, l, smem, WS_CTR(P) + 16 + l * 3);
#else
  check_pre(P, l, smem);
#endif
  GSYNC();
#endif
  phase_mixers(P, l, smem);
  GSYNC();
#if defined(SELFCHECK) && SELFCHECK == 1
  check_post(P, l, WS_CTR(P) + 17 + l * 3);
  check_mlstm(P, l, smem, WS_CTR(P) + 17 + l * 3);
  GSYNC();
#endif
  DBG(21)
  DBG(22)
  DBG(23)
  phase_ya(P, l, Mtok);
  GSYNC();
  phase_merge(P, l, Mtok, smem);
#ifdef REPEAT_GEMMS
  if (l == 1) phase_merge(P, l, Mtok, smem);
#endif
  GSYNC();
  DBG(3)
  pg8::gemm_phase(smem, WS_HFB(P), 1024, Wl + W_O, 1024, Mtok, 1024, 1024, pg8::EpiResidT{P, xlat, modl, 2048});
  GSYNC();
#if defined(SELFCHECK) && SELFCHECK == 2
  check_post6(P, l, smem, WS_CTR(P) + 18 + l * 3, xlat);
  GSYNC();
#endif
  DBG(4)
  phase_norm_mod(P, P.out, WS_XC(P), Mtok, P.g_ffn + l * 1024, modl, 3072, 4096);
  GSYNC();
  DBG(5)
  pg8::gemm_phase(smem, WS_H(P), 1024, Wl + W_FI, 1024, Mtok, 5632, 1024, pg8::EpiSwigluT{WS_P(P)});
#ifdef REPEAT_GEMMS
  if (l == 1) pg8::gemm_phase(smem, WS_H(P), 1024, Wl + W_FI, 1024, Mtok, 5632, 1024, pg8::EpiSwigluT{WS_P(P)});
#endif
  GSYNC();
  DBG(6)
  pg8::gemm_phase(smem, WS_P(P), FH, Wl + W_FO, FH, Mtok, 1024, FH, pg8::EpiResidT{P, P.out, modl, 5120});
  GSYNC();
#if defined(SELFCHECK) && SELFCHECK == 2
  check_post9(P, l, smem, WS_CTR(P) + 18 + l * 3);
  GSYNC();
#endif
  return false;
}

__global__ void __launch_bounds__(NTHREADS) fwd_megakernel(Params P) {
  extern __shared__ __attribute__((aligned(16))) char smem[];
  cg::grid_group grid = cg::this_grid();
  unsigned* bar = WS_CTR(P) + 64;
  unsigned epoch = 0;
  grid.sync();
  phase_prologue(P, smem);
  GSYNC();
  if (layer_body<0>(P, bar, epoch, smem)) return;
  if (layer_body<1>(P, bar, epoch, smem)) return;
  phase_final_norm(P);
#ifdef SELFCHECK
  GSYNC();
  if (blockIdx.x == 0 && my_tid() == 0) {
    float scale = 1000.f;
    for (int w = 0; w < 6; ++w) {
      unsigned f = WS_CTR(P)[16 + w];
      if (f) { P.out[0] = (10.f + (float)f) * scale; break; }
      scale *= 10.f;
    }
  }
#endif
}

extern "C" void kernel_launch(void* const* d_in, const int* in_sizes, int n_in, void* d_out, int out_size, void* d_ws,
                              size_t ws_size, hipStream_t stream) {
  static int grid_blocks = 0;
  if (!grid_blocks) {
    int dev = 0, cus = 0, per_cu = 0;
    hipGetDevice(&dev);
    hipDeviceGetAttribute(&cus, hipDeviceAttributeMultiprocessorCount, dev);
    hipFuncSetAttribute((const void*)fwd_megakernel, hipFuncAttributeMaxDynamicSharedMemorySize, LDS_BYTES);
    hipOccupancyMaxActiveBlocksPerMultiprocessor(&per_cu, fwd_megakernel, NTHREADS, LDS_BYTES);
    if (per_cu < 1) per_cu = 1;
    if (per_cu > 1) per_cu = 1;
    grid_blocks = cus * per_cu;
  }
  Params P{};
  const float* const* in = reinterpret_cast<const float* const*>(d_in);
  P.x = in[0]; P.c = in[1]; P.ctx = in[2]; P.c_ctx = in[3]; P.w_mod = in[4]; P.b_mod = in[5]; P.g_mix = in[6];
  P.g_ffn = in[7]; P.w_in = in[8]; P.b_gate = in[9]; P.conv_w = in[10]; P.m_norm = in[11]; P.sink = in[12];
  P.lam_q1 = in[13]; P.lam_k1 = in[14]; P.lam_q2 = in[15]; P.lam_k2 = in[16]; P.d_norm = in[17]; P.w_branch = in[18];
  P.w_out = in[19]; P.w_ffn_in = in[20]; P.w_ffn_out = in[21]; P.g_final = in[22];
  P.out = reinterpret_cast<float*>(d_out);
  P.ws = reinterpret_cast<char*>(d_ws);
  if (WS_TOTAL > ws_size) fprintf(stderr, "workspace too small: need %zu have %zu\n", (size_t)WS_TOTAL, ws_size);
  hipMemsetAsync(P.ws + O_CTR, 0, 2048, stream);
  void* args[] = {&P};
  hipError_t e = hipLaunchCooperativeKernel((const void*)fwd_megakernel, dim3(grid_blocks), dim3(NTHREADS), args, LDS_BYTES, stream);
  if (e != hipSuccess) fprintf(stderr, "cooperative launch failed: %s (grid %d)\n", hipGetErrorString(e), grid_blocks);
}
```
